# Optimizing an MI355X kernel written in HIP

```python
import math
import jax
import jax.numpy as jnp
from jax import lax
import numpy as np

D_MODEL = 1024
BATCH = 4
SEQ = 8192
DEPTH = 2

A_WIDTH = 512
A_CONV = 3
B_WIDTH = 512
B_CONV = 31
C_HEADS = 8
C_HEAD_DIM = 64
IDX_HEADS = 8
IDX_DIM = 32
TOPK_MAX = 256
DIFF_HEADS = 4
DIFF_HEAD_DIM = 64
NUM_BUCKETS = 32
MAX_DISTANCE = 128
N_ATTN_HEADS = C_HEADS + DIFF_HEADS
N_GROUPS = 4
EXPERTS_PER_GROUP = 8
N_EXPERTS = N_GROUPS * EXPERTS_PER_GROUP
TOP_E = 2
D_EXPERT = 512
Q_BLOCK = 128
MOE_BLOCK = 128
EPS = 1e-6
N_EVEN = (DEPTH + 1) // 2
N_ODD = DEPTH // 2

AB_SIZES = (A_WIDTH, A_WIDTH, A_WIDTH, B_WIDTH, B_WIDTH)
AB_IN = 3 * A_WIDTH + 2 * B_WIDTH
C_WIDTH = C_HEADS * C_HEAD_DIM
DIFF_QK = DIFF_HEADS * 2 * DIFF_HEAD_DIM
DIFF_V = DIFF_HEADS * 2 * DIFF_HEAD_DIM
CD_SIZES = (C_WIDTH, C_WIDTH, C_WIDTH, IDX_HEADS * IDX_DIM, IDX_DIM, IDX_HEADS, DIFF_QK, DIFF_QK, DIFF_V)
CD_IN = 3 * C_WIDTH + IDX_HEADS * IDX_DIM + IDX_DIM + IDX_HEADS + 2 * DIFF_QK + DIFF_V

kernel_name = 'hybrid_conv_sparse_diff_hmoe_trunk'


def rmsnorm(x, g):
    xf = x.astype(jnp.float32)
    y = xf * lax.rsqrt(jnp.mean(xf * xf, axis=-1, keepdims=True) + EPS)
    return (y * g.astype(jnp.float32)).astype(x.dtype)


def layernorm(x, g, b):
    xf = x.astype(jnp.float32)
    mu = jnp.mean(xf, axis=-1, keepdims=True)
    var = jnp.mean(jnp.square(xf - mu), axis=-1, keepdims=True)
    y = (xf - mu) * lax.rsqrt(var + EPS) * g.astype(jnp.float32) + b.astype(jnp.float32)
    return y.astype(x.dtype)


def modulate(h, shift, scale):
    return h * (1 + scale[:, None, :]) + shift[:, None, :]


def split_cols(z, sizes):
    cuts = [int(v) for v in np.cumsum(sizes)[:-1]]
    return jnp.split(z, cuts, axis=-1)


def causal_depthwise_conv(u, w):
    width, ch = w.shape
    return lax.conv_general_dilated(u, w[:, None, :].astype(u.dtype), window_strides=(1,),
                                    padding=[(width - 1, 0)],
                                    dimension_numbers=('NWC', 'WIO', 'NWC'),
                                    feature_group_count=ch)


def rel_bucket(dist):
    max_exact = NUM_BUCKETS // 2
    n = jnp.maximum(dist, 0)
    log_ratio = jnp.log(jnp.maximum(n, 1).astype(jnp.float32) / max_exact) / math.log(MAX_DISTANCE / max_exact)
    large = max_exact + (log_ratio * (NUM_BUCKETS - max_exact)).astype(jnp.int32)
    return jnp.where(n < max_exact, n, jnp.minimum(large, NUM_BUCKETS - 1))


def conv_mixers(h, w_in, conv_a, conv_b, conv_b_bias, ln_g, ln_b, w_out):
    gate_b, gate_c, x_a, val_b, glu_gate = split_cols(h @ w_in, AB_SIZES)
    y_a = gate_b * causal_depthwise_conv(gate_c * x_a, conv_a)
    u = causal_depthwise_conv(val_b * jax.nn.sigmoid(glu_gate), conv_b) + conv_b_bias
    y_b = jax.nn.silu(layernorm(u, ln_g, ln_b))
    return jnp.concatenate([y_a, y_b], axis=-1) @ w_out


def attn_mixers(h, positions, w_in, rel_bias, diff_lam, diff_norm_g, w_out, lambda_init):
    bsz, seq, _ = h.shape
    n_blocks = seq // Q_BLOCK
    topk = min(TOPK_MAX, seq // 4)
    q_c, k_c, v_c, q_idx, k_idx, w_idx, q_d, k_d, v_d = split_cols(h @ w_in, CD_SIZES)
    q_c = q_c.reshape(bsz, seq, C_HEADS, C_HEAD_DIM)
    k_c = k_c.reshape(bsz, seq, C_HEADS, C_HEAD_DIM)
    v_c = v_c.reshape(bsz, seq, C_HEADS, C_HEAD_DIM)
    q_idx = q_idx.reshape(bsz, seq, IDX_HEADS, IDX_DIM)
    q_d = q_d.reshape(bsz, seq, DIFF_HEADS, 2, DIFF_HEAD_DIM)
    k_d = k_d.reshape(bsz, seq, DIFF_HEADS, 2, DIFF_HEAD_DIM)
    q1, q2 = q_d[..., 0, :], q_d[..., 1, :]
    k1, k2 = k_d[..., 0, :], k_d[..., 1, :]
    v_d = v_d.reshape(bsz, seq, DIFF_HEADS, 2 * DIFF_HEAD_DIM)
    lam_f = diff_lam.astype(jnp.float32)
    lam = jnp.exp(jnp.sum(lam_f[0] * lam_f[1])) - jnp.exp(jnp.sum(lam_f[2] * lam_f[3])) + lambda_init
    bias_c = rel_bias[:, :C_HEADS]
    bias_d = rel_bias[:, C_HEADS:]
    scale_c = C_HEAD_DIM ** -0.5
    scale_d = DIFF_HEAD_DIM ** -0.5
    scale_idx = (IDX_DIM * IDX_HEADS) ** -0.5
    gather_rows = jax.vmap(lambda a, i: a[i])

    def block(j):
        s0 = j * Q_BLOCK
        take = lambda a: lax.dynamic_slice_in_dim(a, s0, Q_BLOCK, axis=1)
        pos_q = take(positions)
        causal = positions[:, None, :] <= pos_q[:, :, None]
        rel = jnp.einsum('bqhd,bsd->bqhs', take(q_idx), k_idx)
        score = jnp.einsum('bqhs,bqh->bqs', jax.nn.relu(rel), take(w_idx)).astype(jnp.float32) * scale_idx
        score = jnp.where(causal, score, -jnp.inf)
        _, sel = lax.top_k(score, topk)
        k_sel = gather_rows(k_c, sel)
        v_sel = gather_rows(v_c, sel)
        pos_sel = gather_rows(positions, sel)
        dist_c = pos_q[:, :, None] - pos_sel
        logit_c = (jnp.einsum('bqhd,bqkhd->bhqk', take(q_c), k_sel).astype(jnp.float32) * scale_c
                   + jnp.moveaxis(bias_c[rel_bucket(dist_c)], -1, 1))
        logit_c = jnp.where((dist_c >= 0)[:, None], logit_c, -jnp.inf)
        p_c = jax.nn.softmax(logit_c, axis=-1).astype(v_sel.dtype)
        out_c = jnp.einsum('bhqk,bqkhd->bqhd', p_c, v_sel)
        dist_d = pos_q[:, :, None] - positions[:, None, :]
        b_d = jnp.moveaxis(bias_d[rel_bucket(dist_d)], -1, 1)
        mask_d = causal[:, None]

        def softmax_map(qb, kk):
            lg = jnp.einsum('bqhd,bshd->bhqs', qb, kk).astype(jnp.float32) * scale_d + b_d
            return jax.nn.softmax(jnp.where(mask_d, lg, -jnp.inf), axis=-1)

        attn = softmax_map(take(q1), k1) - lam * softmax_map(take(q2), k2)
        out_d = jnp.einsum('bhqs,bshd->bqhd', attn.astype(v_d.dtype), v_d)
        return out_c, out_d

    out_c, out_d = lax.map(block, jnp.arange(n_blocks))
    out_c = jnp.moveaxis(out_c, 0, 1).reshape(bsz, seq, C_WIDTH)
    out_d = jnp.moveaxis(out_d, 0, 1).reshape(bsz, seq, DIFF_HEADS, 2 * DIFF_HEAD_DIM)
    out_d = (rmsnorm(out_d, diff_norm_g) * (1 - lambda_init)).reshape(bsz, seq, DIFF_V)
    return jnp.concatenate([out_c, out_d], axis=-1) @ w_out


def hier_moe(h, wr_g, br_g, wr_e, br_e, w_gate, w_up, w_down):
    bsz, seq, d = h.shape
    n_tok = bsz * seq
    xf = h.reshape(n_tok, d)
    p_group = jax.nn.softmax((xf @ wr_g + br_g).astype(jnp.float32), axis=-1)
    p_top, g_sel = lax.top_k(p_group, 1)
    fine = (xf @ wr_e + br_e).astype(jnp.float32).reshape(n_tok, N_GROUPS, EXPERTS_PER_GROUP)
    fine = jnp.take_along_axis(fine, g_sel[:, :, None], axis=1)[:, 0]
    e_val, e_sel = lax.top_k(fine, TOP_E)
    gate = (p_top * jax.nn.softmax(e_val, axis=-1)).reshape(-1)
    expert_id = (g_sel * EXPERTS_PER_GROUP + e_sel).reshape(-1)
    token_id = jnp.repeat(jnp.arange(n_tok, dtype=jnp.int32), TOP_E)
    n_assign = n_tok * TOP_E
    order = jnp.argsort(expert_id)
    e_sorted = expert_id[order]
    counts = jnp.bincount(expert_id, length=N_EXPERTS)
    starts = jnp.cumsum(counts) - counts
    padded = (counts + MOE_BLOCK - 1) // MOE_BLOCK * MOE_BLOCK
    pad_end = jnp.cumsum(padded)
    pad_start = pad_end - padded
    dest = pad_start[e_sorted] + jnp.arange(n_assign, dtype=jnp.int32) - starts[e_sorted]
    n_blocks = -(-n_assign // MOE_BLOCK) + N_EXPERTS
    n_rows = n_blocks * MOE_BLOCK
    row_token = jnp.full((n_rows,), n_tok, jnp.int32).at[dest].set(token_id[order])
    row_gate = jnp.zeros((n_rows,), gate.dtype).at[dest].set(gate[order])
    block_expert = jnp.minimum(jnp.searchsorted(pad_end, jnp.arange(n_blocks, dtype=jnp.int32) * MOE_BLOCK, side='right'),
                               N_EXPERTS - 1)
    x_rows = jnp.concatenate([xf, jnp.zeros((1, d), xf.dtype)], axis=0)[row_token].reshape(n_blocks, MOE_BLOCK, d)

    def expert_block(args):
        xb, e = args
        return (jax.nn.silu(xb @ w_gate[e]) * (xb @ w_up[e])) @ w_down[e]

    y_rows = lax.map(expert_block, (x_rows, block_expert)).reshape(n_rows, d)
    y_rows = y_rows * row_gate[:, None].astype(y_rows.dtype)
    out = jnp.zeros((n_tok + 1, d), y_rows.dtype).at[row_token].add(y_rows)[:n_tok]
    return out.reshape(bsz, seq, d)


def setup_inputs(seed: int = 0) -> dict:
    key = jax.random.key(seed)
    ks = jax.random.split(key, 32)
    f32 = jnp.float32

    def nrm(k, shape, scale):
        return jax.random.normal(k, shape, f32) * scale

    return {
        'x': nrm(ks[0], (BATCH, SEQ, D_MODEL), 1.0),
        'c': nrm(ks[1], (BATCH, D_MODEL), 1.0),
        'positions': jnp.broadcast_to(jnp.arange(SEQ, dtype=jnp.int32), (BATCH, SEQ)),
        'rel_bias': nrm(ks[2], (NUM_BUCKETS, N_ATTN_HEADS), 0.5),
        'norm_g': 1.0 + nrm(ks[3], (DEPTH, 2, D_MODEL), 0.1),
        'final_norm_g': 1.0 + nrm(ks[4], (D_MODEL,), 0.1),
        'ada_w': nrm(ks[5], (DEPTH, D_MODEL, 6 * D_MODEL), 0.5 * D_MODEL ** -0.5),
        'ada_b': nrm(ks[6], (DEPTH, 6 * D_MODEL), 0.02),
        'ab_w_in': nrm(ks[7], (N_EVEN, D_MODEL, AB_IN), D_MODEL ** -0.5),
        'ab_conv_a': nrm(ks[8], (N_EVEN, A_CONV, A_WIDTH), A_CONV ** -0.5),
        'ab_conv_b': nrm(ks[9], (N_EVEN, B_CONV, B_WIDTH), B_CONV ** -0.5),
        'ab_conv_b_bias': nrm(ks[10], (N_EVEN, B_WIDTH), 0.02),
        'ab_ln_g': 1.0 + nrm(ks[11], (N_EVEN, B_WIDTH), 0.1),
        'ab_ln_b': nrm(ks[12], (N_EVEN, B_WIDTH), 0.02),
        'ab_w_out': nrm(ks[13], (N_EVEN, A_WIDTH + B_WIDTH, D_MODEL), (A_WIDTH + B_WIDTH) ** -0.5),
        'cd_w_in': nrm(ks[14], (N_ODD, D_MODEL, CD_IN), D_MODEL ** -0.5),
        'diff_lam': nrm(ks[15], (N_ODD, 4, DIFF_HEAD_DIM), 0.1),
        'diff_norm_g': 1.0 + nrm(ks[16], (N_ODD, 2 * DIFF_HEAD_DIM), 0.1),
        'cd_w_out': nrm(ks[17], (N_ODD, C_WIDTH + DIFF_V, D_MODEL), (C_WIDTH + DIFF_V) ** -0.5),
        'moe_wr_g': nrm(ks[18], (DEPTH, D_MODEL, N_GROUPS), D_MODEL ** -0.5),
        'moe_br_g': nrm(ks[19], (DEPTH, N_GROUPS), 0.01),
        'moe_wr_e': nrm(ks[20], (DEPTH, D_MODEL, N_EXPERTS), D_MODEL ** -0.5),
        'moe_br_e': nrm(ks[21], (DEPTH, N_EXPERTS), 0.01),
        'moe_w_gate': nrm(ks[22], (DEPTH, N_EXPERTS, D_MODEL, D_EXPERT), D_MODEL ** -0.5),
        'moe_w_up': nrm(ks[23], (DEPTH, N_EXPERTS, D_MODEL, D_EXPERT), D_MODEL ** -0.5),
        'moe_w_down': nrm(ks[24], (DEPTH, N_EXPERTS, D_EXPERT, D_MODEL), D_EXPERT ** -0.5),
    }


def reference(x, c, positions, rel_bias, norm_g, final_norm_g, ada_w, ada_b,
              ab_w_in, ab_conv_a, ab_conv_b, ab_conv_b_bias, ab_ln_g, ab_ln_b, ab_w_out,
              cd_w_in, diff_lam, diff_norm_g, cd_w_out,
              moe_wr_g, moe_br_g, moe_wr_e, moe_br_e, moe_w_gate, moe_w_up, moe_w_down):
    cond = jax.nn.silu(c)
    for i in range(DEPTH):
        mod = cond @ ada_w[i] + ada_b[i]
        sh1, sc1, g1, sh2, sc2, g2 = jnp.split(mod, 6, axis=-1)
        h = modulate(rmsnorm(x, norm_g[i, 0]), sh1, sc1)
        j = i // 2
        if i % 2 == 0:
            y = conv_mixers(h, ab_w_in[j], ab_conv_a[j], ab_conv_b[j], ab_conv_b_bias[j],
                            ab_ln_g[j], ab_ln_b[j], ab_w_out[j])
        else:
            lambda_init = 0.8 - 0.6 * math.exp(-0.3 * i)
            y = attn_mixers(h, positions, cd_w_in[j], rel_bias, diff_lam[j], diff_norm_g[j],
                            cd_w_out[j], lambda_init)
        x = x + g1[:, None, :] * y
        h = modulate(rmsnorm(x, norm_g[i, 1]), sh2, sc2)
        x = x + g2[:, None, :] * hier_moe(h, moe_wr_g[i], moe_br_g[i], moe_wr_e[i], moe_br_e[i],
                                          moe_w_gate[i], moe_w_up[i], moe_w_down[i])
    return rmsnorm(x, final_norm_g)
```

```cpp
#include <hip/hip_runtime.h>
#include <cstdio>
#include <cstdint>

#define LAS __attribute__((address_space(3)))
#define DI __device__ __forceinline__
typedef unsigned short bf16_t;
typedef short bf16x8 __attribute__((ext_vector_type(8)));
typedef short s16x4 __attribute__((ext_vector_type(4)));
typedef float f32x2 __attribute__((ext_vector_type(2)));
typedef float f32x4 __attribute__((ext_vector_type(4)));
typedef float f32x16 __attribute__((ext_vector_type(16)));
typedef unsigned u32x2 __attribute__((ext_vector_type(2)));
typedef unsigned u32x4 __attribute__((ext_vector_type(4)));
typedef __bf16 bf16v2 __attribute__((ext_vector_type(2)));

constexpr int NB = 4, SEQ = 8192, DM = 1024, NTOK = NB * SEQ;
constexpr int NTHR = 512, NWAVE = 8;
constexpr int AB_N = 2560;
constexpr int ZC_N = 1536;
constexpr int CD_SRC_N = 3368;
constexpr int CD_N = 3584;
constexpr int Z_QC = 0, Z_KC = 512, Z_VC = 1024, Z_QD = 1536, Z_KD = 2048, Z_VD = 2560, Z_QI = 3072, Z_KI = 3328, Z_WI = 3360;
constexpr int NEXP = 32, DEXP = 512;
constexpr int MOE_ROWS = 2 * NTOK + NEXP * 256;
constexpr float EPS = 1e-6f;
constexpr float LOG2E = 1.4426950408889634f;

constexpr size_t MiB = 1u << 20;
constexpr size_t WS_CTL = 0, CTL_BYTES = 64 * 1024;
constexpr size_t WS_MOD = 1 * MiB;
constexpr size_t WS_WAB_IN = 2 * MiB;
constexpr size_t WS_WAB_OUT = 7 * MiB;
constexpr size_t WS_WCD_IN = 9 * MiB;
constexpr size_t WS_WCD_OUT = 16 * MiB;
constexpr size_t WS_MOE_W = 18 * MiB;
constexpr size_t WS_H = 114 * MiB;
constexpr size_t WS_Y = 178 * MiB;
constexpr size_t WS_BIG = 242 * MiB;
constexpr size_t WS_ACT = WS_BIG;
constexpr size_t WS_YMOE = WS_BIG + 72 * MiB;
constexpr size_t WS_MASK = 466 * MiB;
constexpr size_t WS_LIST = 498 * MiB;
constexpr size_t WS_GATEV = 502 * MiB;
constexpr size_t WS_TOKSLOT = 506 * MiB;
constexpr size_t WS_END = 507 * MiB;

constexpr int CW_BAR = 0;
constexpr int CW_CNT = 4096;

DI unsigned pack_bf16(float lo, float hi) { f32x2 v = {lo, hi}; bf16v2 b = __builtin_convertvector(v, bf16v2); return __builtin_bit_cast(unsigned, b); }
DI float bf_lo(unsigned w) { return __uint_as_float(w << 16); }
DI float bf_hi(unsigned w) { return __uint_as_float(w & 0xffff0000u); }
DI float bf2f(bf16_t b) { return __uint_as_float(((unsigned)b) << 16); }
DI float wave_sum(float v) {
#pragma unroll
    for (int o = 32; o >= 1; o >>= 1) v += __shfl_xor(v, o);
    return v;
}
DI float silu_f(float v) { return v / (1.0f + __expf(-v)); }
DI float sigmoid_f(float v) { return 1.0f / (1.0f + __expf(-v)); }

#define XB_TMO      128
#define XB_XCNT(j)  (256  + 64 * (j))
#define XB_XSUB(j)  (1280 + 64 * (j))
#define XB_XGEN(j)  (2304 + 64 * (j))
#define XB_TOP      3328
#define XB_TOPGEN   3392
#define XCD_BAR_WORDS 3456
#define XB_SPIN_CAP (1u << 22)
DI unsigned xb_ld(unsigned* p)              { return __hip_atomic_load(p, __ATOMIC_RELAXED, __HIP_MEMORY_SCOPE_AGENT); }
DI unsigned xb_add(unsigned* p, unsigned v) { return __hip_atomic_fetch_add(p, v, __ATOMIC_RELAXED, __HIP_MEMORY_SCOPE_AGENT); }
DI unsigned xb_xcc_id() { return (unsigned)__builtin_amdgcn_s_getreg((3 << 11) | 20) & 0xFu; }
#define XB_SPIN(cond, bar) do { unsigned _sp = 0; while (cond) { __builtin_amdgcn_s_sleep(1); \
    if ((++_sp & 255u) == 0u) { if (xb_ld(&(bar)[XB_TMO])) break; if (_sp > XB_SPIN_CAP) { atomicAdd(&(bar)[XB_TMO], 1u); break; } } } } while (0)
struct XcdBarrier { unsigned* bar; unsigned x; volatile LAS unsigned* st; };
DI XcdBarrier xcd_barrier_post(unsigned* bar, volatile LAS unsigned* st) {
    XcdBarrier b; b.bar = bar; b.x = xb_xcc_id(); b.st = st;
    if (threadIdx.x == 0) (void)xb_add(&bar[XB_XCNT(b.x)], 1u);
    return b;
}
DI void xcd_barrier_complete(unsigned* bar, unsigned x, unsigned& nloc, unsigned& nx) {
    const unsigned G = gridDim.x * gridDim.y * gridDim.z;
    unsigned sum, cnt, mine, sp = 0u;
    for (;;) {
        sum = 0u; cnt = 0u; mine = 0u;
#pragma unroll
        for (unsigned j = 0; j < 16; ++j) { const unsigned c = xb_ld(&bar[XB_XCNT(j)]); sum += c; cnt += (c > 0u) ? 1u : 0u; mine = (j == x) ? c : mine; }
        if (sum == G) break;
        __builtin_amdgcn_s_sleep(1);
        if ((++sp & 255u) == 0u) { if (xb_ld(&bar[XB_TMO])) break; if (sp > XB_SPIN_CAP) { atomicAdd(&bar[XB_TMO], 1u); break; } }
    }
    nloc = mine > 0u ? mine : 1u; nx = cnt > 0u ? cnt : 1u;
}
DI void xcd_barrier(const XcdBarrier& b) {
    asm volatile("s_waitcnt vmcnt(0)" ::: "memory");
    __syncthreads();
    if (threadIdx.x == 0) {
        unsigned* bar = b.bar;
        __builtin_amdgcn_s_waitcnt(0);
        unsigned nloc = b.st[0], nx = b.st[1];
        if (nloc == 0u) { xcd_barrier_complete(bar, b.x, nloc, nx); b.st[0] = nloc; b.st[1] = nx; }
        const unsigned old = xb_add(&bar[XB_XSUB(b.x)], 1u);
        const unsigned gen = old / nloc;
        if (old + 1u == (gen + 1u) * nloc) {
            __builtin_amdgcn_fence(__ATOMIC_RELEASE, "agent");
            asm volatile("s_waitcnt vmcnt(0)" ::: "memory");
            const unsigned og = xb_add(&bar[XB_TOP], 1u);
            const unsigned tg = og / nx;
            if (og + 1u == (tg + 1u) * nx) xb_add(&bar[XB_TOPGEN], 1u);
            else XB_SPIN(xb_ld(&bar[XB_TOPGEN]) == tg, bar);
            __builtin_amdgcn_fence(__ATOMIC_ACQUIRE, "agent");
            xb_add(&bar[XB_XGEN(b.x)], 1u);
            asm volatile("s_waitcnt vmcnt(0)" ::: "memory");
        } else {
            XB_SPIN(xb_ld(&bar[XB_XGEN(b.x)]) == gen, bar);
            __builtin_amdgcn_fence(__ATOMIC_ACQUIRE, "agent");
            asm volatile("s_waitcnt vmcnt(0)" ::: "memory");
        }
    }
    __syncthreads();
}

namespace pg8 {
constexpr int BM = 256, BK = 64, HALF = 128, HTB = HALF * BK * 2, STAGE_BYTES = 8 * HTB;
DI int lds_byte(int r, int c) { const int st = (r >> 4) * 2 + (c >> 5), rr = r & 15, cc = c & 31, ob = rr * 64 + cc * 2; return st * 1024 + (ob ^ (((ob >> 9) & 1) << 5)); }
DI void stage_rc(int b, int& R, int& C) { const int st = b / 1024, sb = b % 1024, swz = sb ^ (((sb >> 9) & 1) << 5); R = (st >> 1) * 16 + swz / 64; C = (st & 1) * 32 + (swz % 64) / 2; }
struct Unit { int pm, pn, e, nrow; };

template <class Epi, class Sched>
DI void gemm_phase(LAS unsigned char* lds, const char* Abase, const int K, const Sched& S, const Epi& E) {
    const int tid = threadIdx.x, wid = __builtin_amdgcn_readfirstlane(tid >> 6), lane = tid & 63, wr = wid >> 2, wc = wid & 3, fr = lane & 15, fq = lane >> 4;
    const int nt = K / BK;
    int Rr[2], Cc[2]; unsigned voffB[2];
#pragma unroll
    for (int i = 0; i < 2; ++i) { int R, C; stage_rc(tid * 16 + i * 8192, R, C); Rr[i] = R; Cc[i] = C; voffB[i] = (unsigned)(R * K + C) * 2u; }
    const size_t kstep = (size_t)(BK * 2);
    const size_t hstep = (size_t)HALF * K * 2;
    const unsigned ldsw = (unsigned)wid * 1024u;
    const int aoff = lds_byte(wr * 64 + fr, fq * 8), boff = lds_byte(wc * 32 + fr, fq * 8);
#define PG8_SA(b, h) (((b) * 2 + (h)) * HTB)
#define PG8_SB(b, h) ((4 + (b) * 2 + (h)) * HTB)
#define PG8_STAGE(bufoff, gbase, voff) do { _Pragma("unroll") for (int _i = 0; _i < 2; ++_i) \
        __builtin_amdgcn_global_load_lds((const unsigned*)((const char*)(gbase) + (voff)[_i]), (LAS unsigned*)(lds + (bufoff) + ldsw + _i * 8192), 16, 0, 0); } while (0)
#define PG8_AOFF(dst, u) do { _Pragma("unroll") for (int _h = 0; _h < 2; ++_h) _Pragma("unroll") for (int _i = 0; _i < 2; ++_i) \
        dst[_h][_i] = ((unsigned)S.a_row(u, _h * HALF + Rr[_i]) * (unsigned)K + (unsigned)Cc[_i]) * 2u; } while (0)
#define PG8_LDA(dst, b, h) do { _Pragma("unroll") for (int m = 0; m < 4; ++m) _Pragma("unroll") for (int k = 0; k < 2; ++k) dst[m][k] = *(const LAS bf16x8*)(lds + PG8_SA(b, h) + aoff + m * 2048 + k * 1024); } while (0)
#define PG8_LDB(dst, b, h) do { _Pragma("unroll") for (int n = 0; n < 2; ++n) _Pragma("unroll") for (int k = 0; k < 2; ++k) dst[n][k] = *(const LAS bf16x8*)(lds + PG8_SB(b, h) + boff + n * 2048 + k * 1024); } while (0)
#define PG8_MMA(ai, bj, At, Bt) do { __builtin_amdgcn_s_setprio(1); _Pragma("unroll") for (int m = 0; m < 4; ++m) _Pragma("unroll") for (int n = 0; n < 2; ++n) _Pragma("unroll") for (int k = 0; k < 2; ++k) \
        acc[ai][bj][m][n] = __builtin_amdgcn_mfma_f32_16x16x32_bf16(Bt[n][k], At[m][k], acc[ai][bj][m][n], 0, 0, 0); __builtin_amdgcn_s_setprio(0); } while (0)
#define PG8_WAIT_V(n) asm volatile("s_waitcnt vmcnt(" #n ")" ::: "memory")
#define PG8_WAIT_L(n) asm volatile("s_waitcnt lgkmcnt(" #n ")" ::: "memory")
#define PG8_BAR __builtin_amdgcn_s_barrier()
#define PG8_SCHED __builtin_amdgcn_sched_barrier(0)
    Unit cur, nxt; int ui = 0;
    if (!S.next(0, cur)) return;
    f32x4 acc[2][2][4][2];
#pragma unroll
    for (int a = 0; a < 2; ++a)
#pragma unroll
        for (int b = 0; b < 2; ++b)
#pragma unroll
            for (int m = 0; m < 4; ++m)
#pragma unroll
                for (int n = 0; n < 2; ++n) acc[a][b][m][n] = (f32x4){0.f, 0.f, 0.f, 0.f};
    bf16x8 At[4][2], B0[2][2], B1[2][2];
    unsigned aoC[2][2], aoN[2][2];
    PG8_AOFF(aoC, cur);
    const char* cB = S.b_base(cur);
    PG8_STAGE(PG8_SB(0, 0), cB, voffB); PG8_STAGE(PG8_SA(0, 0), Abase, aoC[0]); PG8_STAGE(PG8_SB(0, 1), cB + hstep, voffB); PG8_STAGE(PG8_SA(0, 1), Abase, aoC[1]);
    if (wr == 1) PG8_BAR;
    PG8_WAIT_V(4); PG8_BAR;
    PG8_STAGE(PG8_SB(1, 0), cB + kstep, voffB); PG8_STAGE(PG8_SA(1, 0), Abase + kstep, aoC[0]); PG8_STAGE(PG8_SB(1, 1), cB + hstep + kstep, voffB);
    PG8_WAIT_V(6); PG8_BAR;
    for (;;) {
        const bool has_next = S.next(ui + 1, nxt);
        const char* nB = cB;
#pragma unroll
        for (int _h = 0; _h < 2; ++_h)
#pragma unroll
            for (int _i = 0; _i < 2; ++_i) aoN[_h][_i] = aoC[_h][_i];
        if (has_next) { PG8_AOFF(aoN, nxt); nB = S.b_base(nxt); }
        for (int t = 0; t < nt; t += 2) {
            const bool last = (t == nt - 2);
            const char* a1 = Abase + (size_t)(t + 1) * kstep;
            const char* a2 = last ? Abase : Abase + (size_t)(t + 2) * kstep; const char* b2 = last ? nB : cB + (size_t)(t + 2) * kstep;
            const char* a3 = a2 + kstep; const char* b3 = b2 + kstep;
            unsigned ao2[2][2];
#pragma unroll
            for (int _h = 0; _h < 2; ++_h)
#pragma unroll
                for (int _i = 0; _i < 2; ++_i) ao2[_h][_i] = last ? aoN[_h][_i] : aoC[_h][_i];
            PG8_LDB(B0, 0, 0); PG8_SCHED; PG8_LDA(At, 0, 0); PG8_STAGE(PG8_SA(1, 1), a1, aoC[1]);
            PG8_WAIT_L(8); PG8_BAR; PG8_WAIT_L(0); PG8_MMA(0, 0, At, B0); PG8_BAR; PG8_SCHED;
            PG8_LDB(B1, 0, 1); PG8_STAGE(PG8_SB(0, 0), b2, voffB);
            PG8_BAR; PG8_WAIT_L(0); PG8_MMA(0, 1, At, B1); PG8_BAR;
            PG8_LDA(At, 0, 1); PG8_STAGE(PG8_SA(0, 0), a2, ao2[0]);
            PG8_BAR; PG8_WAIT_L(0); PG8_MMA(1, 0, At, B0); PG8_BAR; PG8_SCHED;
            PG8_STAGE(PG8_SB(0, 1), b2 + hstep, voffB);
            PG8_WAIT_V(6); PG8_BAR; PG8_MMA(1, 1, At, B1); PG8_BAR;
            PG8_LDB(B0, 1, 0); PG8_SCHED; PG8_LDA(At, 1, 0); PG8_STAGE(PG8_SA(0, 1), a2, ao2[1]);
            PG8_WAIT_L(8); PG8_BAR; PG8_WAIT_L(0); PG8_MMA(0, 0, At, B0); PG8_BAR; PG8_SCHED;
            PG8_LDB(B1, 1, 1); PG8_STAGE(PG8_SB(1, 0), b3, voffB);
            PG8_BAR; PG8_WAIT_L(0); PG8_MMA(0, 1, At, B1); PG8_BAR;
            PG8_LDA(At, 1, 1); PG8_STAGE(PG8_SA(1, 0), a3, ao2[0]);
            PG8_BAR; PG8_WAIT_L(0); PG8_MMA(1, 0, At, B0); PG8_BAR; PG8_SCHED;
            PG8_STAGE(PG8_SB(1, 1), b3 + hstep, voffB);
            PG8_WAIT_V(6); PG8_BAR; PG8_MMA(1, 1, At, B1); PG8_BAR;
        }
        E(acc, cur, wr, wc, fr, fq);
        if (!has_next) break;
#pragma unroll
        for (int a = 0; a < 2; ++a)
#pragma unroll
            for (int b = 0; b < 2; ++b)
#pragma unroll
                for (int m = 0; m < 4; ++m)
#pragma unroll
                    for (int n = 0; n < 2; ++n) acc[a][b][m][n] = (f32x4){0.f, 0.f, 0.f, 0.f};
        cur = nxt; cB = nB; ++ui;
#pragma unroll
        for (int _h = 0; _h < 2; ++_h)
#pragma unroll
            for (int _i = 0; _i < 2; ++_i) aoC[_h][_i] = aoN[_h][_i];
    }
    PG8_WAIT_V(0);
    if (wr == 0) PG8_BAR;
    PG8_BAR;
#undef PG8_SA
#undef PG8_SB
#undef PG8_STAGE
#undef PG8_AOFF
#undef PG8_LDA
#undef PG8_LDB
#undef PG8_MMA
#undef PG8_WAIT_V
#undef PG8_WAIT_L
#undef PG8_BAR
#undef PG8_SCHED
}
}

struct Args {
    const float* x; const float* c; const int* positions; const float* rel_bias; const float* norm_g; const float* final_norm_g;
    const float* ada_w; const float* ada_b; const float* ab_w_in; const float* ab_conv_a; const float* ab_conv_b; const float* ab_conv_b_bias;
    const float* ab_ln_g; const float* ab_ln_b; const float* ab_w_out; const float* cd_w_in; const float* diff_lam; const float* diff_norm_g;
    const float* cd_w_out; const float* moe_wr_g; const float* moe_br_g; const float* moe_wr_e; const float* moe_br_e;
    const float* moe_w_gate; const float* moe_w_up; const float* moe_w_down;
    float* out; unsigned char* ws; int ph_lo, ph_hi;
};
struct Frame {
    LAS unsigned char* lds; int tid, lane, wave, G, bid;
};

struct RowSrc { const float* p; int ld; };
DI void ilv(int rp, int& j, int& second) { const int g = rp >> 5, i = rp & 31; j = 16 * g + (i & 15); second = i >> 4; }

enum { CV_AB_IN = 0, CV_AB_OUT = 1, CV_CD_IN = 2, CV_CD_OUT = 3, CV_MOE_GU = 4, CV_MOE_D = 5 };
template <int KIND> DI RowSrc row_src(const Args& a, int layer, int e, int r) {
    RowSrc s; s.p = nullptr; s.ld = 0;
    if (KIND == CV_AB_IN) {
        s.ld = AB_N;
        if (r < 512) s.p = a.ab_w_in + r;
        else if (r < 1536) { int j, sec; ilv(r - 512, j, sec); s.p = a.ab_w_in + (sec ? 1024 + j : 512 + j); }
        else { int j, sec; ilv(r - 1536, j, sec); s.p = a.ab_w_in + (sec ? 2048 + j : 1536 + j); }
    } else if (KIND == CV_AB_OUT) { s.ld = DM; s.p = a.ab_w_out + r; }
    else if (KIND == CV_CD_IN) {
        s.ld = CD_SRC_N;
        int col = -1;
        if (r < 1536) col = r;
        else if (r < 3072) col = 1832 + (r - 1536);
        else if (r < 3328) col = 1536 + (r - 3072);
        else if (r < 3360) col = 1792 + (r - 3328);
        else if (r < 3368) col = 1824 + (r - 3360);
        if (col >= 0) s.p = a.cd_w_in + col;
    } else if (KIND == CV_CD_OUT) { s.ld = DM; s.p = a.cd_w_out + r; }
    else if (KIND == CV_MOE_GU) {
        int j, sec; ilv(r, j, sec); s.ld = DEXP;
        const size_t base = ((size_t)layer * NEXP + e) * (size_t)DM * DEXP;
        s.p = (sec ? a.moe_w_up : a.moe_w_gate) + base + j;
    } else {
        s.ld = DM; s.p = a.moe_w_down + ((size_t)layer * NEXP + e) * (size_t)DEXP * DM + r;
    }
    return s;
}
template <int KIND> DI void cvt_tile(const Frame& F, const Args& a, bf16_t* dst, int K, int r0, int k0, int layer, int e) {
    LAS bf16_t* T = (LAS bf16_t*)F.lds;
#pragma unroll
    for (int it = 0; it < 2; ++it) {
        const int eidx = F.tid + it * NTHR, kk = eidx >> 4, c4 = eidx & 15;
        const RowSrc s = row_src<KIND>(a, layer, e, r0 + 4 * c4);
        f32x4 v = {0.f, 0.f, 0.f, 0.f};
        if (s.p) v = *(const f32x4*)(s.p + (size_t)(k0 + kk) * s.ld);
        const unsigned p01 = pack_bf16(v[0], v[1]), p23 = pack_bf16(v[2], v[3]);
        T[(4 * c4 + 0) * 66 + kk] = (bf16_t)(p01 & 0xffffu); T[(4 * c4 + 1) * 66 + kk] = (bf16_t)(p01 >> 16);
        T[(4 * c4 + 2) * 66 + kk] = (bf16_t)(p23 & 0xffffu); T[(4 * c4 + 3) * 66 + kk] = (bf16_t)(p23 >> 16);
    }
    __syncthreads();
    {
        const int rr = F.tid >> 3, c = F.tid & 7;
        const LAS unsigned* src = (const LAS unsigned*)(T + rr * 66 + c * 8);
        u32x4 w; w[0] = src[0]; w[1] = src[1]; w[2] = src[2]; w[3] = src[3];
        *(u32x4*)(dst + (size_t)(r0 + rr) * K + k0 + c * 8) = w;
    }
    __syncthreads();
}
constexpr int CVT_DENSE_TILES = (AB_N + DM + CD_N + DM) / 64 * (DM / 64);
constexpr int CVT_MOE_TILES_PER_EXP = (1024 / 64) * (1024 / 64) + (1024 / 64) * (512 / 64);
constexpr int CVT_MOE_TILES = NEXP * CVT_MOE_TILES_PER_EXP;
DI void cvt_dense_item(const Frame& F, const Args& a, int item) {
    const int rt = item >> 4, kt = item & 15;
    int r = rt * 64;
    if (r < AB_N) { cvt_tile<CV_AB_IN>(F, a, (bf16_t*)(a.ws + WS_WAB_IN), DM, r, kt * 64, 0, 0); return; }
    r -= AB_N;
    if (r < DM) { cvt_tile<CV_AB_OUT>(F, a, (bf16_t*)(a.ws + WS_WAB_OUT), DM, r, kt * 64, 0, 0); return; }
    r -= DM;
    if (r < CD_N) { cvt_tile<CV_CD_IN>(F, a, (bf16_t*)(a.ws + WS_WCD_IN), DM, r, kt * 64, 0, 0); return; }
    r -= CD_N;
    cvt_tile<CV_CD_OUT>(F, a, (bf16_t*)(a.ws + WS_WCD_OUT), DM, r, kt * 64, 0, 0);
}
DI void cvt_moe_item(const Frame& F, const Args& a, int layer, int item) {
    const int e = item / CVT_MOE_TILES_PER_EXP, t = item % CVT_MOE_TILES_PER_EXP;
    bf16_t* base = (bf16_t*)(a.ws + WS_MOE_W + (size_t)e * 3 * MiB);
    if (t < 256) cvt_tile<CV_MOE_GU>(F, a, base, DM, (t >> 4) * 64, (t & 15) * 64, layer, e);
    else { const int t2 = t - 256; cvt_tile<CV_MOE_D>(F, a, base + (size_t)DM * DM, DEXP, (t2 >> 3) * 64, (t2 & 7) * 64, layer, e); }
}
DI void mod_item(const Frame& F, const Args& a, int item) {
    LAS float* sc = (LAS float*)F.lds;
    for (int i = F.tid; i < NB * DM; i += NTHR) sc[i] = silu_f(a.c[i]);
    __syncthreads();
    const int l = item / 12, j = (item % 12) * 512 + F.tid;
    const float* w = a.ada_w + (size_t)l * DM * 6 * DM + j;
    float acc[NB] = {0.f, 0.f, 0.f, 0.f};
    for (int k = 0; k < DM; k += 4) {
        float wv[4];
#pragma unroll
        for (int u = 0; u < 4; ++u) wv[u] = w[(size_t)(k + u) * 6 * DM];
#pragma unroll
        for (int u = 0; u < 4; ++u)
#pragma unroll
            for (int b = 0; b < NB; ++b) acc[b] += sc[b * DM + k + u] * wv[u];
    }
    float* mod = (float*)(a.ws + WS_MOD);
    const float bias = a.ada_b[l * 6 * DM + j];
#pragma unroll
    for (int b = 0; b < NB; ++b) mod[((size_t)l * NB + b) * 6 * DM + j] = acc[b] + bias;
    __syncthreads();
}
DI void p0_prologue(const Frame& F, const Args& a) {
    const int n_items = 24 + CVT_DENSE_TILES + CVT_MOE_TILES;
    for (int it = F.bid; it < n_items; it += F.G) {
        if (it < 24) mod_item(F, a, it);
        else if (it < 24 + CVT_DENSE_TILES) cvt_dense_item(F, a, it - 24);
        else cvt_moe_item(F, a, 0, it - 24 - CVT_DENSE_TILES);
    }
}

constexpr int WR_LD = 1028;
DI void moe_seg_table(const Frame& F, const unsigned* cnt, LAS int* seg  ) {
    if (F.tid == 0) { int s = 0; for (int e = 0; e < NEXP; ++e) { seg[e] = s; s += (((int)cnt[e] + 255) >> 8) << 8; } seg[NEXP] = s; }
    __syncthreads();
}
template <bool COMBINE, bool ROUTE, bool FINAL>
DI void norm_phase(const Frame& F, const Args& a, const float* xsrc, int layer, int which, int layer_c) {
    const float* mod = (const float*)(a.ws + WS_MOD);
    bf16_t* hbuf = (bf16_t*)(a.ws + WS_H);
    unsigned* ctl = (unsigned*)(a.ws + WS_CTL);
    LAS float* wrT = (LAS float*)F.lds;
    LAS float* brs = (LAS float*)(F.lds + 36 * WR_LD * 4);
    LAS int* seg = (LAS int*)F.lds;
    if (ROUTE) {
        const float* wg = a.moe_wr_g + (size_t)layer * DM * 4;
        const float* we = a.moe_wr_e + (size_t)layer * DM * 32;
        for (int i = F.tid; i < DM * 4; i += NTHR) { const int k = i >> 2, j = i & 3; wrT[j * WR_LD + k] = wg[i]; }
        for (int i = F.tid; i < DM * 32; i += NTHR) { const int k = i >> 5, j = i & 31; wrT[(4 + j) * WR_LD + k] = we[i]; }
        if (F.tid < 4) brs[F.tid] = a.moe_br_g[layer * 4 + F.tid];
        else if (F.tid < 36) brs[F.tid] = a.moe_br_e[layer * 32 + F.tid - 4];
        __syncthreads();
    }
    if (COMBINE) moe_seg_table(F, ctl + CW_CNT + layer_c * NEXP, seg);
    const bf16_t* ymoe = (const bf16_t*)(a.ws + WS_YMOE);
    const int* tokslot = (const int*)(a.ws + WS_TOKSLOT);
    for (int tok = F.bid * NWAVE + F.wave; tok < NTOK; tok += F.G * NWAVE) {
        const int b = tok / SEQ;
        f32x4 xv[4];
#pragma unroll
        for (int c = 0; c < 4; ++c) xv[c] = *(const f32x4*)(xsrc + (size_t)tok * DM + c * 256 + F.lane * 4);
        if (COMBINE) {
            const int ts0 = tokslot[tok * 2], ts1 = tokslot[tok * 2 + 1];
            const size_t r0 = (size_t)(seg[ts0 >> 20] + (ts0 & 0xfffff)), r1 = (size_t)(seg[ts1 >> 20] + (ts1 & 0xfffff));
            const float* g2 = mod + ((size_t)layer_c * NB + b) * 6 * DM + 5 * DM;
#pragma unroll
            for (int c = 0; c < 4; ++c) {
                const int col = c * 256 + F.lane * 4;
                const u32x2 y0 = *(const u32x2*)(ymoe + r0 * DM + col), y1 = *(const u32x2*)(ymoe + r1 * DM + col);
                const f32x4 gv = *(const f32x4*)(g2 + col);
                xv[c][0] += gv[0] * (bf_lo(y0[0]) + bf_lo(y1[0])); xv[c][1] += gv[1] * (bf_hi(y0[0]) + bf_hi(y1[0]));
                xv[c][2] += gv[2] * (bf_lo(y0[1]) + bf_lo(y1[1])); xv[c][3] += gv[3] * (bf_hi(y0[1]) + bf_hi(y1[1]));
                if (!FINAL) *(f32x4*)(a.out + (size_t)tok * DM + col) = xv[c];
            }
        }
        float ss = 0.f;
#pragma unroll
        for (int c = 0; c < 4; ++c) ss += xv[c][0] * xv[c][0] + xv[c][1] * xv[c][1] + xv[c][2] * xv[c][2] + xv[c][3] * xv[c][3];
        ss = wave_sum(ss);
        const float rinv = rsqrtf(ss * (1.0f / DM) + EPS);
        if (FINAL) {
#pragma unroll
            for (int c = 0; c < 4; ++c) {
                const int col = c * 256 + F.lane * 4;
                const f32x4 g = *(const f32x4*)(a.final_norm_g + col);
                f32x4 o; o[0] = xv[c][0] * rinv * g[0]; o[1] = xv[c][1] * rinv * g[1]; o[2] = xv[c][2] * rinv * g[2]; o[3] = xv[c][3] * rinv * g[3];
                *(f32x4*)(a.out + (size_t)tok * DM + col) = o;
            }
            continue;
        }
        const float* ng = a.norm_g + ((size_t)layer * 2 + which) * DM;
        const float* sh = mod + ((size_t)layer * NB + b) * 6 * DM + (which ? 3 : 0) * DM;
        const float* sc = sh + DM;
        f32x4 hv[4];
#pragma unroll
        for (int c = 0; c < 4; ++c) {
            const int col = c * 256 + F.lane * 4;
            const f32x4 g = *(const f32x4*)(ng + col), s1 = *(const f32x4*)(sc + col), s0 = *(const f32x4*)(sh + col);
#pragma unroll
            for (int u = 0; u < 4; ++u) hv[c][u] = (xv[c][u] * rinv * g[u]) * (1.0f + s1[u]) + s0[u];
            u32x2 w; w[0] = pack_bf16(hv[c][0], hv[c][1]); w[1] = pack_bf16(hv[c][2], hv[c][3]);
            *(u32x2*)(hbuf + (size_t)tok * DM + col) = w;
        }
        if (ROUTE) {
            LAS float* lgs = (LAS float*)(F.lds + 36 * WR_LD * 4 + 256) + F.wave * 36;
#pragma unroll 1
            for (int jb = 0; jb < 36; jb += 4) {
                float pp[4];
#pragma unroll
                for (int u = 0; u < 4; ++u) {
                    float p = 0.f;
#pragma unroll
                    for (int c = 0; c < 4; ++c) {
                        const f32x4 w = *(const LAS f32x4*)(wrT + (jb + u) * WR_LD + c * 256 + F.lane * 4);
                        p += hv[c][0] * w[0] + hv[c][1] * w[1] + hv[c][2] * w[2] + hv[c][3] * w[3];
                    }
                    pp[u] = p;
                }
#pragma unroll
                for (int u = 0; u < 4; ++u) pp[u] = wave_sum(pp[u]);
                if (F.lane == 0) { *(LAS f32x4*)(lgs + jb) = (f32x4){pp[0], pp[1], pp[2], pp[3]}; }
            }
            float lg[36];
#pragma unroll
            for (int j = 0; j < 36; ++j) lg[j] = lgs[j] + brs[j];
            int g = 0; float gm = lg[0];
#pragma unroll
            for (int j = 1; j < 4; ++j) if (lg[j] > gm) { gm = lg[j]; g = j; }
            float den = 0.f;
#pragma unroll
            for (int j = 0; j < 4; ++j) den += __expf(lg[j] - gm);
            const float ptop = 1.0f / den;
            float fv[8];
#pragma unroll
            for (int i = 0; i < 8; ++i) fv[i] = (g == 0) ? lg[4 + i] : (g == 1) ? lg[12 + i] : (g == 2) ? lg[20 + i] : lg[28 + i];
            int i1 = 0; float v1 = fv[0];
#pragma unroll
            for (int i = 1; i < 8; ++i) if (fv[i] > v1) { v1 = fv[i]; i1 = i; }
            int i2 = -1; float v2 = -3.0e38f;
#pragma unroll
            for (int i = 0; i < 8; ++i) if (i != i1 && fv[i] > v2) { v2 = fv[i]; i2 = i; }
            const float e2 = __expf(v2 - v1), ga = ptop / (1.0f + e2), gb = ptop * e2 / (1.0f + e2);
            if (F.lane == 0) {
                unsigned* cnt = ctl + CW_CNT + layer * NEXP;
                int* list = (int*)(a.ws + WS_LIST); float* gatev = (float*)(a.ws + WS_GATEV); int* ts = (int*)(a.ws + WS_TOKSLOT);
                const int ea = g * 8 + i1, eb = g * 8 + i2;
                const unsigned pa = __hip_atomic_fetch_add(cnt + ea, 1u, __ATOMIC_RELAXED, __HIP_MEMORY_SCOPE_AGENT);
                const unsigned pb = __hip_atomic_fetch_add(cnt + eb, 1u, __ATOMIC_RELAXED, __HIP_MEMORY_SCOPE_AGENT);
                list[ea * NTOK + pa] = tok; gatev[ea * NTOK + pa] = ga; ts[tok * 2] = (ea << 20) | (int)pa;
                list[eb * NTOK + pb] = tok; gatev[eb * NTOK + pb] = gb; ts[tok * 2 + 1] = (eb << 20) | (int)pb;
            }
        }
    }
    __syncthreads();
}

constexpr int LDS_MISC = 131072 + 64;
constexpr int LDS_XB = 163840 - 16;
constexpr int LDS_BYTES = 163840;
using pg8::Unit;
struct DenseSched {
    int nM, nN, nwg, G, c; const char* Bt; size_t tstepB;
    DI void init(int M, int N, int K, int G_, int c_, const void* Bt_) { nM = M / 256; nN = N / 256; nwg = nM * nN; G = G_; c = c_; Bt = (const char*)Bt_; tstepB = (size_t)256 * K * 2; }
    DI bool next(int i, Unit& u) const {
        const long L = (long)i * G + c; if (L >= nwg) return false;
        int wgid = (int)L; { const int q = nwg / 8, r = nwg % 8, xcd = wgid % 8, off = wgid / 8; wgid = (xcd < r ? xcd * (q + 1) : r * (q + 1) + (xcd - r) * q) + off; }
        const int nig = 8 * nN, gid = wgid / nig, fm = gid * 8, gsz = (nM - fm) < 8 ? (nM - fm) : 8;
        u.pm = fm + ((wgid % nig) % gsz); u.pn = (wgid % nig) / gsz; u.e = 0; u.nrow = 256; return true;
    }
    DI int a_row(const Unit& u, int r) const { return u.pm * 256 + r; }
    DI const char* b_base(const Unit& u) const { return Bt + (size_t)u.pn * tstepB; }
};
template <bool UP>
struct MoeSched {
    const LAS int* ntp; const unsigned* cnt; const int* list; const char* W; int nU, G, c;
    DI bool next(int i, Unit& u) const {
        const long L = (long)i * G + c; if (L >= nU) return false;
        int wgid = (int)L; { const int q = nU / 8, r = nU % 8, xcd = wgid % 8, off = wgid / 8; wgid = (xcd < r ? xcd * (q + 1) : r * (q + 1) + (xcd - r) * q) + off; }
        const int tg = wgid >> 2; u.pn = wgid & 3; u.pm = tg;
        int e = 0;
        for (int k = 1; k < NEXP; ++k) e += (ntp[k] <= tg) ? 1 : 0;
        u.e = e; const int rem = (int)cnt[e] - (tg - ntp[e]) * 256; u.nrow = rem < 256 ? rem : 256; return true;
    }
    DI int a_row(const Unit& u, int r) const {
        if (UP) { const int p = (u.pm - ntp[u.e]) * 256 + r; return (r < u.nrow) ? list[u.e * NTOK + p] : 0; }
        return u.pm * 256 + r;
    }
    DI const char* b_base(const Unit& u) const {
        return W + (size_t)u.e * 3 * MiB + (UP ? (size_t)u.pn * 256 * DM * 2 : 2 * MiB + (size_t)u.pn * 256 * DEXP * 2);
    }
};
DI void moe_tile_table(const Frame& F, const unsigned* cnt, LAS int* ntp  ) {
    if (F.tid == 0) { int s = 0; for (int e = 0; e < NEXP; ++e) { ntp[e] = s; s += ((int)cnt[e] + 255) >> 8; } ntp[NEXP] = s; }
    __syncthreads();
}

#define EPI_ROWS_BEGIN const int row0 = u.pm * 256 + wr * 64 + fr; _Pragma("unroll") for (int ai = 0; ai < 2; ++ai) _Pragma("unroll") for (int m = 0; m < 4; ++m) { const int row = row0 + ai * 128 + m * 16;
#define EPI_ROWS_END }
DI u32x2 pack4(const f32x4& v) { u32x2 w; w[0] = pack_bf16(v[0], v[1]); w[1] = pack_bf16(v[2], v[3]); return w; }

struct EpiAbIn {
    bf16_t* Zc;
    DI void operator()(const f32x4 (&acc)[2][2][4][2], const Unit& u, int wr, int wc, int fr, int fq) const {
        EPI_ROWS_BEGIN
            bf16_t* rp = Zc + (size_t)row * ZC_N;
#pragma unroll
            for (int bj = 0; bj < 2; ++bj) {
                if (u.pn < 2) {
#pragma unroll
                    for (int n = 0; n < 2; ++n) *(u32x2*)(rp + u.pn * 256 + bj * 128 + wc * 32 + n * 16 + 4 * fq) = pack4(acc[ai][bj][m][n]);
                } else {
                    const int pnp = (u.pn - 2) & 3, j = 16 * (8 * pnp + 4 * bj + wc) + 4 * fq;
                    const f32x4 X = acc[ai][bj][m][0], Y = acc[ai][bj][m][1]; f32x4 v;
                    if (u.pn < 6) { v = X * Y; *(u32x2*)(rp + 512 + j) = pack4(v); }
                    else { v[0] = X[0] * sigmoid_f(Y[0]); v[1] = X[1] * sigmoid_f(Y[1]); v[2] = X[2] * sigmoid_f(Y[2]); v[3] = X[3] * sigmoid_f(Y[3]); *(u32x2*)(rp + 1024 + j) = pack4(v); }
                }
            }
        EPI_ROWS_END
    }
};
struct EpiResid {
    const float* xin; float* xout; const float* g1;
    DI void operator()(const f32x4 (&acc)[2][2][4][2], const Unit& u, int wr, int wc, int fr, int fq) const {
        const float* g = g1 + (size_t)((u.pm * 256) / SEQ) * 6 * DM;
        EPI_ROWS_BEGIN
#pragma unroll
            for (int bj = 0; bj < 2; ++bj)
#pragma unroll
                for (int n = 0; n < 2; ++n) {
                    const int col = u.pn * 256 + bj * 128 + wc * 32 + n * 16 + 4 * fq;
                    const f32x4 xo = *(const f32x4*)(xin + (size_t)row * DM + col), gv = *(const f32x4*)(g + col);
                    *(f32x4*)(xout + (size_t)row * DM + col) = xo + gv * acc[ai][bj][m][n];
                }
        EPI_ROWS_END
    }
};
struct EpiPlain {
    bf16_t* O; int ld;
    DI void operator()(const f32x4 (&acc)[2][2][4][2], const Unit& u, int wr, int wc, int fr, int fq) const {
        EPI_ROWS_BEGIN
#pragma unroll
            for (int bj = 0; bj < 2; ++bj)
#pragma unroll
                for (int n = 0; n < 2; ++n) *(u32x2*)(O + (size_t)row * ld + u.pn * 256 + bj * 128 + wc * 32 + n * 16 + 4 * fq) = pack4(acc[ai][bj][m][n]);
        EPI_ROWS_END
    }
};
struct EpiMoeUp {
    bf16_t* act;
    DI void operator()(const f32x4 (&acc)[2][2][4][2], const Unit& u, int wr, int wc, int fr, int fq) const {
        EPI_ROWS_BEGIN
#pragma unroll
            for (int bj = 0; bj < 2; ++bj) {
                const int j = 16 * (8 * u.pn + 4 * bj + wc) + 4 * fq;
                const f32x4 X = acc[ai][bj][m][0], Y = acc[ai][bj][m][1]; f32x4 v;
                v[0] = silu_f(X[0]) * Y[0]; v[1] = silu_f(X[1]) * Y[1]; v[2] = silu_f(X[2]) * Y[2]; v[3] = silu_f(X[3]) * Y[3];
                *(u32x2*)(act + (size_t)row * DEXP + j) = pack4(v);
            }
        EPI_ROWS_END
    }
};
struct EpiMoeDown {
    bf16_t* y; const float* gatev; const LAS int* ntp;
    DI void operator()(const f32x4 (&acc)[2][2][4][2], const Unit& u, int wr, int wc, int fr, int fq) const {
        const int pbase = (u.pm - ntp[u.e]) * 256;
        EPI_ROWS_BEGIN
            const int r = row - u.pm * 256;
            const float gt = (r < u.nrow) ? gatev[u.e * NTOK + pbase + r] : 0.f;
#pragma unroll
            for (int bj = 0; bj < 2; ++bj)
#pragma unroll
                for (int n = 0; n < 2; ++n) *(u32x2*)(y + (size_t)row * DM + u.pn * 256 + bj * 128 + wc * 32 + n * 16 + 4 * fq) = pack4(acc[ai][bj][m][n] * gt);
        EPI_ROWS_END
    }
};

DI void conv_phase(const Frame& F, const Args& a) {
    const bf16_t* Zc = (const bf16_t*)(a.ws + WS_BIG);
    bf16_t* Y = (bf16_t*)(a.ws + WS_Y);
    LAS unsigned* PB = (LAS unsigned*)F.lds;
    LAS f32x2* ST = (LAS f32x2*)(F.lds + 94 * 1024);
    const int cp = F.tid & 255, th = F.tid >> 8, wq = F.wave & 3;
    float wb[31][2], wa[3][2];
#pragma unroll
    for (int k = 0; k < 31; ++k) { const f32x2 w = *(const f32x2*)(a.ab_conv_b + k * 512 + 2 * cp); wb[k][0] = w[0]; wb[k][1] = w[1]; }
#pragma unroll
    for (int k = 0; k < 3; ++k) { const f32x2 w = *(const f32x2*)(a.ab_conv_a + k * 512 + 2 * cp); wa[k][0] = w[0]; wa[k][1] = w[1]; }
    const f32x2 cbias = *(const f32x2*)(a.ab_conv_b_bias + 2 * cp), lng = *(const f32x2*)(a.ab_ln_g + 2 * cp), lnb = *(const f32x2*)(a.ab_ln_b + 2 * cp);
    for (int tile = F.bid; tile < NTOK / 64; tile += F.G) {
        const int t0 = tile * 64, b = t0 / SEQ, tl0 = t0 % SEQ;
        for (int i = F.tid; i < 94 * 64; i += NTHR) {
            const int r = i >> 6, c8 = i & 63, pos = tl0 - 30 + r;
            u32x4 v = {0u, 0u, 0u, 0u};
            if (pos >= 0) v = *(const u32x4*)(Zc + (size_t)(b * SEQ + pos) * ZC_N + 1024 + c8 * 8);
            *(LAS u32x4*)(PB + r * 256 + c8 * 4) = v;
        }
        __syncthreads();
#pragma unroll 1
        for (int g = 0; g < 4; ++g) {
            float U[8][2];
#pragma unroll
            for (int i = 0; i < 8; ++i) { U[i][0] = cbias[0]; U[i][1] = cbias[1]; }
#pragma unroll
            for (int r = 0; r < 38; ++r) {
                const unsigned xw = PB[(32 * th + 8 * g + r) * 256 + cp];
                const float x0 = bf_lo(xw), x1 = bf_hi(xw);
#pragma unroll
                for (int i = 0; i < 8; ++i) { const int k = r - i; if (k >= 0 && k <= 30) { U[i][0] += wb[k][0] * x0; U[i][1] += wb[k][1] * x1; } }
            }
#pragma unroll
            for (int i = 0; i < 8; ++i) {
                const float s1 = wave_sum(U[i][0] + U[i][1]), s2 = wave_sum(U[i][0] * U[i][0] + U[i][1] * U[i][1]);
                if (F.lane == 0) ST[(32 * th + 8 * g + i) * 4 + wq] = (f32x2){s1, s2};
            }
            __syncthreads();
#pragma unroll
            for (int i = 0; i < 8; ++i) {
                const int tl = 32 * th + 8 * g + i; const size_t tok = (size_t)t0 + tl; const int pos = tl0 + tl;
                const f32x2 p0 = ST[tl * 4 + 0], p1 = ST[tl * 4 + 1], p2 = ST[tl * 4 + 2], p3 = ST[tl * 4 + 3];
                const float mean = ((p0[0] + p1[0]) + (p2[0] + p3[0])) * (1.0f / 512.0f);
                const float var = ((p0[1] + p1[1]) + (p2[1] + p3[1])) * (1.0f / 512.0f) - mean * mean;
                const float rstd = rsqrtf(var + EPS);
                const float yb0 = silu_f((U[i][0] - mean) * rstd * lng[0] + lnb[0]), yb1 = silu_f((U[i][1] - mean) * rstd * lng[1] + lnb[1]);
                *(unsigned*)(Y + tok * DM + 512 + 2 * cp) = pack_bf16(yb0, yb1);
                float a0 = 0.f, a1 = 0.f;
#pragma unroll
                for (int k = 0; k < 3; ++k) {
                    const int pp = pos - 2 + k;
                    if (pp >= 0) { const unsigned w = *(const unsigned*)(Zc + (size_t)(b * SEQ + pp) * ZC_N + 512 + 2 * cp); a0 += wa[k][0] * bf_lo(w); a1 += wa[k][1] * bf_hi(w); }
                }
                const unsigned gw = *(const unsigned*)(Zc + tok * ZC_N + 2 * cp);
                *(unsigned*)(Y + tok * DM + 2 * cp) = pack_bf16(bf_lo(gw) * a0, bf_hi(gw) * a1);
            }
        }
        __syncthreads();
    }
}

#define MFMA32(a, b, c) __builtin_amdgcn_mfma_f32_32x32x16_bf16((a), (b), (c), 0, 0, 0)
constexpr int TK_HIST = 0;
constexpr int TK_TAB = 65536;
constexpr int TK_CAND = 65536 + 512;
constexpr int TK_CCNT = TK_CAND + 4096;
constexpr int TK_BQ = 73728;
DI int crow_c(int r) { return (r & 3) + 8 * (r >> 2); }
template <int PASS>
DI void topk_pass(const Frame& F, const bf16_t* Z, unsigned* maskg, int b, int t0, const float (&wp)[8]) {
    const LAS unsigned char* bq = F.lds + TK_BQ;
    LAS unsigned* hist = (LAS unsigned*)(F.lds + TK_HIST);
    LAS int* tab = (LAS int*)(F.lds + TK_TAB);
    LAS int* cand = (LAS int*)(F.lds + TK_CAND);
    LAS int* ccnt = (LAS int*)(F.lds + TK_CCNT);
    const int q = F.lane & 31, h2 = F.lane >> 5, ntile = t0 / 32 + 1;
    const int myT = (PASS >= 2) ? tab[q * 4 + 0] : 0;
    const bf16_t* kbase = Z + (size_t)b * SEQ * CD_N + Z_KI + 8 * h2;
    for (int kt = F.wave; kt < ntile; kt += NWAVE) {
        const bf16_t* kp = kbase + (size_t)(32 * kt + q) * CD_N;
        const bf16x8 A0l = *(const bf16x8*)kp, A1l = *(const bf16x8*)(kp + 16);
        const bf16x8 A0 = A0l, A1 = A1l;
        f32x16 sc;
#pragma unroll
        for (int r = 0; r < 16; ++r) sc[r] = 0.f;
        sc = MFMA32(A0, *(const LAS bf16x8*)(bq + (16 * 64 + F.lane) * 16), sc); sc = MFMA32(A1, *(const LAS bf16x8*)(bq + (17 * 64 + F.lane) * 16), sc);
#pragma unroll
        for (int r = 0; r < 16; ++r) sc[r] += 131072.0f;
#pragma unroll
        for (int h = 0; h < 8; ++h) {
            f32x16 ac;
#pragma unroll
            for (int r = 0; r < 16; ++r) ac[r] = 0.f;
            ac = MFMA32(A0, *(const LAS bf16x8*)(bq + ((2 * h) * 64 + F.lane) * 16), ac); ac = MFMA32(A1, *(const LAS bf16x8*)(bq + ((2 * h + 1) * 64 + F.lane) * 16), ac);
#pragma unroll
            for (int r = 0; r < 16; ++r) sc[r] += __builtin_fabsf(ac[r]) * wp[h];
        }
        const bool diag = (kt == ntile - 1);
        unsigned bits = 0u;
#pragma unroll
        for (int r = 0; r < 16; ++r) {
            int key = (int)sc[r]; key = key < 0 ? 0 : (key > 262143 ? 262143 : key);
            const bool valid = !diag || (crow_c(r) + 4 * h2 <= q);
            if (PASS == 1) { if (valid) __hip_atomic_fetch_add(&hist[q * 512 + (key >> 9)], 1u, __ATOMIC_RELAXED, __HIP_MEMORY_SCOPE_WORKGROUP); }
            else if (PASS == 2) { if (valid && (key >> 9) == myT) __hip_atomic_fetch_add(&hist[q * 512 + (key & 511)], 1u, __ATOMIC_RELAXED, __HIP_MEMORY_SCOPE_WORKGROUP); }
            else {
                if (valid && key > myT) bits |= 1u << crow_c(r);
                if (valid && key == myT) { const int p = __hip_atomic_fetch_add(&ccnt[q], 1, __ATOMIC_RELAXED, __HIP_MEMORY_SCOPE_WORKGROUP); if (p < 32) cand[q * 32 + p] = 32 * kt + crow_c(r) + 4 * h2; }
            }
        }
        if (PASS == 3) {
            bits <<= 4 * h2;
            bits |= (unsigned)__shfl_xor((int)bits, 32);
            if (h2 == 0) maskg[(size_t)(b * SEQ + t0 + q) * 256 + kt] = bits;
        }
    }
}
DI void topk_scan(const Frame& F, int pass, int t0) {
    LAS unsigned* hist = (LAS unsigned*)(F.lds + TK_HIST);
    LAS int* tab = (LAS int*)(F.lds + TK_TAB);
    for (int qi = 0; qi < 4; ++qi) {
        const int q = F.wave * 4 + qi, n = t0 + q + 1;
        int need = 256, prevT = 0, prevAbove = 0;
        if (pass == 2) { prevT = tab[q * 4 + 0]; prevAbove = tab[q * 4 + 1]; need = 256 - prevAbove; }
        if (n <= 256) { if (F.lane == 0) { tab[q * 4 + 0] = -1; tab[q * 4 + 1] = 0; tab[q * 4 + 2] = 0; } continue; }
        unsigned hv[8]; unsigned s = 0;
#pragma unroll
        for (int i = 0; i < 8; ++i) { hv[i] = hist[q * 512 + 511 - (8 * F.lane + i)]; s += hv[i]; }
        unsigned inc = s;
#pragma unroll
        for (int o = 1; o < 64; o <<= 1) { const unsigned v = (unsigned)__shfl_up((int)inc, o); if (F.lane >= o) inc += v; }
        const unsigned pre = inc - s;
        if ((int)pre < need && (int)inc >= need) {
            unsigned cum = pre; int bsel = 0; unsigned above = 0; bool found = false;
#pragma unroll
            for (int i = 0; i < 8; ++i) { if (!found && (int)(cum + hv[i]) >= need) { found = true; bsel = 511 - (8 * F.lane + i); above = cum; } cum += hv[i]; }
            if (pass == 1) { tab[q * 4 + 0] = bsel; tab[q * 4 + 1] = (int)above; }
            else { tab[q * 4 + 0] = (prevT << 9) | bsel; tab[q * 4 + 1] = prevAbove + (int)above; tab[q * 4 + 2] = 256 - (prevAbove + (int)above); }
        }
    }
}
DI void topk_phase(const Frame& F, const Args& a) {
    const bf16_t* Z = (const bf16_t*)(a.ws + WS_BIG);
    unsigned* maskg = (unsigned*)(a.ws + WS_MASK);
    LAS unsigned* hist = (LAS unsigned*)(F.lds + TK_HIST);
    LAS int* tab = (LAS int*)(F.lds + TK_TAB);
    LAS int* cand = (LAS int*)(F.lds + TK_CAND);
    LAS int* ccnt = (LAS int*)(F.lds + TK_CCNT);
    const int q = F.lane & 31, h2 = F.lane >> 5;
    for (int pi = F.bid; pi < 512; pi += F.G) {
        const int b = pi >> 7, p = pi & 127;
        for (int half = 0; half < 2; ++half) {
            const int t0 = 32 * (half ? 255 - p : p);
            const bf16_t* zr = Z + (size_t)(b * SEQ + t0 + q) * CD_N;
            float wp[8];
            { const u32x4 wv = *(const u32x4*)(zr + Z_WI);
              const float sc = 0.0625f * 0.5f * 16384.0f;
              wp[0] = bf_lo(wv[0]) * sc; wp[1] = bf_hi(wv[0]) * sc; wp[2] = bf_lo(wv[1]) * sc; wp[3] = bf_hi(wv[1]) * sc;
              wp[4] = bf_lo(wv[2]) * sc; wp[5] = bf_hi(wv[2]) * sc; wp[6] = bf_lo(wv[3]) * sc; wp[7] = bf_hi(wv[3]) * sc; }
            __syncthreads();
            if (F.wave == 0) {
                LAS unsigned char* bqw = F.lds + TK_BQ;
                float lin[2][8];
#pragma unroll
                for (int ks = 0; ks < 2; ++ks)
#pragma unroll
                    for (int j = 0; j < 8; ++j) lin[ks][j] = 0.f;
#pragma unroll
                for (int h = 0; h < 8; ++h)
#pragma unroll
                    for (int ks = 0; ks < 2; ++ks) {
                        const u32x4 v = *(const u32x4*)(zr + Z_QI + 32 * h + 16 * ks + 8 * h2);
                        *(LAS u32x4*)(bqw + ((2 * h + ks) * 64 + F.lane) * 16) = v;
#pragma unroll
                        for (int j = 0; j < 4; ++j) { lin[ks][2 * j] += wp[h] * bf_lo(v[j]); lin[ks][2 * j + 1] += wp[h] * bf_hi(v[j]); }
                    }
#pragma unroll
                for (int ks = 0; ks < 2; ++ks) {
                    u32x4 v; v[0] = pack_bf16(lin[ks][0], lin[ks][1]); v[1] = pack_bf16(lin[ks][2], lin[ks][3]); v[2] = pack_bf16(lin[ks][4], lin[ks][5]); v[3] = pack_bf16(lin[ks][6], lin[ks][7]);
                    *(LAS u32x4*)(bqw + ((16 + ks) * 64 + F.lane) * 16) = v;
                }
            }
            for (int i = F.tid; i < 32 * 512; i += NTHR) hist[i] = 0u;
            if (F.tid < 32) ccnt[F.tid] = 0;
            __syncthreads();
            topk_pass<1>(F, Z, maskg, b, t0, wp);
            __syncthreads();
            topk_scan(F, 1, t0);
            __syncthreads();
            for (int i = F.tid; i < 32 * 512; i += NTHR) hist[i] = 0u;
            __syncthreads();
            topk_pass<2>(F, Z, maskg, b, t0, wp);
            __syncthreads();
            topk_scan(F, 2, t0);
            __syncthreads();
            topk_pass<3>(F, Z, maskg, b, t0, wp);
            __threadfence();
            __syncthreads();
            if (F.tid < 32) {
                const int qq = F.tid, need = tab[qq * 4 + 2]; int nc = ccnt[qq]; nc = nc > 32 ? 32 : nc;
                if (tab[qq * 4 + 0] >= 0) {
                    int last = -1;
                    for (int k = 0; k < need && k < nc; ++k) {
                        int best = 0x7fffffff;
                        for (int i = 0; i < nc; ++i) { const int v = cand[qq * 32 + i]; if (v > last && v < best) best = v; }
                        if (best == 0x7fffffff) break;
                        atomicOr(&maskg[(size_t)(b * SEQ + t0 + qq) * 256 + (best >> 5)], 1u << (best & 31));
                        last = best;
                    }
                }
            }
            __syncthreads();
        }
    }
}

constexpr int AT_KSTR = 72;
constexpr int AT_VSTR = 68;
constexpr int AT_KBYTES = 64 * AT_KSTR * 2;
constexpr int AT_VBYTES = 128 * AT_VSTR * 2;
constexpr int AT_BUF = AT_KBYTES + AT_VBYTES;
constexpr int AT_LUT = 2 * AT_BUF;
constexpr int AT_LUT_LD = 132;
constexpr float NEG_INF = -__builtin_huge_valf();

template <int DV, bool MASKED>
DI void attn_core(const Frame& F, const bf16_t* Z, int b, int qcol, int kcol, int vcol, int q0, const LAS float* lut, float c1, const unsigned* maskg, f32x16 (&O)[DV / 32]) {
    constexpr int NDV = DV / 32;
    const int q = F.lane & 31, h2 = F.lane >> 5;
    const int tw0 = q0 + 32 * F.wave, t = tw0 + q;
    const bf16_t* Zb = Z + (size_t)b * SEQ * CD_N;
    bf16x8 Qf[4];
#pragma unroll
    for (int ks = 0; ks < 4; ++ks) Qf[ks] = *(const bf16x8*)(Zb + (size_t)t * CD_N + qcol + 16 * ks + 8 * h2);
#pragma unroll
    for (int d = 0; d < NDV; ++d)
#pragma unroll
        for (int r = 0; r < 16; ++r) O[d][r] = 0.f;
    float m_run = NEG_INF, l_run = 0.f;
    const int jmax = (q0 + 255) >> 6;
    const int kkey = F.tid >> 3, kch = F.tid & 7;
    u32x4 kreg, vreg[DV / 64];
#define AT_LOAD(j) do { kreg = *(const u32x4*)(Zb + (size_t)(64 * (j) + kkey) * CD_N + kcol + 8 * kch); \
        _Pragma("unroll") for (int _i = 0; _i < DV / 64; ++_i) { const int idx = F.tid + NTHR * _i; vreg[_i] = *(const u32x4*)(Zb + (size_t)(64 * (j) + (idx & 63)) * CD_N + vcol + 8 * (idx >> 6)); } } while (0)
#define AT_STORE(buf) do { LAS unsigned char* kb_ = F.lds + (buf) * AT_BUF; *(LAS u32x4*)(kb_ + kkey * (AT_KSTR * 2) + kch * 16) = kreg; \
        LAS bf16_t* vt_ = (LAS bf16_t*)(kb_ + AT_KBYTES); \
        _Pragma("unroll") for (int _i = 0; _i < DV / 64; ++_i) { const int idx = F.tid + NTHR * _i, key_ = idx & 63, ch_ = idx >> 6; \
            _Pragma("unroll") for (int e_ = 0; e_ < 4; ++e_) { vt_[(8 * ch_ + 2 * e_) * AT_VSTR + key_] = (bf16_t)(vreg[_i][e_] & 0xffffu); vt_[(8 * ch_ + 2 * e_ + 1) * AT_VSTR + key_] = (bf16_t)(vreg[_i][e_] >> 16); } } } while (0)
    AT_LOAD(0); AT_STORE(0);
    __syncthreads();
    for (int j = 0; j <= jmax; ++j) {
        if (j < jmax) AT_LOAD(j + 1);
        if (64 * j <= tw0 + 31) {
            const LAS unsigned char* kb = F.lds + (j & 1) * AT_BUF;
            const LAS unsigned char* vt = kb + AT_KBYTES;
            f32x16 s[2];
#pragma unroll
            for (int kb2 = 0; kb2 < 2; ++kb2) {
#pragma unroll
                for (int r = 0; r < 16; ++r) s[kb2][r] = 0.f;
#pragma unroll
                for (int ks = 0; ks < 4; ++ks) {
                    const bf16x8 A = *(const LAS bf16x8*)(kb + (32 * kb2 + q) * (AT_KSTR * 2) + (16 * ks + 8 * h2) * 2);
                    s[kb2] = MFMA32(A, Qf[ks], s[kb2]);
                }
            }
            const bool nearb = (64 * j + 63 + 128 > tw0);
            float mloc = NEG_INF;
            if (!nearb) {
                const float c0 = lut[128];
#pragma unroll
                for (int kb2 = 0; kb2 < 2; ++kb2)
#pragma unroll
                    for (int r = 0; r < 16; ++r) { s[kb2][r] = s[kb2][r] * c1 + c0; mloc = fmaxf(mloc, s[kb2][r]); }
            } else {
#pragma unroll
                for (int kb2 = 0; kb2 < 2; ++kb2)
#pragma unroll
                    for (int r = 0; r < 16; ++r) {
                        const int dist = t - (64 * j + 32 * kb2 + crow_c(r) + 4 * h2);
                        const float bl = lut[dist < 0 ? 0 : (dist > 128 ? 128 : dist)];
                        s[kb2][r] = dist < 0 ? NEG_INF : s[kb2][r] * c1 + bl; mloc = fmaxf(mloc, s[kb2][r]);
                    }
            }
            mloc = fmaxf(mloc, __shfl_xor(mloc, 32));
            const float m_new = fmaxf(m_run, mloc);
            const float alpha = __builtin_amdgcn_exp2f(m_run - m_new);
            m_run = m_new;
            float psum = 0.f;
#pragma unroll
            for (int kb2 = 0; kb2 < 2; ++kb2) {
                unsigned mw = 0u;
                if (MASKED) mw = maskg[(size_t)(b * SEQ + t) * 256 + 2 * j + kb2] >> (4 * h2);
#pragma unroll
                for (int r = 0; r < 16; ++r) {
                    float p = __builtin_amdgcn_exp2f(s[kb2][r] - m_new);
                    if (MASKED) p = ((mw >> crow_c(r)) & 1u) ? p : 0.f;
                    s[kb2][r] = p; psum += p;
                }
            }
            l_run = l_run * alpha + psum;
#pragma unroll
            for (int d = 0; d < NDV; ++d)
#pragma unroll
                for (int r = 0; r < 16; ++r) O[d][r] *= alpha;
#pragma unroll
            for (int kb2 = 0; kb2 < 2; ++kb2)
#pragma unroll
                for (int s2 = 0; s2 < 2; ++s2) {
                    u32x4 pw;
#pragma unroll
                    for (int e = 0; e < 4; ++e) pw[e] = pack_bf16(s[kb2][8 * s2 + 2 * e], s[kb2][8 * s2 + 2 * e + 1]);
                    const bf16x8 Pf = __builtin_bit_cast(bf16x8, pw);
#pragma unroll
                    for (int d = 0; d < NDV; ++d) {
                        const LAS unsigned char* vp = vt + (32 * d + q) * (AT_VSTR * 2) + (32 * kb2 + 16 * s2 + 4 * h2) * 2;
                        const u32x2 lo = *(const LAS u32x2*)vp, hi = *(const LAS u32x2*)(vp + 16);
                        u32x4 av; av[0] = lo[0]; av[1] = lo[1]; av[2] = hi[0]; av[3] = hi[1];
                        O[d] = MFMA32(__builtin_bit_cast(bf16x8, av), Pf, O[d]);
                    }
                }
        }
        if (j < jmax) AT_STORE((j + 1) & 1);
        __syncthreads();
    }
#undef AT_LOAD
#undef AT_STORE
    const float lt = l_run + __shfl_xor(l_run, 32);
    const float inv = 1.0f / lt;
#pragma unroll
    for (int d = 0; d < NDV; ++d)
#pragma unroll
        for (int r = 0; r < 16; ++r) O[d][r] *= inv;
}

DI float rel_bucket_bias(const float* rel_bias, int d, int head) {
    int bkt;
    if (d < 16) bkt = d;
    else { const float lr = __logf((float)d * (1.0f / 16.0f)) / 2.0794415416798357f; int l = 16 + (int)(lr * 16.0f); bkt = l < 31 ? l : 31; }
    return rel_bias[bkt * 12 + head];
}
DI void attn_phase(const Frame& F, const Args& a) {
    const bf16_t* Z = (const bf16_t*)(a.ws + WS_BIG);
    bf16_t* Yo = (bf16_t*)(a.ws + WS_Y);
    float* O1s = (float*)(a.ws + WS_H);
    const unsigned* maskg = (const unsigned*)(a.ws + WS_MASK);
    LAS float* lut = (LAS float*)(F.lds + AT_LUT);
    for (int i = F.tid; i < 12 * 129; i += NTHR) { const int hh = i / 129, d = i % 129; lut[hh * AT_LUT_LD + d] = rel_bucket_bias(a.rel_bias, d, hh) * LOG2E; }
    float lam;
    { float d01 = 0.f, d23 = 0.f; for (int i = 0; i < 64; ++i) { d01 += a.diff_lam[i] * a.diff_lam[64 + i]; d23 += a.diff_lam[128 + i] * a.diff_lam[192 + i]; }
      lam = __expf(d01) - __expf(d23) + 0.35550906759096f; }
    const float one_m_li = 1.0f - 0.35550906759096f;
    __syncthreads();
    const float c1 = 0.125f * LOG2E;
    const int q = F.lane & 31, h2 = F.lane >> 5;
    const int xcd = F.bid & 7, kk = F.bid >> 3;
    for (int it = F.bid; it < 256; it += F.G) {
        const int bh = (F.G == 256) ? 2 * xcd + (kk >> 4) : it >> 4, pr = (F.G == 256) ? (kk & 15) : (it & 15);
        const int b = bh >> 2, hd = bh & 3;
        for (int half = 0; half < 2; ++half) {
            const int q0 = 256 * (half ? 31 - pr : pr), t = q0 + 32 * F.wave + q;
            f32x16 O[4];
            attn_core<128, false>(F, Z, b, Z_QD + 128 * hd, Z_KD + 128 * hd, Z_VD + 128 * hd, q0, lut + (8 + hd) * AT_LUT_LD, c1, nullptr, O);
            float* o1p = O1s + (size_t)(b * SEQ + t) * 512 + 128 * hd;
#pragma unroll
            for (int d = 0; d < 4; ++d)
#pragma unroll
                for (int g = 0; g < 4; ++g) *(f32x4*)(o1p + 32 * d + 8 * g + 4 * h2) = (f32x4){O[d][4 * g], O[d][4 * g + 1], O[d][4 * g + 2], O[d][4 * g + 3]};
            attn_core<128, false>(F, Z, b, Z_QD + 128 * hd + 64, Z_KD + 128 * hd + 64, Z_VD + 128 * hd, q0, lut + (8 + hd) * AT_LUT_LD, c1, nullptr, O);
            float ss = 0.f;
#pragma unroll
            for (int d = 0; d < 4; ++d)
#pragma unroll
                for (int g = 0; g < 4; ++g) {
                    const f32x4 o1 = *(const f32x4*)(o1p + 32 * d + 8 * g + 4 * h2);
#pragma unroll
                    for (int e = 0; e < 4; ++e) { const float v = o1[e] - lam * O[d][4 * g + e]; O[d][4 * g + e] = v; ss += v * v; }
                }
            ss += __shfl_xor(ss, 32);
            const float rinv = rsqrtf(ss * (1.0f / 128.0f) + EPS) * one_m_li;
            bf16_t* yp = Yo + (size_t)(b * SEQ + t) * DM + 512 + 128 * hd;
#pragma unroll
            for (int d = 0; d < 4; ++d)
#pragma unroll
                for (int g = 0; g < 4; ++g) {
                    const int dv = 32 * d + 8 * g + 4 * h2;
                    const f32x4 gn = *(const f32x4*)(a.diff_norm_g + dv);
                    f32x4 v; v[0] = O[d][4 * g] * rinv * gn[0]; v[1] = O[d][4 * g + 1] * rinv * gn[1]; v[2] = O[d][4 * g + 2] * rinv * gn[2]; v[3] = O[d][4 * g + 3] * rinv * gn[3];
                    *(u32x2*)(yp + dv) = pack4(v);
                }
        }
    }
    for (int it = F.bid; it < 512; it += F.G) {
        const int rnd = it / F.G;
        const int bh = (F.G == 256) ? 4 * xcd + 2 * rnd + (kk >> 4) : it >> 4, pr = (F.G == 256) ? (kk & 15) : (it & 15);
        const int b = bh >> 3, hc = bh & 7;
        for (int half = 0; half < 2; ++half) {
            const int q0 = 256 * (half ? 31 - pr : pr), t = q0 + 32 * F.wave + q;
            f32x16 O[2];
            attn_core<64, true>(F, Z, b, Z_QC + 64 * hc, Z_KC + 64 * hc, Z_VC + 64 * hc, q0, lut + hc * AT_LUT_LD, c1, maskg, O);
            bf16_t* yp = Yo + (size_t)(b * SEQ + t) * DM + 64 * hc;
#pragma unroll
            for (int d = 0; d < 2; ++d)
#pragma unroll
                for (int g = 0; g < 4; ++g) {
                    f32x4 v = {O[d][4 * g], O[d][4 * g + 1], O[d][4 * g + 2], O[d][4 * g + 3]};
                    *(u32x2*)(yp + 32 * d + 8 * g + 4 * h2) = pack4(v);
                }
        }
    }
}

#ifndef MK_ONE_LAUNCH
#define MK_ONE_LAUNCH 0
#endif
constexpr int NPH = 17;
__global__ void __launch_bounds__(NTHR, 2) fwd_kernel(Args a) {
    extern __shared__ __attribute__((aligned(16))) unsigned char lds_raw[];
    Frame F; F.lds = (LAS unsigned char*)lds_raw; F.tid = threadIdx.x; F.lane = F.tid & 63; F.wave = __builtin_amdgcn_readfirstlane(F.tid >> 6); F.G = gridDim.x; F.bid = blockIdx.x;
    unsigned* ctl = (unsigned*)(a.ws + WS_CTL);
    volatile LAS unsigned* xbw = (volatile LAS unsigned*)(F.lds + LDS_XB);
    if (F.tid < 4) xbw[F.tid] = 0u;
    __syncthreads();
    const int lo = a.ph_lo, hi = a.ph_hi;
    XcdBarrier bar; bar.bar = ctl + CW_BAR; bar.x = 0; bar.st = xbw;
    if (hi - lo > 1) bar = xcd_barrier_post(ctl + CW_BAR, xbw);
#ifndef PH_ONLY
#define IN(k) (lo <= (k) && (k) < hi)
#else
#define IN(k) ((k) == PH_ONLY && lo <= (k) && (k) < hi)
#endif
#define SEAM(k) do { if (IN(k) && IN((k) + 1)) xcd_barrier(bar); } while (0)
    float* mod = (float*)(a.ws + WS_MOD);
    bf16_t* hbuf = (bf16_t*)(a.ws + WS_H);
    bf16_t* ybuf = (bf16_t*)(a.ws + WS_Y);
    LAS int* ntp = (LAS int*)(F.lds + LDS_MISC);

    if (IN(0)) { p0_prologue(F, a); } SEAM(0);
    if (IN(1)) { norm_phase<false, false, false>(F, a, a.x, 0, 0, 0); } SEAM(1);
    if (IN(2)) {
        DenseSched S; S.init(NTOK, AB_N, DM, F.G, F.bid, a.ws + WS_WAB_IN);
        EpiAbIn E{(bf16_t*)(a.ws + WS_BIG)};
        pg8::gemm_phase(F.lds, (const char*)hbuf, DM, S, E);
    } SEAM(2);
    if (IN(3)) { conv_phase(F, a); } SEAM(3);
    if (IN(4)) {
        DenseSched S; S.init(NTOK, DM, DM, F.G, F.bid, a.ws + WS_WAB_OUT);
        EpiResid E{a.x, a.out, mod + 2 * DM};
        pg8::gemm_phase(F.lds, (const char*)ybuf, DM, S, E);
    } SEAM(4);
#define MOE_PHASES(layer, pb) do { \
        const unsigned* cnt = ctl + CW_CNT + (layer) * NEXP; \
        if (IN(pb)) { norm_phase<false, true, false>(F, a, a.out, (layer), 1, 0); } SEAM(pb); \
        if (IN((pb) + 1)) { \
            moe_tile_table(F, cnt, ntp); \
            MoeSched<true> S; S.ntp = ntp; S.cnt = cnt; S.list = (const int*)(a.ws + WS_LIST); S.W = (const char*)(a.ws + WS_MOE_W); S.nU = 4 * ntp[NEXP]; S.G = F.G; S.c = F.bid; \
            EpiMoeUp E{(bf16_t*)(a.ws + WS_ACT)}; \
            pg8::gemm_phase(F.lds, (const char*)hbuf, DM, S, E); \
        } SEAM((pb) + 1); \
        if (IN((pb) + 2)) { \
            moe_tile_table(F, cnt, ntp); \
            MoeSched<false> S; S.ntp = ntp; S.cnt = cnt; S.list = nullptr; S.W = (const char*)(a.ws + WS_MOE_W); S.nU = 4 * ntp[NEXP]; S.G = F.G; S.c = F.bid; \
            EpiMoeDown E{(bf16_t*)(a.ws + WS_YMOE), (const float*)(a.ws + WS_GATEV), ntp}; \
            pg8::gemm_phase(F.lds, (const char*)(a.ws + WS_ACT), DEXP, S, E); \
        } SEAM((pb) + 2); } while (0)
    MOE_PHASES(0, 5);
    if (IN(8)) {
        norm_phase<true, false, false>(F, a, a.out, 1, 0, 0);
        for (int it = F.bid; it < CVT_MOE_TILES; it += F.G) cvt_moe_item(F, a, 1, it);
    } SEAM(8);
    if (IN(9)) {
        DenseSched S; S.init(NTOK, CD_N, DM, F.G, F.bid, a.ws + WS_WCD_IN);
        EpiPlain E{(bf16_t*)(a.ws + WS_BIG), CD_N};
        pg8::gemm_phase(F.lds, (const char*)hbuf, DM, S, E);
    } SEAM(9);
    if (IN(10)) { topk_phase(F, a); } SEAM(10);
    if (IN(11)) { attn_phase(F, a); } SEAM(11);
    if (IN(12)) {
        DenseSched S; S.init(NTOK, DM, DM, F.G, F.bid, a.ws + WS_WCD_OUT);
        EpiResid E{a.out, a.out, mod + (size_t)NB * 6 * DM + 2 * DM};
        pg8::gemm_phase(F.lds, (const char*)ybuf, DM, S, E);
    } SEAM(12);
    MOE_PHASES(1, 13);
#undef MOE_PHASES
    if (IN(16)) { norm_phase<true, false, true>(F, a, a.out, 1, 0, 1); }
#undef IN
#undef SEAM
}

extern "C" void kernel_launch(void* const* d_in, const int* in_sizes, int n_in, void* d_out, int out_size, void* d_ws, size_t ws_size, hipStream_t stream) {
    static int grid = 0;
    if (grid == 0) {
        if (n_in != 26 || out_size != NTOK * DM || ws_size < WS_END) { fprintf(stderr, "kernel_launch: unexpected problem (n_in %d, out %d, ws %zu < %zu)\n", n_in, out_size, ws_size, (size_t)WS_END); grid = -1; return; }
        int dev = 0, cus = 0, per_cu = 0;
        if (hipGetDevice(&dev) != hipSuccess || hipDeviceGetAttribute(&cus, hipDeviceAttributeMultiprocessorCount, dev) != hipSuccess) { grid = -1; return; }
        if (hipFuncSetAttribute((const void*)fwd_kernel, hipFuncAttributeMaxDynamicSharedMemorySize, LDS_BYTES) != hipSuccess) { fprintf(stderr, "kernel_launch: hipFuncSetAttribute failed\n"); grid = -1; return; }
        if (hipOccupancyMaxActiveBlocksPerMultiprocessor(&per_cu, (const void*)fwd_kernel, NTHR, LDS_BYTES) != hipSuccess || per_cu < 1) { fprintf(stderr, "kernel_launch: occupancy query says %d\n", per_cu); }
        (void)hipGetLastError();
        grid = cus;
    }
    if (grid < 0) return;
    (void)hipMemsetAsync((char*)d_ws + WS_CTL, 0, CTL_BYTES, stream);
    Args a{};
    const float** fp = (const float**)&a.x;
    (void)fp;
    a.x = (const float*)d_in[0]; a.c = (const float*)d_in[1]; a.positions = (const int*)d_in[2]; a.rel_bias = (const float*)d_in[3]; a.norm_g = (const float*)d_in[4];
    a.final_norm_g = (const float*)d_in[5]; a.ada_w = (const float*)d_in[6]; a.ada_b = (const float*)d_in[7]; a.ab_w_in = (const float*)d_in[8]; a.ab_conv_a = (const float*)d_in[9];
    a.ab_conv_b = (const float*)d_in[10]; a.ab_conv_b_bias = (const float*)d_in[11]; a.ab_ln_g = (const float*)d_in[12]; a.ab_ln_b = (const float*)d_in[13]; a.ab_w_out = (const float*)d_in[14];
    a.cd_w_in = (const float*)d_in[15]; a.diff_lam = (const float*)d_in[16]; a.diff_norm_g = (const float*)d_in[17]; a.cd_w_out = (const float*)d_in[18];
    a.moe_wr_g = (const float*)d_in[19]; a.moe_br_g = (const float*)d_in[20]; a.moe_wr_e = (const float*)d_in[21]; a.moe_br_e = (const float*)d_in[22];
    a.moe_w_gate = (const float*)d_in[23]; a.moe_w_up = (const float*)d_in[24]; a.moe_w_down = (const float*)d_in[25];
    a.out = (float*)d_out; a.ws = (unsigned char*)d_ws;
#if MK_ONE_LAUNCH
    a.ph_lo = 0; a.ph_hi = NPH;
    hipLaunchKernelGGL(fwd_kernel, dim3(grid), dim3(NTHR), LDS_BYTES, stream, a);
#else
    for (int p = 0; p < NPH; ++p) { a.ph_lo = p; a.ph_hi = p + 1; hipLaunchKernelGGL(fwd_kernel, dim3(grid), dim3(NTHR), LDS_BYTES, stream, a); }
#endif
}
```

```cpp
#include <hip/hip_runtime.h>
#include <cstdio>
#include <cstdint>

#define LAS __attribute__((address_space(3)))
#define DI __device__ __forceinline__
typedef unsigned short bf16_t;
typedef short bf16x8 __attribute__((ext_vector_type(8)));
typedef short s16x4 __attribute__((ext_vector_type(4)));
typedef float f32x2 __attribute__((ext_vector_type(2)));
typedef float f32x4 __attribute__((ext_vector_type(4)));
typedef float f32x16 __attribute__((ext_vector_type(16)));
typedef unsigned u32x2 __attribute__((ext_vector_type(2)));
typedef unsigned u32x4 __attribute__((ext_vector_type(4)));
typedef __bf16 bf16v2 __attribute__((ext_vector_type(2)));

constexpr int NB = 4, SEQ = 8192, DM = 1024, NTOK = NB * SEQ;
constexpr int NTHR = 512, NWAVE = 8;
constexpr int AB_N = 2560;
constexpr int ZC_N = 1536;
constexpr int CD_SRC_N = 3368;
constexpr int CD_N = 3584;
constexpr int Z_QC = 0, Z_KC = 512, Z_VC = 1024, Z_QD = 1536, Z_KD = 2048, Z_VD = 2560, Z_QI = 3072, Z_KI = 3328, Z_WI = 3360;
constexpr int NEXP = 32, DEXP = 512;
constexpr int MOE_ROWS = 2 * NTOK + NEXP * 256;
constexpr float EPS = 1e-6f;
constexpr float LOG2E = 1.4426950408889634f;

constexpr size_t MiB = 1u << 20;
constexpr size_t WS_CTL = 0, CTL_BYTES = 64 * 1024;
constexpr size_t WS_MOD = 1 * MiB;
constexpr size_t WS_WAB_IN = 2 * MiB;
constexpr size_t WS_WAB_OUT = 7 * MiB;
constexpr size_t WS_WCD_IN = 9 * MiB;
constexpr size_t WS_WCD_OUT = 16 * MiB;
constexpr size_t WS_MOE_W = 18 * MiB;
constexpr size_t WS_H = 114 * MiB;
constexpr size_t WS_Y = 178 * MiB;
constexpr size_t WS_BIG = 242 * MiB;
constexpr size_t WS_ACT = WS_BIG;
constexpr size_t WS_YMOE = WS_BIG + 72 * MiB;
constexpr size_t WS_MASK = 466 * MiB;
constexpr size_t WS_LIST = 498 * MiB;
constexpr size_t WS_GATEV = 502 * MiB;
constexpr size_t WS_TOKSLOT = 506 * MiB;
constexpr size_t WS_END = 507 * MiB;

constexpr int CW_BAR = 0;
constexpr int CW_CNT = 4096;

DI unsigned pack_bf16(float lo, float hi) { f32x2 v = {lo, hi}; bf16v2 b = __builtin_convertvector(v, bf16v2); return __builtin_bit_cast(unsigned, b); }
DI float bf_lo(unsigned w) { return __uint_as_float(w << 16); }
DI float bf_hi(unsigned w) { return __uint_as_float(w & 0xffff0000u); }
DI float bf2f(bf16_t b) { return __uint_as_float(((unsigned)b) << 16); }
DI float wave_sum(float v) {
#pragma unroll
    for (int o = 32; o >= 1; o >>= 1) v += __shfl_xor(v, o);
    return v;
}
DI float silu_f(float v) { return v / (1.0f + __expf(-v)); }
DI float sigmoid_f(float v) { return 1.0f / (1.0f + __expf(-v)); }

#define XB_TMO      128
#define XB_XCNT(j)  (256  + 64 * (j))
#define XB_XSUB(j)  (1280 + 64 * (j))
#define XB_XGEN(j)  (2304 + 64 * (j))
#define XB_TOP      3328
#define XB_TOPGEN   3392
#define XCD_BAR_WORDS 3456
#define XB_SPIN_CAP (1u << 22)
DI unsigned xb_ld(unsigned* p)              { return __hip_atomic_load(p, __ATOMIC_RELAXED, __HIP_MEMORY_SCOPE_AGENT); }
DI unsigned xb_add(unsigned* p, unsigned v) { return __hip_atomic_fetch_add(p, v, __ATOMIC_RELAXED, __HIP_MEMORY_SCOPE_AGENT); }
DI unsigned xb_xcc_id() { return (unsigned)__builtin_amdgcn_s_getreg((3 << 11) | 20) & 0xFu; }
#define XB_SPIN(cond, bar) do { unsigned _sp = 0; while (cond) { __builtin_amdgcn_s_sleep(1); \
    if ((++_sp & 255u) == 0u) { if (xb_ld(&(bar)[XB_TMO])) break; if (_sp > XB_SPIN_CAP) { atomicAdd(&(bar)[XB_TMO], 1u); break; } } } } while (0)
struct XcdBarrier { unsigned* bar; unsigned x; volatile LAS unsigned* st; };
DI XcdBarrier xcd_barrier_post(unsigned* bar, volatile LAS unsigned* st) {
    XcdBarrier b; b.bar = bar; b.x = xb_xcc_id(); b.st = st;
    if (threadIdx.x == 0) (void)xb_add(&bar[XB_XCNT(b.x)], 1u);
    return b;
}
DI void xcd_barrier_complete(unsigned* bar, unsigned x, unsigned& nloc, unsigned& nx) {
    const unsigned G = gridDim.x * gridDim.y * gridDim.z;
    unsigned sum, cnt, mine, sp = 0u;
    for (;;) {
        sum = 0u; cnt = 0u; mine = 0u;
#pragma unroll
        for (unsigned j = 0; j < 16; ++j) { const unsigned c = xb_ld(&bar[XB_XCNT(j)]); sum += c; cnt += (c > 0u) ? 1u : 0u; mine = (j == x) ? c : mine; }
        if (sum == G) break;
        __builtin_amdgcn_s_sleep(1);
        if ((++sp & 255u) == 0u) { if (xb_ld(&bar[XB_TMO])) break; if (sp > XB_SPIN_CAP) { atomicAdd(&bar[XB_TMO], 1u); break; } }
    }
    nloc = mine > 0u ? mine : 1u; nx = cnt > 0u ? cnt : 1u;
}
DI void xcd_barrier(const XcdBarrier& b) {
    asm volatile("s_waitcnt vmcnt(0)" ::: "memory");
    __syncthreads();
    if (threadIdx.x == 0) {
        unsigned* bar = b.bar;
        __builtin_amdgcn_s_waitcnt(0);
        unsigned nloc = b.st[0], nx = b.st[1];
        if (nloc == 0u) { xcd_barrier_complete(bar, b.x, nloc, nx); b.st[0] = nloc; b.st[1] = nx; }
        const unsigned old = xb_add(&bar[XB_XSUB(b.x)], 1u);
        const unsigned gen = old / nloc;
        if (old + 1u == (gen + 1u) * nloc) {
            __builtin_amdgcn_fence(__ATOMIC_RELEASE, "agent");
            asm volatile("s_waitcnt vmcnt(0)" ::: "memory");
            const unsigned og = xb_add(&bar[XB_TOP], 1u);
            const unsigned tg = og / nx;
            if (og + 1u == (tg + 1u) * nx) xb_add(&bar[XB_TOPGEN], 1u);
            else XB_SPIN(xb_ld(&bar[XB_TOPGEN]) == tg, bar);
            __builtin_amdgcn_fence(__ATOMIC_ACQUIRE, "agent");
            xb_add(&bar[XB_XGEN(b.x)], 1u);
            asm volatile("s_waitcnt vmcnt(0)" ::: "memory");
        } else {
            XB_SPIN(xb_ld(&bar[XB_XGEN(b.x)]) == gen, bar);
            __builtin_amdgcn_fence(__ATOMIC_ACQUIRE, "agent");
            asm volatile("s_waitcnt vmcnt(0)" ::: "memory");
        }
    }
    __syncthreads();
}

namespace pg8 {
constexpr int BM = 256, BK = 64, HALF = 128, HTB = HALF * BK * 2, STAGE_BYTES = 8 * HTB;
DI int lds_byte(int r, int c) { const int st = (r >> 4) * 2 + (c >> 5), rr = r & 15, cc = c & 31, ob = rr * 64 + cc * 2; return st * 1024 + (ob ^ (((ob >> 9) & 1) << 5)); }
DI void stage_rc(int b, int& R, int& C) { const int st = b / 1024, sb = b % 1024, swz = sb ^ (((sb >> 9) & 1) << 5); R = (st >> 1) * 16 + swz / 64; C = (st & 1) * 32 + (swz % 64) / 2; }
struct Unit { int pm, pn, e, nrow; };

template <class Epi, class Sched>
DI void gemm_phase(LAS unsigned char* lds, const char* Abase, const int K, const Sched& S, const Epi& E) {
    const int tid = threadIdx.x, wid = __builtin_amdgcn_readfirstlane(tid >> 6), lane = tid & 63, wr = wid >> 2, wc = wid & 3, fr = lane & 15, fq = lane >> 4;
    const int nt = K / BK;
    int Rr[2], Cc[2]; unsigned voffB[2];
#pragma unroll
    for (int i = 0; i < 2; ++i) { int R, C; stage_rc(tid * 16 + i * 8192, R, C); Rr[i] = R; Cc[i] = C; voffB[i] = (unsigned)(R * K + C) * 2u; }
    const size_t kstep = (size_t)(BK * 2);
    const size_t hstep = (size_t)HALF * K * 2;
    const unsigned ldsw = (unsigned)wid * 1024u;
    const int aoff = lds_byte(wr * 64 + fr, fq * 8), boff = lds_byte(wc * 32 + fr, fq * 8);
#define PG8_SA(b, h) (((b) * 2 + (h)) * HTB)
#define PG8_SB(b, h) ((4 + (b) * 2 + (h)) * HTB)
#define PG8_STAGE(bufoff, gbase, voff) do { _Pragma("unroll") for (int _i = 0; _i < 2; ++_i) \
        __builtin_amdgcn_global_load_lds((const unsigned*)((const char*)(gbase) + (voff)[_i]), (LAS unsigned*)(lds + (bufoff) + ldsw + _i * 8192), 16, 0, 0); } while (0)
#define PG8_AOFF(dst, u) do { _Pragma("unroll") for (int _h = 0; _h < 2; ++_h) _Pragma("unroll") for (int _i = 0; _i < 2; ++_i) \
        dst[_h][_i] = ((unsigned)S.a_row(u, _h * HALF + Rr[_i]) * (unsigned)K + (unsigned)Cc[_i]) * 2u; } while (0)
#define PG8_LDA(dst, b, h) do { _Pragma("unroll") for (int m = 0; m < 4; ++m) _Pragma("unroll") for (int k = 0; k < 2; ++k) dst[m][k] = *(const LAS bf16x8*)(lds + PG8_SA(b, h) + aoff + m * 2048 + k * 1024); } while (0)
#define PG8_LDB(dst, b, h) do { _Pragma("unroll") for (int n = 0; n < 2; ++n) _Pragma("unroll") for (int k = 0; k < 2; ++k) dst[n][k] = *(const LAS bf16x8*)(lds + PG8_SB(b, h) + boff + n * 2048 + k * 1024); } while (0)
#define PG8_MMA(ai, bj, At, Bt) do { __builtin_amdgcn_s_setprio(1); _Pragma("unroll") for (int m = 0; m < 4; ++m) _Pragma("unroll") for (int n = 0; n < 2; ++n) _Pragma("unroll") for (int k = 0; k < 2; ++k) \
        acc[ai][bj][m][n] = __builtin_amdgcn_mfma_f32_16x16x32_bf16(Bt[n][k], At[m][k], acc[ai][bj][m][n], 0, 0, 0); __builtin_amdgcn_s_setprio(0); } while (0)
#define PG8_WAIT_V(n) asm volatile("s_waitcnt vmcnt(" #n ")" ::: "memory")
#define PG8_WAIT_L(n) asm volatile("s_waitcnt lgkmcnt(" #n ")" ::: "memory")
#define PG8_BAR __builtin_amdgcn_s_barrier()
#define PG8_SCHED __builtin_amdgcn_sched_barrier(0)
    Unit cur, nxt; int ui = 0;
    if (!S.next(0, cur)) return;
    f32x4 acc[2][2][4][2];
#pragma unroll
    for (int a = 0; a < 2; ++a)
#pragma unroll
        for (int b = 0; b < 2; ++b)
#pragma unroll
            for (int m = 0; m < 4; ++m)
#pragma unroll
                for (int n = 0; n < 2; ++n) acc[a][b][m][n] = (f32x4){0.f, 0.f, 0.f, 0.f};
    bf16x8 At[4][2], B0[2][2], B1[2][2];
    unsigned aoC[2][2], aoN[2][2];
    PG8_AOFF(aoC, cur);
    const char* cB = S.b_base(cur);
    PG8_STAGE(PG8_SB(0, 0), cB, voffB); PG8_STAGE(PG8_SA(0, 0), Abase, aoC[0]); PG8_STAGE(PG8_SB(0, 1), cB + hstep, voffB); PG8_STAGE(PG8_SA(0, 1), Abase, aoC[1]);
    if (wr == 1) PG8_BAR;
    PG8_WAIT_V(4); PG8_BAR;
    PG8_STAGE(PG8_SB(1, 0), cB + kstep, voffB); PG8_STAGE(PG8_SA(1, 0), Abase + kstep, aoC[0]); PG8_STAGE(PG8_SB(1, 1), cB + hstep + kstep, voffB);
    PG8_WAIT_V(6); PG8_BAR;
    for (;;) {
        const bool has_next = S.next(ui + 1, nxt);
        const char* nB = cB;
#pragma unroll
        for (int _h = 0; _h < 2; ++_h)
#pragma unroll
            for (int _i = 0; _i < 2; ++_i) aoN[_h][_i] = aoC[_h][_i];
        if (has_next) { PG8_AOFF(aoN, nxt); nB = S.b_base(nxt); }
        for (int t = 0; t < nt; t += 2) {
            const bool last = (t == nt - 2);
            const char* a1 = Abase + (size_t)(t + 1) * kstep;
            const char* a2 = last ? Abase : Abase + (size_t)(t + 2) * kstep; const char* b2 = last ? nB : cB + (size_t)(t + 2) * kstep;
            const char* a3 = a2 + kstep; const char* b3 = b2 + kstep;
            unsigned ao2[2][2];
#pragma unroll
            for (int _h = 0; _h < 2; ++_h)
#pragma unroll
                for (int _i = 0; _i < 2; ++_i) ao2[_h][_i] = last ? aoN[_h][_i] : aoC[_h][_i];
            PG8_LDB(B0, 0, 0); PG8_SCHED; PG8_LDA(At, 0, 0); PG8_STAGE(PG8_SA(1, 1), a1, aoC[1]);
            PG8_WAIT_L(8); PG8_BAR; PG8_WAIT_L(0); PG8_MMA(0, 0, At, B0); PG8_BAR; PG8_SCHED;
            PG8_LDB(B1, 0, 1); PG8_STAGE(PG8_SB(0, 0), b2, voffB);
            PG8_BAR; PG8_WAIT_L(0); PG8_MMA(0, 1, At, B1); PG8_BAR;
            PG8_LDA(At, 0, 1); PG8_STAGE(PG8_SA(0, 0), a2, ao2[0]);
            PG8_BAR; PG8_WAIT_L(0); PG8_MMA(1, 0, At, B0); PG8_BAR; PG8_SCHED;
            PG8_STAGE(PG8_SB(0, 1), b2 + hstep, voffB);
            PG8_WAIT_V(6); PG8_BAR; PG8_MMA(1, 1, At, B1); PG8_BAR;
            PG8_LDB(B0, 1, 0); PG8_SCHED; PG8_LDA(At, 1, 0); PG8_STAGE(PG8_SA(0, 1), a2, ao2[1]);
            PG8_WAIT_L(8); PG8_BAR; PG8_WAIT_L(0); PG8_MMA(0, 0, At, B0); PG8_BAR; PG8_SCHED;
            PG8_LDB(B1, 1, 1); PG8_STAGE(PG8_SB(1, 0), b3, voffB);
            PG8_BAR; PG8_WAIT_L(0); PG8_MMA(0, 1, At, B1); PG8_BAR;
            PG8_LDA(At, 1, 1); PG8_STAGE(PG8_SA(1, 0), a3, ao2[0]);
            PG8_BAR; PG8_WAIT_L(0); PG8_MMA(1, 0, At, B0); PG8_BAR; PG8_SCHED;
            PG8_STAGE(PG8_SB(1, 1), b3 + hstep, voffB);
            PG8_WAIT_V(6); PG8_BAR; PG8_MMA(1, 1, At, B1); PG8_BAR;
        }
        E(acc, cur, wr, wc, fr, fq);
        if (!has_next) break;
#pragma unroll
        for (int a = 0; a < 2; ++a)
#pragma unroll
            for (int b = 0; b < 2; ++b)
#pragma unroll
                for (int m = 0; m < 4; ++m)
#pragma unroll
                    for (int n = 0; n < 2; ++n) acc[a][b][m][n] = (f32x4){0.f, 0.f, 0.f, 0.f};
        cur = nxt; cB = nB; ++ui;
#pragma unroll
        for (int _h = 0; _h < 2; ++_h)
#pragma unroll
            for (int _i = 0; _i < 2; ++_i) aoC[_h][_i] = aoN[_h][_i];
    }
    PG8_WAIT_V(0);
    if (wr == 0) PG8_BAR;
    PG8_BAR;
#undef PG8_SA
#undef PG8_SB
#undef PG8_STAGE
#undef PG8_AOFF
#undef PG8_LDA
#undef PG8_LDB
#undef PG8_MMA
#undef PG8_WAIT_V
#undef PG8_WAIT_L
#undef PG8_BAR
#undef PG8_SCHED
}
}

struct Args {
    const float* x; const float* c; const int* positions; const float* rel_bias; const float* norm_g; const float* final_norm_g;
    const float* ada_w; const float* ada_b; const float* ab_w_in; const float* ab_conv_a; const float* ab_conv_b; const float* ab_conv_b_bias;
    const float* ab_ln_g; const float* ab_ln_b; const float* ab_w_out; const float* cd_w_in; const float* diff_lam; const float* diff_norm_g;
    const float* cd_w_out; const float* moe_wr_g; const float* moe_br_g; const float* moe_wr_e; const float* moe_br_e;
    const float* moe_w_gate; const float* moe_w_up; const float* moe_w_down;
    float* out; unsigned char* ws; int ph_lo, ph_hi;
};
struct Frame {
    LAS unsigned char* lds; int tid, lane, wave, G, bid;
};

struct RowSrc { const float* p; int ld; };
DI void ilv(int rp, int& j, int& second) { const int g = rp >> 5, i = rp & 31; j = 16 * g + (i & 15); second = i >> 4; }

enum { CV_AB_IN = 0, CV_AB_OUT = 1, CV_CD_IN = 2, CV_CD_OUT = 3, CV_MOE_GU = 4, CV_MOE_D = 5 };
template <int KIND> DI RowSrc row_src(const Args& a, int layer, int e, int r) {
    RowSrc s; s.p = nullptr; s.ld = 0;
    if (KIND == CV_AB_IN) {
        s.ld = AB_N;
        if (r < 512) s.p = a.ab_w_in + r;
        else if (r < 1536) { int j, sec; ilv(r - 512, j, sec); s.p = a.ab_w_in + (sec ? 1024 + j : 512 + j); }
        else { int j, sec; ilv(r - 1536, j, sec); s.p = a.ab_w_in + (sec ? 2048 + j : 1536 + j); }
    } else if (KIND == CV_AB_OUT) { s.ld = DM; s.p = a.ab_w_out + r; }
    else if (KIND == CV_CD_IN) {
        s.ld = CD_SRC_N;
        int col = -1;
        if (r < 1536) col = r;
        else if (r < 3072) col = 1832 + (r - 1536);
        else if (r < 3328) col = 1536 + (r - 3072);
        else if (r < 3360) col = 1792 + (r - 3328);
        else if (r < 3368) col = 1824 + (r - 3360);
        if (col >= 0) s.p = a.cd_w_in + col;
    } else if (KIND == CV_CD_OUT) { s.ld = DM; s.p = a.cd_w_out + r; }
    else if (KIND == CV_MOE_GU) {
        int j, sec; ilv(r, j, sec); s.ld = DEXP;
        const size_t base = ((size_t)layer * NEXP + e) * (size_t)DM * DEXP;
        s.p = (sec ? a.moe_w_up : a.moe_w_gate) + base + j;
    } else {
        s.ld = DM; s.p = a.moe_w_down + ((size_t)layer * NEXP + e) * (size_t)DEXP * DM + r;
    }
    return s;
}
template <int KIND> DI void cvt_tile(const Frame& F, const Args& a, bf16_t* dst, int K, int r0, int k0, int layer, int e) {
    LAS bf16_t* T = (LAS bf16_t*)F.lds;
#pragma unroll
    for (int it = 0; it < 2; ++it) {
        const int eidx = F.tid + it * NTHR, kk = eidx >> 4, c4 = eidx & 15;
        const RowSrc s = row_src<KIND>(a, layer, e, r0 + 4 * c4);
        f32x4 v = {0.f, 0.f, 0.f, 0.f};
        if (s.p) v = *(const f32x4*)(s.p + (size_t)(k0 + kk) * s.ld);
        const unsigned p01 = pack_bf16(v[0], v[1]), p23 = pack_bf16(v[2], v[3]);
        T[(4 * c4 + 0) * 66 + kk] = (bf16_t)(p01 & 0xffffu); T[(4 * c4 + 1) * 66 + kk] = (bf16_t)(p01 >> 16);
        T[(4 * c4 + 2) * 66 + kk] = (bf16_t)(p23 & 0xffffu); T[(4 * c4 + 3) * 66 + kk] = (bf16_t)(p23 >> 16);
    }
    __syncthreads();
    {
        const int rr = F.tid >> 3, c = F.tid & 7;
        const LAS unsigned* src = (const LAS unsigned*)(T + rr * 66 + c * 8);
        u32x4 w; w[0] = src[0]; w[1] = src[1]; w[2] = src[2]; w[3] = src[3];
        *(u32x4*)(dst + (size_t)(r0 + rr) * K + k0 + c * 8) = w;
    }
    __syncthreads();
}
constexpr int CVT_DENSE_TILES = (AB_N + DM + CD_N + DM) / 64 * (DM / 64);
constexpr int CVT_MOE_TILES_PER_EXP = (1024 / 64) * (1024 / 64) + (1024 / 64) * (512 / 64);
constexpr int CVT_MOE_TILES = NEXP * CVT_MOE_TILES_PER_EXP;
DI void cvt_dense_item(const Frame& F, const Args& a, int item) {
    const int rt = item >> 4, kt = item & 15;
    int r = rt * 64;
    if (r < AB_N) { cvt_tile<CV_AB_IN>(F, a, (bf16_t*)(a.ws + WS_WAB_IN), DM, r, kt * 64, 0, 0); return; }
    r -= AB_N;
    if (r < DM) { cvt_tile<CV_AB_OUT>(F, a, (bf16_t*)(a.ws + WS_WAB_OUT), DM, r, kt * 64, 0, 0); return; }
    r -= DM;
    if (r < CD_N) { cvt_tile<CV_CD_IN>(F, a, (bf16_t*)(a.ws + WS_WCD_IN), DM, r, kt * 64, 0, 0); return; }
    r -= CD_N;
    cvt_tile<CV_CD_OUT>(F, a, (bf16_t*)(a.ws + WS_WCD_OUT), DM, r, kt * 64, 0, 0);
}
DI void cvt_moe_item(const Frame& F, const Args& a, int layer, int item) {
    const int e = item / CVT_MOE_TILES_PER_EXP, t = item % CVT_MOE_TILES_PER_EXP;
    bf16_t* base = (bf16_t*)(a.ws + WS_MOE_W + (size_t)e * 3 * MiB);
    if (t < 256) cvt_tile<CV_MOE_GU>(F, a, base, DM, (t >> 4) * 64, (t & 15) * 64, layer, e);
    else { const int t2 = t - 256; cvt_tile<CV_MOE_D>(F, a, base + (size_t)DM * DM, DEXP, (t2 >> 3) * 64, (t2 & 7) * 64, layer, e); }
}
DI void mod_item(const Frame& F, const Args& a, int item) {
    LAS float* sc = (LAS float*)F.lds;
    for (int i = F.tid; i < NB * DM; i += NTHR) sc[i] = silu_f(a.c[i]);
    __syncthreads();
    const int l = item / 12, j = (item % 12) * 512 + F.tid;
    const float* w = a.ada_w + (size_t)l * DM * 6 * DM + j;
    float acc[NB] = {0.f, 0.f, 0.f, 0.f};
    for (int k = 0; k < DM; k += 4) {
        float wv[4];
#pragma unroll
        for (int u = 0; u < 4; ++u) wv[u] = w[(size_t)(k + u) * 6 * DM];
#pragma unroll
        for (int u = 0; u < 4; ++u)
#pragma unroll
            for (int b = 0; b < NB; ++b) acc[b] += sc[b * DM + k + u] * wv[u];
    }
    float* mod = (float*)(a.ws + WS_MOD);
    const float bias = a.ada_b[l * 6 * DM + j];
#pragma unroll
    for (int b = 0; b < NB; ++b) mod[((size_t)l * NB + b) * 6 * DM + j] = acc[b] + bias;
    __syncthreads();
}
DI void p0_prologue(const Frame& F, const Args& a) {
    const int n_items = 24 + CVT_DENSE_TILES + CVT_MOE_TILES;
    for (int it = F.bid; it < n_items; it += F.G) {
        if (it < 24) mod_item(F, a, it);
        else if (it < 24 + CVT_DENSE_TILES) cvt_dense_item(F, a, it - 24);
        else cvt_moe_item(F, a, 0, it - 24 - CVT_DENSE_TILES);
    }
}

constexpr int WR_LD = 1028;
DI void moe_seg_table(const Frame& F, const unsigned* cnt, LAS int* seg  ) {
    if (F.tid == 0) { int s = 0; for (int e = 0; e < NEXP; ++e) { seg[e] = s; s += (((int)cnt[e] + 255) >> 8) << 8; } seg[NEXP] = s; }
    __syncthreads();
}
template <bool COMBINE, bool ROUTE, bool FINAL>
DI void norm_phase(const Frame& F, const Args& a, const float* xsrc, int layer, int which, int layer_c) {
    const float* mod = (const float*)(a.ws + WS_MOD);
    bf16_t* hbuf = (bf16_t*)(a.ws + WS_H);
    unsigned* ctl = (unsigned*)(a.ws + WS_CTL);
    LAS float* wrT = (LAS float*)F.lds;
    LAS float* brs = (LAS float*)(F.lds + 36 * WR_LD * 4);
    LAS int* seg = (LAS int*)F.lds;
    if (ROUTE) {
        const float* wg = a.moe_wr_g + (size_t)layer * DM * 4;
        const float* we = a.moe_wr_e + (size_t)layer * DM * 32;
        for (int i = F.tid; i < DM * 4; i += NTHR) { const int k = i >> 2, j = i & 3; wrT[j * WR_LD + k] = wg[i]; }
        for (int i = F.tid; i < DM * 32; i += NTHR) { const int k = i >> 5, j = i & 31; wrT[(4 + j) * WR_LD + k] = we[i]; }
        if (F.tid < 4) brs[F.tid] = a.moe_br_g[layer * 4 + F.tid];
        else if (F.tid < 36) brs[F.tid] = a.moe_br_e[layer * 32 + F.tid - 4];
        __syncthreads();
    }
    if (COMBINE) moe_seg_table(F, ctl + CW_CNT + layer_c * NEXP, seg);
    const bf16_t* ymoe = (const bf16_t*)(a.ws + WS_YMOE);
    const int* tokslot = (const int*)(a.ws + WS_TOKSLOT);
    for (int tok = F.bid * NWAVE + F.wave; tok < NTOK; tok += F.G * NWAVE) {
        const int b = tok / SEQ;
        f32x4 xv[4];
#pragma unroll
        for (int c = 0; c < 4; ++c) xv[c] = *(const f32x4*)(xsrc + (size_t)tok * DM + c * 256 + F.lane * 4);
        if (COMBINE) {
            const int ts0 = tokslot[tok * 2], ts1 = tokslot[tok * 2 + 1];
            const size_t r0 = (size_t)(seg[ts0 >> 20] + (ts0 & 0xfffff)), r1 = (size_t)(seg[ts1 >> 20] + (ts1 & 0xfffff));
            const float* g2 = mod + ((size_t)layer_c * NB + b) * 6 * DM + 5 * DM;
#pragma unroll
            for (int c = 0; c < 4; ++c) {
                const int col = c * 256 + F.lane * 4;
                const u32x2 y0 = *(const u32x2*)(ymoe + r0 * DM + col), y1 = *(const u32x2*)(ymoe + r1 * DM + col);
                const f32x4 gv = *(const f32x4*)(g2 + col);
                xv[c][0] += gv[0] * (bf_lo(y0[0]) + bf_lo(y1[0])); xv[c][1] += gv[1] * (bf_hi(y0[0]) + bf_hi(y1[0]));
                xv[c][2] += gv[2] * (bf_lo(y0[1]) + bf_lo(y1[1])); xv[c][3] += gv[3] * (bf_hi(y0[1]) + bf_hi(y1[1]));
                if (!FINAL) *(f32x4*)(a.out + (size_t)tok * DM + col) = xv[c];
            }
        }
        float ss = 0.f;
#pragma unroll
        for (int c = 0; c < 4; ++c) ss += xv[c][0] * xv[c][0] + xv[c][1] * xv[c][1] + xv[c][2] * xv[c][2] + xv[c][3] * xv[c][3];
        ss = wave_sum(ss);
        const float rinv = rsqrtf(ss * (1.0f / DM) + EPS);
        if (FINAL) {
#pragma unroll
            for (int c = 0; c < 4; ++c) {
                const int col = c * 256 + F.lane * 4;
                const f32x4 g = *(const f32x4*)(a.final_norm_g + col);
                f32x4 o; o[0] = xv[c][0] * rinv * g[0]; o[1] = xv[c][1] * rinv * g[1]; o[2] = xv[c][2] * rinv * g[2]; o[3] = xv[c][3] * rinv * g[3];
                *(f32x4*)(a.out + (size_t)tok * DM + col) = o;
            }
            continue;
        }
        const float* ng = a.norm_g + ((size_t)layer * 2 + which) * DM;
        const float* sh = mod + ((size_t)layer * NB + b) * 6 * DM + (which ? 3 : 0) * DM;
        const float* sc = sh + DM;
        f32x4 hv[4];
#pragma unroll
        for (int c = 0; c < 4; ++c) {
            const int col = c * 256 + F.lane * 4;
            const f32x4 g = *(const f32x4*)(ng + col), s1 = *(const f32x4*)(sc + col), s0 = *(const f32x4*)(sh + col);
#pragma unroll
            for (int u = 0; u < 4; ++u) hv[c][u] = (xv[c][u] * rinv * g[u]) * (1.0f + s1[u]) + s0[u];
            u32x2 w; w[0] = pack_bf16(hv[c][0], hv[c][1]); w[1] = pack_bf16(hv[c][2], hv[c][3]);
            *(u32x2*)(hbuf + (size_t)tok * DM + col) = w;
        }
        if (ROUTE) {
            LAS float* lgs = (LAS float*)(F.lds + 36 * WR_LD * 4 + 256) + F.wave * 36;
#pragma unroll 1
            for (int jb = 0; jb < 36; jb += 4) {
                float pp[4];
#pragma unroll
                for (int u = 0; u < 4; ++u) {
                    float p = 0.f;
#pragma unroll
                    for (int c = 0; c < 4; ++c) {
                        const f32x4 w = *(const LAS f32x4*)(wrT + (jb + u) * WR_LD + c * 256 + F.lane * 4);
                        p += hv[c][0] * w[0] + hv[c][1] * w[1] + hv[c][2] * w[2] + hv[c][3] * w[3];
                    }
                    pp[u] = p;
                }
#pragma unroll
                for (int u = 0; u < 4; ++u) pp[u] = wave_sum(pp[u]);
                if (F.lane == 0) { *(LAS f32x4*)(lgs + jb) = (f32x4){pp[0], pp[1], pp[2], pp[3]}; }
            }
            float lg[36];
#pragma unroll
            for (int j = 0; j < 36; ++j) lg[j] = lgs[j] + brs[j];
            int g = 0; float gm = lg[0];
#pragma unroll
            for (int j = 1; j < 4; ++j) if (lg[j] > gm) { gm = lg[j]; g = j; }
            float den = 0.f;
#pragma unroll
            for (int j = 0; j < 4; ++j) den += __expf(lg[j] - gm);
            const float ptop = 1.0f / den;
            float fv[8];
#pragma unroll
            for (int i = 0; i < 8; ++i) fv[i] = (g == 0) ? lg[4 + i] : (g == 1) ? lg[12 + i] : (g == 2) ? lg[20 + i] : lg[28 + i];
            int i1 = 0; float v1 = fv[0];
#pragma unroll
            for (int i = 1; i < 8; ++i) if (fv[i] > v1) { v1 = fv[i]; i1 = i; }
            int i2 = -1; float v2 = -3.0e38f;
#pragma unroll
            for (int i = 0; i < 8; ++i) if (i != i1 && fv[i] > v2) { v2 = fv[i]; i2 = i; }
            const float e2 = __expf(v2 - v1), ga = ptop / (1.0f + e2), gb = ptop * e2 / (1.0f + e2);
            if (F.lane == 0) {
                unsigned* cnt = ctl + CW_CNT + layer * NEXP;
                int* list = (int*)(a.ws + WS_LIST); float* gatev = (float*)(a.ws + WS_GATEV); int* ts = (int*)(a.ws + WS_TOKSLOT);
                const int ea = g * 8 + i1, eb = g * 8 + i2;
                const unsigned pa = __hip_atomic_fetch_add(cnt + ea, 1u, __ATOMIC_RELAXED, __HIP_MEMORY_SCOPE_AGENT);
                const unsigned pb = __hip_atomic_fetch_add(cnt + eb, 1u, __ATOMIC_RELAXED, __HIP_MEMORY_SCOPE_AGENT);
                list[ea * NTOK + pa] = tok; gatev[ea * NTOK + pa] = ga; ts[tok * 2] = (ea << 20) | (int)pa;
                list[eb * NTOK + pb] = tok; gatev[eb * NTOK + pb] = gb; ts[tok * 2 + 1] = (eb << 20) | (int)pb;
            }
        }
    }
    __syncthreads();
}

constexpr int LDS_MISC = 131072 + 64;
constexpr int LDS_XB = 163840 - 16;
constexpr int LDS_BYTES = 163840;
using pg8::Unit;
struct DenseSched {
    int nM, nN, nwg, G, c; const char* Bt; size_t tstepB;
    DI void init(int M, int N, int K, int G_, int c_, const void* Bt_) { nM = M / 256; nN = N / 256; nwg = nM * nN; G = G_; c = c_; Bt = (const char*)Bt_; tstepB = (size_t)256 * K * 2; }
    DI bool next(int i, Unit& u) const {
        const long L = (long)i * G + c; if (L >= nwg) return false;
        int wgid = (int)L; { const int q = nwg / 8, r = nwg % 8, xcd = wgid % 8, off = wgid / 8; wgid = (xcd < r ? xcd * (q + 1) : r * (q + 1) + (xcd - r) * q) + off; }
        const int nig = 8 * nN, gid = wgid / nig, fm = gid * 8, gsz = (nM - fm) < 8 ? (nM - fm) : 8;
        u.pm = fm + ((wgid % nig) % gsz); u.pn = (wgid % nig) / gsz; u.e = 0; u.nrow = 256; return true;
    }
    DI int a_row(const Unit& u, int r) const { return u.pm * 256 + r; }
    DI const char* b_base(const Unit& u) const { return Bt + (size_t)u.pn * tstepB; }
};
template <bool UP>
struct MoeSched {
    const LAS int* ntp; const unsigned* cnt; const int* list; const char* W; int nU, G, c;
    DI bool next(int i, Unit& u) const {
        const long L = (long)i * G + c; if (L >= nU) return false;
        int wgid = (int)L; { const int q = nU / 8, r = nU % 8, xcd = wgid % 8, off = wgid / 8; wgid = (xcd < r ? xcd * (q + 1) : r * (q + 1) + (xcd - r) * q) + off; }
        const int tg = wgid >> 2; u.pn = wgid & 3; u.pm = tg;
        int e = 0;
        for (int k = 1; k < NEXP; ++k) e += (ntp[k] <= tg) ? 1 : 0;
        u.e = e; const int rem = (int)cnt[e] - (tg - ntp[e]) * 256; u.nrow = rem < 256 ? rem : 256; return true;
    }
    DI int a_row(const Unit& u, int r) const {
        if (UP) { const int p = (u.pm - ntp[u.e]) * 256 + r; return (r < u.nrow) ? list[u.e * NTOK + p] : 0; }
        return u.pm * 256 + r;
    }
    DI const char* b_base(const Unit& u) const {
        return W + (size_t)u.e * 3 * MiB + (UP ? (size_t)u.pn * 256 * DM * 2 : 2 * MiB + (size_t)u.pn * 256 * DEXP * 2);
    }
};
DI void moe_tile_table(const Frame& F, const unsigned* cnt, LAS int* ntp  ) {
    if (F.tid == 0) { int s = 0; for (int e = 0; e < NEXP; ++e) { ntp[e] = s; s += ((int)cnt[e] + 255) >> 8; } ntp[NEXP] = s; }
    __syncthreads();
}

#define EPI_ROWS_BEGIN const int row0 = u.pm * 256 + wr * 64 + fr; _Pragma("unroll") for (int ai = 0; ai < 2; ++ai) _Pragma("unroll") for (int m = 0; m < 4; ++m) { const int row = row0 + ai * 128 + m * 16;
#define EPI_ROWS_END }
DI u32x2 pack4(const f32x4& v) { u32x2 w; w[0] = pack_bf16(v[0], v[1]); w[1] = pack_bf16(v[2], v[3]); return w; }

struct EpiAbIn {
    bf16_t* Zc;
    DI void operator()(const f32x4 (&acc)[2][2][4][2], const Unit& u, int wr, int wc, int fr, int fq) const {
        EPI_ROWS_BEGIN
            bf16_t* rp = Zc + (size_t)row * ZC_N;
#pragma unroll
            for (int bj = 0; bj < 2; ++bj) {
                if (u.pn < 2) {
#pragma unroll
                    for (int n = 0; n < 2; ++n) *(u32x2*)(rp + u.pn * 256 + bj * 128 + wc * 32 + n * 16 + 4 * fq) = pack4(acc[ai][bj][m][n]);
                } else {
                    const int pnp = (u.pn - 2) & 3, j = 16 * (8 * pnp + 4 * bj + wc) + 4 * fq;
                    const f32x4 X = acc[ai][bj][m][0], Y = acc[ai][bj][m][1]; f32x4 v;
                    if (u.pn < 6) { v = X * Y; *(u32x2*)(rp + 512 + j) = pack4(v); }
                    else { v[0] = X[0] * sigmoid_f(Y[0]); v[1] = X[1] * sigmoid_f(Y[1]); v[2] = X[2] * sigmoid_f(Y[2]); v[3] = X[3] * sigmoid_f(Y[3]); *(u32x2*)(rp + 1024 + j) = pack4(v); }
                }
            }
        EPI_ROWS_END
    }
};
struct EpiResid {
    const float* xin; float* xout; const float* g1;
    DI void operator()(const f32x4 (&acc)[2][2][4][2], const Unit& u, int wr, int wc, int fr, int fq) const {
        const float* g = g1 + (size_t)((u.pm * 256) / SEQ) * 6 * DM;
        EPI_ROWS_BEGIN
#pragma unroll
            for (int bj = 0; bj < 2; ++bj)
#pragma unroll
                for (int n = 0; n < 2; ++n) {
                    const int col = u.pn * 256 + bj * 128 + wc * 32 + n * 16 + 4 * fq;
                    const f32x4 xo = *(const f32x4*)(xin + (size_t)row * DM + col), gv = *(const f32x4*)(g + col);
                    *(f32x4*)(xout + (size_t)row * DM + col) = xo + gv * acc[ai][bj][m][n];
                }
        EPI_ROWS_END
    }
};
struct EpiPlain {
    bf16_t* O; int ld;
    DI void operator()(const f32x4 (&acc)[2][2][4][2], const Unit& u, int wr, int wc, int fr, int fq) const {
        EPI_ROWS_BEGIN
#pragma unroll
            for (int bj = 0; bj < 2; ++bj)
#pragma unroll
                for (int n = 0; n < 2; ++n) *(u32x2*)(O + (size_t)row * ld + u.pn * 256 + bj * 128 + wc * 32 + n * 16 + 4 * fq) = pack4(acc[ai][bj][m][n]);
        EPI_ROWS_END
    }
};
struct EpiMoeUp {
    bf16_t* act;
    DI void operator()(const f32x4 (&acc)[2][2][4][2], const Unit& u, int wr, int wc, int fr, int fq) const {
        EPI_ROWS_BEGIN
#pragma unroll
            for (int bj = 0; bj < 2; ++bj) {
                const int j = 16 * (8 * u.pn + 4 * bj + wc) + 4 * fq;
                const f32x4 X = acc[ai][bj][m][0], Y = acc[ai][bj][m][1]; f32x4 v;
                v[0] = silu_f(X[0]) * Y[0]; v[1] = silu_f(X[1]) * Y[1]; v[2] = silu_f(X[2]) * Y[2]; v[3] = silu_f(X[3]) * Y[3];
                *(u32x2*)(act + (size_t)row * DEXP + j) = pack4(v);
            }
        EPI_ROWS_END
    }
};
struct EpiMoeDown {
    bf16_t* y; const float* gatev; const LAS int* ntp;
    DI void operator()(const f32x4 (&acc)[2][2][4][2], const Unit& u, int wr, int wc, int fr, int fq) const {
        const int pbase = (u.pm - ntp[u.e]) * 256;
        EPI_ROWS_BEGIN
            const int r = row - u.pm * 256;
            const float gt = (r < u.nrow) ? gatev[u.e * NTOK + pbase + r] : 0.f;
#pragma unroll
            for (int bj = 0; bj < 2; ++bj)
#pragma unroll
                for (int n = 0; n < 2; ++n) *(u32x2*)(y + (size_t)row * DM + u.pn * 256 + bj * 128 + wc * 32 + n * 16 + 4 * fq) = pack4(acc[ai][bj][m][n] * gt);
        EPI_ROWS_END
    }
};

DI void conv_phase(const Frame& F, const Args& a) {
    const bf16_t* Zc = (const bf16_t*)(a.ws + WS_BIG);
    bf16_t* Y = (bf16_t*)(a.ws + WS_Y);
    LAS unsigned* PB = (LAS unsigned*)F.lds;
    LAS f32x2* ST = (LAS f32x2*)(F.lds + 94 * 1024);
    const int cp = F.tid & 255, th = F.tid >> 8, wq = F.wave & 3;
    float wb[31][2], wa[3][2];
#pragma unroll
    for (int k = 0; k < 31; ++k) { const f32x2 w = *(const f32x2*)(a.ab_conv_b + k * 512 + 2 * cp); wb[k][0] = w[0]; wb[k][1] = w[1]; }
#pragma unroll
    for (int k = 0; k < 3; ++k) { const f32x2 w = *(const f32x2*)(a.ab_conv_a + k * 512 + 2 * cp); wa[k][0] = w[0]; wa[k][1] = w[1]; }
    const f32x2 cbias = *(const f32x2*)(a.ab_conv_b_bias + 2 * cp), lng = *(const f32x2*)(a.ab_ln_g + 2 * cp), lnb = *(const f32x2*)(a.ab_ln_b + 2 * cp);
    for (int tile = F.bid; tile < NTOK / 64; tile += F.G) {
        const int t0 = tile * 64, b = t0 / SEQ, tl0 = t0 % SEQ;
        for (int i = F.tid; i < 94 * 64; i += NTHR) {
            const int r = i >> 6, c8 = i & 63, pos = tl0 - 30 + r;
            u32x4 v = {0u, 0u, 0u, 0u};
            if (pos >= 0) v = *(const u32x4*)(Zc + (size_t)(b * SEQ + pos) * ZC_N + 1024 + c8 * 8);
            *(LAS u32x4*)(PB + r * 256 + c8 * 4) = v;
        }
        __syncthreads();
#pragma unroll 1
        for (int g = 0; g < 4; ++g) {
            float U[8][2];
#pragma unroll
            for (int i = 0; i < 8; ++i) { U[i][0] = cbias[0]; U[i][1] = cbias[1]; }
#pragma unroll
            for (int r = 0; r < 38; ++r) {
                const unsigned xw = PB[(32 * th + 8 * g + r) * 256 + cp];
                const float x0 = bf_lo(xw), x1 = bf_hi(xw);
#pragma unroll
                for (int i = 0; i < 8; ++i) { const int k = r - i; if (k >= 0 && k <= 30) { U[i][0] += wb[k][0] * x0; U[i][1] += wb[k][1] * x1; } }
            }
#pragma unroll
            for (int i = 0; i < 8; ++i) {
                const float s1 = wave_sum(U[i][0] + U[i][1]), s2 = wave_sum(U[i][0] * U[i][0] + U[i][1] * U[i][1]);
                if (F.lane == 0) ST[(32 * th + 8 * g + i) * 4 + wq] = (f32x2){s1, s2};
            }
            __syncthreads();
#pragma unroll
            for (int i = 0; i < 8; ++i) {
                const int tl = 32 * th + 8 * g + i; const size_t tok = (size_t)t0 + tl; const int pos = tl0 + tl;
                const f32x2 p0 = ST[tl * 4 + 0], p1 = ST[tl * 4 + 1], p2 = ST[tl * 4 + 2], p3 = ST[tl * 4 + 3];
                const float mean = ((p0[0] + p1[0]) + (p2[0] + p3[0])) * (1.0f / 512.0f);
                const float var = ((p0[1] + p1[1]) + (p2[1] + p3[1])) * (1.0f / 512.0f) - mean * mean;
                const float rstd = rsqrtf(var + EPS);
                const float yb0 = silu_f((U[i][0] - mean) * rstd * lng[0] + lnb[0]), yb1 = silu_f((U[i][1] - mean) * rstd * lng[1] + lnb[1]);
                *(unsigned*)(Y + tok * DM + 512 + 2 * cp) = pack_bf16(yb0, yb1);
                float a0 = 0.f, a1 = 0.f;
#pragma unroll
                for (int k = 0; k < 3; ++k) {
                    const int pp = pos - 2 + k;
                    if (pp >= 0) { const unsigned w = *(const unsigned*)(Zc + (size_t)(b * SEQ + pp) * ZC_N + 512 + 2 * cp); a0 += wa[k][0] * bf_lo(w); a1 += wa[k][1] * bf_hi(w); }
                }
                const unsigned gw = *(const unsigned*)(Zc + tok * ZC_N + 2 * cp);
                *(unsigned*)(Y + tok * DM + 2 * cp) = pack_bf16(bf_lo(gw) * a0, bf_hi(gw) * a1);
            }
        }
        __syncthreads();
    }
}

#define MFMA32(a, b, c) __builtin_amdgcn_mfma_f32_32x32x16_bf16((a), (b), (c), 0, 0, 0)
constexpr int TK_HIST = 0;
constexpr int TK_TAB = 65536;
constexpr int TK_CAND = 65536 + 512;
constexpr int TK_CCNT = TK_CAND + 4096;
constexpr int TK_BQ = 73728;
DI int crow_c(int r) { return (r & 3) + 8 * (r >> 2); }
template <int PASS>
DI void topk_pass(const Frame& F, const bf16_t* Z, unsigned* maskg, int b, int t0, const float (&wp)[8]) {
    const LAS unsigned char* bq = F.lds + TK_BQ;
    LAS unsigned* hist = (LAS unsigned*)(F.lds + TK_HIST);
    LAS int* tab = (LAS int*)(F.lds + TK_TAB);
    LAS int* cand = (LAS int*)(F.lds + TK_CAND);
    LAS int* ccnt = (LAS int*)(F.lds + TK_CCNT);
    const int q = F.lane & 31, h2 = F.lane >> 5, ntile = t0 / 32 + 1;
    const int myT = (PASS >= 2) ? tab[q * 4 + 0] : 0;
    const bf16_t* kbase = Z + (size_t)b * SEQ * CD_N + Z_KI + 8 * h2;
    for (int kt = F.wave; kt < ntile; kt += NWAVE) {
        const bf16_t* kp = kbase + (size_t)(32 * kt + q) * CD_N;
        const bf16x8 A0l = *(const bf16x8*)kp, A1l = *(const bf16x8*)(kp + 16);
        const bf16x8 A0 = A0l, A1 = A1l;
        f32x16 sc;
#pragma unroll
        for (int r = 0; r < 16; ++r) sc[r] = 0.f;
        sc = MFMA32(A0, *(const LAS bf16x8*)(bq + (16 * 64 + F.lane) * 16), sc); sc = MFMA32(A1, *(const LAS bf16x8*)(bq + (17 * 64 + F.lane) * 16), sc);
#pragma unroll
        for (int r = 0; r < 16; ++r) sc[r] += 131072.0f;
#pragma unroll
        for (int h = 0; h < 8; ++h) {
            f32x16 ac;
#pragma unroll
            for (int r = 0; r < 16; ++r) ac[r] = 0.f;
            ac = MFMA32(A0, *(const LAS bf16x8*)(bq + ((2 * h) * 64 + F.lane) * 16), ac); ac = MFMA32(A1, *(const LAS bf16x8*)(bq + ((2 * h + 1) * 64 + F.lane) * 16), ac);
#pragma unroll
            for (int r = 0; r < 16; ++r) sc[r] += __builtin_fabsf(ac[r]) * wp[h];
        }
        const bool diag = (kt == ntile - 1);
        unsigned bits = 0u;
#pragma unroll
        for (int r = 0; r < 16; ++r) {
            int key = (int)sc[r]; key = key < 0 ? 0 : (key > 262143 ? 262143 : key);
            const bool valid = !diag || (crow_c(r) + 4 * h2 <= q);
            if (PASS == 1) { if (valid) __hip_atomic_fetch_add(&hist[q * 512 + (key >> 9)], 1u, __ATOMIC_RELAXED, __HIP_MEMORY_SCOPE_WORKGROUP); }
            else if (PASS == 2) { if (valid && (key >> 9) == myT) __hip_atomic_fetch_add(&hist[q * 512 + (key & 511)], 1u, __ATOMIC_RELAXED, __HIP_MEMORY_SCOPE_WORKGROUP); }
            else {
                if (valid && key > myT) bits |= 1u << crow_c(r);
                if (valid && key == myT) { const int p = __hip_atomic_fetch_add(&ccnt[q], 1, __ATOMIC_RELAXED, __HIP_MEMORY_SCOPE_WORKGROUP); if (p < 32) cand[q * 32 + p] = 32 * kt + crow_c(r) + 4 * h2; }
            }
        }
        if (PASS == 3) {
            bits <<= 4 * h2;
            bits |= (unsigned)__shfl_xor((int)bits, 32);
            if (h2 == 0) maskg[(size_t)(b * SEQ + t0 + q) * 256 + kt] = bits;
        }
    }
}
DI void topk_scan(const Frame& F, int pass, int t0) {
    LAS unsigned* hist = (LAS unsigned*)(F.lds + TK_HIST);
    LAS int* tab = (LAS int*)(F.lds + TK_TAB);
    for (int qi = 0; qi < 4; ++qi) {
        const int q = F.wave * 4 + qi, n = t0 + q + 1;
        int need = 256, prevT = 0, prevAbove = 0;
        if (pass == 2) { prevT = tab[q * 4 + 0]; prevAbove = tab[q * 4 + 1]; need = 256 - prevAbove; }
        if (n <= 256) { if (F.lane == 0) { tab[q * 4 + 0] = -1; tab[q * 4 + 1] = 0; tab[q * 4 + 2] = 0; } continue; }
        unsigned hv[8]; unsigned s = 0;
#pragma unroll
        for (int i = 0; i < 8; ++i) { hv[i] = hist[q * 512 + 511 - (8 * F.lane + i)]; s += hv[i]; }
        unsigned inc = s;
#pragma unroll
        for (int o = 1; o < 64; o <<= 1) { const unsigned v = (unsigned)__shfl_up((int)inc, o); if (F.lane >= o) inc += v; }
        const unsigned pre = inc - s;
        if ((int)pre < need && (int)inc >= need) {
            unsigned cum = pre; int bsel = 0; unsigned above = 0; bool found = false;
#pragma unroll
            for (int i = 0; i < 8; ++i) { if (!found && (int)(cum + hv[i]) >= need) { found = true; bsel = 511 - (8 * F.lane + i); above = cum; } cum += hv[i]; }
            if (pass == 1) { tab[q * 4 + 0] = bsel; tab[q * 4 + 1] = (int)above; }
            else { tab[q * 4 + 0] = (prevT << 9) | bsel; tab[q * 4 + 1] = prevAbove + (int)above; tab[q * 4 + 2] = 256 - (prevAbove + (int)above); }
        }
    }
}
DI void topk_phase(const Frame& F, const Args& a) {
    const bf16_t* Z = (const bf16_t*)(a.ws + WS_BIG);
    unsigned* maskg = (unsigned*)(a.ws + WS_MASK);
    LAS unsigned* hist = (LAS unsigned*)(F.lds + TK_HIST);
    LAS int* tab = (LAS int*)(F.lds + TK_TAB);
    LAS int* cand = (LAS int*)(F.lds + TK_CAND);
    LAS int* ccnt = (LAS int*)(F.lds + TK_CCNT);
    const int q = F.lane & 31, h2 = F.lane >> 5;
    for (int pi = F.bid; pi < 512; pi += F.G) {
        const int b = pi >> 7, p = pi & 127;
        for (int half = 0; half < 2; ++half) {
            const int t0 = 32 * (half ? 255 - p : p);
            const bf16_t* zr = Z + (size_t)(b * SEQ + t0 + q) * CD_N;
            float wp[8];
            { const u32x4 wv = *(const u32x4*)(zr + Z_WI);
              const float sc = 0.0625f * 0.5f * 16384.0f;
              wp[0] = bf_lo(wv[0]) * sc; wp[1] = bf_hi(wv[0]) * sc; wp[2] = bf_lo(wv[1]) * sc; wp[3] = bf_hi(wv[1]) * sc;
              wp[4] = bf_lo(wv[2]) * sc; wp[5] = bf_hi(wv[2]) * sc; wp[6] = bf_lo(wv[3]) * sc; wp[7] = bf_hi(wv[3]) * sc; }
            __syncthreads();
            if (F.wave == 0) {
                LAS unsigned char* bqw = F.lds + TK_BQ;
                float lin[2][8];
#pragma unroll
                for (int ks = 0; ks < 2; ++ks)
#pragma unroll
                    for (int j = 0; j < 8; ++j) lin[ks][j] = 0.f;
#pragma unroll
                for (int h = 0; h < 8; ++h)
#pragma unroll
                    for (int ks = 0; ks < 2; ++ks) {
                        const u32x4 v = *(const u32x4*)(zr + Z_QI + 32 * h + 16 * ks + 8 * h2);
                        *(LAS u32x4*)(bqw + ((2 * h + ks) * 64 + F.lane) * 16) = v;
#pragma unroll
                        for (int j = 0; j < 4; ++j) { lin[ks][2 * j] += wp[h] * bf_lo(v[j]); lin[ks][2 * j + 1] += wp[h] * bf_hi(v[j]); }
                    }
#pragma unroll
                for (int ks = 0; ks < 2; ++ks) {
                    u32x4 v; v[0] = pack_bf16(lin[ks][0], lin[ks][1]); v[1] = pack_bf16(lin[ks][2], lin[ks][3]); v[2] = pack_bf16(lin[ks][4], lin[ks][5]); v[3] = pack_bf16(lin[ks][6], lin[ks][7]);
                    *(LAS u32x4*)(bqw + ((16 + ks) * 64 + F.lane) * 16) = v;
                }
            }
            for (int i = F.tid; i < 32 * 512; i += NTHR) hist[i] = 0u;
            if (F.tid < 32) ccnt[F.tid] = 0;
            __syncthreads();
            topk_pass<1>(F, Z, maskg, b, t0, wp);
            __syncthreads();
            topk_scan(F, 1, t0);
            __syncthreads();
            for (int i = F.tid; i < 32 * 512; i += NTHR) hist[i] = 0u;
            __syncthreads();
            topk_pass<2>(F, Z, maskg, b, t0, wp);
            __syncthreads();
            topk_scan(F, 2, t0);
            __syncthreads();
            topk_pass<3>(F, Z, maskg, b, t0, wp);
            __threadfence();
            __syncthreads();
            if (F.tid < 32) {
                const int qq = F.tid, need = tab[qq * 4 + 2]; int nc = ccnt[qq]; nc = nc > 32 ? 32 : nc;
                if (tab[qq * 4 + 0] >= 0) {
                    int last = -1;
                    for (int k = 0; k < need && k < nc; ++k) {
                        int best = 0x7fffffff;
                        for (int i = 0; i < nc; ++i) { const int v = cand[qq * 32 + i]; if (v > last && v < best) best = v; }
                        if (best == 0x7fffffff) break;
                        atomicOr(&maskg[(size_t)(b * SEQ + t0 + qq) * 256 + (best >> 5)], 1u << (best & 31));
                        last = best;
                    }
                }
            }
            __syncthreads();
        }
    }
}

constexpr int AT_KSTR = 72;
constexpr int AT_VSTR = 68;
constexpr int AT_KBYTES = 64 * AT_KSTR * 2;
constexpr int AT_VBYTES = 128 * AT_VSTR * 2;
constexpr int AT_BUF = AT_KBYTES + AT_VBYTES;
constexpr int AT_LUT = 2 * AT_BUF;
constexpr int AT_LUT_LD = 132;
constexpr float NEG_INF = -__builtin_huge_valf();

template <int DV, bool MASKED>
DI void attn_core(const Frame& F, const bf16_t* Z, int b, int qcol, int kcol, int vcol, int q0, const LAS float* lut, float c1, const unsigned* maskg, f32x16 (&O)[DV / 32]) {
    constexpr int NDV = DV / 32;
    const int q = F.lane & 31, h2 = F.lane >> 5;
    const int tw0 = q0 + 32 * F.wave, t = tw0 + q;
    const bf16_t* Zb = Z + (size_t)b * SEQ * CD_N;
    bf16x8 Qf[4];
#pragma unroll
    for (int ks = 0; ks < 4; ++ks) Qf[ks] = *(const bf16x8*)(Zb + (size_t)t * CD_N + qcol + 16 * ks + 8 * h2);
#pragma unroll
    for (int d = 0; d < NDV; ++d)
#pragma unroll
        for (int r = 0; r < 16; ++r) O[d][r] = 0.f;
    float m_run = NEG_INF, l_run = 0.f;
    const int jmax = (q0 + 255) >> 6;
    const int kkey = F.tid >> 3, kch = F.tid & 7;
    u32x4 kreg, vreg[DV / 64];
#define AT_LOAD(j) do { kreg = *(const u32x4*)(Zb + (size_t)(64 * (j) + kkey) * CD_N + kcol + 8 * kch); \
        _Pragma("unroll") for (int _i = 0; _i < DV / 64; ++_i) { const int idx = F.tid + NTHR * _i; vreg[_i] = *(const u32x4*)(Zb + (size_t)(64 * (j) + (idx & 63)) * CD_N + vcol + 8 * (idx >> 6)); } } while (0)
#define AT_STORE(buf) do { LAS unsigned char* kb_ = F.lds + (buf) * AT_BUF; *(LAS u32x4*)(kb_ + kkey * (AT_KSTR * 2) + kch * 16) = kreg; \
        LAS bf16_t* vt_ = (LAS bf16_t*)(kb_ + AT_KBYTES); \
        _Pragma("unroll") for (int _i = 0; _i < DV / 64; ++_i) { const int idx = F.tid + NTHR * _i, key_ = idx & 63, ch_ = idx >> 6; \
            _Pragma("unroll") for (int e_ = 0; e_ < 4; ++e_) { vt_[(8 * ch_ + 2 * e_) * AT_VSTR + key_] = (bf16_t)(vreg[_i][e_] & 0xffffu); vt_[(8 * ch_ + 2 * e_ + 1) * AT_VSTR + key_] = (bf16_t)(vreg[_i][e_] >> 16); } } } while (0)
    AT_LOAD(0); AT_STORE(0);
    __syncthreads();
    for (int j = 0; j <= jmax; ++j) {
        if (j < jmax) AT_LOAD(j + 1);
        if (64 * j <= tw0 + 31) {
            const LAS unsigned char* kb = F.lds + (j & 1) * AT_BUF;
            const LAS unsigned char* vt = kb + AT_KBYTES;
            f32x16 s[2];
#pragma unroll
            for (int kb2 = 0; kb2 < 2; ++kb2) {
#pragma unroll
                for (int r = 0; r < 16; ++r) s[kb2][r] = 0.f;
#pragma unroll
                for (int ks = 0; ks < 4; ++ks) {
                    const bf16x8 A = *(const LAS bf16x8*)(kb + (32 * kb2 + q) * (AT_KSTR * 2) + (16 * ks + 8 * h2) * 2);
                    s[kb2] = MFMA32(A, Qf[ks], s[kb2]);
                }
            }
            const bool nearb = (64 * j + 63 + 128 > tw0);
            float mloc = NEG_INF;
            if (!nearb) {
                const float c0 = lut[128];
#pragma unroll
                for (int kb2 = 0; kb2 < 2; ++kb2)
#pragma unroll
                    for (int r = 0; r < 16; ++r) { s[kb2][r] = s[kb2][r] * c1 + c0; mloc = fmaxf(mloc, s[kb2][r]); }
            } else {
#pragma unroll
                for (int kb2 = 0; kb2 < 2; ++kb2)
#pragma unroll
                    for (int r = 0; r < 16; ++r) {
                        const int dist = t - (64 * j + 32 * kb2 + crow_c(r) + 4 * h2);
                        const float bl = lut[dist < 0 ? 0 : (dist > 128 ? 128 : dist)];
                        s[kb2][r] = dist < 0 ? NEG_INF : s[kb2][r] * c1 + bl; mloc = fmaxf(mloc, s[kb2][r]);
                    }
            }
            mloc = fmaxf(mloc, __shfl_xor(mloc, 32));
            const float m_new = fmaxf(m_run, mloc);
            const float alpha = __builtin_amdgcn_exp2f(m_run - m_new);
            m_run = m_new;
            float psum = 0.f;
#pragma unroll
            for (int kb2 = 0; kb2 < 2; ++kb2) {
                unsigned mw = 0u;
                if (MASKED) mw = maskg[(size_t)(b * SEQ + t) * 256 + 2 * j + kb2] >> (4 * h2);
#pragma unroll
                for (int r = 0; r < 16; ++r) {
                    float p = __builtin_amdgcn_exp2f(s[kb2][r] - m_new);
                    if (MASKED) p = ((mw >> crow_c(r)) & 1u) ? p : 0.f;
                    s[kb2][r] = p; psum += p;
                }
            }
            l_run = l_run * alpha + psum;
#pragma unroll
            for (int d = 0; d < NDV; ++d)
#pragma unroll
                for (int r = 0; r < 16; ++r) O[d][r] *= alpha;
#pragma unroll
            for (int kb2 = 0; kb2 < 2; ++kb2)
#pragma unroll
                for (int s2 = 0; s2 < 2; ++s2) {
                    u32x4 pw;
#pragma unroll
                    for (int e = 0; e < 4; ++e) pw[e] = pack_bf16(s[kb2][8 * s2 + 2 * e], s[kb2][8 * s2 + 2 * e + 1]);
                    const bf16x8 Pf = __builtin_bit_cast(bf16x8, pw);
#pragma unroll
                    for (int d = 0; d < NDV; ++d) {
                        const LAS unsigned char* vp = vt + (32 * d + q) * (AT_VSTR * 2) + (32 * kb2 + 16 * s2 + 4 * h2) * 2;
                        const u32x2 lo = *(const LAS u32x2*)vp, hi = *(const LAS u32x2*)(vp + 16);
                        u32x4 av; av[0] = lo[0]; av[1] = lo[1]; av[2] = hi[0]; av[3] = hi[1];
                        O[d] = MFMA32(__builtin_bit_cast(bf16x8, av), Pf, O[d]);
                    }
                }
        }
        if (j < jmax) AT_STORE((j + 1) & 1);
        __syncthreads();
    }
#undef AT_LOAD
#undef AT_STORE
    const float lt = l_run + __shfl_xor(l_run, 32);
    const float inv = 1.0f / lt;
#pragma unroll
    for (int d = 0; d < NDV; ++d)
#pragma unroll
        for (int r = 0; r < 16; ++r) O[d][r] *= inv;
}

DI float rel_bucket_bias(const float* rel_bias, int d, int head) {
    int bkt;
    if (d < 16) bkt = d;
    else { const float lr = __logf((float)d * (1.0f / 16.0f)) / 2.0794415416798357f; int l = 16 + (int)(lr * 16.0f); bkt = l < 31 ? l : 31; }
    return rel_bias[bkt * 12 + head];
}
DI void attn_phase(const Frame& F, const Args& a) {
    const bf16_t* Z = (const bf16_t*)(a.ws + WS_BIG);
    bf16_t* Yo = (bf16_t*)(a.ws + WS_Y);
    float* O1s = (float*)(a.ws + WS_H);
    const unsigned* maskg = (const unsigned*)(a.ws + WS_MASK);
    LAS float* lut = (LAS float*)(F.lds + AT_LUT);
    for (int i = F.tid; i < 12 * 129; i += NTHR) { const int hh = i / 129, d = i % 129; lut[hh * AT_LUT_LD + d] = rel_bucket_bias(a.rel_bias, d, hh) * LOG2E; }
    float lam;
    { float d01 = 0.f, d23 = 0.f; for (int i = 0; i < 64; ++i) { d01 += a.diff_lam[i] * a.diff_lam[64 + i]; d23 += a.diff_lam[128 + i] * a.diff_lam[192 + i]; }
      lam = __expf(d01) - __expf(d23) + 0.35550906759096f; }
    const float one_m_li = 1.0f - 0.35550906759096f;
    __syncthreads();
    const float c1 = 0.125f * LOG2E;
    const int q = F.lane & 31, h2 = F.lane >> 5;
    const int xcd = F.bid & 7, kk = F.bid >> 3;
    for (int it = F.bid; it < 256; it += F.G) {
        const int bh = (F.G == 256) ? 2 * xcd + (kk >> 4) : it >> 4, pr = (F.G == 256) ? (kk & 15) : (it & 15);
        const int b = bh >> 2, hd = bh & 3;
        for (int half = 0; half < 2; ++half) {
            const int q0 = 256 * (half ? 31 - pr : pr), t = q0 + 32 * F.wave + q;
            f32x16 O[4];
            attn_core<128, false>(F, Z, b, Z_QD + 128 * hd, Z_KD + 128 * hd, Z_VD + 128 * hd, q0, lut + (8 + hd) * AT_LUT_LD, c1, nullptr, O);
            float* o1p = O1s + (size_t)(b * SEQ + t) * 512 + 128 * hd;
#pragma unroll
            for (int d = 0; d < 4; ++d)
#pragma unroll
                for (int g = 0; g < 4; ++g) *(f32x4*)(o1p + 32 * d + 8 * g + 4 * h2) = (f32x4){O[d][4 * g], O[d][4 * g + 1], O[d][4 * g + 2], O[d][4 * g + 3]};
            attn_core<128, false>(F, Z, b, Z_QD + 128 * hd + 64, Z_KD + 128 * hd + 64, Z_VD + 128 * hd, q0, lut + (8 + hd) * AT_LUT_LD, c1, nullptr, O);
            float ss = 0.f;
#pragma unroll
            for (int d = 0; d < 4; ++d)
#pragma unroll
                for (int g = 0; g < 4; ++g) {
                    const f32x4 o1 = *(const f32x4*)(o1p + 32 * d + 8 * g + 4 * h2);
#pragma unroll
                    for (int e = 0; e < 4; ++e) { const float v = o1[e] - lam * O[d][4 * g + e]; O[d][4 * g + e] = v; ss += v * v; }
                }
            ss += __shfl_xor(ss, 32);
            const float rinv = rsqrtf(ss * (1.0f / 128.0f) + EPS) * one_m_li;
            bf16_t* yp = Yo + (size_t)(b * SEQ + t) * DM + 512 + 128 * hd;
#pragma unroll
            for (int d = 0; d < 4; ++d)
#pragma unroll
                for (int g = 0; g < 4; ++g) {
                    const int dv = 32 * d + 8 * g + 4 * h2;
                    const f32x4 gn = *(const f32x4*)(a.diff_norm_g + dv);
                    f32x4 v; v[0] = O[d][4 * g] * rinv * gn[0]; v[1] = O[d][4 * g + 1] * rinv * gn[1]; v[2] = O[d][4 * g + 2] * rinv * gn[2]; v[3] = O[d][4 * g + 3] * rinv * gn[3];
                    *(u32x2*)(yp + dv) = pack4(v);
                }
        }
    }
    for (int it = F.bid; it < 512; it += F.G) {
        const int rnd = it / F.G;
        const int bh = (F.G == 256) ? 4 * xcd + 2 * rnd + (kk >> 4) : it >> 4, pr = (F.G == 256) ? (kk & 15) : (it & 15);
        const int b = bh >> 3, hc = bh & 7;
        for (int half = 0; half < 2; ++half) {
            const int q0 = 256 * (half ? 31 - pr : pr), t = q0 + 32 * F.wave + q;
            f32x16 O[2];
            attn_core<64, true>(F, Z, b, Z_QC + 64 * hc, Z_KC + 64 * hc, Z_VC + 64 * hc, q0, lut + hc * AT_LUT_LD, c1, maskg, O);
            bf16_t* yp = Yo + (size_t)(b * SEQ + t) * DM + 64 * hc;
#pragma unroll
            for (int d = 0; d < 2; ++d)
#pragma unroll
                for (int g = 0; g < 4; ++g) {
                    f32x4 v = {O[d][4 * g], O[d][4 * g + 1], O[d][4 * g + 2], O[d][4 * g + 3]};
                    *(u32x2*)(yp + 32 * d + 8 * g + 4 * h2) = pack4(v);
                }
        }
    }
}

#ifndef MK_ONE_LAUNCH
#define MK_ONE_LAUNCH 1
#endif
constexpr int NPH = 17;
__global__ void __launch_bounds__(NTHR, 2) fwd_kernel(Args a) {
    extern __shared__ __attribute__((aligned(16))) unsigned char lds_raw[];
    Frame F; F.lds = (LAS unsigned char*)lds_raw; F.tid = threadIdx.x; F.lane = F.tid & 63; F.wave = __builtin_amdgcn_readfirstlane(F.tid >> 6); F.G = gridDim.x; F.bid = blockIdx.x;
    unsigned* ctl = (unsigned*)(a.ws + WS_CTL);
    volatile LAS unsigned* xbw = (volatile LAS unsigned*)(F.lds + LDS_XB);
    if (F.tid < 4) xbw[F.tid] = 0u;
    __syncthreads();
    const int lo = a.ph_lo, hi = a.ph_hi;
    XcdBarrier bar; bar.bar = ctl + CW_BAR; bar.x = 0; bar.st = xbw;
    if (hi - lo > 1) bar = xcd_barrier_post(ctl + CW_BAR, xbw);
#ifndef PH_ONLY
#define IN(k) (lo <= (k) && (k) < hi)
#else
#define IN(k) ((k) == PH_ONLY && lo <= (k) && (k) < hi)
#endif
#define SEAM(k) do { if (IN(k) && IN((k) + 1)) xcd_barrier(bar); } while (0)
    float* mod = (float*)(a.ws + WS_MOD);
    bf16_t* hbuf = (bf16_t*)(a.ws + WS_H);
    bf16_t* ybuf = (bf16_t*)(a.ws + WS_Y);
    LAS int* ntp = (LAS int*)(F.lds + LDS_MISC);

    if (IN(0)) { p0_prologue(F, a); } SEAM(0);
    if (IN(1)) { norm_phase<false, false, false>(F, a, a.x, 0, 0, 0); } SEAM(1);
    if (IN(2)) {
        DenseSched S; S.init(NTOK, AB_N, DM, F.G, F.bid, a.ws + WS_WAB_IN);
        EpiAbIn E{(bf16_t*)(a.ws + WS_BIG)};
        pg8::gemm_phase(F.lds, (const char*)hbuf, DM, S, E);
    } SEAM(2);
    if (IN(3)) { conv_phase(F, a); } SEAM(3);
    if (IN(4)) {
        DenseSched S; S.init(NTOK, DM, DM, F.G, F.bid, a.ws + WS_WAB_OUT);
        EpiResid E{a.x, a.out, mod + 2 * DM};
        pg8::gemm_phase(F.lds, (const char*)ybuf, DM, S, E);
    } SEAM(4);
#define MOE_PHASES(layer, pb) do { \
        const unsigned* cnt = ctl + CW_CNT + (layer) * NEXP; \
        if (IN(pb)) { norm_phase<false, true, false>(F, a, a.out, (layer), 1, 0); } SEAM(pb); \
        if (IN((pb) + 1)) { \
            moe_tile_table(F, cnt, ntp); \
            MoeSched<true> S; S.ntp = ntp; S.cnt = cnt; S.list = (const int*)(a.ws + WS_LIST); S.W = (const char*)(a.ws + WS_MOE_W); S.nU = 4 * ntp[NEXP]; S.G = F.G; S.c = F.bid; \
            EpiMoeUp E{(bf16_t*)(a.ws + WS_ACT)}; \
            pg8::gemm_phase(F.lds, (const char*)hbuf, DM, S, E); \
        } SEAM((pb) + 1); \
        if (IN((pb) + 2)) { \
            moe_tile_table(F, cnt, ntp); \
            MoeSched<false> S; S.ntp = ntp; S.cnt = cnt; S.list = nullptr; S.W = (const char*)(a.ws + WS_MOE_W); S.nU = 4 * ntp[NEXP]; S.G = F.G; S.c = F.bid; \
            EpiMoeDown E{(bf16_t*)(a.ws + WS_YMOE), (const float*)(a.ws + WS_GATEV), ntp}; \
            pg8::gemm_phase(F.lds, (const char*)(a.ws + WS_ACT), DEXP, S, E); \
        } SEAM((pb) + 2); } while (0)
    MOE_PHASES(0, 5);
    if (IN(8)) {
        norm_phase<true, false, false>(F, a, a.out, 1, 0, 0);
        for (int it = F.bid; it < CVT_MOE_TILES; it += F.G) cvt_moe_item(F, a, 1, it);
    } SEAM(8);
    if (IN(9)) {
        DenseSched S; S.init(NTOK, CD_N, DM, F.G, F.bid, a.ws + WS_WCD_IN);
        EpiPlain E{(bf16_t*)(a.ws + WS_BIG), CD_N};
        pg8::gemm_phase(F.lds, (const char*)hbuf, DM, S, E);
    } SEAM(9);
    if (IN(10)) { topk_phase(F, a); } SEAM(10);
    if (IN(11)) { attn_phase(F, a); } SEAM(11);
    if (IN(12)) {
        DenseSched S; S.init(NTOK, DM, DM, F.G, F.bid, a.ws + WS_WCD_OUT);
        EpiResid E{a.out, a.out, mod + (size_t)NB * 6 * DM + 2 * DM};
        pg8::gemm_phase(F.lds, (const char*)ybuf, DM, S, E);
    } SEAM(12);
    MOE_PHASES(1, 13);
#undef MOE_PHASES
    if (IN(16)) { norm_phase<true, false, true>(F, a, a.out, 1, 0, 1); }
#undef IN
#undef SEAM
}

extern "C" void kernel_launch(void* const* d_in, const int* in_sizes, int n_in, void* d_out, int out_size, void* d_ws, size_t ws_size, hipStream_t stream) {
    static int grid = 0;
    if (grid == 0) {
        if (n_in != 26 || out_size != NTOK * DM || ws_size < WS_END) { fprintf(stderr, "kernel_launch: unexpected problem (n_in %d, out %d, ws %zu < %zu)\n", n_in, out_size, ws_size, (size_t)WS_END); grid = -1; return; }
        int dev = 0, cus = 0, per_cu = 0;
        if (hipGetDevice(&dev) != hipSuccess || hipDeviceGetAttribute(&cus, hipDeviceAttributeMultiprocessorCount, dev) != hipSuccess) { grid = -1; return; }
        if (hipFuncSetAttribute((const void*)fwd_kernel, hipFuncAttributeMaxDynamicSharedMemorySize, LDS_BYTES) != hipSuccess) { fprintf(stderr, "kernel_launch: hipFuncSetAttribute failed\n"); grid = -1; return; }
        if (hipOccupancyMaxActiveBlocksPerMultiprocessor(&per_cu, (const void*)fwd_kernel, NTHR, LDS_BYTES) != hipSuccess || per_cu < 1) { fprintf(stderr, "kernel_launch: occupancy query says %d\n", per_cu); }
        (void)hipGetLastError();
        grid = cus;
    }
    if (grid < 0) return;
    (void)hipMemsetAsync((char*)d_ws + WS_CTL, 0, CTL_BYTES, stream);
    Args a{};
    const float** fp = (const float**)&a.x;
    (void)fp;
    a.x = (const float*)d_in[0]; a.c = (const float*)d_in[1]; a.positions = (const int*)d_in[2]; a.rel_bias = (const float*)d_in[3]; a.norm_g = (const float*)d_in[4];
    a.final_norm_g = (const float*)d_in[5]; a.ada_w = (const float*)d_in[6]; a.ada_b = (const float*)d_in[7]; a.ab_w_in = (const float*)d_in[8]; a.ab_conv_a = (const float*)d_in[9];
    a.ab_conv_b = (const float*)d_in[10]; a.ab_conv_b_bias = (const float*)d_in[11]; a.ab_ln_g = (const float*)d_in[12]; a.ab_ln_b = (const float*)d_in[13]; a.ab_w_out = (const float*)d_in[14];
    a.cd_w_in = (const float*)d_in[15]; a.diff_lam = (const float*)d_in[16]; a.diff_norm_g = (const float*)d_in[17]; a.cd_w_out = (const float*)d_in[18];
    a.moe_wr_g = (const float*)d_in[19]; a.moe_br_g = (const float*)d_in[20]; a.moe_wr_e = (const float*)d_in[21]; a.moe_br_e = (const float*)d_in[22];
    a.moe_w_gate = (const float*)d_in[23]; a.moe_w_up = (const float*)d_in[24]; a.moe_w_down = (const float*)d_in[25];
    a.out = (float*)d_out; a.ws = (unsigned char*)d_ws;
#if MK_ONE_LAUNCH
    a.ph_lo = 0; a.ph_hi = NPH;
    hipLaunchKernelGGL(fwd_kernel, dim3(grid), dim3(NTHR), LDS_BYTES, stream, a);
#else
    for (int p = 0; p < NPH; ++p) { a.ph_lo = p; a.ph_hi = p + 1; hipLaunchKernelGGL(fwd_kernel, dim3(grid), dim3(NTHR), LDS_BYTES, stream, a); }
#endif
}
```

```cpp
#include <hip/hip_runtime.h>
#include <cstdio>
#include <cstdint>

#define LAS __attribute__((address_space(3)))
#define DI __device__ __forceinline__
typedef unsigned short bf16_t;
typedef short bf16x8 __attribute__((ext_vector_type(8)));
typedef short s16x4 __attribute__((ext_vector_type(4)));
typedef float f32x2 __attribute__((ext_vector_type(2)));
typedef float f32x4 __attribute__((ext_vector_type(4)));
typedef float f32x16 __attribute__((ext_vector_type(16)));
typedef unsigned u32x2 __attribute__((ext_vector_type(2)));
typedef unsigned u32x4 __attribute__((ext_vector_type(4)));
typedef __bf16 bf16v2 __attribute__((ext_vector_type(2)));

constexpr int NB = 4, SEQ = 8192, DM = 1024, NTOK = NB * SEQ;
constexpr int NTHR = 512, NWAVE = 8;
constexpr int AB_N = 2560;
constexpr int ZC_N = 1536;
constexpr int CD_SRC_N = 3368;
constexpr int CD_N = 3584;
constexpr int Z_QC = 0, Z_KC = 512, Z_VC = 1024, Z_QD = 1536, Z_KD = 2048, Z_VD = 2560, Z_QI = 3072, Z_KI = 3328, Z_WI = 3360;
constexpr int NEXP = 32, DEXP = 512;
constexpr int MOE_ROWS = 2 * NTOK + NEXP * 256;
constexpr float EPS = 1e-6f;
constexpr float LOG2E = 1.4426950408889634f;

constexpr size_t MiB = 1u << 20;
constexpr size_t WS_CTL = 0, CTL_BYTES = 64 * 1024;
constexpr size_t WS_MOD = 1 * MiB;
constexpr size_t WS_WAB_IN = 2 * MiB;
constexpr size_t WS_WAB_OUT = 7 * MiB;
constexpr size_t WS_WCD_IN = 9 * MiB;
constexpr size_t WS_WCD_OUT = 16 * MiB;
constexpr size_t WS_MOE_W = 18 * MiB;
constexpr size_t WS_H = 114 * MiB;
constexpr size_t WS_Y = 178 * MiB;
constexpr size_t WS_BIG = 242 * MiB;
constexpr size_t WS_ACT = WS_BIG;
constexpr size_t WS_YMOE = WS_BIG + 72 * MiB;
constexpr size_t WS_MASK = 466 * MiB;
constexpr size_t WS_LIST = 498 * MiB;
constexpr size_t WS_GATEV = 502 * MiB;
constexpr size_t WS_TOKSLOT = 506 * MiB;
constexpr size_t WS_END = 507 * MiB;

constexpr int CW_BAR = 0;
constexpr int CW_CNT = 4096;
constexpr int CNT_STRIDE = 64;

DI unsigned pack_bf16(float lo, float hi) { f32x2 v = {lo, hi}; bf16v2 b = __builtin_convertvector(v, bf16v2); return __builtin_bit_cast(unsigned, b); }
DI float bf_lo(unsigned w) { return __uint_as_float(w << 16); }
DI float bf_hi(unsigned w) { return __uint_as_float(w & 0xffff0000u); }
DI float bf2f(bf16_t b) { return __uint_as_float(((unsigned)b) << 16); }
DI float wave_sum(float v) {
#pragma unroll
    for (int o = 32; o >= 1; o >>= 1) v += __shfl_xor(v, o);
    return v;
}
DI float silu_f(float v) { return v / (1.0f + __expf(-v)); }
DI float sigmoid_f(float v) { return 1.0f / (1.0f + __expf(-v)); }

#define XB_TMO      128
#define XB_XCNT(j)  (256  + 64 * (j))
#define XB_XSUB(j)  (1280 + 64 * (j))
#define XB_XGEN(j)  (2304 + 64 * (j))
#define XB_TOP      3328
#define XB_TOPGEN   3392
#define XCD_BAR_WORDS 3456
#define XB_SPIN_CAP (1u << 22)
DI unsigned xb_ld(unsigned* p)              { return __hip_atomic_load(p, __ATOMIC_RELAXED, __HIP_MEMORY_SCOPE_AGENT); }
DI unsigned xb_add(unsigned* p, unsigned v) { return __hip_atomic_fetch_add(p, v, __ATOMIC_RELAXED, __HIP_MEMORY_SCOPE_AGENT); }
DI unsigned xb_xcc_id() { return (unsigned)__builtin_amdgcn_s_getreg((3 << 11) | 20) & 0xFu; }
#define XB_SPIN(cond, bar) do { unsigned _sp = 0; while (cond) { __builtin_amdgcn_s_sleep(1); \
    if ((++_sp & 255u) == 0u) { if (xb_ld(&(bar)[XB_TMO])) break; if (_sp > XB_SPIN_CAP) { atomicAdd(&(bar)[XB_TMO], 1u); break; } } } } while (0)
struct XcdBarrier { unsigned* bar; unsigned x; volatile LAS unsigned* st; };
DI XcdBarrier xcd_barrier_post(unsigned* bar, volatile LAS unsigned* st) {
    XcdBarrier b; b.bar = bar; b.x = xb_xcc_id(); b.st = st;
    if (threadIdx.x == 0) (void)xb_add(&bar[XB_XCNT(b.x)], 1u);
    return b;
}
DI void xcd_barrier_complete(unsigned* bar, unsigned x, unsigned& nloc, unsigned& nx) {
    const unsigned G = gridDim.x * gridDim.y * gridDim.z;
    unsigned sum, cnt, mine, sp = 0u;
    for (;;) {
        sum = 0u; cnt = 0u; mine = 0u;
#pragma unroll
        for (unsigned j = 0; j < 16; ++j) { const unsigned c = xb_ld(&bar[XB_XCNT(j)]); sum += c; cnt += (c > 0u) ? 1u : 0u; mine = (j == x) ? c : mine; }
        if (sum == G) break;
        __builtin_amdgcn_s_sleep(1);
        if ((++sp & 255u) == 0u) { if (xb_ld(&bar[XB_TMO])) break; if (sp > XB_SPIN_CAP) { atomicAdd(&bar[XB_TMO], 1u); break; } }
    }
    nloc = mine > 0u ? mine : 1u; nx = cnt > 0u ? cnt : 1u;
}
DI void xcd_barrier(const XcdBarrier& b) {
    asm volatile("s_waitcnt vmcnt(0)" ::: "memory");
    __syncthreads();
    if (threadIdx.x == 0) {
        unsigned* bar = b.bar;
        __builtin_amdgcn_s_waitcnt(0);
        unsigned nloc = b.st[0], nx = b.st[1];
        if (nloc == 0u) { xcd_barrier_complete(bar, b.x, nloc, nx); b.st[0] = nloc; b.st[1] = nx; }
        const unsigned old = xb_add(&bar[XB_XSUB(b.x)], 1u);
        const unsigned gen = old / nloc;
        if (old + 1u == (gen + 1u) * nloc) {
            __builtin_amdgcn_fence(__ATOMIC_RELEASE, "agent");
            asm volatile("s_waitcnt vmcnt(0)" ::: "memory");
            const unsigned og = xb_add(&bar[XB_TOP], 1u);
            const unsigned tg = og / nx;
            if (og + 1u == (tg + 1u) * nx) xb_add(&bar[XB_TOPGEN], 1u);
            else XB_SPIN(xb_ld(&bar[XB_TOPGEN]) == tg, bar);
            __builtin_amdgcn_fence(__ATOMIC_ACQUIRE, "agent");
            xb_add(&bar[XB_XGEN(b.x)], 1u);
            asm volatile("s_waitcnt vmcnt(0)" ::: "memory");
        } else {
            XB_SPIN(xb_ld(&bar[XB_XGEN(b.x)]) == gen, bar);
            __builtin_amdgcn_fence(__ATOMIC_ACQUIRE, "agent");
            asm volatile("s_waitcnt vmcnt(0)" ::: "memory");
        }
    }
    __syncthreads();
}

namespace pg8 {
constexpr int BM = 256, BK = 64, HALF = 128, HTB = HALF * BK * 2, STAGE_BYTES = 8 * HTB;
DI int lds_byte(int r, int c) { const int st = (r >> 4) * 2 + (c >> 5), rr = r & 15, cc = c & 31, ob = rr * 64 + cc * 2; return st * 1024 + (ob ^ (((ob >> 9) & 1) << 5)); }
DI void stage_rc(int b, int& R, int& C) { const int st = b / 1024, sb = b % 1024, swz = sb ^ (((sb >> 9) & 1) << 5); R = (st >> 1) * 16 + swz / 64; C = (st & 1) * 32 + (swz % 64) / 2; }
struct Unit { int pm, pn, e, nrow; };

template <class Epi, class Sched>
DI void gemm_phase(LAS unsigned char* lds, const char* Abase, const int K, const Sched& S, const Epi& E) {
    const int tid = threadIdx.x, wid = __builtin_amdgcn_readfirstlane(tid >> 6), lane = tid & 63, wr = wid >> 2, wc = wid & 3, fr = lane & 15, fq = lane >> 4;
    const int nt = K / BK;
    int Rr[2], Cc[2]; unsigned voffB[2];
#pragma unroll
    for (int i = 0; i < 2; ++i) { int R, C; stage_rc(tid * 16 + i * 8192, R, C); Rr[i] = R; Cc[i] = C; voffB[i] = (unsigned)(R * K + C) * 2u; }
    const size_t kstep = (size_t)(BK * 2);
    const size_t hstep = (size_t)HALF * K * 2;
    const unsigned ldsw = (unsigned)wid * 1024u;
    const int aoff = lds_byte(wr * 64 + fr, fq * 8), boff = lds_byte(wc * 32 + fr, fq * 8);
#define PG8_SA(b, h) (((b) * 2 + (h)) * HTB)
#define PG8_SB(b, h) ((4 + (b) * 2 + (h)) * HTB)
#define PG8_STAGE(bufoff, gbase, voff) do { _Pragma("unroll") for (int _i = 0; _i < 2; ++_i) \
        __builtin_amdgcn_global_load_lds((const unsigned*)((const char*)(gbase) + (voff)[_i]), (LAS unsigned*)(lds + (bufoff) + ldsw + _i * 8192), 16, 0, 0); } while (0)
#define PG8_AOFF(dst, u) do { _Pragma("unroll") for (int _h = 0; _h < 2; ++_h) _Pragma("unroll") for (int _i = 0; _i < 2; ++_i) \
        dst[_h][_i] = ((unsigned)S.a_row(u, _h * HALF + Rr[_i]) * (unsigned)K + (unsigned)Cc[_i]) * 2u; } while (0)
#define PG8_LDA(dst, b, h) do { _Pragma("unroll") for (int m = 0; m < 4; ++m) _Pragma("unroll") for (int k = 0; k < 2; ++k) dst[m][k] = *(const LAS bf16x8*)(lds + PG8_SA(b, h) + aoff + m * 2048 + k * 1024); } while (0)
#define PG8_LDB(dst, b, h) do { _Pragma("unroll") for (int n = 0; n < 2; ++n) _Pragma("unroll") for (int k = 0; k < 2; ++k) dst[n][k] = *(const LAS bf16x8*)(lds + PG8_SB(b, h) + boff + n * 2048 + k * 1024); } while (0)
#define PG8_MMA(ai, bj, At, Bt) do { __builtin_amdgcn_s_setprio(1); _Pragma("unroll") for (int m = 0; m < 4; ++m) _Pragma("unroll") for (int n = 0; n < 2; ++n) _Pragma("unroll") for (int k = 0; k < 2; ++k) \
        acc[ai][bj][m][n] = __builtin_amdgcn_mfma_f32_16x16x32_bf16(Bt[n][k], At[m][k], acc[ai][bj][m][n], 0, 0, 0); __builtin_amdgcn_s_setprio(0); } while (0)
#define PG8_WAIT_V(n) asm volatile("s_waitcnt vmcnt(" #n ")" ::: "memory")
#define PG8_WAIT_L(n) asm volatile("s_waitcnt lgkmcnt(" #n ")" ::: "memory")
#define PG8_BAR __builtin_amdgcn_s_barrier()
#define PG8_SCHED __builtin_amdgcn_sched_barrier(0)
    Unit cur, nxt; int ui = 0;
    if (!S.next(0, cur)) return;
    f32x4 acc[2][2][4][2];
#pragma unroll
    for (int a = 0; a < 2; ++a)
#pragma unroll
        for (int b = 0; b < 2; ++b)
#pragma unroll
            for (int m = 0; m < 4; ++m)
#pragma unroll
                for (int n = 0; n < 2; ++n) acc[a][b][m][n] = (f32x4){0.f, 0.f, 0.f, 0.f};
    bf16x8 At[4][2], B0[2][2], B1[2][2];
    unsigned aoC[2][2], aoN[2][2];
    PG8_AOFF(aoC, cur);
    const char* cB = S.b_base(cur);
    PG8_STAGE(PG8_SB(0, 0), cB, voffB); PG8_STAGE(PG8_SA(0, 0), Abase, aoC[0]); PG8_STAGE(PG8_SB(0, 1), cB + hstep, voffB); PG8_STAGE(PG8_SA(0, 1), Abase, aoC[1]);
    if (wr == 1) PG8_BAR;
    PG8_WAIT_V(4); PG8_BAR;
    PG8_STAGE(PG8_SB(1, 0), cB + kstep, voffB); PG8_STAGE(PG8_SA(1, 0), Abase + kstep, aoC[0]); PG8_STAGE(PG8_SB(1, 1), cB + hstep + kstep, voffB);
    PG8_WAIT_V(6); PG8_BAR;
    for (;;) {
        const bool has_next = S.next(ui + 1, nxt);
        const char* nB = cB;
#pragma unroll
        for (int _h = 0; _h < 2; ++_h)
#pragma unroll
            for (int _i = 0; _i < 2; ++_i) aoN[_h][_i] = aoC[_h][_i];
        if (has_next) { PG8_AOFF(aoN, nxt); nB = S.b_base(nxt); }
        for (int t = 0; t < nt; t += 2) {
            const bool last = (t == nt - 2);
            const char* a1 = Abase + (size_t)(t + 1) * kstep;
            const char* a2 = last ? Abase : Abase + (size_t)(t + 2) * kstep; const char* b2 = last ? nB : cB + (size_t)(t + 2) * kstep;
            const char* a3 = a2 + kstep; const char* b3 = b2 + kstep;
            unsigned ao2[2][2];
#pragma unroll
            for (int _h = 0; _h < 2; ++_h)
#pragma unroll
                for (int _i = 0; _i < 2; ++_i) ao2[_h][_i] = last ? aoN[_h][_i] : aoC[_h][_i];
            PG8_LDB(B0, 0, 0); PG8_SCHED; PG8_LDA(At, 0, 0); PG8_STAGE(PG8_SA(1, 1), a1, aoC[1]);
            PG8_WAIT_L(8); PG8_BAR; PG8_WAIT_L(0); PG8_MMA(0, 0, At, B0); PG8_BAR; PG8_SCHED;
            PG8_LDB(B1, 0, 1); PG8_STAGE(PG8_SB(0, 0), b2, voffB);
            PG8_BAR; PG8_WAIT_L(0); PG8_MMA(0, 1, At, B1); PG8_BAR;
            PG8_LDA(At, 0, 1); PG8_STAGE(PG8_SA(0, 0), a2, ao2[0]);
            PG8_BAR; PG8_WAIT_L(0); PG8_MMA(1, 0, At, B0); PG8_BAR; PG8_SCHED;
            PG8_STAGE(PG8_SB(0, 1), b2 + hstep, voffB);
            PG8_WAIT_V(6); PG8_BAR; PG8_MMA(1, 1, At, B1); PG8_BAR;
            PG8_LDB(B0, 1, 0); PG8_SCHED; PG8_LDA(At, 1, 0); PG8_STAGE(PG8_SA(0, 1), a2, ao2[1]);
            PG8_WAIT_L(8); PG8_BAR; PG8_WAIT_L(0); PG8_MMA(0, 0, At, B0); PG8_BAR; PG8_SCHED;
            PG8_LDB(B1, 1, 1); PG8_STAGE(PG8_SB(1, 0), b3, voffB);
            PG8_BAR; PG8_WAIT_L(0); PG8_MMA(0, 1, At, B1); PG8_BAR;
            PG8_LDA(At, 1, 1); PG8_STAGE(PG8_SA(1, 0), a3, ao2[0]);
            PG8_BAR; PG8_WAIT_L(0); PG8_MMA(1, 0, At, B0); PG8_BAR; PG8_SCHED;
            PG8_STAGE(PG8_SB(1, 1), b3 + hstep, voffB);
            PG8_WAIT_V(6); PG8_BAR; PG8_MMA(1, 1, At, B1); PG8_BAR;
        }
        E(acc, cur, wr, wc, fr, fq);
        if (!has_next) break;
#pragma unroll
        for (int a = 0; a < 2; ++a)
#pragma unroll
            for (int b = 0; b < 2; ++b)
#pragma unroll
                for (int m = 0; m < 4; ++m)
#pragma unroll
                    for (int n = 0; n < 2; ++n) acc[a][b][m][n] = (f32x4){0.f, 0.f, 0.f, 0.f};
        cur = nxt; cB = nB; ++ui;
#pragma unroll
        for (int _h = 0; _h < 2; ++_h)
#pragma unroll
            for (int _i = 0; _i < 2; ++_i) aoC[_h][_i] = aoN[_h][_i];
    }
    PG8_WAIT_V(0);
    if (wr == 0) PG8_BAR;
    PG8_BAR;
#undef PG8_SA
#undef PG8_SB
#undef PG8_STAGE
#undef PG8_AOFF
#undef PG8_LDA
#undef PG8_LDB
#undef PG8_MMA
#undef PG8_WAIT_V
#undef PG8_WAIT_L
#undef PG8_BAR
#undef PG8_SCHED
}
}

struct Args {
    const float* x; const float* c; const int* positions; const float* rel_bias; const float* norm_g; const float* final_norm_g;
    const float* ada_w; const float* ada_b; const float* ab_w_in; const float* ab_conv_a; const float* ab_conv_b; const float* ab_conv_b_bias;
    const float* ab_ln_g; const float* ab_ln_b; const float* ab_w_out; const float* cd_w_in; const float* diff_lam; const float* diff_norm_g;
    const float* cd_w_out; const float* moe_wr_g; const float* moe_br_g; const float* moe_wr_e; const float* moe_br_e;
    const float* moe_w_gate; const float* moe_w_up; const float* moe_w_down;
    float* out; unsigned char* ws; int ph_lo, ph_hi;
};
struct Frame {
    LAS unsigned char* lds; int tid, lane, wave, G, bid;
};

struct RowSrc { const float* p; int ld; };
DI void ilv(int rp, int& j, int& second) { const int g = rp >> 5, i = rp & 31; j = 16 * g + (i & 15); second = i >> 4; }

enum { CV_AB_IN = 0, CV_AB_OUT = 1, CV_CD_IN = 2, CV_CD_OUT = 3, CV_MOE_GU = 4, CV_MOE_D = 5 };
template <int KIND> DI RowSrc row_src(const Args& a, int layer, int e, int r) {
    RowSrc s; s.p = nullptr; s.ld = 0;
    if (KIND == CV_AB_IN) {
        s.ld = AB_N;
        if (r < 512) s.p = a.ab_w_in + r;
        else if (r < 1536) { int j, sec; ilv(r - 512, j, sec); s.p = a.ab_w_in + (sec ? 1024 + j : 512 + j); }
        else { int j, sec; ilv(r - 1536, j, sec); s.p = a.ab_w_in + (sec ? 2048 + j : 1536 + j); }
    } else if (KIND == CV_AB_OUT) { s.ld = DM; s.p = a.ab_w_out + r; }
    else if (KIND == CV_CD_IN) {
        s.ld = CD_SRC_N;
        int col = -1;
        if (r < 1536) col = r;
        else if (r < 3072) col = 1832 + (r - 1536);
        else if (r < 3328) col = 1536 + (r - 3072);
        else if (r < 3360) col = 1792 + (r - 3328);
        else if (r < 3368) col = 1824 + (r - 3360);
        if (col >= 0) s.p = a.cd_w_in + col;
    } else if (KIND == CV_CD_OUT) { s.ld = DM; s.p = a.cd_w_out + r; }
    else if (KIND == CV_MOE_GU) {
        int j, sec; ilv(r, j, sec); s.ld = DEXP;
        const size_t base = ((size_t)layer * NEXP + e) * (size_t)DM * DEXP;
        s.p = (sec ? a.moe_w_up : a.moe_w_gate) + base + j;
    } else {
        s.ld = DM; s.p = a.moe_w_down + ((size_t)layer * NEXP + e) * (size_t)DEXP * DM + r;
    }
    return s;
}
constexpr int CV_LD = 258;
template <int KIND> DI void cvt_tile(const Frame& F, const Args& a, bf16_t* dst, int K, int r0, int k0, int layer, int e) {
    LAS bf16_t* T = (LAS bf16_t*)F.lds;
    const int c4 = F.tid & 15;
    const RowSrc s = row_src<KIND>(a, layer, e, r0 + 4 * c4);
    f32x4 v[8];
#pragma unroll
    for (int it = 0; it < 8; ++it) {
        const int kk = (F.tid >> 4) + 32 * it;
        v[it] = (f32x4){0.f, 0.f, 0.f, 0.f};
        if (s.p) v[it] = *(const f32x4*)(s.p + (size_t)(k0 + kk) * s.ld);
    }
#pragma unroll
    for (int it = 0; it < 8; ++it) {
        const int kk = (F.tid >> 4) + 32 * it;
        const unsigned p01 = pack_bf16(v[it][0], v[it][1]), p23 = pack_bf16(v[it][2], v[it][3]);
        T[(4 * c4 + 0) * CV_LD + kk] = (bf16_t)(p01 & 0xffffu); T[(4 * c4 + 1) * CV_LD + kk] = (bf16_t)(p01 >> 16);
        T[(4 * c4 + 2) * CV_LD + kk] = (bf16_t)(p23 & 0xffffu); T[(4 * c4 + 3) * CV_LD + kk] = (bf16_t)(p23 >> 16);
    }
    __syncthreads();
    {
        const int rr = F.tid >> 3, c = F.tid & 7;
#pragma unroll
        for (int j = 0; j < 4; ++j) {
            const LAS unsigned* src = (const LAS unsigned*)(T + rr * CV_LD + 64 * j + c * 8);
            u32x4 w; w[0] = src[0]; w[1] = src[1]; w[2] = src[2]; w[3] = src[3];
            *(u32x4*)(dst + (size_t)(r0 + rr) * K + k0 + 64 * j + c * 8) = w;
        }
    }
    __syncthreads();
}
constexpr int CVT_DENSE_TILES = (AB_N + DM + CD_N + DM) / 64 * (DM / 256);
constexpr int CVT_MOE_TILES_PER_EXP = (1024 / 64) * (1024 / 256) + (1024 / 64) * (512 / 256);
constexpr int CVT_MOE_TILES = NEXP * CVT_MOE_TILES_PER_EXP;
DI void cvt_dense_item(const Frame& F, const Args& a, int item) {
    const int rt = item >> 2, kt = item & 3;
    int r = rt * 64;
    if (r < AB_N) { cvt_tile<CV_AB_IN>(F, a, (bf16_t*)(a.ws + WS_WAB_IN), DM, r, kt * 256, 0, 0); return; }
    r -= AB_N;
    if (r < DM) { cvt_tile<CV_AB_OUT>(F, a, (bf16_t*)(a.ws + WS_WAB_OUT), DM, r, kt * 256, 0, 0); return; }
    r -= DM;
    if (r < CD_N) { cvt_tile<CV_CD_IN>(F, a, (bf16_t*)(a.ws + WS_WCD_IN), DM, r, kt * 256, 0, 0); return; }
    r -= CD_N;
    cvt_tile<CV_CD_OUT>(F, a, (bf16_t*)(a.ws + WS_WCD_OUT), DM, r, kt * 256, 0, 0);
}
DI void cvt_moe_item(const Frame& F, const Args& a, int layer, int item) {
    const int e = item / CVT_MOE_TILES_PER_EXP, t = item % CVT_MOE_TILES_PER_EXP;
    bf16_t* base = (bf16_t*)(a.ws + WS_MOE_W + (size_t)e * 3 * MiB);
    if (t < 64) cvt_tile<CV_MOE_GU>(F, a, base, DM, (t >> 2) * 64, (t & 3) * 256, layer, e);
    else { const int t2 = t - 64; cvt_tile<CV_MOE_D>(F, a, base + (size_t)DM * DM, DEXP, (t2 >> 1) * 64, (t2 & 1) * 256, layer, e); }
}
DI void mod_item(const Frame& F, const Args& a, int item) {
    LAS float* sc = (LAS float*)F.lds;
    for (int i = F.tid; i < NB * DM; i += NTHR) sc[i] = silu_f(a.c[i]);
    __syncthreads();
    const int l = item / 12, j = (item % 12) * 512 + F.tid;
    const float* w = a.ada_w + (size_t)l * DM * 6 * DM + j;
    float acc[NB] = {0.f, 0.f, 0.f, 0.f};
    for (int k = 0; k < DM; k += 4) {
        float wv[4];
#pragma unroll
        for (int u = 0; u < 4; ++u) wv[u] = w[(size_t)(k + u) * 6 * DM];
#pragma unroll
        for (int u = 0; u < 4; ++u)
#pragma unroll
            for (int b = 0; b < NB; ++b) acc[b] += sc[b * DM + k + u] * wv[u];
    }
    float* mod = (float*)(a.ws + WS_MOD);
    const float bias = a.ada_b[l * 6 * DM + j];
#pragma unroll
    for (int b = 0; b < NB; ++b) mod[((size_t)l * NB + b) * 6 * DM + j] = acc[b] + bias;
    __syncthreads();
}
DI void p0_prologue(const Frame& F, const Args& a) {
    const int n_items = 24 + CVT_DENSE_TILES + CVT_MOE_TILES;
    for (int it = F.bid; it < n_items; it += F.G) {
        if (it < 24) mod_item(F, a, it);
        else if (it < 24 + CVT_DENSE_TILES) cvt_dense_item(F, a, it - 24);
        else cvt_moe_item(F, a, 0, it - 24 - CVT_DENSE_TILES);
    }
}

constexpr int WR_LD = 1028;
DI void moe_seg_table(const Frame& F, const unsigned* cnt, LAS int* seg  ) {
    if (F.tid == 0) { int s = 0; for (int e = 0; e < NEXP; ++e) { seg[e] = s; s += (((int)cnt[e * CNT_STRIDE] + 255) >> 8) << 8; } seg[NEXP] = s; }
    __syncthreads();
}
template <bool COMBINE, bool ROUTE, bool FINAL>
DI void norm_phase(const Frame& F, const Args& a, const float* xsrc, int layer, int which, int layer_c) {
    const float* mod = (const float*)(a.ws + WS_MOD);
    bf16_t* hbuf = (bf16_t*)(a.ws + WS_H);
    unsigned* ctl = (unsigned*)(a.ws + WS_CTL);
    LAS float* wrT = (LAS float*)F.lds;
    LAS float* brs = (LAS float*)(F.lds + 36 * WR_LD * 4);
    LAS int* seg = (LAS int*)F.lds;
    constexpr int RT_CAP = 512;
    LAS int* rcnt = (LAS int*)(F.lds + 149504);
    LAS int* rbase = (LAS int*)(F.lds + 149632);
    LAS int* rt_er = (LAS int*)(F.lds + 149760);
    LAS float* rt_gate = (LAS float*)(F.lds + 149760 + 4096);
    LAS int* rt_tok = (LAS int*)(F.lds + 149760 + 8192);
    if (ROUTE) {
        const float* wg = a.moe_wr_g + (size_t)layer * DM * 4;
        const float* we = a.moe_wr_e + (size_t)layer * DM * 32;
        for (int i = F.tid; i < DM * 4; i += NTHR) { const int k = i >> 2, j = i & 3; wrT[j * WR_LD + k] = wg[i]; }
        for (int i = F.tid; i < DM * 32; i += NTHR) { const int k = i >> 5, j = i & 31; wrT[(4 + j) * WR_LD + k] = we[i]; }
        if (F.tid < NEXP) rcnt[F.tid] = 0;
        for (int i = F.tid; i < 2 * RT_CAP; i += NTHR) rt_er[i] = -1;
        if (F.tid < 4) brs[F.tid] = a.moe_br_g[layer * 4 + F.tid];
        else if (F.tid < 36) brs[F.tid] = a.moe_br_e[layer * 32 + F.tid - 4];
        __syncthreads();
    }
    if (COMBINE) moe_seg_table(F, ctl + CW_CNT + layer_c * NEXP * CNT_STRIDE, seg);
    const bf16_t* ymoe = (const bf16_t*)(a.ws + WS_YMOE);
    const int* tokslot = (const int*)(a.ws + WS_TOKSLOT);
    constexpr int TPW = ROUTE ? 2 : 4;
    for (int tb = (F.bid * NWAVE + F.wave) * TPW; tb < NTOK; tb += F.G * NWAVE * TPW) {
      const int b = tb / SEQ;
      f32x4 xall[TPW][4];
#pragma unroll
      for (int i = 0; i < TPW; ++i)
#pragma unroll
        for (int c = 0; c < 4; ++c) xall[i][c] = *(const f32x4*)(xsrc + (size_t)(tb + i) * DM + c * 256 + F.lane * 4);
      if (COMBINE) {
        int ts[TPW][2];
#pragma unroll
        for (int i = 0; i < TPW; ++i) { ts[i][0] = tokslot[(tb + i) * 2]; ts[i][1] = tokslot[(tb + i) * 2 + 1]; }
        u32x2 yv[TPW][2][4];
#pragma unroll
        for (int i = 0; i < TPW; ++i)
#pragma unroll
          for (int k = 0; k < 2; ++k) {
            const size_t r = (size_t)(seg[ts[i][k] >> 20] + (ts[i][k] & 0xfffff));
#pragma unroll
            for (int c = 0; c < 4; ++c) yv[i][k][c] = *(const u32x2*)(ymoe + r * DM + c * 256 + F.lane * 4);
          }
        const float* g2 = mod + ((size_t)layer_c * NB + b) * 6 * DM + 5 * DM;
#pragma unroll
        for (int c = 0; c < 4; ++c) {
          const int col = c * 256 + F.lane * 4;
          const f32x4 gv = *(const f32x4*)(g2 + col);
#pragma unroll
          for (int i = 0; i < TPW; ++i) {
            const u32x2 y0 = yv[i][0][c], y1 = yv[i][1][c];
            xall[i][c][0] += gv[0] * (bf_lo(y0[0]) + bf_lo(y1[0])); xall[i][c][1] += gv[1] * (bf_hi(y0[0]) + bf_hi(y1[0]));
            xall[i][c][2] += gv[2] * (bf_lo(y0[1]) + bf_lo(y1[1])); xall[i][c][3] += gv[3] * (bf_hi(y0[1]) + bf_hi(y1[1]));
            if (!FINAL) *(f32x4*)(a.out + (size_t)(tb + i) * DM + col) = xall[i][c];
          }
        }
      }
#pragma unroll
      for (int ti = 0; ti < TPW; ++ti) {
        const int tok = tb + ti;
        f32x4 xv[4];
#pragma unroll
        for (int c = 0; c < 4; ++c) xv[c] = xall[ti][c];
        float ss = 0.f;
#pragma unroll
        for (int c = 0; c < 4; ++c) ss += xv[c][0] * xv[c][0] + xv[c][1] * xv[c][1] + xv[c][2] * xv[c][2] + xv[c][3] * xv[c][3];
        ss = wave_sum(ss);
        const float rinv = rsqrtf(ss * (1.0f / DM) + EPS);
        if (FINAL) {
#pragma unroll
            for (int c = 0; c < 4; ++c) {
                const int col = c * 256 + F.lane * 4;
                const f32x4 g = *(const f32x4*)(a.final_norm_g + col);
                f32x4 o; o[0] = xv[c][0] * rinv * g[0]; o[1] = xv[c][1] * rinv * g[1]; o[2] = xv[c][2] * rinv * g[2]; o[3] = xv[c][3] * rinv * g[3];
                *(f32x4*)(a.out + (size_t)tok * DM + col) = o;
            }
            continue;
        }
        const float* ng = a.norm_g + ((size_t)layer * 2 + which) * DM;
        const float* sh = mod + ((size_t)layer * NB + b) * 6 * DM + (which ? 3 : 0) * DM;
        const float* sc = sh + DM;
        f32x4 hv[4];
#pragma unroll
        for (int c = 0; c < 4; ++c) {
            const int col = c * 256 + F.lane * 4;
            const f32x4 g = *(const f32x4*)(ng + col), s1 = *(const f32x4*)(sc + col), s0 = *(const f32x4*)(sh + col);
#pragma unroll
            for (int u = 0; u < 4; ++u) hv[c][u] = (xv[c][u] * rinv * g[u]) * (1.0f + s1[u]) + s0[u];
            u32x2 w; w[0] = pack_bf16(hv[c][0], hv[c][1]); w[1] = pack_bf16(hv[c][2], hv[c][3]);
            *(u32x2*)(hbuf + (size_t)tok * DM + col) = w;
        }
        if (ROUTE) {
            LAS float* lgs = (LAS float*)(F.lds + 36 * WR_LD * 4 + 256) + F.wave * 36;
#pragma unroll 1
            for (int jb = 0; jb < 36; jb += 4) {
                float pp[4];
#pragma unroll
                for (int u = 0; u < 4; ++u) {
                    float p = 0.f;
#pragma unroll
                    for (int c = 0; c < 4; ++c) {
                        const f32x4 w = *(const LAS f32x4*)(wrT + (jb + u) * WR_LD + c * 256 + F.lane * 4);
                        p += hv[c][0] * w[0] + hv[c][1] * w[1] + hv[c][2] * w[2] + hv[c][3] * w[3];
                    }
                    pp[u] = p;
                }
#pragma unroll
                for (int u = 0; u < 4; ++u) pp[u] = wave_sum(pp[u]);
                if (F.lane == 0) { *(LAS f32x4*)(lgs + jb) = (f32x4){pp[0], pp[1], pp[2], pp[3]}; }
            }
            float lg[36];
#pragma unroll
            for (int j = 0; j < 36; ++j) lg[j] = lgs[j] + brs[j];
            int g = 0; float gm = lg[0];
#pragma unroll
            for (int j = 1; j < 4; ++j) if (lg[j] > gm) { gm = lg[j]; g = j; }
            float den = 0.f;
#pragma unroll
            for (int j = 0; j < 4; ++j) den += __expf(lg[j] - gm);
            const float ptop = 1.0f / den;
            float fv[8];
#pragma unroll
            for (int i = 0; i < 8; ++i) fv[i] = (g == 0) ? lg[4 + i] : (g == 1) ? lg[12 + i] : (g == 2) ? lg[20 + i] : lg[28 + i];
            int i1 = 0; float v1 = fv[0];
#pragma unroll
            for (int i = 1; i < 8; ++i) if (fv[i] > v1) { v1 = fv[i]; i1 = i; }
            int i2 = -1; float v2 = -3.0e38f;
#pragma unroll
            for (int i = 0; i < 8; ++i) if (i != i1 && fv[i] > v2) { v2 = fv[i]; i2 = i; }
            const float e2 = __expf(v2 - v1), ga = ptop / (1.0f + e2), gb = ptop * e2 / (1.0f + e2);
            if (F.lane == 0) {
                const int li = ((tb - F.bid * NWAVE * TPW) / (F.G * NWAVE * TPW)) * NWAVE * TPW + F.wave * TPW + ti;
                const int ea = g * 8 + i1, eb = g * 8 + i2;
                const int ra = __hip_atomic_fetch_add(&rcnt[ea], 1, __ATOMIC_RELAXED, __HIP_MEMORY_SCOPE_WORKGROUP);
                const int rb = __hip_atomic_fetch_add(&rcnt[eb], 1, __ATOMIC_RELAXED, __HIP_MEMORY_SCOPE_WORKGROUP);
                if (li < RT_CAP) { rt_er[2 * li] = (ea << 16) | ra; rt_gate[2 * li] = ga; rt_tok[2 * li] = tok; rt_er[2 * li + 1] = (eb << 16) | rb; rt_gate[2 * li + 1] = gb; rt_tok[2 * li + 1] = tok; }
            }
        }
      }
    }
    if (ROUTE) {
        __syncthreads();
        unsigned* cnt = ctl + CW_CNT + layer * NEXP * CNT_STRIDE;
        if (F.tid < NEXP) { const int n = rcnt[F.tid]; rbase[F.tid] = n ? (int)__hip_atomic_fetch_add(cnt + F.tid * CNT_STRIDE, (unsigned)n, __ATOMIC_RELAXED, __HIP_MEMORY_SCOPE_AGENT) : 0; }
        __syncthreads();
        int* list = (int*)(a.ws + WS_LIST); float* gatev = (float*)(a.ws + WS_GATEV); int* tsl = (int*)(a.ws + WS_TOKSLOT);
        int nloc = 0;
        for (int tb = F.bid * NWAVE * TPW; tb < NTOK; tb += F.G * NWAVE * TPW) nloc += NWAVE * TPW;
        nloc = nloc < RT_CAP ? nloc : RT_CAP;
        for (int i = F.tid; i < 2 * nloc; i += NTHR) {
            const int er = rt_er[i]; if (er < 0) continue;
            const int e = er >> 16, pos = rbase[e] + (er & 0xffff), tok = rt_tok[i];
            list[e * NTOK + pos] = tok; gatev[e * NTOK + pos] = rt_gate[i]; tsl[tok * 2 + (i & 1)] = (e << 20) | pos;
        }
    }
    __syncthreads();
}

constexpr int LDS_MISC = 131072 + 64;
constexpr int LDS_XB = 163840 - 16;
constexpr int LDS_BYTES = 163840;
using pg8::Unit;
struct DenseSched {
    int nM, nN, nwg, G, c; const char* Bt; size_t tstepB;
    DI void init(int M, int N, int K, int G_, int c_, const void* Bt_) { nM = M / 256; nN = N / 256; nwg = nM * nN; G = G_; c = c_; Bt = (const char*)Bt_; tstepB = (size_t)256 * K * 2; }
    DI bool next(int i, Unit& u) const {
        const long L = (long)i * G + c; if (L >= nwg) return false;
        int wgid = (int)L; { const int q = nwg / 8, r = nwg % 8, xcd = wgid % 8, off = wgid / 8; wgid = (xcd < r ? xcd * (q + 1) : r * (q + 1) + (xcd - r) * q) + off; }
        const int nig = 8 * nN, gid = wgid / nig, fm = gid * 8, gsz = (nM - fm) < 8 ? (nM - fm) : 8;
        u.pm = fm + ((wgid % nig) % gsz); u.pn = (wgid % nig) / gsz; u.e = 0; u.nrow = 256; return true;
    }
    DI int a_row(const Unit& u, int r) const { return u.pm * 256 + r; }
    DI const char* b_base(const Unit& u) const { return Bt + (size_t)u.pn * tstepB; }
};
template <bool UP>
struct MoeSched {
    const LAS int* ntp; const unsigned* cnt; const int* list; const char* W; int nU, G, c;
    DI bool next(int i, Unit& u) const {
        const long L = (long)i * G + c; if (L >= nU) return false;
        int wgid = (int)L; { const int q = nU / 8, r = nU % 8, xcd = wgid % 8, off = wgid / 8; wgid = (xcd < r ? xcd * (q + 1) : r * (q + 1) + (xcd - r) * q) + off; }
        const int tg = wgid >> 2; u.pn = wgid & 3; u.pm = tg;
        int e = 0;
        for (int k = 1; k < NEXP; ++k) e += (ntp[k] <= tg) ? 1 : 0;
        u.e = e; const int rem = (int)cnt[e * CNT_STRIDE] - (tg - ntp[e]) * 256; u.nrow = rem < 256 ? rem : 256; return true;
    }
    DI int a_row(const Unit& u, int r) const {
        if (UP) { const int p = (u.pm - ntp[u.e]) * 256 + r; return (r < u.nrow) ? list[u.e * NTOK + p] : 0; }
        return u.pm * 256 + r;
    }
    DI const char* b_base(const Unit& u) const {
        return W + (size_t)u.e * 3 * MiB + (UP ? (size_t)u.pn * 256 * DM * 2 : 2 * MiB + (size_t)u.pn * 256 * DEXP * 2);
    }
};
DI void moe_tile_table(const Frame& F, const unsigned* cnt, LAS int* ntp  ) {
    if (F.tid == 0) { int s = 0; for (int e = 0; e < NEXP; ++e) { ntp[e] = s; s += ((int)cnt[e * CNT_STRIDE] + 255) >> 8; } ntp[NEXP] = s; }
    __syncthreads();
}

#define EPI_ROWS_BEGIN const int row0 = u.pm * 256 + wr * 64 + fr; _Pragma("unroll") for (int ai = 0; ai < 2; ++ai) _Pragma("unroll") for (int m = 0; m < 4; ++m) { const int row = row0 + ai * 128 + m * 16;
#define EPI_ROWS_END }
DI u32x2 pack4(const f32x4& v) { u32x2 w; w[0] = pack_bf16(v[0], v[1]); w[1] = pack_bf16(v[2], v[3]); return w; }

struct EpiAbIn {
    bf16_t* Zc;
    DI void operator()(const f32x4 (&acc)[2][2][4][2], const Unit& u, int wr, int wc, int fr, int fq) const {
        EPI_ROWS_BEGIN
            bf16_t* rp = Zc + (size_t)row * ZC_N;
#pragma unroll
            for (int bj = 0; bj < 2; ++bj) {
                if (u.pn < 2) {
#pragma unroll
                    for (int n = 0; n < 2; ++n) *(u32x2*)(rp + u.pn * 256 + bj * 128 + wc * 32 + n * 16 + 4 * fq) = pack4(acc[ai][bj][m][n]);
                } else {
                    const int pnp = (u.pn - 2) & 3, j = 16 * (8 * pnp + 4 * bj + wc) + 4 * fq;
                    const f32x4 X = acc[ai][bj][m][0], Y = acc[ai][bj][m][1]; f32x4 v;
                    if (u.pn < 6) { v = X * Y; *(u32x2*)(rp + 512 + j) = pack4(v); }
                    else { v[0] = X[0] * sigmoid_f(Y[0]); v[1] = X[1] * sigmoid_f(Y[1]); v[2] = X[2] * sigmoid_f(Y[2]); v[3] = X[3] * sigmoid_f(Y[3]); *(u32x2*)(rp + 1024 + j) = pack4(v); }
                }
            }
        EPI_ROWS_END
    }
};
struct EpiResid {
    const float* xin; float* xout; const float* g1;
    DI void operator()(const f32x4 (&acc)[2][2][4][2], const Unit& u, int wr, int wc, int fr, int fq) const {
        const float* g = g1 + (size_t)((u.pm * 256) / SEQ) * 6 * DM;
        EPI_ROWS_BEGIN
#pragma unroll
            for (int bj = 0; bj < 2; ++bj)
#pragma unroll
                for (int n = 0; n < 2; ++n) {
                    const int col = u.pn * 256 + bj * 128 + wc * 32 + n * 16 + 4 * fq;
                    const f32x4 xo = *(const f32x4*)(xin + (size_t)row * DM + col), gv = *(const f32x4*)(g + col);
                    *(f32x4*)(xout + (size_t)row * DM + col) = xo + gv * acc[ai][bj][m][n];
                }
        EPI_ROWS_END
    }
};
struct EpiPlain {
    bf16_t* O; int ld;
    DI void operator()(const f32x4 (&acc)[2][2][4][2], const Unit& u, int wr, int wc, int fr, int fq) const {
        EPI_ROWS_BEGIN
#pragma unroll
            for (int bj = 0; bj < 2; ++bj)
#pragma unroll
                for (int n = 0; n < 2; ++n) *(u32x2*)(O + (size_t)row * ld + u.pn * 256 + bj * 128 + wc * 32 + n * 16 + 4 * fq) = pack4(acc[ai][bj][m][n]);
        EPI_ROWS_END
    }
};
struct EpiMoeUp {
    bf16_t* act;
    DI void operator()(const f32x4 (&acc)[2][2][4][2], const Unit& u, int wr, int wc, int fr, int fq) const {
        EPI_ROWS_BEGIN
#pragma unroll
            for (int bj = 0; bj < 2; ++bj) {
                const int j = 16 * (8 * u.pn + 4 * bj + wc) + 4 * fq;
                const f32x4 X = acc[ai][bj][m][0], Y = acc[ai][bj][m][1]; f32x4 v;
                v[0] = silu_f(X[0]) * Y[0]; v[1] = silu_f(X[1]) * Y[1]; v[2] = silu_f(X[2]) * Y[2]; v[3] = silu_f(X[3]) * Y[3];
                *(u32x2*)(act + (size_t)row * DEXP + j) = pack4(v);
            }
        EPI_ROWS_END
    }
};
struct EpiMoeDown {
    bf16_t* y; const float* gatev; const LAS int* ntp;
    DI void operator()(const f32x4 (&acc)[2][2][4][2], const Unit& u, int wr, int wc, int fr, int fq) const {
        const int pbase = (u.pm - ntp[u.e]) * 256;
        EPI_ROWS_BEGIN
            const int r = row - u.pm * 256;
            const float gt = (r < u.nrow) ? gatev[u.e * NTOK + pbase + r] : 0.f;
#pragma unroll
            for (int bj = 0; bj < 2; ++bj)
#pragma unroll
                for (int n = 0; n < 2; ++n) *(u32x2*)(y + (size_t)row * DM + u.pn * 256 + bj * 128 + wc * 32 + n * 16 + 4 * fq) = pack4(acc[ai][bj][m][n] * gt);
        EPI_ROWS_END
    }
};

DI void conv_phase(const Frame& F, const Args& a) {
    const bf16_t* Zc = (const bf16_t*)(a.ws + WS_BIG);
    bf16_t* Y = (bf16_t*)(a.ws + WS_Y);
    LAS unsigned* PB = (LAS unsigned*)F.lds;
    LAS f32x2* ST = (LAS f32x2*)(F.lds + 94 * 1024);
    const int cp = F.tid & 255, th = F.tid >> 8, wq = F.wave & 3;
    float wb[31][2], wa[3][2];
#pragma unroll
    for (int k = 0; k < 31; ++k) { const f32x2 w = *(const f32x2*)(a.ab_conv_b + k * 512 + 2 * cp); wb[k][0] = w[0]; wb[k][1] = w[1]; }
#pragma unroll
    for (int k = 0; k < 3; ++k) { const f32x2 w = *(const f32x2*)(a.ab_conv_a + k * 512 + 2 * cp); wa[k][0] = w[0]; wa[k][1] = w[1]; }
    const f32x2 cbias = *(const f32x2*)(a.ab_conv_b_bias + 2 * cp), lng = *(const f32x2*)(a.ab_ln_g + 2 * cp), lnb = *(const f32x2*)(a.ab_ln_b + 2 * cp);
    for (int tile = F.bid; tile < NTOK / 64; tile += F.G) {
        const int t0 = tile * 64, b = t0 / SEQ, tl0 = t0 % SEQ;
        for (int i = F.tid; i < 94 * 64; i += NTHR) {
            const int r = i >> 6, c8 = i & 63, pos = tl0 - 30 + r;
            u32x4 v = {0u, 0u, 0u, 0u};
            if (pos >= 0) v = *(const u32x4*)(Zc + (size_t)(b * SEQ + pos) * ZC_N + 1024 + c8 * 8);
            *(LAS u32x4*)(PB + r * 256 + c8 * 4) = v;
        }
        __syncthreads();
#pragma unroll 1
        for (int g = 0; g < 4; ++g) {
            float U[8][2];
#pragma unroll
            for (int i = 0; i < 8; ++i) { U[i][0] = cbias[0]; U[i][1] = cbias[1]; }
#pragma unroll
            for (int r = 0; r < 38; ++r) {
                const unsigned xw = PB[(32 * th + 8 * g + r) * 256 + cp];
                const float x0 = bf_lo(xw), x1 = bf_hi(xw);
#pragma unroll
                for (int i = 0; i < 8; ++i) { const int k = r - i; if (k >= 0 && k <= 30) { U[i][0] += wb[k][0] * x0; U[i][1] += wb[k][1] * x1; } }
            }
#pragma unroll
            for (int i = 0; i < 8; ++i) {
                const float s1 = wave_sum(U[i][0] + U[i][1]), s2 = wave_sum(U[i][0] * U[i][0] + U[i][1] * U[i][1]);
                if (F.lane == 0) ST[(32 * th + 8 * g + i) * 4 + wq] = (f32x2){s1, s2};
            }
            __syncthreads();
#pragma unroll
            for (int i = 0; i < 8; ++i) {
                const int tl = 32 * th + 8 * g + i; const size_t tok = (size_t)t0 + tl; const int pos = tl0 + tl;
                const f32x2 p0 = ST[tl * 4 + 0], p1 = ST[tl * 4 + 1], p2 = ST[tl * 4 + 2], p3 = ST[tl * 4 + 3];
                const float mean = ((p0[0] + p1[0]) + (p2[0] + p3[0])) * (1.0f / 512.0f);
                const float var = ((p0[1] + p1[1]) + (p2[1] + p3[1])) * (1.0f / 512.0f) - mean * mean;
                const float rstd = rsqrtf(var + EPS);
                const float yb0 = silu_f((U[i][0] - mean) * rstd * lng[0] + lnb[0]), yb1 = silu_f((U[i][1] - mean) * rstd * lng[1] + lnb[1]);
                *(unsigned*)(Y + tok * DM + 512 + 2 * cp) = pack_bf16(yb0, yb1);
                float a0 = 0.f, a1 = 0.f;
#pragma unroll
                for (int k = 0; k < 3; ++k) {
                    const int pp = pos - 2 + k;
                    if (pp >= 0) { const unsigned w = *(const unsigned*)(Zc + (size_t)(b * SEQ + pp) * ZC_N + 512 + 2 * cp); a0 += wa[k][0] * bf_lo(w); a1 += wa[k][1] * bf_hi(w); }
                }
                const unsigned gw = *(const unsigned*)(Zc + tok * ZC_N + 2 * cp);
                *(unsigned*)(Y + tok * DM + 2 * cp) = pack_bf16(bf_lo(gw) * a0, bf_hi(gw) * a1);
            }
        }
        __syncthreads();
    }
}

#define MFMA32(a, b, c) __builtin_amdgcn_mfma_f32_32x32x16_bf16((a), (b), (c), 0, 0, 0)
constexpr int TK_HIST = 0;
constexpr int TK_TAB = 65536;
constexpr int TK_CAND = 65536 + 512;
constexpr int TK_CCNT = TK_CAND + 4096;
constexpr int TK_BQ = 73728;
DI int crow_c(int r) { return (r & 3) + 8 * (r >> 2); }
template <int PASS>
DI void topk_pass(const Frame& F, const bf16_t* Z, unsigned* maskg, int b, int t0, const float (&wp)[8]) {
    const LAS unsigned char* bq = F.lds + TK_BQ;
    LAS unsigned* hist = (LAS unsigned*)(F.lds + TK_HIST);
    LAS int* tab = (LAS int*)(F.lds + TK_TAB);
    LAS int* cand = (LAS int*)(F.lds + TK_CAND);
    LAS int* ccnt = (LAS int*)(F.lds + TK_CCNT);
    const int q = F.lane & 31, h2 = F.lane >> 5, ntile = t0 / 32 + 1;
    const int myT = (PASS >= 2) ? tab[q * 4 + 0] : 0;
    const bf16_t* kbase = Z + (size_t)b * SEQ * CD_N + Z_KI + 8 * h2;
    for (int kt = F.wave; kt < ntile; kt += NWAVE) {
        const bf16_t* kp = kbase + (size_t)(32 * kt + q) * CD_N;
        const bf16x8 A0l = *(const bf16x8*)kp, A1l = *(const bf16x8*)(kp + 16);
        const bf16x8 A0 = A0l, A1 = A1l;
        f32x16 sc;
#pragma unroll
        for (int r = 0; r < 16; ++r) sc[r] = 0.f;
        sc = MFMA32(A0, *(const LAS bf16x8*)(bq + (16 * 64 + F.lane) * 16), sc); sc = MFMA32(A1, *(const LAS bf16x8*)(bq + (17 * 64 + F.lane) * 16), sc);
#pragma unroll
        for (int r = 0; r < 16; ++r) sc[r] += 131072.0f;
#pragma unroll
        for (int h = 0; h < 8; ++h) {
            f32x16 ac;
#pragma unroll
            for (int r = 0; r < 16; ++r) ac[r] = 0.f;
            ac = MFMA32(A0, *(const LAS bf16x8*)(bq + ((2 * h) * 64 + F.lane) * 16), ac); ac = MFMA32(A1, *(const LAS bf16x8*)(bq + ((2 * h + 1) * 64 + F.lane) * 16), ac);
#pragma unroll
            for (int r = 0; r < 16; ++r) sc[r] += __builtin_fabsf(ac[r]) * wp[h];
        }
        const bool diag = (kt == ntile - 1);
        unsigned bits = 0u;
#pragma unroll
        for (int r = 0; r < 16; ++r) {
            int key = (int)sc[r]; key = key < 0 ? 0 : (key > 262143 ? 262143 : key);
            const bool valid = !diag || (crow_c(r) + 4 * h2 <= q);
            if (PASS == 1) { if (valid) __hip_atomic_fetch_add(&hist[q * 512 + (key >> 9)], 1u, __ATOMIC_RELAXED, __HIP_MEMORY_SCOPE_WORKGROUP); }
            else if (PASS == 2) { if (valid && (key >> 9) == myT) __hip_atomic_fetch_add(&hist[q * 512 + (key & 511)], 1u, __ATOMIC_RELAXED, __HIP_MEMORY_SCOPE_WORKGROUP); }
            else {
                if (valid && key > myT) bits |= 1u << crow_c(r);
                if (valid && key == myT) { const int p = __hip_atomic_fetch_add(&ccnt[q], 1, __ATOMIC_RELAXED, __HIP_MEMORY_SCOPE_WORKGROUP); if (p < 32) cand[q * 32 + p] = 32 * kt + crow_c(r) + 4 * h2; }
            }
        }
        if (PASS == 3) {
            bits <<= 4 * h2;
            bits |= (unsigned)__shfl_xor((int)bits, 32);
            if (h2 == 0) maskg[(size_t)(b * SEQ + t0 + q) * 256 + kt] = bits;
        }
    }
}
DI void topk_scan(const Frame& F, int pass, int t0) {
    LAS unsigned* hist = (LAS unsigned*)(F.lds + TK_HIST);
    LAS int* tab = (LAS int*)(F.lds + TK_TAB);
    for (int qi = 0; qi < 4; ++qi) {
        const int q = F.wave * 4 + qi, n = t0 + q + 1;
        int need = 256, prevT = 0, prevAbove = 0;
        if (pass == 2) { prevT = tab[q * 4 + 0]; prevAbove = tab[q * 4 + 1]; need = 256 - prevAbove; }
        if (n <= 256) { if (F.lane == 0) { tab[q * 4 + 0] = -1; tab[q * 4 + 1] = 0; tab[q * 4 + 2] = 0; } continue; }
        unsigned hv[8]; unsigned s = 0;
#pragma unroll
        for (int i = 0; i < 8; ++i) { hv[i] = hist[q * 512 + 511 - (8 * F.lane + i)]; s += hv[i]; }
        unsigned inc = s;
#pragma unroll
        for (int o = 1; o < 64; o <<= 1) { const unsigned v = (unsigned)__shfl_up((int)inc, o); if (F.lane >= o) inc += v; }
        const unsigned pre = inc - s;
        if ((int)pre < need && (int)inc >= need) {
            unsigned cum = pre; int bsel = 0; unsigned above = 0; bool found = false;
#pragma unroll
            for (int i = 0; i < 8; ++i) { if (!found && (int)(cum + hv[i]) >= need) { found = true; bsel = 511 - (8 * F.lane + i); above = cum; } cum += hv[i]; }
            if (pass == 1) { tab[q * 4 + 0] = bsel; tab[q * 4 + 1] = (int)above; }
            else { tab[q * 4 + 0] = (prevT << 9) | bsel; tab[q * 4 + 1] = prevAbove + (int)above; tab[q * 4 + 2] = 256 - (prevAbove + (int)above); }
        }
    }
}
DI void topk_phase(const Frame& F, const Args& a) {
    const bf16_t* Z = (const bf16_t*)(a.ws + WS_BIG);
    unsigned* maskg = (unsigned*)(a.ws + WS_MASK);
    LAS unsigned* hist = (LAS unsigned*)(F.lds + TK_HIST);
    LAS int* tab = (LAS int*)(F.lds + TK_TAB);
    LAS int* cand = (LAS int*)(F.lds + TK_CAND);
    LAS int* ccnt = (LAS int*)(F.lds + TK_CCNT);
    const int q = F.lane & 31, h2 = F.lane >> 5;
    for (int pi = F.bid; pi < 512; pi += F.G) {
        const int b = pi >> 7, p = pi & 127;
        for (int half = 0; half < 2; ++half) {
            const int t0 = 32 * (half ? 255 - p : p);
            const bf16_t* zr = Z + (size_t)(b * SEQ + t0 + q) * CD_N;
            float wp[8];
            { const u32x4 wv = *(const u32x4*)(zr + Z_WI);
              const float sc = 0.0625f * 0.5f * 16384.0f;
              wp[0] = bf_lo(wv[0]) * sc; wp[1] = bf_hi(wv[0]) * sc; wp[2] = bf_lo(wv[1]) * sc; wp[3] = bf_hi(wv[1]) * sc;
              wp[4] = bf_lo(wv[2]) * sc; wp[5] = bf_hi(wv[2]) * sc; wp[6] = bf_lo(wv[3]) * sc; wp[7] = bf_hi(wv[3]) * sc; }
            __syncthreads();
            if (F.wave == 0) {
                LAS unsigned char* bqw = F.lds + TK_BQ;
                float lin[2][8];
#pragma unroll
                for (int ks = 0; ks < 2; ++ks)
#pragma unroll
                    for (int j = 0; j < 8; ++j) lin[ks][j] = 0.f;
#pragma unroll
                for (int h = 0; h < 8; ++h)
#pragma unroll
                    for (int ks = 0; ks < 2; ++ks) {
                        const u32x4 v = *(const u32x4*)(zr + Z_QI + 32 * h + 16 * ks + 8 * h2);
                        *(LAS u32x4*)(bqw + ((2 * h + ks) * 64 + F.lane) * 16) = v;
#pragma unroll
                        for (int j = 0; j < 4; ++j) { lin[ks][2 * j] += wp[h] * bf_lo(v[j]); lin[ks][2 * j + 1] += wp[h] * bf_hi(v[j]); }
                    }
#pragma unroll
                for (int ks = 0; ks < 2; ++ks) {
                    u32x4 v; v[0] = pack_bf16(lin[ks][0], lin[ks][1]); v[1] = pack_bf16(lin[ks][2], lin[ks][3]); v[2] = pack_bf16(lin[ks][4], lin[ks][5]); v[3] = pack_bf16(lin[ks][6], lin[ks][7]);
                    *(LAS u32x4*)(bqw + ((16 + ks) * 64 + F.lane) * 16) = v;
                }
            }
            for (int i = F.tid; i < 32 * 512; i += NTHR) hist[i] = 0u;
            if (F.tid < 32) ccnt[F.tid] = 0;
            __syncthreads();
            topk_pass<1>(F, Z, maskg, b, t0, wp);
            __syncthreads();
            topk_scan(F, 1, t0);
            __syncthreads();
            for (int i = F.tid; i < 32 * 512; i += NTHR) hist[i] = 0u;
            __syncthreads();
            topk_pass<2>(F, Z, maskg, b, t0, wp);
            __syncthreads();
            topk_scan(F, 2, t0);
            __syncthreads();
            topk_pass<3>(F, Z, maskg, b, t0, wp);
            __threadfence();
            __syncthreads();
            if (F.tid < 32) {
                const int qq = F.tid, need = tab[qq * 4 + 2]; int nc = ccnt[qq]; nc = nc > 32 ? 32 : nc;
                if (tab[qq * 4 + 0] >= 0) {
                    int last = -1;
                    for (int k = 0; k < need && k < nc; ++k) {
                        int best = 0x7fffffff;
                        for (int i = 0; i < nc; ++i) { const int v = cand[qq * 32 + i]; if (v > last && v < best) best = v; }
                        if (best == 0x7fffffff) break;
                        atomicOr(&maskg[(size_t)(b * SEQ + t0 + qq) * 256 + (best >> 5)], 1u << (best & 31));
                        last = best;
                    }
                }
            }
            __syncthreads();
        }
    }
}

constexpr int AT_KSTR = 72;
constexpr int AT_VSTR = 68;
constexpr int AT_KBYTES = 64 * AT_KSTR * 2;
constexpr int AT_VBYTES = 128 * AT_VSTR * 2;
constexpr int AT_BUF = AT_KBYTES + AT_VBYTES;
constexpr int AT_LUT = 2 * AT_BUF;
constexpr int AT_LUT_LD = 132;
constexpr float NEG_INF = -__builtin_huge_valf();

template <int DV, bool MASKED>
DI void attn_core(const Frame& F, const bf16_t* Z, int b, int qcol, int kcol, int vcol, int q0, const LAS float* lut, float c1, const unsigned* maskg, f32x16 (&O)[DV / 32]) {
    constexpr int NDV = DV / 32;
    const int q = F.lane & 31, h2 = F.lane >> 5;
    const int tw0 = q0 + 32 * F.wave, t = tw0 + q;
    const bf16_t* Zb = Z + (size_t)b * SEQ * CD_N;
    bf16x8 Qf[4];
#pragma unroll
    for (int ks = 0; ks < 4; ++ks) Qf[ks] = *(const bf16x8*)(Zb + (size_t)t * CD_N + qcol + 16 * ks + 8 * h2);
#pragma unroll
    for (int d = 0; d < NDV; ++d)
#pragma unroll
        for (int r = 0; r < 16; ++r) O[d][r] = 0.f;
    float m_run = NEG_INF, l_run = 0.f;
    const int jmax = (q0 + 255) >> 6;
    const int kkey = F.tid >> 3, kch = F.tid & 7;
    u32x4 kreg, vreg[DV / 64];
#define AT_LOAD(j) do { kreg = *(const u32x4*)(Zb + (size_t)(64 * (j) + kkey) * CD_N + kcol + 8 * kch); \
        _Pragma("unroll") for (int _i = 0; _i < DV / 64; ++_i) { const int idx = F.tid + NTHR * _i; vreg[_i] = *(const u32x4*)(Zb + (size_t)(64 * (j) + (idx & 63)) * CD_N + vcol + 8 * (idx >> 6)); } } while (0)
#define AT_STORE(buf) do { LAS unsigned char* kb_ = F.lds + (buf) * AT_BUF; *(LAS u32x4*)(kb_ + kkey * (AT_KSTR * 2) + kch * 16) = kreg; \
        LAS bf16_t* vt_ = (LAS bf16_t*)(kb_ + AT_KBYTES); \
        _Pragma("unroll") for (int _i = 0; _i < DV / 64; ++_i) { const int idx = F.tid + NTHR * _i, key_ = idx & 63, ch_ = idx >> 6; \
            _Pragma("unroll") for (int e_ = 0; e_ < 4; ++e_) { vt_[(8 * ch_ + 2 * e_) * AT_VSTR + key_] = (bf16_t)(vreg[_i][e_] & 0xffffu); vt_[(8 * ch_ + 2 * e_ + 1) * AT_VSTR + key_] = (bf16_t)(vreg[_i][e_] >> 16); } } } while (0)
    AT_LOAD(0); AT_STORE(0);
    __syncthreads();
    for (int j = 0; j <= jmax; ++j) {
        if (j < jmax) AT_LOAD(j + 1);
        if (64 * j <= tw0 + 31) {
            const LAS unsigned char* kb = F.lds + (j & 1) * AT_BUF;
            const LAS unsigned char* vt = kb + AT_KBYTES;
            f32x16 s[2];
#pragma unroll
            for (int kb2 = 0; kb2 < 2; ++kb2) {
#pragma unroll
                for (int r = 0; r < 16; ++r) s[kb2][r] = 0.f;
#pragma unroll
                for (int ks = 0; ks < 4; ++ks) {
                    const bf16x8 A = *(const LAS bf16x8*)(kb + (32 * kb2 + q) * (AT_KSTR * 2) + (16 * ks + 8 * h2) * 2);
                    s[kb2] = MFMA32(A, Qf[ks], s[kb2]);
                }
            }
            const bool nearb = (64 * j + 63 + 128 > tw0);
            float mloc = NEG_INF;
            if (!nearb) {
                const float c0 = lut[128];
#pragma unroll
                for (int kb2 = 0; kb2 < 2; ++kb2)
#pragma unroll
                    for (int r = 0; r < 16; ++r) { s[kb2][r] = s[kb2][r] * c1 + c0; mloc = fmaxf(mloc, s[kb2][r]); }
            } else {
#pragma unroll
                for (int kb2 = 0; kb2 < 2; ++kb2)
#pragma unroll
                    for (int r = 0; r < 16; ++r) {
                        const int dist = t - (64 * j + 32 * kb2 + crow_c(r) + 4 * h2);
                        const float bl = lut[dist < 0 ? 0 : (dist > 128 ? 128 : dist)];
                        s[kb2][r] = dist < 0 ? NEG_INF : s[kb2][r] * c1 + bl; mloc = fmaxf(mloc, s[kb2][r]);
                    }
            }
            mloc = fmaxf(mloc, __shfl_xor(mloc, 32));
            const float m_new = fmaxf(m_run, mloc);
            const float alpha = __builtin_amdgcn_exp2f(m_run - m_new);
            m_run = m_new;
            float psum = 0.f;
#pragma unroll
            for (int kb2 = 0; kb2 < 2; ++kb2) {
                unsigned mw = 0u;
                if (MASKED) mw = maskg[(size_t)(b * SEQ + t) * 256 + 2 * j + kb2] >> (4 * h2);
#pragma unroll
                for (int r = 0; r < 16; ++r) {
                    float p = __builtin_amdgcn_exp2f(s[kb2][r] - m_new);
                    if (MASKED) p = ((mw >> crow_c(r)) & 1u) ? p : 0.f;
                    s[kb2][r] = p; psum += p;
                }
            }
            l_run = l_run * alpha + psum;
#pragma unroll
            for (int d = 0; d < NDV; ++d)
#pragma unroll
                for (int r = 0; r < 16; ++r) O[d][r] *= alpha;
#pragma unroll
            for (int kb2 = 0; kb2 < 2; ++kb2)
#pragma unroll
                for (int s2 = 0; s2 < 2; ++s2) {
                    u32x4 pw;
#pragma unroll
                    for (int e = 0; e < 4; ++e) pw[e] = pack_bf16(s[kb2][8 * s2 + 2 * e], s[kb2][8 * s2 + 2 * e + 1]);
                    const bf16x8 Pf = __builtin_bit_cast(bf16x8, pw);
#pragma unroll
                    for (int d = 0; d < NDV; ++d) {
                        const LAS unsigned char* vp = vt + (32 * d + q) * (AT_VSTR * 2) + (32 * kb2 + 16 * s2 + 4 * h2) * 2;
                        const u32x2 lo = *(const LAS u32x2*)vp, hi = *(const LAS u32x2*)(vp + 16);
                        u32x4 av; av[0] = lo[0]; av[1] = lo[1]; av[2] = hi[0]; av[3] = hi[1];
                        O[d] = MFMA32(__builtin_bit_cast(bf16x8, av), Pf, O[d]);
                    }
                }
        }
        if (j < jmax) AT_STORE((j + 1) & 1);
        __syncthreads();
    }
#undef AT_LOAD
#undef AT_STORE
    const float lt = l_run + __shfl_xor(l_run, 32);
    const float inv = 1.0f / lt;
#pragma unroll
    for (int d = 0; d < NDV; ++d)
#pragma unroll
        for (int r = 0; r < 16; ++r) O[d][r] *= inv;
}

DI float rel_bucket_bias(const float* rel_bias, int d, int head) {
    int bkt;
    if (d < 16) bkt = d;
    else { const float lr = __logf((float)d * (1.0f / 16.0f)) / 2.0794415416798357f; int l = 16 + (int)(lr * 16.0f); bkt = l < 31 ? l : 31; }
    return rel_bias[bkt * 12 + head];
}
DI void attn_phase(const Frame& F, const Args& a) {
    const bf16_t* Z = (const bf16_t*)(a.ws + WS_BIG);
    bf16_t* Yo = (bf16_t*)(a.ws + WS_Y);
    float* O1s = (float*)(a.ws + WS_H);
    const unsigned* maskg = (const unsigned*)(a.ws + WS_MASK);
    LAS float* lut = (LAS float*)(F.lds + AT_LUT);
    for (int i = F.tid; i < 12 * 129; i += NTHR) { const int hh = i / 129, d = i % 129; lut[hh * AT_LUT_LD + d] = rel_bucket_bias(a.rel_bias, d, hh) * LOG2E; }
    float lam;
    { float d01 = 0.f, d23 = 0.f; for (int i = 0; i < 64; ++i) { d01 += a.diff_lam[i] * a.diff_lam[64 + i]; d23 += a.diff_lam[128 + i] * a.diff_lam[192 + i]; }
      lam = __expf(d01) - __expf(d23) + 0.35550906759096f; }
    const float one_m_li = 1.0f - 0.35550906759096f;
    __syncthreads();
    const float c1 = 0.125f * LOG2E;
    const int q = F.lane & 31, h2 = F.lane >> 5;
    const int xcd = F.bid & 7, kk = F.bid >> 3;
    for (int it = F.bid; it < 256; it += F.G) {
        const int bh = (F.G == 256) ? 2 * xcd + (kk >> 4) : it >> 4, pr = (F.G == 256) ? (kk & 15) : (it & 15);
        const int b = bh >> 2, hd = bh & 3;
        for (int half = 0; half < 2; ++half) {
            const int q0 = 256 * (half ? 31 - pr : pr), t = q0 + 32 * F.wave + q;
            f32x16 O[4];
            attn_core<128, false>(F, Z, b, Z_QD + 128 * hd, Z_KD + 128 * hd, Z_VD + 128 * hd, q0, lut + (8 + hd) * AT_LUT_LD, c1, nullptr, O);
            float* o1p = O1s + (size_t)(b * SEQ + t) * 512 + 128 * hd;
#pragma unroll
            for (int d = 0; d < 4; ++d)
#pragma unroll
                for (int g = 0; g < 4; ++g) *(f32x4*)(o1p + 32 * d + 8 * g + 4 * h2) = (f32x4){O[d][4 * g], O[d][4 * g + 1], O[d][4 * g + 2], O[d][4 * g + 3]};
            attn_core<128, false>(F, Z, b, Z_QD + 128 * hd + 64, Z_KD + 128 * hd + 64, Z_VD + 128 * hd, q0, lut + (8 + hd) * AT_LUT_LD, c1, nullptr, O);
            float ss = 0.f;
#pragma unroll
            for (int d = 0; d < 4; ++d)
#pragma unroll
                for (int g = 0; g < 4; ++g) {
                    const f32x4 o1 = *(const f32x4*)(o1p + 32 * d + 8 * g + 4 * h2);
#pragma unroll
                    for (int e = 0; e < 4; ++e) { const float v = o1[e] - lam * O[d][4 * g + e]; O[d][4 * g + e] = v; ss += v * v; }
                }
            ss += __shfl_xor(ss, 32);
            const float rinv = rsqrtf(ss * (1.0f / 128.0f) + EPS) * one_m_li;
            bf16_t* yp = Yo + (size_t)(b * SEQ + t) * DM + 512 + 128 * hd;
#pragma unroll
            for (int d = 0; d < 4; ++d)
#pragma unroll
                for (int g = 0; g < 4; ++g) {
                    const int dv = 32 * d + 8 * g + 4 * h2;
                    const f32x4 gn = *(const f32x4*)(a.diff_norm_g + dv);
                    f32x4 v; v[0] = O[d][4 * g] * rinv * gn[0]; v[1] = O[d][4 * g + 1] * rinv * gn[1]; v[2] = O[d][4 * g + 2] * rinv * gn[2]; v[3] = O[d][4 * g + 3] * rinv * gn[3];
                    *(u32x2*)(yp + dv) = pack4(v);
                }
        }
    }
    for (int it = F.bid; it < 512; it += F.G) {
        const int rnd = it / F.G;
        const int bh = (F.G == 256) ? 4 * xcd + 2 * rnd + (kk >> 4) : it >> 4, pr = (F.G == 256) ? (kk & 15) : (it & 15);
        const int b = bh >> 3, hc = bh & 7;
        for (int half = 0; half < 2; ++half) {
            const int q0 = 256 * (half ? 31 - pr : pr), t = q0 + 32 * F.wave + q;
            f32x16 O[2];
            attn_core<64, true>(F, Z, b, Z_QC + 64 * hc, Z_KC + 64 * hc, Z_VC + 64 * hc, q0, lut + hc * AT_LUT_LD, c1, maskg, O);
            bf16_t* yp = Yo + (size_t)(b * SEQ + t) * DM + 64 * hc;
#pragma unroll
            for (int d = 0; d < 2; ++d)
#pragma unroll
                for (int g = 0; g < 4; ++g) {
                    f32x4 v = {O[d][4 * g], O[d][4 * g + 1], O[d][4 * g + 2], O[d][4 * g + 3]};
                    *(u32x2*)(yp + 32 * d + 8 * g + 4 * h2) = pack4(v);
                }
        }
    }
}

#ifndef MK_ONE_LAUNCH
#define MK_ONE_LAUNCH 1
#endif
constexpr int NPH = 17;
__global__ void __launch_bounds__(NTHR, 2) fwd_kernel(Args a) {
    extern __shared__ __attribute__((aligned(16))) unsigned char lds_raw[];
    Frame F; F.lds = (LAS unsigned char*)lds_raw; F.tid = threadIdx.x; F.lane = F.tid & 63; F.wave = __builtin_amdgcn_readfirstlane(F.tid >> 6); F.G = gridDim.x; F.bid = blockIdx.x;
    unsigned* ctl = (unsigned*)(a.ws + WS_CTL);
    volatile LAS unsigned* xbw = (volatile LAS unsigned*)(F.lds + LDS_XB);
    if (F.tid < 4) xbw[F.tid] = 0u;
    __syncthreads();
    const int lo = a.ph_lo, hi = a.ph_hi;
    XcdBarrier bar; bar.bar = ctl + CW_BAR; bar.x = 0; bar.st = xbw;
    if (hi - lo > 1) bar = xcd_barrier_post(ctl + CW_BAR, xbw);
#ifndef PH_ONLY
#define IN(k) (lo <= (k) && (k) < hi)
#else
#define IN(k) ((k) == PH_ONLY && lo <= (k) && (k) < hi)
#endif
#ifndef DUP_PH
#define DUP_PH -1
#endif
#define REP(k) for (int rep_ = 0; rep_ < ((k) == DUP_PH ? 2 : 1); ++rep_)
#ifndef TIME_PH
#define TIME_PH -1
#endif
#define TIME_AMP 4
    unsigned long long tp0_ = 0, tp1_ = 0;
    if (TIME_PH == 0) tp0_ = wall_clock64();
#define SEAM(k) do { if (IN(k) && IN((k) + 1)) xcd_barrier(bar); if ((k) == TIME_PH) tp1_ = wall_clock64(); if ((k) + 1 == TIME_PH) tp0_ = wall_clock64(); } while (0)
    float* mod = (float*)(a.ws + WS_MOD);
    bf16_t* hbuf = (bf16_t*)(a.ws + WS_H);
    bf16_t* ybuf = (bf16_t*)(a.ws + WS_Y);
    LAS int* ntp = (LAS int*)(F.lds + LDS_MISC);

    if (IN(0)) REP(0) { p0_prologue(F, a); } SEAM(0);
    if (IN(1)) REP(1) { norm_phase<false, false, false>(F, a, a.x, 0, 0, 0); } SEAM(1);
    if (IN(2)) REP(2) {
        DenseSched S; S.init(NTOK, AB_N, DM, F.G, F.bid, a.ws + WS_WAB_IN);
        EpiAbIn E{(bf16_t*)(a.ws + WS_BIG)};
        pg8::gemm_phase(F.lds, (const char*)hbuf, DM, S, E);
    } SEAM(2);
    if (IN(3)) REP(3) { conv_phase(F, a); } SEAM(3);
    if (IN(4)) REP(4) {
        DenseSched S; S.init(NTOK, DM, DM, F.G, F.bid, a.ws + WS_WAB_OUT);
        EpiResid E{a.x, a.out, mod + 2 * DM};
        pg8::gemm_phase(F.lds, (const char*)ybuf, DM, S, E);
    } SEAM(4);
#define MOE_PHASES(layer, pb) do { \
        const unsigned* cnt = ctl + CW_CNT + (layer) * NEXP * CNT_STRIDE; \
        if (IN(pb)) { norm_phase<false, true, false>(F, a, a.out, (layer), 1, 0); } SEAM(pb); \
        if (IN((pb) + 1)) REP((pb) + 1) { \
            moe_tile_table(F, cnt, ntp); \
            MoeSched<true> S; S.ntp = ntp; S.cnt = cnt; S.list = (const int*)(a.ws + WS_LIST); S.W = (const char*)(a.ws + WS_MOE_W); S.nU = 4 * ntp[NEXP]; S.G = F.G; S.c = F.bid; \
            EpiMoeUp E{(bf16_t*)(a.ws + WS_ACT)}; \
            pg8::gemm_phase(F.lds, (const char*)hbuf, DM, S, E); \
        } SEAM((pb) + 1); \
        if (IN((pb) + 2)) REP((pb) + 2) { \
            moe_tile_table(F, cnt, ntp); \
            MoeSched<false> S; S.ntp = ntp; S.cnt = cnt; S.list = nullptr; S.W = (const char*)(a.ws + WS_MOE_W); S.nU = 4 * ntp[NEXP]; S.G = F.G; S.c = F.bid; \
            EpiMoeDown E{(bf16_t*)(a.ws + WS_YMOE), (const float*)(a.ws + WS_GATEV), ntp}; \
            pg8::gemm_phase(F.lds, (const char*)(a.ws + WS_ACT), DEXP, S, E); \
        } SEAM((pb) + 2); } while (0)
    MOE_PHASES(0, 5);
    if (IN(8)) {
        norm_phase<true, false, false>(F, a, a.out, 1, 0, 0);
        for (int it = F.bid; it < CVT_MOE_TILES; it += F.G) cvt_moe_item(F, a, 1, it);
    } SEAM(8);
    if (IN(9)) REP(9) {
        DenseSched S; S.init(NTOK, CD_N, DM, F.G, F.bid, a.ws + WS_WCD_IN);
        EpiPlain E{(bf16_t*)(a.ws + WS_BIG), CD_N};
        pg8::gemm_phase(F.lds, (const char*)hbuf, DM, S, E);
    } SEAM(9);
    if (IN(10)) REP(10) { topk_phase(F, a); } SEAM(10);
    if (IN(11)) REP(11) { attn_phase(F, a); } SEAM(11);
    if (IN(12)) {
        DenseSched S; S.init(NTOK, DM, DM, F.G, F.bid, a.ws + WS_WCD_OUT);
        EpiResid E{a.out, a.out, mod + (size_t)NB * 6 * DM + 2 * DM};
        pg8::gemm_phase(F.lds, (const char*)ybuf, DM, S, E);
    } SEAM(12);
    MOE_PHASES(1, 13);
#undef MOE_PHASES
    if (IN(16)) { norm_phase<true, false, true>(F, a, a.out, 1, 0, 1); }
    if (TIME_PH >= 0) {
        if (TIME_PH == 16) { asm volatile("s_waitcnt vmcnt(0)" ::: "memory"); __syncthreads(); tp1_ = wall_clock64(); }
        if (F.bid == 0 && F.tid == 0) { const unsigned long long te = wall_clock64(), dt = (tp1_ - tp0_) * TIME_AMP; while (wall_clock64() - te < dt) __builtin_amdgcn_s_sleep(8); }
    }
#undef IN
#undef SEAM
}

extern "C" void kernel_launch(void* const* d_in, const int* in_sizes, int n_in, void* d_out, int out_size, void* d_ws, size_t ws_size, hipStream_t stream) {
    static int grid = 0;
    if (grid == 0) {
        if (n_in != 26 || out_size != NTOK * DM || ws_size < WS_END) { fprintf(stderr, "kernel_launch: unexpected problem (n_in %d, out %d, ws %zu < %zu)\n", n_in, out_size, ws_size, (size_t)WS_END); grid = -1; return; }
        int dev = 0, cus = 0, per_cu = 0;
        if (hipGetDevice(&dev) != hipSuccess || hipDeviceGetAttribute(&cus, hipDeviceAttributeMultiprocessorCount, dev) != hipSuccess) { grid = -1; return; }
        if (hipFuncSetAttribute((const void*)fwd_kernel, hipFuncAttributeMaxDynamicSharedMemorySize, LDS_BYTES) != hipSuccess) { fprintf(stderr, "kernel_launch: hipFuncSetAttribute failed\n"); grid = -1; return; }
        if (hipOccupancyMaxActiveBlocksPerMultiprocessor(&per_cu, (const void*)fwd_kernel, NTHR, LDS_BYTES) != hipSuccess || per_cu < 1) { fprintf(stderr, "kernel_launch: occupancy query says %d\n", per_cu); }
        (void)hipGetLastError();
        grid = cus;
    }
    if (grid < 0) return;
    (void)hipMemsetAsync((char*)d_ws + WS_CTL, 0, CTL_BYTES, stream);
    Args a{};
    const float** fp = (const float**)&a.x;
    (void)fp;
    a.x = (const float*)d_in[0]; a.c = (const float*)d_in[1]; a.positions = (const int*)d_in[2]; a.rel_bias = (const float*)d_in[3]; a.norm_g = (const float*)d_in[4];
    a.final_norm_g = (const float*)d_in[5]; a.ada_w = (const float*)d_in[6]; a.ada_b = (const float*)d_in[7]; a.ab_w_in = (const float*)d_in[8]; a.ab_conv_a = (const float*)d_in[9];
    a.ab_conv_b = (const float*)d_in[10]; a.ab_conv_b_bias = (const float*)d_in[11]; a.ab_ln_g = (const float*)d_in[12]; a.ab_ln_b = (const float*)d_in[13]; a.ab_w_out = (const float*)d_in[14];
    a.cd_w_in = (const float*)d_in[15]; a.diff_lam = (const float*)d_in[16]; a.diff_norm_g = (const float*)d_in[17]; a.cd_w_out = (const float*)d_in[18];
    a.moe_wr_g = (const float*)d_in[19]; a.moe_br_g = (const float*)d_in[20]; a.moe_wr_e = (const float*)d_in[21]; a.moe_br_e = (const float*)d_in[22];
    a.moe_w_gate = (const float*)d_in[23]; a.moe_w_up = (const float*)d_in[24]; a.moe_w_down = (const float*)d_in[25];
    a.out = (float*)d_out; a.ws = (unsigned char*)d_ws;
#if MK_ONE_LAUNCH
    a.ph_lo = 0; a.ph_hi = NPH;
    hipLaunchKernelGGL(fwd_kernel, dim3(grid), dim3(NTHR), LDS_BYTES, stream, a);
#else
    for (int p = 0; p < NPH; ++p) { a.ph_lo = p; a.ph_hi = p + 1; hipLaunchKernelGGL(fwd_kernel, dim3(grid), dim3(NTHR), LDS_BYTES, stream, a); }
#endif
}
```

```cpp
#include <hip/hip_runtime.h>
#include <cstdio>
#include <cstdint>

#define LAS __attribute__((address_space(3)))
#define DI __device__ __forceinline__
typedef unsigned short bf16_t;
typedef short bf16x8 __attribute__((ext_vector_type(8)));
typedef short s16x4 __attribute__((ext_vector_type(4)));
typedef float f32x2 __attribute__((ext_vector_type(2)));
typedef float f32x4 __attribute__((ext_vector_type(4)));
typedef float f32x16 __attribute__((ext_vector_type(16)));
typedef unsigned u32x2 __attribute__((ext_vector_type(2)));
typedef unsigned u32x4 __attribute__((ext_vector_type(4)));
typedef __bf16 bf16v2 __attribute__((ext_vector_type(2)));

constexpr int NB = 4, SEQ = 8192, DM = 1024, NTOK = NB * SEQ;
constexpr int NTHR = 512, NWAVE = 8;
constexpr int AB_N = 2560;
constexpr int ZC_N = 1536;
constexpr int CD_SRC_N = 3368;
constexpr int CD_N = 2560;
constexpr int Z_QC = 0, Z_KC = 512, Z_QD = 1024, Z_KD = 1536, Z_QI = 2048, Z_KI = 2304, Z_WI = 2336;
constexpr int VT_C = 0, VT_D = 512;
constexpr int NEXP = 32, DEXP = 512;
constexpr int MOE_ROWS = 2 * NTOK + NEXP * 256;
constexpr float EPS = 1e-6f;
constexpr float LOG2E = 1.4426950408889634f;

constexpr size_t MiB = 1u << 20;
constexpr size_t WS_CTL = 0, CTL_BYTES = 64 * 1024;
constexpr size_t WS_MOD = 1 * MiB;
constexpr size_t WS_WAB_IN = 2 * MiB;
constexpr size_t WS_WAB_OUT = 7 * MiB;
constexpr size_t WS_WCD_IN = 9 * MiB;
constexpr size_t WS_WCD_OUT = 16 * MiB;
constexpr size_t WS_MOE_W = 18 * MiB;
constexpr size_t WS_H = 114 * MiB;
constexpr size_t WS_Y = 178 * MiB;
constexpr size_t WS_BIG = 242 * MiB;
constexpr size_t WS_ACT = WS_BIG;
constexpr size_t WS_YMOE = WS_BIG + 72 * MiB;
constexpr size_t WS_VT = WS_BIG + 160 * MiB;
constexpr size_t WS_MASK = 466 * MiB;
constexpr size_t WS_LIST = 498 * MiB;
constexpr size_t WS_GATEV = 502 * MiB;
constexpr size_t WS_TOKSLOT = 506 * MiB;
constexpr size_t WS_END = 507 * MiB;

constexpr int CW_BAR = 0;
constexpr int CW_CNT = 4096;
constexpr int CNT_STRIDE = 64;

DI unsigned pack_bf16(float lo, float hi) { f32x2 v = {lo, hi}; bf16v2 b = __builtin_convertvector(v, bf16v2); return __builtin_bit_cast(unsigned, b); }
DI float bf_lo(unsigned w) { return __uint_as_float(w << 16); }
DI float bf_hi(unsigned w) { return __uint_as_float(w & 0xffff0000u); }
DI float bf2f(bf16_t b) { return __uint_as_float(((unsigned)b) << 16); }
DI float wave_sum(float v) {
#pragma unroll
    for (int o = 32; o >= 1; o >>= 1) v += __shfl_xor(v, o);
    return v;
}
DI float silu_f(float v) { return v / (1.0f + __expf(-v)); }
DI float sigmoid_f(float v) { return 1.0f / (1.0f + __expf(-v)); }

#define XB_TMO      128
#define XB_XCNT(j)  (256  + 64 * (j))
#define XB_XSUB(j)  (1280 + 64 * (j))
#define XB_XGEN(j)  (2304 + 64 * (j))
#define XB_TOP      3328
#define XB_TOPGEN   3392
#define XCD_BAR_WORDS 3456
#define XB_SPIN_CAP (1u << 22)
DI unsigned xb_ld(unsigned* p)              { return __hip_atomic_load(p, __ATOMIC_RELAXED, __HIP_MEMORY_SCOPE_AGENT); }
DI unsigned xb_add(unsigned* p, unsigned v) { return __hip_atomic_fetch_add(p, v, __ATOMIC_RELAXED, __HIP_MEMORY_SCOPE_AGENT); }
DI unsigned xb_xcc_id() { return (unsigned)__builtin_amdgcn_s_getreg((3 << 11) | 20) & 0xFu; }
#define XB_SPIN(cond, bar) do { unsigned _sp = 0; while (cond) { __builtin_amdgcn_s_sleep(1); \
    if ((++_sp & 255u) == 0u) { if (xb_ld(&(bar)[XB_TMO])) break; if (_sp > XB_SPIN_CAP) { atomicAdd(&(bar)[XB_TMO], 1u); break; } } } } while (0)
struct XcdBarrier { unsigned* bar; unsigned x; volatile LAS unsigned* st; };
DI XcdBarrier xcd_barrier_post(unsigned* bar, volatile LAS unsigned* st) {
    XcdBarrier b; b.bar = bar; b.x = xb_xcc_id(); b.st = st;
    if (threadIdx.x == 0) (void)xb_add(&bar[XB_XCNT(b.x)], 1u);
    return b;
}
DI void xcd_barrier_complete(unsigned* bar, unsigned x, unsigned& nloc, unsigned& nx) {
    const unsigned G = gridDim.x * gridDim.y * gridDim.z;
    unsigned sum, cnt, mine, sp = 0u;
    for (;;) {
        sum = 0u; cnt = 0u; mine = 0u;
#pragma unroll
        for (unsigned j = 0; j < 16; ++j) { const unsigned c = xb_ld(&bar[XB_XCNT(j)]); sum += c; cnt += (c > 0u) ? 1u : 0u; mine = (j == x) ? c : mine; }
        if (sum == G) break;
        __builtin_amdgcn_s_sleep(1);
        if ((++sp & 255u) == 0u) { if (xb_ld(&bar[XB_TMO])) break; if (sp > XB_SPIN_CAP) { atomicAdd(&bar[XB_TMO], 1u); break; } }
    }
    nloc = mine > 0u ? mine : 1u; nx = cnt > 0u ? cnt : 1u;
}
DI void xcd_barrier(const XcdBarrier& b) {
    asm volatile("s_waitcnt vmcnt(0)" ::: "memory");
    __syncthreads();
    if (threadIdx.x == 0) {
        unsigned* bar = b.bar;
        __builtin_amdgcn_s_waitcnt(0);
        unsigned nloc = b.st[0], nx = b.st[1];
        if (nloc == 0u) { xcd_barrier_complete(bar, b.x, nloc, nx); b.st[0] = nloc; b.st[1] = nx; }
        const unsigned old = xb_add(&bar[XB_XSUB(b.x)], 1u);
        const unsigned gen = old / nloc;
        if (old + 1u == (gen + 1u) * nloc) {
            __builtin_amdgcn_fence(__ATOMIC_RELEASE, "agent");
            asm volatile("s_waitcnt vmcnt(0)" ::: "memory");
            const unsigned og = xb_add(&bar[XB_TOP], 1u);
            const unsigned tg = og / nx;
            if (og + 1u == (tg + 1u) * nx) xb_add(&bar[XB_TOPGEN], 1u);
            else XB_SPIN(xb_ld(&bar[XB_TOPGEN]) == tg, bar);
            __builtin_amdgcn_fence(__ATOMIC_ACQUIRE, "agent");
            xb_add(&bar[XB_XGEN(b.x)], 1u);
            asm volatile("s_waitcnt vmcnt(0)" ::: "memory");
        } else {
            XB_SPIN(xb_ld(&bar[XB_XGEN(b.x)]) == gen, bar);
            __builtin_amdgcn_fence(__ATOMIC_ACQUIRE, "agent");
            asm volatile("s_waitcnt vmcnt(0)" ::: "memory");
        }
    }
    __syncthreads();
}

namespace pg8 {
constexpr int BM = 256, BK = 64, HALF = 128, HTB = HALF * BK * 2, STAGE_BYTES = 8 * HTB;
DI int lds_byte(int r, int c) { const int st = (r >> 4) * 2 + (c >> 5), rr = r & 15, cc = c & 31, ob = rr * 64 + cc * 2; return st * 1024 + (ob ^ (((ob >> 9) & 1) << 5)); }
DI void stage_rc(int b, int& R, int& C) { const int st = b / 1024, sb = b % 1024, swz = sb ^ (((sb >> 9) & 1) << 5); R = (st >> 1) * 16 + swz / 64; C = (st & 1) * 32 + (swz % 64) / 2; }
struct Unit { int pm, pn, e, nrow; };

template <class Epi, class Sched>
DI void gemm_phase(LAS unsigned char* lds, const char* Abase, const int K, const Sched& S, const Epi& E) {
    const int tid = threadIdx.x, wid = __builtin_amdgcn_readfirstlane(tid >> 6), lane = tid & 63, wr = wid >> 2, wc = wid & 3, fr = lane & 15, fq = lane >> 4;
    const int nt = K / BK;
    int Rr[2], Cc[2]; unsigned voffB[2];
#pragma unroll
    for (int i = 0; i < 2; ++i) { int R, C; stage_rc(tid * 16 + i * 8192, R, C); Rr[i] = R; Cc[i] = C; voffB[i] = (unsigned)(R * K + C) * 2u; }
    const size_t kstep = (size_t)(BK * 2);
    const size_t hstep = (size_t)HALF * K * 2;
    const unsigned ldsw = (unsigned)wid * 1024u;
    const int aoff = lds_byte(wr * 64 + fr, fq * 8), boff = lds_byte(wc * 32 + fr, fq * 8);
#define PG8_SA(b, h) (((b) * 2 + (h)) * HTB)
#define PG8_SB(b, h) ((4 + (b) * 2 + (h)) * HTB)
#define PG8_STAGE(bufoff, gbase, voff) do { _Pragma("unroll") for (int _i = 0; _i < 2; ++_i) \
        __builtin_amdgcn_global_load_lds((const unsigned*)((const char*)(gbase) + (voff)[_i]), (LAS unsigned*)(lds + (bufoff) + ldsw + _i * 8192), 16, 0, 0); } while (0)
#define PG8_AOFF(dst, u) do { _Pragma("unroll") for (int _h = 0; _h < 2; ++_h) _Pragma("unroll") for (int _i = 0; _i < 2; ++_i) \
        dst[_h][_i] = ((unsigned)S.a_row(u, _h * HALF + Rr[_i]) * (unsigned)K + (unsigned)Cc[_i]) * 2u; } while (0)
#define PG8_LDA(dst, b, h) do { _Pragma("unroll") for (int m = 0; m < 4; ++m) _Pragma("unroll") for (int k = 0; k < 2; ++k) dst[m][k] = *(const LAS bf16x8*)(lds + PG8_SA(b, h) + aoff + m * 2048 + k * 1024); } while (0)
#define PG8_LDB(dst, b, h) do { _Pragma("unroll") for (int n = 0; n < 2; ++n) _Pragma("unroll") for (int k = 0; k < 2; ++k) dst[n][k] = *(const LAS bf16x8*)(lds + PG8_SB(b, h) + boff + n * 2048 + k * 1024); } while (0)
#define PG8_MMA(ai, bj, At, Bt) do { __builtin_amdgcn_s_setprio(1); _Pragma("unroll") for (int m = 0; m < 4; ++m) _Pragma("unroll") for (int n = 0; n < 2; ++n) _Pragma("unroll") for (int k = 0; k < 2; ++k) \
        acc[ai][bj][m][n] = __builtin_amdgcn_mfma_f32_16x16x32_bf16(Bt[n][k], At[m][k], acc[ai][bj][m][n], 0, 0, 0); __builtin_amdgcn_s_setprio(0); } while (0)
#define PG8_WAIT_V(n) asm volatile("s_waitcnt vmcnt(" #n ")" ::: "memory")
#define PG8_WAIT_L(n) asm volatile("s_waitcnt lgkmcnt(" #n ")" ::: "memory")
#define PG8_BAR __builtin_amdgcn_s_barrier()
#define PG8_SCHED __builtin_amdgcn_sched_barrier(0)
    Unit cur, nxt; int ui = 0;
    if (!S.next(0, cur)) return;
    f32x4 acc[2][2][4][2];
#pragma unroll
    for (int a = 0; a < 2; ++a)
#pragma unroll
        for (int b = 0; b < 2; ++b)
#pragma unroll
            for (int m = 0; m < 4; ++m)
#pragma unroll
                for (int n = 0; n < 2; ++n) acc[a][b][m][n] = (f32x4){0.f, 0.f, 0.f, 0.f};
    bf16x8 At[4][2], B0[2][2], B1[2][2];
    unsigned aoC[2][2], aoN[2][2];
    PG8_AOFF(aoC, cur);
    const char* cB = S.b_base(cur);
    PG8_STAGE(PG8_SB(0, 0), cB, voffB); PG8_STAGE(PG8_SA(0, 0), Abase, aoC[0]); PG8_STAGE(PG8_SB(0, 1), cB + hstep, voffB); PG8_STAGE(PG8_SA(0, 1), Abase, aoC[1]);
    if (wr == 1) PG8_BAR;
    PG8_WAIT_V(4); PG8_BAR;
    PG8_STAGE(PG8_SB(1, 0), cB + kstep, voffB); PG8_STAGE(PG8_SA(1, 0), Abase + kstep, aoC[0]); PG8_STAGE(PG8_SB(1, 1), cB + hstep + kstep, voffB);
    PG8_WAIT_V(6); PG8_BAR;
    for (;;) {
        const bool has_next = S.next(ui + 1, nxt);
        const char* nB = cB;
#pragma unroll
        for (int _h = 0; _h < 2; ++_h)
#pragma unroll
            for (int _i = 0; _i < 2; ++_i) aoN[_h][_i] = aoC[_h][_i];
        if (has_next) { PG8_AOFF(aoN, nxt); nB = S.b_base(nxt); }
        for (int t = 0; t < nt; t += 2) {
            const bool last = (t == nt - 2);
            const char* a1 = Abase + (size_t)(t + 1) * kstep;
            const char* a2 = last ? Abase : Abase + (size_t)(t + 2) * kstep; const char* b2 = last ? nB : cB + (size_t)(t + 2) * kstep;
            const char* a3 = a2 + kstep; const char* b3 = b2 + kstep;
            unsigned ao2[2][2];
#pragma unroll
            for (int _h = 0; _h < 2; ++_h)
#pragma unroll
                for (int _i = 0; _i < 2; ++_i) ao2[_h][_i] = last ? aoN[_h][_i] : aoC[_h][_i];
            PG8_LDB(B0, 0, 0); PG8_SCHED; PG8_LDA(At, 0, 0); PG8_STAGE(PG8_SA(1, 1), a1, aoC[1]);
            PG8_WAIT_L(8); PG8_BAR; PG8_WAIT_L(0); PG8_MMA(0, 0, At, B0); PG8_BAR; PG8_SCHED;
            PG8_LDB(B1, 0, 1); PG8_STAGE(PG8_SB(0, 0), b2, voffB);
            PG8_BAR; PG8_WAIT_L(0); PG8_MMA(0, 1, At, B1); PG8_BAR;
            PG8_LDA(At, 0, 1); PG8_STAGE(PG8_SA(0, 0), a2, ao2[0]);
            PG8_BAR; PG8_WAIT_L(0); PG8_MMA(1, 0, At, B0); PG8_BAR; PG8_SCHED;
            PG8_STAGE(PG8_SB(0, 1), b2 + hstep, voffB);
            PG8_WAIT_V(6); PG8_BAR; PG8_MMA(1, 1, At, B1); PG8_BAR;
            PG8_LDB(B0, 1, 0); PG8_SCHED; PG8_LDA(At, 1, 0); PG8_STAGE(PG8_SA(0, 1), a2, ao2[1]);
            PG8_WAIT_L(8); PG8_BAR; PG8_WAIT_L(0); PG8_MMA(0, 0, At, B0); PG8_BAR; PG8_SCHED;
            PG8_LDB(B1, 1, 1); PG8_STAGE(PG8_SB(1, 0), b3, voffB);
            PG8_BAR; PG8_WAIT_L(0); PG8_MMA(0, 1, At, B1); PG8_BAR;
            PG8_LDA(At, 1, 1); PG8_STAGE(PG8_SA(1, 0), a3, ao2[0]);
            PG8_BAR; PG8_WAIT_L(0); PG8_MMA(1, 0, At, B0); PG8_BAR; PG8_SCHED;
            PG8_STAGE(PG8_SB(1, 1), b3 + hstep, voffB);
            PG8_WAIT_V(6); PG8_BAR; PG8_MMA(1, 1, At, B1); PG8_BAR;
        }
        E(acc, cur, wr, wc, fr, fq);
        if (!has_next) break;
#pragma unroll
        for (int a = 0; a < 2; ++a)
#pragma unroll
            for (int b = 0; b < 2; ++b)
#pragma unroll
                for (int m = 0; m < 4; ++m)
#pragma unroll
                    for (int n = 0; n < 2; ++n) acc[a][b][m][n] = (f32x4){0.f, 0.f, 0.f, 0.f};
        cur = nxt; cB = nB; ++ui;
#pragma unroll
        for (int _h = 0; _h < 2; ++_h)
#pragma unroll
            for (int _i = 0; _i < 2; ++_i) aoC[_h][_i] = aoN[_h][_i];
    }
    PG8_WAIT_V(0);
    if (wr == 0) PG8_BAR;
    PG8_BAR;
#undef PG8_SA
#undef PG8_SB
#undef PG8_STAGE
#undef PG8_AOFF
#undef PG8_LDA
#undef PG8_LDB
#undef PG8_MMA
#undef PG8_WAIT_V
#undef PG8_WAIT_L
#undef PG8_BAR
#undef PG8_SCHED
}
}

struct Args {
    const float* x; const float* c; const int* positions; const float* rel_bias; const float* norm_g; const float* final_norm_g;
    const float* ada_w; const float* ada_b; const float* ab_w_in; const float* ab_conv_a; const float* ab_conv_b; const float* ab_conv_b_bias;
    const float* ab_ln_g; const float* ab_ln_b; const float* ab_w_out; const float* cd_w_in; const float* diff_lam; const float* diff_norm_g;
    const float* cd_w_out; const float* moe_wr_g; const float* moe_br_g; const float* moe_wr_e; const float* moe_br_e;
    const float* moe_w_gate; const float* moe_w_up; const float* moe_w_down;
    float* out; unsigned char* ws; int ph_lo, ph_hi;
};
struct Frame {
    LAS unsigned char* lds; int tid, lane, wave, G, bid;
};

struct RowSrc { const float* p; int ld; };
DI void ilv(int rp, int& j, int& second) { const int g = rp >> 5, i = rp & 31; j = 16 * g + (i & 15); second = i >> 4; }

enum { CV_AB_IN = 0, CV_AB_OUT = 1, CV_CD_IN = 2, CV_CD_OUT = 3, CV_MOE_GU = 4, CV_MOE_D = 5 };
template <int KIND> DI RowSrc row_src(const Args& a, int layer, int e, int r) {
    RowSrc s; s.p = nullptr; s.ld = 0;
    if (KIND == CV_AB_IN) {
        s.ld = AB_N;
        if (r < 512) s.p = a.ab_w_in + r;
        else if (r < 1536) { int j, sec; ilv(r - 512, j, sec); s.p = a.ab_w_in + (sec ? 1024 + j : 512 + j); }
        else { int j, sec; ilv(r - 1536, j, sec); s.p = a.ab_w_in + (sec ? 2048 + j : 1536 + j); }
    } else if (KIND == CV_AB_OUT) { s.ld = DM; s.p = a.ab_w_out + r; }
    else if (KIND == CV_CD_IN) {
        s.ld = CD_SRC_N;
        int col = -1;
        if (r < 1024) col = r;
        else if (r < 2048) col = 1832 + (r - 1024);
        else if (r < 2304) col = 1536 + (r - 2048);
        else if (r < 2336) col = 1792 + (r - 2304);
        else if (r < 2344) col = 1824 + (r - 2336);
        else if (r < 2560) col = -1;
        else if (r < 3072) col = 1024 + (r - 2560);
        else col = 2856 + (r - 3072);
        if (col >= 0) s.p = a.cd_w_in + col;
    } else if (KIND == CV_CD_OUT) { s.ld = DM; s.p = a.cd_w_out + r; }
    else if (KIND == CV_MOE_GU) {
        int j, sec; ilv(r, j, sec); s.ld = DEXP;
        const size_t base = ((size_t)layer * NEXP + e) * (size_t)DM * DEXP;
        s.p = (sec ? a.moe_w_up : a.moe_w_gate) + base + j;
    } else {
        s.ld = DM; s.p = a.moe_w_down + ((size_t)layer * NEXP + e) * (size_t)DEXP * DM + r;
    }
    return s;
}
constexpr int CV_LD = 258;
template <int KIND> DI void cvt_tile(const Frame& F, const Args& a, bf16_t* dst, int K, int r0, int k0, int layer, int e) {
    LAS bf16_t* T = (LAS bf16_t*)F.lds;
    const int c4 = F.tid & 15;
    const RowSrc s = row_src<KIND>(a, layer, e, r0 + 4 * c4);
    f32x4 v[8];
#pragma unroll
    for (int it = 0; it < 8; ++it) {
        const int kk = (F.tid >> 4) + 32 * it;
        v[it] = (f32x4){0.f, 0.f, 0.f, 0.f};
        if (s.p) v[it] = *(const f32x4*)(s.p + (size_t)(k0 + kk) * s.ld);
    }
#pragma unroll
    for (int it = 0; it < 8; ++it) {
        const int kk = (F.tid >> 4) + 32 * it;
        const unsigned p01 = pack_bf16(v[it][0], v[it][1]), p23 = pack_bf16(v[it][2], v[it][3]);
        T[(4 * c4 + 0) * CV_LD + kk] = (bf16_t)(p01 & 0xffffu); T[(4 * c4 + 1) * CV_LD + kk] = (bf16_t)(p01 >> 16);
        T[(4 * c4 + 2) * CV_LD + kk] = (bf16_t)(p23 & 0xffffu); T[(4 * c4 + 3) * CV_LD + kk] = (bf16_t)(p23 >> 16);
    }
    __syncthreads();
    {
        const int rr = F.tid >> 3, c = F.tid & 7;
#pragma unroll
        for (int j = 0; j < 4; ++j) {
            const LAS unsigned* src = (const LAS unsigned*)(T + rr * CV_LD + 64 * j + c * 8);
            u32x4 w; w[0] = src[0]; w[1] = src[1]; w[2] = src[2]; w[3] = src[3];
            *(u32x4*)(dst + (size_t)(r0 + rr) * K + k0 + 64 * j + c * 8) = w;
        }
    }
    __syncthreads();
}
constexpr int CVT_DENSE_TILES = (AB_N + DM + CD_N + 1024 + DM) / 64 * (DM / 256);
constexpr int CVT_MOE_TILES_PER_EXP = (1024 / 64) * (1024 / 256) + (1024 / 64) * (512 / 256);
constexpr int CVT_MOE_TILES = NEXP * CVT_MOE_TILES_PER_EXP;
DI void cvt_dense_item(const Frame& F, const Args& a, int item) {
    const int rt = item >> 2, kt = item & 3;
    int r = rt * 64;
    if (r < AB_N) { cvt_tile<CV_AB_IN>(F, a, (bf16_t*)(a.ws + WS_WAB_IN), DM, r, kt * 256, 0, 0); return; }
    r -= AB_N;
    if (r < DM) { cvt_tile<CV_AB_OUT>(F, a, (bf16_t*)(a.ws + WS_WAB_OUT), DM, r, kt * 256, 0, 0); return; }
    r -= DM;
    if (r < CD_N + 1024) { cvt_tile<CV_CD_IN>(F, a, (bf16_t*)(a.ws + WS_WCD_IN), DM, r, kt * 256, 0, 0); return; }
    r -= CD_N + 1024;
    cvt_tile<CV_CD_OUT>(F, a, (bf16_t*)(a.ws + WS_WCD_OUT), DM, r, kt * 256, 0, 0);
}
DI void cvt_moe_item(const Frame& F, const Args& a, int layer, int item) {
    const int e = item / CVT_MOE_TILES_PER_EXP, t = item % CVT_MOE_TILES_PER_EXP;
    bf16_t* base = (bf16_t*)(a.ws + WS_MOE_W + (size_t)e * 3 * MiB);
    if (t < 64) cvt_tile<CV_MOE_GU>(F, a, base, DM, (t >> 2) * 64, (t & 3) * 256, layer, e);
    else { const int t2 = t - 64; cvt_tile<CV_MOE_D>(F, a, base + (size_t)DM * DM, DEXP, (t2 >> 1) * 64, (t2 & 1) * 256, layer, e); }
}
DI void mod_item(const Frame& F, const Args& a, int item) {
    LAS float* sc = (LAS float*)F.lds;
    for (int i = F.tid; i < NB * DM; i += NTHR) sc[i] = silu_f(a.c[i]);
    __syncthreads();
    const int l = item / 12, j = (item % 12) * 512 + F.tid;
    const float* w = a.ada_w + (size_t)l * DM * 6 * DM + j;
    float acc[NB] = {0.f, 0.f, 0.f, 0.f};
    for (int k = 0; k < DM; k += 4) {
        float wv[4];
#pragma unroll
        for (int u = 0; u < 4; ++u) wv[u] = w[(size_t)(k + u) * 6 * DM];
#pragma unroll
        for (int u = 0; u < 4; ++u)
#pragma unroll
            for (int b = 0; b < NB; ++b) acc[b] += sc[b * DM + k + u] * wv[u];
    }
    float* mod = (float*)(a.ws + WS_MOD);
    const float bias = a.ada_b[l * 6 * DM + j];
#pragma unroll
    for (int b = 0; b < NB; ++b) mod[((size_t)l * NB + b) * 6 * DM + j] = acc[b] + bias;
    __syncthreads();
}
DI void p0_prologue(const Frame& F, const Args& a) {
    const int n_items = 24 + CVT_DENSE_TILES + CVT_MOE_TILES;
    for (int it = F.bid; it < n_items; it += F.G) {
        if (it < 24) mod_item(F, a, it);
        else if (it < 24 + CVT_DENSE_TILES) cvt_dense_item(F, a, it - 24);
        else cvt_moe_item(F, a, 0, it - 24 - CVT_DENSE_TILES);
    }
}

constexpr int WR_LD = 1028;
DI void moe_seg_table(const Frame& F, const unsigned* cnt, LAS int* seg  ) {
    if (F.tid == 0) { int s = 0; for (int e = 0; e < NEXP; ++e) { seg[e] = s; s += (((int)cnt[e * CNT_STRIDE] + 255) >> 8) << 8; } seg[NEXP] = s; }
    __syncthreads();
}
template <bool COMBINE, bool ROUTE, bool FINAL>
DI void norm_phase(const Frame& F, const Args& a, const float* xsrc, int layer, int which, int layer_c) {
    const float* mod = (const float*)(a.ws + WS_MOD);
    bf16_t* hbuf = (bf16_t*)(a.ws + WS_H);
    unsigned* ctl = (unsigned*)(a.ws + WS_CTL);
    LAS float* wrT = (LAS float*)F.lds;
    LAS float* brs = (LAS float*)(F.lds + 36 * WR_LD * 4);
    LAS int* seg = (LAS int*)F.lds;
    constexpr int RT_CAP = 512;
    LAS int* rcnt = (LAS int*)(F.lds + 149504);
    LAS int* rbase = (LAS int*)(F.lds + 149632);
    LAS int* rt_er = (LAS int*)(F.lds + 149760);
    LAS float* rt_gate = (LAS float*)(F.lds + 149760 + 4096);
    LAS int* rt_tok = (LAS int*)(F.lds + 149760 + 8192);
    if (ROUTE) {
        const float* wg = a.moe_wr_g + (size_t)layer * DM * 4;
        const float* we = a.moe_wr_e + (size_t)layer * DM * 32;
        for (int i = F.tid; i < DM * 4; i += NTHR) { const int k = i >> 2, j = i & 3; wrT[j * WR_LD + k] = wg[i]; }
        for (int i = F.tid; i < DM * 32; i += NTHR) { const int k = i >> 5, j = i & 31; wrT[(4 + j) * WR_LD + k] = we[i]; }
        if (F.tid < NEXP) rcnt[F.tid] = 0;
        for (int i = F.tid; i < 2 * RT_CAP; i += NTHR) rt_er[i] = -1;
        if (F.tid < 4) brs[F.tid] = a.moe_br_g[layer * 4 + F.tid];
        else if (F.tid < 36) brs[F.tid] = a.moe_br_e[layer * 32 + F.tid - 4];
        __syncthreads();
    }
    if (COMBINE) moe_seg_table(F, ctl + CW_CNT + layer_c * NEXP * CNT_STRIDE, seg);
    const bf16_t* ymoe = (const bf16_t*)(a.ws + WS_YMOE);
    const int* tokslot = (const int*)(a.ws + WS_TOKSLOT);
    constexpr int TPW = ROUTE ? 2 : 4;
    for (int tb = (F.bid * NWAVE + F.wave) * TPW; tb < NTOK; tb += F.G * NWAVE * TPW) {
      const int b = tb / SEQ;
      f32x4 xall[TPW][4];
#pragma unroll
      for (int i = 0; i < TPW; ++i)
#pragma unroll
        for (int c = 0; c < 4; ++c) xall[i][c] = *(const f32x4*)(xsrc + (size_t)(tb + i) * DM + c * 256 + F.lane * 4);
      if (COMBINE) {
        int ts[TPW][2];
#pragma unroll
        for (int i = 0; i < TPW; ++i) { ts[i][0] = tokslot[(tb + i) * 2]; ts[i][1] = tokslot[(tb + i) * 2 + 1]; }
        u32x2 yv[TPW][2][4];
#pragma unroll
        for (int i = 0; i < TPW; ++i)
#pragma unroll
          for (int k = 0; k < 2; ++k) {
            const size_t r = (size_t)(seg[ts[i][k] >> 20] + (ts[i][k] & 0xfffff));
#pragma unroll
            for (int c = 0; c < 4; ++c) yv[i][k][c] = *(const u32x2*)(ymoe + r * DM + c * 256 + F.lane * 4);
          }
        const float* g2 = mod + ((size_t)layer_c * NB + b) * 6 * DM + 5 * DM;
#pragma unroll
        for (int c = 0; c < 4; ++c) {
          const int col = c * 256 + F.lane * 4;
          const f32x4 gv = *(const f32x4*)(g2 + col);
#pragma unroll
          for (int i = 0; i < TPW; ++i) {
            const u32x2 y0 = yv[i][0][c], y1 = yv[i][1][c];
            xall[i][c][0] += gv[0] * (bf_lo(y0[0]) + bf_lo(y1[0])); xall[i][c][1] += gv[1] * (bf_hi(y0[0]) + bf_hi(y1[0]));
            xall[i][c][2] += gv[2] * (bf_lo(y0[1]) + bf_lo(y1[1])); xall[i][c][3] += gv[3] * (bf_hi(y0[1]) + bf_hi(y1[1]));
            if (!FINAL) *(f32x4*)(a.out + (size_t)(tb + i) * DM + col) = xall[i][c];
          }
        }
      }
#pragma unroll
      for (int ti = 0; ti < TPW; ++ti) {
        const int tok = tb + ti;
        f32x4 xv[4];
#pragma unroll
        for (int c = 0; c < 4; ++c) xv[c] = xall[ti][c];
        float ss = 0.f;
#pragma unroll
        for (int c = 0; c < 4; ++c) ss += xv[c][0] * xv[c][0] + xv[c][1] * xv[c][1] + xv[c][2] * xv[c][2] + xv[c][3] * xv[c][3];
        ss = wave_sum(ss);
        const float rinv = rsqrtf(ss * (1.0f / DM) + EPS);
        if (FINAL) {
#pragma unroll
            for (int c = 0; c < 4; ++c) {
                const int col = c * 256 + F.lane * 4;
                const f32x4 g = *(const f32x4*)(a.final_norm_g + col);
                f32x4 o; o[0] = xv[c][0] * rinv * g[0]; o[1] = xv[c][1] * rinv * g[1]; o[2] = xv[c][2] * rinv * g[2]; o[3] = xv[c][3] * rinv * g[3];
                *(f32x4*)(a.out + (size_t)tok * DM + col) = o;
            }
            continue;
        }
        const float* ng = a.norm_g + ((size_t)layer * 2 + which) * DM;
        const float* sh = mod + ((size_t)layer * NB + b) * 6 * DM + (which ? 3 : 0) * DM;
        const float* sc = sh + DM;
        f32x4 hv[4];
#pragma unroll
        for (int c = 0; c < 4; ++c) {
            const int col = c * 256 + F.lane * 4;
            const f32x4 g = *(const f32x4*)(ng + col), s1 = *(const f32x4*)(sc + col), s0 = *(const f32x4*)(sh + col);
#pragma unroll
            for (int u = 0; u < 4; ++u) hv[c][u] = (xv[c][u] * rinv * g[u]) * (1.0f + s1[u]) + s0[u];
            u32x2 w; w[0] = pack_bf16(hv[c][0], hv[c][1]); w[1] = pack_bf16(hv[c][2], hv[c][3]);
            *(u32x2*)(hbuf + (size_t)tok * DM + col) = w;
        }
        if (ROUTE) {
            LAS float* lgs = (LAS float*)(F.lds + 36 * WR_LD * 4 + 256) + F.wave * 36;
#pragma unroll 1
            for (int jb = 0; jb < 36; jb += 4) {
                float pp[4];
#pragma unroll
                for (int u = 0; u < 4; ++u) {
                    float p = 0.f;
#pragma unroll
                    for (int c = 0; c < 4; ++c) {
                        const f32x4 w = *(const LAS f32x4*)(wrT + (jb + u) * WR_LD + c * 256 + F.lane * 4);
                        p += hv[c][0] * w[0] + hv[c][1] * w[1] + hv[c][2] * w[2] + hv[c][3] * w[3];
                    }
                    pp[u] = p;
                }
#pragma unroll
                for (int u = 0; u < 4; ++u) pp[u] = wave_sum(pp[u]);
                if (F.lane == 0) { *(LAS f32x4*)(lgs + jb) = (f32x4){pp[0], pp[1], pp[2], pp[3]}; }
            }
            float lg[36];
#pragma unroll
            for (int j = 0; j < 36; ++j) lg[j] = lgs[j] + brs[j];
            int g = 0; float gm = lg[0];
#pragma unroll
            for (int j = 1; j < 4; ++j) if (lg[j] > gm) { gm = lg[j]; g = j; }
            float den = 0.f;
#pragma unroll
            for (int j = 0; j < 4; ++j) den += __expf(lg[j] - gm);
            const float ptop = 1.0f / den;
            float fv[8];
#pragma unroll
            for (int i = 0; i < 8; ++i) fv[i] = (g == 0) ? lg[4 + i] : (g == 1) ? lg[12 + i] : (g == 2) ? lg[20 + i] : lg[28 + i];
            int i1 = 0; float v1 = fv[0];
#pragma unroll
            for (int i = 1; i < 8; ++i) if (fv[i] > v1) { v1 = fv[i]; i1 = i; }
            int i2 = -1; float v2 = -3.0e38f;
#pragma unroll
            for (int i = 0; i < 8; ++i) if (i != i1 && fv[i] > v2) { v2 = fv[i]; i2 = i; }
            const float e2 = __expf(v2 - v1), ga = ptop / (1.0f + e2), gb = ptop * e2 / (1.0f + e2);
            if (F.lane == 0) {
                const int li = ((tb - F.bid * NWAVE * TPW) / (F.G * NWAVE * TPW)) * NWAVE * TPW + F.wave * TPW + ti;
                const int ea = g * 8 + i1, eb = g * 8 + i2;
                const int ra = __hip_atomic_fetch_add(&rcnt[ea], 1, __ATOMIC_RELAXED, __HIP_MEMORY_SCOPE_WORKGROUP);
                const int rb = __hip_atomic_fetch_add(&rcnt[eb], 1, __ATOMIC_RELAXED, __HIP_MEMORY_SCOPE_WORKGROUP);
                if (li < RT_CAP) { rt_er[2 * li] = (ea << 16) | ra; rt_gate[2 * li] = ga; rt_tok[2 * li] = tok; rt_er[2 * li + 1] = (eb << 16) | rb; rt_gate[2 * li + 1] = gb; rt_tok[2 * li + 1] = tok; }
            }
        }
      }
    }
    if (ROUTE) {
        __syncthreads();
        unsigned* cnt = ctl + CW_CNT + layer * NEXP * CNT_STRIDE;
        if (F.tid < NEXP) { const int n = rcnt[F.tid]; rbase[F.tid] = n ? (int)__hip_atomic_fetch_add(cnt + F.tid * CNT_STRIDE, (unsigned)n, __ATOMIC_RELAXED, __HIP_MEMORY_SCOPE_AGENT) : 0; }
        __syncthreads();
        int* list = (int*)(a.ws + WS_LIST); float* gatev = (float*)(a.ws + WS_GATEV); int* tsl = (int*)(a.ws + WS_TOKSLOT);
        int nloc = 0;
        for (int tb = F.bid * NWAVE * TPW; tb < NTOK; tb += F.G * NWAVE * TPW) nloc += NWAVE * TPW;
        nloc = nloc < RT_CAP ? nloc : RT_CAP;
        for (int i = F.tid; i < 2 * nloc; i += NTHR) {
            const int er = rt_er[i]; if (er < 0) continue;
            const int e = er >> 16, pos = rbase[e] + (er & 0xffff), tok = rt_tok[i];
            list[e * NTOK + pos] = tok; gatev[e * NTOK + pos] = rt_gate[i]; tsl[tok * 2 + (i & 1)] = (e << 20) | pos;
        }
    }
    __syncthreads();
}

constexpr int LDS_MISC = 131072 + 64;
constexpr int LDS_XB = 163840 - 16;
constexpr int LDS_BYTES = 163840;
using pg8::Unit;
struct DenseSched {
    int nM, nN, nwg, G, c; const char* Bt; size_t tstepB;
    DI void init(int M, int N, int K, int G_, int c_, const void* Bt_) { nM = M / 256; nN = N / 256; nwg = nM * nN; G = G_; c = c_; Bt = (const char*)Bt_; tstepB = (size_t)256 * K * 2; }
    DI bool next(int i, Unit& u) const {
        const long L = (long)i * G + c; if (L >= nwg) return false;
        int wgid = (int)L; { const int q = nwg / 8, r = nwg % 8, xcd = wgid % 8, off = wgid / 8; wgid = (xcd < r ? xcd * (q + 1) : r * (q + 1) + (xcd - r) * q) + off; }
        const int nig = 8 * nN, gid = wgid / nig, fm = gid * 8, gsz = (nM - fm) < 8 ? (nM - fm) : 8;
        u.pm = fm + ((wgid % nig) % gsz); u.pn = (wgid % nig) / gsz; u.e = 0; u.nrow = 256; return true;
    }
    DI int a_row(const Unit& u, int r) const { return u.pm * 256 + r; }
    DI const char* b_base(const Unit& u) const { return Bt + (size_t)u.pn * tstepB; }
};
template <bool UP>
struct MoeSched {
    const LAS int* ntp; const unsigned* cnt; const int* list; const char* W; int nU, G, c;
    DI bool next(int i, Unit& u) const {
        const long L = (long)i * G + c; if (L >= nU) return false;
        int wgid = (int)L; { const int q = nU / 8, r = nU % 8, xcd = wgid % 8, off = wgid / 8; wgid = (xcd < r ? xcd * (q + 1) : r * (q + 1) + (xcd - r) * q) + off; }
        const int tg = wgid >> 2; u.pn = wgid & 3; u.pm = tg;
        int e = 0;
        for (int k = 1; k < NEXP; ++k) e += (ntp[k] <= tg) ? 1 : 0;
        u.e = e; const int rem = (int)cnt[e * CNT_STRIDE] - (tg - ntp[e]) * 256; u.nrow = rem < 256 ? rem : 256; return true;
    }
    DI int a_row(const Unit& u, int r) const {
        if (UP) { const int p = (u.pm - ntp[u.e]) * 256 + r; return (r < u.nrow) ? list[u.e * NTOK + p] : 0; }
        return u.pm * 256 + r;
    }
    DI const char* b_base(const Unit& u) const {
        return W + (size_t)u.e * 3 * MiB + (UP ? (size_t)u.pn * 256 * DM * 2 : 2 * MiB + (size_t)u.pn * 256 * DEXP * 2);
    }
};
DI void moe_tile_table(const Frame& F, const unsigned* cnt, LAS int* ntp  ) {
    if (F.tid == 0) { int s = 0; for (int e = 0; e < NEXP; ++e) { ntp[e] = s; s += ((int)cnt[e * CNT_STRIDE] + 255) >> 8; } ntp[NEXP] = s; }
    __syncthreads();
}

#define EPI_ROWS_BEGIN const int row0 = u.pm * 256 + wr * 64 + fr; _Pragma("unroll") for (int ai = 0; ai < 2; ++ai) _Pragma("unroll") for (int m = 0; m < 4; ++m) { const int row = row0 + ai * 128 + m * 16;
#define EPI_ROWS_END }
DI u32x2 pack4(const f32x4& v) { u32x2 w; w[0] = pack_bf16(v[0], v[1]); w[1] = pack_bf16(v[2], v[3]); return w; }

struct EpiAbIn {
    bf16_t* Zc;
    DI void operator()(const f32x4 (&acc)[2][2][4][2], const Unit& u, int wr, int wc, int fr, int fq) const {
        EPI_ROWS_BEGIN
            bf16_t* rp = Zc + (size_t)row * ZC_N;
#pragma unroll
            for (int bj = 0; bj < 2; ++bj) {
                if (u.pn < 2) {
#pragma unroll
                    for (int n = 0; n < 2; ++n) *(u32x2*)(rp + u.pn * 256 + bj * 128 + wc * 32 + n * 16 + 4 * fq) = pack4(acc[ai][bj][m][n]);
                } else {
                    const int pnp = (u.pn - 2) & 3, j = 16 * (8 * pnp + 4 * bj + wc) + 4 * fq;
                    const f32x4 X = acc[ai][bj][m][0], Y = acc[ai][bj][m][1]; f32x4 v;
                    if (u.pn < 6) { v = X * Y; *(u32x2*)(rp + 512 + j) = pack4(v); }
                    else { v[0] = X[0] * sigmoid_f(Y[0]); v[1] = X[1] * sigmoid_f(Y[1]); v[2] = X[2] * sigmoid_f(Y[2]); v[3] = X[3] * sigmoid_f(Y[3]); *(u32x2*)(rp + 1024 + j) = pack4(v); }
                }
            }
        EPI_ROWS_END
    }
};
struct EpiResid {
    const float* xin; float* xout; const float* g1;
    DI void operator()(const f32x4 (&acc)[2][2][4][2], const Unit& u, int wr, int wc, int fr, int fq) const {
        const float* g = g1 + (size_t)((u.pm * 256) / SEQ) * 6 * DM;
        EPI_ROWS_BEGIN
#pragma unroll
            for (int bj = 0; bj < 2; ++bj)
#pragma unroll
                for (int n = 0; n < 2; ++n) {
                    const int col = u.pn * 256 + bj * 128 + wc * 32 + n * 16 + 4 * fq;
                    const f32x4 xo = *(const f32x4*)(xin + (size_t)row * DM + col), gv = *(const f32x4*)(g + col);
                    *(f32x4*)(xout + (size_t)row * DM + col) = xo + gv * acc[ai][bj][m][n];
                }
        EPI_ROWS_END
    }
};
struct EpiPlain {
    bf16_t* O; int ld;
    DI void operator()(const f32x4 (&acc)[2][2][4][2], const Unit& u, int wr, int wc, int fr, int fq) const {
        EPI_ROWS_BEGIN
#pragma unroll
            for (int bj = 0; bj < 2; ++bj)
#pragma unroll
                for (int n = 0; n < 2; ++n) *(u32x2*)(O + (size_t)row * ld + u.pn * 256 + bj * 128 + wc * 32 + n * 16 + 4 * fq) = pack4(acc[ai][bj][m][n]);
        EPI_ROWS_END
    }
};
struct EpiMoeUp {
    bf16_t* act;
    DI void operator()(const f32x4 (&acc)[2][2][4][2], const Unit& u, int wr, int wc, int fr, int fq) const {
        EPI_ROWS_BEGIN
#pragma unroll
            for (int bj = 0; bj < 2; ++bj) {
                const int j = 16 * (8 * u.pn + 4 * bj + wc) + 4 * fq;
                const f32x4 X = acc[ai][bj][m][0], Y = acc[ai][bj][m][1]; f32x4 v;
                v[0] = silu_f(X[0]) * Y[0]; v[1] = silu_f(X[1]) * Y[1]; v[2] = silu_f(X[2]) * Y[2]; v[3] = silu_f(X[3]) * Y[3];
                *(u32x2*)(act + (size_t)row * DEXP + j) = pack4(v);
            }
        EPI_ROWS_END
    }
};
struct EpiMoeDown {
    bf16_t* y; const float* gatev; const LAS int* ntp;
    DI void operator()(const f32x4 (&acc)[2][2][4][2], const Unit& u, int wr, int wc, int fr, int fq) const {
        const int pbase = (u.pm - ntp[u.e]) * 256;
        EPI_ROWS_BEGIN
            const int r = row - u.pm * 256;
            const float gt = (r < u.nrow) ? gatev[u.e * NTOK + pbase + r] : 0.f;
#pragma unroll
            for (int bj = 0; bj < 2; ++bj)
#pragma unroll
                for (int n = 0; n < 2; ++n) *(u32x2*)(y + (size_t)row * DM + u.pn * 256 + bj * 128 + wc * 32 + n * 16 + 4 * fq) = pack4(acc[ai][bj][m][n] * gt);
        EPI_ROWS_END
    }
};

DI void conv_phase(const Frame& F, const Args& a) {
    const bf16_t* Zc = (const bf16_t*)(a.ws + WS_BIG);
    bf16_t* Y = (bf16_t*)(a.ws + WS_Y);
    LAS unsigned* PB = (LAS unsigned*)F.lds;
    LAS f32x2* ST = (LAS f32x2*)(F.lds + 94 * 1024);
    const int cp = F.tid & 255, th = F.tid >> 8, wq = F.wave & 3;
    float wb[31][2], wa[3][2];
#pragma unroll
    for (int k = 0; k < 31; ++k) { const f32x2 w = *(const f32x2*)(a.ab_conv_b + k * 512 + 2 * cp); wb[k][0] = w[0]; wb[k][1] = w[1]; }
#pragma unroll
    for (int k = 0; k < 3; ++k) { const f32x2 w = *(const f32x2*)(a.ab_conv_a + k * 512 + 2 * cp); wa[k][0] = w[0]; wa[k][1] = w[1]; }
    const f32x2 cbias = *(const f32x2*)(a.ab_conv_b_bias + 2 * cp), lng = *(const f32x2*)(a.ab_ln_g + 2 * cp), lnb = *(const f32x2*)(a.ab_ln_b + 2 * cp);
    for (int tile = F.bid; tile < NTOK / 64; tile += F.G) {
        const int t0 = tile * 64, b = t0 / SEQ, tl0 = t0 % SEQ;
        for (int i = F.tid; i < 94 * 64; i += NTHR) {
            const int r = i >> 6, c8 = i & 63, pos = tl0 - 30 + r;
            u32x4 v = {0u, 0u, 0u, 0u};
            if (pos >= 0) v = *(const u32x4*)(Zc + (size_t)(b * SEQ + pos) * ZC_N + 1024 + c8 * 8);
            *(LAS u32x4*)(PB + r * 256 + c8 * 4) = v;
        }
        __syncthreads();
#pragma unroll 1
        for (int g = 0; g < 4; ++g) {
            float U[8][2];
#pragma unroll
            for (int i = 0; i < 8; ++i) { U[i][0] = cbias[0]; U[i][1] = cbias[1]; }
#pragma unroll
            for (int r = 0; r < 38; ++r) {
                const unsigned xw = PB[(32 * th + 8 * g + r) * 256 + cp];
                const float x0 = bf_lo(xw), x1 = bf_hi(xw);
#pragma unroll
                for (int i = 0; i < 8; ++i) { const int k = r - i; if (k >= 0 && k <= 30) { U[i][0] += wb[k][0] * x0; U[i][1] += wb[k][1] * x1; } }
            }
#pragma unroll
            for (int i = 0; i < 8; ++i) {
                const float s1 = wave_sum(U[i][0] + U[i][1]), s2 = wave_sum(U[i][0] * U[i][0] + U[i][1] * U[i][1]);
                if (F.lane == 0) ST[(32 * th + 8 * g + i) * 4 + wq] = (f32x2){s1, s2};
            }
            __syncthreads();
#pragma unroll
            for (int i = 0; i < 8; ++i) {
                const int tl = 32 * th + 8 * g + i; const size_t tok = (size_t)t0 + tl; const int pos = tl0 + tl;
                const f32x2 p0 = ST[tl * 4 + 0], p1 = ST[tl * 4 + 1], p2 = ST[tl * 4 + 2], p3 = ST[tl * 4 + 3];
                const float mean = ((p0[0] + p1[0]) + (p2[0] + p3[0])) * (1.0f / 512.0f);
                const float var = ((p0[1] + p1[1]) + (p2[1] + p3[1])) * (1.0f / 512.0f) - mean * mean;
                const float rstd = rsqrtf(var + EPS);
                const float yb0 = silu_f((U[i][0] - mean) * rstd * lng[0] + lnb[0]), yb1 = silu_f((U[i][1] - mean) * rstd * lng[1] + lnb[1]);
                *(unsigned*)(Y + tok * DM + 512 + 2 * cp) = pack_bf16(yb0, yb1);
                float a0 = 0.f, a1 = 0.f;
#pragma unroll
                for (int k = 0; k < 3; ++k) {
                    const int pp = pos - 2 + k;
                    if (pp >= 0) { const unsigned w = *(const unsigned*)(Zc + (size_t)(b * SEQ + pp) * ZC_N + 512 + 2 * cp); a0 += wa[k][0] * bf_lo(w); a1 += wa[k][1] * bf_hi(w); }
                }
                const unsigned gw = *(const unsigned*)(Zc + tok * ZC_N + 2 * cp);
                *(unsigned*)(Y + tok * DM + 2 * cp) = pack_bf16(bf_lo(gw) * a0, bf_hi(gw) * a1);
            }
        }
        __syncthreads();
    }
}

#define MFMA32(a, b, c) __builtin_amdgcn_mfma_f32_32x32x16_bf16((a), (b), (c), 0, 0, 0)
constexpr int TK_HIST = 0;
constexpr int TK_TAB = 65536;
constexpr int TK_CAND = 65536 + 512;
constexpr int TK_CCNT = TK_CAND + 4096;
constexpr int TK_BQ = 73728;
DI int crow_c(int r) { return (r & 3) + 8 * (r >> 2); }
template <int PASS>
DI void topk_pass(const Frame& F, const bf16_t* Z, unsigned* maskg, int b, int t0, const float (&wp)[8]) {
    const LAS unsigned char* bq = F.lds + TK_BQ;
    LAS unsigned* hist = (LAS unsigned*)(F.lds + TK_HIST);
    LAS int* tab = (LAS int*)(F.lds + TK_TAB);
    LAS int* cand = (LAS int*)(F.lds + TK_CAND);
    LAS int* ccnt = (LAS int*)(F.lds + TK_CCNT);
    const int q = F.lane & 31, h2 = F.lane >> 5, ntile = t0 / 32 + 1;
    const int myT = (PASS >= 2) ? tab[q * 4 + 0] : 0;
    const bf16_t* kbase = Z + (size_t)b * SEQ * CD_N + Z_KI + 8 * h2;
    for (int kt = F.wave; kt < ntile; kt += NWAVE) {
        const bf16_t* kp = kbase + (size_t)(32 * kt + q) * CD_N;
        const bf16x8 A0l = *(const bf16x8*)kp, A1l = *(const bf16x8*)(kp + 16);
        const bf16x8 A0 = A0l, A1 = A1l;
        f32x16 sc;
#pragma unroll
        for (int r = 0; r < 16; ++r) sc[r] = 0.f;
        sc = MFMA32(A0, *(const LAS bf16x8*)(bq + (16 * 64 + F.lane) * 16), sc); sc = MFMA32(A1, *(const LAS bf16x8*)(bq + (17 * 64 + F.lane) * 16), sc);
#pragma unroll
        for (int r = 0; r < 16; ++r) sc[r] += 131072.0f;
#pragma unroll
        for (int h = 0; h < 8; ++h) {
            f32x16 ac;
#pragma unroll
            for (int r = 0; r < 16; ++r) ac[r] = 0.f;
            ac = MFMA32(A0, *(const LAS bf16x8*)(bq + ((2 * h) * 64 + F.lane) * 16), ac); ac = MFMA32(A1, *(const LAS bf16x8*)(bq + ((2 * h + 1) * 64 + F.lane) * 16), ac);
#pragma unroll
            for (int r = 0; r < 16; ++r) sc[r] += __builtin_fabsf(ac[r]) * wp[h];
        }
        const bool diag = (kt == ntile - 1);
        unsigned bits = 0u;
#pragma unroll
        for (int r = 0; r < 16; ++r) {
            int key = (int)sc[r]; key = key < 0 ? 0 : (key > 262143 ? 262143 : key);
            const bool valid = !diag || (crow_c(r) + 4 * h2 <= q);
            if (PASS == 1) { if (valid) __hip_atomic_fetch_add(&hist[q * 512 + (key >> 9)], 1u, __ATOMIC_RELAXED, __HIP_MEMORY_SCOPE_WORKGROUP); }
            else if (PASS == 2) { if (valid && (key >> 9) == myT) __hip_atomic_fetch_add(&hist[q * 512 + (key & 511)], 1u, __ATOMIC_RELAXED, __HIP_MEMORY_SCOPE_WORKGROUP); }
            else {
                if (valid && key > myT) bits |= 1u << crow_c(r);
                if (valid && key == myT) { const int p = __hip_atomic_fetch_add(&ccnt[q], 1, __ATOMIC_RELAXED, __HIP_MEMORY_SCOPE_WORKGROUP); if (p < 32) cand[q * 32 + p] = 32 * kt + crow_c(r) + 4 * h2; }
            }
        }
        if (PASS == 3) {
            bits <<= 4 * h2;
            bits |= (unsigned)__shfl_xor((int)bits, 32);
            if (h2 == 0) maskg[(size_t)(b * SEQ + t0 + q) * 256 + kt] = bits;
        }
    }
}
DI void topk_scan(const Frame& F, int pass, int t0) {
    LAS unsigned* hist = (LAS unsigned*)(F.lds + TK_HIST);
    LAS int* tab = (LAS int*)(F.lds + TK_TAB);
    for (int qi = 0; qi < 4; ++qi) {
        const int q = F.wave * 4 + qi, n = t0 + q + 1;
        int need = 256, prevT = 0, prevAbove = 0;
        if (pass == 2) { prevT = tab[q * 4 + 0]; prevAbove = tab[q * 4 + 1]; need = 256 - prevAbove; }
        if (n <= 256) { if (F.lane == 0) { tab[q * 4 + 0] = -1; tab[q * 4 + 1] = 0; tab[q * 4 + 2] = 0; } continue; }
        unsigned hv[8]; unsigned s = 0;
#pragma unroll
        for (int i = 0; i < 8; ++i) { hv[i] = hist[q * 512 + 511 - (8 * F.lane + i)]; s += hv[i]; }
        unsigned inc = s;
#pragma unroll
        for (int o = 1; o < 64; o <<= 1) { const unsigned v = (unsigned)__shfl_up((int)inc, o); if (F.lane >= o) inc += v; }
        const unsigned pre = inc - s;
        if ((int)pre < need && (int)inc >= need) {
            unsigned cum = pre; int bsel = 0; unsigned above = 0; bool found = false;
#pragma unroll
            for (int i = 0; i < 8; ++i) { if (!found && (int)(cum + hv[i]) >= need) { found = true; bsel = 511 - (8 * F.lane + i); above = cum; } cum += hv[i]; }
            if (pass == 1) { tab[q * 4 + 0] = bsel; tab[q * 4 + 1] = (int)above; }
            else { tab[q * 4 + 0] = (prevT << 9) | bsel; tab[q * 4 + 1] = prevAbove + (int)above; tab[q * 4 + 2] = 256 - (prevAbove + (int)above); }
        }
    }
}
DI void topk_phase(const Frame& F, const Args& a) {
    const bf16_t* Z = (const bf16_t*)(a.ws + WS_BIG);
    unsigned* maskg = (unsigned*)(a.ws + WS_MASK);
    LAS unsigned* hist = (LAS unsigned*)(F.lds + TK_HIST);
    LAS int* tab = (LAS int*)(F.lds + TK_TAB);
    LAS int* cand = (LAS int*)(F.lds + TK_CAND);
    LAS int* ccnt = (LAS int*)(F.lds + TK_CCNT);
    const int q = F.lane & 31, h2 = F.lane >> 5;
    for (int pi = F.bid; pi < 512; pi += F.G) {
        const int b = pi >> 7, p = pi & 127;
        for (int half = 0; half < 2; ++half) {
            const int t0 = 32 * (half ? 255 - p : p);
            const bf16_t* zr = Z + (size_t)(b * SEQ + t0 + q) * CD_N;
            float wp[8];
            { const u32x4 wv = *(const u32x4*)(zr + Z_WI);
              const float sc = 0.0625f * 0.5f * 16384.0f;
              wp[0] = bf_lo(wv[0]) * sc; wp[1] = bf_hi(wv[0]) * sc; wp[2] = bf_lo(wv[1]) * sc; wp[3] = bf_hi(wv[1]) * sc;
              wp[4] = bf_lo(wv[2]) * sc; wp[5] = bf_hi(wv[2]) * sc; wp[6] = bf_lo(wv[3]) * sc; wp[7] = bf_hi(wv[3]) * sc; }
            __syncthreads();
            if (F.wave == 0) {
                LAS unsigned char* bqw = F.lds + TK_BQ;
                float lin[2][8];
#pragma unroll
                for (int ks = 0; ks < 2; ++ks)
#pragma unroll
                    for (int j = 0; j < 8; ++j) lin[ks][j] = 0.f;
#pragma unroll
                for (int h = 0; h < 8; ++h)
#pragma unroll
                    for (int ks = 0; ks < 2; ++ks) {
                        const u32x4 v = *(const u32x4*)(zr + Z_QI + 32 * h + 16 * ks + 8 * h2);
                        *(LAS u32x4*)(bqw + ((2 * h + ks) * 64 + F.lane) * 16) = v;
#pragma unroll
                        for (int j = 0; j < 4; ++j) { lin[ks][2 * j] += wp[h] * bf_lo(v[j]); lin[ks][2 * j + 1] += wp[h] * bf_hi(v[j]); }
                    }
#pragma unroll
                for (int ks = 0; ks < 2; ++ks) {
                    u32x4 v; v[0] = pack_bf16(lin[ks][0], lin[ks][1]); v[1] = pack_bf16(lin[ks][2], lin[ks][3]); v[2] = pack_bf16(lin[ks][4], lin[ks][5]); v[3] = pack_bf16(lin[ks][6], lin[ks][7]);
                    *(LAS u32x4*)(bqw + ((16 + ks) * 64 + F.lane) * 16) = v;
                }
            }
            for (int i = F.tid; i < 32 * 512; i += NTHR) hist[i] = 0u;
            if (F.tid < 32) ccnt[F.tid] = 0;
            __syncthreads();
            topk_pass<1>(F, Z, maskg, b, t0, wp);
            __syncthreads();
            topk_scan(F, 1, t0);
            __syncthreads();
            for (int i = F.tid; i < 32 * 512; i += NTHR) hist[i] = 0u;
            __syncthreads();
            topk_pass<2>(F, Z, maskg, b, t0, wp);
            __syncthreads();
            topk_scan(F, 2, t0);
            __syncthreads();
            topk_pass<3>(F, Z, maskg, b, t0, wp);
            __threadfence();
            __syncthreads();
            if (F.tid < 32) {
                const int qq = F.tid, need = tab[qq * 4 + 2]; int nc = ccnt[qq]; nc = nc > 32 ? 32 : nc;
                if (tab[qq * 4 + 0] >= 0) {
                    int last = -1;
                    for (int k = 0; k < need && k < nc; ++k) {
                        int best = 0x7fffffff;
                        for (int i = 0; i < nc; ++i) { const int v = cand[qq * 32 + i]; if (v > last && v < best) best = v; }
                        if (best == 0x7fffffff) break;
                        atomicOr(&maskg[(size_t)(b * SEQ + t0 + qq) * 256 + (best >> 5)], 1u << (best & 31));
                        last = best;
                    }
                }
            }
            __syncthreads();
        }
    }
}

constexpr int AT_KSTR = 72;
constexpr int AT_VSTR = 72;
constexpr int AT_KBYTES = 64 * AT_KSTR * 2;
constexpr int AT_VBYTES = 128 * AT_VSTR * 2;
constexpr int AT_BUF = AT_KBYTES + AT_VBYTES;
constexpr int AT_LUT = 2 * AT_BUF;
constexpr int AT_LUT_LD = 132;
constexpr float NEG_INF = -__builtin_huge_valf();
constexpr float AT_THR = 8.0f;

template <int DV, bool MASKED>
DI void attn_core(const Frame& F, const bf16_t* Z, const bf16_t* Vt, int b, int qcol, int kcol, int vrow, int q0, const LAS float* lut, float c1, const unsigned* maskg, f32x16 (&O)[DV / 32]) {
    constexpr int NDV = DV / 32;
    const int q = F.lane & 31, h2 = F.lane >> 5;
    const int tw0 = q0 + 32 * F.wave, t = tw0 + q;
    const bf16_t* Zb = Z + (size_t)b * SEQ * CD_N;
    const bf16_t* Vb = Vt + (size_t)vrow * NTOK + (size_t)b * SEQ;
    const unsigned* mrow = maskg + (size_t)(b * SEQ + t) * 256;
    bf16x8 Qf[4];
#pragma unroll
    for (int ks = 0; ks < 4; ++ks) Qf[ks] = *(const bf16x8*)(Zb + (size_t)t * CD_N + qcol + 16 * ks + 8 * h2);
#pragma unroll
    for (int d = 0; d < NDV; ++d)
#pragma unroll
        for (int r = 0; r < 16; ++r) O[d][r] = 0.f;
    float m_run = NEG_INF, l_run = 0.f;
    const int jmax = (q0 + 255) >> 6;
    const int kkey = F.tid >> 3, kch = F.tid & 7;
    u32x4 kreg, vreg[DV / 64]; unsigned mreg[2] = {0u, 0u};
#define AT_LOAD(j) do { kreg = *(const u32x4*)(Zb + (size_t)(64 * (j) + kkey) * CD_N + kcol + 8 * kch); \
        _Pragma("unroll") for (int _i = 0; _i < DV / 64; ++_i) { const int idx = F.tid + NTHR * _i; vreg[_i] = *(const u32x4*)(Vb + (size_t)(idx >> 3) * NTOK + 64 * (j) + 8 * (idx & 7)); } \
        if (MASKED) { mreg[0] = mrow[2 * (j)]; mreg[1] = mrow[2 * (j) + 1]; } } while (0)
#define AT_STORE(buf) do { LAS unsigned char* kb_ = F.lds + (buf) * AT_BUF; *(LAS u32x4*)(kb_ + kkey * (AT_KSTR * 2) + kch * 16) = kreg; \
        _Pragma("unroll") for (int _i = 0; _i < DV / 64; ++_i) { const int idx = F.tid + NTHR * _i, dv_ = idx >> 3, ch_ = idx & 7; \
            LAS unsigned char* vp_ = kb_ + AT_KBYTES + dv_ * (AT_VSTR * 2) + (16 * (ch_ >> 1) + 4 * (ch_ & 1)) * 2; \
            *(LAS u32x2*)vp_ = (u32x2){vreg[_i][0], vreg[_i][1]}; *(LAS u32x2*)(vp_ + 16) = (u32x2){vreg[_i][2], vreg[_i][3]}; } } while (0)
    AT_LOAD(0); AT_STORE(0);
    unsigned mcur[2] = {mreg[0], mreg[1]};
    __syncthreads();
    for (int j = 0; j <= jmax; ++j) {
        if (j < jmax) AT_LOAD(j + 1);
        if (64 * j <= tw0 + 31) {
            const LAS unsigned char* kb = F.lds + (j & 1) * AT_BUF;
            const LAS unsigned char* vt = kb + AT_KBYTES;
            f32x16 s[2];
#pragma unroll
            for (int kb2 = 0; kb2 < 2; ++kb2) {
                bf16x8 Kf[4];
#pragma unroll
                for (int ks = 0; ks < 4; ++ks) Kf[ks] = *(const LAS bf16x8*)(kb + (32 * kb2 + q) * (AT_KSTR * 2) + (16 * ks + 8 * h2) * 2);
#pragma unroll
                for (int r = 0; r < 16; ++r) s[kb2][r] = 0.f;
#pragma unroll
                for (int ks = 0; ks < 4; ++ks) s[kb2] = MFMA32(Kf[ks], Qf[ks], s[kb2]);
            }
            const bool nearb = (64 * j + 63 + 128 > tw0);
            float mloc = NEG_INF;
            if (!nearb) {
#pragma unroll
                for (int kb2 = 0; kb2 < 2; ++kb2)
#pragma unroll
                    for (int r = 0; r < 16; ++r) mloc = fmaxf(mloc, s[kb2][r]);
                mloc = mloc * c1 + lut[128];
            } else {
#pragma unroll
                for (int kb2 = 0; kb2 < 2; ++kb2) {
                    float bl[16];
#pragma unroll
                    for (int r = 0; r < 16; ++r) {
                        int dist = t - (64 * j + 32 * kb2 + crow_c(r) + 4 * h2);
                        dist = dist < 0 ? 129 : (dist > 128 ? 128 : dist);
                        bl[r] = lut[dist];
                    }
#pragma unroll
                    for (int r = 0; r < 16; ++r) { s[kb2][r] = s[kb2][r] * c1 + bl[r]; mloc = fmaxf(mloc, s[kb2][r]); }
                }
            }
            mloc = fmaxf(mloc, __shfl_xor(mloc, 32));
            if (__any(mloc > m_run + AT_THR)) {
                const float m_new = fmaxf(m_run, mloc);
                const float alpha = __builtin_amdgcn_exp2f(m_run - m_new);
                m_run = m_new; l_run *= alpha;
#pragma unroll
                for (int d = 0; d < NDV; ++d)
#pragma unroll
                    for (int r = 0; r < 16; ++r) O[d][r] *= alpha;
            }
            const float sub = lut[128] - m_run;
            float psum0 = 0.f, psum1 = 0.f;
            constexpr int NH = NDV / 2, NST = 4 * NH;
            bf16x8 Av[2][2];
#pragma unroll
            for (int d = 0; d < 2; ++d) Av[0][d] = *(const LAS bf16x8*)(vt + (32 * d + q) * (AT_VSTR * 2) + (8 * h2) * 2);
            if (!nearb) {
#pragma unroll
                for (int kb2 = 0; kb2 < 2; ++kb2)
#pragma unroll
                    for (int r = 0; r < 16; ++r) s[kb2][r] = __builtin_amdgcn_exp2f(s[kb2][r] * c1 + sub);
            } else {
#pragma unroll
                for (int kb2 = 0; kb2 < 2; ++kb2)
#pragma unroll
                    for (int r = 0; r < 16; ++r) s[kb2][r] = __builtin_amdgcn_exp2f(s[kb2][r] - m_run);
            }
#pragma unroll
            for (int kb2 = 0; kb2 < 2; ++kb2) {
                const unsigned mw = mcur[kb2] >> (4 * h2);
#pragma unroll
                for (int r = 0; r < 16; ++r) {
                    float p = s[kb2][r];
                    if (MASKED) { p = __uint_as_float(__float_as_uint(p) & (unsigned)(-(int)((mw >> crow_c(r)) & 1u))); s[kb2][r] = p; }
                    if (r & 1) psum1 += p; else psum0 += p;
                }
            }
            l_run += psum0 + psum1;
            bf16x8 Pf;
#pragma unroll
            for (int u = 0; u < NST; ++u) {
                const int st = u / NH, dh = u % NH, kb2 = st >> 1, s2 = st & 1;
                if (dh == 0) {
                    u32x4 pw;
#pragma unroll
                    for (int e = 0; e < 4; ++e) pw[e] = pack_bf16(s[kb2][8 * s2 + 2 * e], s[kb2][8 * s2 + 2 * e + 1]);
                    Pf = __builtin_bit_cast(bf16x8, pw);
                }
                if (u + 1 < NST) {
                    const int st1 = (u + 1) / NH, dh1 = (u + 1) % NH;
#pragma unroll
                    for (int d = 0; d < 2; ++d) Av[(u + 1) & 1][d] = *(const LAS bf16x8*)(vt + (32 * (2 * dh1 + d) + q) * (AT_VSTR * 2) + (16 * st1 + 8 * h2) * 2);
                }
                __builtin_amdgcn_s_setprio(1);
#pragma unroll
                for (int d = 0; d < 2; ++d) O[2 * dh + d] = MFMA32(Av[u & 1][d], Pf, O[2 * dh + d]);
                __builtin_amdgcn_s_setprio(0);
                __builtin_amdgcn_sched_barrier(0);
            }
        }
        if (j < jmax) AT_STORE((j + 1) & 1);
        mcur[0] = mreg[0]; mcur[1] = mreg[1];
        __syncthreads();
    }
#undef AT_LOAD
#undef AT_STORE
    const float lt = l_run + __shfl_xor(l_run, 32);
    const float inv = 1.0f / lt;
#pragma unroll
    for (int d = 0; d < NDV; ++d)
#pragma unroll
        for (int r = 0; r < 16; ++r) O[d][r] *= inv;
}

DI float rel_bucket_bias(const float* rel_bias, int d, int head) {
    int bkt;
    if (d < 16) bkt = d;
    else { const float lr = __logf((float)d * (1.0f / 16.0f)) / 2.0794415416798357f; int l = 16 + (int)(lr * 16.0f); bkt = l < 31 ? l : 31; }
    return rel_bias[bkt * 12 + head];
}
DI void attn_phase(const Frame& F, const Args& a) {
    const bf16_t* Z = (const bf16_t*)(a.ws + WS_BIG);
    const bf16_t* Vtg = (const bf16_t*)(a.ws + WS_VT);
    bf16_t* Yo = (bf16_t*)(a.ws + WS_Y);
    float* O1s = (float*)(a.ws + WS_H);
    const unsigned* maskg = (const unsigned*)(a.ws + WS_MASK);
    LAS float* lut = (LAS float*)(F.lds + AT_LUT);
    for (int i = F.tid; i < 12 * 130; i += NTHR) { const int hh = i / 130, d = i % 130; lut[hh * AT_LUT_LD + d] = d < 129 ? rel_bucket_bias(a.rel_bias, d, hh) * LOG2E : NEG_INF; }
    float lam;
    { float d01 = 0.f, d23 = 0.f; for (int i = 0; i < 64; ++i) { d01 += a.diff_lam[i] * a.diff_lam[64 + i]; d23 += a.diff_lam[128 + i] * a.diff_lam[192 + i]; }
      lam = __expf(d01) - __expf(d23) + 0.35550906759096f; }
    const float one_m_li = 1.0f - 0.35550906759096f;
    __syncthreads();
    const float c1 = 0.125f * LOG2E;
    const int q = F.lane & 31, h2 = F.lane >> 5;
    const int xcd = F.bid & 7, kk = F.bid >> 3;
    for (int it = F.bid; it < 256; it += F.G) {
        const int bh = (F.G == 256) ? 2 * xcd + (kk >> 4) : it >> 4, pr = (F.G == 256) ? (kk & 15) : (it & 15);
        const int b = bh >> 2, hd = bh & 3;
        for (int half = 0; half < 2; ++half) {
            const int q0 = 256 * (half ? 31 - pr : pr), t = q0 + 32 * F.wave + q;
            f32x16 O[4];
            attn_core<128, false>(F, Z, Vtg, b, Z_QD + 128 * hd, Z_KD + 128 * hd, VT_D + 128 * hd, q0, lut + (8 + hd) * AT_LUT_LD, c1, nullptr, O);
            float* o1p = O1s + (size_t)(b * SEQ + t) * 512 + 128 * hd;
#pragma unroll
            for (int d = 0; d < 4; ++d)
#pragma unroll
                for (int g = 0; g < 4; ++g) *(f32x4*)(o1p + 32 * d + 8 * g + 4 * h2) = (f32x4){O[d][4 * g], O[d][4 * g + 1], O[d][4 * g + 2], O[d][4 * g + 3]};
            attn_core<128, false>(F, Z, Vtg, b, Z_QD + 128 * hd + 64, Z_KD + 128 * hd + 64, VT_D + 128 * hd, q0, lut + (8 + hd) * AT_LUT_LD, c1, nullptr, O);
            float ss = 0.f;
#pragma unroll
            for (int d = 0; d < 4; ++d)
#pragma unroll
                for (int g = 0; g < 4; ++g) {
                    const f32x4 o1 = *(const f32x4*)(o1p + 32 * d + 8 * g + 4 * h2);
#pragma unroll
                    for (int e = 0; e < 4; ++e) { const float v = o1[e] - lam * O[d][4 * g + e]; O[d][4 * g + e] = v; ss += v * v; }
                }
            ss += __shfl_xor(ss, 32);
            const float rinv = rsqrtf(ss * (1.0f / 128.0f) + EPS) * one_m_li;
            bf16_t* yp = Yo + (size_t)(b * SEQ + t) * DM + 512 + 128 * hd;
#pragma unroll
            for (int d = 0; d < 4; ++d)
#pragma unroll
                for (int g = 0; g < 4; ++g) {
                    const int dv = 32 * d + 8 * g + 4 * h2;
                    const f32x4 gn = *(const f32x4*)(a.diff_norm_g + dv);
                    f32x4 v; v[0] = O[d][4 * g] * rinv * gn[0]; v[1] = O[d][4 * g + 1] * rinv * gn[1]; v[2] = O[d][4 * g + 2] * rinv * gn[2]; v[3] = O[d][4 * g + 3] * rinv * gn[3];
                    *(u32x2*)(yp + dv) = pack4(v);
                }
        }
    }
    for (int it = F.bid; it < 512; it += F.G) {
        const int rnd = it / F.G;
        const int bh = (F.G == 256) ? 4 * xcd + 2 * rnd + (kk >> 4) : it >> 4, pr = (F.G == 256) ? (kk & 15) : (it & 15);
        const int b = bh >> 3, hc = bh & 7;
        for (int half = 0; half < 2; ++half) {
            const int q0 = 256 * (half ? 31 - pr : pr), t = q0 + 32 * F.wave + q;
            f32x16 O[2];
            attn_core<64, true>(F, Z, Vtg, b, Z_QC + 64 * hc, Z_KC + 64 * hc, VT_C + 64 * hc, q0, lut + hc * AT_LUT_LD, c1, maskg, O);
            bf16_t* yp = Yo + (size_t)(b * SEQ + t) * DM + 64 * hc;
#pragma unroll
            for (int d = 0; d < 2; ++d)
#pragma unroll
                for (int g = 0; g < 4; ++g) {
                    f32x4 v = {O[d][4 * g], O[d][4 * g + 1], O[d][4 * g + 2], O[d][4 * g + 3]};
                    *(u32x2*)(yp + 32 * d + 8 * g + 4 * h2) = pack4(v);
                }
        }
    }
}

#ifndef MK_ONE_LAUNCH
#define MK_ONE_LAUNCH 1
#endif
constexpr int NPH = 17;
__global__ void __launch_bounds__(NTHR, 2) fwd_kernel(Args a) {
    extern __shared__ __attribute__((aligned(16))) unsigned char lds_raw[];
    Frame F; F.lds = (LAS unsigned char*)lds_raw; F.tid = threadIdx.x; F.lane = F.tid & 63; F.wave = __builtin_amdgcn_readfirstlane(F.tid >> 6); F.G = gridDim.x; F.bid = blockIdx.x;
    unsigned* ctl = (unsigned*)(a.ws + WS_CTL);
    volatile LAS unsigned* xbw = (volatile LAS unsigned*)(F.lds + LDS_XB);
    if (F.tid < 4) xbw[F.tid] = 0u;
    __syncthreads();
    const int lo = a.ph_lo, hi = a.ph_hi;
    XcdBarrier bar; bar.bar = ctl + CW_BAR; bar.x = 0; bar.st = xbw;
    if (hi - lo > 1) bar = xcd_barrier_post(ctl + CW_BAR, xbw);
#ifndef PH_ONLY
#define IN(k) (lo <= (k) && (k) < hi)
#else
#define IN(k) ((k) == PH_ONLY && lo <= (k) && (k) < hi)
#endif
#ifndef DUP_PH
#define DUP_PH -1
#endif
#define REP(k) for (int rep_ = 0; rep_ < ((k) == DUP_PH ? 2 : 1); ++rep_)
#ifndef TIME_PH
#define TIME_PH -1
#endif
#define TIME_AMP 4
    unsigned long long tp0_ = 0, tp1_ = 0;
    if (TIME_PH == 0) tp0_ = wall_clock64();
#define SEAM(k) do { if (IN(k) && IN((k) + 1)) xcd_barrier(bar); if ((k) == TIME_PH) tp1_ = wall_clock64(); if ((k) + 1 == TIME_PH) tp0_ = wall_clock64(); } while (0)
    float* mod = (float*)(a.ws + WS_MOD);
    bf16_t* hbuf = (bf16_t*)(a.ws + WS_H);
    bf16_t* ybuf = (bf16_t*)(a.ws + WS_Y);
    LAS int* ntp = (LAS int*)(F.lds + LDS_MISC);

    if (IN(0)) REP(0) { p0_prologue(F, a); } SEAM(0);
    if (IN(1)) REP(1) { norm_phase<false, false, false>(F, a, a.x, 0, 0, 0); } SEAM(1);
    if (IN(2)) REP(2) {
        DenseSched S; S.init(NTOK, AB_N, DM, F.G, F.bid, a.ws + WS_WAB_IN);
        EpiAbIn E{(bf16_t*)(a.ws + WS_BIG)};
        pg8::gemm_phase(F.lds, (const char*)hbuf, DM, S, E);
    } SEAM(2);
    if (IN(3)) REP(3) { conv_phase(F, a); } SEAM(3);
    if (IN(4)) REP(4) {
        DenseSched S; S.init(NTOK, DM, DM, F.G, F.bid, a.ws + WS_WAB_OUT);
        EpiResid E{a.x, a.out, mod + 2 * DM};
        pg8::gemm_phase(F.lds, (const char*)ybuf, DM, S, E);
    } SEAM(4);
#define MOE_PHASES(layer, pb) do { \
        const unsigned* cnt = ctl + CW_CNT + (layer) * NEXP * CNT_STRIDE; \
        if (IN(pb)) { norm_phase<false, true, false>(F, a, a.out, (layer), 1, 0); } SEAM(pb); \
        if (IN((pb) + 1)) REP((pb) + 1) { \
            moe_tile_table(F, cnt, ntp); \
            MoeSched<true> S; S.ntp = ntp; S.cnt = cnt; S.list = (const int*)(a.ws + WS_LIST); S.W = (const char*)(a.ws + WS_MOE_W); S.nU = 4 * ntp[NEXP]; S.G = F.G; S.c = F.bid; \
            EpiMoeUp E{(bf16_t*)(a.ws + WS_ACT)}; \
            pg8::gemm_phase(F.lds, (const char*)hbuf, DM, S, E); \
        } SEAM((pb) + 1); \
        if (IN((pb) + 2)) REP((pb) + 2) { \
            moe_tile_table(F, cnt, ntp); \
            MoeSched<false> S; S.ntp = ntp; S.cnt = cnt; S.list = nullptr; S.W = (const char*)(a.ws + WS_MOE_W); S.nU = 4 * ntp[NEXP]; S.G = F.G; S.c = F.bid; \
            EpiMoeDown E{(bf16_t*)(a.ws + WS_YMOE), (const float*)(a.ws + WS_GATEV), ntp}; \
            pg8::gemm_phase(F.lds, (const char*)(a.ws + WS_ACT), DEXP, S, E); \
        } SEAM((pb) + 2); } while (0)
    MOE_PHASES(0, 5);
    if (IN(8)) {
        norm_phase<true, false, false>(F, a, a.out, 1, 0, 0);
        for (int it = F.bid; it < CVT_MOE_TILES; it += F.G) cvt_moe_item(F, a, 1, it);
    } SEAM(8);
    if (IN(9)) REP(9) {
        { DenseSched S; S.init(NTOK, CD_N, DM, F.G, F.bid, a.ws + WS_WCD_IN);
          EpiPlain E{(bf16_t*)(a.ws + WS_BIG), CD_N};
          pg8::gemm_phase(F.lds, (const char*)hbuf, DM, S, E); }
        __syncthreads();
        { DenseSched S; S.init(1024, NTOK, DM, F.G, F.bid, hbuf);
          EpiPlain E{(bf16_t*)(a.ws + WS_VT), NTOK};
          pg8::gemm_phase(F.lds, (const char*)(a.ws + WS_WCD_IN + (size_t)CD_N * DM * 2), DM, S, E); }
    } SEAM(9);
    if (IN(10)) REP(10) { topk_phase(F, a); } SEAM(10);
    if (IN(11)) REP(11) { attn_phase(F, a); } SEAM(11);
    if (IN(12)) {
        DenseSched S; S.init(NTOK, DM, DM, F.G, F.bid, a.ws + WS_WCD_OUT);
        EpiResid E{a.out, a.out, mod + (size_t)NB * 6 * DM + 2 * DM};
        pg8::gemm_phase(F.lds, (const char*)ybuf, DM, S, E);
    } SEAM(12);
    MOE_PHASES(1, 13);
#undef MOE_PHASES
    if (IN(16)) { norm_phase<true, false, true>(F, a, a.out, 1, 0, 1); }
    if (TIME_PH >= 0) {
        if (TIME_PH == 16) { asm volatile("s_waitcnt vmcnt(0)" ::: "memory"); __syncthreads(); tp1_ = wall_clock64(); }
        if (F.bid == 0 && F.tid == 0) { const unsigned long long te = wall_clock64(), dt = (tp1_ - tp0_) * TIME_AMP; while (wall_clock64() - te < dt) __builtin_amdgcn_s_sleep(8); }
    }
#undef IN
#undef SEAM
}

extern "C" void kernel_launch(void* const* d_in, const int* in_sizes, int n_in, void* d_out, int out_size, void* d_ws, size_t ws_size, hipStream_t stream) {
    static int grid = 0;
    if (grid == 0) {
        if (n_in != 26 || out_size != NTOK * DM || ws_size < WS_END) { fprintf(stderr, "kernel_launch: unexpected problem (n_in %d, out %d, ws %zu < %zu)\n", n_in, out_size, ws_size, (size_t)WS_END); grid = -1; return; }
        int dev = 0, cus = 0, per_cu = 0;
        if (hipGetDevice(&dev) != hipSuccess || hipDeviceGetAttribute(&cus, hipDeviceAttributeMultiprocessorCount, dev) != hipSuccess) { grid = -1; return; }
        if (hipFuncSetAttribute((const void*)fwd_kernel, hipFuncAttributeMaxDynamicSharedMemorySize, LDS_BYTES) != hipSuccess) { fprintf(stderr, "kernel_launch: hipFuncSetAttribute failed\n"); grid = -1; return; }
        if (hipOccupancyMaxActiveBlocksPerMultiprocessor(&per_cu, (const void*)fwd_kernel, NTHR, LDS_BYTES) != hipSuccess || per_cu < 1) { fprintf(stderr, "kernel_launch: occupancy query says %d\n", per_cu); }
        (void)hipGetLastError();
        grid = cus;
    }
    if (grid < 0) return;
    (void)hipMemsetAsync((char*)d_ws + WS_CTL, 0, CTL_BYTES, stream);
    Args a{};
    const float** fp = (const float**)&a.x;
    (void)fp;
    a.x = (const float*)d_in[0]; a.c = (const float*)d_in[1]; a.positions = (const int*)d_in[2]; a.rel_bias = (const float*)d_in[3]; a.norm_g = (const float*)d_in[4];
    a.final_norm_g = (const float*)d_in[5]; a.ada_w = (const float*)d_in[6]; a.ada_b = (const float*)d_in[7]; a.ab_w_in = (const float*)d_in[8]; a.ab_conv_a = (const float*)d_in[9];
    a.ab_conv_b = (const float*)d_in[10]; a.ab_conv_b_bias = (const float*)d_in[11]; a.ab_ln_g = (const float*)d_in[12]; a.ab_ln_b = (const float*)d_in[13]; a.ab_w_out = (const float*)d_in[14];
    a.cd_w_in = (const float*)d_in[15]; a.diff_lam = (const float*)d_in[16]; a.diff_norm_g = (const float*)d_in[17]; a.cd_w_out = (const float*)d_in[18];
    a.moe_wr_g = (const float*)d_in[19]; a.moe_br_g = (const float*)d_in[20]; a.moe_wr_e = (const float*)d_in[21]; a.moe_br_e = (const float*)d_in[22];
    a.moe_w_gate = (const float*)d_in[23]; a.moe_w_up = (const float*)d_in[24]; a.moe_w_down = (const float*)d_in[25];
    a.out = (float*)d_out; a.ws = (unsigned char*)d_ws;
#if MK_ONE_LAUNCH
    a.ph_lo = 0; a.ph_hi = NPH;
    hipLaunchKernelGGL(fwd_kernel, dim3(grid), dim3(NTHR), LDS_BYTES, stream, a);
#else
    for (int p = 0; p < NPH; ++p) { a.ph_lo = p; a.ph_hi = p + 1; hipLaunchKernelGGL(fwd_kernel, dim3(grid), dim3(NTHR), LDS_BYTES, stream, a); }
#endif
}
```

```cpp
#include <hip/hip_runtime.h>
#include <cstdio>
#include <cstdint>

#define LAS __attribute__((address_space(3)))
#define DI __device__ __forceinline__
typedef unsigned short bf16_t;
typedef short bf16x8 __attribute__((ext_vector_type(8)));
typedef short s16x4 __attribute__((ext_vector_type(4)));
typedef float f32x2 __attribute__((ext_vector_type(2)));
typedef float f32x4 __attribute__((ext_vector_type(4)));
typedef float f32x16 __attribute__((ext_vector_type(16)));
typedef unsigned u32x2 __attribute__((ext_vector_type(2)));
typedef unsigned u32x4 __attribute__((ext_vector_type(4)));
typedef __bf16 bf16v2 __attribute__((ext_vector_type(2)));

constexpr int NB = 4, SEQ = 8192, DM = 1024, NTOK = NB * SEQ;
constexpr int NTHR = 512, NWAVE = 8;
constexpr int AB_N = 2560;
constexpr int ZC_N = 1536;
constexpr int CD_SRC_N = 3368;
constexpr int CD_N = 2560;
constexpr int Z_QC = 0, Z_KC = 512, Z_QD = 1024, Z_KD = 1536, Z_QI = 2048, Z_KI = 2304, Z_WI = 2336;
constexpr int VT_C = 0, VT_D = 512;
constexpr int NEXP = 32, DEXP = 512;
constexpr int MOE_ROWS = 2 * NTOK + NEXP * 256;
constexpr float EPS = 1e-6f;
constexpr float LOG2E = 1.4426950408889634f;

constexpr size_t MiB = 1u << 20;
constexpr size_t WS_CTL = 0, CTL_BYTES = 64 * 1024;
constexpr size_t WS_MOD = 1 * MiB;
constexpr size_t WS_WAB_IN = 2 * MiB;
constexpr size_t WS_WAB_OUT = 7 * MiB;
constexpr size_t WS_WCD_IN = 9 * MiB;
constexpr size_t WS_WCD_OUT = 16 * MiB;
constexpr size_t WS_MOE_W = 18 * MiB;
constexpr size_t WS_H = 114 * MiB;
constexpr size_t WS_Y = 178 * MiB;
constexpr size_t WS_BIG = 242 * MiB;
constexpr size_t WS_ACT = WS_BIG;
constexpr size_t WS_YMOE = WS_BIG + 72 * MiB;
constexpr size_t WS_VT = WS_BIG + 160 * MiB;
constexpr size_t WS_MASK = 466 * MiB;
constexpr size_t WS_LIST = 498 * MiB;
constexpr size_t WS_GATEV = 502 * MiB;
constexpr size_t WS_TOKSLOT = 506 * MiB;
constexpr size_t WS_END = 507 * MiB;

constexpr int CW_BAR = 0;
constexpr int CW_CNT = 4096;
constexpr int CNT_STRIDE = 64;

DI unsigned pack_bf16(float lo, float hi) { f32x2 v = {lo, hi}; bf16v2 b = __builtin_convertvector(v, bf16v2); return __builtin_bit_cast(unsigned, b); }
DI float bf_lo(unsigned w) { return __uint_as_float(w << 16); }
DI float bf_hi(unsigned w) { return __uint_as_float(w & 0xffff0000u); }
DI float bf2f(bf16_t b) { return __uint_as_float(((unsigned)b) << 16); }
DI float wave_sum(float v) {
#pragma unroll
    for (int o = 32; o >= 1; o >>= 1) v += __shfl_xor(v, o);
    return v;
}
DI int fresh_lane() { int l; asm volatile("v_mbcnt_lo_u32_b32 %0, -1, 0\n\tv_mbcnt_hi_u32_b32 %0, -1, %0" : "=v"(l)); return l; }
DI float silu_f(float v) { return v / (1.0f + __expf(-v)); }
DI float sigmoid_f(float v) { return 1.0f / (1.0f + __expf(-v)); }

#define XB_TMO      128
#define XB_XCNT(j)  (256  + 64 * (j))
#define XB_XSUB(j)  (1280 + 64 * (j))
#define XB_XGEN(j)  (2304 + 64 * (j))
#define XB_TOP      3328
#define XB_TOPGEN   3392
#define XCD_BAR_WORDS 3456
#define XB_SPIN_CAP (1u << 22)
DI unsigned xb_ld(unsigned* p)              { return __hip_atomic_load(p, __ATOMIC_RELAXED, __HIP_MEMORY_SCOPE_AGENT); }
DI unsigned xb_add(unsigned* p, unsigned v) { return __hip_atomic_fetch_add(p, v, __ATOMIC_RELAXED, __HIP_MEMORY_SCOPE_AGENT); }
DI unsigned xb_xcc_id() { return (unsigned)__builtin_amdgcn_s_getreg((3 << 11) | 20) & 0xFu; }
#define XB_SPIN(cond, bar) do { unsigned _sp = 0; while (cond) { __builtin_amdgcn_s_sleep(1); \
    if ((++_sp & 255u) == 0u) { if (xb_ld(&(bar)[XB_TMO])) break; if (_sp > XB_SPIN_CAP) { atomicAdd(&(bar)[XB_TMO], 1u); break; } } } } while (0)
struct XcdBarrier { unsigned* bar; unsigned x; volatile LAS unsigned* st; };
DI XcdBarrier xcd_barrier_post(unsigned* bar, volatile LAS unsigned* st) {
    XcdBarrier b; b.bar = bar; b.x = xb_xcc_id(); b.st = st;
    if (threadIdx.x == 0) (void)xb_add(&bar[XB_XCNT(b.x)], 1u);
    return b;
}
DI void xcd_barrier_complete(unsigned* bar, unsigned x, unsigned& nloc, unsigned& nx) {
    const unsigned G = gridDim.x * gridDim.y * gridDim.z;
    unsigned sum, cnt, mine, sp = 0u;
    for (;;) {
        sum = 0u; cnt = 0u; mine = 0u;
#pragma unroll
        for (unsigned j = 0; j < 16; ++j) { const unsigned c = xb_ld(&bar[XB_XCNT(j)]); sum += c; cnt += (c > 0u) ? 1u : 0u; mine = (j == x) ? c : mine; }
        if (sum == G) break;
        __builtin_amdgcn_s_sleep(1);
        if ((++sp & 255u) == 0u) { if (xb_ld(&bar[XB_TMO])) break; if (sp > XB_SPIN_CAP) { atomicAdd(&bar[XB_TMO], 1u); break; } }
    }
    nloc = mine > 0u ? mine : 1u; nx = cnt > 0u ? cnt : 1u;
}
DI void xcd_barrier(const XcdBarrier& b) {
    asm volatile("s_waitcnt vmcnt(0)" ::: "memory");
    __syncthreads();
    if (threadIdx.x == 0) {
        unsigned* bar = b.bar;
        __builtin_amdgcn_s_waitcnt(0);
        unsigned nloc = b.st[0], nx = b.st[1];
        if (nloc == 0u) { xcd_barrier_complete(bar, b.x, nloc, nx); b.st[0] = nloc; b.st[1] = nx; }
        const unsigned old = xb_add(&bar[XB_XSUB(b.x)], 1u);
        const unsigned gen = old / nloc;
        if (old + 1u == (gen + 1u) * nloc) {
            __builtin_amdgcn_fence(__ATOMIC_RELEASE, "agent");
            asm volatile("s_waitcnt vmcnt(0)" ::: "memory");
            const unsigned og = xb_add(&bar[XB_TOP], 1u);
            const unsigned tg = og / nx;
            if (og + 1u == (tg + 1u) * nx) xb_add(&bar[XB_TOPGEN], 1u);
            else XB_SPIN(xb_ld(&bar[XB_TOPGEN]) == tg, bar);
            __builtin_amdgcn_fence(__ATOMIC_ACQUIRE, "agent");
            xb_add(&bar[XB_XGEN(b.x)], 1u);
            asm volatile("s_waitcnt vmcnt(0)" ::: "memory");
        } else {
            XB_SPIN(xb_ld(&bar[XB_XGEN(b.x)]) == gen, bar);
            __builtin_amdgcn_fence(__ATOMIC_ACQUIRE, "agent");
            asm volatile("s_waitcnt vmcnt(0)" ::: "memory");
        }
    }
    __syncthreads();
}

namespace pg8 {
constexpr int BM = 256, BK = 64, HALF = 128, HTB = HALF * BK * 2, STAGE_BYTES = 8 * HTB;
DI int lds_byte(int r, int c) { const int st = (r >> 4) * 2 + (c >> 5), rr = r & 15, cc = c & 31, ob = rr * 64 + cc * 2; return st * 1024 + (ob ^ (((ob >> 9) & 1) << 5)); }
DI void stage_rc(int b, int& R, int& C) { const int st = b / 1024, sb = b % 1024, swz = sb ^ (((sb >> 9) & 1) << 5); R = (st >> 1) * 16 + swz / 64; C = (st & 1) * 32 + (swz % 64) / 2; }
struct Unit { int pm, pn, e, nrow; };

template <class Epi, class Sched>
DI void gemm_phase(LAS unsigned char* lds, const char* Abase, const int K, const Sched& S, const Epi& E) {
    const int tid = threadIdx.x, wid = __builtin_amdgcn_readfirstlane(tid >> 6), lane = tid & 63, wr = wid >> 2, wc = wid & 3, fr = lane & 15, fq = lane >> 4;
    const int nt = K / BK;
    int Rr[2], Cc[2]; unsigned voffB[2];
#pragma unroll
    for (int i = 0; i < 2; ++i) { int R, C; stage_rc(tid * 16 + i * 8192, R, C); Rr[i] = R; Cc[i] = C; voffB[i] = (unsigned)(R * K + C) * 2u; }
    const size_t kstep = (size_t)(BK * 2);
    const size_t hstep = (size_t)HALF * K * 2;
    const unsigned ldsw = (unsigned)wid * 1024u;
    const int aoff = lds_byte(wr * 64 + fr, fq * 8), boff = lds_byte(wc * 32 + fr, fq * 8);
#define PG8_SA(b, h) (((b) * 2 + (h)) * HTB)
#define PG8_SB(b, h) ((4 + (b) * 2 + (h)) * HTB)
#define PG8_STAGE(bufoff, gbase, voff) do { _Pragma("unroll") for (int _i = 0; _i < 2; ++_i) \
        __builtin_amdgcn_global_load_lds((const unsigned*)((const char*)(gbase) + (voff)[_i]), (LAS unsigned*)(lds + (bufoff) + ldsw + _i * 8192), 16, 0, 0); } while (0)
#define PG8_AOFF(dst, u) do { _Pragma("unroll") for (int _h = 0; _h < 2; ++_h) _Pragma("unroll") for (int _i = 0; _i < 2; ++_i) \
        dst[_h][_i] = ((unsigned)S.a_row(u, _h * HALF + Rr[_i]) * (unsigned)K + (unsigned)Cc[_i]) * 2u; } while (0)
#define PG8_LDA(dst, b, h) do { _Pragma("unroll") for (int m = 0; m < 4; ++m) _Pragma("unroll") for (int k = 0; k < 2; ++k) dst[m][k] = *(const LAS bf16x8*)(lds + PG8_SA(b, h) + aoff + m * 2048 + k * 1024); } while (0)
#define PG8_LDB(dst, b, h) do { _Pragma("unroll") for (int n = 0; n < 2; ++n) _Pragma("unroll") for (int k = 0; k < 2; ++k) dst[n][k] = *(const LAS bf16x8*)(lds + PG8_SB(b, h) + boff + n * 2048 + k * 1024); } while (0)
#define PG8_MMA(ai, bj, At, Bt) do { __builtin_amdgcn_s_setprio(1); _Pragma("unroll") for (int m = 0; m < 4; ++m) _Pragma("unroll") for (int n = 0; n < 2; ++n) _Pragma("unroll") for (int k = 0; k < 2; ++k) \
        acc[ai][bj][m][n] = __builtin_amdgcn_mfma_f32_16x16x32_bf16(Bt[n][k], At[m][k], acc[ai][bj][m][n], 0, 0, 0); __builtin_amdgcn_s_setprio(0); } while (0)
#define PG8_WAIT_V(n) asm volatile("s_waitcnt vmcnt(" #n ")" ::: "memory")
#define PG8_WAIT_L(n) asm volatile("s_waitcnt lgkmcnt(" #n ")" ::: "memory")
#define PG8_BAR __builtin_amdgcn_s_barrier()
#define PG8_SCHED __builtin_amdgcn_sched_barrier(0)
    Unit cur, nxt; int ui = 0;
    if (!S.next(0, cur)) return;
    f32x4 acc[2][2][4][2];
#pragma unroll
    for (int a = 0; a < 2; ++a)
#pragma unroll
        for (int b = 0; b < 2; ++b)
#pragma unroll
            for (int m = 0; m < 4; ++m)
#pragma unroll
                for (int n = 0; n < 2; ++n) acc[a][b][m][n] = (f32x4){0.f, 0.f, 0.f, 0.f};
    bf16x8 At[4][2], B0[2][2], B1[2][2];
    unsigned aoC[2][2], aoN[2][2];
    PG8_AOFF(aoC, cur);
    const char* cB = S.b_base(cur);
    PG8_STAGE(PG8_SB(0, 0), cB, voffB); PG8_STAGE(PG8_SA(0, 0), Abase, aoC[0]); PG8_STAGE(PG8_SB(0, 1), cB + hstep, voffB); PG8_STAGE(PG8_SA(0, 1), Abase, aoC[1]);
    if (wr == 1) PG8_BAR;
    PG8_WAIT_V(4); PG8_BAR;
    PG8_STAGE(PG8_SB(1, 0), cB + kstep, voffB); PG8_STAGE(PG8_SA(1, 0), Abase + kstep, aoC[0]); PG8_STAGE(PG8_SB(1, 1), cB + hstep + kstep, voffB);
    PG8_WAIT_V(6); PG8_BAR;
    for (;;) {
        const bool has_next = S.next(ui + 1, nxt);
        const char* nB = cB;
#pragma unroll
        for (int _h = 0; _h < 2; ++_h)
#pragma unroll
            for (int _i = 0; _i < 2; ++_i) aoN[_h][_i] = aoC[_h][_i];
        if (has_next) { PG8_AOFF(aoN, nxt); nB = S.b_base(nxt); }
        for (int t = 0; t < nt; t += 2) {
            const bool last = (t == nt - 2);
            const char* a1 = Abase + (size_t)(t + 1) * kstep;
            const char* a2 = last ? Abase : Abase + (size_t)(t + 2) * kstep; const char* b2 = last ? nB : cB + (size_t)(t + 2) * kstep;
            const char* a3 = a2 + kstep; const char* b3 = b2 + kstep;
            unsigned ao2[2][2];
#pragma unroll
            for (int _h = 0; _h < 2; ++_h)
#pragma unroll
                for (int _i = 0; _i < 2; ++_i) ao2[_h][_i] = last ? aoN[_h][_i] : aoC[_h][_i];
            PG8_LDB(B0, 0, 0); PG8_SCHED; PG8_LDA(At, 0, 0); PG8_STAGE(PG8_SA(1, 1), a1, aoC[1]);
            PG8_WAIT_L(8); PG8_BAR; PG8_WAIT_L(0); PG8_MMA(0, 0, At, B0); PG8_BAR; PG8_SCHED;
            PG8_LDB(B1, 0, 1); PG8_STAGE(PG8_SB(0, 0), b2, voffB);
            PG8_BAR; PG8_WAIT_L(0); PG8_MMA(0, 1, At, B1); PG8_BAR;
            PG8_LDA(At, 0, 1); PG8_STAGE(PG8_SA(0, 0), a2, ao2[0]);
            PG8_BAR; PG8_WAIT_L(0); PG8_MMA(1, 0, At, B0); PG8_BAR; PG8_SCHED;
            PG8_STAGE(PG8_SB(0, 1), b2 + hstep, voffB);
            PG8_WAIT_V(6); PG8_BAR; PG8_MMA(1, 1, At, B1); PG8_BAR;
            PG8_LDB(B0, 1, 0); PG8_SCHED; PG8_LDA(At, 1, 0); PG8_STAGE(PG8_SA(0, 1), a2, ao2[1]);
            PG8_WAIT_L(8); PG8_BAR; PG8_WAIT_L(0); PG8_MMA(0, 0, At, B0); PG8_BAR; PG8_SCHED;
            PG8_LDB(B1, 1, 1); PG8_STAGE(PG8_SB(1, 0), b3, voffB);
            PG8_BAR; PG8_WAIT_L(0); PG8_MMA(0, 1, At, B1); PG8_BAR;
            PG8_LDA(At, 1, 1); PG8_STAGE(PG8_SA(1, 0), a3, ao2[0]);
            PG8_BAR; PG8_WAIT_L(0); PG8_MMA(1, 0, At, B0); PG8_BAR; PG8_SCHED;
            PG8_STAGE(PG8_SB(1, 1), b3 + hstep, voffB);
            PG8_WAIT_V(6); PG8_BAR; PG8_MMA(1, 1, At, B1); PG8_BAR;
        }
        E(acc, cur, wr, wc, fr, fq);
        if (!has_next) break;
#pragma unroll
        for (int a = 0; a < 2; ++a)
#pragma unroll
            for (int b = 0; b < 2; ++b)
#pragma unroll
                for (int m = 0; m < 4; ++m)
#pragma unroll
                    for (int n = 0; n < 2; ++n) acc[a][b][m][n] = (f32x4){0.f, 0.f, 0.f, 0.f};
        cur = nxt; cB = nB; ++ui;
#pragma unroll
        for (int _h = 0; _h < 2; ++_h)
#pragma unroll
            for (int _i = 0; _i < 2; ++_i) aoC[_h][_i] = aoN[_h][_i];
    }
    PG8_WAIT_V(0);
    if (wr == 0) PG8_BAR;
    PG8_BAR;
#undef PG8_SA
#undef PG8_SB
#undef PG8_STAGE
#undef PG8_AOFF
#undef PG8_LDA
#undef PG8_LDB
#undef PG8_MMA
#undef PG8_WAIT_V
#undef PG8_WAIT_L
#undef PG8_BAR
#undef PG8_SCHED
}
}

struct Args {
    const float* x; const float* c; const int* positions; const float* rel_bias; const float* norm_g; const float* final_norm_g;
    const float* ada_w; const float* ada_b; const float* ab_w_in; const float* ab_conv_a; const float* ab_conv_b; const float* ab_conv_b_bias;
    const float* ab_ln_g; const float* ab_ln_b; const float* ab_w_out; const float* cd_w_in; const float* diff_lam; const float* diff_norm_g;
    const float* cd_w_out; const float* moe_wr_g; const float* moe_br_g; const float* moe_wr_e; const float* moe_br_e;
    const float* moe_w_gate; const float* moe_w_up; const float* moe_w_down;
    float* out; unsigned char* ws; int ph_lo, ph_hi;
};
struct Frame {
    LAS unsigned char* lds; int tid, lane, wave, G, bid;
};

struct RowSrc { const float* p; int ld; };
DI void ilv(int rp, int& j, int& second) { const int g = rp >> 5, i = rp & 31; j = 16 * g + (i & 15); second = i >> 4; }

enum { CV_AB_IN = 0, CV_AB_OUT = 1, CV_CD_IN = 2, CV_CD_OUT = 3, CV_MOE_GU = 4, CV_MOE_D = 5 };
template <int KIND> DI RowSrc row_src(const Args& a, int layer, int e, int r) {
    RowSrc s; s.p = nullptr; s.ld = 0;
    if (KIND == CV_AB_IN) {
        s.ld = AB_N;
        if (r < 512) s.p = a.ab_w_in + r;
        else if (r < 1536) { int j, sec; ilv(r - 512, j, sec); s.p = a.ab_w_in + (sec ? 1024 + j : 512 + j); }
        else { int j, sec; ilv(r - 1536, j, sec); s.p = a.ab_w_in + (sec ? 2048 + j : 1536 + j); }
    } else if (KIND == CV_AB_OUT) { s.ld = DM; s.p = a.ab_w_out + r; }
    else if (KIND == CV_CD_IN) {
        s.ld = CD_SRC_N;
        int col = -1;
        if (r < 1024) col = r;
        else if (r < 2048) col = 1832 + (r - 1024);
        else if (r < 2304) col = 1536 + (r - 2048);
        else if (r < 2336) col = 1792 + (r - 2304);
        else if (r < 2344) col = 1824 + (r - 2336);
        else if (r < 2560) col = -1;
        else if (r < 3072) col = 1024 + (r - 2560);
        else col = 2856 + (r - 3072);
        if (col >= 0) s.p = a.cd_w_in + col;
    } else if (KIND == CV_CD_OUT) { s.ld = DM; s.p = a.cd_w_out + r; }
    else if (KIND == CV_MOE_GU) {
        int j, sec; ilv(r, j, sec); s.ld = DEXP;
        const size_t base = ((size_t)layer * NEXP + e) * (size_t)DM * DEXP;
        s.p = (sec ? a.moe_w_up : a.moe_w_gate) + base + j;
    } else {
        s.ld = DM; s.p = a.moe_w_down + ((size_t)layer * NEXP + e) * (size_t)DEXP * DM + r;
    }
    return s;
}
constexpr int CV_LD = 258;
struct CvtTile { const float* sp; int ld; bf16_t* dst; int K, r0, k0; };
template <int KIND> DI CvtTile cvt_desc(const Frame& F, const Args& a, bf16_t* dst, int K, int r0, int k0, int layer, int e) {
    const RowSrc s = row_src<KIND>(a, layer, e, r0 + 4 * (F.tid & 15));
    CvtTile t; t.sp = s.p; t.ld = s.ld; t.dst = dst; t.K = K; t.r0 = r0; t.k0 = k0; return t;
}
constexpr int CVT_DENSE_TILES = (AB_N + DM + CD_N + 1024 + DM) / 64 * (DM / 256);
constexpr int CVT_MOE_TILES_PER_EXP = (1024 / 64) * (1024 / 256) + (1024 / 64) * (512 / 256);
constexpr int CVT_MOE_TILES = NEXP * CVT_MOE_TILES_PER_EXP;
DI CvtTile cvt_dense_desc(const Frame& F, const Args& a, int item) {
    const int rt = item >> 2, kt = item & 3;
    int r = rt * 64;
    if (r < AB_N) return cvt_desc<CV_AB_IN>(F, a, (bf16_t*)(a.ws + WS_WAB_IN), DM, r, kt * 256, 0, 0);
    r -= AB_N;
    if (r < DM) return cvt_desc<CV_AB_OUT>(F, a, (bf16_t*)(a.ws + WS_WAB_OUT), DM, r, kt * 256, 0, 0);
    r -= DM;
    if (r < CD_N + 1024) return cvt_desc<CV_CD_IN>(F, a, (bf16_t*)(a.ws + WS_WCD_IN), DM, r, kt * 256, 0, 0);
    r -= CD_N + 1024;
    return cvt_desc<CV_CD_OUT>(F, a, (bf16_t*)(a.ws + WS_WCD_OUT), DM, r, kt * 256, 0, 0);
}
DI CvtTile cvt_moe_desc(const Frame& F, const Args& a, int layer, int item) {
    const int e = item / CVT_MOE_TILES_PER_EXP, t = item % CVT_MOE_TILES_PER_EXP;
    bf16_t* base = (bf16_t*)(a.ws + WS_MOE_W + (size_t)e * 3 * MiB);
    if (t < 64) return cvt_desc<CV_MOE_GU>(F, a, base, DM, (t >> 2) * 64, (t & 3) * 256, layer, e);
    const int t2 = t - 64; return cvt_desc<CV_MOE_D>(F, a, base + (size_t)DM * DM, DEXP, (t2 >> 1) * 64, (t2 & 1) * 256, layer, e);
}
DI void cvt_load(const Frame& F, const CvtTile& t, f32x4 (&v)[8]) {
#pragma unroll
    for (int it = 0; it < 8; ++it) {
        const int kk = (F.tid >> 4) + 32 * it;
        v[it] = (f32x4){0.f, 0.f, 0.f, 0.f};
        if (t.sp) v[it] = *(const f32x4*)(t.sp + (size_t)(t.k0 + kk) * t.ld);
    }
}
DI void cvt_store(const Frame& F, const CvtTile& t, const f32x4 (&v)[8]) {
    LAS bf16_t* T = (LAS bf16_t*)F.lds;
    const int c4 = F.tid & 15;
#pragma unroll
    for (int it = 0; it < 8; ++it) {
        const int kk = (F.tid >> 4) + 32 * it;
        const unsigned p01 = pack_bf16(v[it][0], v[it][1]), p23 = pack_bf16(v[it][2], v[it][3]);
        T[(4 * c4 + 0) * CV_LD + kk] = (bf16_t)(p01 & 0xffffu); T[(4 * c4 + 1) * CV_LD + kk] = (bf16_t)(p01 >> 16);
        T[(4 * c4 + 2) * CV_LD + kk] = (bf16_t)(p23 & 0xffffu); T[(4 * c4 + 3) * CV_LD + kk] = (bf16_t)(p23 >> 16);
    }
    __syncthreads();
    {
        const int rr = F.tid >> 3, c = F.tid & 7;
#pragma unroll
        for (int j = 0; j < 4; ++j) {
            const LAS unsigned* src = (const LAS unsigned*)(T + rr * CV_LD + 64 * j + c * 8);
            u32x4 w; w[0] = src[0]; w[1] = src[1]; w[2] = src[2]; w[3] = src[3];
            *(u32x4*)(t.dst + (size_t)(t.r0 + rr) * t.K + t.k0 + 64 * j + c * 8) = w;
        }
    }
    __syncthreads();
}
DI CvtTile cvt_any_desc(const Frame& F, const Args& a, int which, int item) {
    if (which == 0) { if (item < CVT_DENSE_TILES) return cvt_dense_desc(F, a, item); return cvt_moe_desc(F, a, 0, item - CVT_DENSE_TILES); }
    return cvt_moe_desc(F, a, 1, item);
}
DI void cvt_run(const Frame& F, const Args& a, int which, int n_items) {
    int it = F.bid;
    if (it >= n_items) return;
    CvtTile cur = cvt_any_desc(F, a, which, it);
    f32x4 v[8]; cvt_load(F, cur, v);
    for (;;) {
        const int nx = it + F.G; const bool has = nx < n_items;
        CvtTile nxt = cur; f32x4 vn[8];
        if (has) { nxt = cvt_any_desc(F, a, which, nx); cvt_load(F, nxt, vn); }
        cvt_store(F, cur, v);
        if (!has) break;
        cur = nxt; it = nx;
#pragma unroll
        for (int i = 0; i < 8; ++i) v[i] = vn[i];
    }
}
DI void mod_item(const Frame& F, const Args& a, int item) {
    LAS float* sc = (LAS float*)F.lds;
    LAS float* part = (LAS float*)(F.lds + 16384);
    for (int i = F.tid; i < NB * DM; i += NTHR) sc[i] = silu_f(a.c[i]);
    __syncthreads();
    const int l = item / 96, j = (item % 96) * 64 + F.lane;
    const float* w = a.ada_w + (size_t)l * DM * 6 * DM + (size_t)(F.wave * 128) * 6 * DM + j;
    float acc[NB] = {0.f, 0.f, 0.f, 0.f};
#pragma unroll 8
    for (int k = 0; k < 128; ++k) {
        const float wv = w[(size_t)k * 6 * DM];
#pragma unroll
        for (int b = 0; b < NB; ++b) acc[b] += sc[b * DM + F.wave * 128 + k] * wv;
    }
#pragma unroll
    for (int b = 0; b < NB; ++b) part[(F.wave * NB + b) * 64 + F.lane] = acc[b];
    __syncthreads();
    if (F.tid < NB * 64) {
        const int b = F.tid >> 6, c = F.tid & 63;
        float sum = 0.f;
#pragma unroll
        for (int wv = 0; wv < NWAVE; ++wv) sum += part[(wv * NB + b) * 64 + c];
        const int jj = (item % 96) * 64 + c;
        float* mod = (float*)(a.ws + WS_MOD);
        mod[((size_t)l * NB + b) * 6 * DM + jj] = sum + a.ada_b[l * 6 * DM + jj];
    }
    __syncthreads();
}
DI void p0_prologue(const Frame& F, const Args& a) {
    for (int it = F.bid; it < 192; it += F.G) mod_item(F, a, it);
    cvt_run(F, a, 0, CVT_DENSE_TILES + CVT_MOE_TILES);
}

constexpr int WR_LD = 1028;
DI void moe_seg_table(const Frame& F, const unsigned* cnt, LAS int* seg  ) {
    if (F.tid == 0) { int s = 0; for (int e = 0; e < NEXP; ++e) { seg[e] = s; s += (((int)cnt[e * CNT_STRIDE] + 255) >> 8) << 8; } seg[NEXP] = s; }
    __syncthreads();
}
template <bool COMBINE, bool ROUTE, bool FINAL>
DI void norm_phase(const Frame& F, const Args& a, const float* xsrc, int layer, int which, int layer_c) {
    const float* mod = (const float*)(a.ws + WS_MOD);
    bf16_t* hbuf = (bf16_t*)(a.ws + WS_H);
    unsigned* ctl = (unsigned*)(a.ws + WS_CTL);
    LAS float* wrT = (LAS float*)F.lds;
    LAS float* brs = (LAS float*)(F.lds + 36 * WR_LD * 4);
    LAS int* seg = (LAS int*)F.lds;
    constexpr int RT_CAP = 512;
    LAS int* rcnt = (LAS int*)(F.lds + 149504);
    LAS int* rbase = (LAS int*)(F.lds + 149632);
    LAS int* rt_er = (LAS int*)(F.lds + 149760);
    LAS float* rt_gate = (LAS float*)(F.lds + 149760 + 4096);
    LAS int* rt_tok = (LAS int*)(F.lds + 149760 + 8192);
    if (ROUTE) {
        const float* wg = a.moe_wr_g + (size_t)layer * DM * 4;
        const float* we = a.moe_wr_e + (size_t)layer * DM * 32;
        for (int i = F.tid; i < DM * 4; i += NTHR) { const int k = i >> 2, j = i & 3; wrT[j * WR_LD + k] = wg[i]; }
        for (int i = F.tid; i < DM * 32; i += NTHR) { const int k = i >> 5, j = i & 31; wrT[(4 + j) * WR_LD + k] = we[i]; }
        if (F.tid < NEXP) rcnt[F.tid] = 0;
        for (int i = F.tid; i < 2 * RT_CAP; i += NTHR) rt_er[i] = -1;
        if (F.tid < 4) brs[F.tid] = a.moe_br_g[layer * 4 + F.tid];
        else if (F.tid < 36) brs[F.tid] = a.moe_br_e[layer * 32 + F.tid - 4];
        __syncthreads();
    }
    if (COMBINE) moe_seg_table(F, ctl + CW_CNT + layer_c * NEXP * CNT_STRIDE, seg);
    const bf16_t* ymoe = (const bf16_t*)(a.ws + WS_YMOE);
    const int* tokslot = (const int*)(a.ws + WS_TOKSLOT);
    constexpr int TPW = ROUTE ? 2 : 4;
    for (int tb = (F.bid * NWAVE + F.wave) * TPW; tb < NTOK; tb += F.G * NWAVE * TPW) {
      const int b = tb / SEQ;
      f32x4 xall[TPW][4];
#pragma unroll
      for (int i = 0; i < TPW; ++i)
#pragma unroll
        for (int c = 0; c < 4; ++c) xall[i][c] = *(const f32x4*)(xsrc + (size_t)(tb + i) * DM + c * 256 + F.lane * 4);
      if (COMBINE) {
        int ts[TPW][2];
#pragma unroll
        for (int i = 0; i < TPW; ++i) { ts[i][0] = tokslot[(tb + i) * 2]; ts[i][1] = tokslot[(tb + i) * 2 + 1]; }
        u32x2 yv[TPW][2][4];
#pragma unroll
        for (int i = 0; i < TPW; ++i)
#pragma unroll
          for (int k = 0; k < 2; ++k) {
            const size_t r = (size_t)(seg[ts[i][k] >> 20] + (ts[i][k] & 0xfffff));
#pragma unroll
            for (int c = 0; c < 4; ++c) yv[i][k][c] = *(const u32x2*)(ymoe + r * DM + c * 256 + F.lane * 4);
          }
        const float* g2 = mod + ((size_t)layer_c * NB + b) * 6 * DM + 5 * DM;
#pragma unroll
        for (int c = 0; c < 4; ++c) {
          const int col = c * 256 + F.lane * 4;
          const f32x4 gv = *(const f32x4*)(g2 + col);
#pragma unroll
          for (int i = 0; i < TPW; ++i) {
            const u32x2 y0 = yv[i][0][c], y1 = yv[i][1][c];
            xall[i][c][0] += gv[0] * (bf_lo(y0[0]) + bf_lo(y1[0])); xall[i][c][1] += gv[1] * (bf_hi(y0[0]) + bf_hi(y1[0]));
            xall[i][c][2] += gv[2] * (bf_lo(y0[1]) + bf_lo(y1[1])); xall[i][c][3] += gv[3] * (bf_hi(y0[1]) + bf_hi(y1[1]));
            if (!FINAL) *(f32x4*)(a.out + (size_t)(tb + i) * DM + col) = xall[i][c];
          }
        }
      }
#pragma unroll
      for (int ti = 0; ti < TPW; ++ti) {
        const int tok = tb + ti;
        f32x4 xv[4];
#pragma unroll
        for (int c = 0; c < 4; ++c) xv[c] = xall[ti][c];
        float ss = 0.f;
#pragma unroll
        for (int c = 0; c < 4; ++c) ss += xv[c][0] * xv[c][0] + xv[c][1] * xv[c][1] + xv[c][2] * xv[c][2] + xv[c][3] * xv[c][3];
        ss = wave_sum(ss);
        const float rinv = rsqrtf(ss * (1.0f / DM) + EPS);
        if (FINAL) {
#pragma unroll
            for (int c = 0; c < 4; ++c) {
                const int col = c * 256 + F.lane * 4;
                const f32x4 g = *(const f32x4*)(a.final_norm_g + col);
                f32x4 o; o[0] = xv[c][0] * rinv * g[0]; o[1] = xv[c][1] * rinv * g[1]; o[2] = xv[c][2] * rinv * g[2]; o[3] = xv[c][3] * rinv * g[3];
                *(f32x4*)(a.out + (size_t)tok * DM + col) = o;
            }
            continue;
        }
        const float* ng = a.norm_g + ((size_t)layer * 2 + which) * DM;
        const float* sh = mod + ((size_t)layer * NB + b) * 6 * DM + (which ? 3 : 0) * DM;
        const float* sc = sh + DM;
        f32x4 hv[4];
#pragma unroll
        for (int c = 0; c < 4; ++c) {
            const int col = c * 256 + F.lane * 4;
            const f32x4 g = *(const f32x4*)(ng + col), s1 = *(const f32x4*)(sc + col), s0 = *(const f32x4*)(sh + col);
#pragma unroll
            for (int u = 0; u < 4; ++u) hv[c][u] = (xv[c][u] * rinv * g[u]) * (1.0f + s1[u]) + s0[u];
            u32x2 w; w[0] = pack_bf16(hv[c][0], hv[c][1]); w[1] = pack_bf16(hv[c][2], hv[c][3]);
            *(u32x2*)(hbuf + (size_t)tok * DM + col) = w;
        }
        if (ROUTE) {
            LAS float* lgs = (LAS float*)(F.lds + 36 * WR_LD * 4 + 256) + F.wave * 36;
#pragma unroll 1
            for (int jb = 0; jb < 36; jb += 4) {
                float pp[4];
#pragma unroll
                for (int u = 0; u < 4; ++u) {
                    float p = 0.f;
#pragma unroll
                    for (int c = 0; c < 4; ++c) {
                        const f32x4 w = *(const LAS f32x4*)(wrT + (jb + u) * WR_LD + c * 256 + F.lane * 4);
                        p += hv[c][0] * w[0] + hv[c][1] * w[1] + hv[c][2] * w[2] + hv[c][3] * w[3];
                    }
                    pp[u] = p;
                }
#pragma unroll
                for (int u = 0; u < 4; ++u) pp[u] = wave_sum(pp[u]);
                if (F.lane == 0) { *(LAS f32x4*)(lgs + jb) = (f32x4){pp[0], pp[1], pp[2], pp[3]}; }
            }
            float lg[36];
#pragma unroll
            for (int j = 0; j < 36; ++j) lg[j] = lgs[j] + brs[j];
            int g = 0; float gm = lg[0];
#pragma unroll
            for (int j = 1; j < 4; ++j) if (lg[j] > gm) { gm = lg[j]; g = j; }
            float den = 0.f;
#pragma unroll
            for (int j = 0; j < 4; ++j) den += __expf(lg[j] - gm);
            const float ptop = 1.0f / den;
            float fv[8];
#pragma unroll
            for (int i = 0; i < 8; ++i) fv[i] = (g == 0) ? lg[4 + i] : (g == 1) ? lg[12 + i] : (g == 2) ? lg[20 + i] : lg[28 + i];
            int i1 = 0; float v1 = fv[0];
#pragma unroll
            for (int i = 1; i < 8; ++i) if (fv[i] > v1) { v1 = fv[i]; i1 = i; }
            int i2 = -1; float v2 = -3.0e38f;
#pragma unroll
            for (int i = 0; i < 8; ++i) if (i != i1 && fv[i] > v2) { v2 = fv[i]; i2 = i; }
            const float e2 = __expf(v2 - v1), ga = ptop / (1.0f + e2), gb = ptop * e2 / (1.0f + e2);
            if (F.lane == 0) {
                const int li = ((tb - F.bid * NWAVE * TPW) / (F.G * NWAVE * TPW)) * NWAVE * TPW + F.wave * TPW + ti;
                const int ea = g * 8 + i1, eb = g * 8 + i2;
                const int ra = __hip_atomic_fetch_add(&rcnt[ea], 1, __ATOMIC_RELAXED, __HIP_MEMORY_SCOPE_WORKGROUP);
                const int rb = __hip_atomic_fetch_add(&rcnt[eb], 1, __ATOMIC_RELAXED, __HIP_MEMORY_SCOPE_WORKGROUP);
                if (li < RT_CAP) { rt_er[2 * li] = (ea << 16) | ra; rt_gate[2 * li] = ga; rt_tok[2 * li] = tok; rt_er[2 * li + 1] = (eb << 16) | rb; rt_gate[2 * li + 1] = gb; rt_tok[2 * li + 1] = tok; }
            }
        }
      }
    }
    if (ROUTE) {
        __syncthreads();
        unsigned* cnt = ctl + CW_CNT + layer * NEXP * CNT_STRIDE;
        if (F.tid < NEXP) { const int n = rcnt[F.tid]; rbase[F.tid] = n ? (int)__hip_atomic_fetch_add(cnt + F.tid * CNT_STRIDE, (unsigned)n, __ATOMIC_RELAXED, __HIP_MEMORY_SCOPE_AGENT) : 0; }
        __syncthreads();
        int* list = (int*)(a.ws + WS_LIST); float* gatev = (float*)(a.ws + WS_GATEV); int* tsl = (int*)(a.ws + WS_TOKSLOT);
        int nloc = 0;
        for (int tb = F.bid * NWAVE * TPW; tb < NTOK; tb += F.G * NWAVE * TPW) nloc += NWAVE * TPW;
        nloc = nloc < RT_CAP ? nloc : RT_CAP;
        for (int i = F.tid; i < 2 * nloc; i += NTHR) {
            const int er = rt_er[i]; if (er < 0) continue;
            const int e = er >> 16, pos = rbase[e] + (er & 0xffff), tok = rt_tok[i];
            list[e * NTOK + pos] = tok; gatev[e * NTOK + pos] = rt_gate[i]; tsl[tok * 2 + (i & 1)] = (e << 20) | pos;
        }
    }
    __syncthreads();
}

constexpr int RP_HT = 0, RP_HT_LD = 1028;
constexpr int RP_PART = 16 * RP_HT_LD * 4;
constexpr int RP_LG = RP_PART + 8 * 16 * 48 * 4;
DI void route_phase(const Frame& F, const Args& a, int layer) {
    const float* mod = (const float*)(a.ws + WS_MOD);
    bf16_t* hbuf = (bf16_t*)(a.ws + WS_H);
    unsigned* ctl = (unsigned*)(a.ws + WS_CTL);
    LAS float* HT = (LAS float*)(F.lds + RP_HT);
    LAS float* PART = (LAS float*)(F.lds + RP_PART);
    LAS float* LG = (LAS float*)(F.lds + RP_LG);
    constexpr int RT_CAP = 512;
    LAS int* rcnt = (LAS int*)(F.lds + 149504);
    LAS int* rbase = (LAS int*)(F.lds + 149632);
    LAS int* rt_er = (LAS int*)(F.lds + 149760);
    LAS float* rt_gate = (LAS float*)(F.lds + 149760 + 4096);
    LAS int* rt_tok = (LAS int*)(F.lds + 149760 + 8192);
    if (F.tid < NEXP) rcnt[F.tid] = 0;
    for (int i = F.tid; i < 2 * RT_CAP; i += NTHR) rt_er[i] = -1;
    const float* wg = a.moe_wr_g + (size_t)layer * DM * 4;
    const float* we = a.moe_wr_e + (size_t)layer * DM * 32;
    const int col = F.lane & 15, kq = F.lane >> 4;
    float Bw[3][32];
#pragma unroll
    for (int s2 = 0; s2 < 32; ++s2) {
        const int k = 128 * F.wave + 16 * (s2 >> 2) + 4 * kq + (s2 & 3);
        Bw[0][s2] = col < 4 ? wg[k * 4 + col] : we[k * 32 + col - 4];
        Bw[1][s2] = we[k * 32 + 12 + col];
        Bw[2][s2] = col < 4 ? we[k * 32 + 28 + col] : 0.f;
    }
    const float* ng = a.norm_g + ((size_t)layer * 2 + 1) * DM;
    __syncthreads();
    const int ngroups = NTOK / 16;
    int li0 = 0;
    for (int gi = F.bid; gi < ngroups; gi += F.G, li0 += 16) {
        const int tb = gi * 16 + F.wave * 2, b = tb / SEQ;
        const float* sh = mod + ((size_t)layer * NB + b) * 6 * DM + 3 * DM;
        const float* scp = sh + DM;
#pragma unroll
        for (int ti = 0; ti < 2; ++ti) {
            const int tok = tb + ti;
            f32x4 xv[4];
#pragma unroll
            for (int c = 0; c < 4; ++c) xv[c] = *(const f32x4*)(a.out + (size_t)tok * DM + c * 256 + F.lane * 4);
            float ss = 0.f;
#pragma unroll
            for (int c = 0; c < 4; ++c) ss += xv[c][0] * xv[c][0] + xv[c][1] * xv[c][1] + xv[c][2] * xv[c][2] + xv[c][3] * xv[c][3];
            ss = wave_sum(ss);
            const float rinv = rsqrtf(ss * (1.0f / DM) + EPS);
#pragma unroll
            for (int c = 0; c < 4; ++c) {
                const int cl = c * 256 + F.lane * 4;
                const f32x4 g = *(const f32x4*)(ng + cl), s1 = *(const f32x4*)(scp + cl), s0 = *(const f32x4*)(sh + cl);
                f32x4 hv;
#pragma unroll
                for (int u = 0; u < 4; ++u) hv[u] = (xv[c][u] * rinv * g[u]) * (1.0f + s1[u]) + s0[u];
                u32x2 w; w[0] = pack_bf16(hv[0], hv[1]); w[1] = pack_bf16(hv[2], hv[3]);
                *(u32x2*)(hbuf + (size_t)tok * DM + cl) = w;
                *(LAS f32x4*)(HT + (F.wave * 2 + ti) * RP_HT_LD + cl) = hv;
            }
        }
        __syncthreads();
        {
            f32x4 acc[3];
#pragma unroll
            for (int n = 0; n < 3; ++n) acc[n] = (f32x4){0.f, 0.f, 0.f, 0.f};
            const LAS float* ap = HT + col * RP_HT_LD + 128 * F.wave + 4 * kq;
#pragma unroll
            for (int s4 = 0; s4 < 8; ++s4) {
                const f32x4 av = *(const LAS f32x4*)(ap + 16 * s4);
#pragma unroll
                for (int u = 0; u < 4; ++u)
#pragma unroll
                    for (int n = 0; n < 3; ++n) acc[n] = __builtin_amdgcn_mfma_f32_16x16x4f32(av[u], Bw[n][4 * s4 + u], acc[n], 0, 0, 0);
            }
#pragma unroll
            for (int n = 0; n < 3; ++n)
#pragma unroll
                for (int r = 0; r < 4; ++r) PART[(F.wave * 16 + 4 * kq + r) * 48 + 16 * n + col] = acc[n][r];
        }
        __syncthreads();
        {
            const int tk = F.tid >> 5, j = F.tid & 31;
            float s0 = 0.f, s1 = 0.f;
#pragma unroll
            for (int wv = 0; wv < NWAVE; ++wv) { s0 += PART[(wv * 16 + tk) * 48 + j]; s1 += PART[(wv * 16 + tk) * 48 + 32 + (j & 3)]; }
            LG[tk * 36 + j] = s0 + (j < 4 ? a.moe_br_g[layer * 4 + j] : a.moe_br_e[layer * 32 + j - 4]);
            if (j < 4) LG[tk * 36 + 32 + j] = s1 + a.moe_br_e[layer * 32 + 28 + j];
        }
        __syncthreads();
        if (F.tid < 16) {
            const int tk = F.tid, tok = gi * 16 + tk;
            float lg[36];
#pragma unroll
            for (int j = 0; j < 36; ++j) lg[j] = LG[tk * 36 + j];
            int g = 0; float gm = lg[0];
#pragma unroll
            for (int j = 1; j < 4; ++j) if (lg[j] > gm) { gm = lg[j]; g = j; }
            float den = 0.f;
#pragma unroll
            for (int j = 0; j < 4; ++j) den += __expf(lg[j] - gm);
            const float ptop = 1.0f / den;
            float fv[8];
#pragma unroll
            for (int i = 0; i < 8; ++i) fv[i] = (g == 0) ? lg[4 + i] : (g == 1) ? lg[12 + i] : (g == 2) ? lg[20 + i] : lg[28 + i];
            int i1 = 0; float v1 = fv[0];
#pragma unroll
            for (int i = 1; i < 8; ++i) if (fv[i] > v1) { v1 = fv[i]; i1 = i; }
            int i2 = -1; float v2 = -3.0e38f;
#pragma unroll
            for (int i = 0; i < 8; ++i) if (i != i1 && fv[i] > v2) { v2 = fv[i]; i2 = i; }
            const float e2 = __expf(v2 - v1), ga = ptop / (1.0f + e2), gb = ptop * e2 / (1.0f + e2);
            const int li = li0 + tk, ea = g * 8 + i1, eb = g * 8 + i2;
            const int ra = __hip_atomic_fetch_add(&rcnt[ea], 1, __ATOMIC_RELAXED, __HIP_MEMORY_SCOPE_WORKGROUP);
            const int rb = __hip_atomic_fetch_add(&rcnt[eb], 1, __ATOMIC_RELAXED, __HIP_MEMORY_SCOPE_WORKGROUP);
            if (li < RT_CAP) { rt_er[2 * li] = (ea << 16) | ra; rt_gate[2 * li] = ga; rt_tok[2 * li] = tok; rt_er[2 * li + 1] = (eb << 16) | rb; rt_gate[2 * li + 1] = gb; rt_tok[2 * li + 1] = tok; }
        }
    }
    __syncthreads();
    unsigned* cnt = ctl + CW_CNT + layer * NEXP * CNT_STRIDE;
    if (F.tid < NEXP) { const int n = rcnt[F.tid]; rbase[F.tid] = n ? (int)__hip_atomic_fetch_add(cnt + F.tid * CNT_STRIDE, (unsigned)n, __ATOMIC_RELAXED, __HIP_MEMORY_SCOPE_AGENT) : 0; }
    __syncthreads();
    int* list = (int*)(a.ws + WS_LIST); float* gatev = (float*)(a.ws + WS_GATEV); int* tsl = (int*)(a.ws + WS_TOKSLOT);
    const int nloc = li0 < RT_CAP ? li0 : RT_CAP;
    for (int i = F.tid; i < 2 * nloc; i += NTHR) {
        const int er = rt_er[i]; if (er < 0) continue;
        const int e = er >> 16, pos = rbase[e] + (er & 0xffff), tok = rt_tok[i];
        list[e * NTOK + pos] = tok; gatev[e * NTOK + pos] = rt_gate[i]; tsl[tok * 2 + (i & 1)] = (e << 20) | pos;
    }
    __syncthreads();
}

constexpr int LDS_MISC = 131072 + 64;
constexpr int LDS_XB = 163840 - 16;
constexpr int LDS_BYTES = 163840;
using pg8::Unit;
struct DenseSched {
    int nM, nN, nwg, G, c; const char* Bt; size_t tstepB;
    DI void init(int M, int N, int K, int G_, int c_, const void* Bt_) { nM = M / 256; nN = N / 256; nwg = nM * nN; G = G_; c = c_; Bt = (const char*)Bt_; tstepB = (size_t)256 * K * 2; }
    DI bool next(int i, Unit& u) const {
        const long L = (long)i * G + c; if (L >= nwg) return false;
        int wgid = (int)L; { const int q = nwg / 8, r = nwg % 8, xcd = wgid % 8, off = wgid / 8; wgid = (xcd < r ? xcd * (q + 1) : r * (q + 1) + (xcd - r) * q) + off; }
        const int nig = 8 * nN, gid = wgid / nig, fm = gid * 8, gsz = (nM - fm) < 8 ? (nM - fm) : 8;
        u.pm = fm + ((wgid % nig) % gsz); u.pn = (wgid % nig) / gsz; u.e = 0; u.nrow = 256; return true;
    }
    DI int a_row(const Unit& u, int r) const { return u.pm * 256 + r; }
    DI const char* b_base(const Unit& u) const { return Bt + (size_t)u.pn * tstepB; }
};
template <bool UP>
struct MoeSched {
    const LAS int* ntp; const unsigned* cnt; const int* list; const char* W; int nU, G, c;
    DI bool next(int i, Unit& u) const {
        const long L = (long)i * G + c; if (L >= nU) return false;
        int wgid = (int)L; { const int q = nU / 8, r = nU % 8, xcd = wgid % 8, off = wgid / 8; wgid = (xcd < r ? xcd * (q + 1) : r * (q + 1) + (xcd - r) * q) + off; }
        const int tg = wgid >> 2; u.pn = wgid & 3; u.pm = tg;
        int e = 0;
        for (int k = 1; k < NEXP; ++k) e += (ntp[k] <= tg) ? 1 : 0;
        u.e = e; const int rem = (int)cnt[e * CNT_STRIDE] - (tg - ntp[e]) * 256; u.nrow = rem < 256 ? rem : 256; return true;
    }
    DI int a_row(const Unit& u, int r) const {
        if (UP) { const int p = (u.pm - ntp[u.e]) * 256 + r; return (r < u.nrow) ? list[u.e * NTOK + p] : 0; }
        return u.pm * 256 + r;
    }
    DI const char* b_base(const Unit& u) const {
        return W + (size_t)u.e * 3 * MiB + (UP ? (size_t)u.pn * 256 * DM * 2 : 2 * MiB + (size_t)u.pn * 256 * DEXP * 2);
    }
};
DI void moe_tile_table(const Frame& F, const unsigned* cnt, LAS int* ntp  ) {
    if (F.tid == 0) { int s = 0; for (int e = 0; e < NEXP; ++e) { ntp[e] = s; s += ((int)cnt[e * CNT_STRIDE] + 255) >> 8; } ntp[NEXP] = s; }
    __syncthreads();
}

#define EPI_ROWS_BEGIN const int row0 = u.pm * 256 + wr * 64 + fr; _Pragma("unroll") for (int ai = 0; ai < 2; ++ai) _Pragma("unroll") for (int m = 0; m < 4; ++m) { const int row = row0 + ai * 128 + m * 16;
#define EPI_ROWS_END }
DI u32x2 pack4(const f32x4& v) { u32x2 w; w[0] = pack_bf16(v[0], v[1]); w[1] = pack_bf16(v[2], v[3]); return w; }

struct EpiAbIn {
    bf16_t* Zc;
    DI void operator()(const f32x4 (&acc)[2][2][4][2], const Unit& u, int wr, int wc, int fr, int fq) const {
        EPI_ROWS_BEGIN
            bf16_t* rp = Zc + (size_t)row * ZC_N;
#pragma unroll
            for (int bj = 0; bj < 2; ++bj) {
                if (u.pn < 2) {
#pragma unroll
                    for (int n = 0; n < 2; ++n) *(u32x2*)(rp + u.pn * 256 + bj * 128 + wc * 32 + n * 16 + 4 * fq) = pack4(acc[ai][bj][m][n]);
                } else {
                    const int pnp = (u.pn - 2) & 3, j = 16 * (8 * pnp + 4 * bj + wc) + 4 * fq;
                    const f32x4 X = acc[ai][bj][m][0], Y = acc[ai][bj][m][1]; f32x4 v;
                    if (u.pn < 6) { v = X * Y; *(u32x2*)(rp + 512 + j) = pack4(v); }
                    else { v[0] = X[0] * sigmoid_f(Y[0]); v[1] = X[1] * sigmoid_f(Y[1]); v[2] = X[2] * sigmoid_f(Y[2]); v[3] = X[3] * sigmoid_f(Y[3]); *(u32x2*)(rp + 1024 + j) = pack4(v); }
                }
            }
        EPI_ROWS_END
    }
};
struct EpiResid {
    const float* xin; float* xout; const float* g1;
    DI void operator()(const f32x4 (&acc)[2][2][4][2], const Unit& u, int wr, int wc, int fr, int fq) const {
        const float* g = g1 + (size_t)((u.pm * 256) / SEQ) * 6 * DM;
        EPI_ROWS_BEGIN
#pragma unroll
            for (int bj = 0; bj < 2; ++bj)
#pragma unroll
                for (int n = 0; n < 2; ++n) {
                    const int col = u.pn * 256 + bj * 128 + wc * 32 + n * 16 + 4 * fq;
                    const f32x4 xo = *(const f32x4*)(xin + (size_t)row * DM + col), gv = *(const f32x4*)(g + col);
                    *(f32x4*)(xout + (size_t)row * DM + col) = xo + gv * acc[ai][bj][m][n];
                }
        EPI_ROWS_END
    }
};
struct EpiPlain {
    bf16_t* O; int ld;
    DI void operator()(const f32x4 (&acc)[2][2][4][2], const Unit& u, int wr, int wc, int fr, int fq) const {
        EPI_ROWS_BEGIN
#pragma unroll
            for (int bj = 0; bj < 2; ++bj)
#pragma unroll
                for (int n = 0; n < 2; ++n) *(u32x2*)(O + (size_t)row * ld + u.pn * 256 + bj * 128 + wc * 32 + n * 16 + 4 * fq) = pack4(acc[ai][bj][m][n]);
        EPI_ROWS_END
    }
};
struct EpiMoeUp {
    bf16_t* act;
    DI void operator()(const f32x4 (&acc)[2][2][4][2], const Unit& u, int wr, int wc, int fr, int fq) const {
        EPI_ROWS_BEGIN
#pragma unroll
            for (int bj = 0; bj < 2; ++bj) {
                const int j = 16 * (8 * u.pn + 4 * bj + wc) + 4 * fq;
                const f32x4 X = acc[ai][bj][m][0], Y = acc[ai][bj][m][1]; f32x4 v;
                v[0] = silu_f(X[0]) * Y[0]; v[1] = silu_f(X[1]) * Y[1]; v[2] = silu_f(X[2]) * Y[2]; v[3] = silu_f(X[3]) * Y[3];
                *(u32x2*)(act + (size_t)row * DEXP + j) = pack4(v);
            }
        EPI_ROWS_END
    }
};
struct EpiMoeDown {
    bf16_t* y; const float* gatev; const LAS int* ntp;
    DI void operator()(const f32x4 (&acc)[2][2][4][2], const Unit& u, int wr, int wc, int fr, int fq) const {
        const int pbase = (u.pm - ntp[u.e]) * 256;
        EPI_ROWS_BEGIN
            const int r = row - u.pm * 256;
            const float gt = (r < u.nrow) ? gatev[u.e * NTOK + pbase + r] : 0.f;
#pragma unroll
            for (int bj = 0; bj < 2; ++bj)
#pragma unroll
                for (int n = 0; n < 2; ++n) *(u32x2*)(y + (size_t)row * DM + u.pn * 256 + bj * 128 + wc * 32 + n * 16 + 4 * fq) = pack4(acc[ai][bj][m][n] * gt);
        EPI_ROWS_END
    }
};

DI void conv_phase(const Frame& F, const Args& a) {
    const bf16_t* Zc = (const bf16_t*)(a.ws + WS_BIG);
    bf16_t* Y = (bf16_t*)(a.ws + WS_Y);
    LAS unsigned* PB = (LAS unsigned*)F.lds;
    LAS f32x2* ST = (LAS f32x2*)(F.lds + 94 * 1024);
    const int cp = F.tid & 255, th = F.tid >> 8, wq = F.wave & 3;
    float wb[31][2], wa[3][2];
#pragma unroll
    for (int k = 0; k < 31; ++k) { const f32x2 w = *(const f32x2*)(a.ab_conv_b + k * 512 + 2 * cp); wb[k][0] = w[0]; wb[k][1] = w[1]; }
#pragma unroll
    for (int k = 0; k < 3; ++k) { const f32x2 w = *(const f32x2*)(a.ab_conv_a + k * 512 + 2 * cp); wa[k][0] = w[0]; wa[k][1] = w[1]; }
    const f32x2 cbias = *(const f32x2*)(a.ab_conv_b_bias + 2 * cp), lng = *(const f32x2*)(a.ab_ln_g + 2 * cp), lnb = *(const f32x2*)(a.ab_ln_b + 2 * cp);
    for (int tile = F.bid; tile < NTOK / 64; tile += F.G) {
        const int t0 = tile * 64, b = t0 / SEQ, tl0 = t0 % SEQ;
        for (int i = F.tid; i < 94 * 64; i += NTHR) {
            const int r = i >> 6, c8 = i & 63, pos = tl0 - 30 + r;
            u32x4 v = {0u, 0u, 0u, 0u};
            if (pos >= 0) v = *(const u32x4*)(Zc + (size_t)(b * SEQ + pos) * ZC_N + 1024 + c8 * 8);
            *(LAS u32x4*)(PB + r * 256 + c8 * 4) = v;
        }
        __syncthreads();
#pragma unroll 1
        for (int g = 0; g < 4; ++g) {
            float U[8][2];
#pragma unroll
            for (int i = 0; i < 8; ++i) { U[i][0] = cbias[0]; U[i][1] = cbias[1]; }
#pragma unroll
            for (int r = 0; r < 38; ++r) {
                const unsigned xw = PB[(32 * th + 8 * g + r) * 256 + cp];
                const float x0 = bf_lo(xw), x1 = bf_hi(xw);
#pragma unroll
                for (int i = 0; i < 8; ++i) { const int k = r - i; if (k >= 0 && k <= 30) { U[i][0] += wb[k][0] * x0; U[i][1] += wb[k][1] * x1; } }
            }
#pragma unroll
            for (int i = 0; i < 8; ++i) {
                const float s1 = wave_sum(U[i][0] + U[i][1]), s2 = wave_sum(U[i][0] * U[i][0] + U[i][1] * U[i][1]);
                if (F.lane == 0) ST[(32 * th + 8 * g + i) * 4 + wq] = (f32x2){s1, s2};
            }
            __syncthreads();
#pragma unroll
            for (int i = 0; i < 8; ++i) {
                const int tl = 32 * th + 8 * g + i; const size_t tok = (size_t)t0 + tl; const int pos = tl0 + tl;
                const f32x2 p0 = ST[tl * 4 + 0], p1 = ST[tl * 4 + 1], p2 = ST[tl * 4 + 2], p3 = ST[tl * 4 + 3];
                const float mean = ((p0[0] + p1[0]) + (p2[0] + p3[0])) * (1.0f / 512.0f);
                const float var = ((p0[1] + p1[1]) + (p2[1] + p3[1])) * (1.0f / 512.0f) - mean * mean;
                const float rstd = rsqrtf(var + EPS);
                const float yb0 = silu_f((U[i][0] - mean) * rstd * lng[0] + lnb[0]), yb1 = silu_f((U[i][1] - mean) * rstd * lng[1] + lnb[1]);
                *(unsigned*)(Y + tok * DM + 512 + 2 * cp) = pack_bf16(yb0, yb1);
                float a0 = 0.f, a1 = 0.f;
#pragma unroll
                for (int k = 0; k < 3; ++k) {
                    const int pp = pos - 2 + k;
                    if (pp >= 0) { const unsigned w = *(const unsigned*)(Zc + (size_t)(b * SEQ + pp) * ZC_N + 512 + 2 * cp); a0 += wa[k][0] * bf_lo(w); a1 += wa[k][1] * bf_hi(w); }
                }
                const unsigned gw = *(const unsigned*)(Zc + tok * ZC_N + 2 * cp);
                *(unsigned*)(Y + tok * DM + 2 * cp) = pack_bf16(bf_lo(gw) * a0, bf_hi(gw) * a1);
            }
        }
        __syncthreads();
    }
}

#define MFMA32(a, b, c) __builtin_amdgcn_mfma_f32_32x32x16_bf16((a), (b), (c), 0, 0, 0)
constexpr int TK_HIST = 0;
constexpr int TK_TAB = 65536;
constexpr int TK_CAP = 128;
constexpr int TK_CAND = 66048;
constexpr int TK_CCNT = TK_CAND + 32 * TK_CAP * 4;
constexpr int TK_OVF = TK_CCNT + 128;
constexpr int TK_BQ = 83968;
constexpr int TK_MASK = 102400;
DI int crow_c(int r) { return (r & 3) + 8 * (r >> 2); }
template <int MODE, bool DIAG>
DI void topk_elems(const Frame& F, const f32x16& sc, int kt, int q, int h2, int myT, LAS unsigned* hist, LAS unsigned* cand, LAS int* ccnt, LAS unsigned* maskl) {
    unsigned bits = 0u;
    const int lo = myT << 9, hi = (myT + 1) << 9;
#pragma unroll
    for (int r = 0; r < 16; ++r) {
        int key = (int)sc[r]; key = key < 0 ? 0 : (key > 262143 ? 262143 : key);
        const bool valid = !DIAG || (crow_c(r) + 4 * h2 <= q);
        if (MODE == 1) { if (valid) __hip_atomic_fetch_add(&hist[q * 512 + (key >> 9)], 1u, __ATOMIC_RELAXED, __HIP_MEMORY_SCOPE_WORKGROUP); }
        else if (MODE == 2) { if (valid && (key >> 9) == myT) __hip_atomic_fetch_add(&hist[q * 512 + (key & 511)], 1u, __ATOMIC_RELAXED, __HIP_MEMORY_SCOPE_WORKGROUP); }
        else if (MODE == 3) {
            if (valid && key > myT) bits |= 1u << crow_c(r);
            if (valid && key == myT) { const int p = __hip_atomic_fetch_add(&ccnt[q], 1, __ATOMIC_RELAXED, __HIP_MEMORY_SCOPE_WORKGROUP); if (p < TK_CAP) cand[q * TK_CAP + p] = (unsigned)(8191 - (32 * kt + crow_c(r) + 4 * h2)); }
        } else {
            if (valid && key >= hi) bits |= 1u << crow_c(r);
            if (valid && key >= lo && key < hi) { const int p = __hip_atomic_fetch_add(&ccnt[q], 1, __ATOMIC_RELAXED, __HIP_MEMORY_SCOPE_WORKGROUP); if (p < TK_CAP) cand[q * TK_CAP + p] = ((unsigned)(key - lo) << 13) | (unsigned)(8191 - (32 * kt + crow_c(r) + 4 * h2)); }
        }
    }
    if (MODE >= 3) {
        bits <<= 4 * h2;
        bits |= (unsigned)__shfl_xor((int)bits, 32);
        if (h2 == 0) maskl[q * 256 + kt] = bits;
    }
}
template <int MODE>
DI void topk_pass(const Frame& F, const bf16_t* Z, int b, int t0, const float (&wp)[8]) {
    const LAS unsigned char* bq = F.lds + TK_BQ;
    LAS unsigned* hist = (LAS unsigned*)(F.lds + TK_HIST);
    LAS int* tab = (LAS int*)(F.lds + TK_TAB);
    LAS unsigned* cand = (LAS unsigned*)(F.lds + TK_CAND);
    LAS int* ccnt = (LAS int*)(F.lds + TK_CCNT);
    LAS unsigned* maskl = (LAS unsigned*)(F.lds + TK_MASK);
    const int lane = fresh_lane(), q = lane & 31, h2 = lane >> 5, ntile = t0 / 32 + 1;
    const int myT = (MODE >= 2) ? tab[q * 4 + 0] : 0;
    const bf16_t* kbase = Z + (size_t)b * SEQ * CD_N + Z_KI + 8 * h2 + (size_t)q * CD_N;
    bf16x8 A0n = (bf16x8){0, 0, 0, 0, 0, 0, 0, 0}, A1n = A0n;
    if (F.wave < ntile) { const bf16_t* kp = kbase + (size_t)(32 * F.wave) * CD_N; A0n = *(const bf16x8*)kp; A1n = *(const bf16x8*)(kp + 16); }
    for (int kt = F.wave; kt < ntile; kt += NWAVE) {
        const bf16x8 A0 = A0n, A1 = A1n;
        if (kt + NWAVE < ntile) { const bf16_t* kp = kbase + (size_t)(32 * (kt + NWAVE)) * CD_N; A0n = *(const bf16x8*)kp; A1n = *(const bf16x8*)(kp + 16); }
        f32x16 sc;
#pragma unroll
        for (int r = 0; r < 16; ++r) sc[r] = 131072.0f;
        bf16x8 A0g = A0, A1g = A1;
#pragma unroll
        for (int g = 0; g < 3; ++g) {
            if (g > 0) asm volatile("" : "+v"(A0g), "+v"(A1g) : "v"(sc[15]));
            f32x16 ac[3];
#pragma unroll
            for (int u = 0; u < 3; ++u) {
                const int h = (g == 0) ? (u == 0 ? 8 : u - 1) : (3 * g + u - 1);
#pragma unroll
                for (int r = 0; r < 16; ++r) ac[u][r] = 0.f;
                ac[u] = MFMA32(A0g, *(const LAS bf16x8*)(bq + ((2 * h) * 64 + lane) * 16), ac[u]); ac[u] = MFMA32(A1g, *(const LAS bf16x8*)(bq + ((2 * h + 1) * 64 + lane) * 16), ac[u]);
            }
#pragma unroll
            for (int u = 0; u < 3; ++u) {
                const int h = (g == 0) ? (u == 0 ? 8 : u - 1) : (3 * g + u - 1);
                if (h == 8) {
#pragma unroll
                    for (int r = 0; r < 16; ++r) sc[r] += ac[u][r];
                } else {
#pragma unroll
                    for (int r = 0; r < 16; ++r) sc[r] += __builtin_fabsf(ac[u][r]) * wp[h];
                }
            }
        }
        if (kt == ntile - 1) topk_elems<MODE, true>(F, sc, kt, q, h2, myT, hist, cand, ccnt, maskl);
        else topk_elems<MODE, false>(F, sc, kt, q, h2, myT, hist, cand, ccnt, maskl);
    }
}
DI void topk_scan(const Frame& F, int pass, int t0) {
    LAS unsigned* hist = (LAS unsigned*)(F.lds + TK_HIST);
    LAS int* tab = (LAS int*)(F.lds + TK_TAB);
    LAS int* ovf = (LAS int*)(F.lds + TK_OVF);
    for (int qi = 0; qi < 4; ++qi) {
        const int q = F.wave * 4 + qi, n = t0 + q + 1;
        int need = 256, prevT = 0, prevAbove = 0;
        if (pass == 2) { prevT = tab[q * 4 + 0]; prevAbove = tab[q * 4 + 1]; need = 256 - prevAbove; }
        if (n <= 256) { if (F.lane == 0) { tab[q * 4 + 0] = -1; tab[q * 4 + 1] = 0; tab[q * 4 + 2] = 0; } continue; }
        unsigned hv[8]; unsigned s = 0;
#pragma unroll
        for (int i = 0; i < 8; ++i) { hv[i] = hist[q * 512 + 511 - (8 * F.lane + i)]; s += hv[i]; }
        unsigned inc = s;
#pragma unroll
        for (int o = 1; o < 64; o <<= 1) { const unsigned v = (unsigned)__shfl_up((int)inc, o); if (F.lane >= o) inc += v; }
        const unsigned pre = inc - s;
        if ((int)pre < need && (int)inc >= need) {
            unsigned cum = pre; int bsel = 0; unsigned above = 0, inbin = 0; bool found = false;
#pragma unroll
            for (int i = 0; i < 8; ++i) { if (!found && (int)(cum + hv[i]) >= need) { found = true; bsel = 511 - (8 * F.lane + i); above = cum; inbin = hv[i]; } cum += hv[i]; }
            if (pass == 1) { tab[q * 4 + 0] = bsel; tab[q * 4 + 1] = (int)above; tab[q * 4 + 2] = 256 - (int)above; if (inbin > (unsigned)TK_CAP) *ovf = 1; }
            else { tab[q * 4 + 0] = (prevT << 9) | bsel; tab[q * 4 + 1] = prevAbove + (int)above; tab[q * 4 + 2] = 256 - (prevAbove + (int)above); }
        }
    }
}
DI void topk_select(const Frame& F) {
    LAS int* tab = (LAS int*)(F.lds + TK_TAB);
    LAS unsigned* cand = (LAS unsigned*)(F.lds + TK_CAND);
    LAS int* ccnt = (LAS int*)(F.lds + TK_CCNT);
    LAS unsigned* maskl = (LAS unsigned*)(F.lds + TK_MASK);
    for (int qi = 0; qi < 4; ++qi) {
        const int q = F.wave * 4 + qi, need = tab[q * 4 + 2];
        int n = ccnt[q]; n = n > TK_CAP ? TK_CAP : n;
        if (need <= 0 || n <= 0) continue;
        const bool v0 = F.lane < n, v1 = F.lane + 64 < n;
        const unsigned c0 = v0 ? cand[q * TK_CAP + F.lane] : 0u, c1 = v1 ? cand[q * TK_CAP + F.lane + 64] : 0u;
        int r0 = 0, r1 = 0;
        for (int j = 0; j < n; ++j) { const unsigned cj = cand[q * TK_CAP + j]; r0 += (cj > c0) ? 1 : 0; r1 += (cj > c1) ? 1 : 0; }
        if (v0 && r0 < need) { const int idx = 8191 - (int)(c0 & 8191u); __hip_atomic_fetch_or(&maskl[q * 256 + (idx >> 5)], 1u << (idx & 31), __ATOMIC_RELAXED, __HIP_MEMORY_SCOPE_WORKGROUP); }
        if (v1 && r1 < need) { const int idx = 8191 - (int)(c1 & 8191u); __hip_atomic_fetch_or(&maskl[q * 256 + (idx >> 5)], 1u << (idx & 31), __ATOMIC_RELAXED, __HIP_MEMORY_SCOPE_WORKGROUP); }
    }
}
DI void topk_phase(const Frame& F, const Args& a) {
    const bf16_t* Z = (const bf16_t*)(a.ws + WS_BIG);
    unsigned* maskg = (unsigned*)(a.ws + WS_MASK);
    LAS unsigned* hist = (LAS unsigned*)(F.lds + TK_HIST);
    LAS int* ccnt = (LAS int*)(F.lds + TK_CCNT);
    LAS int* ovf = (LAS int*)(F.lds + TK_OVF);
    LAS unsigned* maskl = (LAS unsigned*)(F.lds + TK_MASK);
    for (int pi = F.bid; pi < 512; pi += F.G) {
        const int b = pi >> 7, p = pi & 127;
        for (int half = 0; half < 2; ++half) {
            const int t0 = 32 * (half ? 255 - p : p), ntile = t0 / 32 + 1;
            const int lane0 = fresh_lane(), q = lane0 & 31, h2 = lane0 >> 5;
            const bf16_t* zr = Z + (size_t)(b * SEQ + t0 + q) * CD_N;
            float wp[8];
            { const u32x4 wv = *(const u32x4*)(zr + Z_WI);
              const float sc = 0.0625f * 0.5f * 16384.0f;
              wp[0] = bf_lo(wv[0]) * sc; wp[1] = bf_hi(wv[0]) * sc; wp[2] = bf_lo(wv[1]) * sc; wp[3] = bf_hi(wv[1]) * sc;
              wp[4] = bf_lo(wv[2]) * sc; wp[5] = bf_hi(wv[2]) * sc; wp[6] = bf_lo(wv[3]) * sc; wp[7] = bf_hi(wv[3]) * sc; }
            __syncthreads();
            if (F.wave == 0) {
                LAS unsigned char* bqw = F.lds + TK_BQ;
                float lin[2][8];
#pragma unroll
                for (int ks = 0; ks < 2; ++ks)
#pragma unroll
                    for (int j = 0; j < 8; ++j) lin[ks][j] = 0.f;
#pragma unroll
                for (int h = 0; h < 8; ++h)
#pragma unroll
                    for (int ks = 0; ks < 2; ++ks) {
                        const u32x4 v = *(const u32x4*)(zr + Z_QI + 32 * h + 16 * ks + 8 * h2);
                        *(LAS u32x4*)(bqw + ((2 * h + ks) * 64 + lane0) * 16) = v;
#pragma unroll
                        for (int j = 0; j < 4; ++j) { lin[ks][2 * j] += wp[h] * bf_lo(v[j]); lin[ks][2 * j + 1] += wp[h] * bf_hi(v[j]); }
                    }
#pragma unroll
                for (int ks = 0; ks < 2; ++ks) {
                    u32x4 v; v[0] = pack_bf16(lin[ks][0], lin[ks][1]); v[1] = pack_bf16(lin[ks][2], lin[ks][3]); v[2] = pack_bf16(lin[ks][4], lin[ks][5]); v[3] = pack_bf16(lin[ks][6], lin[ks][7]);
                    *(LAS u32x4*)(bqw + ((16 + ks) * 64 + lane0) * 16) = v;
                }
            }
            for (int i = F.tid; i < 32 * 512; i += NTHR) hist[i] = 0u;
            if (F.tid < 32) ccnt[F.tid] = 0;
            if (F.tid == 32) *ovf = 0;
            __syncthreads();
            topk_pass<1>(F, Z, b, t0, wp);
            __syncthreads();
            topk_scan(F, 1, t0);
            __syncthreads();
            if (*ovf == 0) {
                topk_pass<4>(F, Z, b, t0, wp);
            } else {
                for (int i = F.tid; i < 32 * 512; i += NTHR) hist[i] = 0u;
                __syncthreads();
                topk_pass<2>(F, Z, b, t0, wp);
                __syncthreads();
                topk_scan(F, 2, t0);
                __syncthreads();
                topk_pass<3>(F, Z, b, t0, wp);
            }
            __syncthreads();
            topk_select(F);
            __syncthreads();
            for (int i = F.wave * 64 + fresh_lane(); i < 32 * ntile; i += NTHR) { const int qq = i / ntile, kt = i - qq * ntile; maskg[(size_t)(b * SEQ + t0 + qq) * 256 + kt] = maskl[qq * 256 + kt]; }
        }
    }
}

constexpr int AT_KSTR = 72;
constexpr int AT_VSTR = 72;
constexpr int AT_KBYTES = 64 * AT_KSTR * 2;
constexpr int AT_VBYTES = 128 * AT_VSTR * 2;
constexpr int AT_BUF = AT_KBYTES + AT_VBYTES;
constexpr int AT_LUT = 2 * AT_BUF;
constexpr int AT_LUT_LD = 132;
constexpr float NEG_INF = -__builtin_huge_valf();
constexpr float AT_THR = 8.0f;

template <int DV, bool MASKED>
DI void attn_core(const Frame& F, const bf16_t* Z, const bf16_t* Vt, int b, int qcol, int kcol, int vrow, int q0, const LAS float* lut, float c1, const unsigned* maskg, f32x16 (&O)[DV / 32]) {
    constexpr int NDV = DV / 32;
    const int q = F.lane & 31, h2 = F.lane >> 5;
    const int tw0 = q0 + 32 * F.wave, t = tw0 + q;
    const bf16_t* Zb = Z + (size_t)b * SEQ * CD_N;
    const bf16_t* Vb = Vt + (size_t)vrow * NTOK + (size_t)b * SEQ;
    const unsigned* mrow = maskg + (size_t)(b * SEQ + t) * 256;
    bf16x8 Qf[4];
#pragma unroll
    for (int ks = 0; ks < 4; ++ks) Qf[ks] = *(const bf16x8*)(Zb + (size_t)t * CD_N + qcol + 16 * ks + 8 * h2);
#pragma unroll
    for (int d = 0; d < NDV; ++d)
#pragma unroll
        for (int r = 0; r < 16; ++r) O[d][r] = 0.f;
    float m_run = NEG_INF, l_run = 0.f;
    const int jmax = (q0 + 255) >> 6;
    const int kkey = F.tid >> 3, kch = F.tid & 7;
    u32x4 kreg, vreg[DV / 64]; unsigned mreg[2] = {0u, 0u};
#define AT_LOAD(j) do { kreg = *(const u32x4*)(Zb + (size_t)(64 * (j) + kkey) * CD_N + kcol + 8 * kch); \
        _Pragma("unroll") for (int _i = 0; _i < DV / 64; ++_i) { const int idx = F.tid + NTHR * _i; vreg[_i] = *(const u32x4*)(Vb + (size_t)(idx >> 3) * NTOK + 64 * (j) + 8 * (idx & 7)); } \
        if (MASKED) { mreg[0] = mrow[2 * (j)]; mreg[1] = mrow[2 * (j) + 1]; } } while (0)
#define AT_STORE(buf) do { LAS unsigned char* kb_ = F.lds + (buf) * AT_BUF; *(LAS u32x4*)(kb_ + kkey * (AT_KSTR * 2) + kch * 16) = kreg; \
        _Pragma("unroll") for (int _i = 0; _i < DV / 64; ++_i) { const int idx = F.tid + NTHR * _i, dv_ = idx >> 3, ch_ = idx & 7; \
            LAS unsigned char* vp_ = kb_ + AT_KBYTES + dv_ * (AT_VSTR * 2) + (16 * (ch_ >> 1) + 4 * (ch_ & 1)) * 2; \
            *(LAS u32x2*)vp_ = (u32x2){vreg[_i][0], vreg[_i][1]}; *(LAS u32x2*)(vp_ + 16) = (u32x2){vreg[_i][2], vreg[_i][3]}; } } while (0)
    AT_LOAD(0); AT_STORE(0);
    unsigned mcur[2] = {mreg[0], mreg[1]};
    __syncthreads();
    for (int j = 0; j <= jmax; ++j) {
        if (j < jmax) AT_LOAD(j + 1);
        if (64 * j <= tw0 + 31) {
            const LAS unsigned char* kb = F.lds + (j & 1) * AT_BUF;
            const LAS unsigned char* vt = kb + AT_KBYTES;
            f32x16 s[2];
#pragma unroll
            for (int kb2 = 0; kb2 < 2; ++kb2) {
                bf16x8 Kf[4];
#pragma unroll
                for (int ks = 0; ks < 4; ++ks) Kf[ks] = *(const LAS bf16x8*)(kb + (32 * kb2 + q) * (AT_KSTR * 2) + (16 * ks + 8 * h2) * 2);
#pragma unroll
                for (int r = 0; r < 16; ++r) s[kb2][r] = 0.f;
#pragma unroll
                for (int ks = 0; ks < 4; ++ks) s[kb2] = MFMA32(Kf[ks], Qf[ks], s[kb2]);
            }
            const bool nearb = (64 * j + 63 + 128 > tw0);
            float mloc = NEG_INF;
            if (!nearb) {
#pragma unroll
                for (int kb2 = 0; kb2 < 2; ++kb2)
#pragma unroll
                    for (int r = 0; r < 16; ++r) mloc = fmaxf(mloc, s[kb2][r]);
                mloc = mloc * c1 + lut[128];
            } else {
#pragma unroll
                for (int kb2 = 0; kb2 < 2; ++kb2) {
                    float bl[16];
#pragma unroll
                    for (int r = 0; r < 16; ++r) {
                        int dist = t - (64 * j + 32 * kb2 + crow_c(r) + 4 * h2);
                        dist = dist < 0 ? 129 : (dist > 128 ? 128 : dist);
                        bl[r] = lut[dist];
                    }
#pragma unroll
                    for (int r = 0; r < 16; ++r) { s[kb2][r] = s[kb2][r] * c1 + bl[r]; mloc = fmaxf(mloc, s[kb2][r]); }
                }
            }
            mloc = fmaxf(mloc, __shfl_xor(mloc, 32));
            if (__any(mloc > m_run + AT_THR)) {
                const float m_new = fmaxf(m_run, mloc);
                const float alpha = __builtin_amdgcn_exp2f(m_run - m_new);
                m_run = m_new; l_run *= alpha;
#pragma unroll
                for (int d = 0; d < NDV; ++d)
#pragma unroll
                    for (int r = 0; r < 16; ++r) O[d][r] *= alpha;
            }
            const float sub = lut[128] - m_run;
            float psum0 = 0.f, psum1 = 0.f;
            constexpr int NH = NDV / 2, NST = 4 * NH;
            bf16x8 Av[2][2];
#pragma unroll
            for (int d = 0; d < 2; ++d) Av[0][d] = *(const LAS bf16x8*)(vt + (32 * d + q) * (AT_VSTR * 2) + (8 * h2) * 2);
            if (!nearb) {
#pragma unroll
                for (int kb2 = 0; kb2 < 2; ++kb2)
#pragma unroll
                    for (int r = 0; r < 16; ++r) s[kb2][r] = __builtin_amdgcn_exp2f(s[kb2][r] * c1 + sub);
            } else {
#pragma unroll
                for (int kb2 = 0; kb2 < 2; ++kb2)
#pragma unroll
                    for (int r = 0; r < 16; ++r) s[kb2][r] = __builtin_amdgcn_exp2f(s[kb2][r] - m_run);
            }
#pragma unroll
            for (int kb2 = 0; kb2 < 2; ++kb2) {
                const unsigned mw = mcur[kb2] >> (4 * h2);
#pragma unroll
                for (int r = 0; r < 16; ++r) {
                    float p = s[kb2][r];
                    if (MASKED) { p = __uint_as_float(__float_as_uint(p) & (unsigned)(-(int)((mw >> crow_c(r)) & 1u))); s[kb2][r] = p; }
                    if (r & 1) psum1 += p; else psum0 += p;
                }
            }
            l_run += psum0 + psum1;
            bf16x8 Pf;
#pragma unroll
            for (int u = 0; u < NST; ++u) {
                const int st = u / NH, dh = u % NH, kb2 = st >> 1, s2 = st & 1;
                if (dh == 0) {
                    u32x4 pw;
#pragma unroll
                    for (int e = 0; e < 4; ++e) pw[e] = pack_bf16(s[kb2][8 * s2 + 2 * e], s[kb2][8 * s2 + 2 * e + 1]);
                    Pf = __builtin_bit_cast(bf16x8, pw);
                }
                if (u + 1 < NST) {
                    const int st1 = (u + 1) / NH, dh1 = (u + 1) % NH;
#pragma unroll
                    for (int d = 0; d < 2; ++d) Av[(u + 1) & 1][d] = *(const LAS bf16x8*)(vt + (32 * (2 * dh1 + d) + q) * (AT_VSTR * 2) + (16 * st1 + 8 * h2) * 2);
                }
                __builtin_amdgcn_s_setprio(1);
#pragma unroll
                for (int d = 0; d < 2; ++d) O[2 * dh + d] = MFMA32(Av[u & 1][d], Pf, O[2 * dh + d]);
                __builtin_amdgcn_s_setprio(0);
                __builtin_amdgcn_sched_barrier(0);
            }
        }
        if (j < jmax) AT_STORE((j + 1) & 1);
        mcur[0] = mreg[0]; mcur[1] = mreg[1];
        __syncthreads();
    }
#undef AT_LOAD
#undef AT_STORE
    const float lt = l_run + __shfl_xor(l_run, 32);
    const float inv = 1.0f / lt;
#pragma unroll
    for (int d = 0; d < NDV; ++d)
#pragma unroll
        for (int r = 0; r < 16; ++r) O[d][r] *= inv;
}

DI float rel_bucket_bias(const float* rel_bias, int d, int head) {
    int bkt;
    if (d < 16) bkt = d;
    else { const float lr = __logf((float)d * (1.0f / 16.0f)) / 2.0794415416798357f; int l = 16 + (int)(lr * 16.0f); bkt = l < 31 ? l : 31; }
    return rel_bias[bkt * 12 + head];
}
DI void attn_phase(const Frame& F, const Args& a) {
    const bf16_t* Z = (const bf16_t*)(a.ws + WS_BIG);
    const bf16_t* Vtg = (const bf16_t*)(a.ws + WS_VT);
    bf16_t* Yo = (bf16_t*)(a.ws + WS_Y);
    float* O1s = (float*)(a.ws + WS_H);
    const unsigned* maskg = (const unsigned*)(a.ws + WS_MASK);
    LAS float* lut = (LAS float*)(F.lds + AT_LUT);
    for (int i = F.tid; i < 12 * 130; i += NTHR) { const int hh = i / 130, d = i % 130; lut[hh * AT_LUT_LD + d] = d < 129 ? rel_bucket_bias(a.rel_bias, d, hh) * LOG2E : NEG_INF; }
    float lam;
    { float d01 = 0.f, d23 = 0.f; for (int i = 0; i < 64; ++i) { d01 += a.diff_lam[i] * a.diff_lam[64 + i]; d23 += a.diff_lam[128 + i] * a.diff_lam[192 + i]; }
      lam = __expf(d01) - __expf(d23) + 0.35550906759096f; }
    const float one_m_li = 1.0f - 0.35550906759096f;
    __syncthreads();
    const float c1 = 0.125f * LOG2E;
    const int q = F.lane & 31, h2 = F.lane >> 5;
    const int xcd = F.bid & 7, kk = F.bid >> 3;
    for (int it = F.bid; it < 256; it += F.G) {
        const int bh = (F.G == 256) ? 2 * xcd + (kk >> 4) : it >> 4, pr = (F.G == 256) ? (kk & 15) : (it & 15);
        const int b = bh >> 2, hd = bh & 3;
        for (int half = 0; half < 2; ++half) {
            const int q0 = 256 * (half ? 31 - pr : pr), t = q0 + 32 * F.wave + q;
            f32x16 O[4];
            attn_core<128, false>(F, Z, Vtg, b, Z_QD + 128 * hd, Z_KD + 128 * hd, VT_D + 128 * hd, q0, lut + (8 + hd) * AT_LUT_LD, c1, nullptr, O);
            float* o1p = O1s + (size_t)(b * SEQ + t) * 512 + 128 * hd;
#pragma unroll
            for (int d = 0; d < 4; ++d)
#pragma unroll
                for (int g = 0; g < 4; ++g) *(f32x4*)(o1p + 32 * d + 8 * g + 4 * h2) = (f32x4){O[d][4 * g], O[d][4 * g + 1], O[d][4 * g + 2], O[d][4 * g + 3]};
            attn_core<128, false>(F, Z, Vtg, b, Z_QD + 128 * hd + 64, Z_KD + 128 * hd + 64, VT_D + 128 * hd, q0, lut + (8 + hd) * AT_LUT_LD, c1, nullptr, O);
            float ss = 0.f;
#pragma unroll
            for (int d = 0; d < 4; ++d)
#pragma unroll
                for (int g = 0; g < 4; ++g) {
                    const f32x4 o1 = *(const f32x4*)(o1p + 32 * d + 8 * g + 4 * h2);
#pragma unroll
                    for (int e = 0; e < 4; ++e) { const float v = o1[e] - lam * O[d][4 * g + e]; O[d][4 * g + e] = v; ss += v * v; }
                }
            ss += __shfl_xor(ss, 32);
            const float rinv = rsqrtf(ss * (1.0f / 128.0f) + EPS) * one_m_li;
            bf16_t* yp = Yo + (size_t)(b * SEQ + t) * DM + 512 + 128 * hd;
#pragma unroll
            for (int d = 0; d < 4; ++d)
#pragma unroll
                for (int g = 0; g < 4; ++g) {
                    const int dv = 32 * d + 8 * g + 4 * h2;
                    const f32x4 gn = *(const f32x4*)(a.diff_norm_g + dv);
                    f32x4 v; v[0] = O[d][4 * g] * rinv * gn[0]; v[1] = O[d][4 * g + 1] * rinv * gn[1]; v[2] = O[d][4 * g + 2] * rinv * gn[2]; v[3] = O[d][4 * g + 3] * rinv * gn[3];
                    *(u32x2*)(yp + dv) = pack4(v);
                }
        }
    }
    for (int it = F.bid; it < 512; it += F.G) {
        const int rnd = it / F.G;
        const int bh = (F.G == 256) ? 4 * xcd + 2 * rnd + (kk >> 4) : it >> 4, pr = (F.G == 256) ? (kk & 15) : (it & 15);
        const int b = bh >> 3, hc = bh & 7;
        for (int half = 0; half < 2; ++half) {
            const int q0 = 256 * (half ? 31 - pr : pr), t = q0 + 32 * F.wave + q;
            f32x16 O[2];
            attn_core<64, true>(F, Z, Vtg, b, Z_QC + 64 * hc, Z_KC + 64 * hc, VT_C + 64 * hc, q0, lut + hc * AT_LUT_LD, c1, maskg, O);
            bf16_t* yp = Yo + (size_t)(b * SEQ + t) * DM + 64 * hc;
#pragma unroll
            for (int d = 0; d < 2; ++d)
#pragma unroll
                for (int g = 0; g < 4; ++g) {
                    f32x4 v = {O[d][4 * g], O[d][4 * g + 1], O[d][4 * g + 2], O[d][4 * g + 3]};
                    *(u32x2*)(yp + 32 * d + 8 * g + 4 * h2) = pack4(v);
                }
        }
    }
}

#ifndef MK_ONE_LAUNCH
#define MK_ONE_LAUNCH 1
#endif
constexpr int NPH = 17;
__global__ void __launch_bounds__(NTHR, 2) fwd_kernel(Args a) {
    extern __shared__ __attribute__((aligned(16))) unsigned char lds_raw[];
    Frame F; F.lds = (LAS unsigned char*)lds_raw; F.tid = threadIdx.x; F.lane = F.tid & 63; F.wave = __builtin_amdgcn_readfirstlane(F.tid >> 6); F.G = gridDim.x; F.bid = blockIdx.x;
    unsigned* ctl = (unsigned*)(a.ws + WS_CTL);
    volatile LAS unsigned* xbw = (volatile LAS unsigned*)(F.lds + LDS_XB);
    if (F.tid < 4) xbw[F.tid] = 0u;
    __syncthreads();
    const int lo = a.ph_lo, hi = a.ph_hi;
    XcdBarrier bar; bar.bar = ctl + CW_BAR; bar.x = 0; bar.st = xbw;
    if (hi - lo > 1) bar = xcd_barrier_post(ctl + CW_BAR, xbw);
#ifndef PH_ONLY
#define IN(k) (lo <= (k) && (k) < hi)
#else
#define IN(k) ((k) == PH_ONLY && lo <= (k) && (k) < hi)
#endif
#ifndef DUP_PH
#define DUP_PH -1
#endif
#define REP(k) for (int rep_ = 0; rep_ < ((k) == DUP_PH ? 2 : 1); ++rep_)
#ifndef TIME_PH
#define TIME_PH -1
#endif
#define TIME_AMP 4
    unsigned long long tp0_ = 0, tp1_ = 0;
    if (TIME_PH == 0) tp0_ = wall_clock64();
#define SEAM(k) do { if (IN(k) && IN((k) + 1)) xcd_barrier(bar); if ((k) == TIME_PH) tp1_ = wall_clock64(); if ((k) + 1 == TIME_PH) tp0_ = wall_clock64(); } while (0)
    float* mod = (float*)(a.ws + WS_MOD);
    bf16_t* hbuf = (bf16_t*)(a.ws + WS_H);
    bf16_t* ybuf = (bf16_t*)(a.ws + WS_Y);
    LAS int* ntp = (LAS int*)(F.lds + LDS_MISC);

    if (IN(0)) REP(0) { p0_prologue(F, a); } SEAM(0);
    if (IN(1)) REP(1) { norm_phase<false, false, false>(F, a, a.x, 0, 0, 0); } SEAM(1);
    if (IN(2)) REP(2) {
        DenseSched S; S.init(NTOK, AB_N, DM, F.G, F.bid, a.ws + WS_WAB_IN);
        EpiAbIn E{(bf16_t*)(a.ws + WS_BIG)};
        pg8::gemm_phase(F.lds, (const char*)hbuf, DM, S, E);
    } SEAM(2);
    if (IN(3)) REP(3) { conv_phase(F, a); } SEAM(3);
    if (IN(4)) REP(4) {
        DenseSched S; S.init(NTOK, DM, DM, F.G, F.bid, a.ws + WS_WAB_OUT);
        EpiResid E{a.x, a.out, mod + 2 * DM};
        pg8::gemm_phase(F.lds, (const char*)ybuf, DM, S, E);
    } SEAM(4);
#define MOE_PHASES(layer, pb) do { \
        const unsigned* cnt = ctl + CW_CNT + (layer) * NEXP * CNT_STRIDE; \
        if (IN(pb)) { route_phase(F, a, (layer)); } SEAM(pb); \
        if (IN((pb) + 1)) REP((pb) + 1) { \
            moe_tile_table(F, cnt, ntp); \
            MoeSched<true> S; S.ntp = ntp; S.cnt = cnt; S.list = (const int*)(a.ws + WS_LIST); S.W = (const char*)(a.ws + WS_MOE_W); S.nU = 4 * ntp[NEXP]; S.G = F.G; S.c = F.bid; \
            EpiMoeUp E{(bf16_t*)(a.ws + WS_ACT)}; \
            pg8::gemm_phase(F.lds, (const char*)hbuf, DM, S, E); \
        } SEAM((pb) + 1); \
        if (IN((pb) + 2)) REP((pb) + 2) { \
            moe_tile_table(F, cnt, ntp); \
            MoeSched<false> S; S.ntp = ntp; S.cnt = cnt; S.list = nullptr; S.W = (const char*)(a.ws + WS_MOE_W); S.nU = 4 * ntp[NEXP]; S.G = F.G; S.c = F.bid; \
            EpiMoeDown E{(bf16_t*)(a.ws + WS_YMOE), (const float*)(a.ws + WS_GATEV), ntp}; \
            pg8::gemm_phase(F.lds, (const char*)(a.ws + WS_ACT), DEXP, S, E); \
        } SEAM((pb) + 2); } while (0)
    MOE_PHASES(0, 5);
    if (IN(8)) {
        norm_phase<true, false, false>(F, a, a.out, 1, 0, 0);
        cvt_run(F, a, 1, CVT_MOE_TILES);
    } SEAM(8);
    if (IN(9)) REP(9) {
        { DenseSched S; S.init(NTOK, CD_N, DM, F.G, F.bid, a.ws + WS_WCD_IN);
          EpiPlain E{(bf16_t*)(a.ws + WS_BIG), CD_N};
          pg8::gemm_phase(F.lds, (const char*)hbuf, DM, S, E); }
        __syncthreads();
        { DenseSched S; S.init(1024, NTOK, DM, F.G, F.bid, hbuf);
          EpiPlain E{(bf16_t*)(a.ws + WS_VT), NTOK};
          pg8::gemm_phase(F.lds, (const char*)(a.ws + WS_WCD_IN + (size_t)CD_N * DM * 2), DM, S, E); }
    } SEAM(9);
    if (IN(10)) REP(10) { topk_phase(F, a); } SEAM(10);
    if (IN(11)) REP(11) { attn_phase(F, a); } SEAM(11);
    if (IN(12)) {
        DenseSched S; S.init(NTOK, DM, DM, F.G, F.bid, a.ws + WS_WCD_OUT);
        EpiResid E{a.out, a.out, mod + (size_t)NB * 6 * DM + 2 * DM};
        pg8::gemm_phase(F.lds, (const char*)ybuf, DM, S, E);
    } SEAM(12);
    MOE_PHASES(1, 13);
#undef MOE_PHASES
    if (IN(16)) { norm_phase<true, false, true>(F, a, a.out, 1, 0, 1); }
    if (TIME_PH >= 0) {
        if (TIME_PH == 16) { asm volatile("s_waitcnt vmcnt(0)" ::: "memory"); __syncthreads(); tp1_ = wall_clock64(); }
        if (F.bid == 0 && F.tid == 0) { const unsigned long long te = wall_clock64(), dt = (tp1_ - tp0_) * TIME_AMP; while (wall_clock64() - te < dt) __builtin_amdgcn_s_sleep(8); }
    }
#undef IN
#undef SEAM
}

extern "C" void kernel_launch(void* const* d_in, const int* in_sizes, int n_in, void* d_out, int out_size, void* d_ws, size_t ws_size, hipStream_t stream) {
    static int grid = 0;
    if (grid == 0) {
        if (n_in != 26 || out_size != NTOK * DM || ws_size < WS_END) { fprintf(stderr, "kernel_launch: unexpected problem (n_in %d, out %d, ws %zu < %zu)\n", n_in, out_size, ws_size, (size_t)WS_END); grid = -1; return; }
        int dev = 0, cus = 0, per_cu = 0;
        if (hipGetDevice(&dev) != hipSuccess || hipDeviceGetAttribute(&cus, hipDeviceAttributeMultiprocessorCount, dev) != hipSuccess) { grid = -1; return; }
        if (hipFuncSetAttribute((const void*)fwd_kernel, hipFuncAttributeMaxDynamicSharedMemorySize, LDS_BYTES) != hipSuccess) { fprintf(stderr, "kernel_launch: hipFuncSetAttribute failed\n"); grid = -1; return; }
        if (hipOccupancyMaxActiveBlocksPerMultiprocessor(&per_cu, (const void*)fwd_kernel, NTHR, LDS_BYTES) != hipSuccess || per_cu < 1) { fprintf(stderr, "kernel_launch: occupancy query says %d\n", per_cu); }
        (void)hipGetLastError();
        grid = cus;
    }
    if (grid < 0) return;
    (void)hipMemsetAsync((char*)d_ws + WS_CTL, 0, CTL_BYTES, stream);
    Args a{};
    const float** fp = (const float**)&a.x;
    (void)fp;
    a.x = (const float*)d_in[0]; a.c = (const float*)d_in[1]; a.positions = (const int*)d_in[2]; a.rel_bias = (const float*)d_in[3]; a.norm_g = (const float*)d_in[4];
    a.final_norm_g = (const float*)d_in[5]; a.ada_w = (const float*)d_in[6]; a.ada_b = (const float*)d_in[7]; a.ab_w_in = (const float*)d_in[8]; a.ab_conv_a = (const float*)d_in[9];
    a.ab_conv_b = (const float*)d_in[10]; a.ab_conv_b_bias = (const float*)d_in[11]; a.ab_ln_g = (const float*)d_in[12]; a.ab_ln_b = (const float*)d_in[13]; a.ab_w_out = (const float*)d_in[14];
    a.cd_w_in = (const float*)d_in[15]; a.diff_lam = (const float*)d_in[16]; a.diff_norm_g = (const float*)d_in[17]; a.cd_w_out = (const float*)d_in[18];
    a.moe_wr_g = (const float*)d_in[19]; a.moe_br_g = (const float*)d_in[20]; a.moe_wr_e = (const float*)d_in[21]; a.moe_br_e = (const float*)d_in[22];
    a.moe_w_gate = (const float*)d_in[23]; a.moe_w_up = (const float*)d_in[24]; a.moe_w_down = (const float*)d_in[25];
    a.out = (float*)d_out; a.ws = (unsigned char*)d_ws;
#if MK_ONE_LAUNCH
    a.ph_lo = 0; a.ph_hi = NPH;
    hipLaunchKernelGGL(fwd_kernel, dim3(grid), dim3(NTHR), LDS_BYTES, stream, a);
#else
    for (int p = 0; p < NPH; ++p) { a.ph_lo = p; a.ph_hi = p + 1; hipLaunchKernelGGL(fwd_kernel, dim3(grid), dim3(NTHR), LDS_BYTES, stream, a); }
#endif
}
```

```cpp
#include <hip/hip_runtime.h>
#include <cstdio>
#include <cstdint>

#ifndef TIME_PH
#define TIME_PH -1
#endif
#define LAS __attribute__((address_space(3)))
#define DI __device__ __forceinline__
typedef unsigned short bf16_t;
typedef short bf16x8 __attribute__((ext_vector_type(8)));
typedef short s16x4 __attribute__((ext_vector_type(4)));
typedef float f32x2 __attribute__((ext_vector_type(2)));
typedef float f32x4 __attribute__((ext_vector_type(4)));
typedef float f32x16 __attribute__((ext_vector_type(16)));
typedef unsigned u32x2 __attribute__((ext_vector_type(2)));
typedef unsigned u32x4 __attribute__((ext_vector_type(4)));
typedef __bf16 bf16v2 __attribute__((ext_vector_type(2)));

constexpr int NB = 4, SEQ = 8192, DM = 1024, NTOK = NB * SEQ;
constexpr int NTHR = 512, NWAVE = 8;
constexpr int AB_N = 2560;
constexpr int ZC_N = 1536;
constexpr int CD_SRC_N = 3368;
constexpr int CD_N = 2560;
constexpr int Z_QC = 0, Z_KC = 512, Z_QD = 1024, Z_KD = 1536, Z_QI = 2048, Z_KI = 2304, Z_WI = 2336;
constexpr int VT_C = 0, VT_D = 512;
constexpr int NEXP = 32, DEXP = 512;
constexpr int MOE_ROWS = 2 * NTOK + NEXP * 256;
constexpr float EPS = 1e-6f;
constexpr float LOG2E = 1.4426950408889634f;

constexpr size_t MiB = 1u << 20;
constexpr size_t WS_CTL = 0, CTL_BYTES = 64 * 1024;
constexpr size_t WS_MOD = 1 * MiB;
constexpr size_t WS_WAB_IN = 2 * MiB;
constexpr size_t WS_WAB_OUT = 7 * MiB;
constexpr size_t WS_WCD_IN = 9 * MiB;
constexpr size_t WS_WCD_OUT = 16 * MiB;
constexpr size_t WS_MOE_W = 18 * MiB;
constexpr size_t WS_H = 114 * MiB;
constexpr size_t WS_Y = 178 * MiB;
constexpr size_t WS_BIG = 242 * MiB;
constexpr size_t WS_ACT = WS_BIG;
constexpr size_t WS_YMOE = WS_BIG + 72 * MiB;
constexpr size_t WS_VT = WS_BIG + 160 * MiB;
constexpr size_t WS_MASK = 466 * MiB;
constexpr size_t WS_LIST = 498 * MiB;
constexpr size_t WS_GATEV = 502 * MiB;
constexpr size_t WS_TOKSLOT = 506 * MiB;
constexpr size_t WS_END = 507 * MiB;

constexpr int CW_BAR = 0;
constexpr int CW_CNT = 4096;
constexpr int CNT_STRIDE = 64;

DI unsigned pack_bf16(float lo, float hi) { f32x2 v = {lo, hi}; bf16v2 b = __builtin_convertvector(v, bf16v2); return __builtin_bit_cast(unsigned, b); }
DI float bf_lo(unsigned w) { return __uint_as_float(w << 16); }
DI float bf_hi(unsigned w) { return __uint_as_float(w & 0xffff0000u); }
DI float bf2f(bf16_t b) { return __uint_as_float(((unsigned)b) << 16); }
DI float wave_sum(float v) {
#pragma unroll
    for (int o = 32; o >= 1; o >>= 1) v += __shfl_xor(v, o);
    return v;
}
DI int fresh_lane() { int l; asm volatile("v_mbcnt_lo_u32_b32 %0, -1, 0\n\tv_mbcnt_hi_u32_b32 %0, -1, %0" : "=v"(l)); return l; }
DI float silu_f(float v) { return v / (1.0f + __expf(-v)); }
DI float sigmoid_f(float v) { return 1.0f / (1.0f + __expf(-v)); }

#define XB_TMO      128
#define XB_XCNT(j)  (256  + 64 * (j))
#define XB_XSUB(j)  (1280 + 64 * (j))
#define XB_XGEN(j)  (2304 + 64 * (j))
#define XB_TOP      3328
#define XB_TOPGEN   3392
#define XCD_BAR_WORDS 3456
#define XB_SPIN_CAP (1u << 22)
DI unsigned xb_ld(unsigned* p)              { return __hip_atomic_load(p, __ATOMIC_RELAXED, __HIP_MEMORY_SCOPE_AGENT); }
DI unsigned xb_add(unsigned* p, unsigned v) { return __hip_atomic_fetch_add(p, v, __ATOMIC_RELAXED, __HIP_MEMORY_SCOPE_AGENT); }
DI unsigned xb_xcc_id() { return (unsigned)__builtin_amdgcn_s_getreg((3 << 11) | 20) & 0xFu; }
#define XB_SPIN(cond, bar) do { unsigned _sp = 0; while (cond) { __builtin_amdgcn_s_sleep(1); \
    if ((++_sp & 255u) == 0u) { if (xb_ld(&(bar)[XB_TMO])) break; if (_sp > XB_SPIN_CAP) { atomicAdd(&(bar)[XB_TMO], 1u); break; } } } } while (0)
struct XcdBarrier { unsigned* bar; unsigned x; volatile LAS unsigned* st; };
DI XcdBarrier xcd_barrier_post(unsigned* bar, volatile LAS unsigned* st) {
    XcdBarrier b; b.bar = bar; b.x = xb_xcc_id(); b.st = st;
    if (threadIdx.x == 0) (void)xb_add(&bar[XB_XCNT(b.x)], 1u);
    return b;
}
DI void xcd_barrier_complete(unsigned* bar, unsigned x, unsigned& nloc, unsigned& nx) {
    const unsigned G = gridDim.x * gridDim.y * gridDim.z;
    unsigned sum, cnt, mine, sp = 0u;
    for (;;) {
        sum = 0u; cnt = 0u; mine = 0u;
#pragma unroll
        for (unsigned j = 0; j < 16; ++j) { const unsigned c = xb_ld(&bar[XB_XCNT(j)]); sum += c; cnt += (c > 0u) ? 1u : 0u; mine = (j == x) ? c : mine; }
        if (sum == G) break;
        __builtin_amdgcn_s_sleep(1);
        if ((++sp & 255u) == 0u) { if (xb_ld(&bar[XB_TMO])) break; if (sp > XB_SPIN_CAP) { atomicAdd(&bar[XB_TMO], 1u); break; } }
    }
    nloc = mine > 0u ? mine : 1u; nx = cnt > 0u ? cnt : 1u;
}
DI void xcd_barrier(const XcdBarrier& b) {
    asm volatile("s_waitcnt vmcnt(0)" ::: "memory");
    __syncthreads();
    if (threadIdx.x == 0) {
        unsigned* bar = b.bar;
        __builtin_amdgcn_s_waitcnt(0);
        unsigned nloc = b.st[0], nx = b.st[1];
        if (nloc == 0u) { xcd_barrier_complete(bar, b.x, nloc, nx); b.st[0] = nloc; b.st[1] = nx; }
        const unsigned old = xb_add(&bar[XB_XSUB(b.x)], 1u);
        const unsigned gen = old / nloc;
        if (old + 1u == (gen + 1u) * nloc) {
            __builtin_amdgcn_fence(__ATOMIC_RELEASE, "agent");
            asm volatile("s_waitcnt vmcnt(0)" ::: "memory");
            const unsigned og = xb_add(&bar[XB_TOP], 1u);
            const unsigned tg = og / nx;
            if (og + 1u == (tg + 1u) * nx) xb_add(&bar[XB_TOPGEN], 1u);
            else XB_SPIN(xb_ld(&bar[XB_TOPGEN]) == tg, bar);
            __builtin_amdgcn_fence(__ATOMIC_ACQUIRE, "agent");
            xb_add(&bar[XB_XGEN(b.x)], 1u);
            asm volatile("s_waitcnt vmcnt(0)" ::: "memory");
        } else {
            XB_SPIN(xb_ld(&bar[XB_XGEN(b.x)]) == gen, bar);
            __builtin_amdgcn_fence(__ATOMIC_ACQUIRE, "agent");
            asm volatile("s_waitcnt vmcnt(0)" ::: "memory");
        }
    }
    __syncthreads();
}

namespace pg8 {
constexpr int BM = 256, BK = 64, HALF = 128, HTB = HALF * BK * 2, STAGE_BYTES = 8 * HTB;
DI int lds_byte(int r, int c) { const int st = (r >> 4) * 2 + (c >> 5), rr = r & 15, cc = c & 31, ob = rr * 64 + cc * 2; return st * 1024 + (ob ^ (((ob >> 9) & 1) << 5)); }
DI void stage_rc(int b, int& R, int& C) { const int st = b / 1024, sb = b % 1024, swz = sb ^ (((sb >> 9) & 1) << 5); R = (st >> 1) * 16 + swz / 64; C = (st & 1) * 32 + (swz % 64) / 2; }
struct Unit { int pm, pn, e, nrow; };

template <class Epi, class Sched>
DI void gemm_phase(LAS unsigned char* lds, const char* Abase, const int K, const Sched& S, const Epi& E) {
    const int tid = threadIdx.x, wid = __builtin_amdgcn_readfirstlane(tid >> 6), lane = tid & 63, wr = wid >> 2, wc = wid & 3, fr = lane & 15, fq = lane >> 4;
    const int nt = K / BK;
    int Rr[2], Cc[2]; unsigned voffB[2];
#pragma unroll
    for (int i = 0; i < 2; ++i) { int R, C; stage_rc(tid * 16 + i * 8192, R, C); Rr[i] = R; Cc[i] = C; voffB[i] = (unsigned)(R * K + C) * 2u; }
    const size_t kstep = (size_t)(BK * 2);
    const size_t hstep = (size_t)HALF * K * 2;
    const unsigned ldsw = (unsigned)wid * 1024u;
    const int aoff = lds_byte(wr * 64 + fr, fq * 8), boff = lds_byte(wc * 32 + fr, fq * 8);
#define PG8_SA(b, h) (((b) * 2 + (h)) * HTB)
#define PG8_SB(b, h) ((4 + (b) * 2 + (h)) * HTB)
#define PG8_STAGE(bufoff, gbase, voff) do { _Pragma("unroll") for (int _i = 0; _i < 2; ++_i) \
        __builtin_amdgcn_global_load_lds((const unsigned*)((const char*)(gbase) + (voff)[_i]), (LAS unsigned*)(lds + (bufoff) + ldsw + _i * 8192), 16, 0, 0); } while (0)
#define PG8_AOFF(dst, u) do { _Pragma("unroll") for (int _h = 0; _h < 2; ++_h) _Pragma("unroll") for (int _i = 0; _i < 2; ++_i) \
        dst[_h][_i] = ((unsigned)S.a_row(u, _h * HALF + Rr[_i]) * (unsigned)K + (unsigned)Cc[_i]) * 2u; } while (0)
#define PG8_LDA(dst, b, h) do { _Pragma("unroll") for (int m = 0; m < 4; ++m) _Pragma("unroll") for (int k = 0; k < 2; ++k) dst[m][k] = *(const LAS bf16x8*)(lds + PG8_SA(b, h) + aoff + m * 2048 + k * 1024); } while (0)
#define PG8_LDB(dst, b, h) do { _Pragma("unroll") for (int n = 0; n < 2; ++n) _Pragma("unroll") for (int k = 0; k < 2; ++k) dst[n][k] = *(const LAS bf16x8*)(lds + PG8_SB(b, h) + boff + n * 2048 + k * 1024); } while (0)
#define PG8_MMA(ai, bj, At, Bt) do { __builtin_amdgcn_s_setprio(1); _Pragma("unroll") for (int m = 0; m < 4; ++m) _Pragma("unroll") for (int n = 0; n < 2; ++n) _Pragma("unroll") for (int k = 0; k < 2; ++k) \
        acc[ai][bj][m][n] = __builtin_amdgcn_mfma_f32_16x16x32_bf16(Bt[n][k], At[m][k], acc[ai][bj][m][n], 0, 0, 0); __builtin_amdgcn_s_setprio(0); } while (0)
#define PG8_WAIT_V(n) asm volatile("s_waitcnt vmcnt(" #n ")" ::: "memory")
#define PG8_WAIT_L(n) asm volatile("s_waitcnt lgkmcnt(" #n ")" ::: "memory")
#define PG8_BAR __builtin_amdgcn_s_barrier()
#define PG8_SCHED __builtin_amdgcn_sched_barrier(0)
    Unit cur, nxt; int ui = 0;
    if (!S.next(0, cur)) return;
    f32x4 acc[2][2][4][2];
#pragma unroll
    for (int a = 0; a < 2; ++a)
#pragma unroll
        for (int b = 0; b < 2; ++b)
#pragma unroll
            for (int m = 0; m < 4; ++m)
#pragma unroll
                for (int n = 0; n < 2; ++n) acc[a][b][m][n] = (f32x4){0.f, 0.f, 0.f, 0.f};
    bf16x8 At[4][2], B0[2][2], B1[2][2];
    unsigned aoC[2][2], aoN[2][2];
    PG8_AOFF(aoC, cur);
    const char* cB = S.b_base(cur);
    PG8_STAGE(PG8_SB(0, 0), cB, voffB); PG8_STAGE(PG8_SA(0, 0), Abase, aoC[0]); PG8_STAGE(PG8_SB(0, 1), cB + hstep, voffB); PG8_STAGE(PG8_SA(0, 1), Abase, aoC[1]);
    if (wr == 1) PG8_BAR;
    PG8_WAIT_V(4); PG8_BAR;
    PG8_STAGE(PG8_SB(1, 0), cB + kstep, voffB); PG8_STAGE(PG8_SA(1, 0), Abase + kstep, aoC[0]); PG8_STAGE(PG8_SB(1, 1), cB + hstep + kstep, voffB);
    PG8_WAIT_V(6); PG8_BAR;
    for (;;) {
        const bool has_next = S.next(ui + 1, nxt);
        const char* nB = cB;
#pragma unroll
        for (int _h = 0; _h < 2; ++_h)
#pragma unroll
            for (int _i = 0; _i < 2; ++_i) aoN[_h][_i] = aoC[_h][_i];
        if (has_next) { PG8_AOFF(aoN, nxt); nB = S.b_base(nxt); }
        for (int t = 0; t < nt; t += 2) {
            const bool last = (t == nt - 2);
            const char* a1 = Abase + (size_t)(t + 1) * kstep;
            const char* a2 = last ? Abase : Abase + (size_t)(t + 2) * kstep; const char* b2 = last ? nB : cB + (size_t)(t + 2) * kstep;
            const char* a3 = a2 + kstep; const char* b3 = b2 + kstep;
            unsigned ao2[2][2];
#pragma unroll
            for (int _h = 0; _h < 2; ++_h)
#pragma unroll
                for (int _i = 0; _i < 2; ++_i) ao2[_h][_i] = last ? aoN[_h][_i] : aoC[_h][_i];
            PG8_LDB(B0, 0, 0); PG8_SCHED; PG8_LDA(At, 0, 0); PG8_STAGE(PG8_SA(1, 1), a1, aoC[1]);
            PG8_WAIT_L(8); PG8_BAR; PG8_WAIT_L(0); PG8_MMA(0, 0, At, B0); PG8_BAR; PG8_SCHED;
            PG8_LDB(B1, 0, 1); PG8_STAGE(PG8_SB(0, 0), b2, voffB);
            PG8_BAR; PG8_WAIT_L(0); PG8_MMA(0, 1, At, B1); PG8_BAR;
            PG8_LDA(At, 0, 1); PG8_STAGE(PG8_SA(0, 0), a2, ao2[0]);
            PG8_BAR; PG8_WAIT_L(0); PG8_MMA(1, 0, At, B0); PG8_BAR; PG8_SCHED;
            PG8_STAGE(PG8_SB(0, 1), b2 + hstep, voffB);
            PG8_WAIT_V(6); PG8_BAR; PG8_MMA(1, 1, At, B1); PG8_BAR;
            PG8_LDB(B0, 1, 0); PG8_SCHED; PG8_LDA(At, 1, 0); PG8_STAGE(PG8_SA(0, 1), a2, ao2[1]);
            PG8_WAIT_L(8); PG8_BAR; PG8_WAIT_L(0); PG8_MMA(0, 0, At, B0); PG8_BAR; PG8_SCHED;
            PG8_LDB(B1, 1, 1); PG8_STAGE(PG8_SB(1, 0), b3, voffB);
            PG8_BAR; PG8_WAIT_L(0); PG8_MMA(0, 1, At, B1); PG8_BAR;
            PG8_LDA(At, 1, 1); PG8_STAGE(PG8_SA(1, 0), a3, ao2[0]);
            PG8_BAR; PG8_WAIT_L(0); PG8_MMA(1, 0, At, B0); PG8_BAR; PG8_SCHED;
            PG8_STAGE(PG8_SB(1, 1), b3 + hstep, voffB);
            PG8_WAIT_V(6); PG8_BAR; PG8_MMA(1, 1, At, B1); PG8_BAR;
        }
        E(acc, cur, wr, wc, fr, fq);
        if (!has_next) break;
#pragma unroll
        for (int a = 0; a < 2; ++a)
#pragma unroll
            for (int b = 0; b < 2; ++b)
#pragma unroll
                for (int m = 0; m < 4; ++m)
#pragma unroll
                    for (int n = 0; n < 2; ++n) acc[a][b][m][n] = (f32x4){0.f, 0.f, 0.f, 0.f};
        cur = nxt; cB = nB; ++ui;
#pragma unroll
        for (int _h = 0; _h < 2; ++_h)
#pragma unroll
            for (int _i = 0; _i < 2; ++_i) aoC[_h][_i] = aoN[_h][_i];
    }
    PG8_WAIT_V(0);
    if (wr == 0) PG8_BAR;
    PG8_BAR;
#undef PG8_SA
#undef PG8_SB
#undef PG8_STAGE
#undef PG8_AOFF
#undef PG8_LDA
#undef PG8_LDB
#undef PG8_MMA
#undef PG8_WAIT_V
#undef PG8_WAIT_L
#undef PG8_BAR
#undef PG8_SCHED
}
}

struct Args {
    const float* x; const float* c; const int* positions; const float* rel_bias; const float* norm_g; const float* final_norm_g;
    const float* ada_w; const float* ada_b; const float* ab_w_in; const float* ab_conv_a; const float* ab_conv_b; const float* ab_conv_b_bias;
    const float* ab_ln_g; const float* ab_ln_b; const float* ab_w_out; const float* cd_w_in; const float* diff_lam; const float* diff_norm_g;
    const float* cd_w_out; const float* moe_wr_g; const float* moe_br_g; const float* moe_wr_e; const float* moe_br_e;
    const float* moe_w_gate; const float* moe_w_up; const float* moe_w_down;
    float* out; unsigned char* ws; int ph_lo, ph_hi;
};
struct Frame {
    LAS unsigned char* lds; int tid, lane, wave, G, bid;
};

struct RowSrc { const float* p; int ld; };
DI void ilv(int rp, int& j, int& second) { const int g = rp >> 5, i = rp & 31; j = 16 * g + (i & 15); second = i >> 4; }

enum { CV_AB_IN = 0, CV_AB_OUT = 1, CV_CD_IN = 2, CV_CD_OUT = 3, CV_MOE_GU = 4, CV_MOE_D = 5 };
template <int KIND> DI RowSrc row_src(const Args& a, int layer, int e, int r) {
    RowSrc s; s.p = nullptr; s.ld = 0;
    if (KIND == CV_AB_IN) {
        s.ld = AB_N;
        if (r < 512) s.p = a.ab_w_in + r;
        else if (r < 1536) { int j, sec; ilv(r - 512, j, sec); s.p = a.ab_w_in + (sec ? 1024 + j : 512 + j); }
        else { int j, sec; ilv(r - 1536, j, sec); s.p = a.ab_w_in + (sec ? 2048 + j : 1536 + j); }
    } else if (KIND == CV_AB_OUT) { s.ld = DM; s.p = a.ab_w_out + r; }
    else if (KIND == CV_CD_IN) {
        s.ld = CD_SRC_N;
        int col = -1;
        if (r < 1024) col = r;
        else if (r < 2048) col = 1832 + (r - 1024);
        else if (r < 2304) col = 1536 + (r - 2048);
        else if (r < 2336) col = 1792 + (r - 2304);
        else if (r < 2344) col = 1824 + (r - 2336);
        else if (r < 2560) col = -1;
        else if (r < 3072) col = 1024 + (r - 2560);
        else col = 2856 + (r - 3072);
        if (col >= 0) s.p = a.cd_w_in + col;
    } else if (KIND == CV_CD_OUT) { s.ld = DM; s.p = a.cd_w_out + r; }
    else if (KIND == CV_MOE_GU) {
        int j, sec; ilv(r, j, sec); s.ld = DEXP;
        const size_t base = ((size_t)layer * NEXP + e) * (size_t)DM * DEXP;
        s.p = (sec ? a.moe_w_up : a.moe_w_gate) + base + j;
    } else {
        s.ld = DM; s.p = a.moe_w_down + ((size_t)layer * NEXP + e) * (size_t)DEXP * DM + r;
    }
    return s;
}
constexpr int CV_LD = 258;
struct CvtTile { const float* sp; int ld; bf16_t* dst; int K, r0, k0; };
template <int KIND> DI CvtTile cvt_desc(const Frame& F, const Args& a, bf16_t* dst, int K, int r0, int k0, int layer, int e) {
    const RowSrc s = row_src<KIND>(a, layer, e, r0 + 4 * (F.tid & 15));
    CvtTile t; t.sp = s.p; t.ld = s.ld; t.dst = dst; t.K = K; t.r0 = r0; t.k0 = k0; return t;
}
constexpr int CVT_DENSE_TILES = (AB_N + DM + CD_N + 1024 + DM) / 64 * (DM / 256);
constexpr int CVT_MOE_TILES_PER_EXP = (1024 / 64) * (1024 / 256) + (1024 / 64) * (512 / 256);
constexpr int CVT_MOE_TILES = NEXP * CVT_MOE_TILES_PER_EXP;
DI CvtTile cvt_dense_desc(const Frame& F, const Args& a, int item) {
    const int rt = item >> 2, kt = item & 3;
    int r = rt * 64;
    if (r < AB_N) return cvt_desc<CV_AB_IN>(F, a, (bf16_t*)(a.ws + WS_WAB_IN), DM, r, kt * 256, 0, 0);
    r -= AB_N;
    if (r < DM) return cvt_desc<CV_AB_OUT>(F, a, (bf16_t*)(a.ws + WS_WAB_OUT), DM, r, kt * 256, 0, 0);
    r -= DM;
    if (r < CD_N + 1024) return cvt_desc<CV_CD_IN>(F, a, (bf16_t*)(a.ws + WS_WCD_IN), DM, r, kt * 256, 0, 0);
    r -= CD_N + 1024;
    return cvt_desc<CV_CD_OUT>(F, a, (bf16_t*)(a.ws + WS_WCD_OUT), DM, r, kt * 256, 0, 0);
}
DI CvtTile cvt_moe_desc(const Frame& F, const Args& a, int layer, int item) {
    const int e = item / CVT_MOE_TILES_PER_EXP, t = item % CVT_MOE_TILES_PER_EXP;
    bf16_t* base = (bf16_t*)(a.ws + WS_MOE_W + (size_t)e * 3 * MiB);
    if (t < 64) return cvt_desc<CV_MOE_GU>(F, a, base, DM, (t >> 2) * 64, (t & 3) * 256, layer, e);
    const int t2 = t - 64; return cvt_desc<CV_MOE_D>(F, a, base + (size_t)DM * DM, DEXP, (t2 >> 1) * 64, (t2 & 1) * 256, layer, e);
}
DI void cvt_load(const Frame& F, const CvtTile& t, f32x4 (&v)[8]) {
#pragma unroll
    for (int it = 0; it < 8; ++it) {
        const int kk = (F.tid >> 4) + 32 * it;
        v[it] = (f32x4){0.f, 0.f, 0.f, 0.f};
        if (t.sp) v[it] = *(const f32x4*)(t.sp + (size_t)(t.k0 + kk) * t.ld);
    }
}
DI void cvt_store(const Frame& F, const CvtTile& t, const f32x4 (&v)[8]) {
    LAS bf16_t* T = (LAS bf16_t*)F.lds;
    const int c4 = F.tid & 15;
#pragma unroll
    for (int it = 0; it < 8; ++it) {
        const int kk = (F.tid >> 4) + 32 * it;
        const unsigned p01 = pack_bf16(v[it][0], v[it][1]), p23 = pack_bf16(v[it][2], v[it][3]);
        T[(4 * c4 + 0) * CV_LD + kk] = (bf16_t)(p01 & 0xffffu); T[(4 * c4 + 1) * CV_LD + kk] = (bf16_t)(p01 >> 16);
        T[(4 * c4 + 2) * CV_LD + kk] = (bf16_t)(p23 & 0xffffu); T[(4 * c4 + 3) * CV_LD + kk] = (bf16_t)(p23 >> 16);
    }
    __syncthreads();
    {
        const int rr = F.tid >> 3, c = F.tid & 7;
#pragma unroll
        for (int j = 0; j < 4; ++j) {
            const LAS unsigned* src = (const LAS unsigned*)(T + rr * CV_LD + 64 * j + c * 8);
            u32x4 w; w[0] = src[0]; w[1] = src[1]; w[2] = src[2]; w[3] = src[3];
            *(u32x4*)(t.dst + (size_t)(t.r0 + rr) * t.K + t.k0 + 64 * j + c * 8) = w;
        }
    }
    __syncthreads();
}
DI CvtTile cvt_any_desc(const Frame& F, const Args& a, int which, int item) {
    if (which == 0) { if (item < CVT_DENSE_TILES) return cvt_dense_desc(F, a, item); return cvt_moe_desc(F, a, 0, item - CVT_DENSE_TILES); }
    return cvt_moe_desc(F, a, 1, item);
}
DI void cvt_run(const Frame& F, const Args& a, int which, int n_items) {
    int it = F.bid;
    if (it >= n_items) return;
    CvtTile cur = cvt_any_desc(F, a, which, it);
    f32x4 v[8]; cvt_load(F, cur, v);
    for (;;) {
        const int nx = it + F.G; const bool has = nx < n_items;
        CvtTile nxt = cur; f32x4 vn[8];
        if (has) { nxt = cvt_any_desc(F, a, which, nx); cvt_load(F, nxt, vn); }
        cvt_store(F, cur, v);
        if (!has) break;
        cur = nxt; it = nx;
#pragma unroll
        for (int i = 0; i < 8; ++i) v[i] = vn[i];
    }
}
DI void mod_item(const Frame& F, const Args& a, int item) {
    LAS float* sc = (LAS float*)F.lds;
    LAS float* part = (LAS float*)(F.lds + 16384);
    for (int i = F.tid; i < NB * DM; i += NTHR) sc[i] = silu_f(a.c[i]);
    __syncthreads();
    const int l = item / 96, j = (item % 96) * 64 + F.lane;
    const float* w = a.ada_w + (size_t)l * DM * 6 * DM + (size_t)(F.wave * 128) * 6 * DM + j;
    float acc[NB] = {0.f, 0.f, 0.f, 0.f};
#pragma unroll 8
    for (int k = 0; k < 128; ++k) {
        const float wv = w[(size_t)k * 6 * DM];
#pragma unroll
        for (int b = 0; b < NB; ++b) acc[b] += sc[b * DM + F.wave * 128 + k] * wv;
    }
#pragma unroll
    for (int b = 0; b < NB; ++b) part[(F.wave * NB + b) * 64 + F.lane] = acc[b];
    __syncthreads();
    if (F.tid < NB * 64) {
        const int b = F.tid >> 6, c = F.tid & 63;
        float sum = 0.f;
#pragma unroll
        for (int wv = 0; wv < NWAVE; ++wv) sum += part[(wv * NB + b) * 64 + c];
        const int jj = (item % 96) * 64 + c;
        float* mod = (float*)(a.ws + WS_MOD);
        mod[((size_t)l * NB + b) * 6 * DM + jj] = sum + a.ada_b[l * 6 * DM + jj];
    }
    __syncthreads();
}
DI void p0_prologue(const Frame& F, const Args& a) {
    for (int it = F.bid; it < 192; it += F.G) mod_item(F, a, it);
    cvt_run(F, a, 0, CVT_DENSE_TILES + CVT_MOE_TILES);
}

constexpr int WR_LD = 1028;
DI void moe_seg_table(const Frame& F, const unsigned* cnt, LAS int* seg  ) {
    if (F.tid == 0) { int s = 0; for (int e = 0; e < NEXP; ++e) { seg[e] = s; s += (((int)cnt[e * CNT_STRIDE] + 255) >> 8) << 8; } seg[NEXP] = s; }
    __syncthreads();
}
template <bool COMBINE, bool ROUTE, bool FINAL>
DI void norm_phase(const Frame& F, const Args& a, const float* xsrc, int layer, int which, int layer_c) {
    const float* mod = (const float*)(a.ws + WS_MOD);
    bf16_t* hbuf = (bf16_t*)(a.ws + WS_H);
    unsigned* ctl = (unsigned*)(a.ws + WS_CTL);
    LAS float* wrT = (LAS float*)F.lds;
    LAS float* brs = (LAS float*)(F.lds + 36 * WR_LD * 4);
    LAS int* seg = (LAS int*)F.lds;
    constexpr int RT_CAP = 512;
    LAS int* rcnt = (LAS int*)(F.lds + 149504);
    LAS int* rbase = (LAS int*)(F.lds + 149632);
    LAS int* rt_er = (LAS int*)(F.lds + 149760);
    LAS float* rt_gate = (LAS float*)(F.lds + 149760 + 4096);
    LAS int* rt_tok = (LAS int*)(F.lds + 149760 + 8192);
    if (ROUTE) {
        const float* wg = a.moe_wr_g + (size_t)layer * DM * 4;
        const float* we = a.moe_wr_e + (size_t)layer * DM * 32;
        for (int i = F.tid; i < DM * 4; i += NTHR) { const int k = i >> 2, j = i & 3; wrT[j * WR_LD + k] = wg[i]; }
        for (int i = F.tid; i < DM * 32; i += NTHR) { const int k = i >> 5, j = i & 31; wrT[(4 + j) * WR_LD + k] = we[i]; }
        if (F.tid < NEXP) rcnt[F.tid] = 0;
        for (int i = F.tid; i < 2 * RT_CAP; i += NTHR) rt_er[i] = -1;
        if (F.tid < 4) brs[F.tid] = a.moe_br_g[layer * 4 + F.tid];
        else if (F.tid < 36) brs[F.tid] = a.moe_br_e[layer * 32 + F.tid - 4];
        __syncthreads();
    }
    if (COMBINE) moe_seg_table(F, ctl + CW_CNT + layer_c * NEXP * CNT_STRIDE, seg);
    const bf16_t* ymoe = (const bf16_t*)(a.ws + WS_YMOE);
    const int* tokslot = (const int*)(a.ws + WS_TOKSLOT);
    constexpr int TPW = ROUTE ? 2 : 4;
    for (int tb = (F.bid * NWAVE + F.wave) * TPW; tb < NTOK; tb += F.G * NWAVE * TPW) {
      const int b = tb / SEQ;
      f32x4 xall[TPW][4];
#pragma unroll
      for (int i = 0; i < TPW; ++i)
#pragma unroll
        for (int c = 0; c < 4; ++c) xall[i][c] = *(const f32x4*)(xsrc + (size_t)(tb + i) * DM + c * 256 + F.lane * 4);
      if (COMBINE) {
        int ts[TPW][2];
#pragma unroll
        for (int i = 0; i < TPW; ++i) { ts[i][0] = tokslot[(tb + i) * 2]; ts[i][1] = tokslot[(tb + i) * 2 + 1]; }
        u32x2 yv[TPW][2][4];
#pragma unroll
        for (int i = 0; i < TPW; ++i)
#pragma unroll
          for (int k = 0; k < 2; ++k) {
            const size_t r = (size_t)(seg[ts[i][k] >> 20] + (ts[i][k] & 0xfffff));
#pragma unroll
            for (int c = 0; c < 4; ++c) yv[i][k][c] = *(const u32x2*)(ymoe + r * DM + c * 256 + F.lane * 4);
          }
        const float* g2 = mod + ((size_t)layer_c * NB + b) * 6 * DM + 5 * DM;
#pragma unroll
        for (int c = 0; c < 4; ++c) {
          const int col = c * 256 + F.lane * 4;
          const f32x4 gv = *(const f32x4*)(g2 + col);
#pragma unroll
          for (int i = 0; i < TPW; ++i) {
            const u32x2 y0 = yv[i][0][c], y1 = yv[i][1][c];
            xall[i][c][0] += gv[0] * (bf_lo(y0[0]) + bf_lo(y1[0])); xall[i][c][1] += gv[1] * (bf_hi(y0[0]) + bf_hi(y1[0]));
            xall[i][c][2] += gv[2] * (bf_lo(y0[1]) + bf_lo(y1[1])); xall[i][c][3] += gv[3] * (bf_hi(y0[1]) + bf_hi(y1[1]));
            if (!FINAL) *(f32x4*)(a.out + (size_t)(tb + i) * DM + col) = xall[i][c];
          }
        }
      }
#pragma unroll
      for (int ti = 0; ti < TPW; ++ti) {
        const int tok = tb + ti;
        f32x4 xv[4];
#pragma unroll
        for (int c = 0; c < 4; ++c) xv[c] = xall[ti][c];
        float ss = 0.f;
#pragma unroll
        for (int c = 0; c < 4; ++c) ss += xv[c][0] * xv[c][0] + xv[c][1] * xv[c][1] + xv[c][2] * xv[c][2] + xv[c][3] * xv[c][3];
        ss = wave_sum(ss);
        const float rinv = rsqrtf(ss * (1.0f / DM) + EPS);
        if (FINAL) {
#pragma unroll
            for (int c = 0; c < 4; ++c) {
                const int col = c * 256 + F.lane * 4;
                const f32x4 g = *(const f32x4*)(a.final_norm_g + col);
                f32x4 o; o[0] = xv[c][0] * rinv * g[0]; o[1] = xv[c][1] * rinv * g[1]; o[2] = xv[c][2] * rinv * g[2]; o[3] = xv[c][3] * rinv * g[3];
                *(f32x4*)(a.out + (size_t)tok * DM + col) = o;
            }
            continue;
        }
        const float* ng = a.norm_g + ((size_t)layer * 2 + which) * DM;
        const float* sh = mod + ((size_t)layer * NB + b) * 6 * DM + (which ? 3 : 0) * DM;
        const float* sc = sh + DM;
        f32x4 hv[4];
#pragma unroll
        for (int c = 0; c < 4; ++c) {
            const int col = c * 256 + F.lane * 4;
            const f32x4 g = *(const f32x4*)(ng + col), s1 = *(const f32x4*)(sc + col), s0 = *(const f32x4*)(sh + col);
#pragma unroll
            for (int u = 0; u < 4; ++u) hv[c][u] = (xv[c][u] * rinv * g[u]) * (1.0f + s1[u]) + s0[u];
            u32x2 w; w[0] = pack_bf16(hv[c][0], hv[c][1]); w[1] = pack_bf16(hv[c][2], hv[c][3]);
            *(u32x2*)(hbuf + (size_t)tok * DM + col) = w;
        }
        if (ROUTE) {
            LAS float* lgs = (LAS float*)(F.lds + 36 * WR_LD * 4 + 256) + F.wave * 36;
#pragma unroll 1
            for (int jb = 0; jb < 36; jb += 4) {
                float pp[4];
#pragma unroll
                for (int u = 0; u < 4; ++u) {
                    float p = 0.f;
#pragma unroll
                    for (int c = 0; c < 4; ++c) {
                        const f32x4 w = *(const LAS f32x4*)(wrT + (jb + u) * WR_LD + c * 256 + F.lane * 4);
                        p += hv[c][0] * w[0] + hv[c][1] * w[1] + hv[c][2] * w[2] + hv[c][3] * w[3];
                    }
                    pp[u] = p;
                }
#pragma unroll
                for (int u = 0; u < 4; ++u) pp[u] = wave_sum(pp[u]);
                if (F.lane == 0) { *(LAS f32x4*)(lgs + jb) = (f32x4){pp[0], pp[1], pp[2], pp[3]}; }
            }
            float lg[36];
#pragma unroll
            for (int j = 0; j < 36; ++j) lg[j] = lgs[j] + brs[j];
            int g = 0; float gm = lg[0];
#pragma unroll
            for (int j = 1; j < 4; ++j) if (lg[j] > gm) { gm = lg[j]; g = j; }
            float den = 0.f;
#pragma unroll
            for (int j = 0; j < 4; ++j) den += __expf(lg[j] - gm);
            const float ptop = 1.0f / den;
            float fv[8];
#pragma unroll
            for (int i = 0; i < 8; ++i) fv[i] = (g == 0) ? lg[4 + i] : (g == 1) ? lg[12 + i] : (g == 2) ? lg[20 + i] : lg[28 + i];
            int i1 = 0; float v1 = fv[0];
#pragma unroll
            for (int i = 1; i < 8; ++i) if (fv[i] > v1) { v1 = fv[i]; i1 = i; }
            int i2 = -1; float v2 = -3.0e38f;
#pragma unroll
            for (int i = 0; i < 8; ++i) if (i != i1 && fv[i] > v2) { v2 = fv[i]; i2 = i; }
            const float e2 = __expf(v2 - v1), ga = ptop / (1.0f + e2), gb = ptop * e2 / (1.0f + e2);
            if (F.lane == 0) {
                const int li = ((tb - F.bid * NWAVE * TPW) / (F.G * NWAVE * TPW)) * NWAVE * TPW + F.wave * TPW + ti;
                const int ea = g * 8 + i1, eb = g * 8 + i2;
                const int ra = __hip_atomic_fetch_add(&rcnt[ea], 1, __ATOMIC_RELAXED, __HIP_MEMORY_SCOPE_WORKGROUP);
                const int rb = __hip_atomic_fetch_add(&rcnt[eb], 1, __ATOMIC_RELAXED, __HIP_MEMORY_SCOPE_WORKGROUP);
                if (li < RT_CAP) { rt_er[2 * li] = (ea << 16) | ra; rt_gate[2 * li] = ga; rt_tok[2 * li] = tok; rt_er[2 * li + 1] = (eb << 16) | rb; rt_gate[2 * li + 1] = gb; rt_tok[2 * li + 1] = tok; }
            }
        }
      }
    }
    if (ROUTE) {
        __syncthreads();
        unsigned* cnt = ctl + CW_CNT + layer * NEXP * CNT_STRIDE;
        if (F.tid < NEXP) { const int n = rcnt[F.tid]; rbase[F.tid] = n ? (int)__hip_atomic_fetch_add(cnt + F.tid * CNT_STRIDE, (unsigned)n, __ATOMIC_RELAXED, __HIP_MEMORY_SCOPE_AGENT) : 0; }
        __syncthreads();
        int* list = (int*)(a.ws + WS_LIST); float* gatev = (float*)(a.ws + WS_GATEV); int* tsl = (int*)(a.ws + WS_TOKSLOT);
        int nloc = 0;
        for (int tb = F.bid * NWAVE * TPW; tb < NTOK; tb += F.G * NWAVE * TPW) nloc += NWAVE * TPW;
        nloc = nloc < RT_CAP ? nloc : RT_CAP;
        for (int i = F.tid; i < 2 * nloc; i += NTHR) {
            const int er = rt_er[i]; if (er < 0) continue;
            const int e = er >> 16, pos = rbase[e] + (er & 0xffff), tok = rt_tok[i];
            list[e * NTOK + pos] = tok; gatev[e * NTOK + pos] = rt_gate[i]; tsl[tok * 2 + (i & 1)] = (e << 20) | pos;
        }
    }
    __syncthreads();
}

constexpr int RP_HT = 0, RP_HT_LD = 1028;
constexpr int RP_PART = 16 * RP_HT_LD * 4;
constexpr int RP_LG = RP_PART + 8 * 16 * 48 * 4;
DI void route_phase(const Frame& F, const Args& a, int layer) {
    const float* mod = (const float*)(a.ws + WS_MOD);
    bf16_t* hbuf = (bf16_t*)(a.ws + WS_H);
    unsigned* ctl = (unsigned*)(a.ws + WS_CTL);
    LAS float* HT = (LAS float*)(F.lds + RP_HT);
    LAS float* PART = (LAS float*)(F.lds + RP_PART);
    LAS float* LG = (LAS float*)(F.lds + RP_LG);
    constexpr int RT_CAP = 512;
    LAS int* rcnt = (LAS int*)(F.lds + 149504);
    LAS int* rbase = (LAS int*)(F.lds + 149632);
    LAS int* rt_er = (LAS int*)(F.lds + 149760);
    LAS float* rt_gate = (LAS float*)(F.lds + 149760 + 4096);
    LAS int* rt_tok = (LAS int*)(F.lds + 149760 + 8192);
    if (F.tid < NEXP) rcnt[F.tid] = 0;
    for (int i = F.tid; i < 2 * RT_CAP; i += NTHR) rt_er[i] = -1;
    const float* wg = a.moe_wr_g + (size_t)layer * DM * 4;
    const float* we = a.moe_wr_e + (size_t)layer * DM * 32;
    const int col = F.lane & 15, kq = F.lane >> 4;
    float Bw[3][32];
#pragma unroll
    for (int s2 = 0; s2 < 32; ++s2) {
        const int k = 128 * F.wave + 16 * (s2 >> 2) + 4 * kq + (s2 & 3);
        Bw[0][s2] = col < 4 ? wg[k * 4 + col] : we[k * 32 + col - 4];
        Bw[1][s2] = we[k * 32 + 12 + col];
        Bw[2][s2] = col < 4 ? we[k * 32 + 28 + col] : 0.f;
    }
    const float* ng = a.norm_g + ((size_t)layer * 2 + 1) * DM;
    __syncthreads();
    const int ngroups = NTOK / 16;
    int li0 = 0;
    for (int gi = F.bid; gi < ngroups; gi += F.G, li0 += 16) {
        const int tb = gi * 16 + F.wave * 2, b = tb / SEQ;
        const float* sh = mod + ((size_t)layer * NB + b) * 6 * DM + 3 * DM;
        const float* scp = sh + DM;
#pragma unroll
        for (int ti = 0; ti < 2; ++ti) {
            const int tok = tb + ti;
            f32x4 xv[4];
#pragma unroll
            for (int c = 0; c < 4; ++c) xv[c] = *(const f32x4*)(a.out + (size_t)tok * DM + c * 256 + F.lane * 4);
            float ss = 0.f;
#pragma unroll
            for (int c = 0; c < 4; ++c) ss += xv[c][0] * xv[c][0] + xv[c][1] * xv[c][1] + xv[c][2] * xv[c][2] + xv[c][3] * xv[c][3];
            ss = wave_sum(ss);
            const float rinv = rsqrtf(ss * (1.0f / DM) + EPS);
#pragma unroll
            for (int c = 0; c < 4; ++c) {
                const int cl = c * 256 + F.lane * 4;
                const f32x4 g = *(const f32x4*)(ng + cl), s1 = *(const f32x4*)(scp + cl), s0 = *(const f32x4*)(sh + cl);
                f32x4 hv;
#pragma unroll
                for (int u = 0; u < 4; ++u) hv[u] = (xv[c][u] * rinv * g[u]) * (1.0f + s1[u]) + s0[u];
                u32x2 w; w[0] = pack_bf16(hv[0], hv[1]); w[1] = pack_bf16(hv[2], hv[3]);
                *(u32x2*)(hbuf + (size_t)tok * DM + cl) = w;
                *(LAS f32x4*)(HT + (F.wave * 2 + ti) * RP_HT_LD + cl) = hv;
            }
        }
        __syncthreads();
        {
            f32x4 acc[3];
#pragma unroll
            for (int n = 0; n < 3; ++n) acc[n] = (f32x4){0.f, 0.f, 0.f, 0.f};
            const LAS float* ap = HT + col * RP_HT_LD + 128 * F.wave + 4 * kq;
#pragma unroll
            for (int s4 = 0; s4 < 8; ++s4) {
                const f32x4 av = *(const LAS f32x4*)(ap + 16 * s4);
#pragma unroll
                for (int u = 0; u < 4; ++u)
#pragma unroll
                    for (int n = 0; n < 3; ++n) acc[n] = __builtin_amdgcn_mfma_f32_16x16x4f32(av[u], Bw[n][4 * s4 + u], acc[n], 0, 0, 0);
            }
#pragma unroll
            for (int n = 0; n < 3; ++n)
#pragma unroll
                for (int r = 0; r < 4; ++r) PART[(F.wave * 16 + 4 * kq + r) * 48 + 16 * n + col] = acc[n][r];
        }
        __syncthreads();
        {
            const int tk = F.tid >> 5, j = F.tid & 31;
            float s0 = 0.f, s1 = 0.f;
#pragma unroll
            for (int wv = 0; wv < NWAVE; ++wv) { s0 += PART[(wv * 16 + tk) * 48 + j]; s1 += PART[(wv * 16 + tk) * 48 + 32 + (j & 3)]; }
            LG[tk * 36 + j] = s0 + (j < 4 ? a.moe_br_g[layer * 4 + j] : a.moe_br_e[layer * 32 + j - 4]);
            if (j < 4) LG[tk * 36 + 32 + j] = s1 + a.moe_br_e[layer * 32 + 28 + j];
        }
        __syncthreads();
        if (F.tid < 16) {
            const int tk = F.tid, tok = gi * 16 + tk;
            float lg[36];
#pragma unroll
            for (int j = 0; j < 36; ++j) lg[j] = LG[tk * 36 + j];
            int g = 0; float gm = lg[0];
#pragma unroll
            for (int j = 1; j < 4; ++j) if (lg[j] > gm) { gm = lg[j]; g = j; }
            float den = 0.f;
#pragma unroll
            for (int j = 0; j < 4; ++j) den += __expf(lg[j] - gm);
            const float ptop = 1.0f / den;
            float fv[8];
#pragma unroll
            for (int i = 0; i < 8; ++i) fv[i] = (g == 0) ? lg[4 + i] : (g == 1) ? lg[12 + i] : (g == 2) ? lg[20 + i] : lg[28 + i];
            int i1 = 0; float v1 = fv[0];
#pragma unroll
            for (int i = 1; i < 8; ++i) if (fv[i] > v1) { v1 = fv[i]; i1 = i; }
            int i2 = -1; float v2 = -3.0e38f;
#pragma unroll
            for (int i = 0; i < 8; ++i) if (i != i1 && fv[i] > v2) { v2 = fv[i]; i2 = i; }
            const float e2 = __expf(v2 - v1), ga = ptop / (1.0f + e2), gb = ptop * e2 / (1.0f + e2);
            const int li = li0 + tk, ea = g * 8 + i1, eb = g * 8 + i2;
            const int ra = __hip_atomic_fetch_add(&rcnt[ea], 1, __ATOMIC_RELAXED, __HIP_MEMORY_SCOPE_WORKGROUP);
            const int rb = __hip_atomic_fetch_add(&rcnt[eb], 1, __ATOMIC_RELAXED, __HIP_MEMORY_SCOPE_WORKGROUP);
            if (li < RT_CAP) { rt_er[2 * li] = (ea << 16) | ra; rt_gate[2 * li] = ga; rt_tok[2 * li] = tok; rt_er[2 * li + 1] = (eb << 16) | rb; rt_gate[2 * li + 1] = gb; rt_tok[2 * li + 1] = tok; }
        }
    }
    __syncthreads();
    unsigned* cnt = ctl + CW_CNT + layer * NEXP * CNT_STRIDE;
    if (F.tid < NEXP) { const int n = rcnt[F.tid]; rbase[F.tid] = n ? (int)__hip_atomic_fetch_add(cnt + F.tid * CNT_STRIDE, (unsigned)n, __ATOMIC_RELAXED, __HIP_MEMORY_SCOPE_AGENT) : 0; }
    __syncthreads();
    int* list = (int*)(a.ws + WS_LIST); float* gatev = (float*)(a.ws + WS_GATEV); int* tsl = (int*)(a.ws + WS_TOKSLOT);
    const int nloc = li0 < RT_CAP ? li0 : RT_CAP;
    for (int i = F.tid; i < 2 * nloc; i += NTHR) {
        const int er = rt_er[i]; if (er < 0) continue;
        const int e = er >> 16, pos = rbase[e] + (er & 0xffff), tok = rt_tok[i];
        list[e * NTOK + pos] = tok; gatev[e * NTOK + pos] = rt_gate[i]; tsl[tok * 2 + (i & 1)] = (e << 20) | pos;
    }
    __syncthreads();
}

constexpr int LDS_MISC = 131072 + 64;
constexpr int LDS_XB = 163840 - 16;
constexpr int LDS_BYTES = 163840;
using pg8::Unit;
struct DenseSched {
    int nM, nN, nwg, G, c; const char* Bt; size_t tstepB;
    DI void init(int M, int N, int K, int G_, int c_, const void* Bt_) { nM = M / 256; nN = N / 256; nwg = nM * nN; G = G_; c = c_; Bt = (const char*)Bt_; tstepB = (size_t)256 * K * 2; }
    DI bool next(int i, Unit& u) const {
        const long L = (long)i * G + c; if (L >= nwg) return false;
        int wgid = (int)L; { const int q = nwg / 8, r = nwg % 8, xcd = wgid % 8, off = wgid / 8; wgid = (xcd < r ? xcd * (q + 1) : r * (q + 1) + (xcd - r) * q) + off; }
        const int nig = 8 * nN, gid = wgid / nig, fm = gid * 8, gsz = (nM - fm) < 8 ? (nM - fm) : 8;
        u.pm = fm + ((wgid % nig) % gsz); u.pn = (wgid % nig) / gsz; u.e = 0; u.nrow = 256; return true;
    }
    DI int a_row(const Unit& u, int r) const { return u.pm * 256 + r; }
    DI const char* b_base(const Unit& u) const { return Bt + (size_t)u.pn * tstepB; }
};
template <bool UP>
struct MoeSched {
    const LAS int* ntp; const unsigned* cnt; const int* list; const char* W; int nU, G, c;
    DI bool next(int i, Unit& u) const {
        const long L = (long)i * G + c; if (L >= nU) return false;
        int wgid = (int)L; { const int q = nU / 8, r = nU % 8, xcd = wgid % 8, off = wgid / 8; wgid = (xcd < r ? xcd * (q + 1) : r * (q + 1) + (xcd - r) * q) + off; }
        const int tg = wgid >> 2; u.pn = wgid & 3; u.pm = tg;
        int e = 0;
        for (int k = 1; k < NEXP; ++k) e += (ntp[k] <= tg) ? 1 : 0;
        u.e = e; const int rem = (int)cnt[e * CNT_STRIDE] - (tg - ntp[e]) * 256; u.nrow = rem < 256 ? rem : 256; return true;
    }
    DI int a_row(const Unit& u, int r) const {
        if (UP) { const int p = (u.pm - ntp[u.e]) * 256 + r; return (r < u.nrow) ? list[u.e * NTOK + p] : 0; }
        return u.pm * 256 + r;
    }
    DI const char* b_base(const Unit& u) const {
        return W + (size_t)u.e * 3 * MiB + (UP ? (size_t)u.pn * 256 * DM * 2 : 2 * MiB + (size_t)u.pn * 256 * DEXP * 2);
    }
};
DI void moe_tile_table(const Frame& F, const unsigned* cnt, LAS int* ntp  ) {
    if (F.tid == 0) { int s = 0; for (int e = 0; e < NEXP; ++e) { ntp[e] = s; s += ((int)cnt[e * CNT_STRIDE] + 255) >> 8; } ntp[NEXP] = s; }
    __syncthreads();
}

#define EPI_ROWS_BEGIN const int row0 = u.pm * 256 + wr * 64 + fr; _Pragma("unroll") for (int ai = 0; ai < 2; ++ai) _Pragma("unroll") for (int m = 0; m < 4; ++m) { const int row = row0 + ai * 128 + m * 16;
#define EPI_ROWS_END }
DI u32x2 pack4(const f32x4& v) { u32x2 w; w[0] = pack_bf16(v[0], v[1]); w[1] = pack_bf16(v[2], v[3]); return w; }

struct EpiAbIn {
    bf16_t* Zc;
    DI void operator()(const f32x4 (&acc)[2][2][4][2], const Unit& u, int wr, int wc, int fr, int fq) const {
        EPI_ROWS_BEGIN
            bf16_t* rp = Zc + (size_t)row * ZC_N;
#pragma unroll
            for (int bj = 0; bj < 2; ++bj) {
                if (u.pn < 2) {
#pragma unroll
                    for (int n = 0; n < 2; ++n) *(u32x2*)(rp + u.pn * 256 + bj * 128 + wc * 32 + n * 16 + 4 * fq) = pack4(acc[ai][bj][m][n]);
                } else {
                    const int pnp = (u.pn - 2) & 3, j = 16 * (8 * pnp + 4 * bj + wc) + 4 * fq;
                    const f32x4 X = acc[ai][bj][m][0], Y = acc[ai][bj][m][1]; f32x4 v;
                    if (u.pn < 6) { v = X * Y; *(u32x2*)(rp + 512 + j) = pack4(v); }
                    else { v[0] = X[0] * sigmoid_f(Y[0]); v[1] = X[1] * sigmoid_f(Y[1]); v[2] = X[2] * sigmoid_f(Y[2]); v[3] = X[3] * sigmoid_f(Y[3]); *(u32x2*)(rp + 1024 + j) = pack4(v); }
                }
            }
        EPI_ROWS_END
    }
};
struct EpiResid {
    const float* xin; float* xout; const float* g1;
    DI void operator()(const f32x4 (&acc)[2][2][4][2], const Unit& u, int wr, int wc, int fr, int fq) const {
        const float* g = g1 + (size_t)((u.pm * 256) / SEQ) * 6 * DM;
        EPI_ROWS_BEGIN
#pragma unroll
            for (int bj = 0; bj < 2; ++bj)
#pragma unroll
                for (int n = 0; n < 2; ++n) {
                    const int col = u.pn * 256 + bj * 128 + wc * 32 + n * 16 + 4 * fq;
                    const f32x4 xo = *(const f32x4*)(xin + (size_t)row * DM + col), gv = *(const f32x4*)(g + col);
                    *(f32x4*)(xout + (size_t)row * DM + col) = xo + gv * acc[ai][bj][m][n];
                }
        EPI_ROWS_END
    }
};
struct EpiPlain {
    bf16_t* O; int ld;
    DI void operator()(const f32x4 (&acc)[2][2][4][2], const Unit& u, int wr, int wc, int fr, int fq) const {
        EPI_ROWS_BEGIN
#pragma unroll
            for (int bj = 0; bj < 2; ++bj)
#pragma unroll
                for (int n = 0; n < 2; ++n) *(u32x2*)(O + (size_t)row * ld + u.pn * 256 + bj * 128 + wc * 32 + n * 16 + 4 * fq) = pack4(acc[ai][bj][m][n]);
        EPI_ROWS_END
    }
};
struct EpiMoeUp {
    bf16_t* act;
    DI void operator()(const f32x4 (&acc)[2][2][4][2], const Unit& u, int wr, int wc, int fr, int fq) const {
        EPI_ROWS_BEGIN
#pragma unroll
            for (int bj = 0; bj < 2; ++bj) {
                const int j = 16 * (8 * u.pn + 4 * bj + wc) + 4 * fq;
                const f32x4 X = acc[ai][bj][m][0], Y = acc[ai][bj][m][1]; f32x4 v;
                v[0] = silu_f(X[0]) * Y[0]; v[1] = silu_f(X[1]) * Y[1]; v[2] = silu_f(X[2]) * Y[2]; v[3] = silu_f(X[3]) * Y[3];
                *(u32x2*)(act + (size_t)row * DEXP + j) = pack4(v);
            }
        EPI_ROWS_END
    }
};
struct EpiMoeDown {
    bf16_t* y; const float* gatev; const LAS int* ntp;
    DI void operator()(const f32x4 (&acc)[2][2][4][2], const Unit& u, int wr, int wc, int fr, int fq) const {
        const int pbase = (u.pm - ntp[u.e]) * 256;
        EPI_ROWS_BEGIN
            const int r = row - u.pm * 256;
            const float gt = (r < u.nrow) ? gatev[u.e * NTOK + pbase + r] : 0.f;
#pragma unroll
            for (int bj = 0; bj < 2; ++bj)
#pragma unroll
                for (int n = 0; n < 2; ++n) *(u32x2*)(y + (size_t)row * DM + u.pn * 256 + bj * 128 + wc * 32 + n * 16 + 4 * fq) = pack4(acc[ai][bj][m][n] * gt);
        EPI_ROWS_END
    }
};

DI void conv_phase(const Frame& F, const Args& a) {
    const bf16_t* Zc = (const bf16_t*)(a.ws + WS_BIG);
    bf16_t* Y = (bf16_t*)(a.ws + WS_Y);
    LAS unsigned* PB = (LAS unsigned*)F.lds;
    LAS f32x2* ST = (LAS f32x2*)(F.lds + 94 * 1024);
    const int cp = F.tid & 255, th = F.tid >> 8, wq = F.wave & 3;
    float wb[31][2], wa[3][2];
#pragma unroll
    for (int k = 0; k < 31; ++k) { const f32x2 w = *(const f32x2*)(a.ab_conv_b + k * 512 + 2 * cp); wb[k][0] = w[0]; wb[k][1] = w[1]; }
#pragma unroll
    for (int k = 0; k < 3; ++k) { const f32x2 w = *(const f32x2*)(a.ab_conv_a + k * 512 + 2 * cp); wa[k][0] = w[0]; wa[k][1] = w[1]; }
    const f32x2 cbias = *(const f32x2*)(a.ab_conv_b_bias + 2 * cp), lng = *(const f32x2*)(a.ab_ln_g + 2 * cp), lnb = *(const f32x2*)(a.ab_ln_b + 2 * cp);
    for (int tile = F.bid; tile < NTOK / 64; tile += F.G) {
        const int t0 = tile * 64, b = t0 / SEQ, tl0 = t0 % SEQ;
        for (int i = F.tid; i < 94 * 64; i += NTHR) {
            const int r = i >> 6, c8 = i & 63, pos = tl0 - 30 + r;
            u32x4 v = {0u, 0u, 0u, 0u};
            if (pos >= 0) v = *(const u32x4*)(Zc + (size_t)(b * SEQ + pos) * ZC_N + 1024 + c8 * 8);
            *(LAS u32x4*)(PB + r * 256 + c8 * 4) = v;
        }
        __syncthreads();
#pragma unroll 1
        for (int g = 0; g < 4; ++g) {
            float U[8][2];
#pragma unroll
            for (int i = 0; i < 8; ++i) { U[i][0] = cbias[0]; U[i][1] = cbias[1]; }
#pragma unroll
            for (int r = 0; r < 38; ++r) {
                const unsigned xw = PB[(32 * th + 8 * g + r) * 256 + cp];
                const float x0 = bf_lo(xw), x1 = bf_hi(xw);
#pragma unroll
                for (int i = 0; i < 8; ++i) { const int k = r - i; if (k >= 0 && k <= 30) { U[i][0] += wb[k][0] * x0; U[i][1] += wb[k][1] * x1; } }
            }
#pragma unroll
            for (int i = 0; i < 8; ++i) {
                const float s1 = wave_sum(U[i][0] + U[i][1]), s2 = wave_sum(U[i][0] * U[i][0] + U[i][1] * U[i][1]);
                if (F.lane == 0) ST[(32 * th + 8 * g + i) * 4 + wq] = (f32x2){s1, s2};
            }
            __syncthreads();
#pragma unroll
            for (int i = 0; i < 8; ++i) {
                const int tl = 32 * th + 8 * g + i; const size_t tok = (size_t)t0 + tl; const int pos = tl0 + tl;
                const f32x2 p0 = ST[tl * 4 + 0], p1 = ST[tl * 4 + 1], p2 = ST[tl * 4 + 2], p3 = ST[tl * 4 + 3];
                const float mean = ((p0[0] + p1[0]) + (p2[0] + p3[0])) * (1.0f / 512.0f);
                const float var = ((p0[1] + p1[1]) + (p2[1] + p3[1])) * (1.0f / 512.0f) - mean * mean;
                const float rstd = rsqrtf(var + EPS);
                const float yb0 = silu_f((U[i][0] - mean) * rstd * lng[0] + lnb[0]), yb1 = silu_f((U[i][1] - mean) * rstd * lng[1] + lnb[1]);
                *(unsigned*)(Y + tok * DM + 512 + 2 * cp) = pack_bf16(yb0, yb1);
                float a0 = 0.f, a1 = 0.f;
#pragma unroll
                for (int k = 0; k < 3; ++k) {
                    const int pp = pos - 2 + k;
                    if (pp >= 0) { const unsigned w = *(const unsigned*)(Zc + (size_t)(b * SEQ + pp) * ZC_N + 512 + 2 * cp); a0 += wa[k][0] * bf_lo(w); a1 += wa[k][1] * bf_hi(w); }
                }
                const unsigned gw = *(const unsigned*)(Zc + tok * ZC_N + 2 * cp);
                *(unsigned*)(Y + tok * DM + 2 * cp) = pack_bf16(bf_lo(gw) * a0, bf_hi(gw) * a1);
            }
        }
        __syncthreads();
    }
}

#define MFMA32(a, b, c) __builtin_amdgcn_mfma_f32_32x32x16_bf16((a), (b), (c), 0, 0, 0)
constexpr int TK_HIST = 0;
constexpr int TK_HLD = 513;
constexpr int TK_TAB = 66048;
constexpr int TK_CAP = 256;
constexpr int TK_CAND = 66560;
constexpr int TK_CCNT = TK_CAND + 32 * TK_CAP * 4;
constexpr int TK_OVF = TK_CCNT + 128;
constexpr int TK_BQ = 100352;
constexpr int TK_MASK = 118784;
DI int crow_c(int r) { return (r & 3) + 8 * (r >> 2); }
template <int MODE, bool DIAG>
DI void topk_elems(const Frame& F, const f32x16& sc, int kt, int q, int h2, int myT, LAS unsigned* hist, LAS unsigned* cand, LAS int* ccnt, LAS unsigned* maskl) {
    const int lo = myT << 9, hi = (myT + 1) << 9;
    if (MODE <= 2) {
#pragma unroll
        for (int r = 0; r < 16; ++r) {
            unsigned key = (unsigned)sc[r]; key = key > 262143u ? 262143u : key;
            const bool valid = !DIAG || (crow_c(r) + 4 * h2 <= q);
            if (MODE == 1) { if (valid) __hip_atomic_fetch_add(&hist[q * TK_HLD + (key >> 9)], 1u, __ATOMIC_RELAXED, __HIP_MEMORY_SCOPE_WORKGROUP); }
            else { if (valid && (int)(key >> 9) == myT) __hip_atomic_fetch_add(&hist[q * TK_HLD + (key & 511)], 1u, __ATOMIC_RELAXED, __HIP_MEMORY_SCOPE_WORKGROUP); }
        }
        return;
    }
    const int selb = (MODE == 3 ? myT : hi - 1), geb = (MODE == 3 ? myT - 1 : lo - 1);
    unsigned selw = 0u, gew = 0u;
#pragma unroll
    for (int r = 0; r < 16; ++r) {
        unsigned key = (unsigned)sc[r]; key = key > 262143u ? 262143u : key;
        const unsigned d1 = (unsigned)(selb - (int)key), d2 = (unsigned)(geb - (int)key);
        selw = __builtin_amdgcn_alignbit(selw, d1, 31);
        gew = __builtin_amdgcn_alignbit(gew, d2, 31);
    }
    if (DIAG) {
        unsigned vw = 0u;
#pragma unroll
        for (int r = 0; r < 16; ++r) vw |= (crow_c(r) + 4 * h2 <= q) ? (1u << (15 - r)) : 0u;
        selw &= vw; gew &= vw;
    }
    unsigned cw = gew & ~selw & 0xffffu;
    if (cw) {
#pragma unroll
        for (int r = 0; r < 16; ++r) {
            if (cw & (1u << (15 - r))) {
                unsigned key = (unsigned)sc[r]; key = key > 262143u ? 262143u : key;
                const int p = __hip_atomic_fetch_add(&ccnt[q], 1, __ATOMIC_RELAXED, __HIP_MEMORY_SCOPE_WORKGROUP);
                if (p < TK_CAP) cand[q * TK_CAP + p] = (MODE == 3 ? 0u : ((key - (unsigned)lo) << 13)) | (unsigned)(8191 - (32 * kt + crow_c(r) + 4 * h2));
            }
        }
    }
    unsigned rv = __builtin_bitreverse32(selw) >> 16;
    unsigned bits = (rv & 0xfu) | ((rv & 0xf0u) << 4) | ((rv & 0xf00u) << 8) | ((rv & 0xf000u) << 12);
    bits <<= 4 * h2;
    bits |= (unsigned)__shfl_xor((int)bits, 32);
    if (h2 == 0) maskl[q * 256 + kt] = bits;
}
template <int MODE>
DI void topk_pass(const Frame& F, const bf16_t* Z, int b, int t0, const float (&wp)[8]) {
    const LAS unsigned char* bq = F.lds + TK_BQ;
    LAS unsigned* hist = (LAS unsigned*)(F.lds + TK_HIST);
    LAS int* tab = (LAS int*)(F.lds + TK_TAB);
    LAS unsigned* cand = (LAS unsigned*)(F.lds + TK_CAND);
    LAS int* ccnt = (LAS int*)(F.lds + TK_CCNT);
    LAS unsigned* maskl = (LAS unsigned*)(F.lds + TK_MASK);
    const int lane = fresh_lane(), q = lane & 31, h2 = lane >> 5, ntile = t0 / 32 + 1;
    const int myT = (MODE >= 2) ? tab[q * 4 + 0] : 0;
    const bf16_t* kbase = Z + (size_t)b * SEQ * CD_N + Z_KI + 8 * h2 + (size_t)q * CD_N;
    bf16x8 A0n = (bf16x8){0, 0, 0, 0, 0, 0, 0, 0}, A1n = A0n;
    if (F.wave < ntile) { const bf16_t* kp = kbase + (size_t)(32 * F.wave) * CD_N; A0n = *(const bf16x8*)kp; A1n = *(const bf16x8*)(kp + 16); }
    for (int kt = F.wave; kt < ntile; kt += NWAVE) {
        const bf16x8 A0 = A0n, A1 = A1n;
        if (kt + NWAVE < ntile) { const bf16_t* kp = kbase + (size_t)(32 * (kt + NWAVE)) * CD_N; A0n = *(const bf16x8*)kp; A1n = *(const bf16x8*)(kp + 16); }
        f32x16 sc;
#pragma unroll
        for (int r = 0; r < 16; ++r) sc[r] = 131072.0f;
        bf16x8 A0g = A0, A1g = A1;
#pragma unroll
        for (int g = 0; g < 3; ++g) {
            if (g > 0) asm volatile("" : "+v"(A0g), "+v"(A1g) : "v"(sc[15]));
            f32x16 ac[3];
#pragma unroll
            for (int u = 0; u < 3; ++u) {
                const int h = (g == 0) ? (u == 0 ? 8 : u - 1) : (3 * g + u - 1);
#pragma unroll
                for (int r = 0; r < 16; ++r) ac[u][r] = 0.f;
                ac[u] = MFMA32(A0g, *(const LAS bf16x8*)(bq + ((2 * h) * 64 + lane) * 16), ac[u]); ac[u] = MFMA32(A1g, *(const LAS bf16x8*)(bq + ((2 * h + 1) * 64 + lane) * 16), ac[u]);
            }
#pragma unroll
            for (int u = 0; u < 3; ++u) {
                const int h = (g == 0) ? (u == 0 ? 8 : u - 1) : (3 * g + u - 1);
                if (h == 8) {
#pragma unroll
                    for (int r = 0; r < 16; ++r) sc[r] += ac[u][r];
                } else {
#pragma unroll
                    for (int r = 0; r < 16; ++r) sc[r] += __builtin_fabsf(ac[u][r]) * wp[h];
                }
            }
        }
        if (kt == ntile - 1) topk_elems<MODE, true>(F, sc, kt, q, h2, myT, hist, cand, ccnt, maskl);
        else topk_elems<MODE, false>(F, sc, kt, q, h2, myT, hist, cand, ccnt, maskl);
    }
}
DI void topk_scan(const Frame& F, int pass, int t0) {
    LAS unsigned* hist = (LAS unsigned*)(F.lds + TK_HIST);
    LAS int* tab = (LAS int*)(F.lds + TK_TAB);
    LAS int* ovf = (LAS int*)(F.lds + TK_OVF);
    for (int qi = 0; qi < 4; ++qi) {
        const int q = F.wave * 4 + qi, n = t0 + q + 1;
        int need = 256, prevT = 0, prevAbove = 0;
        if (pass == 2) { prevT = tab[q * 4 + 0]; prevAbove = tab[q * 4 + 1]; need = 256 - prevAbove; }
        if (n <= 256) { if (F.lane == 0) { tab[q * 4 + 0] = -1; tab[q * 4 + 1] = 0; tab[q * 4 + 2] = 0; } continue; }
        unsigned hv[8]; unsigned s = 0;
#pragma unroll
        for (int i = 0; i < 8; ++i) { hv[i] = hist[q * TK_HLD + 511 - (8 * F.lane + i)]; s += hv[i]; }
        unsigned inc = s;
#pragma unroll
        for (int o = 1; o < 64; o <<= 1) { const unsigned v = (unsigned)__shfl_up((int)inc, o); if (F.lane >= o) inc += v; }
        const unsigned pre = inc - s;
        if ((int)pre < need && (int)inc >= need) {
            unsigned cum = pre; int bsel = 0; unsigned above = 0, inbin = 0; bool found = false;
#pragma unroll
            for (int i = 0; i < 8; ++i) { if (!found && (int)(cum + hv[i]) >= need) { found = true; bsel = 511 - (8 * F.lane + i); above = cum; inbin = hv[i]; } cum += hv[i]; }
            if (pass == 1) { tab[q * 4 + 0] = bsel; tab[q * 4 + 1] = (int)above; tab[q * 4 + 2] = 256 - (int)above; if (inbin > (unsigned)TK_CAP) *ovf = 1; }
            else { tab[q * 4 + 0] = (prevT << 9) | bsel; tab[q * 4 + 1] = prevAbove + (int)above; tab[q * 4 + 2] = 256 - (prevAbove + (int)above); }
        }
    }
}
DI void topk_select(const Frame& F) {
    LAS int* tab = (LAS int*)(F.lds + TK_TAB);
    LAS unsigned* cand = (LAS unsigned*)(F.lds + TK_CAND);
    LAS int* ccnt = (LAS int*)(F.lds + TK_CCNT);
    LAS unsigned* maskl = (LAS unsigned*)(F.lds + TK_MASK);
    for (int qi = 0; qi < 4; ++qi) {
        const int q = F.wave * 4 + qi, need = tab[q * 4 + 2];
        int n = ccnt[q]; n = n > TK_CAP ? TK_CAP : n;
        if (need <= 0 || n <= 0) continue;
        unsigned c[4]; int rk[4]; bool vv[4];
#pragma unroll
        for (int i = 0; i < 4; ++i) { vv[i] = F.lane + 64 * i < n; c[i] = vv[i] ? cand[q * TK_CAP + F.lane + 64 * i] : 0u; rk[i] = 0; }
        for (int j = 0; j < n; ++j) {
            const unsigned cj = cand[q * TK_CAP + j];
#pragma unroll
            for (int i = 0; i < 4; ++i) rk[i] += (cj > c[i]) ? 1 : 0;
        }
#pragma unroll
        for (int i = 0; i < 4; ++i)
            if (vv[i] && rk[i] < need) { const int idx = 8191 - (int)(c[i] & 8191u); __hip_atomic_fetch_or(&maskl[q * 256 + (idx >> 5)], 1u << (idx & 31), __ATOMIC_RELAXED, __HIP_MEMORY_SCOPE_WORKGROUP); }
    }
}
DI void topk_phase(const Frame& F, const Args& a, unsigned long long& tacc) {
    unsigned long long t_s = 0;
#define TKT0(n) do { if (TIME_PH == 100 + (n)) { __syncthreads(); t_s = wall_clock64(); } } while (0)
#define TKT1(n) do { if (TIME_PH == 100 + (n)) { __syncthreads(); tacc += wall_clock64() - t_s; } } while (0)
    const bf16_t* Z = (const bf16_t*)(a.ws + WS_BIG);
    unsigned* maskg = (unsigned*)(a.ws + WS_MASK);
    LAS unsigned* hist = (LAS unsigned*)(F.lds + TK_HIST);
    LAS int* ccnt = (LAS int*)(F.lds + TK_CCNT);
    LAS int* ovf = (LAS int*)(F.lds + TK_OVF);
    LAS unsigned* maskl = (LAS unsigned*)(F.lds + TK_MASK);
    for (int pi = F.bid; pi < 512; pi += F.G) {
        const int b = pi >> 7, p = pi & 127;
        for (int half = 0; half < 2; ++half) {
            const int t0 = 32 * (half ? 255 - p : p), ntile = t0 / 32 + 1;
            const int lane0 = fresh_lane(), q = lane0 & 31, h2 = lane0 >> 5;
            const bf16_t* zr = Z + (size_t)(b * SEQ + t0 + q) * CD_N;
            TKT0(1);
            float wp[8];
            { const u32x4 wv = *(const u32x4*)(zr + Z_WI);
              const float sc = 0.0625f * 0.5f * 16384.0f;
              wp[0] = bf_lo(wv[0]) * sc; wp[1] = bf_hi(wv[0]) * sc; wp[2] = bf_lo(wv[1]) * sc; wp[3] = bf_hi(wv[1]) * sc;
              wp[4] = bf_lo(wv[2]) * sc; wp[5] = bf_hi(wv[2]) * sc; wp[6] = bf_lo(wv[3]) * sc; wp[7] = bf_hi(wv[3]) * sc; }
            __syncthreads();
            if (F.wave == 0) {
                LAS unsigned char* bqw = F.lds + TK_BQ;
                float lin[2][8];
#pragma unroll
                for (int ks = 0; ks < 2; ++ks)
#pragma unroll
                    for (int j = 0; j < 8; ++j) lin[ks][j] = 0.f;
#pragma unroll
                for (int h = 0; h < 8; ++h)
#pragma unroll
                    for (int ks = 0; ks < 2; ++ks) {
                        const u32x4 v = *(const u32x4*)(zr + Z_QI + 32 * h + 16 * ks + 8 * h2);
                        *(LAS u32x4*)(bqw + ((2 * h + ks) * 64 + lane0) * 16) = v;
#pragma unroll
                        for (int j = 0; j < 4; ++j) { lin[ks][2 * j] += wp[h] * bf_lo(v[j]); lin[ks][2 * j + 1] += wp[h] * bf_hi(v[j]); }
                    }
#pragma unroll
                for (int ks = 0; ks < 2; ++ks) {
                    u32x4 v; v[0] = pack_bf16(lin[ks][0], lin[ks][1]); v[1] = pack_bf16(lin[ks][2], lin[ks][3]); v[2] = pack_bf16(lin[ks][4], lin[ks][5]); v[3] = pack_bf16(lin[ks][6], lin[ks][7]);
                    *(LAS u32x4*)(bqw + ((16 + ks) * 64 + lane0) * 16) = v;
                }
            }
            for (int i = F.tid; i < 32 * TK_HLD; i += NTHR) hist[i] = 0u;
            if (F.tid < 32) ccnt[F.tid] = 0;
            if (F.tid == 32) *ovf = 0;
            __syncthreads();
            TKT1(1); TKT0(2);
            topk_pass<1>(F, Z, b, t0, wp);
            __syncthreads();
            TKT1(2); TKT0(3);
            topk_scan(F, 1, t0);
            __syncthreads();
            TKT1(3); TKT0(4);
            if (*ovf == 0) {
                topk_pass<4>(F, Z, b, t0, wp);
            } else {
                for (int i = F.tid; i < 32 * TK_HLD; i += NTHR) hist[i] = 0u;
                __syncthreads();
                topk_pass<2>(F, Z, b, t0, wp);
                __syncthreads();
                topk_scan(F, 2, t0);
                __syncthreads();
                topk_pass<3>(F, Z, b, t0, wp);
            }
            __syncthreads();
            TKT1(4); TKT0(5);
            topk_select(F);
            __syncthreads();
            for (int i = F.wave * 64 + fresh_lane(); i < 32 * ntile; i += NTHR) { const int qq = i / ntile, kt = i - qq * ntile; maskg[(size_t)(b * SEQ + t0 + qq) * 256 + kt] = maskl[qq * 256 + kt]; }
            TKT1(5);
        }
    }
}

constexpr int AT_KSTR = 72;
constexpr int AT_VSTR = 72;
constexpr int AT_KBYTES = 64 * AT_KSTR * 2;
constexpr int AT_VBYTES = 128 * AT_VSTR * 2;
constexpr int AT_BUF = AT_KBYTES + AT_VBYTES;
constexpr int AT_NSTG = 3;
constexpr int AT_LUT = AT_NSTG * AT_BUF;
constexpr int AT_LUT_LD = 320;
constexpr float NEG_INF = -__builtin_huge_valf();
constexpr float AT_THR = 8.0f;

template <int DV, bool MASKED>
DI void attn_core(const Frame& F, const bf16_t* Z, const bf16_t* Vt, int b, int qcol, int kcol, int vrow, int q0, const LAS float* lut, float c1, const unsigned* maskg, f32x16 (&O)[DV / 32]) {
    constexpr int NDV = DV / 32;
    const int q = F.lane & 31, h2 = F.lane >> 5;
    const int tw0 = q0 + 32 * F.wave, t = tw0 + q;
    const bf16_t* Zb = Z + (size_t)b * SEQ * CD_N;
    const bf16_t* Vb = Vt + (size_t)vrow * NTOK + (size_t)b * SEQ;
    const unsigned* mrow = maskg + (size_t)(b * SEQ + t) * 256;
    bf16x8 Qf[4];
#pragma unroll
    for (int ks = 0; ks < 4; ++ks) Qf[ks] = *(const bf16x8*)(Zb + (size_t)t * CD_N + qcol + 16 * ks + 8 * h2);
#pragma unroll
    for (int d = 0; d < NDV; ++d)
#pragma unroll
        for (int r = 0; r < 16; ++r) O[d][r] = 0.f;
    float m_run = NEG_INF, l_run = 0.f;
    const int jmax = (q0 + 255) >> 6;
    const int kkey = F.tid >> 3, kch = F.tid & 7;
    u32x4 kreg, vreg[DV / 64]; unsigned mreg[2] = {0u, 0u};
    bf16x8 Pf[4];
#pragma unroll
    for (int i = 0; i < 4; ++i) Pf[i] = (bf16x8){0, 0, 0, 0, 0, 0, 0, 0};
#define AT_LOAD(j) do { kreg = *(const u32x4*)(Zb + (size_t)(64 * (j) + kkey) * CD_N + kcol + 8 * kch); \
        _Pragma("unroll") for (int _i = 0; _i < DV / 64; ++_i) { const int idx = F.tid + NTHR * _i; vreg[_i] = *(const u32x4*)(Vb + (size_t)(idx >> 3) * NTOK + 64 * (j) + 8 * (idx & 7)); } \
        if (MASKED) { mreg[0] = mrow[2 * (j)]; mreg[1] = mrow[2 * (j) + 1]; } } while (0)
#define AT_STORE(buf) do { LAS unsigned char* kb_ = F.lds + (buf) * AT_BUF; *(LAS u32x4*)(kb_ + kkey * (AT_KSTR * 2) + kch * 16) = kreg; \
        _Pragma("unroll") for (int _i = 0; _i < DV / 64; ++_i) { const int idx = F.tid + NTHR * _i, dv_ = idx >> 3, ch_ = idx & 7; \
            LAS unsigned char* vp_ = kb_ + AT_KBYTES + dv_ * (AT_VSTR * 2) + (16 * (ch_ >> 1) + 4 * (ch_ & 1)) * 2; \
            *(LAS u32x2*)vp_ = (u32x2){vreg[_i][0], vreg[_i][1]}; *(LAS u32x2*)(vp_ + 16) = (u32x2){vreg[_i][2], vreg[_i][3]}; } } while (0)
#define AT_QKSM(jj) do { \
        const LAS unsigned char* kb = F.lds + ((jj) % AT_NSTG) * AT_BUF; \
        f32x16 s[2]; \
        _Pragma("unroll") for (int kb2 = 0; kb2 < 2; ++kb2) { \
            bf16x8 Kf[4]; \
            _Pragma("unroll") for (int ks = 0; ks < 4; ++ks) Kf[ks] = *(const LAS bf16x8*)(kb + (32 * kb2 + q) * (AT_KSTR * 2) + (16 * ks + 8 * h2) * 2); \
            _Pragma("unroll") for (int r = 0; r < 16; ++r) s[kb2][r] = 0.f; \
            _Pragma("unroll") for (int ks = 0; ks < 4; ++ks) s[kb2] = MFMA32(Kf[ks], Qf[ks], s[kb2]); \
        } \
        const bool nearb = (64 * (jj) + 63 + 128 > tw0); \
        float mloc = NEG_INF; \
        if (!nearb) { \
            _Pragma("unroll") for (int kb2 = 0; kb2 < 2; ++kb2) _Pragma("unroll") for (int r = 0; r < 16; ++r) mloc = fmaxf(mloc, s[kb2][r]); \
            mloc = mloc * c1 + lut[96 + 128]; \
        } else { \
            const LAS float* lp = lut + (t - 64 * (jj) - 4 * h2 + 96 - 63); \
            _Pragma("unroll") for (int kb2 = 0; kb2 < 2; ++kb2) \
                _Pragma("unroll") for (int r = 0; r < 16; ++r) { const float v_ = s[kb2][r] * c1 + lp[63 - (32 * kb2 + crow_c(r))]; s[kb2][r] = v_; mloc = fmaxf(mloc, v_); } \
        } \
        mloc = fmaxf(mloc, __shfl_xor(mloc, 32)); \
        if (__any(mloc > m_run + AT_THR)) { \
            const float m_new = fmaxf(m_run, mloc); \
            const float alpha = __builtin_amdgcn_exp2f(m_run - m_new); \
            m_run = m_new; l_run *= alpha; \
            _Pragma("unroll") for (int d = 0; d < NDV; ++d) _Pragma("unroll") for (int r = 0; r < 16; ++r) O[d][r] *= alpha; \
        } \
        const float sub = lut[96 + 128] - m_run; \
        if (!nearb) { _Pragma("unroll") for (int kb2 = 0; kb2 < 2; ++kb2) _Pragma("unroll") for (int r = 0; r < 16; ++r) s[kb2][r] = __builtin_amdgcn_exp2f(s[kb2][r] * c1 + sub); } \
        else        { _Pragma("unroll") for (int kb2 = 0; kb2 < 2; ++kb2) _Pragma("unroll") for (int r = 0; r < 16; ++r) s[kb2][r] = __builtin_amdgcn_exp2f(s[kb2][r] - m_run); } \
        float psum0 = 0.f, psum1 = 0.f; \
        _Pragma("unroll") for (int kb2 = 0; kb2 < 2; ++kb2) { \
            const unsigned mw = mcur[kb2] >> (4 * h2); \
            _Pragma("unroll") for (int r = 0; r < 16; ++r) { \
                float p = s[kb2][r]; \
                if (MASKED) { p = __uint_as_float(__float_as_uint(p) & (unsigned)(-(int)((mw >> crow_c(r)) & 1u))); s[kb2][r] = p; } \
                if (r & 1) psum1 += p; else psum0 += p; \
            } \
        } \
        l_run += psum0 + psum1; \
        _Pragma("unroll") for (int st = 0; st < 4; ++st) { \
            u32x4 pw; \
            _Pragma("unroll") for (int e = 0; e < 4; ++e) pw[e] = pack_bf16(s[st >> 1][8 * (st & 1) + 2 * e], s[st >> 1][8 * (st & 1) + 2 * e + 1]); \
            Pf[st] = __builtin_bit_cast(bf16x8, pw); \
        } \
    } while (0)
#define AT_PV(jj) do { \
        const LAS unsigned char* vt = F.lds + ((jj) % AT_NSTG) * AT_BUF + AT_KBYTES + q * (AT_VSTR * 2) + (8 * h2) * 2; \
        constexpr int NH = NDV / 2, NST = 4 * NH; \
        bf16x8 Av[2][2]; \
        _Pragma("unroll") for (int d = 0; d < 2; ++d) Av[0][d] = *(const LAS bf16x8*)(vt + (32 * d) * (AT_VSTR * 2)); \
        _Pragma("unroll") for (int u = 0; u < NST; ++u) { \
            const int st = u / NH, dh = u % NH; \
            if (u + 1 < NST) { \
                const int st1 = (u + 1) / NH, dh1 = (u + 1) % NH; \
                _Pragma("unroll") for (int d = 0; d < 2; ++d) Av[(u + 1) & 1][d] = *(const LAS bf16x8*)(vt + (32 * (2 * dh1 + d)) * (AT_VSTR * 2) + (16 * st1) * 2); \
            } \
            __builtin_amdgcn_s_setprio(1); \
            _Pragma("unroll") for (int d = 0; d < 2; ++d) O[2 * dh + d] = MFMA32(Av[u & 1][d], Pf[st], O[2 * dh + d]); \
            __builtin_amdgcn_s_setprio(0); \
            __builtin_amdgcn_sched_barrier(0); \
        } \
    } while (0)
#define AT_ACT(jj) (64 * (jj) <= tw0 + 31)
    AT_LOAD(0); AT_STORE(0);
    unsigned mcur[2] = {mreg[0], mreg[1]};
    __syncthreads();
    if (F.wave < 4) {
        for (int j = 0; j <= jmax; ++j) {
            if (j < jmax) AT_LOAD(j + 1);
            if (AT_ACT(j)) { AT_QKSM(j); AT_PV(j); }
            if (j < jmax) AT_STORE((j + 1) % AT_NSTG);
            mcur[0] = mreg[0]; mcur[1] = mreg[1];
            __syncthreads();
        }
    } else {
        for (int j = 0; j <= jmax; ++j) {
            if (j < jmax) AT_LOAD(j + 1);
            if (j > 0 && AT_ACT(j - 1)) AT_PV(j - 1);
            if (AT_ACT(j)) AT_QKSM(j);
            if (j < jmax) AT_STORE((j + 1) % AT_NSTG);
            mcur[0] = mreg[0]; mcur[1] = mreg[1];
            __syncthreads();
        }
        if (AT_ACT(jmax)) AT_PV(jmax);
    }
    __syncthreads();
#undef AT_LOAD
#undef AT_STORE
#undef AT_QKSM
#undef AT_PV
#undef AT_ACT
    const float lt = l_run + __shfl_xor(l_run, 32);
    const float inv = 1.0f / lt;
#pragma unroll
    for (int d = 0; d < NDV; ++d)
#pragma unroll
        for (int r = 0; r < 16; ++r) O[d][r] *= inv;
}

DI float rel_bucket_bias(const float* rel_bias, int d, int head) {
    int bkt;
    if (d < 16) bkt = d;
    else { const float lr = __logf((float)d * (1.0f / 16.0f)) / 2.0794415416798357f; int l = 16 + (int)(lr * 16.0f); bkt = l < 31 ? l : 31; }
    return rel_bias[bkt * 12 + head];
}
template <bool DPART>
DI void attn_phase(const Frame& F, const Args& a) {
    const bf16_t* Z = (const bf16_t*)(a.ws + WS_BIG);
    const bf16_t* Vtg = (const bf16_t*)(a.ws + WS_VT);
    bf16_t* Yo = (bf16_t*)(a.ws + WS_Y);
    float* O1s = (float*)(a.ws + WS_H);
    const unsigned* maskg = (const unsigned*)(a.ws + WS_MASK);
    LAS float* lut = (LAS float*)(F.lds + AT_LUT);
    for (int i = F.tid; i < 12 * AT_LUT_LD; i += NTHR) { const int hh = i / AT_LUT_LD, d = i % AT_LUT_LD - 96; lut[i] = d < 0 ? NEG_INF : rel_bucket_bias(a.rel_bias, d < 128 ? d : 128, hh) * LOG2E; }
    float lam;
    { float d01 = 0.f, d23 = 0.f; for (int i = 0; i < 64; ++i) { d01 += a.diff_lam[i] * a.diff_lam[64 + i]; d23 += a.diff_lam[128 + i] * a.diff_lam[192 + i]; }
      lam = __expf(d01) - __expf(d23) + 0.35550906759096f; lam = __uint_as_float(__builtin_amdgcn_readfirstlane(__float_as_uint(lam))); }
    const float one_m_li = 1.0f - 0.35550906759096f;
    __syncthreads();
    const float c1 = 0.125f * LOG2E;
    const int xcd = F.bid & 7, kk = F.bid >> 3;
    if (DPART)
    for (int it = F.bid; it < 256; it += F.G) {
        const int bh = (F.G == 256) ? 2 * xcd + (kk >> 4) : it >> 4, pr = (F.G == 256) ? (kk & 15) : (it & 15);
        const int b_ = bh >> 2, hd_ = bh & 3;
        for (int half = 0; half < 2; ++half) {
            Frame Fu = F; Fu.lane = fresh_lane();
            int b = b_, hd = hd_; asm volatile("" : "+s"(b), "+s"(hd));
            const int q0 = 256 * (half ? 31 - pr : pr);
            f32x16 O[4];
            attn_core<128, false>(Fu, Z, Vtg, b, Z_QD + 128 * hd, Z_KD + 128 * hd, VT_D + 128 * hd, q0, lut + (8 + hd) * AT_LUT_LD, c1, nullptr, O);
            {
                const int l1 = fresh_lane();
                float* o1p = O1s + (size_t)(b * SEQ + q0 + 32 * F.wave + (l1 & 31)) * 512 + 128 * hd + 4 * (l1 >> 5);
#pragma unroll
                for (int d = 0; d < 4; ++d)
#pragma unroll
                    for (int g = 0; g < 4; ++g) *(f32x4*)(o1p + 32 * d + 8 * g) = (f32x4){O[d][4 * g], O[d][4 * g + 1], O[d][4 * g + 2], O[d][4 * g + 3]};
            }
            Frame Fv = F; Fv.lane = fresh_lane();
            attn_core<128, false>(Fv, Z, Vtg, b, Z_QD + 128 * hd + 64, Z_KD + 128 * hd + 64, VT_D + 128 * hd, q0, lut + (8 + hd) * AT_LUT_LD, c1, nullptr, O);
            {
                const int l1 = fresh_lane();
                const int tq = q0 + 32 * F.wave + (l1 & 31), hh = l1 >> 5;
                const float* o1p = O1s + (size_t)(b * SEQ + tq) * 512 + 128 * hd + 4 * hh;
                float ss = 0.f;
#pragma unroll
                for (int d = 0; d < 4; ++d)
#pragma unroll
                    for (int g = 0; g < 4; ++g) {
                        const f32x4 o1 = *(const f32x4*)(o1p + 32 * d + 8 * g);
#pragma unroll
                        for (int e = 0; e < 4; ++e) { const float v = o1[e] - lam * O[d][4 * g + e]; O[d][4 * g + e] = v; ss += v * v; }
                    }
                ss += __shfl_xor(ss, 32);
                const float rinv = rsqrtf(ss * (1.0f / 128.0f) + EPS) * one_m_li;
                bf16_t* yp = Yo + (size_t)(b * SEQ + tq) * DM + 512 + 128 * hd + 4 * hh;
                const float* gp = a.diff_norm_g + 4 * hh;
#pragma unroll
                for (int d = 0; d < 4; ++d)
#pragma unroll
                    for (int g = 0; g < 4; ++g) {
                        const f32x4 gn = *(const f32x4*)(gp + 32 * d + 8 * g);
                        f32x4 v; v[0] = O[d][4 * g] * rinv * gn[0]; v[1] = O[d][4 * g + 1] * rinv * gn[1]; v[2] = O[d][4 * g + 2] * rinv * gn[2]; v[3] = O[d][4 * g + 3] * rinv * gn[3];
                        *(u32x2*)(yp + 32 * d + 8 * g) = pack4(v);
                    }
            }
        }
    }
    if (!DPART)
    for (int it = F.bid; it < 512; it += F.G) {
        const int rnd = it / F.G;
        const int bh = (F.G == 256) ? 4 * xcd + 2 * rnd + (kk >> 4) : it >> 4, pr = (F.G == 256) ? (kk & 15) : (it & 15);
        const int b_ = bh >> 3, hc_ = bh & 7;
        for (int half = 0; half < 2; ++half) {
            Frame Fu = F; Fu.lane = fresh_lane();
            int b = b_, hc = hc_; asm volatile("" : "+s"(b), "+s"(hc));
            const int q0 = 256 * (half ? 31 - pr : pr);
            f32x16 O[2];
            attn_core<64, true>(Fu, Z, Vtg, b, Z_QC + 64 * hc, Z_KC + 64 * hc, VT_C + 64 * hc, q0, lut + hc * AT_LUT_LD, c1, maskg, O);
            {
                const int l1 = fresh_lane();
                bf16_t* yp = Yo + (size_t)(b * SEQ + q0 + 32 * F.wave + (l1 & 31)) * DM + 64 * hc + 4 * (l1 >> 5);
#pragma unroll
                for (int d = 0; d < 2; ++d)
#pragma unroll
                    for (int g = 0; g < 4; ++g) {
                        f32x4 v = {O[d][4 * g], O[d][4 * g + 1], O[d][4 * g + 2], O[d][4 * g + 3]};
                        *(u32x2*)(yp + 32 * d + 8 * g) = pack4(v);
                    }
            }
        }
    }
}

#ifndef MK_ONE_LAUNCH
#define MK_ONE_LAUNCH 1
#endif
constexpr int NPH = 17;
__global__ void __launch_bounds__(NTHR, 2) fwd_kernel(Args a) {
    extern __shared__ __attribute__((aligned(16))) unsigned char lds_raw[];
    Frame F; F.lds = (LAS unsigned char*)lds_raw; F.tid = threadIdx.x; F.lane = F.tid & 63; F.wave = __builtin_amdgcn_readfirstlane(F.tid >> 6); F.G = gridDim.x; F.bid = blockIdx.x;
    unsigned* ctl = (unsigned*)(a.ws + WS_CTL);
    volatile LAS unsigned* xbw = (volatile LAS unsigned*)(F.lds + LDS_XB);
    if (F.tid < 4) xbw[F.tid] = 0u;
    __syncthreads();
    const int lo = a.ph_lo, hi = a.ph_hi;
    XcdBarrier bar; bar.bar = ctl + CW_BAR; bar.x = 0; bar.st = xbw;
    if (hi - lo > 1) bar = xcd_barrier_post(ctl + CW_BAR, xbw);
#ifndef PH_ONLY
#define IN(k) (lo <= (k) && (k) < hi)
#else
#define IN(k) ((k) == PH_ONLY && lo <= (k) && (k) < hi)
#endif
#ifndef DUP_PH
#define DUP_PH -1
#endif
#define REP(k) for (int rep_ = 0; rep_ < ((k) == DUP_PH ? 2 : 1); ++rep_)
#ifndef TIME_PH
#define TIME_PH -1
#endif
#define TIME_AMP 4
    unsigned long long tp0_ = 0, tp1_ = 0;
    if (TIME_PH == 0) tp0_ = wall_clock64();
#define SEAM(k) do { if (IN(k) && IN((k) + 1)) xcd_barrier(bar); if ((k) == TIME_PH) tp1_ = wall_clock64(); if ((k) + 1 == TIME_PH) tp0_ = wall_clock64(); } while (0)
    float* mod = (float*)(a.ws + WS_MOD);
    bf16_t* hbuf = (bf16_t*)(a.ws + WS_H);
    bf16_t* ybuf = (bf16_t*)(a.ws + WS_Y);
    LAS int* ntp = (LAS int*)(F.lds + LDS_MISC);

    if (IN(0)) REP(0) { p0_prologue(F, a); } SEAM(0);
    if (IN(1)) REP(1) { norm_phase<false, false, false>(F, a, a.x, 0, 0, 0); } SEAM(1);
    if (IN(2)) REP(2) {
        DenseSched S; S.init(NTOK, AB_N, DM, F.G, F.bid, a.ws + WS_WAB_IN);
        EpiAbIn E{(bf16_t*)(a.ws + WS_BIG)};
        pg8::gemm_phase(F.lds, (const char*)hbuf, DM, S, E);
    } SEAM(2);
    if (IN(3)) REP(3) { conv_phase(F, a); } SEAM(3);
    if (IN(4)) REP(4) {
        DenseSched S; S.init(NTOK, DM, DM, F.G, F.bid, a.ws + WS_WAB_OUT);
        EpiResid E{a.x, a.out, mod + 2 * DM};
        pg8::gemm_phase(F.lds, (const char*)ybuf, DM, S, E);
    } SEAM(4);
#define MOE_PHASES(layer, pb) do { \
        const unsigned* cnt = ctl + CW_CNT + (layer) * NEXP * CNT_STRIDE; \
        if (IN(pb)) { route_phase(F, a, (layer)); } SEAM(pb); \
        if (IN((pb) + 1)) REP((pb) + 1) { \
            moe_tile_table(F, cnt, ntp); \
            MoeSched<true> S; S.ntp = ntp; S.cnt = cnt; S.list = (const int*)(a.ws + WS_LIST); S.W = (const char*)(a.ws + WS_MOE_W); S.nU = 4 * ntp[NEXP]; S.G = F.G; S.c = F.bid; \
            EpiMoeUp E{(bf16_t*)(a.ws + WS_ACT)}; \
            pg8::gemm_phase(F.lds, (const char*)hbuf, DM, S, E); \
        } SEAM((pb) + 1); \
        if (IN((pb) + 2)) REP((pb) + 2) { \
            moe_tile_table(F, cnt, ntp); \
            MoeSched<false> S; S.ntp = ntp; S.cnt = cnt; S.list = nullptr; S.W = (const char*)(a.ws + WS_MOE_W); S.nU = 4 * ntp[NEXP]; S.G = F.G; S.c = F.bid; \
            EpiMoeDown E{(bf16_t*)(a.ws + WS_YMOE), (const float*)(a.ws + WS_GATEV), ntp}; \
            pg8::gemm_phase(F.lds, (const char*)(a.ws + WS_ACT), DEXP, S, E); \
        } SEAM((pb) + 2); } while (0)
    MOE_PHASES(0, 5);
    if (IN(8)) {
        norm_phase<true, false, false>(F, a, a.out, 1, 0, 0);
        cvt_run(F, a, 1, CVT_MOE_TILES);
    } SEAM(8);
    if (IN(9)) REP(9) {
        { DenseSched S; S.init(NTOK, CD_N, DM, F.G, F.bid, a.ws + WS_WCD_IN);
          EpiPlain E{(bf16_t*)(a.ws + WS_BIG), CD_N};
          pg8::gemm_phase(F.lds, (const char*)hbuf, DM, S, E); }
        __syncthreads();
        { DenseSched S; S.init(1024, NTOK, DM, F.G, F.bid, hbuf);
          EpiPlain E{(bf16_t*)(a.ws + WS_VT), NTOK};
          pg8::gemm_phase(F.lds, (const char*)(a.ws + WS_WCD_IN + (size_t)CD_N * DM * 2), DM, S, E); }
    } SEAM(9);
    if (IN(10)) REP(10) { unsigned long long tacc_ = 0; topk_phase(F, a, tacc_); if (TIME_PH > 100 && TIME_PH < 110) { tp0_ = 0; tp1_ = tacc_; } } SEAM(10);
    if (IN(11)) REP(11) { if (TIME_PH == 111) { __syncthreads(); tp0_ = wall_clock64(); } attn_phase<true>(F, a); __syncthreads(); if (TIME_PH == 111) tp1_ = wall_clock64(); if (TIME_PH == 112) tp0_ = wall_clock64(); attn_phase<false>(F, a); if (TIME_PH == 112) { __syncthreads(); tp1_ = wall_clock64(); } } SEAM(11);
    if (IN(12)) {
        DenseSched S; S.init(NTOK, DM, DM, F.G, F.bid, a.ws + WS_WCD_OUT);
        EpiResid E{a.out, a.out, mod + (size_t)NB * 6 * DM + 2 * DM};
        pg8::gemm_phase(F.lds, (const char*)ybuf, DM, S, E);
    } SEAM(12);
    MOE_PHASES(1, 13);
#undef MOE_PHASES
    if (IN(16)) { norm_phase<true, false, true>(F, a, a.out, 1, 0, 1); }
    if (TIME_PH >= 0) {
        if (TIME_PH == 16) { asm volatile("s_waitcnt vmcnt(0)" ::: "memory"); __syncthreads(); tp1_ = wall_clock64(); }
        if (F.bid == 0 && F.tid == 0) { const unsigned long long te = wall_clock64(), dt = (tp1_ - tp0_) * TIME_AMP; while (wall_clock64() - te < dt) __builtin_amdgcn_s_sleep(8); }
    }
#undef IN
#undef SEAM
}

extern "C" void kernel_launch(void* const* d_in, const int* in_sizes, int n_in, void* d_out, int out_size, void* d_ws, size_t ws_size, hipStream_t stream) {
    static int grid = 0;
    if (grid == 0) {
        if (n_in != 26 || out_size != NTOK * DM || ws_size < WS_END) { fprintf(stderr, "kernel_launch: unexpected problem (n_in %d, out %d, ws %zu < %zu)\n", n_in, out_size, ws_size, (size_t)WS_END); grid = -1; return; }
        int dev = 0, cus = 0, per_cu = 0;
        if (hipGetDevice(&dev) != hipSuccess || hipDeviceGetAttribute(&cus, hipDeviceAttributeMultiprocessorCount, dev) != hipSuccess) { grid = -1; return; }
        if (hipFuncSetAttribute((const void*)fwd_kernel, hipFuncAttributeMaxDynamicSharedMemorySize, LDS_BYTES) != hipSuccess) { fprintf(stderr, "kernel_launch: hipFuncSetAttribute failed\n"); grid = -1; return; }
        if (hipOccupancyMaxActiveBlocksPerMultiprocessor(&per_cu, (const void*)fwd_kernel, NTHR, LDS_BYTES) != hipSuccess || per_cu < 1) { fprintf(stderr, "kernel_launch: occupancy query says %d\n", per_cu); }
        (void)hipGetLastError();
        grid = cus;
    }
    if (grid < 0) return;
    (void)hipMemsetAsync((char*)d_ws + WS_CTL, 0, CTL_BYTES, stream);
    Args a{};
    const float** fp = (const float**)&a.x;
    (void)fp;
    a.x = (const float*)d_in[0]; a.c = (const float*)d_in[1]; a.positions = (const int*)d_in[2]; a.rel_bias = (const float*)d_in[3]; a.norm_g = (const float*)d_in[4];
    a.final_norm_g = (const float*)d_in[5]; a.ada_w = (const float*)d_in[6]; a.ada_b = (const float*)d_in[7]; a.ab_w_in = (const float*)d_in[8]; a.ab_conv_a = (const float*)d_in[9];
    a.ab_conv_b = (const float*)d_in[10]; a.ab_conv_b_bias = (const float*)d_in[11]; a.ab_ln_g = (const float*)d_in[12]; a.ab_ln_b = (const float*)d_in[13]; a.ab_w_out = (const float*)d_in[14];
    a.cd_w_in = (const float*)d_in[15]; a.diff_lam = (const float*)d_in[16]; a.diff_norm_g = (const float*)d_in[17]; a.cd_w_out = (const float*)d_in[18];
    a.moe_wr_g = (const float*)d_in[19]; a.moe_br_g = (const float*)d_in[20]; a.moe_wr_e = (const float*)d_in[21]; a.moe_br_e = (const float*)d_in[22];
    a.moe_w_gate = (const float*)d_in[23]; a.moe_w_up = (const float*)d_in[24]; a.moe_w_down = (const float*)d_in[25];
    a.out = (float*)d_out; a.ws = (unsigned char*)d_ws;
#if MK_ONE_LAUNCH
    a.ph_lo = 0; a.ph_hi = NPH;
    hipLaunchKernelGGL(fwd_kernel, dim3(grid), dim3(NTHR), LDS_BYTES, stream, a);
#else
    for (int p = 0; p < NPH; ++p) { a.ph_lo = p; a.ph_hi = p + 1; hipLaunchKernelGGL(fwd_kernel, dim3(grid), dim3(NTHR), LDS_BYTES, stream, a); }
#endif
}
```

```cpp
#include <hip/hip_runtime.h>
#include <cstdio>
#include <cstdint>

#ifndef TIME_PH
#define TIME_PH -1
#endif
#define LAS __attribute__((address_space(3)))
#define DI __device__ __forceinline__
typedef unsigned short bf16_t;
typedef short bf16x8 __attribute__((ext_vector_type(8)));
typedef short s16x4 __attribute__((ext_vector_type(4)));
typedef float f32x2 __attribute__((ext_vector_type(2)));
typedef float f32x4 __attribute__((ext_vector_type(4)));
typedef float f32x16 __attribute__((ext_vector_type(16)));
typedef unsigned u32x2 __attribute__((ext_vector_type(2)));
typedef unsigned u32x4 __attribute__((ext_vector_type(4)));
typedef __bf16 bf16v2 __attribute__((ext_vector_type(2)));

constexpr int NB = 4, SEQ = 8192, DM = 1024, NTOK = NB * SEQ;
constexpr int NTHR = 512, NWAVE = 8;
constexpr int AB_N = 2560;
constexpr int ZC_N = 1536;
constexpr int CD_SRC_N = 3368;
constexpr int CD_N = 2560;
constexpr int Z_QC = 0, Z_KC = 512, Z_QD = 1024, Z_KD = 1536, Z_QI = 2048, Z_KI = 2304, Z_WI = 2336;
constexpr int VT_C = 0, VT_D = 512;
constexpr int NEXP = 32, DEXP = 512;
constexpr int MOE_ROWS = 2 * NTOK + NEXP * 256;
constexpr float EPS = 1e-6f;
constexpr float LOG2E = 1.4426950408889634f;

constexpr size_t MiB = 1u << 20;
constexpr size_t WS_CTL = 0, CTL_BYTES = 64 * 1024;
constexpr size_t WS_MOD = 1 * MiB;
constexpr size_t WS_WAB_IN = 2 * MiB;
constexpr size_t WS_WAB_OUT = 7 * MiB;
constexpr size_t WS_WCD_IN = 9 * MiB;
constexpr size_t WS_WCD_OUT = 16 * MiB;
constexpr size_t WS_MOE_W = 18 * MiB;
constexpr size_t WS_H = 114 * MiB;
constexpr size_t WS_Y = 178 * MiB;
constexpr size_t WS_BIG = 242 * MiB;
constexpr size_t WS_ACT = WS_BIG;
constexpr size_t WS_YMOE = WS_BIG + 72 * MiB;
constexpr size_t WS_VT = WS_BIG + 160 * MiB;
constexpr size_t WS_MASK = 466 * MiB;
constexpr size_t WS_LIST = 498 * MiB;
constexpr size_t WS_GATEV = 502 * MiB;
constexpr size_t WS_TOKSLOT = 506 * MiB;
constexpr size_t WS_END = 507 * MiB;

constexpr int CW_BAR = 0;
constexpr int CW_CNT = 4096;
constexpr int CNT_STRIDE = 64;

DI unsigned pack_bf16(float lo, float hi) { f32x2 v = {lo, hi}; bf16v2 b = __builtin_convertvector(v, bf16v2); return __builtin_bit_cast(unsigned, b); }
DI float bf_lo(unsigned w) { return __uint_as_float(w << 16); }
DI float bf_hi(unsigned w) { return __uint_as_float(w & 0xffff0000u); }
DI float bf2f(bf16_t b) { return __uint_as_float(((unsigned)b) << 16); }
DI float wave_sum(float v) {
#pragma unroll
    for (int o = 32; o >= 1; o >>= 1) v += __shfl_xor(v, o);
    return v;
}
DI int fresh_lane() { int l; asm volatile("v_mbcnt_lo_u32_b32 %0, -1, 0\n\tv_mbcnt_hi_u32_b32 %0, -1, %0" : "=v"(l)); return l; }
DI float silu_f(float v) { return v / (1.0f + __expf(-v)); }
DI float sigmoid_f(float v) { return 1.0f / (1.0f + __expf(-v)); }

#define XB_TMO      128
#define XB_XCNT(j)  (256  + 64 * (j))
#define XB_XSUB(j)  (1280 + 64 * (j))
#define XB_XGEN(j)  (2304 + 64 * (j))
#define XB_TOP      3328
#define XB_TOPGEN   3392
#define XCD_BAR_WORDS 3456
#define XB_SPIN_CAP (1u << 22)
DI unsigned xb_ld(unsigned* p)              { return __hip_atomic_load(p, __ATOMIC_RELAXED, __HIP_MEMORY_SCOPE_AGENT); }
DI unsigned xb_add(unsigned* p, unsigned v) { return __hip_atomic_fetch_add(p, v, __ATOMIC_RELAXED, __HIP_MEMORY_SCOPE_AGENT); }
DI unsigned xb_xcc_id() { return (unsigned)__builtin_amdgcn_s_getreg((3 << 11) | 20) & 0xFu; }
#define XB_SPIN(cond, bar) do { unsigned _sp = 0; while (cond) { __builtin_amdgcn_s_sleep(1); \
    if ((++_sp & 255u) == 0u) { if (xb_ld(&(bar)[XB_TMO])) break; if (_sp > XB_SPIN_CAP) { atomicAdd(&(bar)[XB_TMO], 1u); break; } } } } while (0)
struct XcdBarrier { unsigned* bar; unsigned x; volatile LAS unsigned* st; };
DI XcdBarrier xcd_barrier_post(unsigned* bar, volatile LAS unsigned* st) {
    XcdBarrier b; b.bar = bar; b.x = xb_xcc_id(); b.st = st;
    if (threadIdx.x == 0) (void)xb_add(&bar[XB_XCNT(b.x)], 1u);
    return b;
}
DI void xcd_barrier_complete(unsigned* bar, unsigned x, unsigned& nloc, unsigned& nx) {
    const unsigned G = gridDim.x * gridDim.y * gridDim.z;
    unsigned sum, cnt, mine, sp = 0u;
    for (;;) {
        sum = 0u; cnt = 0u; mine = 0u;
#pragma unroll
        for (unsigned j = 0; j < 16; ++j) { const unsigned c = xb_ld(&bar[XB_XCNT(j)]); sum += c; cnt += (c > 0u) ? 1u : 0u; mine = (j == x) ? c : mine; }
        if (sum == G) break;
        __builtin_amdgcn_s_sleep(1);
        if ((++sp & 255u) == 0u) { if (xb_ld(&bar[XB_TMO])) break; if (sp > XB_SPIN_CAP) { atomicAdd(&bar[XB_TMO], 1u); break; } }
    }
    nloc = mine > 0u ? mine : 1u; nx = cnt > 0u ? cnt : 1u;
}
DI void xcd_barrier(const XcdBarrier& b) {
    asm volatile("s_waitcnt vmcnt(0)" ::: "memory");
    __syncthreads();
    if (threadIdx.x == 0) {
        unsigned* bar = b.bar;
        __builtin_amdgcn_s_waitcnt(0);
        unsigned nloc = b.st[0], nx = b.st[1];
        if (nloc == 0u) { xcd_barrier_complete(bar, b.x, nloc, nx); b.st[0] = nloc; b.st[1] = nx; }
        const unsigned old = xb_add(&bar[XB_XSUB(b.x)], 1u);
        const unsigned gen = old / nloc;
        if (old + 1u == (gen + 1u) * nloc) {
            __builtin_amdgcn_fence(__ATOMIC_RELEASE, "agent");
            asm volatile("s_waitcnt vmcnt(0)" ::: "memory");
            const unsigned og = xb_add(&bar[XB_TOP], 1u);
            const unsigned tg = og / nx;
            if (og + 1u == (tg + 1u) * nx) xb_add(&bar[XB_TOPGEN], 1u);
            else XB_SPIN(xb_ld(&bar[XB_TOPGEN]) == tg, bar);
            __builtin_amdgcn_fence(__ATOMIC_ACQUIRE, "agent");
            xb_add(&bar[XB_XGEN(b.x)], 1u);
            asm volatile("s_waitcnt vmcnt(0)" ::: "memory");
        } else {
            XB_SPIN(xb_ld(&bar[XB_XGEN(b.x)]) == gen, bar);
            __builtin_amdgcn_fence(__ATOMIC_ACQUIRE, "agent");
            asm volatile("s_waitcnt vmcnt(0)" ::: "memory");
        }
    }
    __syncthreads();
}

namespace pg8 {
constexpr int BM = 256, BK = 64, HALF = 128, HTB = HALF * BK * 2, STAGE_BYTES = 8 * HTB;
DI int lds_byte(int r, int c) { const int st = (r >> 4) * 2 + (c >> 5), rr = r & 15, cc = c & 31, ob = rr * 64 + cc * 2; return st * 1024 + (ob ^ (((ob >> 9) & 1) << 5)); }
DI void stage_rc(int b, int& R, int& C) { const int st = b / 1024, sb = b % 1024, swz = sb ^ (((sb >> 9) & 1) << 5); R = (st >> 1) * 16 + swz / 64; C = (st & 1) * 32 + (swz % 64) / 2; }
struct Unit { int pm, pn, e, nrow; };

template <class Epi, class Sched>
DI void gemm_phase(LAS unsigned char* lds, const char* Abase, const int K, const Sched& S, const Epi& E) {
    const int tid = threadIdx.x, wid = __builtin_amdgcn_readfirstlane(tid >> 6), lane = tid & 63, wr = wid >> 2, wc = wid & 3, fr = lane & 15, fq = lane >> 4;
    const int nt = K / BK;
    int Rr[2], Cc[2]; unsigned voffB[2];
#pragma unroll
    for (int i = 0; i < 2; ++i) { int R, C; stage_rc(tid * 16 + i * 8192, R, C); Rr[i] = R; Cc[i] = C; voffB[i] = (unsigned)(R * K + C) * 2u; }
    const size_t kstep = (size_t)(BK * 2);
    const size_t hstep = (size_t)HALF * K * 2;
    const unsigned ldsw = (unsigned)wid * 1024u;
    const int aoff = lds_byte(wr * 64 + fr, fq * 8), boff = lds_byte(wc * 32 + fr, fq * 8);
#define PG8_SA(b, h) (((b) * 2 + (h)) * HTB)
#define PG8_SB(b, h) ((4 + (b) * 2 + (h)) * HTB)
#define PG8_STAGE(bufoff, gbase, voff) do { _Pragma("unroll") for (int _i = 0; _i < 2; ++_i) \
        __builtin_amdgcn_global_load_lds((const unsigned*)((const char*)(gbase) + (voff)[_i]), (LAS unsigned*)(lds + (bufoff) + ldsw + _i * 8192), 16, 0, 0); } while (0)
#define PG8_AOFF(dst, u) do { _Pragma("unroll") for (int _h = 0; _h < 2; ++_h) _Pragma("unroll") for (int _i = 0; _i < 2; ++_i) \
        dst[_h][_i] = ((unsigned)S.a_row(u, _h * HALF + Rr[_i]) * (unsigned)K + (unsigned)Cc[_i]) * 2u; } while (0)
#define PG8_LDA(dst, b, h) do { _Pragma("unroll") for (int m = 0; m < 4; ++m) _Pragma("unroll") for (int k = 0; k < 2; ++k) dst[m][k] = *(const LAS bf16x8*)(lds + PG8_SA(b, h) + aoff + m * 2048 + k * 1024); } while (0)
#define PG8_LDB(dst, b, h) do { _Pragma("unroll") for (int n = 0; n < 2; ++n) _Pragma("unroll") for (int k = 0; k < 2; ++k) dst[n][k] = *(const LAS bf16x8*)(lds + PG8_SB(b, h) + boff + n * 2048 + k * 1024); } while (0)
#define PG8_MMA(ai, bj, At, Bt) do { __builtin_amdgcn_s_setprio(1); _Pragma("unroll") for (int m = 0; m < 4; ++m) _Pragma("unroll") for (int n = 0; n < 2; ++n) _Pragma("unroll") for (int k = 0; k < 2; ++k) \
        acc[ai][bj][m][n] = __builtin_amdgcn_mfma_f32_16x16x32_bf16(Bt[n][k], At[m][k], acc[ai][bj][m][n], 0, 0, 0); __builtin_amdgcn_s_setprio(0); } while (0)
#define PG8_WAIT_V(n) asm volatile("s_waitcnt vmcnt(" #n ")" ::: "memory")
#define PG8_WAIT_L(n) asm volatile("s_waitcnt lgkmcnt(" #n ")" ::: "memory")
#define PG8_BAR __builtin_amdgcn_s_barrier()
#define PG8_SCHED __builtin_amdgcn_sched_barrier(0)
    Unit cur, nxt; int ui = 0;
    if (!S.next(0, cur)) return;
    f32x4 acc[2][2][4][2];
#pragma unroll
    for (int a = 0; a < 2; ++a)
#pragma unroll
        for (int b = 0; b < 2; ++b)
#pragma unroll
            for (int m = 0; m < 4; ++m)
#pragma unroll
                for (int n = 0; n < 2; ++n) acc[a][b][m][n] = (f32x4){0.f, 0.f, 0.f, 0.f};
    bf16x8 At[4][2], B0[2][2], B1[2][2];
    unsigned aoC[2][2], aoN[2][2];
    PG8_AOFF(aoC, cur);
    const char* cB = S.b_base(cur);
    PG8_STAGE(PG8_SB(0, 0), cB, voffB); PG8_STAGE(PG8_SA(0, 0), Abase, aoC[0]); PG8_STAGE(PG8_SB(0, 1), cB + hstep, voffB); PG8_STAGE(PG8_SA(0, 1), Abase, aoC[1]);
    if (wr == 1) PG8_BAR;
    PG8_WAIT_V(4); PG8_BAR;
    PG8_STAGE(PG8_SB(1, 0), cB + kstep, voffB); PG8_STAGE(PG8_SA(1, 0), Abase + kstep, aoC[0]); PG8_STAGE(PG8_SB(1, 1), cB + hstep + kstep, voffB);
    PG8_WAIT_V(6); PG8_BAR;
    for (;;) {
        const bool has_next = S.next(ui + 1, nxt);
        const char* nB = cB;
#pragma unroll
        for (int _h = 0; _h < 2; ++_h)
#pragma unroll
            for (int _i = 0; _i < 2; ++_i) aoN[_h][_i] = aoC[_h][_i];
        if (has_next) { PG8_AOFF(aoN, nxt); nB = S.b_base(nxt); }
        for (int t = 0; t < nt; t += 2) {
            const bool last = (t == nt - 2);
            const char* a1 = Abase + (size_t)(t + 1) * kstep;
            const char* a2 = last ? Abase : Abase + (size_t)(t + 2) * kstep; const char* b2 = last ? nB : cB + (size_t)(t + 2) * kstep;
            const char* a3 = a2 + kstep; const char* b3 = b2 + kstep;
            unsigned ao2[2][2];
#pragma unroll
            for (int _h = 0; _h < 2; ++_h)
#pragma unroll
                for (int _i = 0; _i < 2; ++_i) ao2[_h][_i] = last ? aoN[_h][_i] : aoC[_h][_i];
            PG8_LDB(B0, 0, 0); PG8_SCHED; PG8_LDA(At, 0, 0); PG8_STAGE(PG8_SA(1, 1), a1, aoC[1]);
            PG8_WAIT_L(8); PG8_BAR; PG8_WAIT_L(0); PG8_MMA(0, 0, At, B0); PG8_BAR; PG8_SCHED;
            PG8_LDB(B1, 0, 1); PG8_STAGE(PG8_SB(0, 0), b2, voffB);
            PG8_BAR; PG8_WAIT_L(0); PG8_MMA(0, 1, At, B1); PG8_BAR;
            PG8_LDA(At, 0, 1); PG8_STAGE(PG8_SA(0, 0), a2, ao2[0]);
            PG8_BAR; PG8_WAIT_L(0); PG8_MMA(1, 0, At, B0); PG8_BAR; PG8_SCHED;
            PG8_STAGE(PG8_SB(0, 1), b2 + hstep, voffB);
            PG8_WAIT_V(6); PG8_BAR; PG8_MMA(1, 1, At, B1); PG8_BAR;
            PG8_LDB(B0, 1, 0); PG8_SCHED; PG8_LDA(At, 1, 0); PG8_STAGE(PG8_SA(0, 1), a2, ao2[1]);
            PG8_WAIT_L(8); PG8_BAR; PG8_WAIT_L(0); PG8_MMA(0, 0, At, B0); PG8_BAR; PG8_SCHED;
            PG8_LDB(B1, 1, 1); PG8_STAGE(PG8_SB(1, 0), b3, voffB);
            PG8_BAR; PG8_WAIT_L(0); PG8_MMA(0, 1, At, B1); PG8_BAR;
            PG8_LDA(At, 1, 1); PG8_STAGE(PG8_SA(1, 0), a3, ao2[0]);
            PG8_BAR; PG8_WAIT_L(0); PG8_MMA(1, 0, At, B0); PG8_BAR; PG8_SCHED;
            PG8_STAGE(PG8_SB(1, 1), b3 + hstep, voffB);
            PG8_WAIT_V(6); PG8_BAR; PG8_MMA(1, 1, At, B1); PG8_BAR;
        }
        E(acc, cur, wr, wc, fr, fq);
        if (!has_next) break;
#pragma unroll
        for (int a = 0; a < 2; ++a)
#pragma unroll
            for (int b = 0; b < 2; ++b)
#pragma unroll
                for (int m = 0; m < 4; ++m)
#pragma unroll
                    for (int n = 0; n < 2; ++n) acc[a][b][m][n] = (f32x4){0.f, 0.f, 0.f, 0.f};
        cur = nxt; cB = nB; ++ui;
#pragma unroll
        for (int _h = 0; _h < 2; ++_h)
#pragma unroll
            for (int _i = 0; _i < 2; ++_i) aoC[_h][_i] = aoN[_h][_i];
    }
    PG8_WAIT_V(0);
    if (wr == 0) PG8_BAR;
    PG8_BAR;
#undef PG8_SA
#undef PG8_SB
#undef PG8_STAGE
#undef PG8_AOFF
#undef PG8_LDA
#undef PG8_LDB
#undef PG8_MMA
#undef PG8_WAIT_V
#undef PG8_WAIT_L
#undef PG8_BAR
#undef PG8_SCHED
}
}

struct Args {
    const float* x; const float* c; const int* positions; const float* rel_bias; const float* norm_g; const float* final_norm_g;
    const float* ada_w; const float* ada_b; const float* ab_w_in; const float* ab_conv_a; const float* ab_conv_b; const float* ab_conv_b_bias;
    const float* ab_ln_g; const float* ab_ln_b; const float* ab_w_out; const float* cd_w_in; const float* diff_lam; const float* diff_norm_g;
    const float* cd_w_out; const float* moe_wr_g; const float* moe_br_g; const float* moe_wr_e; const float* moe_br_e;
    const float* moe_w_gate; const float* moe_w_up; const float* moe_w_down;
    float* out; unsigned char* ws; int ph_lo, ph_hi;
};
struct Frame {
    LAS unsigned char* lds; int tid, lane, wave, G, bid;
};

struct RowSrc { const float* p; int ld; };
DI void ilv(int rp, int& j, int& second) { const int g = rp >> 5, i = rp & 31; j = 16 * g + (i & 15); second = i >> 4; }

enum { CV_AB_IN = 0, CV_AB_OUT = 1, CV_CD_IN = 2, CV_CD_OUT = 3, CV_MOE_GU = 4, CV_MOE_D = 5 };
template <int KIND> DI RowSrc row_src(const Args& a, int layer, int e, int r) {
    RowSrc s; s.p = nullptr; s.ld = 0;
    if (KIND == CV_AB_IN) {
        s.ld = AB_N;
        if (r < 512) s.p = a.ab_w_in + r;
        else if (r < 1536) { int j, sec; ilv(r - 512, j, sec); s.p = a.ab_w_in + (sec ? 1024 + j : 512 + j); }
        else { int j, sec; ilv(r - 1536, j, sec); s.p = a.ab_w_in + (sec ? 2048 + j : 1536 + j); }
    } else if (KIND == CV_AB_OUT) { s.ld = DM; s.p = a.ab_w_out + r; }
    else if (KIND == CV_CD_IN) {
        s.ld = CD_SRC_N;
        int col = -1;
        if (r < 1024) col = r;
        else if (r < 2048) col = 1832 + (r - 1024);
        else if (r < 2304) col = 1536 + (r - 2048);
        else if (r < 2336) col = 1792 + (r - 2304);
        else if (r < 2344) col = 1824 + (r - 2336);
        else if (r < 2560) col = -1;
        else if (r < 3072) col = 1024 + (r - 2560);
        else col = 2856 + (r - 3072);
        if (col >= 0) s.p = a.cd_w_in + col;
    } else if (KIND == CV_CD_OUT) { s.ld = DM; s.p = a.cd_w_out + r; }
    else if (KIND == CV_MOE_GU) {
        int j, sec; ilv(r, j, sec); s.ld = DEXP;
        const size_t base = ((size_t)layer * NEXP + e) * (size_t)DM * DEXP;
        s.p = (sec ? a.moe_w_up : a.moe_w_gate) + base + j;
    } else {
        s.ld = DM; s.p = a.moe_w_down + ((size_t)layer * NEXP + e) * (size_t)DEXP * DM + r;
    }
    return s;
}
constexpr int CV_LD = 258;
struct CvtTile { const float* sp; int ld; bf16_t* dst; int K, r0, k0; };
template <int KIND> DI CvtTile cvt_desc(const Frame& F, const Args& a, bf16_t* dst, int K, int r0, int k0, int layer, int e) {
    const RowSrc s = row_src<KIND>(a, layer, e, r0 + 4 * (F.tid & 15));
    CvtTile t; t.sp = s.p; t.ld = s.ld; t.dst = dst; t.K = K; t.r0 = r0; t.k0 = k0; return t;
}
constexpr int CVT_DENSE_TILES = (AB_N + DM + CD_N + 1024 + DM) / 64 * (DM / 256);
constexpr int CVT_MOE_TILES_PER_EXP = (1024 / 64) * (1024 / 256) + (1024 / 64) * (512 / 256);
constexpr int CVT_MOE_TILES = NEXP * CVT_MOE_TILES_PER_EXP;
DI CvtTile cvt_dense_desc(const Frame& F, const Args& a, int item) {
    const int rt = item >> 2, kt = item & 3;
    int r = rt * 64;
    if (r < AB_N) return cvt_desc<CV_AB_IN>(F, a, (bf16_t*)(a.ws + WS_WAB_IN), DM, r, kt * 256, 0, 0);
    r -= AB_N;
    if (r < DM) return cvt_desc<CV_AB_OUT>(F, a, (bf16_t*)(a.ws + WS_WAB_OUT), DM, r, kt * 256, 0, 0);
    r -= DM;
    if (r < CD_N + 1024) return cvt_desc<CV_CD_IN>(F, a, (bf16_t*)(a.ws + WS_WCD_IN), DM, r, kt * 256, 0, 0);
    r -= CD_N + 1024;
    return cvt_desc<CV_CD_OUT>(F, a, (bf16_t*)(a.ws + WS_WCD_OUT), DM, r, kt * 256, 0, 0);
}
DI CvtTile cvt_moe_desc(const Frame& F, const Args& a, int layer, int item) {
    const int e = item / CVT_MOE_TILES_PER_EXP, t = item % CVT_MOE_TILES_PER_EXP;
    bf16_t* base = (bf16_t*)(a.ws + WS_MOE_W + (size_t)e * 3 * MiB);
    if (t < 64) return cvt_desc<CV_MOE_GU>(F, a, base, DM, (t >> 2) * 64, (t & 3) * 256, layer, e);
    const int t2 = t - 64; return cvt_desc<CV_MOE_D>(F, a, base + (size_t)DM * DM, DEXP, (t2 >> 1) * 64, (t2 & 1) * 256, layer, e);
}
DI void cvt_load(const Frame& F, const CvtTile& t, f32x4 (&v)[8]) {
#pragma unroll
    for (int it = 0; it < 8; ++it) {
        const int kk = (F.tid >> 4) + 32 * it;
        v[it] = (f32x4){0.f, 0.f, 0.f, 0.f};
        if (t.sp) v[it] = *(const f32x4*)(t.sp + (size_t)(t.k0 + kk) * t.ld);
    }
}
DI void cvt_store(const Frame& F, const CvtTile& t, const f32x4 (&v)[8]) {
    LAS bf16_t* T = (LAS bf16_t*)F.lds;
    const int c4 = F.tid & 15;
#pragma unroll
    for (int it = 0; it < 8; ++it) {
        const int kk = (F.tid >> 4) + 32 * it;
        const unsigned p01 = pack_bf16(v[it][0], v[it][1]), p23 = pack_bf16(v[it][2], v[it][3]);
        T[(4 * c4 + 0) * CV_LD + kk] = (bf16_t)(p01 & 0xffffu); T[(4 * c4 + 1) * CV_LD + kk] = (bf16_t)(p01 >> 16);
        T[(4 * c4 + 2) * CV_LD + kk] = (bf16_t)(p23 & 0xffffu); T[(4 * c4 + 3) * CV_LD + kk] = (bf16_t)(p23 >> 16);
    }
    __syncthreads();
    {
        const int rr = F.tid >> 3, c = F.tid & 7;
#pragma unroll
        for (int j = 0; j < 4; ++j) {
            const LAS unsigned* src = (const LAS unsigned*)(T + rr * CV_LD + 64 * j + c * 8);
            u32x4 w; w[0] = src[0]; w[1] = src[1]; w[2] = src[2]; w[3] = src[3];
            *(u32x4*)(t.dst + (size_t)(t.r0 + rr) * t.K + t.k0 + 64 * j + c * 8) = w;
        }
    }
    __syncthreads();
}
DI CvtTile cvt_any_desc(const Frame& F, const Args& a, int which, int item) {
    if (which == 0) { if (item < CVT_DENSE_TILES) return cvt_dense_desc(F, a, item); return cvt_moe_desc(F, a, 0, item - CVT_DENSE_TILES); }
    return cvt_moe_desc(F, a, 1, item);
}
DI void cvt_run(const Frame& F, const Args& a, int which, int n_items) {
    int it = F.bid;
    if (it >= n_items) return;
    CvtTile cur = cvt_any_desc(F, a, which, it);
    f32x4 v[8]; cvt_load(F, cur, v);
    for (;;) {
        const int nx = it + F.G; const bool has = nx < n_items;
        CvtTile nxt = cur; f32x4 vn[8];
        if (has) { nxt = cvt_any_desc(F, a, which, nx); cvt_load(F, nxt, vn); }
        cvt_store(F, cur, v);
        if (!has) break;
        cur = nxt; it = nx;
#pragma unroll
        for (int i = 0; i < 8; ++i) v[i] = vn[i];
    }
}
DI void mod_item(const Frame& F, const Args& a, int item) {
    LAS float* sc = (LAS float*)F.lds;
    LAS float* part = (LAS float*)(F.lds + 16384);
    for (int i = F.tid; i < NB * DM; i += NTHR) sc[i] = silu_f(a.c[i]);
    __syncthreads();
    const int l = item / 96, j = (item % 96) * 64 + F.lane;
    const float* w = a.ada_w + (size_t)l * DM * 6 * DM + (size_t)(F.wave * 128) * 6 * DM + j;
    float acc[NB] = {0.f, 0.f, 0.f, 0.f};
#pragma unroll 8
    for (int k = 0; k < 128; ++k) {
        const float wv = w[(size_t)k * 6 * DM];
#pragma unroll
        for (int b = 0; b < NB; ++b) acc[b] += sc[b * DM + F.wave * 128 + k] * wv;
    }
#pragma unroll
    for (int b = 0; b < NB; ++b) part[(F.wave * NB + b) * 64 + F.lane] = acc[b];
    __syncthreads();
    if (F.tid < NB * 64) {
        const int b = F.tid >> 6, c = F.tid & 63;
        float sum = 0.f;
#pragma unroll
        for (int wv = 0; wv < NWAVE; ++wv) sum += part[(wv * NB + b) * 64 + c];
        const int jj = (item % 96) * 64 + c;
        float* mod = (float*)(a.ws + WS_MOD);
        mod[((size_t)l * NB + b) * 6 * DM + jj] = sum + a.ada_b[l * 6 * DM + jj];
    }
    __syncthreads();
}
DI void p0_prologue(const Frame& F, const Args& a) {
    for (int it = F.bid; it < 192; it += F.G) mod_item(F, a, it);
    cvt_run(F, a, 0, CVT_DENSE_TILES + CVT_MOE_TILES);
}

constexpr int WR_LD = 1028;
DI void moe_seg_table(const Frame& F, const unsigned* cnt, LAS int* seg  ) {
    if (F.tid == 0) { int s = 0; for (int e = 0; e < NEXP; ++e) { seg[e] = s; s += (((int)cnt[e * CNT_STRIDE] + 255) >> 8) << 8; } seg[NEXP] = s; }
    __syncthreads();
}
template <bool COMBINE, bool ROUTE, bool FINAL>
DI void norm_phase(const Frame& F, const Args& a, const float* xsrc, int layer, int which, int layer_c) {
    const float* mod = (const float*)(a.ws + WS_MOD);
    bf16_t* hbuf = (bf16_t*)(a.ws + WS_H);
    unsigned* ctl = (unsigned*)(a.ws + WS_CTL);
    LAS float* wrT = (LAS float*)F.lds;
    LAS float* brs = (LAS float*)(F.lds + 36 * WR_LD * 4);
    LAS int* seg = (LAS int*)F.lds;
    constexpr int RT_CAP = 512;
    LAS int* rcnt = (LAS int*)(F.lds + 149504);
    LAS int* rbase = (LAS int*)(F.lds + 149632);
    LAS int* rt_er = (LAS int*)(F.lds + 149760);
    LAS float* rt_gate = (LAS float*)(F.lds + 149760 + 4096);
    LAS int* rt_tok = (LAS int*)(F.lds + 149760 + 8192);
    if (ROUTE) {
        const float* wg = a.moe_wr_g + (size_t)layer * DM * 4;
        const float* we = a.moe_wr_e + (size_t)layer * DM * 32;
        for (int i = F.tid; i < DM * 4; i += NTHR) { const int k = i >> 2, j = i & 3; wrT[j * WR_LD + k] = wg[i]; }
        for (int i = F.tid; i < DM * 32; i += NTHR) { const int k = i >> 5, j = i & 31; wrT[(4 + j) * WR_LD + k] = we[i]; }
        if (F.tid < NEXP) rcnt[F.tid] = 0;
        for (int i = F.tid; i < 2 * RT_CAP; i += NTHR) rt_er[i] = -1;
        if (F.tid < 4) brs[F.tid] = a.moe_br_g[layer * 4 + F.tid];
        else if (F.tid < 36) brs[F.tid] = a.moe_br_e[layer * 32 + F.tid - 4];
        __syncthreads();
    }
    if (COMBINE) moe_seg_table(F, ctl + CW_CNT + layer_c * NEXP * CNT_STRIDE, seg);
    const bf16_t* ymoe = (const bf16_t*)(a.ws + WS_YMOE);
    const int* tokslot = (const int*)(a.ws + WS_TOKSLOT);
    constexpr int TPW = ROUTE ? 2 : 4;
    for (int tb = (F.bid * NWAVE + F.wave) * TPW; tb < NTOK; tb += F.G * NWAVE * TPW) {
      const int b = tb / SEQ;
      f32x4 xall[TPW][4];
#pragma unroll
      for (int i = 0; i < TPW; ++i)
#pragma unroll
        for (int c = 0; c < 4; ++c) xall[i][c] = *(const f32x4*)(xsrc + (size_t)(tb + i) * DM + c * 256 + F.lane * 4);
      if (COMBINE) {
        int ts[TPW][2];
#pragma unroll
        for (int i = 0; i < TPW; ++i) { ts[i][0] = tokslot[(tb + i) * 2]; ts[i][1] = tokslot[(tb + i) * 2 + 1]; }
        u32x2 yv[TPW][2][4];
#pragma unroll
        for (int i = 0; i < TPW; ++i)
#pragma unroll
          for (int k = 0; k < 2; ++k) {
            const size_t r = (size_t)(seg[ts[i][k] >> 20] + (ts[i][k] & 0xfffff));
#pragma unroll
            for (int c = 0; c < 4; ++c) yv[i][k][c] = *(const u32x2*)(ymoe + r * DM + c * 256 + F.lane * 4);
          }
        const float* g2 = mod + ((size_t)layer_c * NB + b) * 6 * DM + 5 * DM;
#pragma unroll
        for (int c = 0; c < 4; ++c) {
          const int col = c * 256 + F.lane * 4;
          const f32x4 gv = *(const f32x4*)(g2 + col);
#pragma unroll
          for (int i = 0; i < TPW; ++i) {
            const u32x2 y0 = yv[i][0][c], y1 = yv[i][1][c];
            xall[i][c][0] += gv[0] * (bf_lo(y0[0]) + bf_lo(y1[0])); xall[i][c][1] += gv[1] * (bf_hi(y0[0]) + bf_hi(y1[0]));
            xall[i][c][2] += gv[2] * (bf_lo(y0[1]) + bf_lo(y1[1])); xall[i][c][3] += gv[3] * (bf_hi(y0[1]) + bf_hi(y1[1]));
            if (!FINAL) *(f32x4*)(a.out + (size_t)(tb + i) * DM + col) = xall[i][c];
          }
        }
      }
#pragma unroll
      for (int ti = 0; ti < TPW; ++ti) {
        const int tok = tb + ti;
        f32x4 xv[4];
#pragma unroll
        for (int c = 0; c < 4; ++c) xv[c] = xall[ti][c];
        float ss = 0.f;
#pragma unroll
        for (int c = 0; c < 4; ++c) ss += xv[c][0] * xv[c][0] + xv[c][1] * xv[c][1] + xv[c][2] * xv[c][2] + xv[c][3] * xv[c][3];
        ss = wave_sum(ss);
        const float rinv = rsqrtf(ss * (1.0f / DM) + EPS);
        if (FINAL) {
#pragma unroll
            for (int c = 0; c < 4; ++c) {
                const int col = c * 256 + F.lane * 4;
                const f32x4 g = *(const f32x4*)(a.final_norm_g + col);
                f32x4 o; o[0] = xv[c][0] * rinv * g[0]; o[1] = xv[c][1] * rinv * g[1]; o[2] = xv[c][2] * rinv * g[2]; o[3] = xv[c][3] * rinv * g[3];
                *(f32x4*)(a.out + (size_t)tok * DM + col) = o;
            }
            continue;
        }
        const float* ng = a.norm_g + ((size_t)layer * 2 + which) * DM;
        const float* sh = mod + ((size_t)layer * NB + b) * 6 * DM + (which ? 3 : 0) * DM;
        const float* sc = sh + DM;
        f32x4 hv[4];
#pragma unroll
        for (int c = 0; c < 4; ++c) {
            const int col = c * 256 + F.lane * 4;
            const f32x4 g = *(const f32x4*)(ng + col), s1 = *(const f32x4*)(sc + col), s0 = *(const f32x4*)(sh + col);
#pragma unroll
            for (int u = 0; u < 4; ++u) hv[c][u] = (xv[c][u] * rinv * g[u]) * (1.0f + s1[u]) + s0[u];
            u32x2 w; w[0] = pack_bf16(hv[c][0], hv[c][1]); w[1] = pack_bf16(hv[c][2], hv[c][3]);
            *(u32x2*)(hbuf + (size_t)tok * DM + col) = w;
        }
        if (ROUTE) {
            LAS float* lgs = (LAS float*)(F.lds + 36 * WR_LD * 4 + 256) + F.wave * 36;
#pragma unroll 1
            for (int jb = 0; jb < 36; jb += 4) {
                float pp[4];
#pragma unroll
                for (int u = 0; u < 4; ++u) {
                    float p = 0.f;
#pragma unroll
                    for (int c = 0; c < 4; ++c) {
                        const f32x4 w = *(const LAS f32x4*)(wrT + (jb + u) * WR_LD + c * 256 + F.lane * 4);
                        p += hv[c][0] * w[0] + hv[c][1] * w[1] + hv[c][2] * w[2] + hv[c][3] * w[3];
                    }
                    pp[u] = p;
                }
#pragma unroll
                for (int u = 0; u < 4; ++u) pp[u] = wave_sum(pp[u]);
                if (F.lane == 0) { *(LAS f32x4*)(lgs + jb) = (f32x4){pp[0], pp[1], pp[2], pp[3]}; }
            }
            float lg[36];
#pragma unroll
            for (int j = 0; j < 36; ++j) lg[j] = lgs[j] + brs[j];
            int g = 0; float gm = lg[0];
#pragma unroll
            for (int j = 1; j < 4; ++j) if (lg[j] > gm) { gm = lg[j]; g = j; }
            float den = 0.f;
#pragma unroll
            for (int j = 0; j < 4; ++j) den += __expf(lg[j] - gm);
            const float ptop = 1.0f / den;
            float fv[8];
#pragma unroll
            for (int i = 0; i < 8; ++i) fv[i] = (g == 0) ? lg[4 + i] : (g == 1) ? lg[12 + i] : (g == 2) ? lg[20 + i] : lg[28 + i];
            int i1 = 0; float v1 = fv[0];
#pragma unroll
            for (int i = 1; i < 8; ++i) if (fv[i] > v1) { v1 = fv[i]; i1 = i; }
            int i2 = -1; float v2 = -3.0e38f;
#pragma unroll
            for (int i = 0; i < 8; ++i) if (i != i1 && fv[i] > v2) { v2 = fv[i]; i2 = i; }
            const float e2 = __expf(v2 - v1), ga = ptop / (1.0f + e2), gb = ptop * e2 / (1.0f + e2);
            if (F.lane == 0) {
                const int li = ((tb - F.bid * NWAVE * TPW) / (F.G * NWAVE * TPW)) * NWAVE * TPW + F.wave * TPW + ti;
                const int ea = g * 8 + i1, eb = g * 8 + i2;
                const int ra = __hip_atomic_fetch_add(&rcnt[ea], 1, __ATOMIC_RELAXED, __HIP_MEMORY_SCOPE_WORKGROUP);
                const int rb = __hip_atomic_fetch_add(&rcnt[eb], 1, __ATOMIC_RELAXED, __HIP_MEMORY_SCOPE_WORKGROUP);
                if (li < RT_CAP) { rt_er[2 * li] = (ea << 16) | ra; rt_gate[2 * li] = ga; rt_tok[2 * li] = tok; rt_er[2 * li + 1] = (eb << 16) | rb; rt_gate[2 * li + 1] = gb; rt_tok[2 * li + 1] = tok; }
            }
        }
      }
    }
    if (ROUTE) {
        __syncthreads();
        unsigned* cnt = ctl + CW_CNT + layer * NEXP * CNT_STRIDE;
        if (F.tid < NEXP) { const int n = rcnt[F.tid]; rbase[F.tid] = n ? (int)__hip_atomic_fetch_add(cnt + F.tid * CNT_STRIDE, (unsigned)n, __ATOMIC_RELAXED, __HIP_MEMORY_SCOPE_AGENT) : 0; }
        __syncthreads();
        int* list = (int*)(a.ws + WS_LIST); float* gatev = (float*)(a.ws + WS_GATEV); int* tsl = (int*)(a.ws + WS_TOKSLOT);
        int nloc = 0;
        for (int tb = F.bid * NWAVE * TPW; tb < NTOK; tb += F.G * NWAVE * TPW) nloc += NWAVE * TPW;
        nloc = nloc < RT_CAP ? nloc : RT_CAP;
        for (int i = F.tid; i < 2 * nloc; i += NTHR) {
            const int er = rt_er[i]; if (er < 0) continue;
            const int e = er >> 16, pos = rbase[e] + (er & 0xffff), tok = rt_tok[i];
            list[e * NTOK + pos] = tok; gatev[e * NTOK + pos] = rt_gate[i]; tsl[tok * 2 + (i & 1)] = (e << 20) | pos;
        }
    }
    __syncthreads();
}

constexpr int RP_HT = 0, RP_HT_LD = 1028;
constexpr int RP_PART = 16 * RP_HT_LD * 4;
constexpr int RP_LG = RP_PART + 8 * 16 * 48 * 4;
DI void route_phase(const Frame& F, const Args& a, int layer) {
    const float* mod = (const float*)(a.ws + WS_MOD);
    bf16_t* hbuf = (bf16_t*)(a.ws + WS_H);
    unsigned* ctl = (unsigned*)(a.ws + WS_CTL);
    LAS float* HT = (LAS float*)(F.lds + RP_HT);
    LAS float* PART = (LAS float*)(F.lds + RP_PART);
    LAS float* LG = (LAS float*)(F.lds + RP_LG);
    constexpr int RT_CAP = 512;
    LAS int* rcnt = (LAS int*)(F.lds + 149504);
    LAS int* rbase = (LAS int*)(F.lds + 149632);
    LAS int* rt_er = (LAS int*)(F.lds + 149760);
    LAS float* rt_gate = (LAS float*)(F.lds + 149760 + 4096);
    LAS int* rt_tok = (LAS int*)(F.lds + 149760 + 8192);
    if (F.tid < NEXP) rcnt[F.tid] = 0;
    for (int i = F.tid; i < 2 * RT_CAP; i += NTHR) rt_er[i] = -1;
    const float* wg = a.moe_wr_g + (size_t)layer * DM * 4;
    const float* we = a.moe_wr_e + (size_t)layer * DM * 32;
    const int col = F.lane & 15, kq = F.lane >> 4;
    float Bw[3][32];
#pragma unroll
    for (int s2 = 0; s2 < 32; ++s2) {
        const int k = 128 * F.wave + 16 * (s2 >> 2) + 4 * kq + (s2 & 3);
        Bw[0][s2] = col < 4 ? wg[k * 4 + col] : we[k * 32 + col - 4];
        Bw[1][s2] = we[k * 32 + 12 + col];
        Bw[2][s2] = col < 4 ? we[k * 32 + 28 + col] : 0.f;
    }
    const float* ng = a.norm_g + ((size_t)layer * 2 + 1) * DM;
    __syncthreads();
    const int ngroups = NTOK / 16;
    int li0 = 0;
    for (int gi = F.bid; gi < ngroups; gi += F.G, li0 += 16) {
        const int tb = gi * 16 + F.wave * 2, b = tb / SEQ;
        const float* sh = mod + ((size_t)layer * NB + b) * 6 * DM + 3 * DM;
        const float* scp = sh + DM;
#pragma unroll
        for (int ti = 0; ti < 2; ++ti) {
            const int tok = tb + ti;
            f32x4 xv[4];
#pragma unroll
            for (int c = 0; c < 4; ++c) xv[c] = *(const f32x4*)(a.out + (size_t)tok * DM + c * 256 + F.lane * 4);
            float ss = 0.f;
#pragma unroll
            for (int c = 0; c < 4; ++c) ss += xv[c][0] * xv[c][0] + xv[c][1] * xv[c][1] + xv[c][2] * xv[c][2] + xv[c][3] * xv[c][3];
            ss = wave_sum(ss);
            const float rinv = rsqrtf(ss * (1.0f / DM) + EPS);
#pragma unroll
            for (int c = 0; c < 4; ++c) {
                const int cl = c * 256 + F.lane * 4;
                const f32x4 g = *(const f32x4*)(ng + cl), s1 = *(const f32x4*)(scp + cl), s0 = *(const f32x4*)(sh + cl);
                f32x4 hv;
#pragma unroll
                for (int u = 0; u < 4; ++u) hv[u] = (xv[c][u] * rinv * g[u]) * (1.0f + s1[u]) + s0[u];
                u32x2 w; w[0] = pack_bf16(hv[0], hv[1]); w[1] = pack_bf16(hv[2], hv[3]);
                *(u32x2*)(hbuf + (size_t)tok * DM + cl) = w;
                *(LAS f32x4*)(HT + (F.wave * 2 + ti) * RP_HT_LD + cl) = hv;
            }
        }
        __syncthreads();
        {
            f32x4 acc[3];
#pragma unroll
            for (int n = 0; n < 3; ++n) acc[n] = (f32x4){0.f, 0.f, 0.f, 0.f};
            const LAS float* ap = HT + col * RP_HT_LD + 128 * F.wave + 4 * kq;
#pragma unroll
            for (int s4 = 0; s4 < 8; ++s4) {
                const f32x4 av = *(const LAS f32x4*)(ap + 16 * s4);
#pragma unroll
                for (int u = 0; u < 4; ++u)
#pragma unroll
                    for (int n = 0; n < 3; ++n) acc[n] = __builtin_amdgcn_mfma_f32_16x16x4f32(av[u], Bw[n][4 * s4 + u], acc[n], 0, 0, 0);
            }
#pragma unroll
            for (int n = 0; n < 3; ++n)
#pragma unroll
                for (int r = 0; r < 4; ++r) PART[(F.wave * 16 + 4 * kq + r) * 48 + 16 * n + col] = acc[n][r];
        }
        __syncthreads();
        {
            const int tk = F.tid >> 5, j = F.tid & 31;
            float s0 = 0.f, s1 = 0.f;
#pragma unroll
            for (int wv = 0; wv < NWAVE; ++wv) { s0 += PART[(wv * 16 + tk) * 48 + j]; s1 += PART[(wv * 16 + tk) * 48 + 32 + (j & 3)]; }
            LG[tk * 36 + j] = s0 + (j < 4 ? a.moe_br_g[layer * 4 + j] : a.moe_br_e[layer * 32 + j - 4]);
            if (j < 4) LG[tk * 36 + 32 + j] = s1 + a.moe_br_e[layer * 32 + 28 + j];
        }
        __syncthreads();
        if (F.tid < 16) {
            const int tk = F.tid, tok = gi * 16 + tk;
            float lg[36];
#pragma unroll
            for (int j = 0; j < 36; ++j) lg[j] = LG[tk * 36 + j];
            int g = 0; float gm = lg[0];
#pragma unroll
            for (int j = 1; j < 4; ++j) if (lg[j] > gm) { gm = lg[j]; g = j; }
            float den = 0.f;
#pragma unroll
            for (int j = 0; j < 4; ++j) den += __expf(lg[j] - gm);
            const float ptop = 1.0f / den;
            float fv[8];
#pragma unroll
            for (int i = 0; i < 8; ++i) fv[i] = (g == 0) ? lg[4 + i] : (g == 1) ? lg[12 + i] : (g == 2) ? lg[20 + i] : lg[28 + i];
            int i1 = 0; float v1 = fv[0];
#pragma unroll
            for (int i = 1; i < 8; ++i) if (fv[i] > v1) { v1 = fv[i]; i1 = i; }
            int i2 = -1; float v2 = -3.0e38f;
#pragma unroll
            for (int i = 0; i < 8; ++i) if (i != i1 && fv[i] > v2) { v2 = fv[i]; i2 = i; }
            const float e2 = __expf(v2 - v1), ga = ptop / (1.0f + e2), gb = ptop * e2 / (1.0f + e2);
            const int li = li0 + tk, ea = g * 8 + i1, eb = g * 8 + i2;
            const int ra = __hip_atomic_fetch_add(&rcnt[ea], 1, __ATOMIC_RELAXED, __HIP_MEMORY_SCOPE_WORKGROUP);
            const int rb = __hip_atomic_fetch_add(&rcnt[eb], 1, __ATOMIC_RELAXED, __HIP_MEMORY_SCOPE_WORKGROUP);
            if (li < RT_CAP) { rt_er[2 * li] = (ea << 16) | ra; rt_gate[2 * li] = ga; rt_tok[2 * li] = tok; rt_er[2 * li + 1] = (eb << 16) | rb; rt_gate[2 * li + 1] = gb; rt_tok[2 * li + 1] = tok; }
        }
    }
    __syncthreads();
    unsigned* cnt = ctl + CW_CNT + layer * NEXP * CNT_STRIDE;
    if (F.tid < NEXP) { const int n = rcnt[F.tid]; rbase[F.tid] = n ? (int)__hip_atomic_fetch_add(cnt + F.tid * CNT_STRIDE, (unsigned)n, __ATOMIC_RELAXED, __HIP_MEMORY_SCOPE_AGENT) : 0; }
    __syncthreads();
    int* list = (int*)(a.ws + WS_LIST); float* gatev = (float*)(a.ws + WS_GATEV); int* tsl = (int*)(a.ws + WS_TOKSLOT);
    const int nloc = li0 < RT_CAP ? li0 : RT_CAP;
    for (int i = F.tid; i < 2 * nloc; i += NTHR) {
        const int er = rt_er[i]; if (er < 0) continue;
        const int e = er >> 16, pos = rbase[e] + (er & 0xffff), tok = rt_tok[i];
        list[e * NTOK + pos] = tok; gatev[e * NTOK + pos] = rt_gate[i]; tsl[tok * 2 + (i & 1)] = (e << 20) | pos;
    }
    __syncthreads();
}

constexpr int LDS_MISC = 131072 + 64;
constexpr int LDS_XB = 163840 - 16;
constexpr int LDS_BYTES = 163840;
using pg8::Unit;
struct DenseSched {
    int nM, nN, nwg, G, c; const char* Bt; size_t tstepB;
    DI void init(int M, int N, int K, int G_, int c_, const void* Bt_) { nM = M / 256; nN = N / 256; nwg = nM * nN; G = G_; c = c_; Bt = (const char*)Bt_; tstepB = (size_t)256 * K * 2; }
    DI bool next(int i, Unit& u) const {
        const long L = (long)i * G + c; if (L >= nwg) return false;
        int wgid = (int)L; { const int q = nwg / 8, r = nwg % 8, xcd = wgid % 8, off = wgid / 8; wgid = (xcd < r ? xcd * (q + 1) : r * (q + 1) + (xcd - r) * q) + off; }
        const int nig = 8 * nN, gid = wgid / nig, fm = gid * 8, gsz = (nM - fm) < 8 ? (nM - fm) : 8;
        u.pm = fm + ((wgid % nig) % gsz); u.pn = (wgid % nig) / gsz; u.e = 0; u.nrow = 256; return true;
    }
    DI int a_row(const Unit& u, int r) const { return u.pm * 256 + r; }
    DI const char* b_base(const Unit& u) const { return Bt + (size_t)u.pn * tstepB; }
};
template <bool UP>
struct MoeSched {
    const LAS int* ntp; const unsigned* cnt; const int* list; const char* W; int nU, G, c;
    DI bool next(int i, Unit& u) const {
        const long L = (long)i * G + c; if (L >= nU) return false;
        int wgid = (int)L; { const int q = nU / 8, r = nU % 8, xcd = wgid % 8, off = wgid / 8; wgid = (xcd < r ? xcd * (q + 1) : r * (q + 1) + (xcd - r) * q) + off; }
        const int tg = wgid >> 2; u.pn = wgid & 3; u.pm = tg;
        int e = 0;
        for (int k = 1; k < NEXP; ++k) e += (ntp[k] <= tg) ? 1 : 0;
        u.e = e; const int rem = (int)cnt[e * CNT_STRIDE] - (tg - ntp[e]) * 256; u.nrow = rem < 256 ? rem : 256; return true;
    }
    DI int a_row(const Unit& u, int r) const {
        if (UP) { const int p = (u.pm - ntp[u.e]) * 256 + r; return (r < u.nrow) ? list[u.e * NTOK + p] : 0; }
        return u.pm * 256 + r;
    }
    DI const char* b_base(const Unit& u) const {
        return W + (size_t)u.e * 3 * MiB + (UP ? (size_t)u.pn * 256 * DM * 2 : 2 * MiB + (size_t)u.pn * 256 * DEXP * 2);
    }
};
DI void moe_tile_table(const Frame& F, const unsigned* cnt, LAS int* ntp  ) {
    if (F.tid == 0) { int s = 0; for (int e = 0; e < NEXP; ++e) { ntp[e] = s; s += ((int)cnt[e * CNT_STRIDE] + 255) >> 8; } ntp[NEXP] = s; }
    __syncthreads();
}

#define EPI_ROWS_BEGIN const int row0 = u.pm * 256 + wr * 64 + fr; _Pragma("unroll") for (int ai = 0; ai < 2; ++ai) _Pragma("unroll") for (int m = 0; m < 4; ++m) { const int row = row0 + ai * 128 + m * 16;
#define EPI_ROWS_END }
DI u32x2 pack4(const f32x4& v) { u32x2 w; w[0] = pack_bf16(v[0], v[1]); w[1] = pack_bf16(v[2], v[3]); return w; }

struct EpiAbIn {
    bf16_t* Zc;
    DI void operator()(const f32x4 (&acc)[2][2][4][2], const Unit& u, int wr, int wc, int fr, int fq) const {
        EPI_ROWS_BEGIN
            bf16_t* rp = Zc + (size_t)row * ZC_N;
#pragma unroll
            for (int bj = 0; bj < 2; ++bj) {
                if (u.pn < 2) {
#pragma unroll
                    for (int n = 0; n < 2; ++n) *(u32x2*)(rp + u.pn * 256 + bj * 128 + wc * 32 + n * 16 + 4 * fq) = pack4(acc[ai][bj][m][n]);
                } else {
                    const int pnp = (u.pn - 2) & 3, j = 16 * (8 * pnp + 4 * bj + wc) + 4 * fq;
                    const f32x4 X = acc[ai][bj][m][0], Y = acc[ai][bj][m][1]; f32x4 v;
                    if (u.pn < 6) { v = X * Y; *(u32x2*)(rp + 512 + j) = pack4(v); }
                    else { v[0] = X[0] * sigmoid_f(Y[0]); v[1] = X[1] * sigmoid_f(Y[1]); v[2] = X[2] * sigmoid_f(Y[2]); v[3] = X[3] * sigmoid_f(Y[3]); *(u32x2*)(rp + 1024 + j) = pack4(v); }
                }
            }
        EPI_ROWS_END
    }
};
struct EpiResid {
    const float* xin; float* xout; const float* g1;
    DI void operator()(const f32x4 (&acc)[2][2][4][2], const Unit& u, int wr, int wc, int fr, int fq) const {
        const float* g = g1 + (size_t)((u.pm * 256) / SEQ) * 6 * DM;
        EPI_ROWS_BEGIN
#pragma unroll
            for (int bj = 0; bj < 2; ++bj)
#pragma unroll
                for (int n = 0; n < 2; ++n) {
                    const int col = u.pn * 256 + bj * 128 + wc * 32 + n * 16 + 4 * fq;
                    const f32x4 xo = *(const f32x4*)(xin + (size_t)row * DM + col), gv = *(const f32x4*)(g + col);
                    *(f32x4*)(xout + (size_t)row * DM + col) = xo + gv * acc[ai][bj][m][n];
                }
        EPI_ROWS_END
    }
};
struct EpiPlain {
    bf16_t* O; int ld;
    DI void operator()(const f32x4 (&acc)[2][2][4][2], const Unit& u, int wr, int wc, int fr, int fq) const {
        EPI_ROWS_BEGIN
#pragma unroll
            for (int bj = 0; bj < 2; ++bj)
#pragma unroll
                for (int n = 0; n < 2; ++n) *(u32x2*)(O + (size_t)row * ld + u.pn * 256 + bj * 128 + wc * 32 + n * 16 + 4 * fq) = pack4(acc[ai][bj][m][n]);
        EPI_ROWS_END
    }
};
struct EpiMoeUp {
    bf16_t* act;
    DI void operator()(const f32x4 (&acc)[2][2][4][2], const Unit& u, int wr, int wc, int fr, int fq) const {
        EPI_ROWS_BEGIN
#pragma unroll
            for (int bj = 0; bj < 2; ++bj) {
                const int j = 16 * (8 * u.pn + 4 * bj + wc) + 4 * fq;
                const f32x4 X = acc[ai][bj][m][0], Y = acc[ai][bj][m][1]; f32x4 v;
                v[0] = silu_f(X[0]) * Y[0]; v[1] = silu_f(X[1]) * Y[1]; v[2] = silu_f(X[2]) * Y[2]; v[3] = silu_f(X[3]) * Y[3];
                *(u32x2*)(act + (size_t)row * DEXP + j) = pack4(v);
            }
        EPI_ROWS_END
    }
};
struct EpiMoeDown {
    bf16_t* y; const float* gatev; const LAS int* ntp;
    DI void operator()(const f32x4 (&acc)[2][2][4][2], const Unit& u, int wr, int wc, int fr, int fq) const {
        const int pbase = (u.pm - ntp[u.e]) * 256;
        EPI_ROWS_BEGIN
            const int r = row - u.pm * 256;
            const float gt = (r < u.nrow) ? gatev[u.e * NTOK + pbase + r] : 0.f;
#pragma unroll
            for (int bj = 0; bj < 2; ++bj)
#pragma unroll
                for (int n = 0; n < 2; ++n) *(u32x2*)(y + (size_t)row * DM + u.pn * 256 + bj * 128 + wc * 32 + n * 16 + 4 * fq) = pack4(acc[ai][bj][m][n] * gt);
        EPI_ROWS_END
    }
};

DI void conv_phase(const Frame& F, const Args& a) {
    const bf16_t* Zc = (const bf16_t*)(a.ws + WS_BIG);
    bf16_t* Y = (bf16_t*)(a.ws + WS_Y);
    LAS unsigned* PB = (LAS unsigned*)F.lds;
    LAS f32x2* ST = (LAS f32x2*)(F.lds + 94 * 1024);
    const int cp = F.tid & 255, th = F.tid >> 8, wq = F.wave & 3;
    float wb[31][2], wa[3][2];
#pragma unroll
    for (int k = 0; k < 31; ++k) { const f32x2 w = *(const f32x2*)(a.ab_conv_b + k * 512 + 2 * cp); wb[k][0] = w[0]; wb[k][1] = w[1]; }
#pragma unroll
    for (int k = 0; k < 3; ++k) { const f32x2 w = *(const f32x2*)(a.ab_conv_a + k * 512 + 2 * cp); wa[k][0] = w[0]; wa[k][1] = w[1]; }
    const f32x2 cbias = *(const f32x2*)(a.ab_conv_b_bias + 2 * cp), lng = *(const f32x2*)(a.ab_ln_g + 2 * cp), lnb = *(const f32x2*)(a.ab_ln_b + 2 * cp);
    for (int tile = F.bid; tile < NTOK / 64; tile += F.G) {
        const int t0 = tile * 64, b = t0 / SEQ, tl0 = t0 % SEQ;
        for (int i = F.tid; i < 94 * 64; i += NTHR) {
            const int r = i >> 6, c8 = i & 63, pos = tl0 - 30 + r;
            u32x4 v = {0u, 0u, 0u, 0u};
            if (pos >= 0) v = *(const u32x4*)(Zc + (size_t)(b * SEQ + pos) * ZC_N + 1024 + c8 * 8);
            *(LAS u32x4*)(PB + r * 256 + c8 * 4) = v;
        }
        __syncthreads();
#pragma unroll 1
        for (int g = 0; g < 4; ++g) {
            float U[8][2];
#pragma unroll
            for (int i = 0; i < 8; ++i) { U[i][0] = cbias[0]; U[i][1] = cbias[1]; }
#pragma unroll
            for (int r = 0; r < 38; ++r) {
                const unsigned xw = PB[(32 * th + 8 * g + r) * 256 + cp];
                const float x0 = bf_lo(xw), x1 = bf_hi(xw);
#pragma unroll
                for (int i = 0; i < 8; ++i) { const int k = r - i; if (k >= 0 && k <= 30) { U[i][0] += wb[k][0] * x0; U[i][1] += wb[k][1] * x1; } }
            }
            unsigned gwv[8], pav[10];
#pragma unroll
            for (int i = 0; i < 8; ++i) gwv[i] = *(const unsigned*)(Zc + ((size_t)t0 + 32 * th + 8 * g + i) * ZC_N + 2 * cp);
#pragma unroll
            for (int i = 0; i < 10; ++i) { const int pp = tl0 + 32 * th + 8 * g + i - 2; pav[i] = pp >= 0 ? *(const unsigned*)(Zc + (size_t)(b * SEQ + pp) * ZC_N + 512 + 2 * cp) : 0u; }
            {
                float v[16];
#pragma unroll
                for (int i = 0; i < 8; ++i) { v[2 * i] = U[i][0] + U[i][1]; v[2 * i + 1] = U[i][0] * U[i][0] + U[i][1] * U[i][1]; }
#pragma unroll
                for (int hw = 8; hw >= 1; hw >>= 1) {
                    const bool up = (F.lane & (4 * hw)) != 0;
#pragma unroll
                    for (int i = 0; i < hw; ++i) { const float send = up ? v[i] : v[i + hw], keep = up ? v[i + hw] : v[i]; v[i] = keep + __shfl_xor(send, 4 * hw); }
                }
                v[0] += __shfl_xor(v[0], 2); v[0] += __shfl_xor(v[0], 1);
                if ((F.lane & 3) == 0) { const int idx = F.lane >> 2; ((LAS float*)ST)[((32 * th + 8 * g + (idx >> 1)) * 4 + wq) * 2 + (idx & 1)] = v[0]; }
            }
            __syncthreads();
#pragma unroll
            for (int i = 0; i < 8; ++i) {
                const int tl = 32 * th + 8 * g + i; const size_t tok = (size_t)t0 + tl;
                const f32x2 p0 = ST[tl * 4 + 0], p1 = ST[tl * 4 + 1], p2 = ST[tl * 4 + 2], p3 = ST[tl * 4 + 3];
                const float mean = ((p0[0] + p1[0]) + (p2[0] + p3[0])) * (1.0f / 512.0f);
                const float var = ((p0[1] + p1[1]) + (p2[1] + p3[1])) * (1.0f / 512.0f) - mean * mean;
                const float rstd = rsqrtf(var + EPS);
                const float yb0 = silu_f((U[i][0] - mean) * rstd * lng[0] + lnb[0]), yb1 = silu_f((U[i][1] - mean) * rstd * lng[1] + lnb[1]);
                *(unsigned*)(Y + tok * DM + 512 + 2 * cp) = pack_bf16(yb0, yb1);
                float a0 = 0.f, a1 = 0.f;
#pragma unroll
                for (int k = 0; k < 3; ++k) { const unsigned w = pav[i + k]; a0 += wa[k][0] * bf_lo(w); a1 += wa[k][1] * bf_hi(w); }
                const unsigned gw = gwv[i];
                *(unsigned*)(Y + tok * DM + 2 * cp) = pack_bf16(bf_lo(gw) * a0, bf_hi(gw) * a1);
            }
        }
        __syncthreads();
    }
}

#define MFMA32(a, b, c) __builtin_amdgcn_mfma_f32_32x32x16_bf16((a), (b), (c), 0, 0, 0)
#define LDS6_ISSUE(B, addr, o0, o1, o2, o3, o4, o5) asm volatile( \
    "ds_read_b128 %0, %6 offset:" #o0 "\n\tds_read_b128 %1, %6 offset:" #o1 "\n\tds_read_b128 %2, %6 offset:" #o2 "\n\tds_read_b128 %3, %6 offset:" #o3 "\n\tds_read_b128 %4, %6 offset:" #o4 "\n\tds_read_b128 %5, %6 offset:" #o5 \
    : "=&v"(B[0]), "=&v"(B[1]), "=&v"(B[2]), "=&v"(B[3]), "=&v"(B[4]), "=&v"(B[5]) : "v"(addr) : "memory")
#define LDS6_WAIT(B) asm volatile("s_waitcnt lgkmcnt(0)" : "+v"(B[0]), "+v"(B[1]), "+v"(B[2]), "+v"(B[3]), "+v"(B[4]), "+v"(B[5]) :: "memory")
constexpr int TK_HIST = 0;
constexpr int TK_HLD = 513;
constexpr int TK_TAB = 66048;
constexpr int TK_CAP = 256;
constexpr int TK_CAND = 66560;
constexpr int TK_CCNT = TK_CAND + 32 * TK_CAP * 4;
constexpr int TK_OVF = TK_CCNT + 128;
constexpr int TK_BQ = 100352;
constexpr int TK_MASK = 118784;
DI int crow_c(int r) { return (r & 3) + 8 * (r >> 2); }
template <int MODE, bool DIAG>
DI void topk_elems(const Frame& F, const f32x16& sc, int kt, int q, int h2, int myT, LAS unsigned* hist, LAS unsigned* cand, LAS int* ccnt, LAS unsigned* maskl) {
    const int lo = myT << 9, hi = (myT + 1) << 9;
    if (MODE <= 2) {
#pragma unroll
        for (int r = 0; r < 16; ++r) {
            unsigned key = (unsigned)sc[r]; key = key > 262143u ? 262143u : key;
            const bool valid = !DIAG || (crow_c(r) + 4 * h2 <= q);
            if (MODE == 1) { if (valid) __hip_atomic_fetch_add(&hist[q * TK_HLD + (key >> 9)], 1u, __ATOMIC_RELAXED, __HIP_MEMORY_SCOPE_WORKGROUP); }
            else { if (valid && (int)(key >> 9) == myT) __hip_atomic_fetch_add(&hist[q * TK_HLD + (key & 511)], 1u, __ATOMIC_RELAXED, __HIP_MEMORY_SCOPE_WORKGROUP); }
        }
        return;
    }
    const int selb = (MODE == 3 ? myT : hi - 1), geb = (MODE == 3 ? myT - 1 : lo - 1);
    unsigned selw = 0u, gew = 0u;
#pragma unroll
    for (int r = 0; r < 16; ++r) {
        unsigned key = (unsigned)sc[r]; key = key > 262143u ? 262143u : key;
        const unsigned d1 = (unsigned)(selb - (int)key), d2 = (unsigned)(geb - (int)key);
        selw = __builtin_amdgcn_alignbit(selw, d1, 31);
        gew = __builtin_amdgcn_alignbit(gew, d2, 31);
    }
    if (DIAG) {
        unsigned vw = 0u;
#pragma unroll
        for (int r = 0; r < 16; ++r) vw |= (crow_c(r) + 4 * h2 <= q) ? (1u << (15 - r)) : 0u;
        selw &= vw; gew &= vw;
    }
    unsigned cw = gew & ~selw & 0xffffu;
    if (cw) {
#pragma unroll
        for (int r = 0; r < 16; ++r) {
            if (cw & (1u << (15 - r))) {
                unsigned key = (unsigned)sc[r]; key = key > 262143u ? 262143u : key;
                const int p = __hip_atomic_fetch_add(&ccnt[q], 1, __ATOMIC_RELAXED, __HIP_MEMORY_SCOPE_WORKGROUP);
                if (p < TK_CAP) cand[q * TK_CAP + p] = (MODE == 3 ? 0u : ((key - (unsigned)lo) << 13)) | (unsigned)(8191 - (32 * kt + crow_c(r) + 4 * h2));
            }
        }
    }
    unsigned rv = __builtin_bitreverse32(selw) >> 16;
    unsigned bits = (rv & 0xfu) | ((rv & 0xf0u) << 4) | ((rv & 0xf00u) << 8) | ((rv & 0xf000u) << 12);
    bits <<= 4 * h2;
    bits |= (unsigned)__shfl_xor((int)bits, 32);
    if (h2 == 0) maskl[q * 256 + kt] = bits;
}
template <int MODE>
DI void topk_pass(const Frame& F, const bf16_t* Z, int b, int t0, const float (&wp)[8]) {
    const LAS unsigned char* bq = F.lds + TK_BQ;
    LAS unsigned* hist = (LAS unsigned*)(F.lds + TK_HIST);
    LAS int* tab = (LAS int*)(F.lds + TK_TAB);
    LAS unsigned* cand = (LAS unsigned*)(F.lds + TK_CAND);
    LAS int* ccnt = (LAS int*)(F.lds + TK_CCNT);
    LAS unsigned* maskl = (LAS unsigned*)(F.lds + TK_MASK);
    const int lane = fresh_lane(), q = lane & 31, h2 = lane >> 5, ntile = t0 / 32 + 1;
    const int myT = (MODE >= 2) ? tab[q * 4 + 0] : 0;
    const unsigned bqa = (unsigned)(size_t)(bq + lane * 16);
    const bf16_t* kbase = Z + (size_t)b * SEQ * CD_N + Z_KI + 8 * h2 + (size_t)q * CD_N;
    bf16x8 A0n = (bf16x8){0, 0, 0, 0, 0, 0, 0, 0}, A1n = A0n;
    if (F.wave < ntile) { const bf16_t* kp = kbase + (size_t)(32 * F.wave) * CD_N; A0n = *(const bf16x8*)kp; A1n = *(const bf16x8*)(kp + 16); }
    for (int kt = F.wave; kt < ntile; kt += NWAVE) {
        const bf16x8 A0 = A0n, A1 = A1n;
        if (kt + NWAVE < ntile) { const bf16_t* kp = kbase + (size_t)(32 * (kt + NWAVE)) * CD_N; A0n = *(const bf16x8*)kp; A1n = *(const bf16x8*)(kp + 16); }
        f32x16 sc;
#pragma unroll
        for (int r = 0; r < 16; ++r) sc[r] = 131072.0f;
        {
#define TK_MF0(acc, A, B) asm volatile("v_mfma_f32_32x32x16_bf16 %0, %1, %2, 0" : "=&v"(acc) : "v"(A), "v"(B))
#define TK_MF1(acc, A, B) asm volatile("v_mfma_f32_32x32x16_bf16 %0, %1, %2, %0" : "+v"(acc) : "v"(A), "v"(B))
#define TK_FA(sv, av, wv) asm volatile("v_fma_f32 %0, |%1|, %2, %0" : "+v"(sv) : "v"(av), "v"(wv))
#define TK_AD(sv, av) asm volatile("v_add_f32 %0, %0, %1" : "+v"(sv) : "v"(av))
        bf16x8 Ba[6], Bb[6];
        f32x16 acA[3], acB[3];
        LDS6_ISSUE(Ba, bqa, 16384, 17408, 0, 1024, 2048, 3072);
        LDS6_WAIT(Ba);
        LDS6_ISSUE(Bb, bqa, 4096, 5120, 6144, 7168, 8192, 9216);
#pragma unroll
        for (int u = 0; u < 3; ++u) TK_MF0(acA[u], A0, Ba[2 * u]);
#pragma unroll
        for (int u = 0; u < 3; ++u) TK_MF1(acA[u], A1, Ba[2 * u + 1]);
        LDS6_WAIT(Bb);
        LDS6_ISSUE(Ba, bqa, 10240, 11264, 12288, 13312, 14336, 15360);
#pragma unroll
        for (int m = 0; m < 6; ++m) {
            if (m >= 3) TK_MF1(acB[m - 3], A1, Bb[2 * (m - 3) + 1]); else TK_MF0(acB[m], A0, Bb[2 * m]);
#pragma unroll
            for (int e = 0; e < 8; ++e) { const int i = 8 * m + e, u = i >> 4, r = i & 15; if (u == 0) TK_AD(sc[r], acA[0][r]); else TK_FA(sc[r], acA[u][r], wp[u - 1]); }
        }
        LDS6_WAIT(Ba);
#pragma unroll
        for (int m = 0; m < 6; ++m) {
            if (m >= 3) TK_MF1(acA[m - 3], A1, Ba[2 * (m - 3) + 1]); else TK_MF0(acA[m], A0, Ba[2 * m]);
#pragma unroll
            for (int e = 0; e < 8; ++e) { const int i = 8 * m + e, u = i >> 4, r = i & 15; TK_FA(sc[r], acB[u][r], wp[2 + u]); }
        }
#pragma unroll
        for (int u = 0; u < 3; ++u)
#pragma unroll
            for (int r = 0; r < 16; ++r) TK_FA(sc[r], acA[u][r], wp[5 + u]);
#undef TK_MF0
#undef TK_MF1
#undef TK_FA
#undef TK_AD
        }
        if (kt == ntile - 1) topk_elems<MODE, true>(F, sc, kt, q, h2, myT, hist, cand, ccnt, maskl);
        else topk_elems<MODE, false>(F, sc, kt, q, h2, myT, hist, cand, ccnt, maskl);
    }
}
DI void topk_scan(const Frame& F, int pass, int t0) {
    LAS unsigned* hist = (LAS unsigned*)(F.lds + TK_HIST);
    LAS int* tab = (LAS int*)(F.lds + TK_TAB);
    LAS int* ovf = (LAS int*)(F.lds + TK_OVF);
    for (int qi = 0; qi < 4; ++qi) {
        const int q = F.wave * 4 + qi, n = t0 + q + 1;
        int need = 256, prevT = 0, prevAbove = 0;
        if (pass == 2) { prevT = tab[q * 4 + 0]; prevAbove = tab[q * 4 + 1]; need = 256 - prevAbove; }
        if (n <= 256) { if (F.lane == 0) { tab[q * 4 + 0] = -1; tab[q * 4 + 1] = 0; tab[q * 4 + 2] = 0; } continue; }
        unsigned hv[8]; unsigned s = 0;
#pragma unroll
        for (int i = 0; i < 8; ++i) { hv[i] = hist[q * TK_HLD + 511 - (8 * F.lane + i)]; s += hv[i]; }
        unsigned inc = s;
#pragma unroll
        for (int o = 1; o < 64; o <<= 1) { const unsigned v = (unsigned)__shfl_up((int)inc, o); if (F.lane >= o) inc += v; }
        const unsigned pre = inc - s;
        if ((int)pre < need && (int)inc >= need) {
            unsigned cum = pre; int bsel = 0; unsigned above = 0, inbin = 0; bool found = false;
#pragma unroll
            for (int i = 0; i < 8; ++i) { if (!found && (int)(cum + hv[i]) >= need) { found = true; bsel = 511 - (8 * F.lane + i); above = cum; inbin = hv[i]; } cum += hv[i]; }
            if (pass == 1) { tab[q * 4 + 0] = bsel; tab[q * 4 + 1] = (int)above; tab[q * 4 + 2] = 256 - (int)above; if (inbin > (unsigned)TK_CAP) *ovf = 1; }
            else { tab[q * 4 + 0] = (prevT << 9) | bsel; tab[q * 4 + 1] = prevAbove + (int)above; tab[q * 4 + 2] = 256 - (prevAbove + (int)above); }
        }
    }
}
DI void topk_select(const Frame& F) {
    LAS int* tab = (LAS int*)(F.lds + TK_TAB);
    LAS unsigned* cand = (LAS unsigned*)(F.lds + TK_CAND);
    LAS int* ccnt = (LAS int*)(F.lds + TK_CCNT);
    LAS unsigned* maskl = (LAS unsigned*)(F.lds + TK_MASK);
    for (int qi = 0; qi < 4; ++qi) {
        const int q = F.wave * 4 + qi, need = tab[q * 4 + 2];
        int n = ccnt[q]; n = n > TK_CAP ? TK_CAP : n;
        if (need <= 0 || n <= 0) continue;
        unsigned c[4]; int rk[4]; bool vv[4];
#pragma unroll
        for (int i = 0; i < 4; ++i) { vv[i] = F.lane + 64 * i < n; c[i] = vv[i] ? cand[q * TK_CAP + F.lane + 64 * i] : 0u; rk[i] = 0; }
        for (int j = 0; j < n; ++j) {
            const unsigned cj = cand[q * TK_CAP + j];
#pragma unroll
            for (int i = 0; i < 4; ++i) rk[i] += (cj > c[i]) ? 1 : 0;
        }
#pragma unroll
        for (int i = 0; i < 4; ++i)
            if (vv[i] && rk[i] < need) { const int idx = 8191 - (int)(c[i] & 8191u); __hip_atomic_fetch_or(&maskl[q * 256 + (idx >> 5)], 1u << (idx & 31), __ATOMIC_RELAXED, __HIP_MEMORY_SCOPE_WORKGROUP); }
    }
}
DI void topk_phase(const Frame& F, const Args& a, unsigned long long& tacc) {
    unsigned long long t_s = 0;
#define TKT0(n) do { if (TIME_PH == 100 + (n)) { __syncthreads(); t_s = wall_clock64(); } } while (0)
#define TKT1(n) do { if (TIME_PH == 100 + (n)) { __syncthreads(); tacc += wall_clock64() - t_s; } } while (0)
    const bf16_t* Z = (const bf16_t*)(a.ws + WS_BIG);
    unsigned* maskg = (unsigned*)(a.ws + WS_MASK);
    LAS unsigned* hist = (LAS unsigned*)(F.lds + TK_HIST);
    LAS int* ccnt = (LAS int*)(F.lds + TK_CCNT);
    LAS int* ovf = (LAS int*)(F.lds + TK_OVF);
    LAS unsigned* maskl = (LAS unsigned*)(F.lds + TK_MASK);
    for (int pi = F.bid; pi < 512; pi += F.G) {
        const int b = pi >> 7, p = pi & 127;
        for (int half = 0; half < 2; ++half) {
            const int t0 = 32 * (half ? 255 - p : p), ntile = t0 / 32 + 1;
            const int lane0 = fresh_lane(), q = lane0 & 31, h2 = lane0 >> 5;
            const bf16_t* zr = Z + (size_t)(b * SEQ + t0 + q) * CD_N;
            TKT0(1);
            float wp[8];
            { const u32x4 wv = *(const u32x4*)(zr + Z_WI);
              const float sc = 0.0625f * 0.5f * 16384.0f;
              wp[0] = bf_lo(wv[0]) * sc; wp[1] = bf_hi(wv[0]) * sc; wp[2] = bf_lo(wv[1]) * sc; wp[3] = bf_hi(wv[1]) * sc;
              wp[4] = bf_lo(wv[2]) * sc; wp[5] = bf_hi(wv[2]) * sc; wp[6] = bf_lo(wv[3]) * sc; wp[7] = bf_hi(wv[3]) * sc; }
            __syncthreads();
            if (F.wave == 0) {
                LAS unsigned char* bqw = F.lds + TK_BQ;
                float lin[2][8];
#pragma unroll
                for (int ks = 0; ks < 2; ++ks)
#pragma unroll
                    for (int j = 0; j < 8; ++j) lin[ks][j] = 0.f;
#pragma unroll
                for (int h = 0; h < 8; ++h)
#pragma unroll
                    for (int ks = 0; ks < 2; ++ks) {
                        const u32x4 v = *(const u32x4*)(zr + Z_QI + 32 * h + 16 * ks + 8 * h2);
                        *(LAS u32x4*)(bqw + ((2 * h + ks) * 64 + lane0) * 16) = v;
#pragma unroll
                        for (int j = 0; j < 4; ++j) { lin[ks][2 * j] += wp[h] * bf_lo(v[j]); lin[ks][2 * j + 1] += wp[h] * bf_hi(v[j]); }
                    }
#pragma unroll
                for (int ks = 0; ks < 2; ++ks) {
                    u32x4 v; v[0] = pack_bf16(lin[ks][0], lin[ks][1]); v[1] = pack_bf16(lin[ks][2], lin[ks][3]); v[2] = pack_bf16(lin[ks][4], lin[ks][5]); v[3] = pack_bf16(lin[ks][6], lin[ks][7]);
                    *(LAS u32x4*)(bqw + ((16 + ks) * 64 + lane0) * 16) = v;
                }
            }
            for (int i = F.tid; i < 32 * TK_HLD; i += NTHR) hist[i] = 0u;
            if (F.tid < 32) ccnt[F.tid] = 0;
            if (F.tid == 32) *ovf = 0;
            __syncthreads();
            TKT1(1); TKT0(2);
            topk_pass<1>(F, Z, b, t0, wp);
            __syncthreads();
            TKT1(2); TKT0(3);
            topk_scan(F, 1, t0);
            __syncthreads();
            TKT1(3); TKT0(4);
            if (*ovf == 0) {
                topk_pass<4>(F, Z, b, t0, wp);
            } else {
                for (int i = F.tid; i < 32 * TK_HLD; i += NTHR) hist[i] = 0u;
                __syncthreads();
                topk_pass<2>(F, Z, b, t0, wp);
                __syncthreads();
                topk_scan(F, 2, t0);
                __syncthreads();
                topk_pass<3>(F, Z, b, t0, wp);
            }
            __syncthreads();
            TKT1(4); TKT0(5);
            topk_select(F);
            __syncthreads();
            for (int i = F.wave * 64 + fresh_lane(); i < 32 * ntile; i += NTHR) { const int qq = i / ntile, kt = i - qq * ntile; maskg[(size_t)(b * SEQ + t0 + qq) * 256 + kt] = maskl[qq * 256 + kt]; }
            TKT1(5);
        }
    }
}

constexpr int AT_KSTR = 72;
constexpr int AT_VSTR = 72;
constexpr int AT_KBYTES = 64 * AT_KSTR * 2;
constexpr int AT_VBYTES = 128 * AT_VSTR * 2;
constexpr int AT_BUF = AT_KBYTES + AT_VBYTES;
constexpr int AT_NSTG = 3;
constexpr int AT_LUT = AT_NSTG * AT_BUF;
constexpr int AT_LUT_LD = 320;
constexpr float NEG_INF = -__builtin_huge_valf();
constexpr float AT_THR = 8.0f;

template <int DV, bool MASKED>
DI void attn_core(const Frame& F, const bf16_t* Z, const bf16_t* Vt, int b, int qcol, int kcol, int vrow, int q0, const LAS float* lut, float c1, const unsigned* maskg, f32x16 (&O)[DV / 32]) {
    constexpr int NDV = DV / 32;
    const int q = F.lane & 31, h2 = F.lane >> 5;
    const int tw0 = q0 + 32 * F.wave, t = tw0 + q;
    const bf16_t* Zb = Z + (size_t)b * SEQ * CD_N;
    const bf16_t* Vb = Vt + (size_t)vrow * NTOK + (size_t)b * SEQ;
    const unsigned* mrow = maskg + (size_t)(b * SEQ + t) * 256;
    bf16x8 Qf[4];
#pragma unroll
    for (int ks = 0; ks < 4; ++ks) Qf[ks] = *(const bf16x8*)(Zb + (size_t)t * CD_N + qcol + 16 * ks + 8 * h2);
#pragma unroll
    for (int d = 0; d < NDV; ++d)
#pragma unroll
        for (int r = 0; r < 16; ++r) O[d][r] = 0.f;
    float m_run = NEG_INF, l_run = 0.f;
    const int jmax = (q0 + 255) >> 6;
    const int kkey = F.tid >> 3, kch = F.tid & 7;
    u32x4 kreg, vreg[DV / 64]; unsigned mreg[2] = {0u, 0u};
    bf16x8 Pf[4];
#pragma unroll
    for (int i = 0; i < 4; ++i) Pf[i] = (bf16x8){0, 0, 0, 0, 0, 0, 0, 0};
#define AT_LOAD(j) do { kreg = *(const u32x4*)(Zb + (size_t)(64 * (j) + kkey) * CD_N + kcol + 8 * kch); \
        _Pragma("unroll") for (int _i = 0; _i < DV / 64; ++_i) { const int idx = F.tid + NTHR * _i; vreg[_i] = *(const u32x4*)(Vb + (size_t)(idx >> 3) * NTOK + 64 * (j) + 8 * (idx & 7)); } \
        if (MASKED) { mreg[0] = mrow[2 * (j)]; mreg[1] = mrow[2 * (j) + 1]; } } while (0)
#define AT_STORE(buf) do { LAS unsigned char* kb_ = F.lds + (buf) * AT_BUF; *(LAS u32x4*)(kb_ + kkey * (AT_KSTR * 2) + kch * 16) = kreg; \
        _Pragma("unroll") for (int _i = 0; _i < DV / 64; ++_i) { const int idx = F.tid + NTHR * _i, dv_ = idx >> 3, ch_ = idx & 7; \
            LAS unsigned char* vp_ = kb_ + AT_KBYTES + dv_ * (AT_VSTR * 2) + (16 * (ch_ >> 1) + 4 * (ch_ & 1)) * 2; \
            *(LAS u32x2*)vp_ = (u32x2){vreg[_i][0], vreg[_i][1]}; *(LAS u32x2*)(vp_ + 16) = (u32x2){vreg[_i][2], vreg[_i][3]}; } } while (0)
#define AT_QKSM(jj) do { \
        const LAS unsigned char* kb = F.lds + ((jj) % AT_NSTG) * AT_BUF; \
        f32x16 s[2]; \
        _Pragma("unroll") for (int kb2 = 0; kb2 < 2; ++kb2) { \
            bf16x8 Kf[4]; \
            _Pragma("unroll") for (int ks = 0; ks < 4; ++ks) Kf[ks] = *(const LAS bf16x8*)(kb + (32 * kb2 + q) * (AT_KSTR * 2) + (16 * ks + 8 * h2) * 2); \
            _Pragma("unroll") for (int r = 0; r < 16; ++r) s[kb2][r] = 0.f; \
            _Pragma("unroll") for (int ks = 0; ks < 4; ++ks) s[kb2] = MFMA32(Kf[ks], Qf[ks], s[kb2]); \
        } \
        const bool nearb = (64 * (jj) + 63 + 128 > tw0); \
        float mloc = NEG_INF; \
        if (!nearb) { \
            _Pragma("unroll") for (int kb2 = 0; kb2 < 2; ++kb2) _Pragma("unroll") for (int r = 0; r < 16; ++r) mloc = fmaxf(mloc, s[kb2][r]); \
            mloc = mloc * c1 + lut[96 + 128]; \
        } else { \
            const LAS float* lp = lut + (t - 64 * (jj) - 4 * h2 + 96 - 63); \
            _Pragma("unroll") for (int kb2 = 0; kb2 < 2; ++kb2) \
                _Pragma("unroll") for (int r = 0; r < 16; ++r) { const float v_ = s[kb2][r] * c1 + lp[63 - (32 * kb2 + crow_c(r))]; s[kb2][r] = v_; mloc = fmaxf(mloc, v_); } \
        } \
        mloc = fmaxf(mloc, __shfl_xor(mloc, 32)); \
        if (__any(mloc > m_run + AT_THR)) { \
            const float m_new = fmaxf(m_run, mloc); \
            const float alpha = __builtin_amdgcn_exp2f(m_run - m_new); \
            m_run = m_new; l_run *= alpha; \
            _Pragma("unroll") for (int d = 0; d < NDV; ++d) _Pragma("unroll") for (int r = 0; r < 16; ++r) O[d][r] *= alpha; \
        } \
        const float sub = lut[96 + 128] - m_run; \
        if (!nearb) { _Pragma("unroll") for (int kb2 = 0; kb2 < 2; ++kb2) _Pragma("unroll") for (int r = 0; r < 16; ++r) s[kb2][r] = __builtin_amdgcn_exp2f(s[kb2][r] * c1 + sub); } \
        else        { _Pragma("unroll") for (int kb2 = 0; kb2 < 2; ++kb2) _Pragma("unroll") for (int r = 0; r < 16; ++r) s[kb2][r] = __builtin_amdgcn_exp2f(s[kb2][r] - m_run); } \
        float psum0 = 0.f, psum1 = 0.f; \
        _Pragma("unroll") for (int kb2 = 0; kb2 < 2; ++kb2) { \
            const unsigned mw = mcur[kb2] >> (4 * h2); \
            _Pragma("unroll") for (int r = 0; r < 16; ++r) { \
                float p = s[kb2][r]; \
                if (MASKED) { p = __uint_as_float(__float_as_uint(p) & (unsigned)(-(int)((mw >> crow_c(r)) & 1u))); s[kb2][r] = p; } \
                if (r & 1) psum1 += p; else psum0 += p; \
            } \
        } \
        l_run += psum0 + psum1; \
        _Pragma("unroll") for (int st = 0; st < 4; ++st) { \
            u32x4 pw; \
            _Pragma("unroll") for (int e = 0; e < 4; ++e) pw[e] = pack_bf16(s[st >> 1][8 * (st & 1) + 2 * e], s[st >> 1][8 * (st & 1) + 2 * e + 1]); \
            Pf[st] = __builtin_bit_cast(bf16x8, pw); \
        } \
    } while (0)
#define AT_PV(jj) do { \
        const LAS unsigned char* vt = F.lds + ((jj) % AT_NSTG) * AT_BUF + AT_KBYTES + q * (AT_VSTR * 2) + (8 * h2) * 2; \
        constexpr int NH = NDV / 2, NST = 4 * NH; \
        bf16x8 Av[2][2]; \
        _Pragma("unroll") for (int d = 0; d < 2; ++d) Av[0][d] = *(const LAS bf16x8*)(vt + (32 * d) * (AT_VSTR * 2)); \
        _Pragma("unroll") for (int u = 0; u < NST; ++u) { \
            const int st = u / NH, dh = u % NH; \
            if (u + 1 < NST) { \
                const int st1 = (u + 1) / NH, dh1 = (u + 1) % NH; \
                _Pragma("unroll") for (int d = 0; d < 2; ++d) Av[(u + 1) & 1][d] = *(const LAS bf16x8*)(vt + (32 * (2 * dh1 + d)) * (AT_VSTR * 2) + (16 * st1) * 2); \
            } \
            __builtin_amdgcn_s_setprio(1); \
            _Pragma("unroll") for (int d = 0; d < 2; ++d) O[2 * dh + d] = MFMA32(Av[u & 1][d], Pf[st], O[2 * dh + d]); \
            __builtin_amdgcn_s_setprio(0); \
            __builtin_amdgcn_sched_barrier(0); \
        } \
    } while (0)
#define AT_ACT(jj) (64 * (jj) <= tw0 + 31)
    AT_LOAD(0); AT_STORE(0);
    unsigned mcur[2] = {mreg[0], mreg[1]};
    __syncthreads();
    if (F.wave < 4) {
        for (int j = 0; j <= jmax; ++j) {
            if (j < jmax) AT_LOAD(j + 1);
            if (AT_ACT(j)) { AT_QKSM(j); AT_PV(j); }
            if (j < jmax) AT_STORE((j + 1) % AT_NSTG);
            mcur[0] = mreg[0]; mcur[1] = mreg[1];
            __syncthreads();
        }
    } else {
        for (int j = 0; j <= jmax; ++j) {
            if (j < jmax) AT_LOAD(j + 1);
            if (j > 0 && AT_ACT(j - 1)) AT_PV(j - 1);
            if (AT_ACT(j)) AT_QKSM(j);
            if (j < jmax) AT_STORE((j + 1) % AT_NSTG);
            mcur[0] = mreg[0]; mcur[1] = mreg[1];
            __syncthreads();
        }
        if (AT_ACT(jmax)) AT_PV(jmax);
    }
    __syncthreads();
#undef AT_LOAD
#undef AT_STORE
#undef AT_QKSM
#undef AT_PV
#undef AT_ACT
    const float lt = l_run + __shfl_xor(l_run, 32);
    const float inv = 1.0f / lt;
#pragma unroll
    for (int d = 0; d < NDV; ++d)
#pragma unroll
        for (int r = 0; r < 16; ++r) O[d][r] *= inv;
}

DI float rel_bucket_bias(const float* rel_bias, int d, int head) {
    int bkt;
    if (d < 16) bkt = d;
    else { const float lr = __logf((float)d * (1.0f / 16.0f)) / 2.0794415416798357f; int l = 16 + (int)(lr * 16.0f); bkt = l < 31 ? l : 31; }
    return rel_bias[bkt * 12 + head];
}
template <bool DPART>
DI void attn_phase(const Frame& F, const Args& a) {
    const bf16_t* Z = (const bf16_t*)(a.ws + WS_BIG);
    const bf16_t* Vtg = (const bf16_t*)(a.ws + WS_VT);
    bf16_t* Yo = (bf16_t*)(a.ws + WS_Y);
    float* O1s = (float*)(a.ws + WS_H);
    const unsigned* maskg = (const unsigned*)(a.ws + WS_MASK);
    LAS float* lut = (LAS float*)(F.lds + AT_LUT);
    for (int i = F.tid; i < 12 * AT_LUT_LD; i += NTHR) { const int hh = i / AT_LUT_LD, d = i % AT_LUT_LD - 96; lut[i] = d < 0 ? NEG_INF : rel_bucket_bias(a.rel_bias, d < 128 ? d : 128, hh) * LOG2E; }
    float lam;
    { float d01 = 0.f, d23 = 0.f; for (int i = 0; i < 64; ++i) { d01 += a.diff_lam[i] * a.diff_lam[64 + i]; d23 += a.diff_lam[128 + i] * a.diff_lam[192 + i]; }
      lam = __expf(d01) - __expf(d23) + 0.35550906759096f; lam = __uint_as_float(__builtin_amdgcn_readfirstlane(__float_as_uint(lam))); }
    const float one_m_li = 1.0f - 0.35550906759096f;
    __syncthreads();
    const float c1 = 0.125f * LOG2E;
    const int xcd = F.bid & 7, kk = F.bid >> 3;
    if (DPART)
    for (int it = F.bid; it < 256; it += F.G) {
        const int bh = (F.G == 256) ? 2 * xcd + (kk >> 4) : it >> 4, pr = (F.G == 256) ? (kk & 15) : (it & 15);
        const int b_ = bh >> 2, hd_ = bh & 3;
        for (int half = 0; half < 2; ++half) {
            Frame Fu = F; Fu.lane = fresh_lane();
            int b = b_, hd = hd_; asm volatile("" : "+s"(b), "+s"(hd));
            const int q0 = 256 * (half ? 31 - pr : pr);
            f32x16 O[4];
            attn_core<128, false>(Fu, Z, Vtg, b, Z_QD + 128 * hd, Z_KD + 128 * hd, VT_D + 128 * hd, q0, lut + (8 + hd) * AT_LUT_LD, c1, nullptr, O);
            {
                const int l1 = fresh_lane();
                float* o1p = O1s + (size_t)(b * SEQ + q0 + 32 * F.wave + (l1 & 31)) * 512 + 128 * hd + 4 * (l1 >> 5);
#pragma unroll
                for (int d = 0; d < 4; ++d)
#pragma unroll
                    for (int g = 0; g < 4; ++g) *(f32x4*)(o1p + 32 * d + 8 * g) = (f32x4){O[d][4 * g], O[d][4 * g + 1], O[d][4 * g + 2], O[d][4 * g + 3]};
            }
            Frame Fv = F; Fv.lane = fresh_lane();
            attn_core<128, false>(Fv, Z, Vtg, b, Z_QD + 128 * hd + 64, Z_KD + 128 * hd + 64, VT_D + 128 * hd, q0, lut + (8 + hd) * AT_LUT_LD, c1, nullptr, O);
            {
                const int l1 = fresh_lane();
                const int tq = q0 + 32 * F.wave + (l1 & 31), hh = l1 >> 5;
                const float* o1p = O1s + (size_t)(b * SEQ + tq) * 512 + 128 * hd + 4 * hh;
                float ss = 0.f;
#pragma unroll
                for (int d = 0; d < 4; ++d)
#pragma unroll
                    for (int g = 0; g < 4; ++g) {
                        const f32x4 o1 = *(const f32x4*)(o1p + 32 * d + 8 * g);
#pragma unroll
                        for (int e = 0; e < 4; ++e) { const float v = o1[e] - lam * O[d][4 * g + e]; O[d][4 * g + e] = v; ss += v * v; }
                    }
                ss += __shfl_xor(ss, 32);
                const float rinv = rsqrtf(ss * (1.0f / 128.0f) + EPS) * one_m_li;
                bf16_t* yp = Yo + (size_t)(b * SEQ + tq) * DM + 512 + 128 * hd + 4 * hh;
                const float* gp = a.diff_norm_g + 4 * hh;
#pragma unroll
                for (int d = 0; d < 4; ++d)
#pragma unroll
                    for (int g = 0; g < 4; ++g) {
                        const f32x4 gn = *(const f32x4*)(gp + 32 * d + 8 * g);
                        f32x4 v; v[0] = O[d][4 * g] * rinv * gn[0]; v[1] = O[d][4 * g + 1] * rinv * gn[1]; v[2] = O[d][4 * g + 2] * rinv * gn[2]; v[3] = O[d][4 * g + 3] * rinv * gn[3];
                        *(u32x2*)(yp + 32 * d + 8 * g) = pack4(v);
                    }
            }
        }
    }
    if (!DPART)
    for (int it = F.bid; it < 512; it += F.G) {
        const int rnd = it / F.G;
        const int bh = (F.G == 256) ? 4 * xcd + 2 * rnd + (kk >> 4) : it >> 4, pr = (F.G == 256) ? (kk & 15) : (it & 15);
        const int b_ = bh >> 3, hc_ = bh & 7;
        for (int half = 0; half < 2; ++half) {
            Frame Fu = F; Fu.lane = fresh_lane();
            int b = b_, hc = hc_; asm volatile("" : "+s"(b), "+s"(hc));
            const int q0 = 256 * (half ? 31 - pr : pr);
            f32x16 O[2];
            attn_core<64, true>(Fu, Z, Vtg, b, Z_QC + 64 * hc, Z_KC + 64 * hc, VT_C + 64 * hc, q0, lut + hc * AT_LUT_LD, c1, maskg, O);
            {
                const int l1 = fresh_lane();
                bf16_t* yp = Yo + (size_t)(b * SEQ + q0 + 32 * F.wave + (l1 & 31)) * DM + 64 * hc + 4 * (l1 >> 5);
#pragma unroll
                for (int d = 0; d < 2; ++d)
#pragma unroll
                    for (int g = 0; g < 4; ++g) {
                        f32x4 v = {O[d][4 * g], O[d][4 * g + 1], O[d][4 * g + 2], O[d][4 * g + 3]};
                        *(u32x2*)(yp + 32 * d + 8 * g) = pack4(v);
                    }
            }
        }
    }
}

#ifndef MK_ONE_LAUNCH
#define MK_ONE_LAUNCH 1
#endif
constexpr int NPH = 17;
__global__ void __launch_bounds__(NTHR, 2) fwd_kernel(Args a) {
    extern __shared__ __attribute__((aligned(16))) unsigned char lds_raw[];
    Frame F; F.lds = (LAS unsigned char*)lds_raw; F.tid = threadIdx.x; F.lane = F.tid & 63; F.wave = __builtin_amdgcn_readfirstlane(F.tid >> 6); F.G = gridDim.x; F.bid = blockIdx.x;
    unsigned* ctl = (unsigned*)(a.ws + WS_CTL);
    volatile LAS unsigned* xbw = (volatile LAS unsigned*)(F.lds + LDS_XB);
    if (F.tid < 4) xbw[F.tid] = 0u;
    __syncthreads();
    const int lo = a.ph_lo, hi = a.ph_hi;
    XcdBarrier bar; bar.bar = ctl + CW_BAR; bar.x = 0; bar.st = xbw;
    if (hi - lo > 1) bar = xcd_barrier_post(ctl + CW_BAR, xbw);
#ifndef PH_ONLY
#define IN(k) (lo <= (k) && (k) < hi)
#else
#define IN(k) ((k) == PH_ONLY && lo <= (k) && (k) < hi)
#endif
#ifndef DUP_PH
#define DUP_PH -1
#endif
#define REP(k) for (int rep_ = 0; rep_ < ((k) == DUP_PH ? 2 : 1); ++rep_)
#ifndef TIME_PH
#define TIME_PH -1
#endif
#define TIME_AMP 4
    unsigned long long tp0_ = 0, tp1_ = 0;
    if (TIME_PH == 0) tp0_ = wall_clock64();
#define SEAM(k) do { if (IN(k) && IN((k) + 1)) xcd_barrier(bar); if ((k) == TIME_PH) tp1_ = wall_clock64(); if ((k) + 1 == TIME_PH) tp0_ = wall_clock64(); } while (0)
    float* mod = (float*)(a.ws + WS_MOD);
    bf16_t* hbuf = (bf16_t*)(a.ws + WS_H);
    bf16_t* ybuf = (bf16_t*)(a.ws + WS_Y);
    LAS int* ntp = (LAS int*)(F.lds + LDS_MISC);

    if (IN(0)) REP(0) { p0_prologue(F, a); } SEAM(0);
    if (IN(1)) REP(1) { norm_phase<false, false, false>(F, a, a.x, 0, 0, 0); } SEAM(1);
    if (IN(2)) REP(2) {
        DenseSched S; S.init(NTOK, AB_N, DM, F.G, F.bid, a.ws + WS_WAB_IN);
        EpiAbIn E{(bf16_t*)(a.ws + WS_BIG)};
        pg8::gemm_phase(F.lds, (const char*)hbuf, DM, S, E);
    } SEAM(2);
    if (IN(3)) REP(3) { conv_phase(F, a); } SEAM(3);
    if (IN(4)) REP(4) {
        DenseSched S; S.init(NTOK, DM, DM, F.G, F.bid, a.ws + WS_WAB_OUT);
        EpiResid E{a.x, a.out, mod + 2 * DM};
        pg8::gemm_phase(F.lds, (const char*)ybuf, DM, S, E);
    } SEAM(4);
#define MOE_PHASES(layer, pb) do { \
        const unsigned* cnt = ctl + CW_CNT + (layer) * NEXP * CNT_STRIDE; \
        if (IN(pb)) { route_phase(F, a, (layer)); } SEAM(pb); \
        if (IN((pb) + 1)) REP((pb) + 1) { \
            moe_tile_table(F, cnt, ntp); \
            MoeSched<true> S; S.ntp = ntp; S.cnt = cnt; S.list = (const int*)(a.ws + WS_LIST); S.W = (const char*)(a.ws + WS_MOE_W); S.nU = 4 * ntp[NEXP]; S.G = F.G; S.c = F.bid; \
            EpiMoeUp E{(bf16_t*)(a.ws + WS_ACT)}; \
            pg8::gemm_phase(F.lds, (const char*)hbuf, DM, S, E); \
        } SEAM((pb) + 1); \
        if (IN((pb) + 2)) REP((pb) + 2) { \
            moe_tile_table(F, cnt, ntp); \
            MoeSched<false> S; S.ntp = ntp; S.cnt = cnt; S.list = nullptr; S.W = (const char*)(a.ws + WS_MOE_W); S.nU = 4 * ntp[NEXP]; S.G = F.G; S.c = F.bid; \
            EpiMoeDown E{(bf16_t*)(a.ws + WS_YMOE), (const float*)(a.ws + WS_GATEV), ntp}; \
            pg8::gemm_phase(F.lds, (const char*)(a.ws + WS_ACT), DEXP, S, E); \
        } SEAM((pb) + 2); } while (0)
    MOE_PHASES(0, 5);
    if (IN(8)) {
        norm_phase<true, false, false>(F, a, a.out, 1, 0, 0);
        cvt_run(F, a, 1, CVT_MOE_TILES);
    } SEAM(8);
    if (IN(9)) REP(9) {
        { DenseSched S; S.init(NTOK, CD_N, DM, F.G, F.bid, a.ws + WS_WCD_IN);
          EpiPlain E{(bf16_t*)(a.ws + WS_BIG), CD_N};
          pg8::gemm_phase(F.lds, (const char*)hbuf, DM, S, E); }
        __syncthreads();
        { DenseSched S; S.init(1024, NTOK, DM, F.G, F.bid, hbuf);
          EpiPlain E{(bf16_t*)(a.ws + WS_VT), NTOK};
          pg8::gemm_phase(F.lds, (const char*)(a.ws + WS_WCD_IN + (size_t)CD_N * DM * 2), DM, S, E); }
    } SEAM(9);
    if (IN(10)) REP(10) { unsigned long long tacc_ = 0; topk_phase(F, a, tacc_); if (TIME_PH > 100 && TIME_PH < 110) { tp0_ = 0; tp1_ = tacc_; } } SEAM(10);
    if (IN(11)) REP(11) { if (TIME_PH == 111) { __syncthreads(); tp0_ = wall_clock64(); } attn_phase<true>(F, a); __syncthreads(); if (TIME_PH == 111) tp1_ = wall_clock64(); if (TIME_PH == 112) tp0_ = wall_clock64(); attn_phase<false>(F, a); if (TIME_PH == 112) { __syncthreads(); tp1_ = wall_clock64(); } } SEAM(11);
    if (IN(12)) {
        DenseSched S; S.init(NTOK, DM, DM, F.G, F.bid, a.ws + WS_WCD_OUT);
        EpiResid E{a.out, a.out, mod + (size_t)NB * 6 * DM + 2 * DM};
        pg8::gemm_phase(F.lds, (const char*)ybuf, DM, S, E);
    } SEAM(12);
    MOE_PHASES(1, 13);
#undef MOE_PHASES
    if (IN(16)) { norm_phase<true, false, true>(F, a, a.out, 1, 0, 1); }
    if (TIME_PH >= 0) {
        if (TIME_PH == 16) { asm volatile("s_waitcnt vmcnt(0)" ::: "memory"); __syncthreads(); tp1_ = wall_clock64(); }
        if (F.bid == 0 && F.tid == 0) { const unsigned long long te = wall_clock64(), dt = (tp1_ - tp0_) * TIME_AMP; while (wall_clock64() - te < dt) __builtin_amdgcn_s_sleep(8); }
    }
#undef IN
#undef SEAM
}

extern "C" void kernel_launch(void* const* d_in, const int* in_sizes, int n_in, void* d_out, int out_size, void* d_ws, size_t ws_size, hipStream_t stream) {
    static int grid = 0;
    if (grid == 0) {
        if (n_in != 26 || out_size != NTOK * DM || ws_size < WS_END) { fprintf(stderr, "kernel_launch: unexpected problem (n_in %d, out %d, ws %zu < %zu)\n", n_in, out_size, ws_size, (size_t)WS_END); grid = -1; return; }
        int dev = 0, cus = 0, per_cu = 0;
        if (hipGetDevice(&dev) != hipSuccess || hipDeviceGetAttribute(&cus, hipDeviceAttributeMultiprocessorCount, dev) != hipSuccess) { grid = -1; return; }
        if (hipFuncSetAttribute((const void*)fwd_kernel, hipFuncAttributeMaxDynamicSharedMemorySize, LDS_BYTES) != hipSuccess) { fprintf(stderr, "kernel_launch: hipFuncSetAttribute failed\n"); grid = -1; return; }
        if (hipOccupancyMaxActiveBlocksPerMultiprocessor(&per_cu, (const void*)fwd_kernel, NTHR, LDS_BYTES) != hipSuccess || per_cu < 1) { fprintf(stderr, "kernel_launch: occupancy query says %d\n", per_cu); }
        (void)hipGetLastError();
        grid = cus;
    }
    if (grid < 0) return;
    (void)hipMemsetAsync((char*)d_ws + WS_CTL, 0, CTL_BYTES, stream);
    Args a{};
    const float** fp = (const float**)&a.x;
    (void)fp;
    a.x = (const float*)d_in[0]; a.c = (const float*)d_in[1]; a.positions = (const int*)d_in[2]; a.rel_bias = (const float*)d_in[3]; a.norm_g = (const float*)d_in[4];
    a.final_norm_g = (const float*)d_in[5]; a.ada_w = (const float*)d_in[6]; a.ada_b = (const float*)d_in[7]; a.ab_w_in = (const float*)d_in[8]; a.ab_conv_a = (const float*)d_in[9];
    a.ab_conv_b = (const float*)d_in[10]; a.ab_conv_b_bias = (const float*)d_in[11]; a.ab_ln_g = (const float*)d_in[12]; a.ab_ln_b = (const float*)d_in[13]; a.ab_w_out = (const float*)d_in[14];
    a.cd_w_in = (const float*)d_in[15]; a.diff_lam = (const float*)d_in[16]; a.diff_norm_g = (const float*)d_in[17]; a.cd_w_out = (const float*)d_in[18];
    a.moe_wr_g = (const float*)d_in[19]; a.moe_br_g = (const float*)d_in[20]; a.moe_wr_e = (const float*)d_in[21]; a.moe_br_e = (const float*)d_in[22];
    a.moe_w_gate = (const float*)d_in[23]; a.moe_w_up = (const float*)d_in[24]; a.moe_w_down = (const float*)d_in[25];
    a.out = (float*)d_out; a.ws = (unsigned char*)d_ws;
#if MK_ONE_LAUNCH
    a.ph_lo = 0; a.ph_hi = NPH;
    hipLaunchKernelGGL(fwd_kernel, dim3(grid), dim3(NTHR), LDS_BYTES, stream, a);
#else
    for (int p = 0; p < NPH; ++p) { a.ph_lo = p; a.ph_hi = p + 1; hipLaunchKernelGGL(fwd_kernel, dim3(grid), dim3(NTHR), LDS_BYTES, stream, a); }
#endif
}
```

```cpp
#include <hip/hip_runtime.h>
#include <cstdio>
#include <cstdint>

#ifndef TIME_PH
#define TIME_PH -1
#endif
#define LAS __attribute__((address_space(3)))
#define DI __device__ __forceinline__
typedef unsigned short bf16_t;
typedef short bf16x8 __attribute__((ext_vector_type(8)));
typedef short s16x4 __attribute__((ext_vector_type(4)));
typedef float f32x2 __attribute__((ext_vector_type(2)));
typedef float f32x4 __attribute__((ext_vector_type(4)));
typedef float f32x16 __attribute__((ext_vector_type(16)));
typedef unsigned u32x2 __attribute__((ext_vector_type(2)));
typedef unsigned u32x4 __attribute__((ext_vector_type(4)));
typedef __bf16 bf16v2 __attribute__((ext_vector_type(2)));

constexpr int NB = 4, SEQ = 8192, DM = 1024, NTOK = NB * SEQ;
constexpr int NTHR = 512, NWAVE = 8;
constexpr int AB_N = 2560;
constexpr int ZC_N = 1536;
constexpr int CD_SRC_N = 3368;
constexpr int CD_N = 2560;
constexpr int Z_QC = 0, Z_KC = 512, Z_QD = 1024, Z_KD = 1536, Z_QI = 2048, Z_KI = 2304, Z_WI = 2336;
constexpr int VT_C = 0, VT_D = 512;
constexpr int NEXP = 32, DEXP = 512;
constexpr int MOE_ROWS = 2 * NTOK + NEXP * 256;
constexpr float EPS = 1e-6f;
constexpr float LOG2E = 1.4426950408889634f;

constexpr size_t MiB = 1u << 20;
constexpr size_t WS_CTL = 0, CTL_BYTES = 64 * 1024;
constexpr size_t WS_MOD = 1 * MiB;
constexpr size_t WS_WAB_IN = 2 * MiB;
constexpr size_t WS_WAB_OUT = 7 * MiB;
constexpr size_t WS_WCD_IN = 9 * MiB;
constexpr size_t WS_WCD_OUT = 16 * MiB;
constexpr size_t WS_MOE_W = 18 * MiB;
constexpr size_t WS_H = 114 * MiB;
constexpr size_t WS_Y = 178 * MiB;
constexpr size_t WS_BIG = 242 * MiB;
constexpr size_t WS_ACT = WS_BIG;
constexpr size_t WS_YMOE = WS_BIG + 72 * MiB;
constexpr size_t WS_VT = WS_BIG + 160 * MiB;
constexpr size_t WS_MASK = 466 * MiB;
constexpr size_t WS_LIST = 498 * MiB;
constexpr size_t WS_GATEV = 502 * MiB;
constexpr size_t WS_TOKSLOT = 506 * MiB;
constexpr size_t WS_END = 507 * MiB;

constexpr int CW_BAR = 0;
constexpr int CW_CNT = 4096;
constexpr int CNT_STRIDE = 64;

DI unsigned pack_bf16(float lo, float hi) { f32x2 v = {lo, hi}; bf16v2 b = __builtin_convertvector(v, bf16v2); return __builtin_bit_cast(unsigned, b); }
DI float bf_lo(unsigned w) { return __uint_as_float(w << 16); }
DI float bf_hi(unsigned w) { return __uint_as_float(w & 0xffff0000u); }
DI float bf2f(bf16_t b) { return __uint_as_float(((unsigned)b) << 16); }
DI float wave_sum(float v) {
#pragma unroll
    for (int o = 32; o >= 1; o >>= 1) v += __shfl_xor(v, o);
    return v;
}
DI int fresh_lane() { int l; asm volatile("v_mbcnt_lo_u32_b32 %0, -1, 0\n\tv_mbcnt_hi_u32_b32 %0, -1, %0" : "=v"(l)); return l; }
DI float silu_f(float v) { return v / (1.0f + __expf(-v)); }
DI float sigmoid_f(float v) { return 1.0f / (1.0f + __expf(-v)); }

#define XB_TMO      128
#define XB_XCNT(j)  (256  + 64 * (j))
#define XB_XSUB(j)  (1280 + 64 * (j))
#define XB_XGEN(j)  (2304 + 64 * (j))
#define XB_TOP      3328
#define XB_TOPGEN   3392
#define XCD_BAR_WORDS 3456
#define XB_SPIN_CAP (1u << 22)
DI unsigned xb_ld(unsigned* p)              { return __hip_atomic_load(p, __ATOMIC_RELAXED, __HIP_MEMORY_SCOPE_AGENT); }
DI unsigned xb_add(unsigned* p, unsigned v) { return __hip_atomic_fetch_add(p, v, __ATOMIC_RELAXED, __HIP_MEMORY_SCOPE_AGENT); }
DI unsigned xb_xcc_id() { return (unsigned)__builtin_amdgcn_s_getreg((3 << 11) | 20) & 0xFu; }
#define XB_SPIN(cond, bar) do { unsigned _sp = 0; while (cond) { __builtin_amdgcn_s_sleep(1); \
    if ((++_sp & 255u) == 0u) { if (xb_ld(&(bar)[XB_TMO])) break; if (_sp > XB_SPIN_CAP) { atomicAdd(&(bar)[XB_TMO], 1u); break; } } } } while (0)
struct XcdBarrier { unsigned* bar; unsigned x; volatile LAS unsigned* st; };
DI XcdBarrier xcd_barrier_post(unsigned* bar, volatile LAS unsigned* st) {
    XcdBarrier b; b.bar = bar; b.x = xb_xcc_id(); b.st = st;
    if (threadIdx.x == 0) (void)xb_add(&bar[XB_XCNT(b.x)], 1u);
    return b;
}
DI void xcd_barrier_complete(unsigned* bar, unsigned x, unsigned& nloc, unsigned& nx) {
    const unsigned G = gridDim.x * gridDim.y * gridDim.z;
    unsigned sum, cnt, mine, sp = 0u;
    for (;;) {
        sum = 0u; cnt = 0u; mine = 0u;
#pragma unroll
        for (unsigned j = 0; j < 16; ++j) { const unsigned c = xb_ld(&bar[XB_XCNT(j)]); sum += c; cnt += (c > 0u) ? 1u : 0u; mine = (j == x) ? c : mine; }
        if (sum == G) break;
        __builtin_amdgcn_s_sleep(1);
        if ((++sp & 255u) == 0u) { if (xb_ld(&bar[XB_TMO])) break; if (sp > XB_SPIN_CAP) { atomicAdd(&bar[XB_TMO], 1u); break; } }
    }
    nloc = mine > 0u ? mine : 1u; nx = cnt > 0u ? cnt : 1u;
}
DI void xcd_barrier(const XcdBarrier& b) {
    asm volatile("s_waitcnt vmcnt(0)" ::: "memory");
    __syncthreads();
    if (threadIdx.x == 0) {
        unsigned* bar = b.bar;
        __builtin_amdgcn_s_waitcnt(0);
        unsigned nloc = b.st[0], nx = b.st[1];
        if (nloc == 0u) { xcd_barrier_complete(bar, b.x, nloc, nx); b.st[0] = nloc; b.st[1] = nx; }
        const unsigned old = xb_add(&bar[XB_XSUB(b.x)], 1u);
        const unsigned gen = old / nloc;
        if (old + 1u == (gen + 1u) * nloc) {
            __builtin_amdgcn_fence(__ATOMIC_RELEASE, "agent");
            asm volatile("s_waitcnt vmcnt(0)" ::: "memory");
            const unsigned og = xb_add(&bar[XB_TOP], 1u);
            const unsigned tg = og / nx;
            if (og + 1u == (tg + 1u) * nx) xb_add(&bar[XB_TOPGEN], 1u);
            else XB_SPIN(xb_ld(&bar[XB_TOPGEN]) == tg, bar);
            __builtin_amdgcn_fence(__ATOMIC_ACQUIRE, "agent");
            xb_add(&bar[XB_XGEN(b.x)], 1u);
            asm volatile("s_waitcnt vmcnt(0)" ::: "memory");
        } else {
            XB_SPIN(xb_ld(&bar[XB_XGEN(b.x)]) == gen, bar);
            __builtin_amdgcn_fence(__ATOMIC_ACQUIRE, "agent");
            asm volatile("s_waitcnt vmcnt(0)" ::: "memory");
        }
    }
    __syncthreads();
}

namespace pg8 {
constexpr int BM = 256, BK = 64, HALF = 128, HTB = HALF * BK * 2, STAGE_BYTES = 8 * HTB;
DI int lds_byte(int r, int c) { const int st = (r >> 4) * 2 + (c >> 5), rr = r & 15, cc = c & 31, ob = rr * 64 + cc * 2; return st * 1024 + (ob ^ (((ob >> 9) & 1) << 5)); }
DI void stage_rc(int b, int& R, int& C) { const int st = b / 1024, sb = b % 1024, swz = sb ^ (((sb >> 9) & 1) << 5); R = (st >> 1) * 16 + swz / 64; C = (st & 1) * 32 + (swz % 64) / 2; }
struct Unit { int pm, pn, e, nrow; };

template <class Epi, class Sched>
DI void gemm_phase(LAS unsigned char* lds, const char* Abase, const int K, const Sched& S, const Epi& E) {
    const int tid = threadIdx.x, wid = __builtin_amdgcn_readfirstlane(tid >> 6), lane = tid & 63, wr = wid >> 2, wc = wid & 3, fr = lane & 15, fq = lane >> 4;
    const int nt = K / BK;
    int Rr[2], Cc[2]; unsigned voffB[2];
#pragma unroll
    for (int i = 0; i < 2; ++i) { int R, C; stage_rc(tid * 16 + i * 8192, R, C); Rr[i] = R; Cc[i] = C; voffB[i] = (unsigned)(R * K + C) * 2u; }
    const size_t kstep = (size_t)(BK * 2);
    const size_t hstep = (size_t)HALF * K * 2;
    const unsigned ldsw = (unsigned)wid * 1024u;
    const int aoff = lds_byte(wr * 64 + fr, fq * 8), boff = lds_byte(wc * 32 + fr, fq * 8);
#define PG8_SA(b, h) (((b) * 2 + (h)) * HTB)
#define PG8_SB(b, h) ((4 + (b) * 2 + (h)) * HTB)
#define PG8_STAGE(bufoff, gbase, voff) do { _Pragma("unroll") for (int _i = 0; _i < 2; ++_i) \
        __builtin_amdgcn_global_load_lds((const unsigned*)((const char*)(gbase) + (voff)[_i]), (LAS unsigned*)(lds + (bufoff) + ldsw + _i * 8192), 16, 0, 0); } while (0)
#define PG8_AOFF(dst, u) do { _Pragma("unroll") for (int _h = 0; _h < 2; ++_h) _Pragma("unroll") for (int _i = 0; _i < 2; ++_i) \
        dst[_h][_i] = ((unsigned)S.a_row(u, _h * HALF + Rr[_i]) * (unsigned)K + (unsigned)Cc[_i]) * 2u; } while (0)
#define PG8_LDA(dst, b, h) do { _Pragma("unroll") for (int m = 0; m < 4; ++m) _Pragma("unroll") for (int k = 0; k < 2; ++k) dst[m][k] = *(const LAS bf16x8*)(lds + PG8_SA(b, h) + aoff + m * 2048 + k * 1024); } while (0)
#define PG8_LDB(dst, b, h) do { _Pragma("unroll") for (int n = 0; n < 2; ++n) _Pragma("unroll") for (int k = 0; k < 2; ++k) dst[n][k] = *(const LAS bf16x8*)(lds + PG8_SB(b, h) + boff + n * 2048 + k * 1024); } while (0)
#define PG8_MMA(ai, bj, At, Bt) do { __builtin_amdgcn_s_setprio(1); _Pragma("unroll") for (int m = 0; m < 4; ++m) _Pragma("unroll") for (int n = 0; n < 2; ++n) _Pragma("unroll") for (int k = 0; k < 2; ++k) \
        acc[ai][bj][m][n] = __builtin_amdgcn_mfma_f32_16x16x32_bf16(Bt[n][k], At[m][k], acc[ai][bj][m][n], 0, 0, 0); __builtin_amdgcn_s_setprio(0); } while (0)
#define PG8_WAIT_V(n) asm volatile("s_waitcnt vmcnt(" #n ")" ::: "memory")
#define PG8_WAIT_L(n) asm volatile("s_waitcnt lgkmcnt(" #n ")" ::: "memory")
#define PG8_BAR __builtin_amdgcn_s_barrier()
#define PG8_SCHED __builtin_amdgcn_sched_barrier(0)
    Unit cur, nxt; int ui = 0;
    if (!S.next(0, cur)) return;
    f32x4 acc[2][2][4][2];
#pragma unroll
    for (int a = 0; a < 2; ++a)
#pragma unroll
        for (int b = 0; b < 2; ++b)
#pragma unroll
            for (int m = 0; m < 4; ++m)
#pragma unroll
                for (int n = 0; n < 2; ++n) acc[a][b][m][n] = (f32x4){0.f, 0.f, 0.f, 0.f};
    bf16x8 At[4][2], B0[2][2], B1[2][2];
    unsigned aoC[2][2], aoN[2][2];
    PG8_AOFF(aoC, cur);
    const char* cB = S.b_base(cur);
    PG8_STAGE(PG8_SB(0, 0), cB, voffB); PG8_STAGE(PG8_SA(0, 0), Abase, aoC[0]); PG8_STAGE(PG8_SB(0, 1), cB + hstep, voffB); PG8_STAGE(PG8_SA(0, 1), Abase, aoC[1]);
    if (wr == 1) PG8_BAR;
    PG8_WAIT_V(4); PG8_BAR;
    PG8_STAGE(PG8_SB(1, 0), cB + kstep, voffB); PG8_STAGE(PG8_SA(1, 0), Abase + kstep, aoC[0]); PG8_STAGE(PG8_SB(1, 1), cB + hstep + kstep, voffB);
    PG8_WAIT_V(6); PG8_BAR;
    for (;;) {
        const bool has_next = S.next(ui + 1, nxt);
        const char* nB = cB;
#pragma unroll
        for (int _h = 0; _h < 2; ++_h)
#pragma unroll
            for (int _i = 0; _i < 2; ++_i) aoN[_h][_i] = aoC[_h][_i];
        if (has_next) { PG8_AOFF(aoN, nxt); nB = S.b_base(nxt); }
        for (int t = 0; t < nt; t += 2) {
            const bool last = (t == nt - 2);
            const char* a1 = Abase + (size_t)(t + 1) * kstep;
            const char* a2 = last ? Abase : Abase + (size_t)(t + 2) * kstep; const char* b2 = last ? nB : cB + (size_t)(t + 2) * kstep;
            const char* a3 = a2 + kstep; const char* b3 = b2 + kstep;
            unsigned ao2[2][2];
#pragma unroll
            for (int _h = 0; _h < 2; ++_h)
#pragma unroll
                for (int _i = 0; _i < 2; ++_i) ao2[_h][_i] = last ? aoN[_h][_i] : aoC[_h][_i];
            PG8_LDB(B0, 0, 0); PG8_SCHED; PG8_LDA(At, 0, 0); PG8_STAGE(PG8_SA(1, 1), a1, aoC[1]);
            PG8_WAIT_L(8); PG8_BAR; PG8_WAIT_L(0); PG8_MMA(0, 0, At, B0); PG8_BAR; PG8_SCHED;
            PG8_LDB(B1, 0, 1); PG8_STAGE(PG8_SB(0, 0), b2, voffB);
            PG8_BAR; PG8_WAIT_L(0); PG8_MMA(0, 1, At, B1); PG8_BAR;
            PG8_LDA(At, 0, 1); PG8_STAGE(PG8_SA(0, 0), a2, ao2[0]);
            PG8_BAR; PG8_WAIT_L(0); PG8_MMA(1, 0, At, B0); PG8_BAR; PG8_SCHED;
            PG8_STAGE(PG8_SB(0, 1), b2 + hstep, voffB);
            PG8_WAIT_V(6); PG8_BAR; PG8_MMA(1, 1, At, B1); PG8_BAR;
            PG8_LDB(B0, 1, 0); PG8_SCHED; PG8_LDA(At, 1, 0); PG8_STAGE(PG8_SA(0, 1), a2, ao2[1]);
            PG8_WAIT_L(8); PG8_BAR; PG8_WAIT_L(0); PG8_MMA(0, 0, At, B0); PG8_BAR; PG8_SCHED;
            PG8_LDB(B1, 1, 1); PG8_STAGE(PG8_SB(1, 0), b3, voffB);
            PG8_BAR; PG8_WAIT_L(0); PG8_MMA(0, 1, At, B1); PG8_BAR;
            PG8_LDA(At, 1, 1); PG8_STAGE(PG8_SA(1, 0), a3, ao2[0]);
            PG8_BAR; PG8_WAIT_L(0); PG8_MMA(1, 0, At, B0); PG8_BAR; PG8_SCHED;
            PG8_STAGE(PG8_SB(1, 1), b3 + hstep, voffB);
            PG8_WAIT_V(6); PG8_BAR; PG8_MMA(1, 1, At, B1); PG8_BAR;
        }
        E(acc, cur, wr, wc, fr, fq);
        if (!has_next) break;
#pragma unroll
        for (int a = 0; a < 2; ++a)
#pragma unroll
            for (int b = 0; b < 2; ++b)
#pragma unroll
                for (int m = 0; m < 4; ++m)
#pragma unroll
                    for (int n = 0; n < 2; ++n) acc[a][b][m][n] = (f32x4){0.f, 0.f, 0.f, 0.f};
        cur = nxt; cB = nB; ++ui;
#pragma unroll
        for (int _h = 0; _h < 2; ++_h)
#pragma unroll
            for (int _i = 0; _i < 2; ++_i) aoC[_h][_i] = aoN[_h][_i];
    }
    PG8_WAIT_V(0);
    if (wr == 0) PG8_BAR;
    PG8_BAR;
#undef PG8_SA
#undef PG8_SB
#undef PG8_STAGE
#undef PG8_AOFF
#undef PG8_LDA
#undef PG8_LDB
#undef PG8_MMA
#undef PG8_WAIT_V
#undef PG8_WAIT_L
#undef PG8_BAR
#undef PG8_SCHED
}
}

struct Args {
    const float* x; const float* c; const int* positions; const float* rel_bias; const float* norm_g; const float* final_norm_g;
    const float* ada_w; const float* ada_b; const float* ab_w_in; const float* ab_conv_a; const float* ab_conv_b; const float* ab_conv_b_bias;
    const float* ab_ln_g; const float* ab_ln_b; const float* ab_w_out; const float* cd_w_in; const float* diff_lam; const float* diff_norm_g;
    const float* cd_w_out; const float* moe_wr_g; const float* moe_br_g; const float* moe_wr_e; const float* moe_br_e;
    const float* moe_w_gate; const float* moe_w_up; const float* moe_w_down;
    float* out; unsigned char* ws; int ph_lo, ph_hi;
};
struct Frame {
    LAS unsigned char* lds; int tid, lane, wave, G, bid;
};

struct RowSrc { const float* p; int ld; };
DI void ilv(int rp, int& j, int& second) { const int g = rp >> 5, i = rp & 31; j = 16 * g + (i & 15); second = i >> 4; }

enum { CV_AB_IN = 0, CV_AB_OUT = 1, CV_CD_IN = 2, CV_CD_OUT = 3, CV_MOE_GU = 4, CV_MOE_D = 5 };
template <int KIND> DI RowSrc row_src(const Args& a, int layer, int e, int r) {
    RowSrc s; s.p = nullptr; s.ld = 0;
    if (KIND == CV_AB_IN) {
        s.ld = AB_N;
        if (r < 512) s.p = a.ab_w_in + r;
        else if (r < 1536) { int j, sec; ilv(r - 512, j, sec); s.p = a.ab_w_in + (sec ? 1024 + j : 512 + j); }
        else { int j, sec; ilv(r - 1536, j, sec); s.p = a.ab_w_in + (sec ? 2048 + j : 1536 + j); }
    } else if (KIND == CV_AB_OUT) { s.ld = DM; s.p = a.ab_w_out + r; }
    else if (KIND == CV_CD_IN) {
        s.ld = CD_SRC_N;
        int col = -1;
        if (r < 1024) col = r;
        else if (r < 2048) col = 1832 + (r - 1024);
        else if (r < 2304) col = 1536 + (r - 2048);
        else if (r < 2336) col = 1792 + (r - 2304);
        else if (r < 2344) col = 1824 + (r - 2336);
        else if (r < 2560) col = -1;
        else if (r < 3072) col = 1024 + (r - 2560);
        else col = 2856 + (r - 3072);
        if (col >= 0) s.p = a.cd_w_in + col;
    } else if (KIND == CV_CD_OUT) { s.ld = DM; s.p = a.cd_w_out + r; }
    else if (KIND == CV_MOE_GU) {
        int j, sec; ilv(r, j, sec); s.ld = DEXP;
        const size_t base = ((size_t)layer * NEXP + e) * (size_t)DM * DEXP;
        s.p = (sec ? a.moe_w_up : a.moe_w_gate) + base + j;
    } else {
        s.ld = DM; s.p = a.moe_w_down + ((size_t)layer * NEXP + e) * (size_t)DEXP * DM + r;
    }
    return s;
}
constexpr int CV_LD = 258;
struct CvtTile { const float* sp; int ld; bf16_t* dst; int K, r0, k0; };
template <int KIND> DI CvtTile cvt_desc(const Frame& F, const Args& a, bf16_t* dst, int K, int r0, int k0, int layer, int e) {
    const RowSrc s = row_src<KIND>(a, layer, e, r0 + 4 * (F.tid & 15));
    CvtTile t; t.sp = s.p; t.ld = s.ld; t.dst = dst; t.K = K; t.r0 = r0; t.k0 = k0; return t;
}
constexpr int CVT_DENSE_TILES = (AB_N + DM + CD_N + 1024 + DM) / 64 * (DM / 256);
constexpr int CVT_MOE_TILES_PER_EXP = (1024 / 64) * (1024 / 256) + (1024 / 64) * (512 / 256);
constexpr int CVT_MOE_TILES = NEXP * CVT_MOE_TILES_PER_EXP;
DI CvtTile cvt_dense_desc(const Frame& F, const Args& a, int item) {
    const int rt = item >> 2, kt = item & 3;
    int r = rt * 64;
    if (r < AB_N) return cvt_desc<CV_AB_IN>(F, a, (bf16_t*)(a.ws + WS_WAB_IN), DM, r, kt * 256, 0, 0);
    r -= AB_N;
    if (r < DM) return cvt_desc<CV_AB_OUT>(F, a, (bf16_t*)(a.ws + WS_WAB_OUT), DM, r, kt * 256, 0, 0);
    r -= DM;
    if (r < CD_N + 1024) return cvt_desc<CV_CD_IN>(F, a, (bf16_t*)(a.ws + WS_WCD_IN), DM, r, kt * 256, 0, 0);
    r -= CD_N + 1024;
    return cvt_desc<CV_CD_OUT>(F, a, (bf16_t*)(a.ws + WS_WCD_OUT), DM, r, kt * 256, 0, 0);
}
DI CvtTile cvt_moe_desc(const Frame& F, const Args& a, int layer, int item) {
    const int e = item / CVT_MOE_TILES_PER_EXP, t = item % CVT_MOE_TILES_PER_EXP;
    bf16_t* base = (bf16_t*)(a.ws + WS_MOE_W + (size_t)e * 3 * MiB);
    if (t < 64) return cvt_desc<CV_MOE_GU>(F, a, base, DM, (t >> 2) * 64, (t & 3) * 256, layer, e);
    const int t2 = t - 64; return cvt_desc<CV_MOE_D>(F, a, base + (size_t)DM * DM, DEXP, (t2 >> 1) * 64, (t2 & 1) * 256, layer, e);
}
DI void cvt_load(const Frame& F, const CvtTile& t, f32x4 (&v)[8]) {
#pragma unroll
    for (int it = 0; it < 8; ++it) {
        const int kk = (F.tid >> 4) + 32 * it;
        v[it] = (f32x4){0.f, 0.f, 0.f, 0.f};
        if (t.sp) v[it] = *(const f32x4*)(t.sp + (size_t)(t.k0 + kk) * t.ld);
    }
}
DI void cvt_store(const Frame& F, const CvtTile& t, const f32x4 (&v)[8]) {
    LAS bf16_t* T = (LAS bf16_t*)F.lds;
    const int c4 = F.tid & 15;
#pragma unroll
    for (int it = 0; it < 8; ++it) {
        const int kk = (F.tid >> 4) + 32 * it;
        const unsigned p01 = pack_bf16(v[it][0], v[it][1]), p23 = pack_bf16(v[it][2], v[it][3]);
        T[(4 * c4 + 0) * CV_LD + kk] = (bf16_t)(p01 & 0xffffu); T[(4 * c4 + 1) * CV_LD + kk] = (bf16_t)(p01 >> 16);
        T[(4 * c4 + 2) * CV_LD + kk] = (bf16_t)(p23 & 0xffffu); T[(4 * c4 + 3) * CV_LD + kk] = (bf16_t)(p23 >> 16);
    }
    __syncthreads();
    {
        const int rr = F.tid >> 3, c = F.tid & 7;
#pragma unroll
        for (int j = 0; j < 4; ++j) {
            const LAS unsigned* src = (const LAS unsigned*)(T + rr * CV_LD + 64 * j + c * 8);
            u32x4 w; w[0] = src[0]; w[1] = src[1]; w[2] = src[2]; w[3] = src[3];
            *(u32x4*)(t.dst + (size_t)(t.r0 + rr) * t.K + t.k0 + 64 * j + c * 8) = w;
        }
    }
    __syncthreads();
}
DI CvtTile cvt_any_desc(const Frame& F, const Args& a, int which, int item) {
    if (which == 0) { if (item < CVT_DENSE_TILES) return cvt_dense_desc(F, a, item); return cvt_moe_desc(F, a, 0, item - CVT_DENSE_TILES); }
    return cvt_moe_desc(F, a, 1, item);
}
DI void cvt_run(const Frame& F, const Args& a, int which, int n_items) {
    int it = F.bid;
    if (it >= n_items) return;
    CvtTile t0 = cvt_any_desc(F, a, which, it), t1 = t0, t2 = t0;
    f32x4 v0[8], v1[8], v2[8];
    cvt_load(F, t0, v0);
    bool h1 = it + F.G < n_items, h2 = it + 2 * F.G < n_items;
    if (h1) { t1 = cvt_any_desc(F, a, which, it + F.G); cvt_load(F, t1, v1); }
    for (;;) {
        h2 = it + 2 * F.G < n_items;
        if (h2) { t2 = cvt_any_desc(F, a, which, it + 2 * F.G); cvt_load(F, t2, v2); }
        cvt_store(F, t0, v0);
        if (!h1) break;
        it += F.G; t0 = t1; t1 = t2; h1 = h2;
#pragma unroll
        for (int i = 0; i < 8; ++i) { v0[i] = v1[i]; v1[i] = v2[i]; }
    }
}
DI void mod_item(const Frame& F, const Args& a, int item) {
    LAS float* sc = (LAS float*)F.lds;
    LAS float* part = (LAS float*)(F.lds + 16384);
    for (int i = F.tid; i < NB * DM; i += NTHR) sc[i] = silu_f(a.c[i]);
    __syncthreads();
    const int l = item / 96, j = (item % 96) * 64 + F.lane;
    const float* w = a.ada_w + (size_t)l * DM * 6 * DM + (size_t)(F.wave * 128) * 6 * DM + j;
    float acc[NB] = {0.f, 0.f, 0.f, 0.f};
#pragma unroll 8
    for (int k = 0; k < 128; ++k) {
        const float wv = w[(size_t)k * 6 * DM];
#pragma unroll
        for (int b = 0; b < NB; ++b) acc[b] += sc[b * DM + F.wave * 128 + k] * wv;
    }
#pragma unroll
    for (int b = 0; b < NB; ++b) part[(F.wave * NB + b) * 64 + F.lane] = acc[b];
    __syncthreads();
    if (F.tid < NB * 64) {
        const int b = F.tid >> 6, c = F.tid & 63;
        float sum = 0.f;
#pragma unroll
        for (int wv = 0; wv < NWAVE; ++wv) sum += part[(wv * NB + b) * 64 + c];
        const int jj = (item % 96) * 64 + c;
        float* mod = (float*)(a.ws + WS_MOD);
        mod[((size_t)l * NB + b) * 6 * DM + jj] = sum + a.ada_b[l * 6 * DM + jj];
    }
    __syncthreads();
}
DI void p0_prologue(const Frame& F, const Args& a) {
    for (int it = F.bid; it < 192; it += F.G) mod_item(F, a, it);
    cvt_run(F, a, 0, CVT_DENSE_TILES + CVT_MOE_TILES);
}

constexpr int WR_LD = 1028;
DI void moe_seg_table(const Frame& F, const unsigned* cnt, LAS int* seg  ) {
    if (F.tid < NEXP) seg[40 + F.tid] = (int)cnt[F.tid * CNT_STRIDE];
    __syncthreads();
    if (F.tid == 0) { int s = 0; for (int e = 0; e < NEXP; ++e) { seg[e] = s; s += ((seg[40 + e] + 255) >> 8) << 8; } seg[NEXP] = s; }
    __syncthreads();
}
template <bool COMBINE, bool ROUTE, bool FINAL>
DI void norm_phase(const Frame& F, const Args& a, const float* xsrc, int layer, int which, int layer_c) {
    const float* mod = (const float*)(a.ws + WS_MOD);
    bf16_t* hbuf = (bf16_t*)(a.ws + WS_H);
    unsigned* ctl = (unsigned*)(a.ws + WS_CTL);
    LAS float* wrT = (LAS float*)F.lds;
    LAS float* brs = (LAS float*)(F.lds + 36 * WR_LD * 4);
    LAS int* seg = (LAS int*)F.lds;
    constexpr int RT_CAP = 512;
    LAS int* rcnt = (LAS int*)(F.lds + 149504);
    LAS int* rbase = (LAS int*)(F.lds + 149632);
    LAS int* rt_er = (LAS int*)(F.lds + 149760);
    LAS float* rt_gate = (LAS float*)(F.lds + 149760 + 4096);
    LAS int* rt_tok = (LAS int*)(F.lds + 149760 + 8192);
    if (ROUTE) {
        const float* wg = a.moe_wr_g + (size_t)layer * DM * 4;
        const float* we = a.moe_wr_e + (size_t)layer * DM * 32;
        for (int i = F.tid; i < DM * 4; i += NTHR) { const int k = i >> 2, j = i & 3; wrT[j * WR_LD + k] = wg[i]; }
        for (int i = F.tid; i < DM * 32; i += NTHR) { const int k = i >> 5, j = i & 31; wrT[(4 + j) * WR_LD + k] = we[i]; }
        if (F.tid < NEXP) rcnt[F.tid] = 0;
        for (int i = F.tid; i < 2 * RT_CAP; i += NTHR) rt_er[i] = -1;
        if (F.tid < 4) brs[F.tid] = a.moe_br_g[layer * 4 + F.tid];
        else if (F.tid < 36) brs[F.tid] = a.moe_br_e[layer * 32 + F.tid - 4];
        __syncthreads();
    }
    if (COMBINE) moe_seg_table(F, ctl + CW_CNT + layer_c * NEXP * CNT_STRIDE, seg);
    const bf16_t* ymoe = (const bf16_t*)(a.ws + WS_YMOE);
    const int* tokslot = (const int*)(a.ws + WS_TOKSLOT);
    constexpr int TPW = ROUTE ? 2 : 4;
    for (int tb = (F.bid * NWAVE + F.wave) * TPW; tb < NTOK; tb += F.G * NWAVE * TPW) {
      const int b = tb / SEQ;
      f32x4 xall[TPW][4];
#pragma unroll
      for (int i = 0; i < TPW; ++i)
#pragma unroll
        for (int c = 0; c < 4; ++c) xall[i][c] = *(const f32x4*)(xsrc + (size_t)(tb + i) * DM + c * 256 + F.lane * 4);
      if (COMBINE) {
        int ts[TPW][2];
#pragma unroll
        for (int i = 0; i < TPW; ++i) { ts[i][0] = tokslot[(tb + i) * 2]; ts[i][1] = tokslot[(tb + i) * 2 + 1]; }
        u32x2 yv[TPW][2][4];
#pragma unroll
        for (int i = 0; i < TPW; ++i)
#pragma unroll
          for (int k = 0; k < 2; ++k) {
            const size_t r = (size_t)(seg[ts[i][k] >> 20] + (ts[i][k] & 0xfffff));
#pragma unroll
            for (int c = 0; c < 4; ++c) yv[i][k][c] = *(const u32x2*)(ymoe + r * DM + c * 256 + F.lane * 4);
          }
        const float* g2 = mod + ((size_t)layer_c * NB + b) * 6 * DM + 5 * DM;
#pragma unroll
        for (int c = 0; c < 4; ++c) {
          const int col = c * 256 + F.lane * 4;
          const f32x4 gv = *(const f32x4*)(g2 + col);
#pragma unroll
          for (int i = 0; i < TPW; ++i) {
            const u32x2 y0 = yv[i][0][c], y1 = yv[i][1][c];
            xall[i][c][0] += gv[0] * (bf_lo(y0[0]) + bf_lo(y1[0])); xall[i][c][1] += gv[1] * (bf_hi(y0[0]) + bf_hi(y1[0]));
            xall[i][c][2] += gv[2] * (bf_lo(y0[1]) + bf_lo(y1[1])); xall[i][c][3] += gv[3] * (bf_hi(y0[1]) + bf_hi(y1[1]));
            if (!FINAL) *(f32x4*)(a.out + (size_t)(tb + i) * DM + col) = xall[i][c];
          }
        }
      }
#pragma unroll
      for (int ti = 0; ti < TPW; ++ti) {
        const int tok = tb + ti;
        f32x4 xv[4];
#pragma unroll
        for (int c = 0; c < 4; ++c) xv[c] = xall[ti][c];
        float ss = 0.f;
#pragma unroll
        for (int c = 0; c < 4; ++c) ss += xv[c][0] * xv[c][0] + xv[c][1] * xv[c][1] + xv[c][2] * xv[c][2] + xv[c][3] * xv[c][3];
        ss = wave_sum(ss);
        const float rinv = rsqrtf(ss * (1.0f / DM) + EPS);
        if (FINAL) {
#pragma unroll
            for (int c = 0; c < 4; ++c) {
                const int col = c * 256 + F.lane * 4;
                const f32x4 g = *(const f32x4*)(a.final_norm_g + col);
                f32x4 o; o[0] = xv[c][0] * rinv * g[0]; o[1] = xv[c][1] * rinv * g[1]; o[2] = xv[c][2] * rinv * g[2]; o[3] = xv[c][3] * rinv * g[3];
                *(f32x4*)(a.out + (size_t)tok * DM + col) = o;
            }
            continue;
        }
        const float* ng = a.norm_g + ((size_t)layer * 2 + which) * DM;
        const float* sh = mod + ((size_t)layer * NB + b) * 6 * DM + (which ? 3 : 0) * DM;
        const float* sc = sh + DM;
        f32x4 hv[4];
#pragma unroll
        for (int c = 0; c < 4; ++c) {
            const int col = c * 256 + F.lane * 4;
            const f32x4 g = *(const f32x4*)(ng + col), s1 = *(const f32x4*)(sc + col), s0 = *(const f32x4*)(sh + col);
#pragma unroll
            for (int u = 0; u < 4; ++u) hv[c][u] = (xv[c][u] * rinv * g[u]) * (1.0f + s1[u]) + s0[u];
            u32x2 w; w[0] = pack_bf16(hv[c][0], hv[c][1]); w[1] = pack_bf16(hv[c][2], hv[c][3]);
            *(u32x2*)(hbuf + (size_t)tok * DM + col) = w;
        }
        if (ROUTE) {
            LAS float* lgs = (LAS float*)(F.lds + 36 * WR_LD * 4 + 256) + F.wave * 36;
#pragma unroll 1
            for (int jb = 0; jb < 36; jb += 4) {
                float pp[4];
#pragma unroll
                for (int u = 0; u < 4; ++u) {
                    float p = 0.f;
#pragma unroll
                    for (int c = 0; c < 4; ++c) {
                        const f32x4 w = *(const LAS f32x4*)(wrT + (jb + u) * WR_LD + c * 256 + F.lane * 4);
                        p += hv[c][0] * w[0] + hv[c][1] * w[1] + hv[c][2] * w[2] + hv[c][3] * w[3];
                    }
                    pp[u] = p;
                }
#pragma unroll
                for (int u = 0; u < 4; ++u) pp[u] = wave_sum(pp[u]);
                if (F.lane == 0) { *(LAS f32x4*)(lgs + jb) = (f32x4){pp[0], pp[1], pp[2], pp[3]}; }
            }
            float lg[36];
#pragma unroll
            for (int j = 0; j < 36; ++j) lg[j] = lgs[j] + brs[j];
            int g = 0; float gm = lg[0];
#pragma unroll
            for (int j = 1; j < 4; ++j) if (lg[j] > gm) { gm = lg[j]; g = j; }
            float den = 0.f;
#pragma unroll
            for (int j = 0; j < 4; ++j) den += __expf(lg[j] - gm);
            const float ptop = 1.0f / den;
            float fv[8];
#pragma unroll
            for (int i = 0; i < 8; ++i) fv[i] = (g == 0) ? lg[4 + i] : (g == 1) ? lg[12 + i] : (g == 2) ? lg[20 + i] : lg[28 + i];
            int i1 = 0; float v1 = fv[0];
#pragma unroll
            for (int i = 1; i < 8; ++i) if (fv[i] > v1) { v1 = fv[i]; i1 = i; }
            int i2 = -1; float v2 = -3.0e38f;
#pragma unroll
            for (int i = 0; i < 8; ++i) if (i != i1 && fv[i] > v2) { v2 = fv[i]; i2 = i; }
            const float e2 = __expf(v2 - v1), ga = ptop / (1.0f + e2), gb = ptop * e2 / (1.0f + e2);
            if (F.lane == 0) {
                const int li = ((tb - F.bid * NWAVE * TPW) / (F.G * NWAVE * TPW)) * NWAVE * TPW + F.wave * TPW + ti;
                const int ea = g * 8 + i1, eb = g * 8 + i2;
                const int ra = __hip_atomic_fetch_add(&rcnt[ea], 1, __ATOMIC_RELAXED, __HIP_MEMORY_SCOPE_WORKGROUP);
                const int rb = __hip_atomic_fetch_add(&rcnt[eb], 1, __ATOMIC_RELAXED, __HIP_MEMORY_SCOPE_WORKGROUP);
                if (li < RT_CAP) { rt_er[2 * li] = (ea << 16) | ra; rt_gate[2 * li] = ga; rt_tok[2 * li] = tok; rt_er[2 * li + 1] = (eb << 16) | rb; rt_gate[2 * li + 1] = gb; rt_tok[2 * li + 1] = tok; }
            }
        }
      }
    }
    if (ROUTE) {
        __syncthreads();
        unsigned* cnt = ctl + CW_CNT + layer * NEXP * CNT_STRIDE;
        if (F.tid < NEXP) { const int n = rcnt[F.tid]; rbase[F.tid] = n ? (int)__hip_atomic_fetch_add(cnt + F.tid * CNT_STRIDE, (unsigned)n, __ATOMIC_RELAXED, __HIP_MEMORY_SCOPE_AGENT) : 0; }
        __syncthreads();
        int* list = (int*)(a.ws + WS_LIST); float* gatev = (float*)(a.ws + WS_GATEV); int* tsl = (int*)(a.ws + WS_TOKSLOT);
        int nloc = 0;
        for (int tb = F.bid * NWAVE * TPW; tb < NTOK; tb += F.G * NWAVE * TPW) nloc += NWAVE * TPW;
        nloc = nloc < RT_CAP ? nloc : RT_CAP;
        for (int i = F.tid; i < 2 * nloc; i += NTHR) {
            const int er = rt_er[i]; if (er < 0) continue;
            const int e = er >> 16, pos = rbase[e] + (er & 0xffff), tok = rt_tok[i];
            list[e * NTOK + pos] = tok; gatev[e * NTOK + pos] = rt_gate[i]; tsl[tok * 2 + (i & 1)] = (e << 20) | pos;
        }
    }
    __syncthreads();
}

constexpr int RP_HT = 0, RP_HT_LD = 1028;
constexpr int RP_PART = 16 * RP_HT_LD * 4;
constexpr int RP_LG = RP_PART + 8 * 16 * 48 * 4;
DI void route_phase(const Frame& F, const Args& a, int layer) {
    const float* mod = (const float*)(a.ws + WS_MOD);
    bf16_t* hbuf = (bf16_t*)(a.ws + WS_H);
    unsigned* ctl = (unsigned*)(a.ws + WS_CTL);
    LAS float* HT = (LAS float*)(F.lds + RP_HT);
    LAS float* PART = (LAS float*)(F.lds + RP_PART);
    LAS float* LG = (LAS float*)(F.lds + RP_LG);
    constexpr int RT_CAP = 512;
    LAS int* rcnt = (LAS int*)(F.lds + 149504);
    LAS int* rbase = (LAS int*)(F.lds + 149632);
    LAS int* rt_er = (LAS int*)(F.lds + 149760);
    LAS float* rt_gate = (LAS float*)(F.lds + 149760 + 4096);
    LAS int* rt_tok = (LAS int*)(F.lds + 149760 + 8192);
    if (F.tid < NEXP) rcnt[F.tid] = 0;
    for (int i = F.tid; i < 2 * RT_CAP; i += NTHR) rt_er[i] = -1;
    const float* wg = a.moe_wr_g + (size_t)layer * DM * 4;
    const float* we = a.moe_wr_e + (size_t)layer * DM * 32;
    const int col = F.lane & 15, kq = F.lane >> 4;
    float Bw[3][32];
#pragma unroll
    for (int s2 = 0; s2 < 32; ++s2) {
        const int k = 128 * F.wave + 16 * (s2 >> 2) + 4 * kq + (s2 & 3);
        Bw[0][s2] = col < 4 ? wg[k * 4 + col] : we[k * 32 + col - 4];
        Bw[1][s2] = we[k * 32 + 12 + col];
        Bw[2][s2] = col < 4 ? we[k * 32 + 28 + col] : 0.f;
    }
    const float* ng = a.norm_g + ((size_t)layer * 2 + 1) * DM;
    __syncthreads();
    const int ngroups = NTOK / 16;
    int li0 = 0;
    for (int gi = F.bid; gi < ngroups; gi += F.G, li0 += 16) {
        const int tb = gi * 16 + F.wave * 2, b = tb / SEQ;
        const float* sh = mod + ((size_t)layer * NB + b) * 6 * DM + 3 * DM;
        const float* scp = sh + DM;
#pragma unroll
        for (int ti = 0; ti < 2; ++ti) {
            const int tok = tb + ti;
            f32x4 xv[4];
#pragma unroll
            for (int c = 0; c < 4; ++c) xv[c] = *(const f32x4*)(a.out + (size_t)tok * DM + c * 256 + F.lane * 4);
            float ss = 0.f;
#pragma unroll
            for (int c = 0; c < 4; ++c) ss += xv[c][0] * xv[c][0] + xv[c][1] * xv[c][1] + xv[c][2] * xv[c][2] + xv[c][3] * xv[c][3];
            ss = wave_sum(ss);
            const float rinv = rsqrtf(ss * (1.0f / DM) + EPS);
#pragma unroll
            for (int c = 0; c < 4; ++c) {
                const int cl = c * 256 + F.lane * 4;
                const f32x4 g = *(const f32x4*)(ng + cl), s1 = *(const f32x4*)(scp + cl), s0 = *(const f32x4*)(sh + cl);
                f32x4 hv;
#pragma unroll
                for (int u = 0; u < 4; ++u) hv[u] = (xv[c][u] * rinv * g[u]) * (1.0f + s1[u]) + s0[u];
                u32x2 w; w[0] = pack_bf16(hv[0], hv[1]); w[1] = pack_bf16(hv[2], hv[3]);
                *(u32x2*)(hbuf + (size_t)tok * DM + cl) = w;
                *(LAS f32x4*)(HT + (F.wave * 2 + ti) * RP_HT_LD + cl) = hv;
            }
        }
        __syncthreads();
        {
            f32x4 acc[3];
#pragma unroll
            for (int n = 0; n < 3; ++n) acc[n] = (f32x4){0.f, 0.f, 0.f, 0.f};
            const LAS float* ap = HT + col * RP_HT_LD + 128 * F.wave + 4 * kq;
#pragma unroll
            for (int s4 = 0; s4 < 8; ++s4) {
                const f32x4 av = *(const LAS f32x4*)(ap + 16 * s4);
#pragma unroll
                for (int u = 0; u < 4; ++u)
#pragma unroll
                    for (int n = 0; n < 3; ++n) acc[n] = __builtin_amdgcn_mfma_f32_16x16x4f32(av[u], Bw[n][4 * s4 + u], acc[n], 0, 0, 0);
            }
#pragma unroll
            for (int n = 0; n < 3; ++n)
#pragma unroll
                for (int r = 0; r < 4; ++r) PART[(F.wave * 16 + 4 * kq + r) * 48 + 16 * n + col] = acc[n][r];
        }
        __syncthreads();
        {
            const int tk = F.tid >> 5, j = F.tid & 31;
            float s0 = 0.f, s1 = 0.f;
#pragma unroll
            for (int wv = 0; wv < NWAVE; ++wv) { s0 += PART[(wv * 16 + tk) * 48 + j]; s1 += PART[(wv * 16 + tk) * 48 + 32 + (j & 3)]; }
            LG[tk * 36 + j] = s0 + (j < 4 ? a.moe_br_g[layer * 4 + j] : a.moe_br_e[layer * 32 + j - 4]);
            if (j < 4) LG[tk * 36 + 32 + j] = s1 + a.moe_br_e[layer * 32 + 28 + j];
        }
        __syncthreads();
        if (F.tid < 16) {
            const int tk = F.tid, tok = gi * 16 + tk;
            float lg[36];
#pragma unroll
            for (int j = 0; j < 36; ++j) lg[j] = LG[tk * 36 + j];
            int g = 0; float gm = lg[0];
#pragma unroll
            for (int j = 1; j < 4; ++j) if (lg[j] > gm) { gm = lg[j]; g = j; }
            float den = 0.f;
#pragma unroll
            for (int j = 0; j < 4; ++j) den += __expf(lg[j] - gm);
            const float ptop = 1.0f / den;
            float fv[8];
#pragma unroll
            for (int i = 0; i < 8; ++i) fv[i] = (g == 0) ? lg[4 + i] : (g == 1) ? lg[12 + i] : (g == 2) ? lg[20 + i] : lg[28 + i];
            int i1 = 0; float v1 = fv[0];
#pragma unroll
            for (int i = 1; i < 8; ++i) if (fv[i] > v1) { v1 = fv[i]; i1 = i; }
            int i2 = -1; float v2 = -3.0e38f;
#pragma unroll
            for (int i = 0; i < 8; ++i) if (i != i1 && fv[i] > v2) { v2 = fv[i]; i2 = i; }
            const float e2 = __expf(v2 - v1), ga = ptop / (1.0f + e2), gb = ptop * e2 / (1.0f + e2);
            const int li = li0 + tk, ea = g * 8 + i1, eb = g * 8 + i2;
            const int ra = __hip_atomic_fetch_add(&rcnt[ea], 1, __ATOMIC_RELAXED, __HIP_MEMORY_SCOPE_WORKGROUP);
            const int rb = __hip_atomic_fetch_add(&rcnt[eb], 1, __ATOMIC_RELAXED, __HIP_MEMORY_SCOPE_WORKGROUP);
            if (li < RT_CAP) { rt_er[2 * li] = (ea << 16) | ra; rt_gate[2 * li] = ga; rt_tok[2 * li] = tok; rt_er[2 * li + 1] = (eb << 16) | rb; rt_gate[2 * li + 1] = gb; rt_tok[2 * li + 1] = tok; }
        }
    }
    __syncthreads();
    unsigned* cnt = ctl + CW_CNT + layer * NEXP * CNT_STRIDE;
    if (F.tid < NEXP) { const int n = rcnt[F.tid]; rbase[F.tid] = n ? (int)__hip_atomic_fetch_add(cnt + F.tid * CNT_STRIDE, (unsigned)n, __ATOMIC_RELAXED, __HIP_MEMORY_SCOPE_AGENT) : 0; }
    __syncthreads();
    int* list = (int*)(a.ws + WS_LIST); float* gatev = (float*)(a.ws + WS_GATEV); int* tsl = (int*)(a.ws + WS_TOKSLOT);
    const int nloc = li0 < RT_CAP ? li0 : RT_CAP;
    for (int i = F.tid; i < 2 * nloc; i += NTHR) {
        const int er = rt_er[i]; if (er < 0) continue;
        const int e = er >> 16, pos = rbase[e] + (er & 0xffff), tok = rt_tok[i];
        list[e * NTOK + pos] = tok; gatev[e * NTOK + pos] = rt_gate[i]; tsl[tok * 2 + (i & 1)] = (e << 20) | pos;
    }
    __syncthreads();
}

constexpr int LDS_MISC = 131072 + 64;
constexpr int LDS_XB = 163840 - 16;
constexpr int LDS_BYTES = 163840;
using pg8::Unit;
struct DenseSched {
    int nM, nN, nwg, G, c; const char* Bt; size_t tstepB;
    DI void init(int M, int N, int K, int G_, int c_, const void* Bt_) { nM = M / 256; nN = N / 256; nwg = nM * nN; G = G_; c = c_; Bt = (const char*)Bt_; tstepB = (size_t)256 * K * 2; }
    DI bool next(int i, Unit& u) const {
        const long L = (long)i * G + c; if (L >= nwg) return false;
        int wgid = (int)L; { const int q = nwg / 8, r = nwg % 8, xcd = wgid % 8, off = wgid / 8; wgid = (xcd < r ? xcd * (q + 1) : r * (q + 1) + (xcd - r) * q) + off; }
        const int nig = 8 * nN, gid = wgid / nig, fm = gid * 8, gsz = (nM - fm) < 8 ? (nM - fm) : 8;
        u.pm = fm + ((wgid % nig) % gsz); u.pn = (wgid % nig) / gsz; u.e = 0; u.nrow = 256; return true;
    }
    DI int a_row(const Unit& u, int r) const { return u.pm * 256 + r; }
    DI const char* b_base(const Unit& u) const { return Bt + (size_t)u.pn * tstepB; }
};
template <bool UP>
struct MoeSched {
    const LAS int* ntp; const unsigned* cnt; const int* list; const char* W; int nU, G, c;
    DI bool next(int i, Unit& u) const {
        const long L = (long)i * G + c; if (L >= nU) return false;
        int wgid = (int)L; { const int q = nU / 8, r = nU % 8, xcd = wgid % 8, off = wgid / 8; wgid = (xcd < r ? xcd * (q + 1) : r * (q + 1) + (xcd - r) * q) + off; }
        const int tg = wgid >> 2; u.pn = wgid & 3; u.pm = tg;
        int e = 0;
        for (int k = 1; k < NEXP; ++k) e += (ntp[k] <= tg) ? 1 : 0;
        u.e = e; const int rem = ntp[40 + e] - (tg - ntp[e]) * 256; u.nrow = rem < 256 ? rem : 256; return true;
    }
    DI int a_row(const Unit& u, int r) const {
        if (UP) { const int p = (u.pm - ntp[u.e]) * 256 + r; return (r < u.nrow) ? list[u.e * NTOK + p] : 0; }
        return u.pm * 256 + r;
    }
    DI const char* b_base(const Unit& u) const {
        return W + (size_t)u.e * 3 * MiB + (UP ? (size_t)u.pn * 256 * DM * 2 : 2 * MiB + (size_t)u.pn * 256 * DEXP * 2);
    }
};
DI void moe_tile_table(const Frame& F, const unsigned* cnt, LAS int* ntp  ) {
    if (F.tid < NEXP) ntp[40 + F.tid] = (int)cnt[F.tid * CNT_STRIDE];
    __syncthreads();
    if (F.tid == 0) { int s = 0; for (int e = 0; e < NEXP; ++e) { ntp[e] = s; s += (ntp[40 + e] + 255) >> 8; } ntp[NEXP] = s; }
    __syncthreads();
}

#define EPI_ROWS_BEGIN const int row0 = u.pm * 256 + wr * 64 + fr; _Pragma("unroll") for (int ai = 0; ai < 2; ++ai) _Pragma("unroll") for (int m = 0; m < 4; ++m) { const int row = row0 + ai * 128 + m * 16;
#define EPI_ROWS_END }
DI u32x2 pack4(const f32x4& v) { u32x2 w; w[0] = pack_bf16(v[0], v[1]); w[1] = pack_bf16(v[2], v[3]); return w; }

struct EpiAbIn {
    bf16_t* Zc;
    DI void operator()(const f32x4 (&acc)[2][2][4][2], const Unit& u, int wr, int wc, int fr, int fq) const {
        EPI_ROWS_BEGIN
            bf16_t* rp = Zc + (size_t)row * ZC_N;
#pragma unroll
            for (int bj = 0; bj < 2; ++bj) {
                if (u.pn < 2) {
#pragma unroll
                    for (int n = 0; n < 2; ++n) *(u32x2*)(rp + u.pn * 256 + bj * 128 + wc * 32 + n * 16 + 4 * fq) = pack4(acc[ai][bj][m][n]);
                } else {
                    const int pnp = (u.pn - 2) & 3, j = 16 * (8 * pnp + 4 * bj + wc) + 4 * fq;
                    const f32x4 X = acc[ai][bj][m][0], Y = acc[ai][bj][m][1]; f32x4 v;
                    if (u.pn < 6) { v = X * Y; *(u32x2*)(rp + 512 + j) = pack4(v); }
                    else { v[0] = X[0] * sigmoid_f(Y[0]); v[1] = X[1] * sigmoid_f(Y[1]); v[2] = X[2] * sigmoid_f(Y[2]); v[3] = X[3] * sigmoid_f(Y[3]); *(u32x2*)(rp + 1024 + j) = pack4(v); }
                }
            }
        EPI_ROWS_END
    }
};
struct EpiResid {
    const float* xin; float* xout; const float* g1;
    DI void operator()(const f32x4 (&acc)[2][2][4][2], const Unit& u, int wr, int wc, int fr, int fq) const {
        const float* g = g1 + (size_t)((u.pm * 256) / SEQ) * 6 * DM;
        const int row0 = u.pm * 256 + wr * 64 + fr, col0 = u.pn * 256 + wc * 32 + 4 * fq;
        f32x4 gv[2][2];
#pragma unroll
        for (int bj = 0; bj < 2; ++bj)
#pragma unroll
            for (int n = 0; n < 2; ++n) gv[bj][n] = *(const f32x4*)(g + col0 + bj * 128 + n * 16);
#pragma unroll
        for (int ai = 0; ai < 2; ++ai) {
            f32x4 xo[4][2][2];
#pragma unroll
            for (int m = 0; m < 4; ++m)
#pragma unroll
                for (int bj = 0; bj < 2; ++bj)
#pragma unroll
                    for (int n = 0; n < 2; ++n) xo[m][bj][n] = *(const f32x4*)(xin + (size_t)(row0 + ai * 128 + m * 16) * DM + col0 + bj * 128 + n * 16);
            asm volatile("" ::: "memory");
#pragma unroll
            for (int m = 0; m < 4; ++m)
#pragma unroll
                for (int bj = 0; bj < 2; ++bj)
#pragma unroll
                    for (int n = 0; n < 2; ++n) *(f32x4*)(xout + (size_t)(row0 + ai * 128 + m * 16) * DM + col0 + bj * 128 + n * 16) = xo[m][bj][n] + gv[bj][n] * acc[ai][bj][m][n];
        }
    }
};
struct EpiPlain {
    bf16_t* O; int ld;
    DI void operator()(const f32x4 (&acc)[2][2][4][2], const Unit& u, int wr, int wc, int fr, int fq) const {
        EPI_ROWS_BEGIN
#pragma unroll
            for (int bj = 0; bj < 2; ++bj)
#pragma unroll
                for (int n = 0; n < 2; ++n) *(u32x2*)(O + (size_t)row * ld + u.pn * 256 + bj * 128 + wc * 32 + n * 16 + 4 * fq) = pack4(acc[ai][bj][m][n]);
        EPI_ROWS_END
    }
};
struct EpiMoeUp {
    bf16_t* act;
    DI void operator()(const f32x4 (&acc)[2][2][4][2], const Unit& u, int wr, int wc, int fr, int fq) const {
        EPI_ROWS_BEGIN
#pragma unroll
            for (int bj = 0; bj < 2; ++bj) {
                const int j = 16 * (8 * u.pn + 4 * bj + wc) + 4 * fq;
                const f32x4 X = acc[ai][bj][m][0], Y = acc[ai][bj][m][1]; f32x4 v;
                v[0] = silu_f(X[0]) * Y[0]; v[1] = silu_f(X[1]) * Y[1]; v[2] = silu_f(X[2]) * Y[2]; v[3] = silu_f(X[3]) * Y[3];
                *(u32x2*)(act + (size_t)row * DEXP + j) = pack4(v);
            }
        EPI_ROWS_END
    }
};
struct EpiMoeDown {
    bf16_t* y; const float* gatev; const LAS int* ntp;
    DI void operator()(const f32x4 (&acc)[2][2][4][2], const Unit& u, int wr, int wc, int fr, int fq) const {
        const int pbase = (u.pm - ntp[u.e]) * 256;
        EPI_ROWS_BEGIN
            const int r = row - u.pm * 256;
            const float gt = (r < u.nrow) ? gatev[u.e * NTOK + pbase + r] : 0.f;
#pragma unroll
            for (int bj = 0; bj < 2; ++bj)
#pragma unroll
                for (int n = 0; n < 2; ++n) *(u32x2*)(y + (size_t)row * DM + u.pn * 256 + bj * 128 + wc * 32 + n * 16 + 4 * fq) = pack4(acc[ai][bj][m][n] * gt);
        EPI_ROWS_END
    }
};

DI void conv_phase(const Frame& F, const Args& a) {
    const bf16_t* Zc = (const bf16_t*)(a.ws + WS_BIG);
    bf16_t* Y = (bf16_t*)(a.ws + WS_Y);
    LAS unsigned* PB = (LAS unsigned*)F.lds;
    LAS f32x2* ST = (LAS f32x2*)(F.lds + 94 * 1024);
    const int cp = F.tid & 255, th = F.tid >> 8, wq = F.wave & 3;
    float wb[31][2], wa[3][2];
#pragma unroll
    for (int k = 0; k < 31; ++k) { const f32x2 w = *(const f32x2*)(a.ab_conv_b + k * 512 + 2 * cp); wb[k][0] = w[0]; wb[k][1] = w[1]; }
#pragma unroll
    for (int k = 0; k < 3; ++k) { const f32x2 w = *(const f32x2*)(a.ab_conv_a + k * 512 + 2 * cp); wa[k][0] = w[0]; wa[k][1] = w[1]; }
    const f32x2 cbias = *(const f32x2*)(a.ab_conv_b_bias + 2 * cp), lng = *(const f32x2*)(a.ab_ln_g + 2 * cp), lnb = *(const f32x2*)(a.ab_ln_b + 2 * cp);
    for (int tile = F.bid; tile < NTOK / 64; tile += F.G) {
        const int t0 = tile * 64, b = t0 / SEQ, tl0 = t0 % SEQ;
        for (int i = F.tid; i < 94 * 64; i += NTHR) {
            const int r = i >> 6, c8 = i & 63, pos = tl0 - 30 + r;
            u32x4 v = {0u, 0u, 0u, 0u};
            if (pos >= 0) v = *(const u32x4*)(Zc + (size_t)(b * SEQ + pos) * ZC_N + 1024 + c8 * 8);
            *(LAS u32x4*)(PB + r * 256 + c8 * 4) = v;
        }
        __syncthreads();
#pragma unroll 1
        for (int g = 0; g < 4; ++g) {
            float U[8][2];
#pragma unroll
            for (int i = 0; i < 8; ++i) { U[i][0] = cbias[0]; U[i][1] = cbias[1]; }
#pragma unroll
            for (int r = 0; r < 38; ++r) {
                const unsigned xw = PB[(32 * th + 8 * g + r) * 256 + cp];
                const float x0 = bf_lo(xw), x1 = bf_hi(xw);
#pragma unroll
                for (int i = 0; i < 8; ++i) { const int k = r - i; if (k >= 0 && k <= 30) { U[i][0] += wb[k][0] * x0; U[i][1] += wb[k][1] * x1; } }
            }
            unsigned gwv[8], pav[10];
#pragma unroll
            for (int i = 0; i < 8; ++i) gwv[i] = *(const unsigned*)(Zc + ((size_t)t0 + 32 * th + 8 * g + i) * ZC_N + 2 * cp);
#pragma unroll
            for (int i = 0; i < 10; ++i) { const int pp = tl0 + 32 * th + 8 * g + i - 2; pav[i] = pp >= 0 ? *(const unsigned*)(Zc + (size_t)(b * SEQ + pp) * ZC_N + 512 + 2 * cp) : 0u; }
            {
                float v[16];
#pragma unroll
                for (int i = 0; i < 8; ++i) { v[2 * i] = U[i][0] + U[i][1]; v[2 * i + 1] = U[i][0] * U[i][0] + U[i][1] * U[i][1]; }
#pragma unroll
                for (int hw = 8; hw >= 1; hw >>= 1) {
                    const bool up = (F.lane & (4 * hw)) != 0;
#pragma unroll
                    for (int i = 0; i < hw; ++i) { const float send = up ? v[i] : v[i + hw], keep = up ? v[i + hw] : v[i]; v[i] = keep + __shfl_xor(send, 4 * hw); }
                }
                v[0] += __shfl_xor(v[0], 2); v[0] += __shfl_xor(v[0], 1);
                if ((F.lane & 3) == 0) { const int idx = F.lane >> 2; ((LAS float*)ST)[((32 * th + 8 * g + (idx >> 1)) * 4 + wq) * 2 + (idx & 1)] = v[0]; }
            }
            __syncthreads();
#pragma unroll
            for (int i = 0; i < 8; ++i) {
                const int tl = 32 * th + 8 * g + i; const size_t tok = (size_t)t0 + tl;
                const f32x2 p0 = ST[tl * 4 + 0], p1 = ST[tl * 4 + 1], p2 = ST[tl * 4 + 2], p3 = ST[tl * 4 + 3];
                const float mean = ((p0[0] + p1[0]) + (p2[0] + p3[0])) * (1.0f / 512.0f);
                const float var = ((p0[1] + p1[1]) + (p2[1] + p3[1])) * (1.0f / 512.0f) - mean * mean;
                const float rstd = rsqrtf(var + EPS);
                const float yb0 = silu_f((U[i][0] - mean) * rstd * lng[0] + lnb[0]), yb1 = silu_f((U[i][1] - mean) * rstd * lng[1] + lnb[1]);
                *(unsigned*)(Y + tok * DM + 512 + 2 * cp) = pack_bf16(yb0, yb1);
                float a0 = 0.f, a1 = 0.f;
#pragma unroll
                for (int k = 0; k < 3; ++k) { const unsigned w = pav[i + k]; a0 += wa[k][0] * bf_lo(w); a1 += wa[k][1] * bf_hi(w); }
                const unsigned gw = gwv[i];
                *(unsigned*)(Y + tok * DM + 2 * cp) = pack_bf16(bf_lo(gw) * a0, bf_hi(gw) * a1);
            }
        }
        __syncthreads();
    }
}

#define MFMA32(a, b, c) __builtin_amdgcn_mfma_f32_32x32x16_bf16((a), (b), (c), 0, 0, 0)
#define LDS6_ISSUE(B, addr, o0, o1, o2, o3, o4, o5) asm volatile( \
    "ds_read_b128 %0, %6 offset:" #o0 "\n\tds_read_b128 %1, %6 offset:" #o1 "\n\tds_read_b128 %2, %6 offset:" #o2 "\n\tds_read_b128 %3, %6 offset:" #o3 "\n\tds_read_b128 %4, %6 offset:" #o4 "\n\tds_read_b128 %5, %6 offset:" #o5 \
    : "=&v"(B[0]), "=&v"(B[1]), "=&v"(B[2]), "=&v"(B[3]), "=&v"(B[4]), "=&v"(B[5]) : "v"(addr) : "memory")
#define LDS6_WAIT(B) asm volatile("s_waitcnt lgkmcnt(0)" : "+v"(B[0]), "+v"(B[1]), "+v"(B[2]), "+v"(B[3]), "+v"(B[4]), "+v"(B[5]) :: "memory")
constexpr int TK_HIST = 0;
constexpr int TK_HLD = 513;
constexpr int TK_TAB = 66048;
constexpr int TK_CAP = 256;
constexpr int TK_CAND = 66560;
constexpr int TK_CCNT = TK_CAND + 32 * TK_CAP * 4;
constexpr int TK_OVF = TK_CCNT + 128;
constexpr int TK_BQ = 100352;
constexpr int TK_MASK = 118784;
DI int crow_c(int r) { return (r & 3) + 8 * (r >> 2); }
template <int MODE, bool DIAG>
DI void topk_elems(const Frame& F, const f32x16& sc, int kt, int q, int h2, int myT, LAS unsigned* hist, LAS unsigned* cand, LAS int* ccnt, LAS unsigned* maskl) {
    const int lo = myT << 9, hi = (myT + 1) << 9;
    if (MODE <= 2) {
#pragma unroll
        for (int r = 0; r < 16; ++r) {
            unsigned key = (unsigned)fmaxf(sc[r], 0.0f); key = key > 262143u ? 262143u : key;
            const bool valid = !DIAG || (crow_c(r) + 4 * h2 <= q);
            if (MODE == 1) { if (valid) __hip_atomic_fetch_add(&hist[q * TK_HLD + (key >> 9)], 1u, __ATOMIC_RELAXED, __HIP_MEMORY_SCOPE_WORKGROUP); }
            else { if (valid && (int)(key >> 9) == myT) __hip_atomic_fetch_add(&hist[q * TK_HLD + (key & 511)], 1u, __ATOMIC_RELAXED, __HIP_MEMORY_SCOPE_WORKGROUP); }
        }
        return;
    }
    const int selb = (MODE == 3 ? myT : hi - 1), geb = (MODE == 3 ? myT - 1 : lo - 1);
    unsigned selw = 0u, gew = 0u;
#pragma unroll
    for (int r = 0; r < 16; ++r) {
        unsigned key = (unsigned)fmaxf(sc[r], 0.0f); key = key > 262143u ? 262143u : key;
        const unsigned d1 = (unsigned)(selb - (int)key), d2 = (unsigned)(geb - (int)key);
        selw = __builtin_amdgcn_alignbit(selw, d1, 31);
        gew = __builtin_amdgcn_alignbit(gew, d2, 31);
    }
    if (DIAG) {
        unsigned vw = 0u;
#pragma unroll
        for (int r = 0; r < 16; ++r) vw |= (crow_c(r) + 4 * h2 <= q) ? (1u << (15 - r)) : 0u;
        selw &= vw; gew &= vw;
    }
    unsigned cw = gew & ~selw & 0xffffu;
    if (cw) {
#pragma unroll
        for (int r = 0; r < 16; ++r) {
            if (cw & (1u << (15 - r))) {
                unsigned key = (unsigned)fmaxf(sc[r], 0.0f); key = key > 262143u ? 262143u : key;
                const int p = __hip_atomic_fetch_add(&ccnt[q], 1, __ATOMIC_RELAXED, __HIP_MEMORY_SCOPE_WORKGROUP);
                if (p < TK_CAP) cand[q * TK_CAP + p] = (MODE == 3 ? 0u : ((key - (unsigned)lo) << 13)) | (unsigned)(8191 - (32 * kt + crow_c(r) + 4 * h2));
            }
        }
    }
    unsigned rv = __builtin_bitreverse32(selw) >> 16;
    unsigned bits = (rv & 0xfu) | ((rv & 0xf0u) << 4) | ((rv & 0xf00u) << 8) | ((rv & 0xf000u) << 12);
    bits <<= 4 * h2;
    bits |= (unsigned)__shfl_xor((int)bits, 32);
    if (h2 == 0) maskl[q * 256 + kt] = bits;
}
template <int MODE>
DI void topk_pass(const Frame& F, const bf16_t* Z, int b, int t0, const float (&wp)[8]) {
    const LAS unsigned char* bq = F.lds + TK_BQ;
    LAS unsigned* hist = (LAS unsigned*)(F.lds + TK_HIST);
    LAS int* tab = (LAS int*)(F.lds + TK_TAB);
    LAS unsigned* cand = (LAS unsigned*)(F.lds + TK_CAND);
    LAS int* ccnt = (LAS int*)(F.lds + TK_CCNT);
    LAS unsigned* maskl = (LAS unsigned*)(F.lds + TK_MASK);
    const int lane = fresh_lane(), q = lane & 31, h2 = lane >> 5, ntile = t0 / 32 + 1;
    const int myT = (MODE >= 2) ? tab[q * 4 + 0] : 0;
    const unsigned bqa = (unsigned)(size_t)(bq + lane * 16);
    const bf16_t* kbase = Z + (size_t)b * SEQ * CD_N + Z_KI + 8 * h2 + (size_t)q * CD_N;
    bf16x8 A0n = (bf16x8){0, 0, 0, 0, 0, 0, 0, 0}, A1n = A0n;
    if (F.wave < ntile) { const bf16_t* kp = kbase + (size_t)(32 * F.wave) * CD_N; A0n = *(const bf16x8*)kp; A1n = *(const bf16x8*)(kp + 16); }
    for (int kt = F.wave; kt < ntile; kt += NWAVE) {
        const bf16x8 A0 = A0n, A1 = A1n;
        if (kt + NWAVE < ntile) { const bf16_t* kp = kbase + (size_t)(32 * (kt + NWAVE)) * CD_N; A0n = *(const bf16x8*)kp; A1n = *(const bf16x8*)(kp + 16); }
        f32x16 sc;
#pragma unroll
        for (int r = 0; r < 16; ++r) sc[r] = 131072.0f;
        {
#define TK_MF0(acc, A, B) asm volatile("v_mfma_f32_32x32x16_bf16 %0, %1, %2, 0" : "=&v"(acc) : "v"(A), "v"(B))
#define TK_MF1(acc, A, B) asm volatile("v_mfma_f32_32x32x16_bf16 %0, %1, %2, %0" : "+v"(acc) : "v"(A), "v"(B))
#define TK_FA(sv, av, wv) asm volatile("v_fma_f32 %0, |%1|, %2, %0" : "+v"(sv) : "v"(av), "v"(wv))
#define TK_AD(sv, av) asm volatile("v_add_f32 %0, %0, %1" : "+v"(sv) : "v"(av))
        bf16x8 Ba[6], Bb[6];
        f32x16 acA[3], acB[3];
        LDS6_ISSUE(Ba, bqa, 16384, 17408, 0, 1024, 2048, 3072);
        LDS6_WAIT(Ba);
        LDS6_ISSUE(Bb, bqa, 4096, 5120, 6144, 7168, 8192, 9216);
#pragma unroll
        for (int u = 0; u < 3; ++u) TK_MF0(acA[u], A0, Ba[2 * u]);
#pragma unroll
        for (int u = 0; u < 3; ++u) TK_MF1(acA[u], A1, Ba[2 * u + 1]);
        LDS6_WAIT(Bb);
        LDS6_ISSUE(Ba, bqa, 10240, 11264, 12288, 13312, 14336, 15360);
#pragma unroll
        for (int m = 0; m < 6; ++m) {
            if (m >= 3) TK_MF1(acB[m - 3], A1, Bb[2 * (m - 3) + 1]); else TK_MF0(acB[m], A0, Bb[2 * m]);
#pragma unroll
            for (int e = 0; e < 8; ++e) { const int i = 8 * m + e, u = i >> 4, r = i & 15; if (u == 0) TK_AD(sc[r], acA[0][r]); else TK_FA(sc[r], acA[u][r], wp[u - 1]); }
        }
        LDS6_WAIT(Ba);
#pragma unroll
        for (int m = 0; m < 6; ++m) {
            if (m >= 3) TK_MF1(acA[m - 3], A1, Ba[2 * (m - 3) + 1]); else TK_MF0(acA[m], A0, Ba[2 * m]);
#pragma unroll
            for (int e = 0; e < 8; ++e) { const int i = 8 * m + e, u = i >> 4, r = i & 15; TK_FA(sc[r], acB[u][r], wp[2 + u]); }
        }
#pragma unroll
        for (int u = 0; u < 3; ++u)
#pragma unroll
            for (int r = 0; r < 16; ++r) TK_FA(sc[r], acA[u][r], wp[5 + u]);
#undef TK_MF0
#undef TK_MF1
#undef TK_FA
#undef TK_AD
        }
        if (kt == ntile - 1) topk_elems<MODE, true>(F, sc, kt, q, h2, myT, hist, cand, ccnt, maskl);
        else topk_elems<MODE, false>(F, sc, kt, q, h2, myT, hist, cand, ccnt, maskl);
    }
}
DI void topk_scan(const Frame& F, int pass, int t0) {
    LAS unsigned* hist = (LAS unsigned*)(F.lds + TK_HIST);
    LAS int* tab = (LAS int*)(F.lds + TK_TAB);
    LAS int* ovf = (LAS int*)(F.lds + TK_OVF);
    for (int qi = 0; qi < 4; ++qi) {
        const int q = F.wave * 4 + qi, n = t0 + q + 1;
        int need = 256, prevT = 0, prevAbove = 0;
        if (pass == 2) { prevT = tab[q * 4 + 0]; prevAbove = tab[q * 4 + 1]; need = 256 - prevAbove; }
        if (n <= 256) { if (F.lane == 0) { tab[q * 4 + 0] = -1; tab[q * 4 + 1] = 0; tab[q * 4 + 2] = 0; } continue; }
        unsigned hv[8]; unsigned s = 0;
#pragma unroll
        for (int i = 0; i < 8; ++i) { hv[i] = hist[q * TK_HLD + 511 - (8 * F.lane + i)]; s += hv[i]; }
        unsigned inc = s;
#pragma unroll
        for (int o = 1; o < 64; o <<= 1) { const unsigned v = (unsigned)__shfl_up((int)inc, o); if (F.lane >= o) inc += v; }
        const unsigned pre = inc - s;
        if ((int)pre < need && (int)inc >= need) {
            unsigned cum = pre; int bsel = 0; unsigned above = 0, inbin = 0; bool found = false;
#pragma unroll
            for (int i = 0; i < 8; ++i) { if (!found && (int)(cum + hv[i]) >= need) { found = true; bsel = 511 - (8 * F.lane + i); above = cum; inbin = hv[i]; } cum += hv[i]; }
            if (pass == 1) { tab[q * 4 + 0] = bsel; tab[q * 4 + 1] = (int)above; tab[q * 4 + 2] = 256 - (int)above; if (inbin > (unsigned)TK_CAP) *ovf = 1; }
            else { tab[q * 4 + 0] = (prevT << 9) | bsel; tab[q * 4 + 1] = prevAbove + (int)above; tab[q * 4 + 2] = 256 - (prevAbove + (int)above); }
        }
    }
}
DI void topk_select(const Frame& F) {
    LAS int* tab = (LAS int*)(F.lds + TK_TAB);
    LAS unsigned* cand = (LAS unsigned*)(F.lds + TK_CAND);
    LAS int* ccnt = (LAS int*)(F.lds + TK_CCNT);
    LAS unsigned* maskl = (LAS unsigned*)(F.lds + TK_MASK);
    for (int qi = 0; qi < 4; ++qi) {
        const int q = F.wave * 4 + qi, need = tab[q * 4 + 2];
        int n = ccnt[q]; n = n > TK_CAP ? TK_CAP : n;
        if (need <= 0 || n <= 0) continue;
        unsigned c[4]; int rk[4]; bool vv[4];
#pragma unroll
        for (int i = 0; i < 4; ++i) { vv[i] = F.lane + 64 * i < n; c[i] = vv[i] ? cand[q * TK_CAP + F.lane + 64 * i] : 0u; rk[i] = 0; }
        for (int j = 0; j < n; ++j) {
            const unsigned cj = cand[q * TK_CAP + j];
#pragma unroll
            for (int i = 0; i < 4; ++i) rk[i] += (cj > c[i]) ? 1 : 0;
        }
#pragma unroll
        for (int i = 0; i < 4; ++i)
            if (vv[i] && rk[i] < need) { const int idx = 8191 - (int)(c[i] & 8191u); __hip_atomic_fetch_or(&maskl[q * 256 + (idx >> 5)], 1u << (idx & 31), __ATOMIC_RELAXED, __HIP_MEMORY_SCOPE_WORKGROUP); }
    }
}
DI void topk_phase(const Frame& F, const Args& a, unsigned long long& tacc) {
    unsigned long long t_s = 0;
#define TKT0(n) do { if (TIME_PH == 100 + (n)) { __syncthreads(); t_s = wall_clock64(); } } while (0)
#define TKT1(n) do { if (TIME_PH == 100 + (n)) { __syncthreads(); tacc += wall_clock64() - t_s; } } while (0)
    const bf16_t* Z = (const bf16_t*)(a.ws + WS_BIG);
    unsigned* maskg = (unsigned*)(a.ws + WS_MASK);
    LAS unsigned* hist = (LAS unsigned*)(F.lds + TK_HIST);
    LAS int* ccnt = (LAS int*)(F.lds + TK_CCNT);
    LAS int* ovf = (LAS int*)(F.lds + TK_OVF);
    LAS unsigned* maskl = (LAS unsigned*)(F.lds + TK_MASK);
    for (int pi = F.bid; pi < 512; pi += F.G) {
        const int b = pi >> 7, p = pi & 127;
        for (int half = 0; half < 2; ++half) {
            const int t0 = 32 * (half ? 255 - p : p), ntile = t0 / 32 + 1;
            const int lane0 = fresh_lane(), q = lane0 & 31, h2 = lane0 >> 5;
            const bf16_t* zr = Z + (size_t)(b * SEQ + t0 + q) * CD_N;
            TKT0(1);
            float wp[8];
            { const u32x4 wv = *(const u32x4*)(zr + Z_WI);
              const float sc = 0.0625f * 0.5f * 16384.0f;
              wp[0] = bf_lo(wv[0]) * sc; wp[1] = bf_hi(wv[0]) * sc; wp[2] = bf_lo(wv[1]) * sc; wp[3] = bf_hi(wv[1]) * sc;
              wp[4] = bf_lo(wv[2]) * sc; wp[5] = bf_hi(wv[2]) * sc; wp[6] = bf_lo(wv[3]) * sc; wp[7] = bf_hi(wv[3]) * sc; }
            __syncthreads();
            if (F.wave == 0) {
                LAS unsigned char* bqw = F.lds + TK_BQ;
                float lin[2][8];
#pragma unroll
                for (int ks = 0; ks < 2; ++ks)
#pragma unroll
                    for (int j = 0; j < 8; ++j) lin[ks][j] = 0.f;
#pragma unroll
                for (int h = 0; h < 8; ++h)
#pragma unroll
                    for (int ks = 0; ks < 2; ++ks) {
                        const u32x4 v = *(const u32x4*)(zr + Z_QI + 32 * h + 16 * ks + 8 * h2);
                        *(LAS u32x4*)(bqw + ((2 * h + ks) * 64 + lane0) * 16) = v;
#pragma unroll
                        for (int j = 0; j < 4; ++j) { lin[ks][2 * j] += wp[h] * bf_lo(v[j]); lin[ks][2 * j + 1] += wp[h] * bf_hi(v[j]); }
                    }
#pragma unroll
                for (int ks = 0; ks < 2; ++ks) {
                    u32x4 v; v[0] = pack_bf16(lin[ks][0], lin[ks][1]); v[1] = pack_bf16(lin[ks][2], lin[ks][3]); v[2] = pack_bf16(lin[ks][4], lin[ks][5]); v[3] = pack_bf16(lin[ks][6], lin[ks][7]);
                    *(LAS u32x4*)(bqw + ((16 + ks) * 64 + lane0) * 16) = v;
                }
            }
            for (int i = F.tid; i < 32 * TK_HLD; i += NTHR) hist[i] = 0u;
            if (F.tid < 32) ccnt[F.tid] = 0;
            if (F.tid == 32) *ovf = 0;
            __syncthreads();
            TKT1(1); TKT0(2);
            topk_pass<1>(F, Z, b, t0, wp);
            __syncthreads();
            TKT1(2); TKT0(3);
            topk_scan(F, 1, t0);
            __syncthreads();
            TKT1(3); TKT0(4);
            if (*ovf == 0) {
                topk_pass<4>(F, Z, b, t0, wp);
            } else {
                for (int i = F.tid; i < 32 * TK_HLD; i += NTHR) hist[i] = 0u;
                __syncthreads();
                topk_pass<2>(F, Z, b, t0, wp);
                __syncthreads();
                topk_scan(F, 2, t0);
                __syncthreads();
                topk_pass<3>(F, Z, b, t0, wp);
            }
            __syncthreads();
            TKT1(4); TKT0(5);
            topk_select(F);
            __syncthreads();
            for (int i = F.wave * 64 + fresh_lane(); i < 32 * ntile; i += NTHR) { const int qq = i / ntile, kt = i - qq * ntile; maskg[(size_t)(b * SEQ + t0 + qq) * 256 + kt] = maskl[qq * 256 + kt]; }
            TKT1(5);
        }
    }
}

constexpr int AT_KSTR = 72;
constexpr int AT_VSTR = 72;
constexpr int AT_KBYTES = 64 * AT_KSTR * 2;
constexpr int AT_VBYTES = 128 * AT_VSTR * 2;
constexpr int AT_BUF = AT_KBYTES + AT_VBYTES;
constexpr int AT_NSTG = 3;
constexpr int AT_LUT = AT_NSTG * AT_BUF;
constexpr int AT_LUT_LD = 320;
constexpr float NEG_INF = -__builtin_huge_valf();
constexpr float AT_THR = 8.0f;

template <int DV, bool MASKED>
DI void attn_core(const Frame& F, const bf16_t* Z, const bf16_t* Vt, int b, int qcol, int kcol, int vrow, int q0, const LAS float* lut, float c1, const unsigned* maskg, f32x16 (&O)[DV / 32]) {
    constexpr int NDV = DV / 32;
    const int q = F.lane & 31, h2 = F.lane >> 5;
    const int tw0 = q0 + 32 * F.wave, t = tw0 + q;
    const bf16_t* Zb = Z + (size_t)b * SEQ * CD_N;
    const bf16_t* Vb = Vt + (size_t)vrow * NTOK + (size_t)b * SEQ;
    const unsigned* mrow = maskg + (size_t)(b * SEQ + t) * 256;
    bf16x8 Qf[4];
#pragma unroll
    for (int ks = 0; ks < 4; ++ks) Qf[ks] = *(const bf16x8*)(Zb + (size_t)t * CD_N + qcol + 16 * ks + 8 * h2);
#pragma unroll
    for (int d = 0; d < NDV; ++d)
#pragma unroll
        for (int r = 0; r < 16; ++r) O[d][r] = 0.f;
    float m_run = NEG_INF, l_run = 0.f;
    const int jmax = (q0 + 255) >> 6;
    const int kkey = F.tid >> 3, kch = F.tid & 7;
    u32x4 kreg, vreg[DV / 64]; unsigned mreg[2] = {0u, 0u};
    bf16x8 Pf[4];
#pragma unroll
    for (int i = 0; i < 4; ++i) Pf[i] = (bf16x8){0, 0, 0, 0, 0, 0, 0, 0};
#define AT_LOAD(j) do { kreg = *(const u32x4*)(Zb + (size_t)(64 * (j) + kkey) * CD_N + kcol + 8 * kch); \
        _Pragma("unroll") for (int _i = 0; _i < DV / 64; ++_i) { const int idx = F.tid + NTHR * _i; vreg[_i] = *(const u32x4*)(Vb + (size_t)(idx >> 3) * NTOK + 64 * (j) + 8 * (idx & 7)); } \
        if (MASKED) { mreg[0] = mrow[2 * (j)]; mreg[1] = mrow[2 * (j) + 1]; } } while (0)
#define AT_STORE(buf) do { LAS unsigned char* kb_ = F.lds + (buf) * AT_BUF; *(LAS u32x4*)(kb_ + kkey * (AT_KSTR * 2) + kch * 16) = kreg; \
        _Pragma("unroll") for (int _i = 0; _i < DV / 64; ++_i) { const int idx = F.tid + NTHR * _i, dv_ = idx >> 3, ch_ = idx & 7; \
            LAS unsigned char* vp_ = kb_ + AT_KBYTES + dv_ * (AT_VSTR * 2) + (16 * (ch_ >> 1) + 4 * (ch_ & 1)) * 2; \
            *(LAS u32x2*)vp_ = (u32x2){vreg[_i][0], vreg[_i][1]}; *(LAS u32x2*)(vp_ + 16) = (u32x2){vreg[_i][2], vreg[_i][3]}; } } while (0)
#define AT_QKSM(jj) do { \
        const LAS unsigned char* kb = F.lds + ((jj) % AT_NSTG) * AT_BUF; \
        f32x16 s[2]; \
        _Pragma("unroll") for (int kb2 = 0; kb2 < 2; ++kb2) { \
            bf16x8 Kf[4]; \
            _Pragma("unroll") for (int ks = 0; ks < 4; ++ks) Kf[ks] = *(const LAS bf16x8*)(kb + (32 * kb2 + q) * (AT_KSTR * 2) + (16 * ks + 8 * h2) * 2); \
            _Pragma("unroll") for (int r = 0; r < 16; ++r) s[kb2][r] = 0.f; \
            _Pragma("unroll") for (int ks = 0; ks < 4; ++ks) s[kb2] = MFMA32(Kf[ks], Qf[ks], s[kb2]); \
        } \
        const bool nearb = (64 * (jj) + 63 + 128 > tw0); \
        float mloc = NEG_INF; \
        if (!nearb) { \
            _Pragma("unroll") for (int kb2 = 0; kb2 < 2; ++kb2) _Pragma("unroll") for (int r = 0; r < 16; ++r) mloc = fmaxf(mloc, s[kb2][r]); \
            mloc = mloc * c1 + lut[96 + 128]; \
        } else { \
            const LAS float* lp = lut + (t - 64 * (jj) - 4 * h2 + 96 - 63); \
            _Pragma("unroll") for (int kb2 = 0; kb2 < 2; ++kb2) \
                _Pragma("unroll") for (int r = 0; r < 16; ++r) { const float v_ = s[kb2][r] * c1 + lp[63 - (32 * kb2 + crow_c(r))]; s[kb2][r] = v_; mloc = fmaxf(mloc, v_); } \
        } \
        mloc = fmaxf(mloc, __shfl_xor(mloc, 32)); \
        if (__any(mloc > m_run + AT_THR)) { \
            const float m_new = fmaxf(m_run, mloc); \
            const float alpha = __builtin_amdgcn_exp2f(m_run - m_new); \
            m_run = m_new; l_run *= alpha; \
            _Pragma("unroll") for (int d = 0; d < NDV; ++d) _Pragma("unroll") for (int r = 0; r < 16; ++r) O[d][r] *= alpha; \
        } \
        const float sub = lut[96 + 128] - m_run; \
        if (!nearb) { _Pragma("unroll") for (int kb2 = 0; kb2 < 2; ++kb2) _Pragma("unroll") for (int r = 0; r < 16; ++r) s[kb2][r] = __builtin_amdgcn_exp2f(s[kb2][r] * c1 + sub); } \
        else        { _Pragma("unroll") for (int kb2 = 0; kb2 < 2; ++kb2) _Pragma("unroll") for (int r = 0; r < 16; ++r) s[kb2][r] = __builtin_amdgcn_exp2f(s[kb2][r] - m_run); } \
        float psum0 = 0.f, psum1 = 0.f; \
        _Pragma("unroll") for (int kb2 = 0; kb2 < 2; ++kb2) { \
            const unsigned mw = mcur[kb2] >> (4 * h2); \
            _Pragma("unroll") for (int r = 0; r < 16; ++r) { \
                float p = s[kb2][r]; \
                if (MASKED) { p = __uint_as_float(__float_as_uint(p) & (unsigned)(-(int)((mw >> crow_c(r)) & 1u))); s[kb2][r] = p; } \
                if (r & 1) psum1 += p; else psum0 += p; \
            } \
        } \
        l_run += psum0 + psum1; \
        _Pragma("unroll") for (int st = 0; st < 4; ++st) { \
            u32x4 pw; \
            _Pragma("unroll") for (int e = 0; e < 4; ++e) pw[e] = pack_bf16(s[st >> 1][8 * (st & 1) + 2 * e], s[st >> 1][8 * (st & 1) + 2 * e + 1]); \
            Pf[st] = __builtin_bit_cast(bf16x8, pw); \
        } \
    } while (0)
#define AT_PV(jj) do { \
        const LAS unsigned char* vt = F.lds + ((jj) % AT_NSTG) * AT_BUF + AT_KBYTES + q * (AT_VSTR * 2) + (8 * h2) * 2; \
        constexpr int NH = NDV / 2, NST = 4 * NH; \
        bf16x8 Av[2][2]; \
        _Pragma("unroll") for (int d = 0; d < 2; ++d) Av[0][d] = *(const LAS bf16x8*)(vt + (32 * d) * (AT_VSTR * 2)); \
        _Pragma("unroll") for (int u = 0; u < NST; ++u) { \
            const int st = u / NH, dh = u % NH; \
            if (u + 1 < NST) { \
                const int st1 = (u + 1) / NH, dh1 = (u + 1) % NH; \
                _Pragma("unroll") for (int d = 0; d < 2; ++d) Av[(u + 1) & 1][d] = *(const LAS bf16x8*)(vt + (32 * (2 * dh1 + d)) * (AT_VSTR * 2) + (16 * st1) * 2); \
            } \
            __builtin_amdgcn_s_setprio(1); \
            _Pragma("unroll") for (int d = 0; d < 2; ++d) O[2 * dh + d] = MFMA32(Av[u & 1][d], Pf[st], O[2 * dh + d]); \
            __builtin_amdgcn_s_setprio(0); \
            __builtin_amdgcn_sched_barrier(0); \
        } \
    } while (0)
#define AT_ACT(jj) (64 * (jj) <= tw0 + 31)
    AT_LOAD(0); AT_STORE(0);
    unsigned mcur[2] = {mreg[0], mreg[1]};
    __syncthreads();
    if (F.wave < 4) {
        for (int j = 0; j <= jmax; ++j) {
            if (j < jmax) AT_LOAD(j + 1);
            if (AT_ACT(j)) { AT_QKSM(j); AT_PV(j); }
            if (j < jmax) AT_STORE((j + 1) % AT_NSTG);
            mcur[0] = mreg[0]; mcur[1] = mreg[1];
            __syncthreads();
        }
    } else {
        for (int j = 0; j <= jmax; ++j) {
            if (j < jmax) AT_LOAD(j + 1);
            if (j > 0 && AT_ACT(j - 1)) AT_PV(j - 1);
            if (AT_ACT(j)) AT_QKSM(j);
            if (j < jmax) AT_STORE((j + 1) % AT_NSTG);
            mcur[0] = mreg[0]; mcur[1] = mreg[1];
            __syncthreads();
        }
        if (AT_ACT(jmax)) AT_PV(jmax);
    }
    __syncthreads();
#undef AT_LOAD
#undef AT_STORE
#undef AT_QKSM
#undef AT_PV
#undef AT_ACT
    const float lt = l_run + __shfl_xor(l_run, 32);
    const float inv = 1.0f / lt;
#pragma unroll
    for (int d = 0; d < NDV; ++d)
#pragma unroll
        for (int r = 0; r < 16; ++r) O[d][r] *= inv;
}

DI float rel_bucket_bias(const float* rel_bias, int d, int head) {
    int bkt;
    if (d < 16) bkt = d;
    else { const float lr = __logf((float)d * (1.0f / 16.0f)) / 2.0794415416798357f; int l = 16 + (int)(lr * 16.0f); bkt = l < 31 ? l : 31; }
    return rel_bias[bkt * 12 + head];
}
template <bool DPART>
DI void attn_phase(const Frame& F, const Args& a) {
    const bf16_t* Z = (const bf16_t*)(a.ws + WS_BIG);
    const bf16_t* Vtg = (const bf16_t*)(a.ws + WS_VT);
    bf16_t* Yo = (bf16_t*)(a.ws + WS_Y);
    float* O1s = (float*)(a.ws + WS_H);
    const unsigned* maskg = (const unsigned*)(a.ws + WS_MASK);
    LAS float* lut = (LAS float*)(F.lds + AT_LUT);
    for (int i = F.tid; i < 12 * AT_LUT_LD; i += NTHR) { const int hh = i / AT_LUT_LD, d = i % AT_LUT_LD - 96; lut[i] = d < 0 ? NEG_INF : rel_bucket_bias(a.rel_bias, d < 128 ? d : 128, hh) * LOG2E; }
    float lam;
    { float d01 = 0.f, d23 = 0.f; for (int i = 0; i < 64; ++i) { d01 += a.diff_lam[i] * a.diff_lam[64 + i]; d23 += a.diff_lam[128 + i] * a.diff_lam[192 + i]; }
      lam = __expf(d01) - __expf(d23) + 0.35550906759096f; lam = __uint_as_float(__builtin_amdgcn_readfirstlane(__float_as_uint(lam))); }
    const float one_m_li = 1.0f - 0.35550906759096f;
    __syncthreads();
    const float c1 = 0.125f * LOG2E;
    const int xcd = F.bid & 7, kk = F.bid >> 3;
    if (DPART)
    for (int it = F.bid; it < 256; it += F.G) {
        const int bh = (F.G == 256) ? 2 * xcd + (kk >> 4) : it >> 4, pr = (F.G == 256) ? (kk & 15) : (it & 15);
        const int b_ = bh >> 2, hd_ = bh & 3;
        for (int half = 0; half < 2; ++half) {
            Frame Fu = F; Fu.lane = fresh_lane();
            int b = b_, hd = hd_; asm volatile("" : "+s"(b), "+s"(hd));
            const int q0 = 256 * (half ? 31 - pr : pr);
            f32x16 O[4];
            attn_core<128, false>(Fu, Z, Vtg, b, Z_QD + 128 * hd, Z_KD + 128 * hd, VT_D + 128 * hd, q0, lut + (8 + hd) * AT_LUT_LD, c1, nullptr, O);
            {
                const int l1 = fresh_lane();
                float* o1p = O1s + (size_t)(b * SEQ + q0 + 32 * F.wave + (l1 & 31)) * 512 + 128 * hd + 4 * (l1 >> 5);
#pragma unroll
                for (int d = 0; d < 4; ++d)
#pragma unroll
                    for (int g = 0; g < 4; ++g) *(f32x4*)(o1p + 32 * d + 8 * g) = (f32x4){O[d][4 * g], O[d][4 * g + 1], O[d][4 * g + 2], O[d][4 * g + 3]};
            }
            Frame Fv = F; Fv.lane = fresh_lane();
            attn_core<128, false>(Fv, Z, Vtg, b, Z_QD + 128 * hd + 64, Z_KD + 128 * hd + 64, VT_D + 128 * hd, q0, lut + (8 + hd) * AT_LUT_LD, c1, nullptr, O);
            {
                const int l1 = fresh_lane();
                const int tq = q0 + 32 * F.wave + (l1 & 31), hh = l1 >> 5;
                const float* o1p = O1s + (size_t)(b * SEQ + tq) * 512 + 128 * hd + 4 * hh;
                float ss = 0.f;
#pragma unroll
                for (int d = 0; d < 4; ++d)
#pragma unroll
                    for (int g = 0; g < 4; ++g) {
                        const f32x4 o1 = *(const f32x4*)(o1p + 32 * d + 8 * g);
#pragma unroll
                        for (int e = 0; e < 4; ++e) { const float v = o1[e] - lam * O[d][4 * g + e]; O[d][4 * g + e] = v; ss += v * v; }
                    }
                ss += __shfl_xor(ss, 32);
                const float rinv = rsqrtf(ss * (1.0f / 128.0f) + EPS) * one_m_li;
                bf16_t* yp = Yo + (size_t)(b * SEQ + tq) * DM + 512 + 128 * hd + 4 * hh;
                const float* gp = a.diff_norm_g + 4 * hh;
#pragma unroll
                for (int d = 0; d < 4; ++d)
#pragma unroll
                    for (int g = 0; g < 4; ++g) {
                        const f32x4 gn = *(const f32x4*)(gp + 32 * d + 8 * g);
                        f32x4 v; v[0] = O[d][4 * g] * rinv * gn[0]; v[1] = O[d][4 * g + 1] * rinv * gn[1]; v[2] = O[d][4 * g + 2] * rinv * gn[2]; v[3] = O[d][4 * g + 3] * rinv * gn[3];
                        *(u32x2*)(yp + 32 * d + 8 * g) = pack4(v);
                    }
            }
        }
    }
    if (!DPART)
    for (int it = F.bid; it < 512; it += F.G) {
        const int rnd = it / F.G;
        const int bh = (F.G == 256) ? 4 * xcd + 2 * rnd + (kk >> 4) : it >> 4, pr = (F.G == 256) ? (kk & 15) : (it & 15);
        const int b_ = bh >> 3, hc_ = bh & 7;
        for (int half = 0; half < 2; ++half) {
            Frame Fu = F; Fu.lane = fresh_lane();
            int b = b_, hc = hc_; asm volatile("" : "+s"(b), "+s"(hc));
            const int q0 = 256 * (half ? 31 - pr : pr);
            f32x16 O[2];
            attn_core<64, true>(Fu, Z, Vtg, b, Z_QC + 64 * hc, Z_KC + 64 * hc, VT_C + 64 * hc, q0, lut + hc * AT_LUT_LD, c1, maskg, O);
            {
                const int l1 = fresh_lane();
                bf16_t* yp = Yo + (size_t)(b * SEQ + q0 + 32 * F.wave + (l1 & 31)) * DM + 64 * hc + 4 * (l1 >> 5);
#pragma unroll
                for (int d = 0; d < 2; ++d)
#pragma unroll
                    for (int g = 0; g < 4; ++g) {
                        f32x4 v = {O[d][4 * g], O[d][4 * g + 1], O[d][4 * g + 2], O[d][4 * g + 3]};
                        *(u32x2*)(yp + 32 * d + 8 * g) = pack4(v);
                    }
            }
        }
    }
}

#ifndef MK_ONE_LAUNCH
#define MK_ONE_LAUNCH 1
#endif
constexpr int NPH = 17;
__global__ void __launch_bounds__(NTHR, 2) fwd_kernel(Args a) {
    extern __shared__ __attribute__((aligned(16))) unsigned char lds_raw[];
    Frame F; F.lds = (LAS unsigned char*)lds_raw; F.tid = threadIdx.x; F.lane = F.tid & 63; F.wave = __builtin_amdgcn_readfirstlane(F.tid >> 6); F.G = gridDim.x; F.bid = blockIdx.x;
    unsigned* ctl = (unsigned*)(a.ws + WS_CTL);
    volatile LAS unsigned* xbw = (volatile LAS unsigned*)(F.lds + LDS_XB);
    if (F.tid < 4) xbw[F.tid] = 0u;
    __syncthreads();
    const int lo = a.ph_lo, hi = a.ph_hi;
    XcdBarrier bar; bar.bar = ctl + CW_BAR; bar.x = 0; bar.st = xbw;
    if (hi - lo > 1) bar = xcd_barrier_post(ctl + CW_BAR, xbw);
#ifndef PH_ONLY
#define IN(k) (lo <= (k) && (k) < hi)
#else
#define IN(k) ((k) == PH_ONLY && lo <= (k) && (k) < hi)
#endif
#ifndef DUP_PH
#define DUP_PH -1
#endif
#define REP(k) for (int rep_ = 0; rep_ < ((k) == DUP_PH ? 2 : 1); ++rep_)
#ifndef TIME_PH
#define TIME_PH -1
#endif
#define TIME_AMP 4
    unsigned long long tp0_ = 0, tp1_ = 0;
    if (TIME_PH == 0) tp0_ = wall_clock64();
#define SEAM(k) do { if (IN(k) && IN((k) + 1)) xcd_barrier(bar); if ((k) == TIME_PH) tp1_ = wall_clock64(); if ((k) + 1 == TIME_PH) tp0_ = wall_clock64(); } while (0)
    float* mod = (float*)(a.ws + WS_MOD);
    bf16_t* hbuf = (bf16_t*)(a.ws + WS_H);
    bf16_t* ybuf = (bf16_t*)(a.ws + WS_Y);
    LAS int* ntp = (LAS int*)(F.lds + LDS_MISC);

    if (IN(0)) REP(0) { p0_prologue(F, a); } SEAM(0);
    if (IN(1)) REP(1) { norm_phase<false, false, false>(F, a, a.x, 0, 0, 0); } SEAM(1);
    if (IN(2)) REP(2) {
        DenseSched S; S.init(NTOK, AB_N, DM, F.G, F.bid, a.ws + WS_WAB_IN);
        EpiAbIn E{(bf16_t*)(a.ws + WS_BIG)};
        pg8::gemm_phase(F.lds, (const char*)hbuf, DM, S, E);
    } SEAM(2);
    if (IN(3)) REP(3) { conv_phase(F, a); } SEAM(3);
    if (IN(4)) REP(4) {
        DenseSched S; S.init(NTOK, DM, DM, F.G, F.bid, a.ws + WS_WAB_OUT);
        EpiResid E{a.x, a.out, mod + 2 * DM};
        pg8::gemm_phase(F.lds, (const char*)ybuf, DM, S, E);
    } SEAM(4);
#define MOE_PHASES(layer, pb) do { \
        const unsigned* cnt = ctl + CW_CNT + (layer) * NEXP * CNT_STRIDE; \
        if (IN(pb)) { route_phase(F, a, (layer)); } SEAM(pb); \
        if (IN((pb) + 1)) REP((pb) + 1) { \
            moe_tile_table(F, cnt, ntp); \
            MoeSched<true> S; S.ntp = ntp; S.cnt = cnt; S.list = (const int*)(a.ws + WS_LIST); S.W = (const char*)(a.ws + WS_MOE_W); S.nU = 4 * ntp[NEXP]; S.G = F.G; S.c = F.bid; \
            EpiMoeUp E{(bf16_t*)(a.ws + WS_ACT)}; \
            pg8::gemm_phase(F.lds, (const char*)hbuf, DM, S, E); \
        } SEAM((pb) + 1); \
        if (IN((pb) + 2)) REP((pb) + 2) { \
            moe_tile_table(F, cnt, ntp); \
            MoeSched<false> S; S.ntp = ntp; S.cnt = cnt; S.list = nullptr; S.W = (const char*)(a.ws + WS_MOE_W); S.nU = 4 * ntp[NEXP]; S.G = F.G; S.c = F.bid; \
            EpiMoeDown E{(bf16_t*)(a.ws + WS_YMOE), (const float*)(a.ws + WS_GATEV), ntp}; \
            pg8::gemm_phase(F.lds, (const char*)(a.ws + WS_ACT), DEXP, S, E); \
        } SEAM((pb) + 2); } while (0)
    MOE_PHASES(0, 5);
    if (IN(8)) {
        norm_phase<true, false, false>(F, a, a.out, 1, 0, 0);
        cvt_run(F, a, 1, CVT_MOE_TILES);
    } SEAM(8);
    if (IN(9)) REP(9) {
        { DenseSched S; S.init(NTOK, CD_N, DM, F.G, F.bid, a.ws + WS_WCD_IN);
          EpiPlain E{(bf16_t*)(a.ws + WS_BIG), CD_N};
          pg8::gemm_phase(F.lds, (const char*)hbuf, DM, S, E); }
        __syncthreads();
        { DenseSched S; S.init(1024, NTOK, DM, F.G, F.bid, hbuf);
          EpiPlain E{(bf16_t*)(a.ws + WS_VT), NTOK};
          pg8::gemm_phase(F.lds, (const char*)(a.ws + WS_WCD_IN + (size_t)CD_N * DM * 2), DM, S, E); }
    } SEAM(9);
    if (IN(10)) REP(10) { unsigned long long tacc_ = 0; topk_phase(F, a, tacc_); if (TIME_PH > 100 && TIME_PH < 110) { tp0_ = 0; tp1_ = tacc_; } } SEAM(10);
    if (IN(11)) REP(11) { if (TIME_PH == 111) { __syncthreads(); tp0_ = wall_clock64(); } attn_phase<true>(F, a); __syncthreads(); if (TIME_PH == 111) tp1_ = wall_clock64(); if (TIME_PH == 112) tp0_ = wall_clock64(); attn_phase<false>(F, a); if (TIME_PH == 112) { __syncthreads(); tp1_ = wall_clock64(); } } SEAM(11);
    if (IN(12)) {
        DenseSched S; S.init(NTOK, DM, DM, F.G, F.bid, a.ws + WS_WCD_OUT);
        EpiResid E{a.out, a.out, mod + (size_t)NB * 6 * DM + 2 * DM};
        pg8::gemm_phase(F.lds, (const char*)ybuf, DM, S, E);
    } SEAM(12);
    MOE_PHASES(1, 13);
#undef MOE_PHASES
    if (IN(16)) { norm_phase<true, false, true>(F, a, a.out, 1, 0, 1); }
    if (TIME_PH >= 0) {
        if (TIME_PH == 16) { asm volatile("s_waitcnt vmcnt(0)" ::: "memory"); __syncthreads(); tp1_ = wall_clock64(); }
        if (F.bid == 0 && F.tid == 0) { const unsigned long long te = wall_clock64(), dt = (tp1_ - tp0_) * TIME_AMP; while (wall_clock64() - te < dt) __builtin_amdgcn_s_sleep(8); }
    }
#undef IN
#undef SEAM
}

extern "C" void kernel_launch(void* const* d_in, const int* in_sizes, int n_in, void* d_out, int out_size, void* d_ws, size_t ws_size, hipStream_t stream) {
    static int grid = 0;
    if (grid == 0) {
        if (n_in != 26 || out_size != NTOK * DM || ws_size < WS_END) { fprintf(stderr, "kernel_launch: unexpected problem (n_in %d, out %d, ws %zu < %zu)\n", n_in, out_size, ws_size, (size_t)WS_END); grid = -1; return; }
        int dev = 0, cus = 0, per_cu = 0;
        if (hipGetDevice(&dev) != hipSuccess || hipDeviceGetAttribute(&cus, hipDeviceAttributeMultiprocessorCount, dev) != hipSuccess) { grid = -1; return; }
        if (hipFuncSetAttribute((const void*)fwd_kernel, hipFuncAttributeMaxDynamicSharedMemorySize, LDS_BYTES) != hipSuccess) { fprintf(stderr, "kernel_launch: hipFuncSetAttribute failed\n"); grid = -1; return; }
        if (hipOccupancyMaxActiveBlocksPerMultiprocessor(&per_cu, (const void*)fwd_kernel, NTHR, LDS_BYTES) != hipSuccess || per_cu < 1) { fprintf(stderr, "kernel_launch: occupancy query says %d\n", per_cu); }
        (void)hipGetLastError();
        grid = cus;
    }
    if (grid < 0) return;
    (void)hipMemsetAsync((char*)d_ws + WS_CTL, 0, CTL_BYTES, stream);
    Args a{};
    const float** fp = (const float**)&a.x;
    (void)fp;
    a.x = (const float*)d_in[0]; a.c = (const float*)d_in[1]; a.positions = (const int*)d_in[2]; a.rel_bias = (const float*)d_in[3]; a.norm_g = (const float*)d_in[4];
    a.final_norm_g = (const float*)d_in[5]; a.ada_w = (const float*)d_in[6]; a.ada_b = (const float*)d_in[7]; a.ab_w_in = (const float*)d_in[8]; a.ab_conv_a = (const float*)d_in[9];
    a.ab_conv_b = (const float*)d_in[10]; a.ab_conv_b_bias = (const float*)d_in[11]; a.ab_ln_g = (const float*)d_in[12]; a.ab_ln_b = (const float*)d_in[13]; a.ab_w_out = (const float*)d_in[14];
    a.cd_w_in = (const float*)d_in[15]; a.diff_lam = (const float*)d_in[16]; a.diff_norm_g = (const float*)d_in[17]; a.cd_w_out = (const float*)d_in[18];
    a.moe_wr_g = (const float*)d_in[19]; a.moe_br_g = (const float*)d_in[20]; a.moe_wr_e = (const float*)d_in[21]; a.moe_br_e = (const float*)d_in[22];
    a.moe_w_gate = (const float*)d_in[23]; a.moe_w_up = (const float*)d_in[24]; a.moe_w_down = (const float*)d_in[25];
    a.out = (float*)d_out; a.ws = (unsigned char*)d_ws;
#if MK_ONE_LAUNCH
    a.ph_lo = 0; a.ph_hi = NPH;
    hipLaunchKernelGGL(fwd_kernel, dim3(grid), dim3(NTHR), LDS_BYTES, stream, a);
#else
    for (int p = 0; p < NPH; ++p) { a.ph_lo = p; a.ph_hi = p + 1; hipLaunchKernelGGL(fwd_kernel, dim3(grid), dim3(NTHR), LDS_BYTES, stream, a); }
#endif
}
```

```cpp
#include <hip/hip_runtime.h>
#include <cstdio>
#include <cstdint>

#ifndef TIME_PH
#define TIME_PH -1
#endif
#define LAS __attribute__((address_space(3)))
#define DI __device__ __forceinline__
typedef unsigned short bf16_t;
typedef short bf16x8 __attribute__((ext_vector_type(8)));
typedef short s16x4 __attribute__((ext_vector_type(4)));
typedef float f32x2 __attribute__((ext_vector_type(2)));
typedef float f32x4 __attribute__((ext_vector_type(4)));
typedef float f32x16 __attribute__((ext_vector_type(16)));
typedef unsigned u32x2 __attribute__((ext_vector_type(2)));
typedef unsigned u32x4 __attribute__((ext_vector_type(4)));
typedef __bf16 bf16v2 __attribute__((ext_vector_type(2)));

constexpr int NB = 4, SEQ = 8192, DM = 1024, NTOK = NB * SEQ;
constexpr int NTHR = 512, NWAVE = 8;
constexpr int AB_N = 2560;
constexpr int ZC_N = 1536;
constexpr int CD_SRC_N = 3368;
constexpr int CD_N = 2560;
constexpr int Z_QC = 0, Z_KC = 512, Z_QD = 1024, Z_KD = 1536, Z_QI = 2048, Z_KI = 2304, Z_WI = 2336;
constexpr int VT_C = 0, VT_D = 512;
constexpr int NEXP = 32, DEXP = 512;
constexpr int MOE_ROWS = 2 * NTOK + NEXP * 256;
constexpr float EPS = 1e-6f;
constexpr float LOG2E = 1.4426950408889634f;

constexpr size_t MiB = 1u << 20;
constexpr size_t WS_CTL = 0, CTL_BYTES = 64 * 1024;
constexpr size_t WS_MOD = 1 * MiB;
constexpr size_t WS_WAB_IN = 2 * MiB;
constexpr size_t WS_WAB_OUT = 7 * MiB;
constexpr size_t WS_WCD_IN = 9 * MiB;
constexpr size_t WS_WCD_OUT = 16 * MiB;
constexpr size_t WS_MOE_W = 18 * MiB;
constexpr size_t WS_H = 114 * MiB;
constexpr size_t WS_Y = 178 * MiB;
constexpr size_t WS_BIG = 242 * MiB;
constexpr size_t WS_ACT = WS_BIG;
constexpr size_t WS_YMOE = WS_BIG + 72 * MiB;
constexpr size_t WS_VT = WS_BIG + 160 * MiB;
constexpr size_t WS_MASK = 466 * MiB;
constexpr size_t WS_LIST = 498 * MiB;
constexpr size_t WS_GATEV = 502 * MiB;
constexpr size_t WS_TOKSLOT = 506 * MiB;
constexpr size_t WS_END = 507 * MiB;

constexpr int CW_BAR = 0;
constexpr int CW_CNT = 4096;
constexpr int CNT_STRIDE = 64;

DI unsigned pack_bf16(float lo, float hi) { f32x2 v = {lo, hi}; bf16v2 b = __builtin_convertvector(v, bf16v2); return __builtin_bit_cast(unsigned, b); }
DI float bf_lo(unsigned w) { return __uint_as_float(w << 16); }
DI float bf_hi(unsigned w) { return __uint_as_float(w & 0xffff0000u); }
DI float bf2f(bf16_t b) { return __uint_as_float(((unsigned)b) << 16); }
DI float wave_sum(float v) {
#pragma unroll
    for (int o = 32; o >= 1; o >>= 1) v += __shfl_xor(v, o);
    return v;
}
DI int fresh_lane() { int l; asm volatile("v_mbcnt_lo_u32_b32 %0, -1, 0\n\tv_mbcnt_hi_u32_b32 %0, -1, %0" : "=v"(l)); return l; }
DI float silu_f(float v) { return v / (1.0f + __expf(-v)); }
DI float sigmoid_f(float v) { return 1.0f / (1.0f + __expf(-v)); }

#define XB_TMO      128
#define XB_XCNT(j)  (256  + 64 * (j))
#define XB_XSUB(j)  (1280 + 64 * (j))
#define XB_XGEN(j)  (2304 + 64 * (j))
#define XB_TOP      3328
#define XB_TOPGEN   3392
#define XCD_BAR_WORDS 3456
#define XB_SPIN_CAP (1u << 22)
DI unsigned xb_ld(unsigned* p)              { return __hip_atomic_load(p, __ATOMIC_RELAXED, __HIP_MEMORY_SCOPE_AGENT); }
DI unsigned xb_add(unsigned* p, unsigned v) { return __hip_atomic_fetch_add(p, v, __ATOMIC_RELAXED, __HIP_MEMORY_SCOPE_AGENT); }
DI unsigned xb_xcc_id() { return (unsigned)__builtin_amdgcn_s_getreg((3 << 11) | 20) & 0xFu; }
#define XB_SPIN(cond, bar) do { unsigned _sp = 0; while (cond) { __builtin_amdgcn_s_sleep(1); \
    if ((++_sp & 255u) == 0u) { if (xb_ld(&(bar)[XB_TMO])) break; if (_sp > XB_SPIN_CAP) { atomicAdd(&(bar)[XB_TMO], 1u); break; } } } } while (0)
struct XcdBarrier { unsigned* bar; unsigned x; volatile LAS unsigned* st; };
DI XcdBarrier xcd_barrier_post(unsigned* bar, volatile LAS unsigned* st) {
    XcdBarrier b; b.bar = bar; b.x = xb_xcc_id(); b.st = st;
    if (threadIdx.x == 0) (void)xb_add(&bar[XB_XCNT(b.x)], 1u);
    return b;
}
DI void xcd_barrier_complete(unsigned* bar, unsigned x, unsigned& nloc, unsigned& nx) {
    const unsigned G = gridDim.x * gridDim.y * gridDim.z;
    unsigned sum, cnt, mine, sp = 0u;
    for (;;) {
        sum = 0u; cnt = 0u; mine = 0u;
#pragma unroll
        for (unsigned j = 0; j < 16; ++j) { const unsigned c = xb_ld(&bar[XB_XCNT(j)]); sum += c; cnt += (c > 0u) ? 1u : 0u; mine = (j == x) ? c : mine; }
        if (sum == G) break;
        __builtin_amdgcn_s_sleep(1);
        if ((++sp & 255u) == 0u) { if (xb_ld(&bar[XB_TMO])) break; if (sp > XB_SPIN_CAP) { atomicAdd(&bar[XB_TMO], 1u); break; } }
    }
    nloc = mine > 0u ? mine : 1u; nx = cnt > 0u ? cnt : 1u;
}
DI void xcd_barrier(const XcdBarrier& b) {
    asm volatile("s_waitcnt vmcnt(0)" ::: "memory");
    __syncthreads();
    if (threadIdx.x == 0) {
        unsigned* bar = b.bar;
        __builtin_amdgcn_s_waitcnt(0);
        unsigned nloc = b.st[0], nx = b.st[1];
        if (nloc == 0u) { xcd_barrier_complete(bar, b.x, nloc, nx); b.st[0] = nloc; b.st[1] = nx; }
        const unsigned old = xb_add(&bar[XB_XSUB(b.x)], 1u);
        const unsigned gen = old / nloc;
        if (old + 1u == (gen + 1u) * nloc) {
            __builtin_amdgcn_fence(__ATOMIC_RELEASE, "agent");
            asm volatile("s_waitcnt vmcnt(0)" ::: "memory");
            const unsigned og = xb_add(&bar[XB_TOP], 1u);
            const unsigned tg = og / nx;
            if (og + 1u == (tg + 1u) * nx) xb_add(&bar[XB_TOPGEN], 1u);
            else XB_SPIN(xb_ld(&bar[XB_TOPGEN]) == tg, bar);
            __builtin_amdgcn_fence(__ATOMIC_ACQUIRE, "agent");
            xb_add(&bar[XB_XGEN(b.x)], 1u);
            asm volatile("s_waitcnt vmcnt(0)" ::: "memory");
        } else {
            XB_SPIN(xb_ld(&bar[XB_XGEN(b.x)]) == gen, bar);
            __builtin_amdgcn_fence(__ATOMIC_ACQUIRE, "agent");
            asm volatile("s_waitcnt vmcnt(0)" ::: "memory");
        }
    }
    __syncthreads();
}

namespace pg8 {
constexpr int BM = 256, BK = 64, HALF = 128, HTB = HALF * BK * 2, STAGE_BYTES = 8 * HTB;
DI int lds_byte(int r, int c) { const int st = (r >> 4) * 2 + (c >> 5), rr = r & 15, cc = c & 31, ob = rr * 64 + cc * 2; return st * 1024 + (ob ^ (((ob >> 9) & 1) << 5)); }
DI void stage_rc(int b, int& R, int& C) { const int st = b / 1024, sb = b % 1024, swz = sb ^ (((sb >> 9) & 1) << 5); R = (st >> 1) * 16 + swz / 64; C = (st & 1) * 32 + (swz % 64) / 2; }
struct Unit { int pm, pn, e, nrow; };

template <class Epi, class Sched>
DI void gemm_phase(LAS unsigned char* lds, const char* Abase, const int K, const Sched& S, const Epi& E) {
    const int tid = threadIdx.x, wid = __builtin_amdgcn_readfirstlane(tid >> 6), lane = tid & 63, wr = wid >> 2, wc = wid & 3, fr = lane & 15, fq = lane >> 4;
    const int nt = K / BK;
    int Rr[2], Cc[2]; unsigned voffB[2];
#pragma unroll
    for (int i = 0; i < 2; ++i) { int R, C; stage_rc(tid * 16 + i * 8192, R, C); Rr[i] = R; Cc[i] = C; voffB[i] = (unsigned)(R * K + C) * 2u; }
    const size_t kstep = (size_t)(BK * 2);
    const size_t hstep = (size_t)HALF * K * 2;
    const unsigned ldsw = (unsigned)wid * 1024u;
    const int aoff = lds_byte(wr * 64 + fr, fq * 8), boff = lds_byte(wc * 32 + fr, fq * 8);
#define PG8_SA(b, h) (((b) * 2 + (h)) * HTB)
#define PG8_SB(b, h) ((4 + (b) * 2 + (h)) * HTB)
#define PG8_STAGE(bufoff, gbase, voff) do { _Pragma("unroll") for (int _i = 0; _i < 2; ++_i) \
        __builtin_amdgcn_global_load_lds((const unsigned*)((const char*)(gbase) + (voff)[_i]), (LAS unsigned*)(lds + (bufoff) + ldsw + _i * 8192), 16, 0, 0); } while (0)
#define PG8_AOFF(dst, u) do { _Pragma("unroll") for (int _h = 0; _h < 2; ++_h) _Pragma("unroll") for (int _i = 0; _i < 2; ++_i) \
        dst[_h][_i] = ((unsigned)S.a_row(u, _h * HALF + Rr[_i]) * (unsigned)K + (unsigned)Cc[_i]) * 2u; } while (0)
#define PG8_LDA(dst, b, h) do { _Pragma("unroll") for (int m = 0; m < 4; ++m) _Pragma("unroll") for (int k = 0; k < 2; ++k) dst[m][k] = *(const LAS bf16x8*)(lds + PG8_SA(b, h) + aoff + m * 2048 + k * 1024); } while (0)
#define PG8_LDB(dst, b, h) do { _Pragma("unroll") for (int n = 0; n < 2; ++n) _Pragma("unroll") for (int k = 0; k < 2; ++k) dst[n][k] = *(const LAS bf16x8*)(lds + PG8_SB(b, h) + boff + n * 2048 + k * 1024); } while (0)
#define PG8_MMA(ai, bj, At, Bt) do { __builtin_amdgcn_s_setprio(1); _Pragma("unroll") for (int m = 0; m < 4; ++m) _Pragma("unroll") for (int n = 0; n < 2; ++n) _Pragma("unroll") for (int k = 0; k < 2; ++k) \
        acc[ai][bj][m][n] = __builtin_amdgcn_mfma_f32_16x16x32_bf16(Bt[n][k], At[m][k], acc[ai][bj][m][n], 0, 0, 0); __builtin_amdgcn_s_setprio(0); } while (0)
#define PG8_WAIT_V(n) asm volatile("s_waitcnt vmcnt(" #n ")" ::: "memory")
#define PG8_WAIT_L(n) asm volatile("s_waitcnt lgkmcnt(" #n ")" ::: "memory")
#define PG8_BAR __builtin_amdgcn_s_barrier()
#define PG8_SCHED __builtin_amdgcn_sched_barrier(0)
    Unit cur, nxt; int ui = 0;
    if (!S.next(0, cur)) return;
    f32x4 acc[2][2][4][2];
#pragma unroll
    for (int a = 0; a < 2; ++a)
#pragma unroll
        for (int b = 0; b < 2; ++b)
#pragma unroll
            for (int m = 0; m < 4; ++m)
#pragma unroll
                for (int n = 0; n < 2; ++n) acc[a][b][m][n] = (f32x4){0.f, 0.f, 0.f, 0.f};
    bf16x8 At[4][2], B0[2][2], B1[2][2];
    unsigned aoC[2][2], aoN[2][2];
    PG8_AOFF(aoC, cur);
    const char* cB = S.b_base(cur);
    PG8_STAGE(PG8_SB(0, 0), cB, voffB); PG8_STAGE(PG8_SA(0, 0), Abase, aoC[0]); PG8_STAGE(PG8_SB(0, 1), cB + hstep, voffB); PG8_STAGE(PG8_SA(0, 1), Abase, aoC[1]);
    if (wr == 1) PG8_BAR;
    PG8_WAIT_V(4); PG8_BAR;
    PG8_STAGE(PG8_SB(1, 0), cB + kstep, voffB); PG8_STAGE(PG8_SA(1, 0), Abase + kstep, aoC[0]); PG8_STAGE(PG8_SB(1, 1), cB + hstep + kstep, voffB);
    PG8_WAIT_V(6); PG8_BAR;
    for (;;) {
        const bool has_next = S.next(ui + 1, nxt);
        const char* nB = cB;
#pragma unroll
        for (int _h = 0; _h < 2; ++_h)
#pragma unroll
            for (int _i = 0; _i < 2; ++_i) aoN[_h][_i] = aoC[_h][_i];
        if (has_next) { PG8_AOFF(aoN, nxt); nB = S.b_base(nxt); }
        for (int t = 0; t < nt; t += 2) {
            const bool last = (t == nt - 2);
            const char* a1 = Abase + (size_t)(t + 1) * kstep;
            const char* a2 = last ? Abase : Abase + (size_t)(t + 2) * kstep; const char* b2 = last ? nB : cB + (size_t)(t + 2) * kstep;
            const char* a3 = a2 + kstep; const char* b3 = b2 + kstep;
            unsigned ao2[2][2];
#pragma unroll
            for (int _h = 0; _h < 2; ++_h)
#pragma unroll
                for (int _i = 0; _i < 2; ++_i) ao2[_h][_i] = last ? aoN[_h][_i] : aoC[_h][_i];
            PG8_LDB(B0, 0, 0); PG8_SCHED; PG8_LDA(At, 0, 0); PG8_STAGE(PG8_SA(1, 1), a1, aoC[1]);
            PG8_WAIT_L(8); PG8_BAR; PG8_WAIT_L(0); PG8_MMA(0, 0, At, B0); PG8_BAR; PG8_SCHED;
            PG8_LDB(B1, 0, 1); PG8_STAGE(PG8_SB(0, 0), b2, voffB);
            PG8_BAR; PG8_WAIT_L(0); PG8_MMA(0, 1, At, B1); PG8_BAR;
            PG8_LDA(At, 0, 1); PG8_STAGE(PG8_SA(0, 0), a2, ao2[0]);
            PG8_BAR; PG8_WAIT_L(0); PG8_MMA(1, 0, At, B0); PG8_BAR; PG8_SCHED;
            PG8_STAGE(PG8_SB(0, 1), b2 + hstep, voffB);
            PG8_WAIT_V(6); PG8_BAR; PG8_MMA(1, 1, At, B1); PG8_BAR;
            PG8_LDB(B0, 1, 0); PG8_SCHED; PG8_LDA(At, 1, 0); PG8_STAGE(PG8_SA(0, 1), a2, ao2[1]);
            PG8_WAIT_L(8); PG8_BAR; PG8_WAIT_L(0); PG8_MMA(0, 0, At, B0); PG8_BAR; PG8_SCHED;
            PG8_LDB(B1, 1, 1); PG8_STAGE(PG8_SB(1, 0), b3, voffB);
            PG8_BAR; PG8_WAIT_L(0); PG8_MMA(0, 1, At, B1); PG8_BAR;
            PG8_LDA(At, 1, 1); PG8_STAGE(PG8_SA(1, 0), a3, ao2[0]);
            PG8_BAR; PG8_WAIT_L(0); PG8_MMA(1, 0, At, B0); PG8_BAR; PG8_SCHED;
            PG8_STAGE(PG8_SB(1, 1), b3 + hstep, voffB);
            PG8_WAIT_V(6); PG8_BAR; PG8_MMA(1, 1, At, B1); PG8_BAR;
        }
        E(acc, cur, wr, wc, fr, fq);
        if (!has_next) break;
#pragma unroll
        for (int a = 0; a < 2; ++a)
#pragma unroll
            for (int b = 0; b < 2; ++b)
#pragma unroll
                for (int m = 0; m < 4; ++m)
#pragma unroll
                    for (int n = 0; n < 2; ++n) acc[a][b][m][n] = (f32x4){0.f, 0.f, 0.f, 0.f};
        cur = nxt; cB = nB; ++ui;
#pragma unroll
        for (int _h = 0; _h < 2; ++_h)
#pragma unroll
            for (int _i = 0; _i < 2; ++_i) aoC[_h][_i] = aoN[_h][_i];
    }
    PG8_WAIT_V(0);
    if (wr == 0) PG8_BAR;
    PG8_BAR;
#undef PG8_SA
#undef PG8_SB
#undef PG8_STAGE
#undef PG8_AOFF
#undef PG8_LDA
#undef PG8_LDB
#undef PG8_MMA
#undef PG8_WAIT_V
#undef PG8_WAIT_L
#undef PG8_BAR
#undef PG8_SCHED
}
}

struct Args {
    const float* x; const float* c; const int* positions; const float* rel_bias; const float* norm_g; const float* final_norm_g;
    const float* ada_w; const float* ada_b; const float* ab_w_in; const float* ab_conv_a; const float* ab_conv_b; const float* ab_conv_b_bias;
    const float* ab_ln_g; const float* ab_ln_b; const float* ab_w_out; const float* cd_w_in; const float* diff_lam; const float* diff_norm_g;
    const float* cd_w_out; const float* moe_wr_g; const float* moe_br_g; const float* moe_wr_e; const float* moe_br_e;
    const float* moe_w_gate; const float* moe_w_up; const float* moe_w_down;
    float* out; unsigned char* ws; int ph_lo, ph_hi;
};
struct Frame {
    LAS unsigned char* lds; int tid, lane, wave, G, bid;
};

struct RowSrc { const float* p; int ld; };
DI int perm32(int rho) { const int n = rho >> 4, i = rho & 15; return 8 * (i >> 2) + 4 * n + (i & 3); }
DI int permrow(int r) { return (r & ~31) + perm32(r & 31); }
DI void ilv(int rp, int& j, int& second) { const int U = rp >> 8, ru = rp & 255, bj = ru >> 7, wc = (ru >> 5) & 3, n = (ru >> 4) & 1, fq = (ru >> 2) & 3, e = ru & 3; j = 128 * U + 32 * wc + 8 * fq + 4 * bj + e; second = n; }

enum { CV_AB_IN = 0, CV_AB_OUT = 1, CV_CD_IN = 2, CV_CD_OUT = 3, CV_MOE_GU = 4, CV_MOE_D = 5 };
template <int KIND> DI RowSrc row_src(const Args& a, int layer, int e, int r) {
    RowSrc s; s.p = nullptr; s.ld = 0;
    if (KIND == CV_AB_IN) {
        s.ld = AB_N;
        if (r < 512) s.p = a.ab_w_in + permrow(r);
        else if (r < 1536) { int j, sec; ilv(r - 512, j, sec); s.p = a.ab_w_in + (sec ? 1024 + j : 512 + j); }
        else { int j, sec; ilv(r - 1536, j, sec); s.p = a.ab_w_in + (sec ? 2048 + j : 1536 + j); }
    } else if (KIND == CV_AB_OUT) { s.ld = DM; s.p = a.ab_w_out + r; }
    else if (KIND == CV_CD_IN) {
        s.ld = CD_SRC_N;
        int col = -1;
        if (r < CD_N) r = permrow(r);
        if (r < 1024) col = r;
        else if (r < 2048) col = 1832 + (r - 1024);
        else if (r < 2304) col = 1536 + (r - 2048);
        else if (r < 2336) col = 1792 + (r - 2304);
        else if (r < 2344) col = 1824 + (r - 2336);
        else if (r < 2560) col = -1;
        else if (r < 3072) col = 1024 + (r - 2560);
        else col = 2856 + (r - 3072);
        if (col >= 0) s.p = a.cd_w_in + col;
    } else if (KIND == CV_CD_OUT) { s.ld = DM; s.p = a.cd_w_out + r; }
    else if (KIND == CV_MOE_GU) {
        int j, sec; ilv(r, j, sec); s.ld = DEXP;
        const size_t base = ((size_t)layer * NEXP + e) * (size_t)DM * DEXP;
        s.p = (sec ? a.moe_w_up : a.moe_w_gate) + base + j;
    } else {
        s.ld = DM; s.p = a.moe_w_down + ((size_t)layer * NEXP + e) * (size_t)DEXP * DM + permrow(r);
    }
    return s;
}
constexpr int CV_LD = 258;
struct CvtTile { const float* sp; int ld; bf16_t* dst; int K, r0, k0; };
template <int KIND> DI CvtTile cvt_desc(const Frame& F, const Args& a, bf16_t* dst, int K, int r0, int k0, int layer, int e) {
    const RowSrc s = row_src<KIND>(a, layer, e, r0 + 4 * (F.tid & 15));
    CvtTile t; t.sp = s.p; t.ld = s.ld; t.dst = dst; t.K = K; t.r0 = r0; t.k0 = k0; return t;
}
constexpr int CVT_DENSE_TILES = (AB_N + DM + CD_N + 1024 + DM) / 64 * (DM / 256);
constexpr int CVT_MOE_TILES_PER_EXP = (1024 / 64) * (1024 / 256) + (1024 / 64) * (512 / 256);
constexpr int CVT_MOE_TILES = NEXP * CVT_MOE_TILES_PER_EXP;
DI CvtTile cvt_dense_desc(const Frame& F, const Args& a, int item) {
    const int rt = item >> 2, kt = item & 3;
    int r = rt * 64;
    if (r < AB_N) return cvt_desc<CV_AB_IN>(F, a, (bf16_t*)(a.ws + WS_WAB_IN), DM, r, kt * 256, 0, 0);
    r -= AB_N;
    if (r < DM) return cvt_desc<CV_AB_OUT>(F, a, (bf16_t*)(a.ws + WS_WAB_OUT), DM, r, kt * 256, 0, 0);
    r -= DM;
    if (r < CD_N + 1024) return cvt_desc<CV_CD_IN>(F, a, (bf16_t*)(a.ws + WS_WCD_IN), DM, r, kt * 256, 0, 0);
    r -= CD_N + 1024;
    return cvt_desc<CV_CD_OUT>(F, a, (bf16_t*)(a.ws + WS_WCD_OUT), DM, r, kt * 256, 0, 0);
}
DI CvtTile cvt_moe_desc(const Frame& F, const Args& a, int layer, int item) {
    const int e = item / CVT_MOE_TILES_PER_EXP, t = item % CVT_MOE_TILES_PER_EXP;
    bf16_t* base = (bf16_t*)(a.ws + WS_MOE_W + (size_t)e * 3 * MiB);
    if (t < 64) return cvt_desc<CV_MOE_GU>(F, a, base, DM, (t >> 2) * 64, (t & 3) * 256, layer, e);
    const int t2 = t - 64; return cvt_desc<CV_MOE_D>(F, a, base + (size_t)DM * DM, DEXP, (t2 >> 1) * 64, (t2 & 1) * 256, layer, e);
}
DI void cvt_load(const Frame& F, const CvtTile& t, f32x4 (&v)[8]) {
#pragma unroll
    for (int it = 0; it < 8; ++it) {
        const int kk = (F.tid >> 4) + 32 * it;
        v[it] = (f32x4){0.f, 0.f, 0.f, 0.f};
        if (t.sp) v[it] = *(const f32x4*)(t.sp + (size_t)(t.k0 + kk) * t.ld);
    }
}
DI void cvt_store(const Frame& F, const CvtTile& t, const f32x4 (&v)[8]) {
    LAS bf16_t* T = (LAS bf16_t*)F.lds;
    const int c4 = F.tid & 15;
#pragma unroll
    for (int it = 0; it < 8; ++it) {
        const int kk = (F.tid >> 4) + 32 * it;
        const unsigned p01 = pack_bf16(v[it][0], v[it][1]), p23 = pack_bf16(v[it][2], v[it][3]);
        T[(4 * c4 + 0) * CV_LD + kk] = (bf16_t)(p01 & 0xffffu); T[(4 * c4 + 1) * CV_LD + kk] = (bf16_t)(p01 >> 16);
        T[(4 * c4 + 2) * CV_LD + kk] = (bf16_t)(p23 & 0xffffu); T[(4 * c4 + 3) * CV_LD + kk] = (bf16_t)(p23 >> 16);
    }
    __syncthreads();
    {
        const int rr = F.tid >> 3, c = F.tid & 7;
#pragma unroll
        for (int j = 0; j < 4; ++j) {
            const LAS unsigned* src = (const LAS unsigned*)(T + rr * CV_LD + 64 * j + c * 8);
            u32x4 w; w[0] = src[0]; w[1] = src[1]; w[2] = src[2]; w[3] = src[3];
            *(u32x4*)(t.dst + (size_t)(t.r0 + rr) * t.K + t.k0 + 64 * j + c * 8) = w;
        }
    }
    __syncthreads();
}
DI CvtTile cvt_any_desc(const Frame& F, const Args& a, int which, int item) {
    if (which == 0) { if (item < CVT_DENSE_TILES) return cvt_dense_desc(F, a, item); return cvt_moe_desc(F, a, 0, item - CVT_DENSE_TILES); }
    return cvt_moe_desc(F, a, 1, item);
}
DI void cvt_run(const Frame& F, const Args& a, int which, int n_items) {
    int it = F.bid;
    if (it >= n_items) return;
    CvtTile t0 = cvt_any_desc(F, a, which, it), t1 = t0, t2 = t0;
    f32x4 v0[8], v1[8], v2[8];
    cvt_load(F, t0, v0);
    bool h1 = it + F.G < n_items, h2 = it + 2 * F.G < n_items;
    if (h1) { t1 = cvt_any_desc(F, a, which, it + F.G); cvt_load(F, t1, v1); }
    for (;;) {
        h2 = it + 2 * F.G < n_items;
        if (h2) { t2 = cvt_any_desc(F, a, which, it + 2 * F.G); cvt_load(F, t2, v2); }
        cvt_store(F, t0, v0);
        if (!h1) break;
        it += F.G; t0 = t1; t1 = t2; h1 = h2;
#pragma unroll
        for (int i = 0; i < 8; ++i) { v0[i] = v1[i]; v1[i] = v2[i]; }
    }
}
DI void mod_item(const Frame& F, const Args& a, int item) {
    LAS float* sc = (LAS float*)F.lds;
    LAS float* part = (LAS float*)(F.lds + 16384);
    for (int i = F.tid; i < NB * DM; i += NTHR) sc[i] = silu_f(a.c[i]);
    __syncthreads();
    const int l = item / 96, j = (item % 96) * 64 + F.lane;
    const float* w = a.ada_w + (size_t)l * DM * 6 * DM + (size_t)(F.wave * 128) * 6 * DM + j;
    float acc[NB] = {0.f, 0.f, 0.f, 0.f};
#pragma unroll 8
    for (int k = 0; k < 128; ++k) {
        const float wv = w[(size_t)k * 6 * DM];
#pragma unroll
        for (int b = 0; b < NB; ++b) acc[b] += sc[b * DM + F.wave * 128 + k] * wv;
    }
#pragma unroll
    for (int b = 0; b < NB; ++b) part[(F.wave * NB + b) * 64 + F.lane] = acc[b];
    __syncthreads();
    if (F.tid < NB * 64) {
        const int b = F.tid >> 6, c = F.tid & 63;
        float sum = 0.f;
#pragma unroll
        for (int wv = 0; wv < NWAVE; ++wv) sum += part[(wv * NB + b) * 64 + c];
        const int jj = (item % 96) * 64 + c;
        float* mod = (float*)(a.ws + WS_MOD);
        mod[((size_t)l * NB + b) * 6 * DM + jj] = sum + a.ada_b[l * 6 * DM + jj];
    }
    __syncthreads();
}
DI void p0_prologue(const Frame& F, const Args& a) {
    for (int it = F.bid; it < 192; it += F.G) mod_item(F, a, it);
    cvt_run(F, a, 0, CVT_DENSE_TILES + CVT_MOE_TILES);
}

constexpr int WR_LD = 1028;
DI void moe_seg_table(const Frame& F, const unsigned* cnt, LAS int* seg  ) {
    if (F.tid < NEXP) seg[40 + F.tid] = (int)cnt[F.tid * CNT_STRIDE];
    __syncthreads();
    if (F.tid == 0) { int s = 0; for (int e = 0; e < NEXP; ++e) { seg[e] = s; s += ((seg[40 + e] + 255) >> 8) << 8; } seg[NEXP] = s; }
    __syncthreads();
}
template <bool COMBINE, bool ROUTE, bool FINAL>
DI void norm_phase(const Frame& F, const Args& a, const float* xsrc, int layer, int which, int layer_c) {
    const float* mod = (const float*)(a.ws + WS_MOD);
    bf16_t* hbuf = (bf16_t*)(a.ws + WS_H);
    unsigned* ctl = (unsigned*)(a.ws + WS_CTL);
    LAS float* wrT = (LAS float*)F.lds;
    LAS float* brs = (LAS float*)(F.lds + 36 * WR_LD * 4);
    LAS int* seg = (LAS int*)F.lds;
    constexpr int RT_CAP = 512;
    LAS int* rcnt = (LAS int*)(F.lds + 149504);
    LAS int* rbase = (LAS int*)(F.lds + 149632);
    LAS int* rt_er = (LAS int*)(F.lds + 149760);
    LAS float* rt_gate = (LAS float*)(F.lds + 149760 + 4096);
    LAS int* rt_tok = (LAS int*)(F.lds + 149760 + 8192);
    if (ROUTE) {
        const float* wg = a.moe_wr_g + (size_t)layer * DM * 4;
        const float* we = a.moe_wr_e + (size_t)layer * DM * 32;
        for (int i = F.tid; i < DM * 4; i += NTHR) { const int k = i >> 2, j = i & 3; wrT[j * WR_LD + k] = wg[i]; }
        for (int i = F.tid; i < DM * 32; i += NTHR) { const int k = i >> 5, j = i & 31; wrT[(4 + j) * WR_LD + k] = we[i]; }
        if (F.tid < NEXP) rcnt[F.tid] = 0;
        for (int i = F.tid; i < 2 * RT_CAP; i += NTHR) rt_er[i] = -1;
        if (F.tid < 4) brs[F.tid] = a.moe_br_g[layer * 4 + F.tid];
        else if (F.tid < 36) brs[F.tid] = a.moe_br_e[layer * 32 + F.tid - 4];
        __syncthreads();
    }
    if (COMBINE) moe_seg_table(F, ctl + CW_CNT + layer_c * NEXP * CNT_STRIDE, seg);
    const bf16_t* ymoe = (const bf16_t*)(a.ws + WS_YMOE);
    const int* tokslot = (const int*)(a.ws + WS_TOKSLOT);
    constexpr int TPW = ROUTE ? 2 : 4;
    for (int tb = (F.bid * NWAVE + F.wave) * TPW; tb < NTOK; tb += F.G * NWAVE * TPW) {
      const int b = tb / SEQ;
      f32x4 xall[TPW][4];
#pragma unroll
      for (int i = 0; i < TPW; ++i)
#pragma unroll
        for (int c = 0; c < 4; ++c) xall[i][c] = *(const f32x4*)(xsrc + (size_t)(tb + i) * DM + c * 256 + F.lane * 4);
      if (COMBINE) {
        int ts[TPW][2];
#pragma unroll
        for (int i = 0; i < TPW; ++i) { ts[i][0] = tokslot[(tb + i) * 2]; ts[i][1] = tokslot[(tb + i) * 2 + 1]; }
        u32x2 yv[TPW][2][4];
#pragma unroll
        for (int i = 0; i < TPW; ++i)
#pragma unroll
          for (int k = 0; k < 2; ++k) {
            const size_t r = (size_t)(seg[ts[i][k] >> 20] + (ts[i][k] & 0xfffff));
#pragma unroll
            for (int c = 0; c < 4; ++c) yv[i][k][c] = *(const u32x2*)(ymoe + r * DM + c * 256 + F.lane * 4);
          }
        const float* g2 = mod + ((size_t)layer_c * NB + b) * 6 * DM + 5 * DM;
#pragma unroll
        for (int c = 0; c < 4; ++c) {
          const int col = c * 256 + F.lane * 4;
          const f32x4 gv = *(const f32x4*)(g2 + col);
#pragma unroll
          for (int i = 0; i < TPW; ++i) {
            const u32x2 y0 = yv[i][0][c], y1 = yv[i][1][c];
            xall[i][c][0] += gv[0] * (bf_lo(y0[0]) + bf_lo(y1[0])); xall[i][c][1] += gv[1] * (bf_hi(y0[0]) + bf_hi(y1[0]));
            xall[i][c][2] += gv[2] * (bf_lo(y0[1]) + bf_lo(y1[1])); xall[i][c][3] += gv[3] * (bf_hi(y0[1]) + bf_hi(y1[1]));
            if (!FINAL) *(f32x4*)(a.out + (size_t)(tb + i) * DM + col) = xall[i][c];
          }
        }
      }
#pragma unroll
      for (int ti = 0; ti < TPW; ++ti) {
        const int tok = tb + ti;
        f32x4 xv[4];
#pragma unroll
        for (int c = 0; c < 4; ++c) xv[c] = xall[ti][c];
        float ss = 0.f;
#pragma unroll
        for (int c = 0; c < 4; ++c) ss += xv[c][0] * xv[c][0] + xv[c][1] * xv[c][1] + xv[c][2] * xv[c][2] + xv[c][3] * xv[c][3];
        ss = wave_sum(ss);
        const float rinv = rsqrtf(ss * (1.0f / DM) + EPS);
        if (FINAL) {
#pragma unroll
            for (int c = 0; c < 4; ++c) {
                const int col = c * 256 + F.lane * 4;
                const f32x4 g = *(const f32x4*)(a.final_norm_g + col);
                f32x4 o; o[0] = xv[c][0] * rinv * g[0]; o[1] = xv[c][1] * rinv * g[1]; o[2] = xv[c][2] * rinv * g[2]; o[3] = xv[c][3] * rinv * g[3];
                *(f32x4*)(a.out + (size_t)tok * DM + col) = o;
            }
            continue;
        }
        const float* ng = a.norm_g + ((size_t)layer * 2 + which) * DM;
        const float* sh = mod + ((size_t)layer * NB + b) * 6 * DM + (which ? 3 : 0) * DM;
        const float* sc = sh + DM;
        f32x4 hv[4];
#pragma unroll
        for (int c = 0; c < 4; ++c) {
            const int col = c * 256 + F.lane * 4;
            const f32x4 g = *(const f32x4*)(ng + col), s1 = *(const f32x4*)(sc + col), s0 = *(const f32x4*)(sh + col);
#pragma unroll
            for (int u = 0; u < 4; ++u) hv[c][u] = (xv[c][u] * rinv * g[u]) * (1.0f + s1[u]) + s0[u];
            u32x2 w; w[0] = pack_bf16(hv[c][0], hv[c][1]); w[1] = pack_bf16(hv[c][2], hv[c][3]);
            *(u32x2*)(hbuf + (size_t)tok * DM + col) = w;
        }
        if (ROUTE) {
            LAS float* lgs = (LAS float*)(F.lds + 36 * WR_LD * 4 + 256) + F.wave * 36;
#pragma unroll 1
            for (int jb = 0; jb < 36; jb += 4) {
                float pp[4];
#pragma unroll
                for (int u = 0; u < 4; ++u) {
                    float p = 0.f;
#pragma unroll
                    for (int c = 0; c < 4; ++c) {
                        const f32x4 w = *(const LAS f32x4*)(wrT + (jb + u) * WR_LD + c * 256 + F.lane * 4);
                        p += hv[c][0] * w[0] + hv[c][1] * w[1] + hv[c][2] * w[2] + hv[c][3] * w[3];
                    }
                    pp[u] = p;
                }
#pragma unroll
                for (int u = 0; u < 4; ++u) pp[u] = wave_sum(pp[u]);
                if (F.lane == 0) { *(LAS f32x4*)(lgs + jb) = (f32x4){pp[0], pp[1], pp[2], pp[3]}; }
            }
            float lg[36];
#pragma unroll
            for (int j = 0; j < 36; ++j) lg[j] = lgs[j] + brs[j];
            int g = 0; float gm = lg[0];
#pragma unroll
            for (int j = 1; j < 4; ++j) if (lg[j] > gm) { gm = lg[j]; g = j; }
            float den = 0.f;
#pragma unroll
            for (int j = 0; j < 4; ++j) den += __expf(lg[j] - gm);
            const float ptop = 1.0f / den;
            float fv[8];
#pragma unroll
            for (int i = 0; i < 8; ++i) fv[i] = (g == 0) ? lg[4 + i] : (g == 1) ? lg[12 + i] : (g == 2) ? lg[20 + i] : lg[28 + i];
            int i1 = 0; float v1 = fv[0];
#pragma unroll
            for (int i = 1; i < 8; ++i) if (fv[i] > v1) { v1 = fv[i]; i1 = i; }
            int i2 = -1; float v2 = -3.0e38f;
#pragma unroll
            for (int i = 0; i < 8; ++i) if (i != i1 && fv[i] > v2) { v2 = fv[i]; i2 = i; }
            const float e2 = __expf(v2 - v1), ga = ptop / (1.0f + e2), gb = ptop * e2 / (1.0f + e2);
            if (F.lane == 0) {
                const int li = ((tb - F.bid * NWAVE * TPW) / (F.G * NWAVE * TPW)) * NWAVE * TPW + F.wave * TPW + ti;
                const int ea = g * 8 + i1, eb = g * 8 + i2;
                const int ra = __hip_atomic_fetch_add(&rcnt[ea], 1, __ATOMIC_RELAXED, __HIP_MEMORY_SCOPE_WORKGROUP);
                const int rb = __hip_atomic_fetch_add(&rcnt[eb], 1, __ATOMIC_RELAXED, __HIP_MEMORY_SCOPE_WORKGROUP);
                if (li < RT_CAP) { rt_er[2 * li] = (ea << 16) | ra; rt_gate[2 * li] = ga; rt_tok[2 * li] = tok; rt_er[2 * li + 1] = (eb << 16) | rb; rt_gate[2 * li + 1] = gb; rt_tok[2 * li + 1] = tok; }
            }
        }
      }
    }
    if (ROUTE) {
        __syncthreads();
        unsigned* cnt = ctl + CW_CNT + layer * NEXP * CNT_STRIDE;
        if (F.tid < NEXP) { const int n = rcnt[F.tid]; rbase[F.tid] = n ? (int)__hip_atomic_fetch_add(cnt + F.tid * CNT_STRIDE, (unsigned)n, __ATOMIC_RELAXED, __HIP_MEMORY_SCOPE_AGENT) : 0; }
        __syncthreads();
        int* list = (int*)(a.ws + WS_LIST); float* gatev = (float*)(a.ws + WS_GATEV); int* tsl = (int*)(a.ws + WS_TOKSLOT);
        int nloc = 0;
        for (int tb = F.bid * NWAVE * TPW; tb < NTOK; tb += F.G * NWAVE * TPW) nloc += NWAVE * TPW;
        nloc = nloc < RT_CAP ? nloc : RT_CAP;
        for (int i = F.tid; i < 2 * nloc; i += NTHR) {
            const int er = rt_er[i]; if (er < 0) continue;
            const int e = er >> 16, pos = rbase[e] + (er & 0xffff), tok = rt_tok[i];
            list[e * NTOK + pos] = tok; gatev[e * NTOK + pos] = rt_gate[i]; tsl[tok * 2 + (i & 1)] = (e << 20) | pos;
        }
    }
    __syncthreads();
}

constexpr int RP_HT = 0, RP_HT_LD = 1028;
constexpr int RP_PART = 16 * RP_HT_LD * 4;
constexpr int RP_LG = RP_PART + 8 * 16 * 48 * 4;
DI void route_phase(const Frame& F, const Args& a, int layer) {
    const float* mod = (const float*)(a.ws + WS_MOD);
    bf16_t* hbuf = (bf16_t*)(a.ws + WS_H);
    unsigned* ctl = (unsigned*)(a.ws + WS_CTL);
    LAS float* HT = (LAS float*)(F.lds + RP_HT);
    LAS float* PART = (LAS float*)(F.lds + RP_PART);
    LAS float* LG = (LAS float*)(F.lds + RP_LG);
    constexpr int RT_CAP = 512;
    LAS int* rcnt = (LAS int*)(F.lds + 149504);
    LAS int* rbase = (LAS int*)(F.lds + 149632);
    LAS int* rt_er = (LAS int*)(F.lds + 149760);
    LAS float* rt_gate = (LAS float*)(F.lds + 149760 + 4096);
    LAS int* rt_tok = (LAS int*)(F.lds + 149760 + 8192);
    if (F.tid < NEXP) rcnt[F.tid] = 0;
    for (int i = F.tid; i < 2 * RT_CAP; i += NTHR) rt_er[i] = -1;
    const float* wg = a.moe_wr_g + (size_t)layer * DM * 4;
    const float* we = a.moe_wr_e + (size_t)layer * DM * 32;
    const int col = F.lane & 15, kq = F.lane >> 4;
    float Bw[3][32];
#pragma unroll
    for (int s2 = 0; s2 < 32; ++s2) {
        const int k = 128 * F.wave + 16 * (s2 >> 2) + 4 * kq + (s2 & 3);
        Bw[0][s2] = col < 4 ? wg[k * 4 + col] : we[k * 32 + col - 4];
        Bw[1][s2] = we[k * 32 + 12 + col];
        Bw[2][s2] = col < 4 ? we[k * 32 + 28 + col] : 0.f;
    }
    const float* ng = a.norm_g + ((size_t)layer * 2 + 1) * DM;
    __syncthreads();
    const int ngroups = NTOK / 16;
    int li0 = 0;
    for (int gi = F.bid; gi < ngroups; gi += F.G, li0 += 16) {
        const int tb = gi * 16 + F.wave * 2, b = tb / SEQ;
        const float* sh = mod + ((size_t)layer * NB + b) * 6 * DM + 3 * DM;
        const float* scp = sh + DM;
#pragma unroll
        for (int ti = 0; ti < 2; ++ti) {
            const int tok = tb + ti;
            f32x4 xv[4];
#pragma unroll
            for (int c = 0; c < 4; ++c) xv[c] = *(const f32x4*)(a.out + (size_t)tok * DM + c * 256 + F.lane * 4);
            float ss = 0.f;
#pragma unroll
            for (int c = 0; c < 4; ++c) ss += xv[c][0] * xv[c][0] + xv[c][1] * xv[c][1] + xv[c][2] * xv[c][2] + xv[c][3] * xv[c][3];
            ss = wave_sum(ss);
            const float rinv = rsqrtf(ss * (1.0f / DM) + EPS);
#pragma unroll
            for (int c = 0; c < 4; ++c) {
                const int cl = c * 256 + F.lane * 4;
                const f32x4 g = *(const f32x4*)(ng + cl), s1 = *(const f32x4*)(scp + cl), s0 = *(const f32x4*)(sh + cl);
                f32x4 hv;
#pragma unroll
                for (int u = 0; u < 4; ++u) hv[u] = (xv[c][u] * rinv * g[u]) * (1.0f + s1[u]) + s0[u];
                u32x2 w; w[0] = pack_bf16(hv[0], hv[1]); w[1] = pack_bf16(hv[2], hv[3]);
                *(u32x2*)(hbuf + (size_t)tok * DM + cl) = w;
                *(LAS f32x4*)(HT + (F.wave * 2 + ti) * RP_HT_LD + cl) = hv;
            }
        }
        __syncthreads();
        {
            f32x4 acc[3];
#pragma unroll
            for (int n = 0; n < 3; ++n) acc[n] = (f32x4){0.f, 0.f, 0.f, 0.f};
            const LAS float* ap = HT + col * RP_HT_LD + 128 * F.wave + 4 * kq;
#pragma unroll
            for (int s4 = 0; s4 < 8; ++s4) {
                const f32x4 av = *(const LAS f32x4*)(ap + 16 * s4);
#pragma unroll
                for (int u = 0; u < 4; ++u)
#pragma unroll
                    for (int n = 0; n < 3; ++n) acc[n] = __builtin_amdgcn_mfma_f32_16x16x4f32(av[u], Bw[n][4 * s4 + u], acc[n], 0, 0, 0);
            }
#pragma unroll
            for (int n = 0; n < 3; ++n)
#pragma unroll
                for (int r = 0; r < 4; ++r) PART[(F.wave * 16 + 4 * kq + r) * 48 + 16 * n + col] = acc[n][r];
        }
        __syncthreads();
        {
            const int tk = F.tid >> 5, j = F.tid & 31;
            float s0 = 0.f, s1 = 0.f;
#pragma unroll
            for (int wv = 0; wv < NWAVE; ++wv) { s0 += PART[(wv * 16 + tk) * 48 + j]; s1 += PART[(wv * 16 + tk) * 48 + 32 + (j & 3)]; }
            LG[tk * 36 + j] = s0 + (j < 4 ? a.moe_br_g[layer * 4 + j] : a.moe_br_e[layer * 32 + j - 4]);
            if (j < 4) LG[tk * 36 + 32 + j] = s1 + a.moe_br_e[layer * 32 + 28 + j];
        }
        __syncthreads();
        if (F.tid < 16) {
            const int tk = F.tid, tok = gi * 16 + tk;
            float lg[36];
#pragma unroll
            for (int j = 0; j < 36; ++j) lg[j] = LG[tk * 36 + j];
            int g = 0; float gm = lg[0];
#pragma unroll
            for (int j = 1; j < 4; ++j) if (lg[j] > gm) { gm = lg[j]; g = j; }
            float den = 0.f;
#pragma unroll
            for (int j = 0; j < 4; ++j) den += __expf(lg[j] - gm);
            const float ptop = 1.0f / den;
            float fv[8];
#pragma unroll
            for (int i = 0; i < 8; ++i) fv[i] = (g == 0) ? lg[4 + i] : (g == 1) ? lg[12 + i] : (g == 2) ? lg[20 + i] : lg[28 + i];
            int i1 = 0; float v1 = fv[0];
#pragma unroll
            for (int i = 1; i < 8; ++i) if (fv[i] > v1) { v1 = fv[i]; i1 = i; }
            int i2 = -1; float v2 = -3.0e38f;
#pragma unroll
            for (int i = 0; i < 8; ++i) if (i != i1 && fv[i] > v2) { v2 = fv[i]; i2 = i; }
            const float e2 = __expf(v2 - v1), ga = ptop / (1.0f + e2), gb = ptop * e2 / (1.0f + e2);
            const int li = li0 + tk, ea = g * 8 + i1, eb = g * 8 + i2;
            const int ra = __hip_atomic_fetch_add(&rcnt[ea], 1, __ATOMIC_RELAXED, __HIP_MEMORY_SCOPE_WORKGROUP);
            const int rb = __hip_atomic_fetch_add(&rcnt[eb], 1, __ATOMIC_RELAXED, __HIP_MEMORY_SCOPE_WORKGROUP);
            if (li < RT_CAP) { rt_er[2 * li] = (ea << 16) | ra; rt_gate[2 * li] = ga; rt_tok[2 * li] = tok; rt_er[2 * li + 1] = (eb << 16) | rb; rt_gate[2 * li + 1] = gb; rt_tok[2 * li + 1] = tok; }
        }
    }
    __syncthreads();
    unsigned* cnt = ctl + CW_CNT + layer * NEXP * CNT_STRIDE;
    if (F.tid < NEXP) { const int n = rcnt[F.tid]; rbase[F.tid] = n ? (int)__hip_atomic_fetch_add(cnt + F.tid * CNT_STRIDE, (unsigned)n, __ATOMIC_RELAXED, __HIP_MEMORY_SCOPE_AGENT) : 0; }
    __syncthreads();
    int* list = (int*)(a.ws + WS_LIST); float* gatev = (float*)(a.ws + WS_GATEV); int* tsl = (int*)(a.ws + WS_TOKSLOT);
    const int nloc = li0 < RT_CAP ? li0 : RT_CAP;
    for (int i = F.tid; i < 2 * nloc; i += NTHR) {
        const int er = rt_er[i]; if (er < 0) continue;
        const int e = er >> 16, pos = rbase[e] + (er & 0xffff), tok = rt_tok[i];
        list[e * NTOK + pos] = tok; gatev[e * NTOK + pos] = rt_gate[i]; tsl[tok * 2 + (i & 1)] = (e << 20) | pos;
    }
    __syncthreads();
}

constexpr int LDS_MISC = 131072 + 64;
constexpr int LDS_XB = 163840 - 16;
constexpr int LDS_BYTES = 163840;
using pg8::Unit;
struct DenseSched {
    int nM, nN, nwg, G, c; const char* Bt; size_t tstepB;
    DI void init(int M, int N, int K, int G_, int c_, const void* Bt_) { nM = M / 256; nN = N / 256; nwg = nM * nN; G = G_; c = c_; Bt = (const char*)Bt_; tstepB = (size_t)256 * K * 2; }
    DI bool next(int i, Unit& u) const {
        const long L = (long)i * G + c; if (L >= nwg) return false;
        int wgid = (int)L; { const int q = nwg / 8, r = nwg % 8, xcd = wgid % 8, off = wgid / 8; wgid = (xcd < r ? xcd * (q + 1) : r * (q + 1) + (xcd - r) * q) + off; }
        const int nig = 8 * nN, gid = wgid / nig, fm = gid * 8, gsz = (nM - fm) < 8 ? (nM - fm) : 8;
        u.pm = fm + ((wgid % nig) % gsz); u.pn = (wgid % nig) / gsz; u.e = 0; u.nrow = 256; return true;
    }
    DI int a_row(const Unit& u, int r) const { return u.pm * 256 + r; }
    DI const char* b_base(const Unit& u) const { return Bt + (size_t)u.pn * tstepB; }
};
template <bool UP>
struct MoeSched {
    const LAS int* ntp; const unsigned* cnt; const int* list; const char* W; int nU, G, c;
    DI bool next(int i, Unit& u) const {
        const long L = (long)i * G + c; if (L >= nU) return false;
        int wgid = (int)L; { const int q = nU / 8, r = nU % 8, xcd = wgid % 8, off = wgid / 8; wgid = (xcd < r ? xcd * (q + 1) : r * (q + 1) + (xcd - r) * q) + off; }
        const int tg = wgid >> 2; u.pn = wgid & 3; u.pm = tg;
        int e = 0;
        for (int k = 1; k < NEXP; ++k) e += (ntp[k] <= tg) ? 1 : 0;
        u.e = e; const int rem = ntp[40 + e] - (tg - ntp[e]) * 256; u.nrow = rem < 256 ? rem : 256; return true;
    }
    DI int a_row(const Unit& u, int r) const {
        if (UP) { const int p = (u.pm - ntp[u.e]) * 256 + r; return (r < u.nrow) ? list[u.e * NTOK + p] : 0; }
        return u.pm * 256 + r;
    }
    DI const char* b_base(const Unit& u) const {
        return W + (size_t)u.e * 3 * MiB + (UP ? (size_t)u.pn * 256 * DM * 2 : 2 * MiB + (size_t)u.pn * 256 * DEXP * 2);
    }
};
DI void moe_tile_table(const Frame& F, const unsigned* cnt, LAS int* ntp  ) {
    if (F.tid < NEXP) ntp[40 + F.tid] = (int)cnt[F.tid * CNT_STRIDE];
    __syncthreads();
    if (F.tid == 0) { int s = 0; for (int e = 0; e < NEXP; ++e) { ntp[e] = s; s += (ntp[40 + e] + 255) >> 8; } ntp[NEXP] = s; }
    __syncthreads();
}

#define EPI_ROWS_BEGIN const int row0 = u.pm * 256 + wr * 64 + fr; _Pragma("unroll") for (int ai = 0; ai < 2; ++ai) _Pragma("unroll") for (int m = 0; m < 4; ++m) { const int row = row0 + ai * 128 + m * 16;
#define EPI_ROWS_END }
DI u32x2 pack4(const f32x4& v) { u32x2 w; w[0] = pack_bf16(v[0], v[1]); w[1] = pack_bf16(v[2], v[3]); return w; }

struct EpiAbIn {
    bf16_t* Zc;
    DI void operator()(const f32x4 (&acc)[2][2][4][2], const Unit& u, int wr, int wc, int fr, int fq) const {
        EPI_ROWS_BEGIN
            bf16_t* rp = Zc + (size_t)row * ZC_N;
            if (u.pn < 2) {
#pragma unroll
                for (int bj = 0; bj < 2; ++bj) {
                    const u32x2 lo = pack4(acc[ai][bj][m][0]), hi = pack4(acc[ai][bj][m][1]);
                    *(u32x4*)(rp + u.pn * 256 + bj * 128 + wc * 32 + 8 * fq) = (u32x4){lo[0], lo[1], hi[0], hi[1]};
                }
            } else {
                const int pnp = (u.pn - 2) & 3, j = 128 * pnp + 32 * wc + 8 * fq;
                u32x2 o[2];
#pragma unroll
                for (int bj = 0; bj < 2; ++bj) {
                    const f32x4 X = acc[ai][bj][m][0], Y = acc[ai][bj][m][1]; f32x4 v;
                    if (u.pn < 6) v = X * Y;
                    else { v[0] = X[0] * sigmoid_f(Y[0]); v[1] = X[1] * sigmoid_f(Y[1]); v[2] = X[2] * sigmoid_f(Y[2]); v[3] = X[3] * sigmoid_f(Y[3]); }
                    o[bj] = pack4(v);
                }
                *(u32x4*)(rp + (u.pn < 6 ? 512 : 1024) + j) = (u32x4){o[0][0], o[0][1], o[1][0], o[1][1]};
            }
        EPI_ROWS_END
    }
};
struct EpiResid {
    const float* xin; float* xout; const float* g1;
    DI void operator()(const f32x4 (&acc)[2][2][4][2], const Unit& u, int wr, int wc, int fr, int fq) const {
        const float* g = g1 + (size_t)((u.pm * 256) / SEQ) * 6 * DM;
        const int row0 = u.pm * 256 + wr * 64 + fr, col0 = u.pn * 256 + wc * 32 + 4 * fq;
        f32x4 gv[2][2];
#pragma unroll
        for (int bj = 0; bj < 2; ++bj)
#pragma unroll
            for (int n = 0; n < 2; ++n) gv[bj][n] = *(const f32x4*)(g + col0 + bj * 128 + n * 16);
#pragma unroll
        for (int ai = 0; ai < 2; ++ai) {
            f32x4 xo[4][2][2];
#pragma unroll
            for (int m = 0; m < 4; ++m)
#pragma unroll
                for (int bj = 0; bj < 2; ++bj)
#pragma unroll
                    for (int n = 0; n < 2; ++n) xo[m][bj][n] = *(const f32x4*)(xin + (size_t)(row0 + ai * 128 + m * 16) * DM + col0 + bj * 128 + n * 16);
            asm volatile("" ::: "memory");
#pragma unroll
            for (int m = 0; m < 4; ++m)
#pragma unroll
                for (int bj = 0; bj < 2; ++bj)
#pragma unroll
                    for (int n = 0; n < 2; ++n) *(f32x4*)(xout + (size_t)(row0 + ai * 128 + m * 16) * DM + col0 + bj * 128 + n * 16) = xo[m][bj][n] + gv[bj][n] * acc[ai][bj][m][n];
        }
    }
};
struct EpiPlain {
    bf16_t* O; int ld;
    DI void operator()(const f32x4 (&acc)[2][2][4][2], const Unit& u, int wr, int wc, int fr, int fq) const {
        EPI_ROWS_BEGIN
#pragma unroll
            for (int bj = 0; bj < 2; ++bj) {
                const u32x2 lo = pack4(acc[ai][bj][m][0]), hi = pack4(acc[ai][bj][m][1]);
                *(u32x4*)(O + (size_t)row * ld + u.pn * 256 + bj * 128 + wc * 32 + 8 * fq) = (u32x4){lo[0], lo[1], hi[0], hi[1]};
            }
        EPI_ROWS_END
    }
};
struct EpiPlainNat {
    bf16_t* O; int ld;
    DI void operator()(const f32x4 (&acc)[2][2][4][2], const Unit& u, int wr, int wc, int fr, int fq) const {
        EPI_ROWS_BEGIN
#pragma unroll
            for (int bj = 0; bj < 2; ++bj)
#pragma unroll
                for (int n = 0; n < 2; ++n) *(u32x2*)(O + (size_t)row * ld + u.pn * 256 + bj * 128 + wc * 32 + n * 16 + 4 * fq) = pack4(acc[ai][bj][m][n]);
        EPI_ROWS_END
    }
};
struct EpiMoeUp {
    bf16_t* act;
    DI void operator()(const f32x4 (&acc)[2][2][4][2], const Unit& u, int wr, int wc, int fr, int fq) const {
        EPI_ROWS_BEGIN
            u32x2 o[2];
#pragma unroll
            for (int bj = 0; bj < 2; ++bj) {
                const f32x4 X = acc[ai][bj][m][0], Y = acc[ai][bj][m][1]; f32x4 v;
                v[0] = silu_f(X[0]) * Y[0]; v[1] = silu_f(X[1]) * Y[1]; v[2] = silu_f(X[2]) * Y[2]; v[3] = silu_f(X[3]) * Y[3];
                o[bj] = pack4(v);
            }
            *(u32x4*)(act + (size_t)row * DEXP + 128 * u.pn + 32 * wc + 8 * fq) = (u32x4){o[0][0], o[0][1], o[1][0], o[1][1]};
        EPI_ROWS_END
    }
};
struct EpiMoeDown {
    bf16_t* y; const float* gatev; const LAS int* ntp;
    DI void operator()(const f32x4 (&acc)[2][2][4][2], const Unit& u, int wr, int wc, int fr, int fq) const {
        const int pbase = (u.pm - ntp[u.e]) * 256;
        EPI_ROWS_BEGIN
            const int r = row - u.pm * 256;
            const float gt = (r < u.nrow) ? gatev[u.e * NTOK + pbase + r] : 0.f;
#pragma unroll
            for (int bj = 0; bj < 2; ++bj) {
                const u32x2 lo = pack4(acc[ai][bj][m][0] * gt), hi = pack4(acc[ai][bj][m][1] * gt);
                *(u32x4*)(y + (size_t)row * DM + u.pn * 256 + bj * 128 + wc * 32 + 8 * fq) = (u32x4){lo[0], lo[1], hi[0], hi[1]};
            }
        EPI_ROWS_END
    }
};

DI void conv_phase(const Frame& F, const Args& a) {
    const bf16_t* Zc = (const bf16_t*)(a.ws + WS_BIG);
    bf16_t* Y = (bf16_t*)(a.ws + WS_Y);
    LAS unsigned* PB = (LAS unsigned*)F.lds;
    LAS f32x2* ST = (LAS f32x2*)(F.lds + 94 * 1024);
    const int cp = F.tid & 255, th = F.tid >> 8, wq = F.wave & 3;
    float wb[31][2], wa[3][2];
#pragma unroll
    for (int k = 0; k < 31; ++k) { const f32x2 w = *(const f32x2*)(a.ab_conv_b + k * 512 + 2 * cp); wb[k][0] = w[0]; wb[k][1] = w[1]; }
#pragma unroll
    for (int k = 0; k < 3; ++k) { const f32x2 w = *(const f32x2*)(a.ab_conv_a + k * 512 + 2 * cp); wa[k][0] = w[0]; wa[k][1] = w[1]; }
    const f32x2 cbias = *(const f32x2*)(a.ab_conv_b_bias + 2 * cp), lng = *(const f32x2*)(a.ab_ln_g + 2 * cp), lnb = *(const f32x2*)(a.ab_ln_b + 2 * cp);
    for (int tile = F.bid; tile < NTOK / 64; tile += F.G) {
        const int t0 = tile * 64, b = t0 / SEQ, tl0 = t0 % SEQ;
        for (int i = F.tid; i < 94 * 64; i += NTHR) {
            const int r = i >> 6, c8 = i & 63, pos = tl0 - 30 + r;
            u32x4 v = {0u, 0u, 0u, 0u};
            if (pos >= 0) v = *(const u32x4*)(Zc + (size_t)(b * SEQ + pos) * ZC_N + 1024 + c8 * 8);
            *(LAS u32x4*)(PB + r * 256 + c8 * 4) = v;
        }
        __syncthreads();
#pragma unroll 1
        for (int g = 0; g < 4; ++g) {
            float U[8][2];
#pragma unroll
            for (int i = 0; i < 8; ++i) { U[i][0] = cbias[0]; U[i][1] = cbias[1]; }
#pragma unroll
            for (int r = 0; r < 38; ++r) {
                const unsigned xw = PB[(32 * th + 8 * g + r) * 256 + cp];
                const float x0 = bf_lo(xw), x1 = bf_hi(xw);
#pragma unroll
                for (int i = 0; i < 8; ++i) { const int k = r - i; if (k >= 0 && k <= 30) { U[i][0] += wb[k][0] * x0; U[i][1] += wb[k][1] * x1; } }
            }
            unsigned gwv[8], pav[10];
#pragma unroll
            for (int i = 0; i < 8; ++i) gwv[i] = *(const unsigned*)(Zc + ((size_t)t0 + 32 * th + 8 * g + i) * ZC_N + 2 * cp);
#pragma unroll
            for (int i = 0; i < 10; ++i) { const int pp = tl0 + 32 * th + 8 * g + i - 2; pav[i] = pp >= 0 ? *(const unsigned*)(Zc + (size_t)(b * SEQ + pp) * ZC_N + 512 + 2 * cp) : 0u; }
            {
                float v[16];
#pragma unroll
                for (int i = 0; i < 8; ++i) { v[2 * i] = U[i][0] + U[i][1]; v[2 * i + 1] = U[i][0] * U[i][0] + U[i][1] * U[i][1]; }
#pragma unroll
                for (int hw = 8; hw >= 1; hw >>= 1) {
                    const bool up = (F.lane & (4 * hw)) != 0;
#pragma unroll
                    for (int i = 0; i < hw; ++i) { const float send = up ? v[i] : v[i + hw], keep = up ? v[i + hw] : v[i]; v[i] = keep + __shfl_xor(send, 4 * hw); }
                }
                v[0] += __shfl_xor(v[0], 2); v[0] += __shfl_xor(v[0], 1);
                if ((F.lane & 3) == 0) { const int idx = F.lane >> 2; ((LAS float*)ST)[((32 * th + 8 * g + (idx >> 1)) * 4 + wq) * 2 + (idx & 1)] = v[0]; }
            }
            __syncthreads();
#pragma unroll
            for (int i = 0; i < 8; ++i) {
                const int tl = 32 * th + 8 * g + i; const size_t tok = (size_t)t0 + tl;
                const f32x2 p0 = ST[tl * 4 + 0], p1 = ST[tl * 4 + 1], p2 = ST[tl * 4 + 2], p3 = ST[tl * 4 + 3];
                const float mean = ((p0[0] + p1[0]) + (p2[0] + p3[0])) * (1.0f / 512.0f);
                const float var = ((p0[1] + p1[1]) + (p2[1] + p3[1])) * (1.0f / 512.0f) - mean * mean;
                const float rstd = rsqrtf(var + EPS);
                const float yb0 = silu_f((U[i][0] - mean) * rstd * lng[0] + lnb[0]), yb1 = silu_f((U[i][1] - mean) * rstd * lng[1] + lnb[1]);
                *(unsigned*)(Y + tok * DM + 512 + 2 * cp) = pack_bf16(yb0, yb1);
                float a0 = 0.f, a1 = 0.f;
#pragma unroll
                for (int k = 0; k < 3; ++k) { const unsigned w = pav[i + k]; a0 += wa[k][0] * bf_lo(w); a1 += wa[k][1] * bf_hi(w); }
                const unsigned gw = gwv[i];
                *(unsigned*)(Y + tok * DM + 2 * cp) = pack_bf16(bf_lo(gw) * a0, bf_hi(gw) * a1);
            }
        }
        __syncthreads();
    }
}

#define MFMA32(a, b, c) __builtin_amdgcn_mfma_f32_32x32x16_bf16((a), (b), (c), 0, 0, 0)
#define LDS6_ISSUE(B, addr, o0, o1, o2, o3, o4, o5) asm volatile( \
    "ds_read_b128 %0, %6 offset:" #o0 "\n\tds_read_b128 %1, %6 offset:" #o1 "\n\tds_read_b128 %2, %6 offset:" #o2 "\n\tds_read_b128 %3, %6 offset:" #o3 "\n\tds_read_b128 %4, %6 offset:" #o4 "\n\tds_read_b128 %5, %6 offset:" #o5 \
    : "=&v"(B[0]), "=&v"(B[1]), "=&v"(B[2]), "=&v"(B[3]), "=&v"(B[4]), "=&v"(B[5]) : "v"(addr) : "memory")
#define LDS6_WAIT(B) asm volatile("s_waitcnt lgkmcnt(0)" : "+v"(B[0]), "+v"(B[1]), "+v"(B[2]), "+v"(B[3]), "+v"(B[4]), "+v"(B[5]) :: "memory")
constexpr int TK_HIST = 0;
constexpr int TK_HLD = 513;
constexpr int TK_TAB = 66048;
constexpr int TK_CAP = 256;
constexpr int TK_CAND = 66560;
constexpr int TK_CCNT = TK_CAND + 32 * TK_CAP * 4;
constexpr int TK_OVF = TK_CCNT + 128;
constexpr int TK_BQ = 100352;
constexpr int TK_MASK = 118784;
DI int crow_c(int r) { return (r & 3) + 8 * (r >> 2); }
template <int MODE, bool DIAG>
DI void topk_elems(const Frame& F, const f32x16& sc, int kt, int q, int h2, int myT, LAS unsigned* hist, LAS unsigned* cand, LAS int* ccnt, LAS unsigned* maskl) {
    const int lo = myT << 9, hi = (myT + 1) << 9;
    if (MODE <= 2) {
#pragma unroll
        for (int r = 0; r < 16; ++r) {
            unsigned key = (unsigned)fmaxf(sc[r], 0.0f); key = key > 262143u ? 262143u : key;
            const bool valid = !DIAG || (crow_c(r) + 4 * h2 <= q);
            if (MODE == 1) { if (valid) __hip_atomic_fetch_add(&hist[q * TK_HLD + (key >> 9)], 1u, __ATOMIC_RELAXED, __HIP_MEMORY_SCOPE_WORKGROUP); }
            else { if (valid && (int)(key >> 9) == myT) __hip_atomic_fetch_add(&hist[q * TK_HLD + (key & 511)], 1u, __ATOMIC_RELAXED, __HIP_MEMORY_SCOPE_WORKGROUP); }
        }
        return;
    }
    const int selb = (MODE == 3 ? myT : hi - 1), geb = (MODE == 3 ? myT - 1 : lo - 1);
    unsigned selw = 0u, gew = 0u;
#pragma unroll
    for (int r = 0; r < 16; ++r) {
        unsigned key = (unsigned)fmaxf(sc[r], 0.0f); key = key > 262143u ? 262143u : key;
        const unsigned d1 = (unsigned)(selb - (int)key), d2 = (unsigned)(geb - (int)key);
        selw = __builtin_amdgcn_alignbit(selw, d1, 31);
        gew = __builtin_amdgcn_alignbit(gew, d2, 31);
    }
    if (DIAG) {
        unsigned vw = 0u;
#pragma unroll
        for (int r = 0; r < 16; ++r) vw |= (crow_c(r) + 4 * h2 <= q) ? (1u << (15 - r)) : 0u;
        selw &= vw; gew &= vw;
    }
    unsigned cw = gew & ~selw & 0xffffu;
    if (cw) {
#pragma unroll
        for (int r = 0; r < 16; ++r) {
            if (cw & (1u << (15 - r))) {
                unsigned key = (unsigned)fmaxf(sc[r], 0.0f); key = key > 262143u ? 262143u : key;
                const int p = __hip_atomic_fetch_add(&ccnt[q], 1, __ATOMIC_RELAXED, __HIP_MEMORY_SCOPE_WORKGROUP);
                if (p < TK_CAP) cand[q * TK_CAP + p] = (MODE == 3 ? 0u : ((key - (unsigned)lo) << 13)) | (unsigned)(8191 - (32 * kt + crow_c(r) + 4 * h2));
            }
        }
    }
    unsigned rv = __builtin_bitreverse32(selw) >> 16;
    unsigned bits = (rv & 0xfu) | ((rv & 0xf0u) << 4) | ((rv & 0xf00u) << 8) | ((rv & 0xf000u) << 12);
    bits <<= 4 * h2;
    bits |= (unsigned)__shfl_xor((int)bits, 32);
    if (h2 == 0) maskl[q * 256 + kt] = bits;
}
template <int MODE>
DI void topk_pass(const Frame& F, const bf16_t* Z, int b, int t0, const float (&wp)[8]) {
    const LAS unsigned char* bq = F.lds + TK_BQ;
    LAS unsigned* hist = (LAS unsigned*)(F.lds + TK_HIST);
    LAS int* tab = (LAS int*)(F.lds + TK_TAB);
    LAS unsigned* cand = (LAS unsigned*)(F.lds + TK_CAND);
    LAS int* ccnt = (LAS int*)(F.lds + TK_CCNT);
    LAS unsigned* maskl = (LAS unsigned*)(F.lds + TK_MASK);
    const int lane = fresh_lane(), q = lane & 31, h2 = lane >> 5, ntile = t0 / 32 + 1;
    const int myT = (MODE >= 2) ? tab[q * 4 + 0] : 0;
    const unsigned bqa = (unsigned)(size_t)(bq + lane * 16);
    const bf16_t* kbase = Z + (size_t)b * SEQ * CD_N + Z_KI + 8 * h2 + (size_t)q * CD_N;
    bf16x8 A0n = (bf16x8){0, 0, 0, 0, 0, 0, 0, 0}, A1n = A0n;
    if (F.wave < ntile) { const bf16_t* kp = kbase + (size_t)(32 * F.wave) * CD_N; A0n = *(const bf16x8*)kp; A1n = *(const bf16x8*)(kp + 16); }
    for (int kt = F.wave; kt < ntile; kt += NWAVE) {
        const bf16x8 A0 = A0n, A1 = A1n;
        if (kt + NWAVE < ntile) { const bf16_t* kp = kbase + (size_t)(32 * (kt + NWAVE)) * CD_N; A0n = *(const bf16x8*)kp; A1n = *(const bf16x8*)(kp + 16); }
        f32x16 sc;
#pragma unroll
        for (int r = 0; r < 16; ++r) sc[r] = 131072.0f;
        {
#define TK_MF0(acc, A, B) asm volatile("v_mfma_f32_32x32x16_bf16 %0, %1, %2, 0" : "=&v"(acc) : "v"(A), "v"(B))
#define TK_MF1(acc, A, B) asm volatile("v_mfma_f32_32x32x16_bf16 %0, %1, %2, %0" : "+v"(acc) : "v"(A), "v"(B))
#define TK_FA(sv, av, wv) asm volatile("v_fma_f32 %0, |%1|, %2, %0" : "+v"(sv) : "v"(av), "v"(wv))
#define TK_AD(sv, av) asm volatile("v_add_f32 %0, %0, %1" : "+v"(sv) : "v"(av))
        bf16x8 Ba[6], Bb[6];
        f32x16 acA[3], acB[3];
        LDS6_ISSUE(Ba, bqa, 16384, 17408, 0, 1024, 2048, 3072);
        LDS6_WAIT(Ba);
        LDS6_ISSUE(Bb, bqa, 4096, 5120, 6144, 7168, 8192, 9216);
#pragma unroll
        for (int u = 0; u < 3; ++u) TK_MF0(acA[u], A0, Ba[2 * u]);
#pragma unroll
        for (int u = 0; u < 3; ++u) TK_MF1(acA[u], A1, Ba[2 * u + 1]);
        LDS6_WAIT(Bb);
        LDS6_ISSUE(Ba, bqa, 10240, 11264, 12288, 13312, 14336, 15360);
#pragma unroll
        for (int m = 0; m < 6; ++m) {
            if (m >= 3) TK_MF1(acB[m - 3], A1, Bb[2 * (m - 3) + 1]); else TK_MF0(acB[m], A0, Bb[2 * m]);
#pragma unroll
            for (int e = 0; e < 8; ++e) { const int i = 8 * m + e, u = i >> 4, r = i & 15; if (u == 0) TK_AD(sc[r], acA[0][r]); else TK_FA(sc[r], acA[u][r], wp[u - 1]); }
        }
        LDS6_WAIT(Ba);
#pragma unroll
        for (int m = 0; m < 6; ++m) {
            if (m >= 3) TK_MF1(acA[m - 3], A1, Ba[2 * (m - 3) + 1]); else TK_MF0(acA[m], A0, Ba[2 * m]);
#pragma unroll
            for (int e = 0; e < 8; ++e) { const int i = 8 * m + e, u = i >> 4, r = i & 15; TK_FA(sc[r], acB[u][r], wp[2 + u]); }
        }
#pragma unroll
        for (int u = 0; u < 3; ++u)
#pragma unroll
            for (int r = 0; r < 16; ++r) TK_FA(sc[r], acA[u][r], wp[5 + u]);
#undef TK_MF0
#undef TK_MF1
#undef TK_FA
#undef TK_AD
        }
        if (kt == ntile - 1) topk_elems<MODE, true>(F, sc, kt, q, h2, myT, hist, cand, ccnt, maskl);
        else topk_elems<MODE, false>(F, sc, kt, q, h2, myT, hist, cand, ccnt, maskl);
    }
}
DI void topk_scan(const Frame& F, int pass, int t0) {
    LAS unsigned* hist = (LAS unsigned*)(F.lds + TK_HIST);
    LAS int* tab = (LAS int*)(F.lds + TK_TAB);
    LAS int* ovf = (LAS int*)(F.lds + TK_OVF);
    for (int qi = 0; qi < 4; ++qi) {
        const int q = F.wave * 4 + qi, n = t0 + q + 1;
        int need = 256, prevT = 0, prevAbove = 0;
        if (pass == 2) { prevT = tab[q * 4 + 0]; prevAbove = tab[q * 4 + 1]; need = 256 - prevAbove; }
        if (n <= 256) { if (F.lane == 0) { tab[q * 4 + 0] = -1; tab[q * 4 + 1] = 0; tab[q * 4 + 2] = 0; } continue; }
        unsigned hv[8]; unsigned s = 0;
#pragma unroll
        for (int i = 0; i < 8; ++i) { hv[i] = hist[q * TK_HLD + 511 - (8 * F.lane + i)]; s += hv[i]; }
        unsigned inc = s;
#pragma unroll
        for (int o = 1; o < 64; o <<= 1) { const unsigned v = (unsigned)__shfl_up((int)inc, o); if (F.lane >= o) inc += v; }
        const unsigned pre = inc - s;
        if ((int)pre < need && (int)inc >= need) {
            unsigned cum = pre; int bsel = 0; unsigned above = 0, inbin = 0; bool found = false;
#pragma unroll
            for (int i = 0; i < 8; ++i) { if (!found && (int)(cum + hv[i]) >= need) { found = true; bsel = 511 - (8 * F.lane + i); above = cum; inbin = hv[i]; } cum += hv[i]; }
            if (pass == 1) { tab[q * 4 + 0] = bsel; tab[q * 4 + 1] = (int)above; tab[q * 4 + 2] = 256 - (int)above; if (inbin > (unsigned)TK_CAP) *ovf = 1; }
            else { tab[q * 4 + 0] = (prevT << 9) | bsel; tab[q * 4 + 1] = prevAbove + (int)above; tab[q * 4 + 2] = 256 - (prevAbove + (int)above); }
        }
    }
}
DI void topk_select(const Frame& F) {
    LAS int* tab = (LAS int*)(F.lds + TK_TAB);
    LAS unsigned* cand = (LAS unsigned*)(F.lds + TK_CAND);
    LAS int* ccnt = (LAS int*)(F.lds + TK_CCNT);
    LAS unsigned* maskl = (LAS unsigned*)(F.lds + TK_MASK);
    for (int qi = 0; qi < 4; ++qi) {
        const int q = F.wave * 4 + qi, need = tab[q * 4 + 2];
        int n = ccnt[q]; n = n > TK_CAP ? TK_CAP : n;
        if (need <= 0 || n <= 0) continue;
        unsigned c[4]; int rk[4]; bool vv[4];
#pragma unroll
        for (int i = 0; i < 4; ++i) { vv[i] = F.lane + 64 * i < n; c[i] = vv[i] ? cand[q * TK_CAP + F.lane + 64 * i] : 0u; rk[i] = 0; }
        for (int j = 0; j < n; ++j) {
            const unsigned cj = cand[q * TK_CAP + j];
#pragma unroll
            for (int i = 0; i < 4; ++i) rk[i] += (cj > c[i]) ? 1 : 0;
        }
#pragma unroll
        for (int i = 0; i < 4; ++i)
            if (vv[i] && rk[i] < need) { const int idx = 8191 - (int)(c[i] & 8191u); __hip_atomic_fetch_or(&maskl[q * 256 + (idx >> 5)], 1u << (idx & 31), __ATOMIC_RELAXED, __HIP_MEMORY_SCOPE_WORKGROUP); }
    }
}
DI void topk_phase(const Frame& F, const Args& a, unsigned long long& tacc) {
    unsigned long long t_s = 0;
#define TKT0(n) do { if (TIME_PH == 100 + (n)) { __syncthreads(); t_s = wall_clock64(); } } while (0)
#define TKT1(n) do { if (TIME_PH == 100 + (n)) { __syncthreads(); tacc += wall_clock64() - t_s; } } while (0)
    const bf16_t* Z = (const bf16_t*)(a.ws + WS_BIG);
    unsigned* maskg = (unsigned*)(a.ws + WS_MASK);
    LAS unsigned* hist = (LAS unsigned*)(F.lds + TK_HIST);
    LAS int* ccnt = (LAS int*)(F.lds + TK_CCNT);
    LAS int* ovf = (LAS int*)(F.lds + TK_OVF);
    LAS unsigned* maskl = (LAS unsigned*)(F.lds + TK_MASK);
    for (int pi = F.bid; pi < 512; pi += F.G) {
        const int b = pi >> 7, p = pi & 127;
        for (int half = 0; half < 2; ++half) {
            const int t0 = 32 * (half ? 255 - p : p), ntile = t0 / 32 + 1;
            const int lane0 = fresh_lane(), q = lane0 & 31, h2 = lane0 >> 5;
            const bf16_t* zr = Z + (size_t)(b * SEQ + t0 + q) * CD_N;
            TKT0(1);
            float wp[8];
            { const u32x4 wv = *(const u32x4*)(zr + Z_WI);
              const float sc = 0.0625f * 0.5f * 16384.0f;
              wp[0] = bf_lo(wv[0]) * sc; wp[1] = bf_hi(wv[0]) * sc; wp[2] = bf_lo(wv[1]) * sc; wp[3] = bf_hi(wv[1]) * sc;
              wp[4] = bf_lo(wv[2]) * sc; wp[5] = bf_hi(wv[2]) * sc; wp[6] = bf_lo(wv[3]) * sc; wp[7] = bf_hi(wv[3]) * sc; }
            __syncthreads();
            if (F.wave == 0) {
                LAS unsigned char* bqw = F.lds + TK_BQ;
                float lin[2][8];
#pragma unroll
                for (int ks = 0; ks < 2; ++ks)
#pragma unroll
                    for (int j = 0; j < 8; ++j) lin[ks][j] = 0.f;
#pragma unroll
                for (int h = 0; h < 8; ++h)
#pragma unroll
                    for (int ks = 0; ks < 2; ++ks) {
                        const u32x4 v = *(const u32x4*)(zr + Z_QI + 32 * h + 16 * ks + 8 * h2);
                        *(LAS u32x4*)(bqw + ((2 * h + ks) * 64 + lane0) * 16) = v;
#pragma unroll
                        for (int j = 0; j < 4; ++j) { lin[ks][2 * j] += wp[h] * bf_lo(v[j]); lin[ks][2 * j + 1] += wp[h] * bf_hi(v[j]); }
                    }
#pragma unroll
                for (int ks = 0; ks < 2; ++ks) {
                    u32x4 v; v[0] = pack_bf16(lin[ks][0], lin[ks][1]); v[1] = pack_bf16(lin[ks][2], lin[ks][3]); v[2] = pack_bf16(lin[ks][4], lin[ks][5]); v[3] = pack_bf16(lin[ks][6], lin[ks][7]);
                    *(LAS u32x4*)(bqw + ((16 + ks) * 64 + lane0) * 16) = v;
                }
            }
            for (int i = F.tid; i < 32 * TK_HLD; i += NTHR) hist[i] = 0u;
            if (F.tid < 32) ccnt[F.tid] = 0;
            if (F.tid == 32) *ovf = 0;
            __syncthreads();
            TKT1(1); TKT0(2);
            topk_pass<1>(F, Z, b, t0, wp);
            __syncthreads();
            TKT1(2); TKT0(3);
            topk_scan(F, 1, t0);
            __syncthreads();
            TKT1(3); TKT0(4);
            if (*ovf == 0) {
                topk_pass<4>(F, Z, b, t0, wp);
            } else {
                for (int i = F.tid; i < 32 * TK_HLD; i += NTHR) hist[i] = 0u;
                __syncthreads();
                topk_pass<2>(F, Z, b, t0, wp);
                __syncthreads();
                topk_scan(F, 2, t0);
                __syncthreads();
                topk_pass<3>(F, Z, b, t0, wp);
            }
            __syncthreads();
            TKT1(4); TKT0(5);
            topk_select(F);
            __syncthreads();
            for (int i = F.wave * 64 + fresh_lane(); i < 32 * ntile; i += NTHR) { const int qq = i / ntile, kt = i - qq * ntile; maskg[(size_t)(b * SEQ + t0 + qq) * 256 + kt] = maskl[qq * 256 + kt]; }
            TKT1(5);
        }
    }
}

constexpr int AT_KSTR = 72;
constexpr int AT_VSTR = 72;
constexpr int AT_KBYTES = 64 * AT_KSTR * 2;
constexpr int AT_VBYTES = 128 * AT_VSTR * 2;
constexpr int AT_BUF = AT_KBYTES + AT_VBYTES;
constexpr int AT_NSTG = 3;
constexpr int AT_LUT = AT_NSTG * AT_BUF;
constexpr int AT_LUT_LD = 320;
constexpr float NEG_INF = -__builtin_huge_valf();
constexpr float AT_THR = 8.0f;

template <int DV, bool MASKED>
DI void attn_core(const Frame& F, const bf16_t* Z, const bf16_t* Vt, int b, int qcol, int kcol, int vrow, int q0, const LAS float* lut, float c1, const unsigned* maskg, f32x16 (&O)[DV / 32]) {
    constexpr int NDV = DV / 32;
    const int q = F.lane & 31, h2 = F.lane >> 5;
    const int tw0 = q0 + 32 * F.wave, t = tw0 + q;
    const bf16_t* Zb = Z + (size_t)b * SEQ * CD_N;
    const bf16_t* Vb = Vt + (size_t)vrow * NTOK + (size_t)b * SEQ;
    const unsigned* mrow = maskg + (size_t)(b * SEQ + t) * 256;
    bf16x8 Qf[4];
#pragma unroll
    for (int ks = 0; ks < 4; ++ks) Qf[ks] = *(const bf16x8*)(Zb + (size_t)t * CD_N + qcol + 16 * ks + 8 * h2);
#pragma unroll
    for (int d = 0; d < NDV; ++d)
#pragma unroll
        for (int r = 0; r < 16; ++r) O[d][r] = 0.f;
    float m_run = NEG_INF, l_run = 0.f;
    const int jmax = (q0 + 255) >> 6;
    const int kkey = F.tid >> 3, kch = F.tid & 7;
    u32x4 kreg, vreg[DV / 64]; unsigned mreg[2] = {0u, 0u};
    bf16x8 Pf[4];
#pragma unroll
    for (int i = 0; i < 4; ++i) Pf[i] = (bf16x8){0, 0, 0, 0, 0, 0, 0, 0};
#define AT_LOAD(j) do { kreg = *(const u32x4*)(Zb + (size_t)(64 * (j) + kkey) * CD_N + kcol + 8 * kch); \
        _Pragma("unroll") for (int _i = 0; _i < DV / 64; ++_i) { const int idx = F.tid + NTHR * _i; vreg[_i] = *(const u32x4*)(Vb + (size_t)(idx >> 3) * NTOK + 64 * (j) + 8 * (idx & 7)); } \
        if (MASKED) { mreg[0] = mrow[2 * (j)]; mreg[1] = mrow[2 * (j) + 1]; } } while (0)
#define AT_STORE(buf) do { LAS unsigned char* kb_ = F.lds + (buf) * AT_BUF; *(LAS u32x4*)(kb_ + kkey * (AT_KSTR * 2) + kch * 16) = kreg; \
        _Pragma("unroll") for (int _i = 0; _i < DV / 64; ++_i) { const int idx = F.tid + NTHR * _i, dv_ = idx >> 3, ch_ = idx & 7; \
            LAS unsigned char* vp_ = kb_ + AT_KBYTES + dv_ * (AT_VSTR * 2) + (16 * (ch_ >> 1) + 4 * (ch_ & 1)) * 2; \
            *(LAS u32x2*)vp_ = (u32x2){vreg[_i][0], vreg[_i][1]}; *(LAS u32x2*)(vp_ + 16) = (u32x2){vreg[_i][2], vreg[_i][3]}; } } while (0)
#define AT_QKSM(jj) do { \
        const LAS unsigned char* kb = F.lds + ((jj) % AT_NSTG) * AT_BUF; \
        f32x16 s[2]; \
        _Pragma("unroll") for (int kb2 = 0; kb2 < 2; ++kb2) { \
            bf16x8 Kf[4]; \
            _Pragma("unroll") for (int ks = 0; ks < 4; ++ks) Kf[ks] = *(const LAS bf16x8*)(kb + (32 * kb2 + q) * (AT_KSTR * 2) + (16 * ks + 8 * h2) * 2); \
            _Pragma("unroll") for (int r = 0; r < 16; ++r) s[kb2][r] = 0.f; \
            _Pragma("unroll") for (int ks = 0; ks < 4; ++ks) s[kb2] = MFMA32(Kf[ks], Qf[ks], s[kb2]); \
        } \
        const bool nearb = (64 * (jj) + 63 + 128 > tw0); \
        float mloc = NEG_INF; \
        if (!nearb) { \
            _Pragma("unroll") for (int kb2 = 0; kb2 < 2; ++kb2) _Pragma("unroll") for (int r = 0; r < 16; ++r) mloc = fmaxf(mloc, s[kb2][r]); \
            mloc = mloc * c1 + lut[96 + 128]; \
        } else { \
            const LAS float* lp = lut + (t - 64 * (jj) - 4 * h2 + 96 - 63); \
            _Pragma("unroll") for (int kb2 = 0; kb2 < 2; ++kb2) \
                _Pragma("unroll") for (int r = 0; r < 16; ++r) { const float v_ = s[kb2][r] * c1 + lp[63 - (32 * kb2 + crow_c(r))]; s[kb2][r] = v_; mloc = fmaxf(mloc, v_); } \
        } \
        mloc = fmaxf(mloc, __shfl_xor(mloc, 32)); \
        if (__any(mloc > m_run + AT_THR)) { \
            const float m_new = fmaxf(m_run, mloc); \
            const float alpha = __builtin_amdgcn_exp2f(m_run - m_new); \
            m_run = m_new; l_run *= alpha; \
            _Pragma("unroll") for (int d = 0; d < NDV; ++d) _Pragma("unroll") for (int r = 0; r < 16; ++r) O[d][r] *= alpha; \
        } \
        const float sub = lut[96 + 128] - m_run; \
        if (!nearb) { _Pragma("unroll") for (int kb2 = 0; kb2 < 2; ++kb2) _Pragma("unroll") for (int r = 0; r < 16; ++r) s[kb2][r] = __builtin_amdgcn_exp2f(s[kb2][r] * c1 + sub); } \
        else        { _Pragma("unroll") for (int kb2 = 0; kb2 < 2; ++kb2) _Pragma("unroll") for (int r = 0; r < 16; ++r) s[kb2][r] = __builtin_amdgcn_exp2f(s[kb2][r] - m_run); } \
        float psum0 = 0.f, psum1 = 0.f; \
        _Pragma("unroll") for (int kb2 = 0; kb2 < 2; ++kb2) { \
            const unsigned mw = mcur[kb2] >> (4 * h2); \
            _Pragma("unroll") for (int r = 0; r < 16; ++r) { \
                float p = s[kb2][r]; \
                if (MASKED) { p = __uint_as_float(__float_as_uint(p) & (unsigned)(-(int)((mw >> crow_c(r)) & 1u))); s[kb2][r] = p; } \
                if (r & 1) psum1 += p; else psum0 += p; \
            } \
        } \
        l_run += psum0 + psum1; \
        _Pragma("unroll") for (int st = 0; st < 4; ++st) { \
            u32x4 pw; \
            _Pragma("unroll") for (int e = 0; e < 4; ++e) pw[e] = pack_bf16(s[st >> 1][8 * (st & 1) + 2 * e], s[st >> 1][8 * (st & 1) + 2 * e + 1]); \
            Pf[st] = __builtin_bit_cast(bf16x8, pw); \
        } \
    } while (0)
#define AT_PV(jj) do { \
        const LAS unsigned char* vt = F.lds + ((jj) % AT_NSTG) * AT_BUF + AT_KBYTES + q * (AT_VSTR * 2) + (8 * h2) * 2; \
        constexpr int NH = NDV / 2, NST = 4 * NH; \
        bf16x8 Av[2][2]; \
        _Pragma("unroll") for (int d = 0; d < 2; ++d) Av[0][d] = *(const LAS bf16x8*)(vt + (32 * d) * (AT_VSTR * 2)); \
        _Pragma("unroll") for (int u = 0; u < NST; ++u) { \
            const int st = u / NH, dh = u % NH; \
            if (u + 1 < NST) { \
                const int st1 = (u + 1) / NH, dh1 = (u + 1) % NH; \
                _Pragma("unroll") for (int d = 0; d < 2; ++d) Av[(u + 1) & 1][d] = *(const LAS bf16x8*)(vt + (32 * (2 * dh1 + d)) * (AT_VSTR * 2) + (16 * st1) * 2); \
            } \
            __builtin_amdgcn_s_setprio(1); \
            _Pragma("unroll") for (int d = 0; d < 2; ++d) O[2 * dh + d] = MFMA32(Av[u & 1][d], Pf[st], O[2 * dh + d]); \
            __builtin_amdgcn_s_setprio(0); \
            __builtin_amdgcn_sched_barrier(0); \
        } \
    } while (0)
#define AT_ACT(jj) (64 * (jj) <= tw0 + 31)
    AT_LOAD(0); AT_STORE(0);
    unsigned mcur[2] = {mreg[0], mreg[1]};
    __syncthreads();
    if (F.wave < 4) {
        for (int j = 0; j <= jmax; ++j) {
            if (j < jmax) AT_LOAD(j + 1);
            if (AT_ACT(j)) { AT_QKSM(j); AT_PV(j); }
            if (j < jmax) AT_STORE((j + 1) % AT_NSTG);
            mcur[0] = mreg[0]; mcur[1] = mreg[1];
            __syncthreads();
        }
    } else {
        for (int j = 0; j <= jmax; ++j) {
            if (j < jmax) AT_LOAD(j + 1);
            if (j > 0 && AT_ACT(j - 1)) AT_PV(j - 1);
            if (AT_ACT(j)) AT_QKSM(j);
            if (j < jmax) AT_STORE((j + 1) % AT_NSTG);
            mcur[0] = mreg[0]; mcur[1] = mreg[1];
            __syncthreads();
        }
        if (AT_ACT(jmax)) AT_PV(jmax);
    }
    __syncthreads();
#undef AT_LOAD
#undef AT_STORE
#undef AT_QKSM
#undef AT_PV
#undef AT_ACT
    const float lt = l_run + __shfl_xor(l_run, 32);
    const float inv = 1.0f / lt;
#pragma unroll
    for (int d = 0; d < NDV; ++d)
#pragma unroll
        for (int r = 0; r < 16; ++r) O[d][r] *= inv;
}

DI float rel_bucket_bias(const float* rel_bias, int d, int head) {
    int bkt;
    if (d < 16) bkt = d;
    else { const float lr = __logf((float)d * (1.0f / 16.0f)) / 2.0794415416798357f; int l = 16 + (int)(lr * 16.0f); bkt = l < 31 ? l : 31; }
    return rel_bias[bkt * 12 + head];
}
template <bool DPART>
DI void attn_phase(const Frame& F, const Args& a) {
    const bf16_t* Z = (const bf16_t*)(a.ws + WS_BIG);
    const bf16_t* Vtg = (const bf16_t*)(a.ws + WS_VT);
    bf16_t* Yo = (bf16_t*)(a.ws + WS_Y);
    float* O1s = (float*)(a.ws + WS_H);
    const unsigned* maskg = (const unsigned*)(a.ws + WS_MASK);
    LAS float* lut = (LAS float*)(F.lds + AT_LUT);
    for (int i = F.tid; i < 12 * AT_LUT_LD; i += NTHR) { const int hh = i / AT_LUT_LD, d = i % AT_LUT_LD - 96; lut[i] = d < 0 ? NEG_INF : rel_bucket_bias(a.rel_bias, d < 128 ? d : 128, hh) * LOG2E; }
    float lam;
    { float d01 = 0.f, d23 = 0.f; for (int i = 0; i < 64; ++i) { d01 += a.diff_lam[i] * a.diff_lam[64 + i]; d23 += a.diff_lam[128 + i] * a.diff_lam[192 + i]; }
      lam = __expf(d01) - __expf(d23) + 0.35550906759096f; lam = __uint_as_float(__builtin_amdgcn_readfirstlane(__float_as_uint(lam))); }
    const float one_m_li = 1.0f - 0.35550906759096f;
    __syncthreads();
    const float c1 = 0.125f * LOG2E;
    const int xcd = F.bid & 7, kk = F.bid >> 3;
    if (DPART)
    for (int it = F.bid; it < 256; it += F.G) {
        const int bh = (F.G == 256) ? 2 * xcd + (kk >> 4) : it >> 4, pr = (F.G == 256) ? (kk & 15) : (it & 15);
        const int b_ = bh >> 2, hd_ = bh & 3;
        for (int half = 0; half < 2; ++half) {
            Frame Fu = F; Fu.lane = fresh_lane();
            int b = b_, hd = hd_; asm volatile("" : "+s"(b), "+s"(hd));
            const int q0 = 256 * (half ? 31 - pr : pr);
            f32x16 O[4];
            attn_core<128, false>(Fu, Z, Vtg, b, Z_QD + 128 * hd, Z_KD + 128 * hd, VT_D + 128 * hd, q0, lut + (8 + hd) * AT_LUT_LD, c1, nullptr, O);
            {
                const int l1 = fresh_lane();
                float* o1p = O1s + (size_t)(b * SEQ + q0 + 32 * F.wave + (l1 & 31)) * 512 + 128 * hd + 4 * (l1 >> 5);
#pragma unroll
                for (int d = 0; d < 4; ++d)
#pragma unroll
                    for (int g = 0; g < 4; ++g) *(f32x4*)(o1p + 32 * d + 8 * g) = (f32x4){O[d][4 * g], O[d][4 * g + 1], O[d][4 * g + 2], O[d][4 * g + 3]};
            }
            Frame Fv = F; Fv.lane = fresh_lane();
            attn_core<128, false>(Fv, Z, Vtg, b, Z_QD + 128 * hd + 64, Z_KD + 128 * hd + 64, VT_D + 128 * hd, q0, lut + (8 + hd) * AT_LUT_LD, c1, nullptr, O);
            {
                const int l1 = fresh_lane();
                const int tq = q0 + 32 * F.wave + (l1 & 31), hh = l1 >> 5;
                const float* o1p = O1s + (size_t)(b * SEQ + tq) * 512 + 128 * hd + 4 * hh;
                float ss = 0.f;
#pragma unroll
                for (int d = 0; d < 4; ++d)
#pragma unroll
                    for (int g = 0; g < 4; ++g) {
                        const f32x4 o1 = *(const f32x4*)(o1p + 32 * d + 8 * g);
#pragma unroll
                        for (int e = 0; e < 4; ++e) { const float v = o1[e] - lam * O[d][4 * g + e]; O[d][4 * g + e] = v; ss += v * v; }
                    }
                ss += __shfl_xor(ss, 32);
                const float rinv = rsqrtf(ss * (1.0f / 128.0f) + EPS) * one_m_li;
                bf16_t* yp = Yo + (size_t)(b * SEQ + tq) * DM + 512 + 128 * hd + 4 * hh;
                const float* gp = a.diff_norm_g + 4 * hh;
#pragma unroll
                for (int d = 0; d < 4; ++d)
#pragma unroll
                    for (int g = 0; g < 4; ++g) {
                        const f32x4 gn = *(const f32x4*)(gp + 32 * d + 8 * g);
                        f32x4 v; v[0] = O[d][4 * g] * rinv * gn[0]; v[1] = O[d][4 * g + 1] * rinv * gn[1]; v[2] = O[d][4 * g + 2] * rinv * gn[2]; v[3] = O[d][4 * g + 3] * rinv * gn[3];
                        *(u32x2*)(yp + 32 * d + 8 * g) = pack4(v);
                    }
            }
        }
    }
    if (!DPART)
    for (int it = F.bid; it < 512; it += F.G) {
        const int rnd = it / F.G;
        const int bh = (F.G == 256) ? 4 * xcd + 2 * rnd + (kk >> 4) : it >> 4, pr = (F.G == 256) ? (kk & 15) : (it & 15);
        const int b_ = bh >> 3, hc_ = bh & 7;
        for (int half = 0; half < 2; ++half) {
            Frame Fu = F; Fu.lane = fresh_lane();
            int b = b_, hc = hc_; asm volatile("" : "+s"(b), "+s"(hc));
            const int q0 = 256 * (half ? 31 - pr : pr);
            f32x16 O[2];
            attn_core<64, true>(Fu, Z, Vtg, b, Z_QC + 64 * hc, Z_KC + 64 * hc, VT_C + 64 * hc, q0, lut + hc * AT_LUT_LD, c1, maskg, O);
            {
                const int l1 = fresh_lane();
                bf16_t* yp = Yo + (size_t)(b * SEQ + q0 + 32 * F.wave + (l1 & 31)) * DM + 64 * hc + 4 * (l1 >> 5);
#pragma unroll
                for (int d = 0; d < 2; ++d)
#pragma unroll
                    for (int g = 0; g < 4; ++g) {
                        f32x4 v = {O[d][4 * g], O[d][4 * g + 1], O[d][4 * g + 2], O[d][4 * g + 3]};
                        *(u32x2*)(yp + 32 * d + 8 * g) = pack4(v);
                    }
            }
        }
    }
}

#ifndef MK_ONE_LAUNCH
#define MK_ONE_LAUNCH 1
#endif
constexpr int NPH = 17;
__global__ void __launch_bounds__(NTHR, 2) fwd_kernel(Args a) {
    extern __shared__ __attribute__((aligned(16))) unsigned char lds_raw[];
    Frame F; F.lds = (LAS unsigned char*)lds_raw; F.tid = threadIdx.x; F.lane = F.tid & 63; F.wave = __builtin_amdgcn_readfirstlane(F.tid >> 6); F.G = gridDim.x; F.bid = blockIdx.x;
    unsigned* ctl = (unsigned*)(a.ws + WS_CTL);
    volatile LAS unsigned* xbw = (volatile LAS unsigned*)(F.lds + LDS_XB);
    if (F.tid < 4) xbw[F.tid] = 0u;
    __syncthreads();
    const int lo = a.ph_lo, hi = a.ph_hi;
    XcdBarrier bar; bar.bar = ctl + CW_BAR; bar.x = 0; bar.st = xbw;
    if (hi - lo > 1) bar = xcd_barrier_post(ctl + CW_BAR, xbw);
#ifndef PH_ONLY
#define IN(k) (lo <= (k) && (k) < hi)
#else
#define IN(k) ((k) == PH_ONLY && lo <= (k) && (k) < hi)
#endif
#ifndef DUP_PH
#define DUP_PH -1
#endif
#define REP(k) for (int rep_ = 0; rep_ < ((k) == DUP_PH ? 2 : 1); ++rep_)
#ifndef TIME_PH
#define TIME_PH -1
#endif
#define TIME_AMP 4
    unsigned long long tp0_ = 0, tp1_ = 0;
    if (TIME_PH == 0) tp0_ = wall_clock64();
#define SEAM(k) do { if (IN(k) && IN((k) + 1)) xcd_barrier(bar); if ((k) == TIME_PH) tp1_ = wall_clock64(); if ((k) + 1 == TIME_PH) tp0_ = wall_clock64(); } while (0)
    float* mod = (float*)(a.ws + WS_MOD);
    bf16_t* hbuf = (bf16_t*)(a.ws + WS_H);
    bf16_t* ybuf = (bf16_t*)(a.ws + WS_Y);
    LAS int* ntp = (LAS int*)(F.lds + LDS_MISC);

    if (IN(0)) REP(0) { p0_prologue(F, a); } SEAM(0);
    if (IN(1)) REP(1) { norm_phase<false, false, false>(F, a, a.x, 0, 0, 0); } SEAM(1);
    if (IN(2)) REP(2) {
        DenseSched S; S.init(NTOK, AB_N, DM, F.G, F.bid, a.ws + WS_WAB_IN);
        EpiAbIn E{(bf16_t*)(a.ws + WS_BIG)};
        pg8::gemm_phase(F.lds, (const char*)hbuf, DM, S, E);
    } SEAM(2);
    if (IN(3)) REP(3) { conv_phase(F, a); } SEAM(3);
    if (IN(4)) REP(4) {
        DenseSched S; S.init(NTOK, DM, DM, F.G, F.bid, a.ws + WS_WAB_OUT);
        EpiResid E{a.x, a.out, mod + 2 * DM};
        pg8::gemm_phase(F.lds, (const char*)ybuf, DM, S, E);
    } SEAM(4);
#define MOE_PHASES(layer, pb) do { \
        const unsigned* cnt = ctl + CW_CNT + (layer) * NEXP * CNT_STRIDE; \
        if (IN(pb)) { route_phase(F, a, (layer)); } SEAM(pb); \
        if (IN((pb) + 1)) REP((pb) + 1) { \
            moe_tile_table(F, cnt, ntp); \
            MoeSched<true> S; S.ntp = ntp; S.cnt = cnt; S.list = (const int*)(a.ws + WS_LIST); S.W = (const char*)(a.ws + WS_MOE_W); S.nU = 4 * ntp[NEXP]; S.G = F.G; S.c = F.bid; \
            EpiMoeUp E{(bf16_t*)(a.ws + WS_ACT)}; \
            pg8::gemm_phase(F.lds, (const char*)hbuf, DM, S, E); \
        } SEAM((pb) + 1); \
        if (IN((pb) + 2)) REP((pb) + 2) { \
            moe_tile_table(F, cnt, ntp); \
            MoeSched<false> S; S.ntp = ntp; S.cnt = cnt; S.list = nullptr; S.W = (const char*)(a.ws + WS_MOE_W); S.nU = 4 * ntp[NEXP]; S.G = F.G; S.c = F.bid; \
            EpiMoeDown E{(bf16_t*)(a.ws + WS_YMOE), (const float*)(a.ws + WS_GATEV), ntp}; \
            pg8::gemm_phase(F.lds, (const char*)(a.ws + WS_ACT), DEXP, S, E); \
        } SEAM((pb) + 2); } while (0)
    MOE_PHASES(0, 5);
    if (IN(8)) {
        norm_phase<true, false, false>(F, a, a.out, 1, 0, 0);
        cvt_run(F, a, 1, CVT_MOE_TILES);
    } SEAM(8);
    if (IN(9)) REP(9) {
        { DenseSched S; S.init(NTOK, CD_N, DM, F.G, F.bid, a.ws + WS_WCD_IN);
          EpiPlain E{(bf16_t*)(a.ws + WS_BIG), CD_N};
          pg8::gemm_phase(F.lds, (const char*)hbuf, DM, S, E); }
        __syncthreads();
        { DenseSched S; S.init(1024, NTOK, DM, F.G, F.bid, hbuf);
          EpiPlainNat E{(bf16_t*)(a.ws + WS_VT), NTOK};
          pg8::gemm_phase(F.lds, (const char*)(a.ws + WS_WCD_IN + (size_t)CD_N * DM * 2), DM, S, E); }
    } SEAM(9);
    if (IN(10)) REP(10) { unsigned long long tacc_ = 0; topk_phase(F, a, tacc_); if (TIME_PH > 100 && TIME_PH < 110) { tp0_ = 0; tp1_ = tacc_; } } SEAM(10);
    if (IN(11)) REP(11) { if (TIME_PH == 111) { __syncthreads(); tp0_ = wall_clock64(); } attn_phase<true>(F, a); __syncthreads(); if (TIME_PH == 111) tp1_ = wall_clock64(); if (TIME_PH == 112) tp0_ = wall_clock64(); attn_phase<false>(F, a); if (TIME_PH == 112) { __syncthreads(); tp1_ = wall_clock64(); } } SEAM(11);
    if (IN(12)) {
        DenseSched S; S.init(NTOK, DM, DM, F.G, F.bid, a.ws + WS_WCD_OUT);
        EpiResid E{a.out, a.out, mod + (size_t)NB * 6 * DM + 2 * DM};
        pg8::gemm_phase(F.lds, (const char*)ybuf, DM, S, E);
    } SEAM(12);
    MOE_PHASES(1, 13);
#undef MOE_PHASES
    if (IN(16)) { norm_phase<true, false, true>(F, a, a.out, 1, 0, 1); }
    if (TIME_PH >= 0) {
        if (TIME_PH == 16) { asm volatile("s_waitcnt vmcnt(0)" ::: "memory"); __syncthreads(); tp1_ = wall_clock64(); }
        if (F.bid == 0 && F.tid == 0) { const unsigned long long te = wall_clock64(), dt = (tp1_ - tp0_) * TIME_AMP; while (wall_clock64() - te < dt) __builtin_amdgcn_s_sleep(8); }
    }
#undef IN
#undef SEAM
}

extern "C" void kernel_launch(void* const* d_in, const int* in_sizes, int n_in, void* d_out, int out_size, void* d_ws, size_t ws_size, hipStream_t stream) {
    static int grid = 0;
    if (grid == 0) {
        if (n_in != 26 || out_size != NTOK * DM || ws_size < WS_END) { fprintf(stderr, "kernel_launch: unexpected problem (n_in %d, out %d, ws %zu < %zu)\n", n_in, out_size, ws_size, (size_t)WS_END); grid = -1; return; }
        int dev = 0, cus = 0, per_cu = 0;
        if (hipGetDevice(&dev) != hipSuccess || hipDeviceGetAttribute(&cus, hipDeviceAttributeMultiprocessorCount, dev) != hipSuccess) { grid = -1; return; }
        if (hipFuncSetAttribute((const void*)fwd_kernel, hipFuncAttributeMaxDynamicSharedMemorySize, LDS_BYTES) != hipSuccess) { fprintf(stderr, "kernel_launch: hipFuncSetAttribute failed\n"); grid = -1; return; }
        if (hipOccupancyMaxActiveBlocksPerMultiprocessor(&per_cu, (const void*)fwd_kernel, NTHR, LDS_BYTES) != hipSuccess || per_cu < 1) { fprintf(stderr, "kernel_launch: occupancy query says %d\n", per_cu); }
        (void)hipGetLastError();
        grid = cus;
    }
    if (grid < 0) return;
    (void)hipMemsetAsync((char*)d_ws + WS_CTL, 0, CTL_BYTES, stream);
    Args a{};
    const float** fp = (const float**)&a.x;
    (void)fp;
    a.x = (const float*)d_in[0]; a.c = (const float*)d_in[1]; a.positions = (const int*)d_in[2]; a.rel_bias = (const float*)d_in[3]; a.norm_g = (const float*)d_in[4];
    a.final_norm_g = (const float*)d_in[5]; a.ada_w = (const float*)d_in[6]; a.ada_b = (const float*)d_in[7]; a.ab_w_in = (const float*)d_in[8]; a.ab_conv_a = (const float*)d_in[9];
    a.ab_conv_b = (const float*)d_in[10]; a.ab_conv_b_bias = (const float*)d_in[11]; a.ab_ln_g = (const float*)d_in[12]; a.ab_ln_b = (const float*)d_in[13]; a.ab_w_out = (const float*)d_in[14];
    a.cd_w_in = (const float*)d_in[15]; a.diff_lam = (const float*)d_in[16]; a.diff_norm_g = (const float*)d_in[17]; a.cd_w_out = (const float*)d_in[18];
    a.moe_wr_g = (const float*)d_in[19]; a.moe_br_g = (const float*)d_in[20]; a.moe_wr_e = (const float*)d_in[21]; a.moe_br_e = (const float*)d_in[22];
    a.moe_w_gate = (const float*)d_in[23]; a.moe_w_up = (const float*)d_in[24]; a.moe_w_down = (const float*)d_in[25];
    a.out = (float*)d_out; a.ws = (unsigned char*)d_ws;
#if MK_ONE_LAUNCH
    a.ph_lo = 0; a.ph_hi = NPH;
    hipLaunchKernelGGL(fwd_kernel, dim3(grid), dim3(NTHR), LDS_BYTES, stream, a);
#else
    for (int p = 0; p < NPH; ++p) { a.ph_lo = p; a.ph_hi = p + 1; hipLaunchKernelGGL(fwd_kernel, dim3(grid), dim3(NTHR), LDS_BYTES, stream, a); }
#endif
}
```

```cpp
#include <hip/hip_runtime.h>
#include <cstdio>
#include <cstdint>

#ifndef TIME_PH
#define TIME_PH -1
#endif
#define LAS __attribute__((address_space(3)))
#define DI __device__ __forceinline__
typedef unsigned short bf16_t;
typedef short bf16x8 __attribute__((ext_vector_type(8)));
typedef short s16x4 __attribute__((ext_vector_type(4)));
typedef float f32x2 __attribute__((ext_vector_type(2)));
typedef float f32x4 __attribute__((ext_vector_type(4)));
typedef float f32x16 __attribute__((ext_vector_type(16)));
typedef unsigned u32x2 __attribute__((ext_vector_type(2)));
typedef unsigned u32x4 __attribute__((ext_vector_type(4)));
typedef __bf16 bf16v2 __attribute__((ext_vector_type(2)));

constexpr int NB = 4, SEQ = 8192, DM = 1024, NTOK = NB * SEQ;
constexpr int NTHR = 512, NWAVE = 8;
constexpr int AB_N = 2560;
constexpr int ZC_N = 1536;
constexpr int CD_SRC_N = 3368;
constexpr int CD_N = 2560;
constexpr int Z_QC = 0, Z_KC = 512, Z_QD = 1024, Z_KD = 1536, Z_QI = 2048, Z_KI = 2304, Z_WI = 2336;
constexpr int VT_C = 0, VT_D = 512;
constexpr int NEXP = 32, DEXP = 512;
constexpr int MOE_ROWS = 2 * NTOK + NEXP * 256;
constexpr float EPS = 1e-6f;
constexpr float LOG2E = 1.4426950408889634f;

constexpr size_t MiB = 1u << 20;
constexpr size_t WS_CTL = 0, CTL_BYTES = 64 * 1024;
constexpr size_t WS_MOD = 1 * MiB;
constexpr size_t WS_WAB_IN = 2 * MiB;
constexpr size_t WS_WAB_OUT = 7 * MiB;
constexpr size_t WS_WCD_IN = 9 * MiB;
constexpr size_t WS_WCD_OUT = 16 * MiB;
constexpr size_t WS_MOE_W = 18 * MiB;
constexpr size_t WS_H = 114 * MiB;
constexpr size_t WS_Y = 178 * MiB;
constexpr size_t WS_BIG = 242 * MiB;
constexpr size_t WS_ACT = WS_BIG;
constexpr size_t WS_YMOE = WS_BIG + 72 * MiB;
constexpr size_t WS_VT = WS_BIG + 160 * MiB;
constexpr size_t WS_MASK = 466 * MiB;
constexpr size_t WS_LIST = 498 * MiB;
constexpr size_t WS_GATEV = 502 * MiB;
constexpr size_t WS_TOKSLOT = 506 * MiB;
constexpr size_t WS_END = 507 * MiB;

constexpr int CW_BAR = 0;
constexpr int CW_CNT = 4096;
constexpr int CNT_STRIDE = 64;

DI unsigned pack_bf16(float lo, float hi) { f32x2 v = {lo, hi}; bf16v2 b = __builtin_convertvector(v, bf16v2); return __builtin_bit_cast(unsigned, b); }
DI float bf_lo(unsigned w) { return __uint_as_float(w << 16); }
DI float bf_hi(unsigned w) { return __uint_as_float(w & 0xffff0000u); }
DI float bf2f(bf16_t b) { return __uint_as_float(((unsigned)b) << 16); }
DI float wave_sum(float v) {
#pragma unroll
    for (int o = 32; o >= 1; o >>= 1) v += __shfl_xor(v, o);
    return v;
}
DI int fresh_lane() { int l; asm volatile("v_mbcnt_lo_u32_b32 %0, -1, 0\n\tv_mbcnt_hi_u32_b32 %0, -1, %0" : "=v"(l)); return l; }
DI float silu_f(float v) { return v / (1.0f + __expf(-v)); }
DI float sigmoid_f(float v) { return 1.0f / (1.0f + __expf(-v)); }

#define XB_TMO      128
#define XB_XCNT(j)  (256  + 64 * (j))
#define XB_XSUB(j)  (1280 + 64 * (j))
#define XB_XGEN(j)  (2304 + 64 * (j))
#define XB_TOP      3328
#define XB_TOPGEN   3392
#define XCD_BAR_WORDS 3456
#define XB_SPIN_CAP (1u << 22)
DI unsigned xb_ld(unsigned* p)              { return __hip_atomic_load(p, __ATOMIC_RELAXED, __HIP_MEMORY_SCOPE_AGENT); }
DI unsigned xb_add(unsigned* p, unsigned v) { return __hip_atomic_fetch_add(p, v, __ATOMIC_RELAXED, __HIP_MEMORY_SCOPE_AGENT); }
DI unsigned xb_xcc_id() { return (unsigned)__builtin_amdgcn_s_getreg((3 << 11) | 20) & 0xFu; }
#define XB_SPIN(cond, bar) do { unsigned _sp = 0; while (cond) { __builtin_amdgcn_s_sleep(1); \
    if ((++_sp & 255u) == 0u) { if (xb_ld(&(bar)[XB_TMO])) break; if (_sp > XB_SPIN_CAP) { atomicAdd(&(bar)[XB_TMO], 1u); break; } } } } while (0)
struct XcdBarrier { unsigned* bar; unsigned x; volatile LAS unsigned* st; };
DI XcdBarrier xcd_barrier_post(unsigned* bar, volatile LAS unsigned* st) {
    XcdBarrier b; b.bar = bar; b.x = xb_xcc_id(); b.st = st;
    if (threadIdx.x == 0) (void)xb_add(&bar[XB_XCNT(b.x)], 1u);
    return b;
}
DI void xcd_barrier_complete(unsigned* bar, unsigned x, unsigned& nloc, unsigned& nx) {
    const unsigned G = gridDim.x * gridDim.y * gridDim.z;
    unsigned sum, cnt, mine, sp = 0u;
    for (;;) {
        sum = 0u; cnt = 0u; mine = 0u;
#pragma unroll
        for (unsigned j = 0; j < 16; ++j) { const unsigned c = xb_ld(&bar[XB_XCNT(j)]); sum += c; cnt += (c > 0u) ? 1u : 0u; mine = (j == x) ? c : mine; }
        if (sum == G) break;
        __builtin_amdgcn_s_sleep(1);
        if ((++sp & 255u) == 0u) { if (xb_ld(&bar[XB_TMO])) break; if (sp > XB_SPIN_CAP) { atomicAdd(&bar[XB_TMO], 1u); break; } }
    }
    nloc = mine > 0u ? mine : 1u; nx = cnt > 0u ? cnt : 1u;
}
DI void xcd_barrier(const XcdBarrier& b) {
    asm volatile("s_waitcnt vmcnt(0)" ::: "memory");
    __syncthreads();
    if (threadIdx.x == 0) {
        unsigned* bar = b.bar;
        __builtin_amdgcn_s_waitcnt(0);
        unsigned nloc = b.st[0], nx = b.st[1];
        if (nloc == 0u) { xcd_barrier_complete(bar, b.x, nloc, nx); b.st[0] = nloc; b.st[1] = nx; }
        const unsigned old = xb_add(&bar[XB_XSUB(b.x)], 1u);
        const unsigned gen = old / nloc;
        if (old + 1u == (gen + 1u) * nloc) {
            __builtin_amdgcn_fence(__ATOMIC_RELEASE, "agent");
            asm volatile("s_waitcnt vmcnt(0)" ::: "memory");
            const unsigned og = xb_add(&bar[XB_TOP], 1u);
            const unsigned tg = og / nx;
            if (og + 1u == (tg + 1u) * nx) xb_add(&bar[XB_TOPGEN], 1u);
            else XB_SPIN(xb_ld(&bar[XB_TOPGEN]) == tg, bar);
            __builtin_amdgcn_fence(__ATOMIC_ACQUIRE, "agent");
            xb_add(&bar[XB_XGEN(b.x)], 1u);
            asm volatile("s_waitcnt vmcnt(0)" ::: "memory");
        } else {
            XB_SPIN(xb_ld(&bar[XB_XGEN(b.x)]) == gen, bar);
            __builtin_amdgcn_fence(__ATOMIC_ACQUIRE, "agent");
            asm volatile("s_waitcnt vmcnt(0)" ::: "memory");
        }
    }
    __syncthreads();
}

namespace pg8 {
constexpr int BM = 256, BK = 64, HALF = 128, HTB = HALF * BK * 2, STAGE_BYTES = 8 * HTB;
DI int lds_byte(int r, int c) { const int st = (r >> 4) * 2 + (c >> 5), rr = r & 15, cc = c & 31, ob = rr * 64 + cc * 2; return st * 1024 + (ob ^ (((ob >> 9) & 1) << 5)); }
DI void stage_rc(int b, int& R, int& C) { const int st = b / 1024, sb = b % 1024, swz = sb ^ (((sb >> 9) & 1) << 5); R = (st >> 1) * 16 + swz / 64; C = (st & 1) * 32 + (swz % 64) / 2; }
struct Unit { int pm, pn, e, nrow; };

template <class Epi, class Sched>
DI void gemm_phase(LAS unsigned char* lds, const char* Abase, const int K, const Sched& S, const Epi& E) {
    const int tid = threadIdx.x, wid = __builtin_amdgcn_readfirstlane(tid >> 6), lane = tid & 63, wr = wid >> 2, wc = wid & 3, fr = lane & 15, fq = lane >> 4;
    const int nt = K / BK;
    int Rr[2], Cc[2]; unsigned voffB[2];
#pragma unroll
    for (int i = 0; i < 2; ++i) { int R, C; stage_rc(tid * 16 + i * 8192, R, C); Rr[i] = R; Cc[i] = C; voffB[i] = (unsigned)(R * K + C) * 2u; }
    const size_t kstep = (size_t)(BK * 2);
    const size_t hstep = (size_t)HALF * K * 2;
    const unsigned ldsw = (unsigned)wid * 1024u;
    const int aoff = lds_byte(wr * 64 + fr, fq * 8), boff = lds_byte(wc * 32 + fr, fq * 8);
#define PG8_SA(b, h) (((b) * 2 + (h)) * HTB)
#define PG8_SB(b, h) ((4 + (b) * 2 + (h)) * HTB)
#define PG8_STAGE(bufoff, gbase, voff) do { _Pragma("unroll") for (int _i = 0; _i < 2; ++_i) \
        __builtin_amdgcn_global_load_lds((const unsigned*)((const char*)(gbase) + (voff)[_i]), (LAS unsigned*)(lds + (bufoff) + ldsw + _i * 8192), 16, 0, 0); } while (0)
#define PG8_AOFF(dst, u) do { _Pragma("unroll") for (int _h = 0; _h < 2; ++_h) _Pragma("unroll") for (int _i = 0; _i < 2; ++_i) \
        dst[_h][_i] = ((unsigned)S.a_row(u, _h * HALF + Rr[_i]) * (unsigned)K + (unsigned)Cc[_i]) * 2u; } while (0)
#define PG8_LDA(dst, b, h) do { _Pragma("unroll") for (int m = 0; m < 4; ++m) _Pragma("unroll") for (int k = 0; k < 2; ++k) dst[m][k] = *(const LAS bf16x8*)(lds + PG8_SA(b, h) + aoff + m * 2048 + k * 1024); } while (0)
#define PG8_LDB(dst, b, h) do { _Pragma("unroll") for (int n = 0; n < 2; ++n) _Pragma("unroll") for (int k = 0; k < 2; ++k) dst[n][k] = *(const LAS bf16x8*)(lds + PG8_SB(b, h) + boff + n * 2048 + k * 1024); } while (0)
#define PG8_MMA(ai, bj, At, Bt) do { __builtin_amdgcn_s_setprio(1); _Pragma("unroll") for (int m = 0; m < 4; ++m) _Pragma("unroll") for (int n = 0; n < 2; ++n) _Pragma("unroll") for (int k = 0; k < 2; ++k) \
        acc[ai][bj][m][n] = __builtin_amdgcn_mfma_f32_16x16x32_bf16(Bt[n][k], At[m][k], acc[ai][bj][m][n], 0, 0, 0); __builtin_amdgcn_s_setprio(0); } while (0)
#define PG8_WAIT_V(n) asm volatile("s_waitcnt vmcnt(" #n ")" ::: "memory")
#define PG8_WAIT_L(n) asm volatile("s_waitcnt lgkmcnt(" #n ")" ::: "memory")
#define PG8_BAR __builtin_amdgcn_s_barrier()
#define PG8_SCHED __builtin_amdgcn_sched_barrier(0)
    Unit cur, nxt; int ui = 0;
    if (!S.next(0, cur)) return;
    f32x4 acc[2][2][4][2];
#pragma unroll
    for (int a = 0; a < 2; ++a)
#pragma unroll
        for (int b = 0; b < 2; ++b)
#pragma unroll
            for (int m = 0; m < 4; ++m)
#pragma unroll
                for (int n = 0; n < 2; ++n) acc[a][b][m][n] = (f32x4){0.f, 0.f, 0.f, 0.f};
    bf16x8 At[4][2], B0[2][2], B1[2][2];
    unsigned aoC[2][2], aoN[2][2];
    PG8_AOFF(aoC, cur);
    const char* cB = S.b_base(cur);
    PG8_STAGE(PG8_SB(0, 0), cB, voffB); PG8_STAGE(PG8_SA(0, 0), Abase, aoC[0]); PG8_STAGE(PG8_SB(0, 1), cB + hstep, voffB); PG8_STAGE(PG8_SA(0, 1), Abase, aoC[1]);
    if (wr == 1) PG8_BAR;
    PG8_WAIT_V(4); PG8_BAR;
    PG8_STAGE(PG8_SB(1, 0), cB + kstep, voffB); PG8_STAGE(PG8_SA(1, 0), Abase + kstep, aoC[0]); PG8_STAGE(PG8_SB(1, 1), cB + hstep + kstep, voffB);
    PG8_WAIT_V(6); PG8_BAR;
    for (;;) {
        const bool has_next = S.next(ui + 1, nxt);
        const char* nB = cB;
#pragma unroll
        for (int _h = 0; _h < 2; ++_h)
#pragma unroll
            for (int _i = 0; _i < 2; ++_i) aoN[_h][_i] = aoC[_h][_i];
        if (has_next) { PG8_AOFF(aoN, nxt); nB = S.b_base(nxt); }
        for (int t = 0; t < nt; t += 2) {
            const bool last = (t == nt - 2);
            const char* a1 = Abase + (size_t)(t + 1) * kstep;
            const char* a2 = last ? Abase : Abase + (size_t)(t + 2) * kstep; const char* b2 = last ? nB : cB + (size_t)(t + 2) * kstep;
            const char* a3 = a2 + kstep; const char* b3 = b2 + kstep;
            unsigned ao2[2][2];
#pragma unroll
            for (int _h = 0; _h < 2; ++_h)
#pragma unroll
                for (int _i = 0; _i < 2; ++_i) ao2[_h][_i] = last ? aoN[_h][_i] : aoC[_h][_i];
            PG8_LDB(B0, 0, 0); PG8_SCHED; PG8_LDA(At, 0, 0); PG8_STAGE(PG8_SA(1, 1), a1, aoC[1]);
            PG8_WAIT_L(8); PG8_BAR; PG8_WAIT_L(0); PG8_MMA(0, 0, At, B0); PG8_BAR; PG8_SCHED;
            PG8_LDB(B1, 0, 1); PG8_STAGE(PG8_SB(0, 0), b2, voffB);
            PG8_BAR; PG8_WAIT_L(0); PG8_MMA(0, 1, At, B1); PG8_BAR;
            PG8_LDA(At, 0, 1); PG8_STAGE(PG8_SA(0, 0), a2, ao2[0]);
            PG8_BAR; PG8_WAIT_L(0); PG8_MMA(1, 0, At, B0); PG8_BAR; PG8_SCHED;
            PG8_STAGE(PG8_SB(0, 1), b2 + hstep, voffB);
            PG8_WAIT_V(6); PG8_BAR; PG8_MMA(1, 1, At, B1); PG8_BAR;
            PG8_LDB(B0, 1, 0); PG8_SCHED; PG8_LDA(At, 1, 0); PG8_STAGE(PG8_SA(0, 1), a2, ao2[1]);
            PG8_WAIT_L(8); PG8_BAR; PG8_WAIT_L(0); PG8_MMA(0, 0, At, B0); PG8_BAR; PG8_SCHED;
            PG8_LDB(B1, 1, 1); PG8_STAGE(PG8_SB(1, 0), b3, voffB);
            PG8_BAR; PG8_WAIT_L(0); PG8_MMA(0, 1, At, B1); PG8_BAR;
            PG8_LDA(At, 1, 1); PG8_STAGE(PG8_SA(1, 0), a3, ao2[0]);
            PG8_BAR; PG8_WAIT_L(0); PG8_MMA(1, 0, At, B0); PG8_BAR; PG8_SCHED;
            PG8_STAGE(PG8_SB(1, 1), b3 + hstep, voffB);
            PG8_WAIT_V(6); PG8_BAR; PG8_MMA(1, 1, At, B1); PG8_BAR;
        }
        E(acc, cur, wr, wc, fr, fq);
        if (!has_next) break;
#pragma unroll
        for (int a = 0; a < 2; ++a)
#pragma unroll
            for (int b = 0; b < 2; ++b)
#pragma unroll
                for (int m = 0; m < 4; ++m)
#pragma unroll
                    for (int n = 0; n < 2; ++n) acc[a][b][m][n] = (f32x4){0.f, 0.f, 0.f, 0.f};
        cur = nxt; cB = nB; ++ui;
#pragma unroll
        for (int _h = 0; _h < 2; ++_h)
#pragma unroll
            for (int _i = 0; _i < 2; ++_i) aoC[_h][_i] = aoN[_h][_i];
    }
    PG8_WAIT_V(0);
    if (wr == 0) PG8_BAR;
    PG8_BAR;
#undef PG8_SA
#undef PG8_SB
#undef PG8_STAGE
#undef PG8_AOFF
#undef PG8_LDA
#undef PG8_LDB
#undef PG8_MMA
#undef PG8_WAIT_V
#undef PG8_WAIT_L
#undef PG8_BAR
#undef PG8_SCHED
}
}

struct Args {
    const float* x; const float* c; const int* positions; const float* rel_bias; const float* norm_g; const float* final_norm_g;
    const float* ada_w; const float* ada_b; const float* ab_w_in; const float* ab_conv_a; const float* ab_conv_b; const float* ab_conv_b_bias;
    const float* ab_ln_g; const float* ab_ln_b; const float* ab_w_out; const float* cd_w_in; const float* diff_lam; const float* diff_norm_g;
    const float* cd_w_out; const float* moe_wr_g; const float* moe_br_g; const float* moe_wr_e; const float* moe_br_e;
    const float* moe_w_gate; const float* moe_w_up; const float* moe_w_down;
    float* out; unsigned char* ws; int ph_lo, ph_hi;
};
struct Frame {
    LAS unsigned char* lds; int tid, lane, wave, G, bid;
};

struct RowSrc { const float* p; int ld; };
DI int perm32(int rho) { const int n = rho >> 4, i = rho & 15; return 8 * (i >> 2) + 4 * n + (i & 3); }
DI int permrow(int r) { return (r & ~31) + perm32(r & 31); }
DI void ilv(int rp, int& j, int& second) { const int U = rp >> 8, ru = rp & 255, bj = ru >> 7, wc = (ru >> 5) & 3, n = (ru >> 4) & 1, fq = (ru >> 2) & 3, e = ru & 3; j = 128 * U + 32 * wc + 8 * fq + 4 * bj + e; second = n; }

enum { CV_AB_IN = 0, CV_AB_OUT = 1, CV_CD_IN = 2, CV_CD_OUT = 3, CV_MOE_GU = 4, CV_MOE_D = 5 };
template <int KIND> DI RowSrc row_src(const Args& a, int layer, int e, int r) {
    RowSrc s; s.p = nullptr; s.ld = 0;
    if (KIND == CV_AB_IN) {
        s.ld = AB_N;
        if (r < 512) s.p = a.ab_w_in + permrow(r);
        else if (r < 1536) { int j, sec; ilv(r - 512, j, sec); s.p = a.ab_w_in + (sec ? 1024 + j : 512 + j); }
        else { int j, sec; ilv(r - 1536, j, sec); s.p = a.ab_w_in + (sec ? 2048 + j : 1536 + j); }
    } else if (KIND == CV_AB_OUT) { s.ld = DM; s.p = a.ab_w_out + r; }
    else if (KIND == CV_CD_IN) {
        s.ld = CD_SRC_N;
        int col = -1;
        if (r < CD_N) r = permrow(r);
        if (r < 1024) col = r;
        else if (r < 2048) col = 1832 + (r - 1024);
        else if (r < 2304) col = 1536 + (r - 2048);
        else if (r < 2336) col = 1792 + (r - 2304);
        else if (r < 2344) col = 1824 + (r - 2336);
        else if (r < 2560) col = -1;
        else if (r < 3072) col = 1024 + (r - 2560);
        else col = 2856 + (r - 3072);
        if (col >= 0) s.p = a.cd_w_in + col;
    } else if (KIND == CV_CD_OUT) { s.ld = DM; s.p = a.cd_w_out + r; }
    else if (KIND == CV_MOE_GU) {
        int j, sec; ilv(r, j, sec); s.ld = DEXP;
        const size_t base = ((size_t)layer * NEXP + e) * (size_t)DM * DEXP;
        s.p = (sec ? a.moe_w_up : a.moe_w_gate) + base + j;
    } else {
        s.ld = DM; s.p = a.moe_w_down + ((size_t)layer * NEXP + e) * (size_t)DEXP * DM + permrow(r);
    }
    return s;
}
constexpr int CV_LD = 258;
struct CvtTile { const float* sp; int ld; bf16_t* dst; int K, r0, k0; };
template <int KIND> DI CvtTile cvt_desc(const Frame& F, const Args& a, bf16_t* dst, int K, int r0, int k0, int layer, int e) {
    const RowSrc s = row_src<KIND>(a, layer, e, r0 + 4 * (F.tid & 15));
    CvtTile t; t.sp = s.p; t.ld = s.ld; t.dst = dst; t.K = K; t.r0 = r0; t.k0 = k0; return t;
}
constexpr int CVT_DENSE_TILES = (AB_N + DM + CD_N + 1024 + DM) / 64 * (DM / 256);
constexpr int CVT_MOE_TILES_PER_EXP = (1024 / 64) * (1024 / 256) + (1024 / 64) * (512 / 256);
constexpr int CVT_MOE_TILES = NEXP * CVT_MOE_TILES_PER_EXP;
DI CvtTile cvt_dense_desc(const Frame& F, const Args& a, int item) {
    const int rt = item >> 2, kt = item & 3;
    int r = rt * 64;
    if (r < AB_N) return cvt_desc<CV_AB_IN>(F, a, (bf16_t*)(a.ws + WS_WAB_IN), DM, r, kt * 256, 0, 0);
    r -= AB_N;
    if (r < DM) return cvt_desc<CV_AB_OUT>(F, a, (bf16_t*)(a.ws + WS_WAB_OUT), DM, r, kt * 256, 0, 0);
    r -= DM;
    if (r < CD_N + 1024) return cvt_desc<CV_CD_IN>(F, a, (bf16_t*)(a.ws + WS_WCD_IN), DM, r, kt * 256, 0, 0);
    r -= CD_N + 1024;
    return cvt_desc<CV_CD_OUT>(F, a, (bf16_t*)(a.ws + WS_WCD_OUT), DM, r, kt * 256, 0, 0);
}
DI CvtTile cvt_moe_desc(const Frame& F, const Args& a, int layer, int item) {
    const int e = item / CVT_MOE_TILES_PER_EXP, t = item % CVT_MOE_TILES_PER_EXP;
    bf16_t* base = (bf16_t*)(a.ws + WS_MOE_W + (size_t)e * 3 * MiB);
    if (t < 64) return cvt_desc<CV_MOE_GU>(F, a, base, DM, (t >> 2) * 64, (t & 3) * 256, layer, e);
    const int t2 = t - 64; return cvt_desc<CV_MOE_D>(F, a, base + (size_t)DM * DM, DEXP, (t2 >> 1) * 64, (t2 & 1) * 256, layer, e);
}
DI void cvt_load(const Frame& F, const CvtTile& t, f32x4 (&v)[8]) {
#pragma unroll
    for (int it = 0; it < 8; ++it) {
        const int kk = (F.tid >> 4) + 32 * it;
        v[it] = (f32x4){0.f, 0.f, 0.f, 0.f};
        if (t.sp) v[it] = *(const f32x4*)(t.sp + (size_t)(t.k0 + kk) * t.ld);
    }
}
DI void cvt_store(const Frame& F, const CvtTile& t, const f32x4 (&v)[8]) {
    LAS bf16_t* T = (LAS bf16_t*)F.lds;
    const int c4 = F.tid & 15;
#pragma unroll
    for (int it = 0; it < 8; ++it) {
        const int kk = (F.tid >> 4) + 32 * it;
        const unsigned p01 = pack_bf16(v[it][0], v[it][1]), p23 = pack_bf16(v[it][2], v[it][3]);
        T[(4 * c4 + 0) * CV_LD + kk] = (bf16_t)(p01 & 0xffffu); T[(4 * c4 + 1) * CV_LD + kk] = (bf16_t)(p01 >> 16);
        T[(4 * c4 + 2) * CV_LD + kk] = (bf16_t)(p23 & 0xffffu); T[(4 * c4 + 3) * CV_LD + kk] = (bf16_t)(p23 >> 16);
    }
    __syncthreads();
    {
        const int rr = F.tid >> 3, c = F.tid & 7;
#pragma unroll
        for (int j = 0; j < 4; ++j) {
            const LAS unsigned* src = (const LAS unsigned*)(T + rr * CV_LD + 64 * j + c * 8);
            u32x4 w; w[0] = src[0]; w[1] = src[1]; w[2] = src[2]; w[3] = src[3];
            *(u32x4*)(t.dst + (size_t)(t.r0 + rr) * t.K + t.k0 + 64 * j + c * 8) = w;
        }
    }
    __syncthreads();
}
DI CvtTile cvt_any_desc(const Frame& F, const Args& a, int which, int item) {
    if (which == 0) { if (item < CVT_DENSE_TILES) return cvt_dense_desc(F, a, item); return cvt_moe_desc(F, a, 0, item - CVT_DENSE_TILES); }
    return cvt_moe_desc(F, a, 1, item);
}
DI void cvt_run(const Frame& F, const Args& a, int which, int n_items) {
    int it = F.bid;
    if (it >= n_items) return;
    CvtTile t0 = cvt_any_desc(F, a, which, it), t1 = t0, t2 = t0;
    f32x4 v0[8], v1[8], v2[8];
    cvt_load(F, t0, v0);
    bool h1 = it + F.G < n_items, h2 = it + 2 * F.G < n_items;
    if (h1) { t1 = cvt_any_desc(F, a, which, it + F.G); cvt_load(F, t1, v1); }
    for (;;) {
        h2 = it + 2 * F.G < n_items;
        if (h2) { t2 = cvt_any_desc(F, a, which, it + 2 * F.G); cvt_load(F, t2, v2); }
        cvt_store(F, t0, v0);
        if (!h1) break;
        it += F.G; t0 = t1; t1 = t2; h1 = h2;
#pragma unroll
        for (int i = 0; i < 8; ++i) { v0[i] = v1[i]; v1[i] = v2[i]; }
    }
}
DI void mod_item(const Frame& F, const Args& a, int item) {
    LAS float* sc = (LAS float*)F.lds;
    LAS float* part = (LAS float*)(F.lds + 16384);
    for (int i = F.tid; i < NB * DM; i += NTHR) sc[i] = silu_f(a.c[i]);
    __syncthreads();
    const int l = item / 96, j = (item % 96) * 64 + F.lane;
    const float* w = a.ada_w + (size_t)l * DM * 6 * DM + (size_t)(F.wave * 128) * 6 * DM + j;
    float acc[NB] = {0.f, 0.f, 0.f, 0.f};
#pragma unroll 8
    for (int k = 0; k < 128; ++k) {
        const float wv = w[(size_t)k * 6 * DM];
#pragma unroll
        for (int b = 0; b < NB; ++b) acc[b] += sc[b * DM + F.wave * 128 + k] * wv;
    }
#pragma unroll
    for (int b = 0; b < NB; ++b) part[(F.wave * NB + b) * 64 + F.lane] = acc[b];
    __syncthreads();
    if (F.tid < NB * 64) {
        const int b = F.tid >> 6, c = F.tid & 63;
        float sum = 0.f;
#pragma unroll
        for (int wv = 0; wv < NWAVE; ++wv) sum += part[(wv * NB + b) * 64 + c];
        const int jj = (item % 96) * 64 + c;
        float* mod = (float*)(a.ws + WS_MOD);
        mod[((size_t)l * NB + b) * 6 * DM + jj] = sum + a.ada_b[l * 6 * DM + jj];
    }
    __syncthreads();
}
DI void p0_prologue(const Frame& F, const Args& a) {
    for (int it = F.bid; it < 192; it += F.G) mod_item(F, a, it);
    cvt_run(F, a, 0, CVT_DENSE_TILES + CVT_MOE_TILES);
}

constexpr int WR_LD = 1028;
DI void moe_seg_table(const Frame& F, const unsigned* cnt, LAS int* seg  ) {
    if (F.tid < NEXP) seg[40 + F.tid] = (int)cnt[F.tid * CNT_STRIDE];
    __syncthreads();
    if (F.tid == 0) { int s = 0; for (int e = 0; e < NEXP; ++e) { seg[e] = s; s += ((seg[40 + e] + 255) >> 8) << 8; } seg[NEXP] = s; }
    __syncthreads();
}
template <bool COMBINE, bool ROUTE, bool FINAL>
DI void norm_phase(const Frame& F, const Args& a, const float* xsrc, int layer, int which, int layer_c) {
    const float* mod = (const float*)(a.ws + WS_MOD);
    bf16_t* hbuf = (bf16_t*)(a.ws + WS_H);
    unsigned* ctl = (unsigned*)(a.ws + WS_CTL);
    LAS float* wrT = (LAS float*)F.lds;
    LAS float* brs = (LAS float*)(F.lds + 36 * WR_LD * 4);
    LAS int* seg = (LAS int*)F.lds;
    constexpr int RT_CAP = 512;
    LAS int* rcnt = (LAS int*)(F.lds + 149504);
    LAS int* rbase = (LAS int*)(F.lds + 149632);
    LAS int* rt_er = (LAS int*)(F.lds + 149760);
    LAS float* rt_gate = (LAS float*)(F.lds + 149760 + 4096);
    LAS int* rt_tok = (LAS int*)(F.lds + 149760 + 8192);
    if (ROUTE) {
        const float* wg = a.moe_wr_g + (size_t)layer * DM * 4;
        const float* we = a.moe_wr_e + (size_t)layer * DM * 32;
        for (int i = F.tid; i < DM * 4; i += NTHR) { const int k = i >> 2, j = i & 3; wrT[j * WR_LD + k] = wg[i]; }
        for (int i = F.tid; i < DM * 32; i += NTHR) { const int k = i >> 5, j = i & 31; wrT[(4 + j) * WR_LD + k] = we[i]; }
        if (F.tid < NEXP) rcnt[F.tid] = 0;
        for (int i = F.tid; i < 2 * RT_CAP; i += NTHR) rt_er[i] = -1;
        if (F.tid < 4) brs[F.tid] = a.moe_br_g[layer * 4 + F.tid];
        else if (F.tid < 36) brs[F.tid] = a.moe_br_e[layer * 32 + F.tid - 4];
        __syncthreads();
    }
    if (COMBINE) moe_seg_table(F, ctl + CW_CNT + layer_c * NEXP * CNT_STRIDE, seg);
    const bf16_t* ymoe = (const bf16_t*)(a.ws + WS_YMOE);
    const int* tokslot = (const int*)(a.ws + WS_TOKSLOT);
    constexpr int TPW = ROUTE ? 2 : 4;
    for (int tb = (F.bid * NWAVE + F.wave) * TPW; tb < NTOK; tb += F.G * NWAVE * TPW) {
      const int b = tb / SEQ;
      f32x4 xall[TPW][4];
#pragma unroll
      for (int i = 0; i < TPW; ++i)
#pragma unroll
        for (int c = 0; c < 4; ++c) xall[i][c] = *(const f32x4*)(xsrc + (size_t)(tb + i) * DM + c * 256 + F.lane * 4);
      if (COMBINE) {
        int ts[TPW][2];
#pragma unroll
        for (int i = 0; i < TPW; ++i) { ts[i][0] = tokslot[(tb + i) * 2]; ts[i][1] = tokslot[(tb + i) * 2 + 1]; }
        u32x2 yv[TPW][2][4];
#pragma unroll
        for (int i = 0; i < TPW; ++i)
#pragma unroll
          for (int k = 0; k < 2; ++k) {
            const size_t r = (size_t)(seg[ts[i][k] >> 20] + (ts[i][k] & 0xfffff));
#pragma unroll
            for (int c = 0; c < 4; ++c) yv[i][k][c] = *(const u32x2*)(ymoe + r * DM + c * 256 + F.lane * 4);
          }
        const float* g2 = mod + ((size_t)layer_c * NB + b) * 6 * DM + 5 * DM;
#pragma unroll
        for (int c = 0; c < 4; ++c) {
          const int col = c * 256 + F.lane * 4;
          const f32x4 gv = *(const f32x4*)(g2 + col);
#pragma unroll
          for (int i = 0; i < TPW; ++i) {
            const u32x2 y0 = yv[i][0][c], y1 = yv[i][1][c];
            xall[i][c][0] += gv[0] * (bf_lo(y0[0]) + bf_lo(y1[0])); xall[i][c][1] += gv[1] * (bf_hi(y0[0]) + bf_hi(y1[0]));
            xall[i][c][2] += gv[2] * (bf_lo(y0[1]) + bf_lo(y1[1])); xall[i][c][3] += gv[3] * (bf_hi(y0[1]) + bf_hi(y1[1]));
            if (!FINAL) *(f32x4*)(a.out + (size_t)(tb + i) * DM + col) = xall[i][c];
          }
        }
      }
#pragma unroll
      for (int ti = 0; ti < TPW; ++ti) {
        const int tok = tb + ti;
        f32x4 xv[4];
#pragma unroll
        for (int c = 0; c < 4; ++c) xv[c] = xall[ti][c];
        float ss = 0.f;
#pragma unroll
        for (int c = 0; c < 4; ++c) ss += xv[c][0] * xv[c][0] + xv[c][1] * xv[c][1] + xv[c][2] * xv[c][2] + xv[c][3] * xv[c][3];
        ss = wave_sum(ss);
        const float rinv = rsqrtf(ss * (1.0f / DM) + EPS);
        if (FINAL) {
#pragma unroll
            for (int c = 0; c < 4; ++c) {
                const int col = c * 256 + F.lane * 4;
                const f32x4 g = *(const f32x4*)(a.final_norm_g + col);
                f32x4 o; o[0] = xv[c][0] * rinv * g[0]; o[1] = xv[c][1] * rinv * g[1]; o[2] = xv[c][2] * rinv * g[2]; o[3] = xv[c][3] * rinv * g[3];
                *(f32x4*)(a.out + (size_t)tok * DM + col) = o;
            }
            continue;
        }
        const float* ng = a.norm_g + ((size_t)layer * 2 + which) * DM;
        const float* sh = mod + ((size_t)layer * NB + b) * 6 * DM + (which ? 3 : 0) * DM;
        const float* sc = sh + DM;
        f32x4 hv[4];
#pragma unroll
        for (int c = 0; c < 4; ++c) {
            const int col = c * 256 + F.lane * 4;
            const f32x4 g = *(const f32x4*)(ng + col), s1 = *(const f32x4*)(sc + col), s0 = *(const f32x4*)(sh + col);
#pragma unroll
            for (int u = 0; u < 4; ++u) hv[c][u] = (xv[c][u] * rinv * g[u]) * (1.0f + s1[u]) + s0[u];
            u32x2 w; w[0] = pack_bf16(hv[c][0], hv[c][1]); w[1] = pack_bf16(hv[c][2], hv[c][3]);
            *(u32x2*)(hbuf + (size_t)tok * DM + col) = w;
        }
        if (ROUTE) {
            LAS float* lgs = (LAS float*)(F.lds + 36 * WR_LD * 4 + 256) + F.wave * 36;
#pragma unroll 1
            for (int jb = 0; jb < 36; jb += 4) {
                float pp[4];
#pragma unroll
                for (int u = 0; u < 4; ++u) {
                    float p = 0.f;
#pragma unroll
                    for (int c = 0; c < 4; ++c) {
                        const f32x4 w = *(const LAS f32x4*)(wrT + (jb + u) * WR_LD + c * 256 + F.lane * 4);
                        p += hv[c][0] * w[0] + hv[c][1] * w[1] + hv[c][2] * w[2] + hv[c][3] * w[3];
                    }
                    pp[u] = p;
                }
#pragma unroll
                for (int u = 0; u < 4; ++u) pp[u] = wave_sum(pp[u]);
                if (F.lane == 0) { *(LAS f32x4*)(lgs + jb) = (f32x4){pp[0], pp[1], pp[2], pp[3]}; }
            }
            float lg[36];
#pragma unroll
            for (int j = 0; j < 36; ++j) lg[j] = lgs[j] + brs[j];
            int g = 0; float gm = lg[0];
#pragma unroll
            for (int j = 1; j < 4; ++j) if (lg[j] > gm) { gm = lg[j]; g = j; }
            float den = 0.f;
#pragma unroll
            for (int j = 0; j < 4; ++j) den += __expf(lg[j] - gm);
            const float ptop = 1.0f / den;
            float fv[8];
#pragma unroll
            for (int i = 0; i < 8; ++i) fv[i] = (g == 0) ? lg[4 + i] : (g == 1) ? lg[12 + i] : (g == 2) ? lg[20 + i] : lg[28 + i];
            int i1 = 0; float v1 = fv[0];
#pragma unroll
            for (int i = 1; i < 8; ++i) if (fv[i] > v1) { v1 = fv[i]; i1 = i; }
            int i2 = -1; float v2 = -3.0e38f;
#pragma unroll
            for (int i = 0; i < 8; ++i) if (i != i1 && fv[i] > v2) { v2 = fv[i]; i2 = i; }
            const float e2 = __expf(v2 - v1), ga = ptop / (1.0f + e2), gb = ptop * e2 / (1.0f + e2);
            if (F.lane == 0) {
                const int li = ((tb - F.bid * NWAVE * TPW) / (F.G * NWAVE * TPW)) * NWAVE * TPW + F.wave * TPW + ti;
                const int ea = g * 8 + i1, eb = g * 8 + i2;
                const int ra = __hip_atomic_fetch_add(&rcnt[ea], 1, __ATOMIC_RELAXED, __HIP_MEMORY_SCOPE_WORKGROUP);
                const int rb = __hip_atomic_fetch_add(&rcnt[eb], 1, __ATOMIC_RELAXED, __HIP_MEMORY_SCOPE_WORKGROUP);
                if (li < RT_CAP) { rt_er[2 * li] = (ea << 16) | ra; rt_gate[2 * li] = ga; rt_tok[2 * li] = tok; rt_er[2 * li + 1] = (eb << 16) | rb; rt_gate[2 * li + 1] = gb; rt_tok[2 * li + 1] = tok; }
            }
        }
      }
    }
    if (ROUTE) {
        __syncthreads();
        unsigned* cnt = ctl + CW_CNT + layer * NEXP * CNT_STRIDE;
        if (F.tid < NEXP) { const int n = rcnt[F.tid]; rbase[F.tid] = n ? (int)__hip_atomic_fetch_add(cnt + F.tid * CNT_STRIDE, (unsigned)n, __ATOMIC_RELAXED, __HIP_MEMORY_SCOPE_AGENT) : 0; }
        __syncthreads();
        int* list = (int*)(a.ws + WS_LIST); float* gatev = (float*)(a.ws + WS_GATEV); int* tsl = (int*)(a.ws + WS_TOKSLOT);
        int nloc = 0;
        for (int tb = F.bid * NWAVE * TPW; tb < NTOK; tb += F.G * NWAVE * TPW) nloc += NWAVE * TPW;
        nloc = nloc < RT_CAP ? nloc : RT_CAP;
        for (int i = F.tid; i < 2 * nloc; i += NTHR) {
            const int er = rt_er[i]; if (er < 0) continue;
            const int e = er >> 16, pos = rbase[e] + (er & 0xffff), tok = rt_tok[i];
            list[e * NTOK + pos] = tok; gatev[e * NTOK + pos] = rt_gate[i]; tsl[tok * 2 + (i & 1)] = (e << 20) | pos;
        }
    }
    __syncthreads();
}

constexpr int RP_HT = 0, RP_HT_LD = 1028;
constexpr int RP_PART = 16 * RP_HT_LD * 4;
constexpr int RP_LG = RP_PART + 8 * 16 * 48 * 4;
DI void route_phase(const Frame& F, const Args& a, int layer) {
    const float* mod = (const float*)(a.ws + WS_MOD);
    bf16_t* hbuf = (bf16_t*)(a.ws + WS_H);
    unsigned* ctl = (unsigned*)(a.ws + WS_CTL);
    LAS float* HT = (LAS float*)(F.lds + RP_HT);
    LAS float* PART = (LAS float*)(F.lds + RP_PART);
    LAS float* LG = (LAS float*)(F.lds + RP_LG);
    constexpr int RT_CAP = 512;
    LAS int* rcnt = (LAS int*)(F.lds + 149504);
    LAS int* rbase = (LAS int*)(F.lds + 149632);
    LAS int* rt_er = (LAS int*)(F.lds + 149760);
    LAS float* rt_gate = (LAS float*)(F.lds + 149760 + 4096);
    LAS int* rt_tok = (LAS int*)(F.lds + 149760 + 8192);
    if (F.tid < NEXP) rcnt[F.tid] = 0;
    for (int i = F.tid; i < 2 * RT_CAP; i += NTHR) rt_er[i] = -1;
    const float* wg = a.moe_wr_g + (size_t)layer * DM * 4;
    const float* we = a.moe_wr_e + (size_t)layer * DM * 32;
    const int col = F.lane & 15, kq = F.lane >> 4;
    float Bw[3][32];
#pragma unroll
    for (int s2 = 0; s2 < 32; ++s2) {
        const int k = 128 * F.wave + 16 * (s2 >> 2) + 4 * kq + (s2 & 3);
        Bw[0][s2] = col < 4 ? wg[k * 4 + col] : we[k * 32 + col - 4];
        Bw[1][s2] = we[k * 32 + 12 + col];
        Bw[2][s2] = col < 4 ? we[k * 32 + 28 + col] : 0.f;
    }
    const float* ng = a.norm_g + ((size_t)layer * 2 + 1) * DM;
    __syncthreads();
    const int ngroups = NTOK / 16;
    int li0 = 0;
    f32x4 xn[2][4];
    if (F.bid < ngroups) {
#pragma unroll
        for (int ti = 0; ti < 2; ++ti)
#pragma unroll
            for (int c = 0; c < 4; ++c) xn[ti][c] = *(const f32x4*)(a.out + (size_t)(F.bid * 16 + F.wave * 2 + ti) * DM + c * 256 + F.lane * 4);
    }
    for (int gi = F.bid; gi < ngroups; gi += F.G, li0 += 16) {
        const int tb = gi * 16 + F.wave * 2, b = tb / SEQ;
        const float* sh = mod + ((size_t)layer * NB + b) * 6 * DM + 3 * DM;
        const float* scp = sh + DM;
        f32x4 xc[2][4];
#pragma unroll
        for (int ti = 0; ti < 2; ++ti)
#pragma unroll
            for (int c = 0; c < 4; ++c) xc[ti][c] = xn[ti][c];
        if (gi + F.G < ngroups) {
#pragma unroll
            for (int ti = 0; ti < 2; ++ti)
#pragma unroll
                for (int c = 0; c < 4; ++c) xn[ti][c] = *(const f32x4*)(a.out + (size_t)((gi + F.G) * 16 + F.wave * 2 + ti) * DM + c * 256 + F.lane * 4);
        }
#pragma unroll
        for (int ti = 0; ti < 2; ++ti) {
            const int tok = tb + ti;
            f32x4 xv[4];
#pragma unroll
            for (int c = 0; c < 4; ++c) xv[c] = xc[ti][c];
            float ss = 0.f;
#pragma unroll
            for (int c = 0; c < 4; ++c) ss += xv[c][0] * xv[c][0] + xv[c][1] * xv[c][1] + xv[c][2] * xv[c][2] + xv[c][3] * xv[c][3];
            ss = wave_sum(ss);
            const float rinv = rsqrtf(ss * (1.0f / DM) + EPS);
#pragma unroll
            for (int c = 0; c < 4; ++c) {
                const int cl = c * 256 + F.lane * 4;
                const f32x4 g = *(const f32x4*)(ng + cl), s1 = *(const f32x4*)(scp + cl), s0 = *(const f32x4*)(sh + cl);
                f32x4 hv;
#pragma unroll
                for (int u = 0; u < 4; ++u) hv[u] = (xv[c][u] * rinv * g[u]) * (1.0f + s1[u]) + s0[u];
                u32x2 w; w[0] = pack_bf16(hv[0], hv[1]); w[1] = pack_bf16(hv[2], hv[3]);
                *(u32x2*)(hbuf + (size_t)tok * DM + cl) = w;
                *(LAS f32x4*)(HT + (F.wave * 2 + ti) * RP_HT_LD + cl) = hv;
            }
        }
        __syncthreads();
        {
            f32x4 acc[3];
#pragma unroll
            for (int n = 0; n < 3; ++n) acc[n] = (f32x4){0.f, 0.f, 0.f, 0.f};
            const LAS float* ap = HT + col * RP_HT_LD + 128 * F.wave + 4 * kq;
#pragma unroll
            for (int s4 = 0; s4 < 8; ++s4) {
                const f32x4 av = *(const LAS f32x4*)(ap + 16 * s4);
#pragma unroll
                for (int u = 0; u < 4; ++u)
#pragma unroll
                    for (int n = 0; n < 3; ++n) acc[n] = __builtin_amdgcn_mfma_f32_16x16x4f32(av[u], Bw[n][4 * s4 + u], acc[n], 0, 0, 0);
            }
#pragma unroll
            for (int n = 0; n < 3; ++n)
#pragma unroll
                for (int r = 0; r < 4; ++r) PART[(F.wave * 16 + 4 * kq + r) * 48 + 16 * n + col] = acc[n][r];
        }
        __syncthreads();
        {
            const int tk = F.tid >> 5, j = F.tid & 31;
            float s0 = 0.f, s1 = 0.f;
#pragma unroll
            for (int wv = 0; wv < NWAVE; ++wv) { s0 += PART[(wv * 16 + tk) * 48 + j]; s1 += PART[(wv * 16 + tk) * 48 + 32 + (j & 3)]; }
            LG[tk * 36 + j] = s0 + (j < 4 ? a.moe_br_g[layer * 4 + j] : a.moe_br_e[layer * 32 + j - 4]);
            if (j < 4) LG[tk * 36 + 32 + j] = s1 + a.moe_br_e[layer * 32 + 28 + j];
        }
        __syncthreads();
        if (F.tid < 16) {
            const int tk = F.tid, tok = gi * 16 + tk;
            float lg[36];
#pragma unroll
            for (int j = 0; j < 36; ++j) lg[j] = LG[tk * 36 + j];
            int g = 0; float gm = lg[0];
#pragma unroll
            for (int j = 1; j < 4; ++j) if (lg[j] > gm) { gm = lg[j]; g = j; }
            float den = 0.f;
#pragma unroll
            for (int j = 0; j < 4; ++j) den += __expf(lg[j] - gm);
            const float ptop = 1.0f / den;
            float fv[8];
#pragma unroll
            for (int i = 0; i < 8; ++i) fv[i] = (g == 0) ? lg[4 + i] : (g == 1) ? lg[12 + i] : (g == 2) ? lg[20 + i] : lg[28 + i];
            int i1 = 0; float v1 = fv[0];
#pragma unroll
            for (int i = 1; i < 8; ++i) if (fv[i] > v1) { v1 = fv[i]; i1 = i; }
            int i2 = -1; float v2 = -3.0e38f;
#pragma unroll
            for (int i = 0; i < 8; ++i) if (i != i1 && fv[i] > v2) { v2 = fv[i]; i2 = i; }
            const float e2 = __expf(v2 - v1), ga = ptop / (1.0f + e2), gb = ptop * e2 / (1.0f + e2);
            const int li = li0 + tk, ea = g * 8 + i1, eb = g * 8 + i2;
            const int ra = __hip_atomic_fetch_add(&rcnt[ea], 1, __ATOMIC_RELAXED, __HIP_MEMORY_SCOPE_WORKGROUP);
            const int rb = __hip_atomic_fetch_add(&rcnt[eb], 1, __ATOMIC_RELAXED, __HIP_MEMORY_SCOPE_WORKGROUP);
            if (li < RT_CAP) { rt_er[2 * li] = (ea << 16) | ra; rt_gate[2 * li] = ga; rt_tok[2 * li] = tok; rt_er[2 * li + 1] = (eb << 16) | rb; rt_gate[2 * li + 1] = gb; rt_tok[2 * li + 1] = tok; }
        }
    }
    __syncthreads();
    unsigned* cnt = ctl + CW_CNT + layer * NEXP * CNT_STRIDE;
    if (F.tid < NEXP) { const int n = rcnt[F.tid]; rbase[F.tid] = n ? (int)__hip_atomic_fetch_add(cnt + F.tid * CNT_STRIDE, (unsigned)n, __ATOMIC_RELAXED, __HIP_MEMORY_SCOPE_AGENT) : 0; }
    __syncthreads();
    int* list = (int*)(a.ws + WS_LIST); float* gatev = (float*)(a.ws + WS_GATEV); int* tsl = (int*)(a.ws + WS_TOKSLOT);
    const int nloc = li0 < RT_CAP ? li0 : RT_CAP;
    for (int i = F.tid; i < 2 * nloc; i += NTHR) {
        const int er = rt_er[i]; if (er < 0) continue;
        const int e = er >> 16, pos = rbase[e] + (er & 0xffff), tok = rt_tok[i];
        list[e * NTOK + pos] = tok; gatev[e * NTOK + pos] = rt_gate[i]; tsl[tok * 2 + (i & 1)] = (e << 20) | pos;
    }
    __syncthreads();
}

constexpr int LDS_MISC = 131072 + 64;
constexpr int LDS_XB = 163840 - 16;
constexpr int LDS_BYTES = 163840;
using pg8::Unit;
struct DenseSched {
    int nM, nN, nwg, G, c; const char* Bt; size_t tstepB;
    DI void init(int M, int N, int K, int G_, int c_, const void* Bt_) { nM = M / 256; nN = N / 256; nwg = nM * nN; G = G_; c = c_; Bt = (const char*)Bt_; tstepB = (size_t)256 * K * 2; }
    DI bool next(int i, Unit& u) const {
        const long L = (long)i * G + c; if (L >= nwg) return false;
        int wgid = (int)L; { const int q = nwg / 8, r = nwg % 8, xcd = wgid % 8, off = wgid / 8; wgid = (xcd < r ? xcd * (q + 1) : r * (q + 1) + (xcd - r) * q) + off; }
        const int nig = 8 * nN, gid = wgid / nig, fm = gid * 8, gsz = (nM - fm) < 8 ? (nM - fm) : 8;
        u.pm = fm + ((wgid % nig) % gsz); u.pn = (wgid % nig) / gsz; u.e = 0; u.nrow = 256; return true;
    }
    DI int a_row(const Unit& u, int r) const { return u.pm * 256 + r; }
    DI const char* b_base(const Unit& u) const { return Bt + (size_t)u.pn * tstepB; }
};
template <bool UP>
struct MoeSched {
    const LAS int* ntp; const unsigned* cnt; const int* list; const char* W; int nU, G, c;
    DI bool next(int i, Unit& u) const {
        const long L = (long)i * G + c; if (L >= nU) return false;
        int wgid = (int)L; { const int q = nU / 8, r = nU % 8, xcd = wgid % 8, off = wgid / 8; wgid = (xcd < r ? xcd * (q + 1) : r * (q + 1) + (xcd - r) * q) + off; }
        const int tg = wgid >> 2; u.pn = wgid & 3; u.pm = tg;
        int e = 0;
        for (int k = 1; k < NEXP; ++k) e += (ntp[k] <= tg) ? 1 : 0;
        u.e = e; const int rem = ntp[40 + e] - (tg - ntp[e]) * 256; u.nrow = rem < 256 ? rem : 256; return true;
    }
    DI int a_row(const Unit& u, int r) const {
        if (UP) { const int p = (u.pm - ntp[u.e]) * 256 + r; return (r < u.nrow) ? list[u.e * NTOK + p] : 0; }
        return u.pm * 256 + r;
    }
    DI const char* b_base(const Unit& u) const {
        return W + (size_t)u.e * 3 * MiB + (UP ? (size_t)u.pn * 256 * DM * 2 : 2 * MiB + (size_t)u.pn * 256 * DEXP * 2);
    }
};
DI void moe_tile_table(const Frame& F, const unsigned* cnt, LAS int* ntp  ) {
    if (F.tid < NEXP) ntp[40 + F.tid] = (int)cnt[F.tid * CNT_STRIDE];
    __syncthreads();
    if (F.tid == 0) { int s = 0; for (int e = 0; e < NEXP; ++e) { ntp[e] = s; s += (ntp[40 + e] + 255) >> 8; } ntp[NEXP] = s; }
    __syncthreads();
}

#define EPI_ROWS_BEGIN const int row0 = u.pm * 256 + wr * 64 + fr; _Pragma("unroll") for (int ai = 0; ai < 2; ++ai) _Pragma("unroll") for (int m = 0; m < 4; ++m) { const int row = row0 + ai * 128 + m * 16;
#define EPI_ROWS_END }
DI u32x2 pack4(const f32x4& v) { u32x2 w; w[0] = pack_bf16(v[0], v[1]); w[1] = pack_bf16(v[2], v[3]); return w; }

struct EpiAbIn {
    bf16_t* Zc;
    DI void operator()(const f32x4 (&acc)[2][2][4][2], const Unit& u, int wr, int wc, int fr, int fq) const {
        EPI_ROWS_BEGIN
            bf16_t* rp = Zc + (size_t)row * ZC_N;
            if (u.pn < 2) {
#pragma unroll
                for (int bj = 0; bj < 2; ++bj) {
                    const u32x2 lo = pack4(acc[ai][bj][m][0]), hi = pack4(acc[ai][bj][m][1]);
                    *(u32x4*)(rp + u.pn * 256 + bj * 128 + wc * 32 + 8 * fq) = (u32x4){lo[0], lo[1], hi[0], hi[1]};
                }
            } else {
                const int pnp = (u.pn - 2) & 3, j = 128 * pnp + 32 * wc + 8 * fq;
                u32x2 o[2];
#pragma unroll
                for (int bj = 0; bj < 2; ++bj) {
                    const f32x4 X = acc[ai][bj][m][0], Y = acc[ai][bj][m][1]; f32x4 v;
                    if (u.pn < 6) v = X * Y;
                    else { v[0] = X[0] * sigmoid_f(Y[0]); v[1] = X[1] * sigmoid_f(Y[1]); v[2] = X[2] * sigmoid_f(Y[2]); v[3] = X[3] * sigmoid_f(Y[3]); }
                    o[bj] = pack4(v);
                }
                *(u32x4*)(rp + (u.pn < 6 ? 512 : 1024) + j) = (u32x4){o[0][0], o[0][1], o[1][0], o[1][1]};
            }
        EPI_ROWS_END
    }
};
struct EpiResid {
    const float* xin; float* xout; const float* g1;
    DI void operator()(const f32x4 (&acc)[2][2][4][2], const Unit& u, int wr, int wc, int fr, int fq) const {
        const float* g = g1 + (size_t)((u.pm * 256) / SEQ) * 6 * DM;
        const int row0 = u.pm * 256 + wr * 64 + fr, col0 = u.pn * 256 + wc * 32 + 4 * fq;
        f32x4 gv[2][2];
#pragma unroll
        for (int bj = 0; bj < 2; ++bj)
#pragma unroll
            for (int n = 0; n < 2; ++n) gv[bj][n] = *(const f32x4*)(g + col0 + bj * 128 + n * 16);
#pragma unroll
        for (int ai = 0; ai < 2; ++ai) {
            f32x4 xo[4][2][2];
#pragma unroll
            for (int m = 0; m < 4; ++m)
#pragma unroll
                for (int bj = 0; bj < 2; ++bj)
#pragma unroll
                    for (int n = 0; n < 2; ++n) xo[m][bj][n] = *(const f32x4*)(xin + (size_t)(row0 + ai * 128 + m * 16) * DM + col0 + bj * 128 + n * 16);
            asm volatile("" ::: "memory");
#pragma unroll
            for (int m = 0; m < 4; ++m)
#pragma unroll
                for (int bj = 0; bj < 2; ++bj)
#pragma unroll
                    for (int n = 0; n < 2; ++n) *(f32x4*)(xout + (size_t)(row0 + ai * 128 + m * 16) * DM + col0 + bj * 128 + n * 16) = xo[m][bj][n] + gv[bj][n] * acc[ai][bj][m][n];
        }
    }
};
struct EpiPlain {
    bf16_t* O; int ld;
    DI void operator()(const f32x4 (&acc)[2][2][4][2], const Unit& u, int wr, int wc, int fr, int fq) const {
        EPI_ROWS_BEGIN
#pragma unroll
            for (int bj = 0; bj < 2; ++bj) {
                const u32x2 lo = pack4(acc[ai][bj][m][0]), hi = pack4(acc[ai][bj][m][1]);
                *(u32x4*)(O + (size_t)row * ld + u.pn * 256 + bj * 128 + wc * 32 + 8 * fq) = (u32x4){lo[0], lo[1], hi[0], hi[1]};
            }
        EPI_ROWS_END
    }
};
struct EpiPlainNat {
    bf16_t* O; int ld;
    DI void operator()(const f32x4 (&acc)[2][2][4][2], const Unit& u, int wr, int wc, int fr, int fq) const {
        EPI_ROWS_BEGIN
#pragma unroll
            for (int bj = 0; bj < 2; ++bj)
#pragma unroll
                for (int n = 0; n < 2; ++n) *(u32x2*)(O + (size_t)row * ld + u.pn * 256 + bj * 128 + wc * 32 + n * 16 + 4 * fq) = pack4(acc[ai][bj][m][n]);
        EPI_ROWS_END
    }
};
struct EpiVt {
    bf16_t* O;
    DI void operator()(const f32x4 (&acc)[2][2][4][2], const Unit& u, int wr, int wc, int fr, int fq) const {
        const int pos = 8 * (fq & 1) + 4 * (fq >> 1);
        EPI_ROWS_BEGIN
#pragma unroll
            for (int bj = 0; bj < 2; ++bj)
#pragma unroll
                for (int n = 0; n < 2; ++n) *(u32x2*)(O + (size_t)row * NTOK + u.pn * 256 + bj * 128 + wc * 32 + n * 16 + pos) = pack4(acc[ai][bj][m][n]);
        EPI_ROWS_END
    }
};
struct EpiMoeUp {
    bf16_t* act;
    DI void operator()(const f32x4 (&acc)[2][2][4][2], const Unit& u, int wr, int wc, int fr, int fq) const {
        EPI_ROWS_BEGIN
            u32x2 o[2];
#pragma unroll
            for (int bj = 0; bj < 2; ++bj) {
                const f32x4 X = acc[ai][bj][m][0], Y = acc[ai][bj][m][1]; f32x4 v;
                v[0] = silu_f(X[0]) * Y[0]; v[1] = silu_f(X[1]) * Y[1]; v[2] = silu_f(X[2]) * Y[2]; v[3] = silu_f(X[3]) * Y[3];
                o[bj] = pack4(v);
            }
            *(u32x4*)(act + (size_t)row * DEXP + 128 * u.pn + 32 * wc + 8 * fq) = (u32x4){o[0][0], o[0][1], o[1][0], o[1][1]};
        EPI_ROWS_END
    }
};
struct EpiMoeDown {
    bf16_t* y; const float* gatev; const LAS int* ntp;
    DI void operator()(const f32x4 (&acc)[2][2][4][2], const Unit& u, int wr, int wc, int fr, int fq) const {
        const int pbase = (u.pm - ntp[u.e]) * 256;
        EPI_ROWS_BEGIN
            const int r = row - u.pm * 256;
            const float gt = (r < u.nrow) ? gatev[u.e * NTOK + pbase + r] : 0.f;
#pragma unroll
            for (int bj = 0; bj < 2; ++bj) {
                const u32x2 lo = pack4(acc[ai][bj][m][0] * gt), hi = pack4(acc[ai][bj][m][1] * gt);
                *(u32x4*)(y + (size_t)row * DM + u.pn * 256 + bj * 128 + wc * 32 + 8 * fq) = (u32x4){lo[0], lo[1], hi[0], hi[1]};
            }
        EPI_ROWS_END
    }
};

DI void conv_phase(const Frame& F, const Args& a) {
    const bf16_t* Zc = (const bf16_t*)(a.ws + WS_BIG);
    bf16_t* Y = (bf16_t*)(a.ws + WS_Y);
    LAS unsigned* PB = (LAS unsigned*)F.lds;
    LAS f32x2* ST = (LAS f32x2*)(F.lds + 94 * 1024);
    const int cp = F.tid & 255, th = F.tid >> 8, wq = F.wave & 3;
    float wb[31][2], wa[3][2];
#pragma unroll
    for (int k = 0; k < 31; ++k) { const f32x2 w = *(const f32x2*)(a.ab_conv_b + k * 512 + 2 * cp); wb[k][0] = w[0]; wb[k][1] = w[1]; }
#pragma unroll
    for (int k = 0; k < 3; ++k) { const f32x2 w = *(const f32x2*)(a.ab_conv_a + k * 512 + 2 * cp); wa[k][0] = w[0]; wa[k][1] = w[1]; }
    const f32x2 cbias = *(const f32x2*)(a.ab_conv_b_bias + 2 * cp), lng = *(const f32x2*)(a.ab_ln_g + 2 * cp), lnb = *(const f32x2*)(a.ab_ln_b + 2 * cp);
    for (int tile = F.bid; tile < NTOK / 64; tile += F.G) {
        const int t0 = tile * 64, b = t0 / SEQ, tl0 = t0 % SEQ;
        for (int i = F.tid; i < 94 * 64; i += NTHR) {
            const int r = i >> 6, c8 = i & 63, pos = tl0 - 30 + r;
            u32x4 v = {0u, 0u, 0u, 0u};
            if (pos >= 0) v = *(const u32x4*)(Zc + (size_t)(b * SEQ + pos) * ZC_N + 1024 + c8 * 8);
            *(LAS u32x4*)(PB + r * 256 + c8 * 4) = v;
        }
        __syncthreads();
#pragma unroll 1
        for (int g = 0; g < 4; ++g) {
            float U[8][2];
#pragma unroll
            for (int i = 0; i < 8; ++i) { U[i][0] = cbias[0]; U[i][1] = cbias[1]; }
#pragma unroll
            for (int r = 0; r < 38; ++r) {
                const unsigned xw = PB[(32 * th + 8 * g + r) * 256 + cp];
                const float x0 = bf_lo(xw), x1 = bf_hi(xw);
#pragma unroll
                for (int i = 0; i < 8; ++i) { const int k = r - i; if (k >= 0 && k <= 30) { U[i][0] += wb[k][0] * x0; U[i][1] += wb[k][1] * x1; } }
            }
            unsigned gwv[8], pav[10];
#pragma unroll
            for (int i = 0; i < 8; ++i) gwv[i] = *(const unsigned*)(Zc + ((size_t)t0 + 32 * th + 8 * g + i) * ZC_N + 2 * cp);
#pragma unroll
            for (int i = 0; i < 10; ++i) { const int pp = tl0 + 32 * th + 8 * g + i - 2; pav[i] = pp >= 0 ? *(const unsigned*)(Zc + (size_t)(b * SEQ + pp) * ZC_N + 512 + 2 * cp) : 0u; }
            {
                float v[16];
#pragma unroll
                for (int i = 0; i < 8; ++i) { v[2 * i] = U[i][0] + U[i][1]; v[2 * i + 1] = U[i][0] * U[i][0] + U[i][1] * U[i][1]; }
#pragma unroll
                for (int hw = 8; hw >= 1; hw >>= 1) {
                    const bool up = (F.lane & (4 * hw)) != 0;
#pragma unroll
                    for (int i = 0; i < hw; ++i) { const float send = up ? v[i] : v[i + hw], keep = up ? v[i + hw] : v[i]; v[i] = keep + __shfl_xor(send, 4 * hw); }
                }
                v[0] += __shfl_xor(v[0], 2); v[0] += __shfl_xor(v[0], 1);
                if ((F.lane & 3) == 0) { const int idx = F.lane >> 2; ((LAS float*)ST)[((32 * th + 8 * g + (idx >> 1)) * 4 + wq) * 2 + (idx & 1)] = v[0]; }
            }
            __syncthreads();
#pragma unroll
            for (int i = 0; i < 8; ++i) {
                const int tl = 32 * th + 8 * g + i; const size_t tok = (size_t)t0 + tl;
                const f32x2 p0 = ST[tl * 4 + 0], p1 = ST[tl * 4 + 1], p2 = ST[tl * 4 + 2], p3 = ST[tl * 4 + 3];
                const float mean = ((p0[0] + p1[0]) + (p2[0] + p3[0])) * (1.0f / 512.0f);
                const float var = ((p0[1] + p1[1]) + (p2[1] + p3[1])) * (1.0f / 512.0f) - mean * mean;
                const float rstd = rsqrtf(var + EPS);
                const float yb0 = silu_f((U[i][0] - mean) * rstd * lng[0] + lnb[0]), yb1 = silu_f((U[i][1] - mean) * rstd * lng[1] + lnb[1]);
                *(unsigned*)(Y + tok * DM + 512 + 2 * cp) = pack_bf16(yb0, yb1);
                float a0 = 0.f, a1 = 0.f;
#pragma unroll
                for (int k = 0; k < 3; ++k) { const unsigned w = pav[i + k]; a0 += wa[k][0] * bf_lo(w); a1 += wa[k][1] * bf_hi(w); }
                const unsigned gw = gwv[i];
                *(unsigned*)(Y + tok * DM + 2 * cp) = pack_bf16(bf_lo(gw) * a0, bf_hi(gw) * a1);
            }
        }
        __syncthreads();
    }
}

#define MFMA32(a, b, c) __builtin_amdgcn_mfma_f32_32x32x16_bf16((a), (b), (c), 0, 0, 0)
#define LDS6_ISSUE(B, addr, o0, o1, o2, o3, o4, o5) asm volatile( \
    "ds_read_b128 %0, %6 offset:" #o0 "\n\tds_read_b128 %1, %6 offset:" #o1 "\n\tds_read_b128 %2, %6 offset:" #o2 "\n\tds_read_b128 %3, %6 offset:" #o3 "\n\tds_read_b128 %4, %6 offset:" #o4 "\n\tds_read_b128 %5, %6 offset:" #o5 \
    : "=&v"(B[0]), "=&v"(B[1]), "=&v"(B[2]), "=&v"(B[3]), "=&v"(B[4]), "=&v"(B[5]) : "v"(addr) : "memory")
#define LDS6_WAIT(B) asm volatile("s_waitcnt lgkmcnt(0)" : "+v"(B[0]), "+v"(B[1]), "+v"(B[2]), "+v"(B[3]), "+v"(B[4]), "+v"(B[5]) :: "memory")
constexpr int TK_HIST = 0;
constexpr int TK_HLD = 513;
constexpr int TK_TAB = 66048;
constexpr int TK_CAP = 256;
constexpr int TK_CAND = 66560;
constexpr int TK_CCNT = TK_CAND + 32 * TK_CAP * 4;
constexpr int TK_OVF = TK_CCNT + 128;
constexpr int TK_BQ = 100352;
constexpr int TK_MASK = 118784;
DI int crow_c(int r) { return (r & 3) + 8 * (r >> 2); }
template <int MODE, bool DIAG>
DI void topk_elems(const Frame& F, const f32x16& sc, int kt, int q, int h2, int myT, LAS unsigned* hist, LAS unsigned* cand, LAS int* ccnt, LAS unsigned* maskl) {
    const int lo = myT << 9, hi = (myT + 1) << 9;
    if (MODE <= 2) {
#pragma unroll
        for (int r = 0; r < 16; ++r) {
            unsigned key = (unsigned)fmaxf(sc[r], 0.0f); key = key > 262143u ? 262143u : key;
            const bool valid = !DIAG || (crow_c(r) + 4 * h2 <= q);
            if (MODE == 1) { if (valid) __hip_atomic_fetch_add(&hist[q * TK_HLD + (key >> 9)], 1u, __ATOMIC_RELAXED, __HIP_MEMORY_SCOPE_WORKGROUP); }
            else { if (valid && (int)(key >> 9) == myT) __hip_atomic_fetch_add(&hist[q * TK_HLD + (key & 511)], 1u, __ATOMIC_RELAXED, __HIP_MEMORY_SCOPE_WORKGROUP); }
        }
        return;
    }
    const int selb = (MODE == 3 ? myT : hi - 1), geb = (MODE == 3 ? myT - 1 : lo - 1);
    unsigned selw = 0u, gew = 0u;
#pragma unroll
    for (int r = 0; r < 16; ++r) {
        unsigned key = (unsigned)fmaxf(sc[r], 0.0f); key = key > 262143u ? 262143u : key;
        const unsigned d1 = (unsigned)(selb - (int)key), d2 = (unsigned)(geb - (int)key);
        selw = __builtin_amdgcn_alignbit(selw, d1, 31);
        gew = __builtin_amdgcn_alignbit(gew, d2, 31);
    }
    if (DIAG) {
        unsigned vw = 0u;
#pragma unroll
        for (int r = 0; r < 16; ++r) vw |= (crow_c(r) + 4 * h2 <= q) ? (1u << (15 - r)) : 0u;
        selw &= vw; gew &= vw;
    }
    unsigned cw = gew & ~selw & 0xffffu;
    if (cw) {
#pragma unroll
        for (int r = 0; r < 16; ++r) {
            if (cw & (1u << (15 - r))) {
                unsigned key = (unsigned)fmaxf(sc[r], 0.0f); key = key > 262143u ? 262143u : key;
                const int p = __hip_atomic_fetch_add(&ccnt[q], 1, __ATOMIC_RELAXED, __HIP_MEMORY_SCOPE_WORKGROUP);
                if (p < TK_CAP) cand[q * TK_CAP + p] = (MODE == 3 ? 0u : ((key - (unsigned)lo) << 13)) | (unsigned)(8191 - (32 * kt + crow_c(r) + 4 * h2));
            }
        }
    }
    unsigned rv = __builtin_bitreverse32(selw) >> 16;
    unsigned bits = (rv & 0xfu) | ((rv & 0xf0u) << 4) | ((rv & 0xf00u) << 8) | ((rv & 0xf000u) << 12);
    bits <<= 4 * h2;
    bits |= (unsigned)__shfl_xor((int)bits, 32);
    if (h2 == 0) maskl[q * 256 + kt] = bits;
}
template <int MODE>
DI void topk_pass(const Frame& F, const bf16_t* Z, int b, int t0, const float (&wp)[8]) {
    const LAS unsigned char* bq = F.lds + TK_BQ;
    LAS unsigned* hist = (LAS unsigned*)(F.lds + TK_HIST);
    LAS int* tab = (LAS int*)(F.lds + TK_TAB);
    LAS unsigned* cand = (LAS unsigned*)(F.lds + TK_CAND);
    LAS int* ccnt = (LAS int*)(F.lds + TK_CCNT);
    LAS unsigned* maskl = (LAS unsigned*)(F.lds + TK_MASK);
    const int lane = fresh_lane(), q = lane & 31, h2 = lane >> 5, ntile = t0 / 32 + 1;
    const int myT = (MODE >= 2) ? tab[q * 4 + 0] : 0;
    const unsigned bqa = (unsigned)(size_t)(bq + lane * 16);
    const bf16_t* kbase = Z + (size_t)b * SEQ * CD_N + Z_KI + 8 * h2 + (size_t)q * CD_N;
    bf16x8 A0n = (bf16x8){0, 0, 0, 0, 0, 0, 0, 0}, A1n = A0n;
    if (F.wave < ntile) { const bf16_t* kp = kbase + (size_t)(32 * F.wave) * CD_N; A0n = *(const bf16x8*)kp; A1n = *(const bf16x8*)(kp + 16); }
    for (int kt = F.wave; kt < ntile; kt += NWAVE) {
        const bf16x8 A0 = A0n, A1 = A1n;
        if (kt + NWAVE < ntile) { const bf16_t* kp = kbase + (size_t)(32 * (kt + NWAVE)) * CD_N; A0n = *(const bf16x8*)kp; A1n = *(const bf16x8*)(kp + 16); }
        f32x16 sc;
#pragma unroll
        for (int r = 0; r < 16; ++r) sc[r] = 131072.0f;
        {
#define TK_MF0(acc, A, B) asm volatile("v_mfma_f32_32x32x16_bf16 %0, %1, %2, 0" : "=&v"(acc) : "v"(A), "v"(B))
#define TK_MF1(acc, A, B) asm volatile("v_mfma_f32_32x32x16_bf16 %0, %1, %2, %0" : "+v"(acc) : "v"(A), "v"(B))
#define TK_FA(sv, av, wv) asm volatile("v_fma_f32 %0, |%1|, %2, %0" : "+v"(sv) : "v"(av), "v"(wv))
#define TK_AD(sv, av) asm volatile("v_add_f32 %0, %0, %1" : "+v"(sv) : "v"(av))
        bf16x8 Ba[6], Bb[6];
        f32x16 acA[3], acB[3];
        LDS6_ISSUE(Ba, bqa, 16384, 17408, 0, 1024, 2048, 3072);
        LDS6_WAIT(Ba);
        LDS6_ISSUE(Bb, bqa, 4096, 5120, 6144, 7168, 8192, 9216);
#pragma unroll
        for (int u = 0; u < 3; ++u) TK_MF0(acA[u], A0, Ba[2 * u]);
#pragma unroll
        for (int u = 0; u < 3; ++u) TK_MF1(acA[u], A1, Ba[2 * u + 1]);
        LDS6_WAIT(Bb);
        LDS6_ISSUE(Ba, bqa, 10240, 11264, 12288, 13312, 14336, 15360);
#pragma unroll
        for (int m = 0; m < 6; ++m) {
            if (m >= 3) TK_MF1(acB[m - 3], A1, Bb[2 * (m - 3) + 1]); else TK_MF0(acB[m], A0, Bb[2 * m]);
#pragma unroll
            for (int e = 0; e < 8; ++e) { const int i = 8 * m + e, u = i >> 4, r = i & 15; if (u == 0) TK_AD(sc[r], acA[0][r]); else TK_FA(sc[r], acA[u][r], wp[u - 1]); }
        }
        LDS6_WAIT(Ba);
#pragma unroll
        for (int m = 0; m < 6; ++m) {
            if (m >= 3) TK_MF1(acA[m - 3], A1, Ba[2 * (m - 3) + 1]); else TK_MF0(acA[m], A0, Ba[2 * m]);
#pragma unroll
            for (int e = 0; e < 8; ++e) { const int i = 8 * m + e, u = i >> 4, r = i & 15; TK_FA(sc[r], acB[u][r], wp[2 + u]); }
        }
#pragma unroll
        for (int u = 0; u < 3; ++u)
#pragma unroll
            for (int r = 0; r < 16; ++r) TK_FA(sc[r], acA[u][r], wp[5 + u]);
#undef TK_MF0
#undef TK_MF1
#undef TK_FA
#undef TK_AD
        }
        if (kt == ntile - 1) topk_elems<MODE, true>(F, sc, kt, q, h2, myT, hist, cand, ccnt, maskl);
        else topk_elems<MODE, false>(F, sc, kt, q, h2, myT, hist, cand, ccnt, maskl);
    }
}
DI void topk_scan(const Frame& F, int pass, int t0) {
    LAS unsigned* hist = (LAS unsigned*)(F.lds + TK_HIST);
    LAS int* tab = (LAS int*)(F.lds + TK_TAB);
    LAS int* ovf = (LAS int*)(F.lds + TK_OVF);
    for (int qi = 0; qi < 4; ++qi) {
        const int q = F.wave * 4 + qi, n = t0 + q + 1;
        int need = 256, prevT = 0, prevAbove = 0;
        if (pass == 2) { prevT = tab[q * 4 + 0]; prevAbove = tab[q * 4 + 1]; need = 256 - prevAbove; }
        if (n <= 256) { if (F.lane == 0) { tab[q * 4 + 0] = -1; tab[q * 4 + 1] = 0; tab[q * 4 + 2] = 0; } continue; }
        unsigned hv[8]; unsigned s = 0;
#pragma unroll
        for (int i = 0; i < 8; ++i) { hv[i] = hist[q * TK_HLD + 511 - (8 * F.lane + i)]; s += hv[i]; }
        unsigned inc = s;
#pragma unroll
        for (int o = 1; o < 64; o <<= 1) { const unsigned v = (unsigned)__shfl_up((int)inc, o); if (F.lane >= o) inc += v; }
        const unsigned pre = inc - s;
        if ((int)pre < need && (int)inc >= need) {
            unsigned cum = pre; int bsel = 0; unsigned above = 0, inbin = 0; bool found = false;
#pragma unroll
            for (int i = 0; i < 8; ++i) { if (!found && (int)(cum + hv[i]) >= need) { found = true; bsel = 511 - (8 * F.lane + i); above = cum; inbin = hv[i]; } cum += hv[i]; }
            if (pass == 1) { tab[q * 4 + 0] = bsel; tab[q * 4 + 1] = (int)above; tab[q * 4 + 2] = 256 - (int)above; if (inbin > (unsigned)TK_CAP) *ovf = 1; }
            else { tab[q * 4 + 0] = (prevT << 9) | bsel; tab[q * 4 + 1] = prevAbove + (int)above; tab[q * 4 + 2] = 256 - (prevAbove + (int)above); }
        }
    }
}
DI void topk_select(const Frame& F) {
    LAS int* tab = (LAS int*)(F.lds + TK_TAB);
    LAS unsigned* cand = (LAS unsigned*)(F.lds + TK_CAND);
    LAS int* ccnt = (LAS int*)(F.lds + TK_CCNT);
    LAS unsigned* maskl = (LAS unsigned*)(F.lds + TK_MASK);
    for (int qi = 0; qi < 4; ++qi) {
        const int q = F.wave * 4 + qi, need = tab[q * 4 + 2];
        int n = ccnt[q]; n = n > TK_CAP ? TK_CAP : n;
        if (need <= 0 || n <= 0) continue;
        unsigned c[4]; int rk[4]; bool vv[4];
#pragma unroll
        for (int i = 0; i < 4; ++i) { vv[i] = F.lane + 64 * i < n; c[i] = vv[i] ? cand[q * TK_CAP + F.lane + 64 * i] : 0u; rk[i] = 0; }
        for (int j = 0; j < n; ++j) {
            const unsigned cj = cand[q * TK_CAP + j];
#pragma unroll
            for (int i = 0; i < 4; ++i) rk[i] += (cj > c[i]) ? 1 : 0;
        }
#pragma unroll
        for (int i = 0; i < 4; ++i)
            if (vv[i] && rk[i] < need) { const int idx = 8191 - (int)(c[i] & 8191u); __hip_atomic_fetch_or(&maskl[q * 256 + (idx >> 5)], 1u << (idx & 31), __ATOMIC_RELAXED, __HIP_MEMORY_SCOPE_WORKGROUP); }
    }
}
DI void topk_phase(const Frame& F, const Args& a, unsigned long long& tacc) {
    unsigned long long t_s = 0;
#define TKT0(n) do { if (TIME_PH == 100 + (n)) { __syncthreads(); t_s = wall_clock64(); } } while (0)
#define TKT1(n) do { if (TIME_PH == 100 + (n)) { __syncthreads(); tacc += wall_clock64() - t_s; } } while (0)
    const bf16_t* Z = (const bf16_t*)(a.ws + WS_BIG);
    unsigned* maskg = (unsigned*)(a.ws + WS_MASK);
    LAS unsigned* hist = (LAS unsigned*)(F.lds + TK_HIST);
    LAS int* ccnt = (LAS int*)(F.lds + TK_CCNT);
    LAS int* ovf = (LAS int*)(F.lds + TK_OVF);
    LAS unsigned* maskl = (LAS unsigned*)(F.lds + TK_MASK);
    for (int pi = F.bid; pi < 512; pi += F.G) {
        const int b = pi >> 7, p = pi & 127;
        for (int half = 0; half < 2; ++half) {
            const int t0 = 32 * (half ? 255 - p : p), ntile = t0 / 32 + 1;
            const int lane0 = fresh_lane(), q = lane0 & 31, h2 = lane0 >> 5;
            const bf16_t* zr = Z + (size_t)(b * SEQ + t0 + q) * CD_N;
            TKT0(1);
            float wp[8];
            { const u32x4 wv = *(const u32x4*)(zr + Z_WI);
              const float sc = 0.0625f * 0.5f * 16384.0f;
              wp[0] = bf_lo(wv[0]) * sc; wp[1] = bf_hi(wv[0]) * sc; wp[2] = bf_lo(wv[1]) * sc; wp[3] = bf_hi(wv[1]) * sc;
              wp[4] = bf_lo(wv[2]) * sc; wp[5] = bf_hi(wv[2]) * sc; wp[6] = bf_lo(wv[3]) * sc; wp[7] = bf_hi(wv[3]) * sc; }
            __syncthreads();
            if (F.wave == 0) {
                LAS unsigned char* bqw = F.lds + TK_BQ;
                float lin[2][8];
#pragma unroll
                for (int ks = 0; ks < 2; ++ks)
#pragma unroll
                    for (int j = 0; j < 8; ++j) lin[ks][j] = 0.f;
#pragma unroll
                for (int h = 0; h < 8; ++h)
#pragma unroll
                    for (int ks = 0; ks < 2; ++ks) {
                        const u32x4 v = *(const u32x4*)(zr + Z_QI + 32 * h + 16 * ks + 8 * h2);
                        *(LAS u32x4*)(bqw + ((2 * h + ks) * 64 + lane0) * 16) = v;
#pragma unroll
                        for (int j = 0; j < 4; ++j) { lin[ks][2 * j] += wp[h] * bf_lo(v[j]); lin[ks][2 * j + 1] += wp[h] * bf_hi(v[j]); }
                    }
#pragma unroll
                for (int ks = 0; ks < 2; ++ks) {
                    u32x4 v; v[0] = pack_bf16(lin[ks][0], lin[ks][1]); v[1] = pack_bf16(lin[ks][2], lin[ks][3]); v[2] = pack_bf16(lin[ks][4], lin[ks][5]); v[3] = pack_bf16(lin[ks][6], lin[ks][7]);
                    *(LAS u32x4*)(bqw + ((16 + ks) * 64 + lane0) * 16) = v;
                }
            }
            for (int i = F.tid; i < 32 * TK_HLD; i += NTHR) hist[i] = 0u;
            if (F.tid < 32) ccnt[F.tid] = 0;
            if (F.tid == 32) *ovf = 0;
            __syncthreads();
            TKT1(1); TKT0(2);
            topk_pass<1>(F, Z, b, t0, wp);
            __syncthreads();
            TKT1(2); TKT0(3);
            topk_scan(F, 1, t0);
            __syncthreads();
            TKT1(3); TKT0(4);
            if (*ovf == 0) {
                topk_pass<4>(F, Z, b, t0, wp);
            } else {
                for (int i = F.tid; i < 32 * TK_HLD; i += NTHR) hist[i] = 0u;
                __syncthreads();
                topk_pass<2>(F, Z, b, t0, wp);
                __syncthreads();
                topk_scan(F, 2, t0);
                __syncthreads();
                topk_pass<3>(F, Z, b, t0, wp);
            }
            __syncthreads();
            TKT1(4); TKT0(5);
            topk_select(F);
            __syncthreads();
            for (int i = F.wave * 64 + fresh_lane(); i < 32 * ntile; i += NTHR) { const int qq = i / ntile, kt = i - qq * ntile; maskg[(size_t)(b * SEQ + t0 + qq) * 256 + kt] = maskl[qq * 256 + kt]; }
            TKT1(5);
        }
    }
}

constexpr int AT_KBYTES = 64 * 128;
constexpr int AT_VBYTES = 128 * 128;
constexpr int AT_BUF = AT_KBYTES + AT_VBYTES;
constexpr int AT_NSTG = 4;
constexpr int AT_LUT = AT_NSTG * AT_BUF;
constexpr int AT_LUTM = AT_LUT + 12 * 320 * 4;
constexpr int AT_LUT_LD = 320;
constexpr float NEG_INF = -__builtin_huge_valf();
constexpr float AT_THR = 8.0f;

template <int DV, bool MASKED>
DI void attn_core(const Frame& F, const bf16_t* Z, const bf16_t* Vt, int b, int qcol, int kcol, int vrow, int q0, const LAS float* lut, float c1, const unsigned* maskg, f32x16 (&O)[DV / 32]) {
    constexpr int NDV = DV / 32;
    const int q = F.lane & 31, h2 = F.lane >> 5;
    const int tw0 = q0 + 32 * F.wave, t = tw0 + q;
    const bf16_t* Zb = Z + (size_t)b * SEQ * CD_N;
    const bf16_t* Vb = Vt + (size_t)vrow * NTOK + (size_t)b * SEQ;
    const unsigned* mrow = maskg + (size_t)(b * SEQ + t) * 256;
    bf16x8 Qf[4];
#pragma unroll
    for (int ks = 0; ks < 4; ++ks) Qf[ks] = *(const bf16x8*)(Zb + (size_t)t * CD_N + qcol + 16 * ks + 8 * h2);
#pragma unroll
    for (int d = 0; d < NDV; ++d)
#pragma unroll
        for (int r = 0; r < 16; ++r) O[d][r] = 0.f;
    const LAS f32x4* lutm = (const LAS f32x4*)(F.lds + AT_LUTM);
    float m_run = NEG_INF, l_run = 0.f;
    const int jmax = (q0 + 255) >> 6;
    const int swz = (q >> 1) & 7;
    const int drow = F.lane >> 3, dpos = F.lane & 7;
    unsigned mreg[2] = {0u, 0u};
    bf16x8 Pf[4];
#pragma unroll
    for (int i = 0; i < 4; ++i) Pf[i] = (bf16x8){0, 0, 0, 0, 0, 0, 0, 0};
#define AT_DMA(j) do { const int sg_ = (j) % AT_NSTG; \
        { const int key_ = 8 * F.wave + drow, c_ = dpos ^ ((key_ >> 1) & 7); \
          __builtin_amdgcn_global_load_lds((const unsigned*)(Zb + (size_t)(64 * (j) + key_) * CD_N + kcol + 8 * c_), (LAS unsigned*)(F.lds + sg_ * AT_BUF + F.wave * 1024), 16, 0, 0); } \
        _Pragma("unroll") for (int _i = 0; _i < DV / 64; ++_i) { const int ii_ = F.wave + 8 * _i, row_ = 8 * ii_ + drow, c_ = dpos ^ ((row_ >> 1) & 7); \
          __builtin_amdgcn_global_load_lds((const unsigned*)(Vb + (size_t)row_ * NTOK + 64 * (j) + 8 * c_), (LAS unsigned*)(F.lds + sg_ * AT_BUF + AT_KBYTES + ii_ * 1024), 16, 0, 0); } \
        } while (0)
#define AT_MLOAD(j) do { if (MASKED) { mreg[0] = mrow[2 * (j)]; mreg[1] = mrow[2 * (j) + 1]; } } while (0)
#define AT_QKSM(jj) do { \
        const LAS unsigned char* kb = F.lds + ((jj) % AT_NSTG) * AT_BUF; \
        f32x16 s[2]; \
        _Pragma("unroll") for (int kb2 = 0; kb2 < 2; ++kb2) { \
            bf16x8 Kf[4]; \
            _Pragma("unroll") for (int ks = 0; ks < 4; ++ks) Kf[ks] = *(const LAS bf16x8*)(kb + (32 * kb2 + q) * 128 + (((2 * ks + h2) ^ swz) << 4)); \
            _Pragma("unroll") for (int r = 0; r < 16; ++r) s[kb2][r] = 0.f; \
            _Pragma("unroll") for (int ks = 0; ks < 4; ++ks) s[kb2] = MFMA32(Kf[ks], Qf[ks], s[kb2]); \
        } \
        const bool nearb = (64 * (jj) + 63 + 128 > tw0); \
        float mloc = NEG_INF; \
        if (!nearb) { \
            _Pragma("unroll") for (int kb2 = 0; kb2 < 2; ++kb2) _Pragma("unroll") for (int r = 0; r < 16; ++r) mloc = fmaxf(mloc, s[kb2][r]); \
            mloc = mloc * c1 + lut[96 + 128]; \
        } else { \
            const LAS float* lp = lut + (t - 64 * (jj) - 4 * h2 + 96 - 63); \
            _Pragma("unroll") for (int kb2 = 0; kb2 < 2; ++kb2) \
                _Pragma("unroll") for (int r = 0; r < 16; ++r) { const float v_ = s[kb2][r] * c1 + lp[63 - (32 * kb2 + crow_c(r))]; s[kb2][r] = v_; mloc = fmaxf(mloc, v_); } \
        } \
        mloc = fmaxf(mloc, __shfl_xor(mloc, 32)); \
        if (__any(mloc > m_run + AT_THR)) { \
            const float m_new = fmaxf(m_run, mloc); \
            const float alpha = __builtin_amdgcn_exp2f(m_run - m_new); \
            m_run = m_new; l_run *= alpha; \
            _Pragma("unroll") for (int d = 0; d < NDV; ++d) _Pragma("unroll") for (int r = 0; r < 16; ++r) O[d][r] *= alpha; \
        } \
        const float sub = lut[96 + 128] - m_run; \
        if (!nearb) { _Pragma("unroll") for (int kb2 = 0; kb2 < 2; ++kb2) _Pragma("unroll") for (int r = 0; r < 16; ++r) s[kb2][r] = __builtin_amdgcn_exp2f(s[kb2][r] * c1 + sub); } \
        else        { _Pragma("unroll") for (int kb2 = 0; kb2 < 2; ++kb2) _Pragma("unroll") for (int r = 0; r < 16; ++r) s[kb2][r] = __builtin_amdgcn_exp2f(s[kb2][r] - m_run); } \
        float psum0 = 0.f, psum1 = 0.f; \
        _Pragma("unroll") for (int kb2 = 0; kb2 < 2; ++kb2) { \
            const unsigned mw = mcur[kb2] >> (4 * h2); \
            _Pragma("unroll") for (int g = 0; g < 4; ++g) { \
                f32x4 mf = {1.f, 1.f, 1.f, 1.f}; \
                if (MASKED) mf = lutm[(mw >> (8 * g)) & 15u];                  \
                _Pragma("unroll") for (int e = 0; e < 4; ++e) { \
                    float p = s[kb2][4 * g + e]; \
                    if (MASKED) { p *= mf[e]; s[kb2][4 * g + e] = p; } \
                    if (e & 1) psum1 += p; else psum0 += p; \
                } \
            } \
        } \
        l_run += psum0 + psum1; \
        _Pragma("unroll") for (int st = 0; st < 4; ++st) { \
            u32x4 pw; \
            _Pragma("unroll") for (int e = 0; e < 4; ++e) pw[e] = pack_bf16(s[st >> 1][8 * (st & 1) + 2 * e], s[st >> 1][8 * (st & 1) + 2 * e + 1]); \
            Pf[st] = __builtin_bit_cast(bf16x8, pw); \
        } \
    } while (0)
#define AT_PV(jj) do { \
        const LAS unsigned char* vt = F.lds + ((jj) % AT_NSTG) * AT_BUF + AT_KBYTES + q * 128; \
        constexpr int NH = NDV / 2, NST = 4 * NH; \
        bf16x8 Av[2][2]; \
        _Pragma("unroll") for (int d = 0; d < 2; ++d) Av[0][d] = *(const LAS bf16x8*)(vt + (32 * d) * 128 + ((h2 ^ swz) << 4)); \
        _Pragma("unroll") for (int u = 0; u < NST; ++u) { \
            const int st = u / NH, dh = u % NH; \
            if (u + 1 < NST) { \
                const int st1 = (u + 1) / NH, dh1 = (u + 1) % NH; \
                _Pragma("unroll") for (int d = 0; d < 2; ++d) Av[(u + 1) & 1][d] = *(const LAS bf16x8*)(vt + (32 * (2 * dh1 + d)) * 128 + (((2 * st1 + h2) ^ swz) << 4)); \
            } \
            __builtin_amdgcn_s_setprio(1); \
            _Pragma("unroll") for (int d = 0; d < 2; ++d) O[2 * dh + d] = MFMA32(Av[u & 1][d], Pf[st], O[2 * dh + d]); \
            __builtin_amdgcn_s_setprio(0); \
            __builtin_amdgcn_sched_barrier(0); \
        } \
    } while (0)
#define AT_ACT(jj) (64 * (jj) <= tw0 + 31)
#define AT_WAITG() do { if (DV == 128) asm volatile("s_waitcnt vmcnt(3)" ::: "memory"); else asm volatile("s_waitcnt vmcnt(2)" ::: "memory"); } while (0)
    AT_DMA(0); AT_MLOAD(0);
    unsigned mcur[2] = {mreg[0], mreg[1]};
    if (jmax >= 1) AT_DMA(1);
    asm volatile("s_waitcnt vmcnt(0)" ::: "memory");
    __syncthreads();
    if (F.wave < 4) {
        for (int j = 0; j <= jmax; ++j) {
            if (j < jmax) AT_MLOAD(j + 1);
            if (j + 2 <= jmax) AT_DMA(j + 2);
            if (AT_ACT(j)) { AT_QKSM(j); AT_PV(j); }
            mcur[0] = mreg[0]; mcur[1] = mreg[1];
            if (j + 2 <= jmax) AT_WAITG(); else asm volatile("s_waitcnt vmcnt(0)" ::: "memory");
            asm volatile("s_waitcnt lgkmcnt(0)" ::: "memory"); __builtin_amdgcn_s_barrier(); asm volatile("" ::: "memory");
        }
    } else {
        for (int j = 0; j <= jmax; ++j) {
            if (j < jmax) AT_MLOAD(j + 1);
            if (j + 2 <= jmax) AT_DMA(j + 2);
            if (j > 0 && AT_ACT(j - 1)) AT_PV(j - 1);
            if (AT_ACT(j)) AT_QKSM(j);
            mcur[0] = mreg[0]; mcur[1] = mreg[1];
            if (j + 2 <= jmax) AT_WAITG(); else asm volatile("s_waitcnt vmcnt(0)" ::: "memory");
            asm volatile("s_waitcnt lgkmcnt(0)" ::: "memory"); __builtin_amdgcn_s_barrier(); asm volatile("" ::: "memory");
        }
        if (AT_ACT(jmax)) AT_PV(jmax);
    }
    __syncthreads();
#undef AT_WAITG
#undef AT_DMA
#undef AT_MLOAD
#undef AT_QKSM
#undef AT_PV
#undef AT_ACT
    const float lt = l_run + __shfl_xor(l_run, 32);
    const float inv = 1.0f / lt;
#pragma unroll
    for (int d = 0; d < NDV; ++d)
#pragma unroll
        for (int r = 0; r < 16; ++r) O[d][r] *= inv;
}

DI float rel_bucket_bias(const float* rel_bias, int d, int head) {
    int bkt;
    if (d < 16) bkt = d;
    else { const float lr = __logf((float)d * (1.0f / 16.0f)) / 2.0794415416798357f; int l = 16 + (int)(lr * 16.0f); bkt = l < 31 ? l : 31; }
    return rel_bias[bkt * 12 + head];
}
template <bool DPART>
DI void attn_phase(const Frame& F, const Args& a) {
    const bf16_t* Z = (const bf16_t*)(a.ws + WS_BIG);
    const bf16_t* Vtg = (const bf16_t*)(a.ws + WS_VT);
    bf16_t* Yo = (bf16_t*)(a.ws + WS_Y);
    float* O1s = (float*)(a.ws + WS_H);
    const unsigned* maskg = (const unsigned*)(a.ws + WS_MASK);
    LAS float* lut = (LAS float*)(F.lds + AT_LUT);
    if (F.tid < 16) ((LAS f32x4*)(F.lds + AT_LUTM))[F.tid] = (f32x4){(float)(F.tid & 1), (float)((F.tid >> 1) & 1), (float)((F.tid >> 2) & 1), (float)((F.tid >> 3) & 1)};
    for (int i = F.tid; i < 12 * AT_LUT_LD; i += NTHR) { const int hh = i / AT_LUT_LD, d = i % AT_LUT_LD - 96; lut[i] = d < 0 ? NEG_INF : rel_bucket_bias(a.rel_bias, d < 128 ? d : 128, hh) * LOG2E; }
    float lam;
    { float d01 = 0.f, d23 = 0.f; for (int i = 0; i < 64; ++i) { d01 += a.diff_lam[i] * a.diff_lam[64 + i]; d23 += a.diff_lam[128 + i] * a.diff_lam[192 + i]; }
      lam = __expf(d01) - __expf(d23) + 0.35550906759096f; lam = __uint_as_float(__builtin_amdgcn_readfirstlane(__float_as_uint(lam))); }
    const float one_m_li = 1.0f - 0.35550906759096f;
    __syncthreads();
    const float c1 = 0.125f * LOG2E;
    const int xcd = F.bid & 7, kk = F.bid >> 3;
    if (DPART)
    for (int it = F.bid; it < 256; it += F.G) {
        const int bh = (F.G == 256) ? 2 * xcd + (kk >> 4) : it >> 4, pr = (F.G == 256) ? (kk & 15) : (it & 15);
        const int b_ = bh >> 2, hd_ = bh & 3;
        for (int half = 0; half < 2; ++half) {
            Frame Fu = F; Fu.lane = fresh_lane();
            int b = b_, hd = hd_; asm volatile("" : "+s"(b), "+s"(hd));
            const int q0 = 256 * (half ? 31 - pr : pr);
            f32x16 O[4];
            attn_core<128, false>(Fu, Z, Vtg, b, Z_QD + 128 * hd, Z_KD + 128 * hd, VT_D + 128 * hd, q0, lut + (8 + hd) * AT_LUT_LD, c1, nullptr, O);
            {
                const int l1 = fresh_lane();
                float* o1p = O1s + (size_t)(b * SEQ + q0 + 32 * F.wave + (l1 & 31)) * 512 + 128 * hd + 4 * (l1 >> 5);
#pragma unroll
                for (int d = 0; d < 4; ++d)
#pragma unroll
                    for (int g = 0; g < 4; ++g) *(f32x4*)(o1p + 32 * d + 8 * g) = (f32x4){O[d][4 * g], O[d][4 * g + 1], O[d][4 * g + 2], O[d][4 * g + 3]};
            }
            Frame Fv = F; Fv.lane = fresh_lane();
            attn_core<128, false>(Fv, Z, Vtg, b, Z_QD + 128 * hd + 64, Z_KD + 128 * hd + 64, VT_D + 128 * hd, q0, lut + (8 + hd) * AT_LUT_LD, c1, nullptr, O);
            {
                const int l1 = fresh_lane();
                const int tq = q0 + 32 * F.wave + (l1 & 31), hh = l1 >> 5;
                const float* o1p = O1s + (size_t)(b * SEQ + tq) * 512 + 128 * hd + 4 * hh;
                float ss = 0.f;
#pragma unroll
                for (int d = 0; d < 4; ++d)
#pragma unroll
                    for (int g = 0; g < 4; ++g) {
                        const f32x4 o1 = *(const f32x4*)(o1p + 32 * d + 8 * g);
#pragma unroll
                        for (int e = 0; e < 4; ++e) { const float v = o1[e] - lam * O[d][4 * g + e]; O[d][4 * g + e] = v; ss += v * v; }
                    }
                ss += __shfl_xor(ss, 32);
                const float rinv = rsqrtf(ss * (1.0f / 128.0f) + EPS) * one_m_li;
                bf16_t* yp = Yo + (size_t)(b * SEQ + tq) * DM + 512 + 128 * hd + 4 * hh;
                const float* gp = a.diff_norm_g + 4 * hh;
#pragma unroll
                for (int d = 0; d < 4; ++d)
#pragma unroll
                    for (int g = 0; g < 4; ++g) {
                        const f32x4 gn = *(const f32x4*)(gp + 32 * d + 8 * g);
                        f32x4 v; v[0] = O[d][4 * g] * rinv * gn[0]; v[1] = O[d][4 * g + 1] * rinv * gn[1]; v[2] = O[d][4 * g + 2] * rinv * gn[2]; v[3] = O[d][4 * g + 3] * rinv * gn[3];
                        *(u32x2*)(yp + 32 * d + 8 * g) = pack4(v);
                    }
            }
        }
    }
    if (!DPART)
    for (int it = F.bid; it < 512; it += F.G) {
        const int rnd = it / F.G;
        const int bh = (F.G == 256) ? 4 * xcd + 2 * rnd + (kk >> 4) : it >> 4, pr = (F.G == 256) ? (kk & 15) : (it & 15);
        const int b_ = bh >> 3, hc_ = bh & 7;
        for (int half = 0; half < 2; ++half) {
            Frame Fu = F; Fu.lane = fresh_lane();
            int b = b_, hc = hc_; asm volatile("" : "+s"(b), "+s"(hc));
            const int q0 = 256 * (half ? 31 - pr : pr);
            f32x16 O[2];
            attn_core<64, true>(Fu, Z, Vtg, b, Z_QC + 64 * hc, Z_KC + 64 * hc, VT_C + 64 * hc, q0, lut + hc * AT_LUT_LD, c1, maskg, O);
            {
                const int l1 = fresh_lane();
                bf16_t* yp = Yo + (size_t)(b * SEQ + q0 + 32 * F.wave + (l1 & 31)) * DM + 64 * hc + 4 * (l1 >> 5);
#pragma unroll
                for (int d = 0; d < 2; ++d)
#pragma unroll
                    for (int g = 0; g < 4; ++g) {
                        f32x4 v = {O[d][4 * g], O[d][4 * g + 1], O[d][4 * g + 2], O[d][4 * g + 3]};
                        *(u32x2*)(yp + 32 * d + 8 * g) = pack4(v);
                    }
            }
        }
    }
}

#ifndef MK_ONE_LAUNCH
#define MK_ONE_LAUNCH 1
#endif
constexpr int NPH = 17;
__global__ void __launch_bounds__(NTHR, 2) fwd_kernel(Args a) {
    extern __shared__ __attribute__((aligned(16))) unsigned char lds_raw[];
    Frame F; F.lds = (LAS unsigned char*)lds_raw; F.tid = threadIdx.x; F.lane = F.tid & 63; F.wave = __builtin_amdgcn_readfirstlane(F.tid >> 6); F.G = gridDim.x; F.bid = blockIdx.x;
    unsigned* ctl = (unsigned*)(a.ws + WS_CTL);
    volatile LAS unsigned* xbw = (volatile LAS unsigned*)(F.lds + LDS_XB);
    if (F.tid < 4) xbw[F.tid] = 0u;
    __syncthreads();
    const int lo = a.ph_lo, hi = a.ph_hi;
    XcdBarrier bar; bar.bar = ctl + CW_BAR; bar.x = 0; bar.st = xbw;
    if (hi - lo > 1) bar = xcd_barrier_post(ctl + CW_BAR, xbw);
#ifndef PH_ONLY
#define IN(k) (lo <= (k) && (k) < hi)
#else
#define IN(k) ((k) == PH_ONLY && lo <= (k) && (k) < hi)
#endif
#ifndef DUP_PH
#define DUP_PH -1
#endif
#define REP(k) for (int rep_ = 0; rep_ < ((k) == DUP_PH ? 2 : 1); ++rep_)
#ifndef TIME_PH
#define TIME_PH -1
#endif
#define TIME_AMP 4
    unsigned long long tp0_ = 0, tp1_ = 0;
    if (TIME_PH == 0) tp0_ = wall_clock64();
#define SEAM(k) do { if (IN(k) && IN((k) + 1)) xcd_barrier(bar); if ((k) == TIME_PH) tp1_ = wall_clock64(); if ((k) + 1 == TIME_PH) tp0_ = wall_clock64(); } while (0)
    float* mod = (float*)(a.ws + WS_MOD);
    bf16_t* hbuf = (bf16_t*)(a.ws + WS_H);
    bf16_t* ybuf = (bf16_t*)(a.ws + WS_Y);
    LAS int* ntp = (LAS int*)(F.lds + LDS_MISC);

    if (IN(0)) REP(0) { p0_prologue(F, a); } SEAM(0);
    if (IN(1)) REP(1) { norm_phase<false, false, false>(F, a, a.x, 0, 0, 0); } SEAM(1);
    if (IN(2)) REP(2) {
        DenseSched S; S.init(NTOK, AB_N, DM, F.G, F.bid, a.ws + WS_WAB_IN);
        EpiAbIn E{(bf16_t*)(a.ws + WS_BIG)};
        pg8::gemm_phase(F.lds, (const char*)hbuf, DM, S, E);
    } SEAM(2);
    if (IN(3)) REP(3) { conv_phase(F, a); } SEAM(3);
    if (IN(4)) REP(4) {
        DenseSched S; S.init(NTOK, DM, DM, F.G, F.bid, a.ws + WS_WAB_OUT);
        EpiResid E{a.x, a.out, mod + 2 * DM};
        pg8::gemm_phase(F.lds, (const char*)ybuf, DM, S, E);
    } SEAM(4);
#define MOE_PHASES(layer, pb) do { \
        const unsigned* cnt = ctl + CW_CNT + (layer) * NEXP * CNT_STRIDE; \
        if (IN(pb)) { route_phase(F, a, (layer)); } SEAM(pb); \
        if (IN((pb) + 1)) REP((pb) + 1) { \
            moe_tile_table(F, cnt, ntp); \
            MoeSched<true> S; S.ntp = ntp; S.cnt = cnt; S.list = (const int*)(a.ws + WS_LIST); S.W = (const char*)(a.ws + WS_MOE_W); S.nU = 4 * ntp[NEXP]; S.G = F.G; S.c = F.bid; \
            EpiMoeUp E{(bf16_t*)(a.ws + WS_ACT)}; \
            pg8::gemm_phase(F.lds, (const char*)hbuf, DM, S, E); \
        } SEAM((pb) + 1); \
        if (IN((pb) + 2)) REP((pb) + 2) { \
            moe_tile_table(F, cnt, ntp); \
            MoeSched<false> S; S.ntp = ntp; S.cnt = cnt; S.list = nullptr; S.W = (const char*)(a.ws + WS_MOE_W); S.nU = 4 * ntp[NEXP]; S.G = F.G; S.c = F.bid; \
            EpiMoeDown E{(bf16_t*)(a.ws + WS_YMOE), (const float*)(a.ws + WS_GATEV), ntp}; \
            pg8::gemm_phase(F.lds, (const char*)(a.ws + WS_ACT), DEXP, S, E); \
        } SEAM((pb) + 2); } while (0)
    MOE_PHASES(0, 5);
    if (IN(8)) {
        norm_phase<true, false, false>(F, a, a.out, 1, 0, 0);
        cvt_run(F, a, 1, CVT_MOE_TILES);
    } SEAM(8);
    if (IN(9)) REP(9) {
        { DenseSched S; S.init(NTOK, CD_N, DM, F.G, F.bid, a.ws + WS_WCD_IN);
          EpiPlain E{(bf16_t*)(a.ws + WS_BIG), CD_N};
          pg8::gemm_phase(F.lds, (const char*)hbuf, DM, S, E); }
        __syncthreads();
        { DenseSched S; S.init(1024, NTOK, DM, F.G, F.bid, hbuf);
          EpiVt E{(bf16_t*)(a.ws + WS_VT)};
          pg8::gemm_phase(F.lds, (const char*)(a.ws + WS_WCD_IN + (size_t)CD_N * DM * 2), DM, S, E); }
    } SEAM(9);
    if (IN(10)) REP(10) { unsigned long long tacc_ = 0; topk_phase(F, a, tacc_); if (TIME_PH > 100 && TIME_PH < 110) { tp0_ = 0; tp1_ = tacc_; } } SEAM(10);
    if (IN(11)) REP(11) { if (TIME_PH == 111) { __syncthreads(); tp0_ = wall_clock64(); } attn_phase<true>(F, a); __syncthreads(); if (TIME_PH == 111) tp1_ = wall_clock64(); if (TIME_PH == 112) tp0_ = wall_clock64(); attn_phase<false>(F, a); if (TIME_PH == 112) { __syncthreads(); tp1_ = wall_clock64(); } } SEAM(11);
    if (IN(12)) {
        DenseSched S; S.init(NTOK, DM, DM, F.G, F.bid, a.ws + WS_WCD_OUT);
        EpiResid E{a.out, a.out, mod + (size_t)NB * 6 * DM + 2 * DM};
        pg8::gemm_phase(F.lds, (const char*)ybuf, DM, S, E);
    } SEAM(12);
    MOE_PHASES(1, 13);
#undef MOE_PHASES
    if (IN(16)) { norm_phase<true, false, true>(F, a, a.out, 1, 0, 1); }
    if (TIME_PH >= 0) {
        if (TIME_PH == 16) { asm volatile("s_waitcnt vmcnt(0)" ::: "memory"); __syncthreads(); tp1_ = wall_clock64(); }
        if (F.bid == 0 && F.tid == 0) { const unsigned long long te = wall_clock64(), dt = (tp1_ - tp0_) * TIME_AMP; while (wall_clock64() - te < dt) __builtin_amdgcn_s_sleep(8); }
    }
#undef IN
#undef SEAM
}

extern "C" void kernel_launch(void* const* d_in, const int* in_sizes, int n_in, void* d_out, int out_size, void* d_ws, size_t ws_size, hipStream_t stream) {
    static int grid = 0;
    if (grid == 0) {
        if (n_in != 26 || out_size != NTOK * DM || ws_size < WS_END) { fprintf(stderr, "kernel_launch: unexpected problem (n_in %d, out %d, ws %zu < %zu)\n", n_in, out_size, ws_size, (size_t)WS_END); grid = -1; return; }
        int dev = 0, cus = 0, per_cu = 0;
        if (hipGetDevice(&dev) != hipSuccess || hipDeviceGetAttribute(&cus, hipDeviceAttributeMultiprocessorCount, dev) != hipSuccess) { grid = -1; return; }
        if (hipFuncSetAttribute((const void*)fwd_kernel, hipFuncAttributeMaxDynamicSharedMemorySize, LDS_BYTES) != hipSuccess) { fprintf(stderr, "kernel_launch: hipFuncSetAttribute failed\n"); grid = -1; return; }
        if (hipOccupancyMaxActiveBlocksPerMultiprocessor(&per_cu, (const void*)fwd_kernel, NTHR, LDS_BYTES) != hipSuccess || per_cu < 1) { fprintf(stderr, "kernel_launch: occupancy query says %d\n", per_cu); }
        (void)hipGetLastError();
        grid = cus;
    }
    if (grid < 0) return;
    (void)hipMemsetAsync((char*)d_ws + WS_CTL, 0, CTL_BYTES, stream);
    Args a{};
    const float** fp = (const float**)&a.x;
    (void)fp;
    a.x = (const float*)d_in[0]; a.c = (const float*)d_in[1]; a.positions = (const int*)d_in[2]; a.rel_bias = (const float*)d_in[3]; a.norm_g = (const float*)d_in[4];
    a.final_norm_g = (const float*)d_in[5]; a.ada_w = (const float*)d_in[6]; a.ada_b = (const float*)d_in[7]; a.ab_w_in = (const float*)d_in[8]; a.ab_conv_a = (const float*)d_in[9];
    a.ab_conv_b = (const float*)d_in[10]; a.ab_conv_b_bias = (const float*)d_in[11]; a.ab_ln_g = (const float*)d_in[12]; a.ab_ln_b = (const float*)d_in[13]; a.ab_w_out = (const float*)d_in[14];
    a.cd_w_in = (const float*)d_in[15]; a.diff_lam = (const float*)d_in[16]; a.diff_norm_g = (const float*)d_in[17]; a.cd_w_out = (const float*)d_in[18];
    a.moe_wr_g = (const float*)d_in[19]; a.moe_br_g = (const float*)d_in[20]; a.moe_wr_e = (const float*)d_in[21]; a.moe_br_e = (const float*)d_in[22];
    a.moe_w_gate = (const float*)d_in[23]; a.moe_w_up = (const float*)d_in[24]; a.moe_w_down = (const float*)d_in[25];
    a.out = (float*)d_out; a.ws = (unsigned char*)d_ws;
#if MK_ONE_LAUNCH
    a.ph_lo = 0; a.ph_hi = NPH;
    hipLaunchKernelGGL(fwd_kernel, dim3(grid), dim3(NTHR), LDS_BYTES, stream, a);
#else
    for (int p = 0; p < NPH; ++p) { a.ph_lo = p; a.ph_hi = p + 1; hipLaunchKernelGGL(fwd_kernel, dim3(grid), dim3(NTHR), LDS_BYTES, stream, a); }
#endif
}
```

```cpp
#include <hip/hip_runtime.h>
#include <cstdio>
#include <cstdint>

#ifndef TIME_PH
#define TIME_PH -1
#endif
#define LAS __attribute__((address_space(3)))
#define DI __device__ __forceinline__
typedef unsigned short bf16_t;
typedef short bf16x8 __attribute__((ext_vector_type(8)));
typedef short s16x4 __attribute__((ext_vector_type(4)));
typedef float f32x2 __attribute__((ext_vector_type(2)));
typedef float f32x4 __attribute__((ext_vector_type(4)));
typedef float f32x16 __attribute__((ext_vector_type(16)));
typedef unsigned u32x2 __attribute__((ext_vector_type(2)));
typedef unsigned u32x4 __attribute__((ext_vector_type(4)));
typedef __bf16 bf16v2 __attribute__((ext_vector_type(2)));

constexpr int NB = 4, SEQ = 8192, DM = 1024, NTOK = NB * SEQ;
constexpr int NTHR = 512, NWAVE = 8;
constexpr int AB_N = 2560;
constexpr int ZC_N = 1536;
constexpr int CD_SRC_N = 3368;
constexpr int CD_N = 3072;
constexpr int Z_QC = 0, Z_KC = 512, Z_QD = 1024, Z_KD = 1536, Z_QI = 2048, Z_KI = 2304, Z_WI = 2336, Z_VC = 2560;
constexpr int VT_D = 0, VT_ROWS = 512;
constexpr int NEXP = 32, DEXP = 512;
constexpr int MOE_ROWS = 2 * NTOK + NEXP * 256;
constexpr float EPS = 1e-6f;
constexpr float LOG2E = 1.4426950408889634f;

constexpr size_t MiB = 1u << 20;
constexpr size_t WS_CTL = 0, CTL_BYTES = 64 * 1024;
constexpr size_t WS_MOD = 1 * MiB;
constexpr size_t WS_WAB_IN = 2 * MiB;
constexpr size_t WS_WAB_OUT = 7 * MiB;
constexpr size_t WS_WCD_IN = 9 * MiB;
constexpr size_t WS_WCD_OUT = 16 * MiB;
constexpr size_t WS_MOE_W = 18 * MiB;
constexpr size_t WS_H = 114 * MiB;
constexpr size_t WS_Y = 178 * MiB;
constexpr size_t WS_BIG = 242 * MiB;
constexpr size_t WS_ACT = WS_BIG;
constexpr size_t WS_YMOE = WS_BIG + 72 * MiB;
constexpr size_t WS_VT = WS_BIG + 192 * MiB;
constexpr size_t WS_MASK = 466 * MiB;
constexpr size_t WS_LIST = 498 * MiB;
constexpr size_t WS_GATEV = 502 * MiB;
constexpr size_t WS_TOKSLOT = 506 * MiB;
constexpr size_t WS_END = 507 * MiB;

constexpr int CW_BAR = 0;
constexpr int CW_CNT = 4096;
constexpr int CNT_STRIDE = 64;

DI unsigned pack_bf16(float lo, float hi) { f32x2 v = {lo, hi}; bf16v2 b = __builtin_convertvector(v, bf16v2); return __builtin_bit_cast(unsigned, b); }
DI float bf_lo(unsigned w) { return __uint_as_float(w << 16); }
DI float bf_hi(unsigned w) { return __uint_as_float(w & 0xffff0000u); }
DI float bf2f(bf16_t b) { return __uint_as_float(((unsigned)b) << 16); }
DI float wave_sum(float v) {
#pragma unroll
    for (int o = 32; o >= 1; o >>= 1) v += __shfl_xor(v, o);
    return v;
}
DI int fresh_lane() { int l; asm volatile("v_mbcnt_lo_u32_b32 %0, -1, 0\n\tv_mbcnt_hi_u32_b32 %0, -1, %0" : "=v"(l)); return l; }
DI float silu_f(float v) { return v / (1.0f + __expf(-v)); }
DI float sigmoid_f(float v) { return 1.0f / (1.0f + __expf(-v)); }

#define XB_TMO      128
#define XB_XCNT(j)  (256  + 64 * (j))
#define XB_XSUB(j)  (1280 + 64 * (j))
#define XB_XGEN(j)  (2304 + 64 * (j))
#define XB_TOP      3328
#define XB_TOPGEN   3392
#define XCD_BAR_WORDS 3456
#define XB_SPIN_CAP (1u << 22)
DI unsigned xb_ld(unsigned* p)              { return __hip_atomic_load(p, __ATOMIC_RELAXED, __HIP_MEMORY_SCOPE_AGENT); }
DI unsigned xb_add(unsigned* p, unsigned v) { return __hip_atomic_fetch_add(p, v, __ATOMIC_RELAXED, __HIP_MEMORY_SCOPE_AGENT); }
DI unsigned xb_xcc_id() { return (unsigned)__builtin_amdgcn_s_getreg((3 << 11) | 20) & 0xFu; }
#define XB_SPIN(cond, bar) do { unsigned _sp = 0; while (cond) { __builtin_amdgcn_s_sleep(1); \
    if ((++_sp & 255u) == 0u) { if (xb_ld(&(bar)[XB_TMO])) break; if (_sp > XB_SPIN_CAP) { atomicAdd(&(bar)[XB_TMO], 1u); break; } } } } while (0)
struct XcdBarrier { unsigned* bar; unsigned x; volatile LAS unsigned* st; };
DI XcdBarrier xcd_barrier_post(unsigned* bar, volatile LAS unsigned* st) {
    XcdBarrier b; b.bar = bar; b.x = xb_xcc_id(); b.st = st;
    if (threadIdx.x == 0) (void)xb_add(&bar[XB_XCNT(b.x)], 1u);
    return b;
}
DI void xcd_barrier_complete(unsigned* bar, unsigned x, unsigned& nloc, unsigned& nx) {
    const unsigned G = gridDim.x * gridDim.y * gridDim.z;
    unsigned sum, cnt, mine, sp = 0u;
    for (;;) {
        sum = 0u; cnt = 0u; mine = 0u;
#pragma unroll
        for (unsigned j = 0; j < 16; ++j) { const unsigned c = xb_ld(&bar[XB_XCNT(j)]); sum += c; cnt += (c > 0u) ? 1u : 0u; mine = (j == x) ? c : mine; }
        if (sum == G) break;
        __builtin_amdgcn_s_sleep(1);
        if ((++sp & 255u) == 0u) { if (xb_ld(&bar[XB_TMO])) break; if (sp > XB_SPIN_CAP) { atomicAdd(&bar[XB_TMO], 1u); break; } }
    }
    nloc = mine > 0u ? mine : 1u; nx = cnt > 0u ? cnt : 1u;
}
DI void xcd_barrier(const XcdBarrier& b) {
    asm volatile("s_waitcnt vmcnt(0)" ::: "memory");
    __syncthreads();
    if (threadIdx.x == 0) {
        unsigned* bar = b.bar;
        __builtin_amdgcn_s_waitcnt(0);
        unsigned nloc = b.st[0], nx = b.st[1];
        if (nloc == 0u) { xcd_barrier_complete(bar, b.x, nloc, nx); b.st[0] = nloc; b.st[1] = nx; }
        const unsigned old = xb_add(&bar[XB_XSUB(b.x)], 1u);
        const unsigned gen = old / nloc;
        if (old + 1u == (gen + 1u) * nloc) {
            __builtin_amdgcn_fence(__ATOMIC_RELEASE, "agent");
            asm volatile("s_waitcnt vmcnt(0)" ::: "memory");
            const unsigned og = xb_add(&bar[XB_TOP], 1u);
            const unsigned tg = og / nx;
            if (og + 1u == (tg + 1u) * nx) xb_add(&bar[XB_TOPGEN], 1u);
            else XB_SPIN(xb_ld(&bar[XB_TOPGEN]) == tg, bar);
            __builtin_amdgcn_fence(__ATOMIC_ACQUIRE, "agent");
            xb_add(&bar[XB_XGEN(b.x)], 1u);
            asm volatile("s_waitcnt vmcnt(0)" ::: "memory");
        } else {
            XB_SPIN(xb_ld(&bar[XB_XGEN(b.x)]) == gen, bar);
            __builtin_amdgcn_fence(__ATOMIC_ACQUIRE, "agent");
            asm volatile("s_waitcnt vmcnt(0)" ::: "memory");
        }
    }
    __syncthreads();
}

namespace pg8 {
constexpr int BM = 256, BK = 64, HALF = 128, HTB = HALF * BK * 2, STAGE_BYTES = 8 * HTB;
DI int lds_byte(int r, int c) { const int st = (r >> 4) * 2 + (c >> 5), rr = r & 15, cc = c & 31, ob = rr * 64 + cc * 2; return st * 1024 + (ob ^ (((ob >> 9) & 1) << 5)); }
DI void stage_rc(int b, int& R, int& C) { const int st = b / 1024, sb = b % 1024, swz = sb ^ (((sb >> 9) & 1) << 5); R = (st >> 1) * 16 + swz / 64; C = (st & 1) * 32 + (swz % 64) / 2; }
struct Unit { int pm, pn, e, nrow; };

template <class Epi, class Sched>
DI void gemm_phase(LAS unsigned char* lds, const char* Abase, const int K, const Sched& S, const Epi& E) {
    const int tid = threadIdx.x, wid = __builtin_amdgcn_readfirstlane(tid >> 6), lane = tid & 63, wr = wid >> 2, wc = wid & 3, fr = lane & 15, fq = lane >> 4;
    const int nt = K / BK;
    int Rr[2], Cc[2]; unsigned voffB[2];
#pragma unroll
    for (int i = 0; i < 2; ++i) { int R, C; stage_rc(tid * 16 + i * 8192, R, C); Rr[i] = R; Cc[i] = C; voffB[i] = (unsigned)(R * K + C) * 2u; }
    const size_t kstep = (size_t)(BK * 2);
    const size_t hstep = (size_t)HALF * K * 2;
    const unsigned ldsw = (unsigned)wid * 1024u;
    const int aoff = lds_byte(wr * 64 + fr, fq * 8), boff = lds_byte(wc * 32 + fr, fq * 8);
#define PG8_SA(b, h) (((b) * 2 + (h)) * HTB)
#define PG8_SB(b, h) ((4 + (b) * 2 + (h)) * HTB)
#define PG8_STAGE(bufoff, gbase, voff) do { _Pragma("unroll") for (int _i = 0; _i < 2; ++_i) \
        __builtin_amdgcn_global_load_lds((const unsigned*)((const char*)(gbase) + (voff)[_i]), (LAS unsigned*)(lds + (bufoff) + ldsw + _i * 8192), 16, 0, 0); } while (0)
#define PG8_AOFF(dst, u) do { _Pragma("unroll") for (int _h = 0; _h < 2; ++_h) _Pragma("unroll") for (int _i = 0; _i < 2; ++_i) \
        dst[_h][_i] = ((unsigned)S.a_row(u, _h * HALF + Rr[_i]) * (unsigned)K + (unsigned)Cc[_i]) * 2u; } while (0)
#define PG8_LDA(dst, b, h) do { _Pragma("unroll") for (int m = 0; m < 4; ++m) _Pragma("unroll") for (int k = 0; k < 2; ++k) dst[m][k] = *(const LAS bf16x8*)(lds + PG8_SA(b, h) + aoff + m * 2048 + k * 1024); } while (0)
#define PG8_LDB(dst, b, h) do { _Pragma("unroll") for (int n = 0; n < 2; ++n) _Pragma("unroll") for (int k = 0; k < 2; ++k) dst[n][k] = *(const LAS bf16x8*)(lds + PG8_SB(b, h) + boff + n * 2048 + k * 1024); } while (0)
#define PG8_MMA(ai, bj, At, Bt) do { __builtin_amdgcn_s_setprio(1); _Pragma("unroll") for (int m = 0; m < 4; ++m) _Pragma("unroll") for (int n = 0; n < 2; ++n) _Pragma("unroll") for (int k = 0; k < 2; ++k) \
        acc[ai][bj][m][n] = __builtin_amdgcn_mfma_f32_16x16x32_bf16(Bt[n][k], At[m][k], acc[ai][bj][m][n], 0, 0, 0); __builtin_amdgcn_s_setprio(0); } while (0)
#define PG8_WAIT_V(n) asm volatile("s_waitcnt vmcnt(" #n ")" ::: "memory")
#define PG8_WAIT_L(n) asm volatile("s_waitcnt lgkmcnt(" #n ")" ::: "memory")
#define PG8_BAR __builtin_amdgcn_s_barrier()
#define PG8_SCHED __builtin_amdgcn_sched_barrier(0)
    Unit cur, nxt; int ui = 0;
    if (!S.next(0, cur)) return;
    f32x4 acc[2][2][4][2];
#pragma unroll
    for (int a = 0; a < 2; ++a)
#pragma unroll
        for (int b = 0; b < 2; ++b)
#pragma unroll
            for (int m = 0; m < 4; ++m)
#pragma unroll
                for (int n = 0; n < 2; ++n) acc[a][b][m][n] = (f32x4){0.f, 0.f, 0.f, 0.f};
    bf16x8 At[4][2], B0[2][2], B1[2][2];
    unsigned aoC[2][2], aoN[2][2];
    PG8_AOFF(aoC, cur);
    const char* cB = S.b_base(cur);
    PG8_STAGE(PG8_SB(0, 0), cB, voffB); PG8_STAGE(PG8_SA(0, 0), Abase, aoC[0]); PG8_STAGE(PG8_SB(0, 1), cB + hstep, voffB); PG8_STAGE(PG8_SA(0, 1), Abase, aoC[1]);
    if (wr == 1) PG8_BAR;
    PG8_WAIT_V(4); PG8_BAR;
    PG8_STAGE(PG8_SB(1, 0), cB + kstep, voffB); PG8_STAGE(PG8_SA(1, 0), Abase + kstep, aoC[0]); PG8_STAGE(PG8_SB(1, 1), cB + hstep + kstep, voffB);
    PG8_WAIT_V(6); PG8_BAR;
    for (;;) {
        const bool has_next = S.next(ui + 1, nxt);
        const char* nB = cB;
#pragma unroll
        for (int _h = 0; _h < 2; ++_h)
#pragma unroll
            for (int _i = 0; _i < 2; ++_i) aoN[_h][_i] = aoC[_h][_i];
        if (has_next) { PG8_AOFF(aoN, nxt); nB = S.b_base(nxt); }
        for (int t = 0; t < nt; t += 2) {
            const bool last = (t == nt - 2);
            const char* a1 = Abase + (size_t)(t + 1) * kstep;
            const char* a2 = last ? Abase : Abase + (size_t)(t + 2) * kstep; const char* b2 = last ? nB : cB + (size_t)(t + 2) * kstep;
            const char* a3 = a2 + kstep; const char* b3 = b2 + kstep;
            unsigned ao2[2][2];
#pragma unroll
            for (int _h = 0; _h < 2; ++_h)
#pragma unroll
                for (int _i = 0; _i < 2; ++_i) ao2[_h][_i] = last ? aoN[_h][_i] : aoC[_h][_i];
            PG8_LDB(B0, 0, 0); PG8_SCHED; PG8_LDA(At, 0, 0); PG8_STAGE(PG8_SA(1, 1), a1, aoC[1]);
            PG8_WAIT_L(8); PG8_BAR; PG8_WAIT_L(0); PG8_MMA(0, 0, At, B0); PG8_BAR; PG8_SCHED;
            PG8_LDB(B1, 0, 1); PG8_STAGE(PG8_SB(0, 0), b2, voffB);
            PG8_BAR; PG8_WAIT_L(0); PG8_MMA(0, 1, At, B1); PG8_BAR;
            PG8_LDA(At, 0, 1); PG8_STAGE(PG8_SA(0, 0), a2, ao2[0]);
            PG8_BAR; PG8_WAIT_L(0); PG8_MMA(1, 0, At, B0); PG8_BAR; PG8_SCHED;
            PG8_STAGE(PG8_SB(0, 1), b2 + hstep, voffB);
            PG8_WAIT_V(6); PG8_BAR; PG8_MMA(1, 1, At, B1); PG8_BAR;
            PG8_LDB(B0, 1, 0); PG8_SCHED; PG8_LDA(At, 1, 0); PG8_STAGE(PG8_SA(0, 1), a2, ao2[1]);
            PG8_WAIT_L(8); PG8_BAR; PG8_WAIT_L(0); PG8_MMA(0, 0, At, B0); PG8_BAR; PG8_SCHED;
            PG8_LDB(B1, 1, 1); PG8_STAGE(PG8_SB(1, 0), b3, voffB);
            PG8_BAR; PG8_WAIT_L(0); PG8_MMA(0, 1, At, B1); PG8_BAR;
            PG8_LDA(At, 1, 1); PG8_STAGE(PG8_SA(1, 0), a3, ao2[0]);
            PG8_BAR; PG8_WAIT_L(0); PG8_MMA(1, 0, At, B0); PG8_BAR; PG8_SCHED;
            PG8_STAGE(PG8_SB(1, 1), b3 + hstep, voffB);
            PG8_WAIT_V(6); PG8_BAR; PG8_MMA(1, 1, At, B1); PG8_BAR;
        }
        E(acc, cur, wr, wc, fr, fq);
        if (!has_next) break;
#pragma unroll
        for (int a = 0; a < 2; ++a)
#pragma unroll
            for (int b = 0; b < 2; ++b)
#pragma unroll
                for (int m = 0; m < 4; ++m)
#pragma unroll
                    for (int n = 0; n < 2; ++n) acc[a][b][m][n] = (f32x4){0.f, 0.f, 0.f, 0.f};
        cur = nxt; cB = nB; ++ui;
#pragma unroll
        for (int _h = 0; _h < 2; ++_h)
#pragma unroll
            for (int _i = 0; _i < 2; ++_i) aoC[_h][_i] = aoN[_h][_i];
    }
    PG8_WAIT_V(0);
    if (wr == 0) PG8_BAR;
    PG8_BAR;
#undef PG8_SA
#undef PG8_SB
#undef PG8_STAGE
#undef PG8_AOFF
#undef PG8_LDA
#undef PG8_LDB
#undef PG8_MMA
#undef PG8_WAIT_V
#undef PG8_WAIT_L
#undef PG8_BAR
#undef PG8_SCHED
}
}

struct Args {
    const float* x; const float* c; const int* positions; const float* rel_bias; const float* norm_g; const float* final_norm_g;
    const float* ada_w; const float* ada_b; const float* ab_w_in; const float* ab_conv_a; const float* ab_conv_b; const float* ab_conv_b_bias;
    const float* ab_ln_g; const float* ab_ln_b; const float* ab_w_out; const float* cd_w_in; const float* diff_lam; const float* diff_norm_g;
    const float* cd_w_out; const float* moe_wr_g; const float* moe_br_g; const float* moe_wr_e; const float* moe_br_e;
    const float* moe_w_gate; const float* moe_w_up; const float* moe_w_down;
    float* out; unsigned char* ws; int ph_lo, ph_hi;
};
struct Frame {
    LAS unsigned char* lds; int tid, lane, wave, G, bid;
};

struct RowSrc { const float* p; int ld; };
DI int perm32(int rho) { const int n = rho >> 4, i = rho & 15; return 8 * (i >> 2) + 4 * n + (i & 3); }
DI int permrow(int r) { return (r & ~31) + perm32(r & 31); }
DI void ilv(int rp, int& j, int& second) { const int U = rp >> 8, ru = rp & 255, bj = ru >> 7, wc = (ru >> 5) & 3, n = (ru >> 4) & 1, fq = (ru >> 2) & 3, e = ru & 3; j = 128 * U + 32 * wc + 8 * fq + 4 * bj + e; second = n; }

enum { CV_AB_IN = 0, CV_AB_OUT = 1, CV_CD_IN = 2, CV_CD_OUT = 3, CV_MOE_GU = 4, CV_MOE_D = 5 };
template <int KIND> DI RowSrc row_src(const Args& a, int layer, int e, int r) {
    RowSrc s; s.p = nullptr; s.ld = 0;
    if (KIND == CV_AB_IN) {
        s.ld = AB_N;
        if (r < 512) s.p = a.ab_w_in + permrow(r);
        else if (r < 1536) { int j, sec; ilv(r - 512, j, sec); s.p = a.ab_w_in + (sec ? 1024 + j : 512 + j); }
        else { int j, sec; ilv(r - 1536, j, sec); s.p = a.ab_w_in + (sec ? 2048 + j : 1536 + j); }
    } else if (KIND == CV_AB_OUT) { s.ld = DM; s.p = a.ab_w_out + r; }
    else if (KIND == CV_CD_IN) {
        s.ld = CD_SRC_N;
        int col = -1;
        if (r < CD_N) r = permrow(r);
        if (r < 1024) col = r;
        else if (r < 2048) col = 1832 + (r - 1024);
        else if (r < 2304) col = 1536 + (r - 2048);
        else if (r < 2336) col = 1792 + (r - 2304);
        else if (r < 2344) col = 1824 + (r - 2336);
        else if (r < 2560) col = -1;
        else if (r < 3072) col = 1024 + (r - 2560);
        else col = 2856 + (r - 3072);
        if (col >= 0) s.p = a.cd_w_in + col;
    } else if (KIND == CV_CD_OUT) { s.ld = DM; s.p = a.cd_w_out + r; }
    else if (KIND == CV_MOE_GU) {
        int j, sec; ilv(r, j, sec); s.ld = DEXP;
        const size_t base = ((size_t)layer * NEXP + e) * (size_t)DM * DEXP;
        s.p = (sec ? a.moe_w_up : a.moe_w_gate) + base + j;
    } else {
        s.ld = DM; s.p = a.moe_w_down + ((size_t)layer * NEXP + e) * (size_t)DEXP * DM + permrow(r);
    }
    return s;
}
constexpr int CV_LD = 258;
struct CvtTile { const float* sp; int ld; bf16_t* dst; int K, r0, k0; };
template <int KIND> DI CvtTile cvt_desc(const Frame& F, const Args& a, bf16_t* dst, int K, int r0, int k0, int layer, int e) {
    const RowSrc s = row_src<KIND>(a, layer, e, r0 + 4 * (F.tid & 15));
    CvtTile t; t.sp = s.p; t.ld = s.ld; t.dst = dst; t.K = K; t.r0 = r0; t.k0 = k0; return t;
}
constexpr int CVT_DENSE_TILES = (AB_N + DM + CD_N + VT_ROWS + DM) / 64 * (DM / 256);
constexpr int CVT_MOE_TILES_PER_EXP = (1024 / 64) * (1024 / 256) + (1024 / 64) * (512 / 256);
constexpr int CVT_MOE_TILES = NEXP * CVT_MOE_TILES_PER_EXP;
DI CvtTile cvt_dense_desc(const Frame& F, const Args& a, int item) {
    const int rt = item >> 2, kt = item & 3;
    int r = rt * 64;
    if (r < AB_N) return cvt_desc<CV_AB_IN>(F, a, (bf16_t*)(a.ws + WS_WAB_IN), DM, r, kt * 256, 0, 0);
    r -= AB_N;
    if (r < DM) return cvt_desc<CV_AB_OUT>(F, a, (bf16_t*)(a.ws + WS_WAB_OUT), DM, r, kt * 256, 0, 0);
    r -= DM;
    if (r < CD_N + VT_ROWS) return cvt_desc<CV_CD_IN>(F, a, (bf16_t*)(a.ws + WS_WCD_IN), DM, r, kt * 256, 0, 0);
    r -= CD_N + VT_ROWS;
    return cvt_desc<CV_CD_OUT>(F, a, (bf16_t*)(a.ws + WS_WCD_OUT), DM, r, kt * 256, 0, 0);
}
DI CvtTile cvt_moe_desc(const Frame& F, const Args& a, int layer, int item) {
    const int e = item / CVT_MOE_TILES_PER_EXP, t = item % CVT_MOE_TILES_PER_EXP;
    bf16_t* base = (bf16_t*)(a.ws + WS_MOE_W + (size_t)e * 3 * MiB);
    if (t < 64) return cvt_desc<CV_MOE_GU>(F, a, base, DM, (t >> 2) * 64, (t & 3) * 256, layer, e);
    const int t2 = t - 64; return cvt_desc<CV_MOE_D>(F, a, base + (size_t)DM * DM, DEXP, (t2 >> 1) * 64, (t2 & 1) * 256, layer, e);
}
DI void cvt_load(const Frame& F, const CvtTile& t, f32x4 (&v)[8]) {
#pragma unroll
    for (int it = 0; it < 8; ++it) {
        const int kk = (F.tid >> 4) + 32 * it;
        v[it] = (f32x4){0.f, 0.f, 0.f, 0.f};
        if (t.sp) v[it] = *(const f32x4*)(t.sp + (size_t)(t.k0 + kk) * t.ld);
    }
}
DI void cvt_store(const Frame& F, const CvtTile& t, const f32x4 (&v)[8]) {
    LAS bf16_t* T = (LAS bf16_t*)F.lds;
    const int c4 = F.tid & 15;
#pragma unroll
    for (int it = 0; it < 8; ++it) {
        const int kk = (F.tid >> 4) + 32 * it;
        const unsigned p01 = pack_bf16(v[it][0], v[it][1]), p23 = pack_bf16(v[it][2], v[it][3]);
        T[(4 * c4 + 0) * CV_LD + kk] = (bf16_t)(p01 & 0xffffu); T[(4 * c4 + 1) * CV_LD + kk] = (bf16_t)(p01 >> 16);
        T[(4 * c4 + 2) * CV_LD + kk] = (bf16_t)(p23 & 0xffffu); T[(4 * c4 + 3) * CV_LD + kk] = (bf16_t)(p23 >> 16);
    }
    __syncthreads();
    {
        const int rr = F.tid >> 3, c = F.tid & 7;
#pragma unroll
        for (int j = 0; j < 4; ++j) {
            const LAS unsigned* src = (const LAS unsigned*)(T + rr * CV_LD + 64 * j + c * 8);
            u32x4 w; w[0] = src[0]; w[1] = src[1]; w[2] = src[2]; w[3] = src[3];
            *(u32x4*)(t.dst + (size_t)(t.r0 + rr) * t.K + t.k0 + 64 * j + c * 8) = w;
        }
    }
    __syncthreads();
}
DI CvtTile cvt_any_desc(const Frame& F, const Args& a, int which, int item) {
    if (which == 0) { if (item < CVT_DENSE_TILES) return cvt_dense_desc(F, a, item); return cvt_moe_desc(F, a, 0, item - CVT_DENSE_TILES); }
    return cvt_moe_desc(F, a, 1, item);
}
DI void cvt_run(const Frame& F, const Args& a, int which, int n_items) {
    int it = F.bid;
    if (it >= n_items) return;
    CvtTile t0 = cvt_any_desc(F, a, which, it), t1 = t0, t2 = t0;
    f32x4 v0[8], v1[8], v2[8];
    cvt_load(F, t0, v0);
    bool h1 = it + F.G < n_items, h2 = it + 2 * F.G < n_items;
    if (h1) { t1 = cvt_any_desc(F, a, which, it + F.G); cvt_load(F, t1, v1); }
    for (;;) {
        h2 = it + 2 * F.G < n_items;
        if (h2) { t2 = cvt_any_desc(F, a, which, it + 2 * F.G); cvt_load(F, t2, v2); }
        cvt_store(F, t0, v0);
        if (!h1) break;
        it += F.G; t0 = t1; t1 = t2; h1 = h2;
#pragma unroll
        for (int i = 0; i < 8; ++i) { v0[i] = v1[i]; v1[i] = v2[i]; }
    }
}
DI void mod_item(const Frame& F, const Args& a, int item) {
    LAS float* sc = (LAS float*)F.lds;
    LAS float* part = (LAS float*)(F.lds + 16384);
    for (int i = F.tid; i < NB * DM; i += NTHR) sc[i] = silu_f(a.c[i]);
    __syncthreads();
    const int l = item / 96, j = (item % 96) * 64 + F.lane;
    const float* w = a.ada_w + (size_t)l * DM * 6 * DM + (size_t)(F.wave * 128) * 6 * DM + j;
    float acc[NB] = {0.f, 0.f, 0.f, 0.f};
#pragma unroll 8
    for (int k = 0; k < 128; ++k) {
        const float wv = w[(size_t)k * 6 * DM];
#pragma unroll
        for (int b = 0; b < NB; ++b) acc[b] += sc[b * DM + F.wave * 128 + k] * wv;
    }
#pragma unroll
    for (int b = 0; b < NB; ++b) part[(F.wave * NB + b) * 64 + F.lane] = acc[b];
    __syncthreads();
    if (F.tid < NB * 64) {
        const int b = F.tid >> 6, c = F.tid & 63;
        float sum = 0.f;
#pragma unroll
        for (int wv = 0; wv < NWAVE; ++wv) sum += part[(wv * NB + b) * 64 + c];
        const int jj = (item % 96) * 64 + c;
        float* mod = (float*)(a.ws + WS_MOD);
        mod[((size_t)l * NB + b) * 6 * DM + jj] = sum + a.ada_b[l * 6 * DM + jj];
    }
    __syncthreads();
}
DI void p0_prologue(const Frame& F, const Args& a) {
    for (int it = F.bid; it < 192; it += F.G) mod_item(F, a, it);
    cvt_run(F, a, 0, CVT_DENSE_TILES + CVT_MOE_TILES);
}

constexpr int WR_LD = 1028;
DI void moe_seg_table(const Frame& F, const unsigned* cnt, LAS int* seg  ) {
    if (F.tid < NEXP) seg[40 + F.tid] = (int)cnt[F.tid * CNT_STRIDE];
    __syncthreads();
    if (F.tid == 0) { int s = 0; for (int e = 0; e < NEXP; ++e) { seg[e] = s; s += ((seg[40 + e] + 255) >> 8) << 8; } seg[NEXP] = s; }
    __syncthreads();
}
template <bool COMBINE, bool ROUTE, bool FINAL>
DI void norm_phase(const Frame& F, const Args& a, const float* xsrc, int layer, int which, int layer_c) {
    const float* mod = (const float*)(a.ws + WS_MOD);
    bf16_t* hbuf = (bf16_t*)(a.ws + WS_H);
    unsigned* ctl = (unsigned*)(a.ws + WS_CTL);
    LAS float* wrT = (LAS float*)F.lds;
    LAS float* brs = (LAS float*)(F.lds + 36 * WR_LD * 4);
    LAS int* seg = (LAS int*)F.lds;
    constexpr int RT_CAP = 512;
    LAS int* rcnt = (LAS int*)(F.lds + 149504);
    LAS int* rbase = (LAS int*)(F.lds + 149632);
    LAS int* rt_er = (LAS int*)(F.lds + 149760);
    LAS float* rt_gate = (LAS float*)(F.lds + 149760 + 4096);
    LAS int* rt_tok = (LAS int*)(F.lds + 149760 + 8192);
    if (ROUTE) {
        const float* wg = a.moe_wr_g + (size_t)layer * DM * 4;
        const float* we = a.moe_wr_e + (size_t)layer * DM * 32;
        for (int i = F.tid; i < DM * 4; i += NTHR) { const int k = i >> 2, j = i & 3; wrT[j * WR_LD + k] = wg[i]; }
        for (int i = F.tid; i < DM * 32; i += NTHR) { const int k = i >> 5, j = i & 31; wrT[(4 + j) * WR_LD + k] = we[i]; }
        if (F.tid < NEXP) rcnt[F.tid] = 0;
        for (int i = F.tid; i < 2 * RT_CAP; i += NTHR) rt_er[i] = -1;
        if (F.tid < 4) brs[F.tid] = a.moe_br_g[layer * 4 + F.tid];
        else if (F.tid < 36) brs[F.tid] = a.moe_br_e[layer * 32 + F.tid - 4];
        __syncthreads();
    }
    if (COMBINE) moe_seg_table(F, ctl + CW_CNT + layer_c * NEXP * CNT_STRIDE, seg);
    const bf16_t* ymoe = (const bf16_t*)(a.ws + WS_YMOE);
    const int* tokslot = (const int*)(a.ws + WS_TOKSLOT);
    constexpr int TPW = ROUTE ? 2 : 4;
    for (int tb = (F.bid * NWAVE + F.wave) * TPW; tb < NTOK; tb += F.G * NWAVE * TPW) {
      const int b = tb / SEQ;
      f32x4 xall[TPW][4];
#pragma unroll
      for (int i = 0; i < TPW; ++i)
#pragma unroll
        for (int c = 0; c < 4; ++c) xall[i][c] = *(const f32x4*)(xsrc + (size_t)(tb + i) * DM + c * 256 + F.lane * 4);
      if (COMBINE) {
        int ts[TPW][2];
#pragma unroll
        for (int i = 0; i < TPW; ++i) { ts[i][0] = tokslot[(tb + i) * 2]; ts[i][1] = tokslot[(tb + i) * 2 + 1]; }
        u32x2 yv[TPW][2][4];
#pragma unroll
        for (int i = 0; i < TPW; ++i)
#pragma unroll
          for (int k = 0; k < 2; ++k) {
            const size_t r = (size_t)(seg[ts[i][k] >> 20] + (ts[i][k] & 0xfffff));
#pragma unroll
            for (int c = 0; c < 4; ++c) yv[i][k][c] = *(const u32x2*)(ymoe + r * DM + c * 256 + F.lane * 4);
          }
        const float* g2 = mod + ((size_t)layer_c * NB + b) * 6 * DM + 5 * DM;
#pragma unroll
        for (int c = 0; c < 4; ++c) {
          const int col = c * 256 + F.lane * 4;
          const f32x4 gv = *(const f32x4*)(g2 + col);
#pragma unroll
          for (int i = 0; i < TPW; ++i) {
            const u32x2 y0 = yv[i][0][c], y1 = yv[i][1][c];
            xall[i][c][0] += gv[0] * (bf_lo(y0[0]) + bf_lo(y1[0])); xall[i][c][1] += gv[1] * (bf_hi(y0[0]) + bf_hi(y1[0]));
            xall[i][c][2] += gv[2] * (bf_lo(y0[1]) + bf_lo(y1[1])); xall[i][c][3] += gv[3] * (bf_hi(y0[1]) + bf_hi(y1[1]));
            if (!FINAL) *(f32x4*)(a.out + (size_t)(tb + i) * DM + col) = xall[i][c];
          }
        }
      }
#pragma unroll
      for (int ti = 0; ti < TPW; ++ti) {
        const int tok = tb + ti;
        f32x4 xv[4];
#pragma unroll
        for (int c = 0; c < 4; ++c) xv[c] = xall[ti][c];
        float ss = 0.f;
#pragma unroll
        for (int c = 0; c < 4; ++c) ss += xv[c][0] * xv[c][0] + xv[c][1] * xv[c][1] + xv[c][2] * xv[c][2] + xv[c][3] * xv[c][3];
        ss = wave_sum(ss);
        const float rinv = rsqrtf(ss * (1.0f / DM) + EPS);
        if (FINAL) {
#pragma unroll
            for (int c = 0; c < 4; ++c) {
                const int col = c * 256 + F.lane * 4;
                const f32x4 g = *(const f32x4*)(a.final_norm_g + col);
                f32x4 o; o[0] = xv[c][0] * rinv * g[0]; o[1] = xv[c][1] * rinv * g[1]; o[2] = xv[c][2] * rinv * g[2]; o[3] = xv[c][3] * rinv * g[3];
                *(f32x4*)(a.out + (size_t)tok * DM + col) = o;
            }
            continue;
        }
        const float* ng = a.norm_g + ((size_t)layer * 2 + which) * DM;
        const float* sh = mod + ((size_t)layer * NB + b) * 6 * DM + (which ? 3 : 0) * DM;
        const float* sc = sh + DM;
        f32x4 hv[4];
#pragma unroll
        for (int c = 0; c < 4; ++c) {
            const int col = c * 256 + F.lane * 4;
            const f32x4 g = *(const f32x4*)(ng + col), s1 = *(const f32x4*)(sc + col), s0 = *(const f32x4*)(sh + col);
#pragma unroll
            for (int u = 0; u < 4; ++u) hv[c][u] = (xv[c][u] * rinv * g[u]) * (1.0f + s1[u]) + s0[u];
            u32x2 w; w[0] = pack_bf16(hv[c][0], hv[c][1]); w[1] = pack_bf16(hv[c][2], hv[c][3]);
            *(u32x2*)(hbuf + (size_t)tok * DM + col) = w;
        }
        if (ROUTE) {
            LAS float* lgs = (LAS float*)(F.lds + 36 * WR_LD * 4 + 256) + F.wave * 36;
#pragma unroll 1
            for (int jb = 0; jb < 36; jb += 4) {
                float pp[4];
#pragma unroll
                for (int u = 0; u < 4; ++u) {
                    float p = 0.f;
#pragma unroll
                    for (int c = 0; c < 4; ++c) {
                        const f32x4 w = *(const LAS f32x4*)(wrT + (jb + u) * WR_LD + c * 256 + F.lane * 4);
                        p += hv[c][0] * w[0] + hv[c][1] * w[1] + hv[c][2] * w[2] + hv[c][3] * w[3];
                    }
                    pp[u] = p;
                }
#pragma unroll
                for (int u = 0; u < 4; ++u) pp[u] = wave_sum(pp[u]);
                if (F.lane == 0) { *(LAS f32x4*)(lgs + jb) = (f32x4){pp[0], pp[1], pp[2], pp[3]}; }
            }
            float lg[36];
#pragma unroll
            for (int j = 0; j < 36; ++j) lg[j] = lgs[j] + brs[j];
            int g = 0; float gm = lg[0];
#pragma unroll
            for (int j = 1; j < 4; ++j) if (lg[j] > gm) { gm = lg[j]; g = j; }
            float den = 0.f;
#pragma unroll
            for (int j = 0; j < 4; ++j) den += __expf(lg[j] - gm);
            const float ptop = 1.0f / den;
            float fv[8];
#pragma unroll
            for (int i = 0; i < 8; ++i) fv[i] = (g == 0) ? lg[4 + i] : (g == 1) ? lg[12 + i] : (g == 2) ? lg[20 + i] : lg[28 + i];
            int i1 = 0; float v1 = fv[0];
#pragma unroll
            for (int i = 1; i < 8; ++i) if (fv[i] > v1) { v1 = fv[i]; i1 = i; }
            int i2 = -1; float v2 = -3.0e38f;
#pragma unroll
            for (int i = 0; i < 8; ++i) if (i != i1 && fv[i] > v2) { v2 = fv[i]; i2 = i; }
            const float e2 = __expf(v2 - v1), ga = ptop / (1.0f + e2), gb = ptop * e2 / (1.0f + e2);
            if (F.lane == 0) {
                const int li = ((tb - F.bid * NWAVE * TPW) / (F.G * NWAVE * TPW)) * NWAVE * TPW + F.wave * TPW + ti;
                const int ea = g * 8 + i1, eb = g * 8 + i2;
                const int ra = __hip_atomic_fetch_add(&rcnt[ea], 1, __ATOMIC_RELAXED, __HIP_MEMORY_SCOPE_WORKGROUP);
                const int rb = __hip_atomic_fetch_add(&rcnt[eb], 1, __ATOMIC_RELAXED, __HIP_MEMORY_SCOPE_WORKGROUP);
                if (li < RT_CAP) { rt_er[2 * li] = (ea << 16) | ra; rt_gate[2 * li] = ga; rt_tok[2 * li] = tok; rt_er[2 * li + 1] = (eb << 16) | rb; rt_gate[2 * li + 1] = gb; rt_tok[2 * li + 1] = tok; }
            }
        }
      }
    }
    if (ROUTE) {
        __syncthreads();
        unsigned* cnt = ctl + CW_CNT + layer * NEXP * CNT_STRIDE;
        if (F.tid < NEXP) { const int n = rcnt[F.tid]; rbase[F.tid] = n ? (int)__hip_atomic_fetch_add(cnt + F.tid * CNT_STRIDE, (unsigned)n, __ATOMIC_RELAXED, __HIP_MEMORY_SCOPE_AGENT) : 0; }
        __syncthreads();
        int* list = (int*)(a.ws + WS_LIST); float* gatev = (float*)(a.ws + WS_GATEV); int* tsl = (int*)(a.ws + WS_TOKSLOT);
        int nloc = 0;
        for (int tb = F.bid * NWAVE * TPW; tb < NTOK; tb += F.G * NWAVE * TPW) nloc += NWAVE * TPW;
        nloc = nloc < RT_CAP ? nloc : RT_CAP;
        for (int i = F.tid; i < 2 * nloc; i += NTHR) {
            const int er = rt_er[i]; if (er < 0) continue;
            const int e = er >> 16, pos = rbase[e] + (er & 0xffff), tok = rt_tok[i];
            list[e * NTOK + pos] = tok; gatev[e * NTOK + pos] = rt_gate[i]; tsl[tok * 2 + (i & 1)] = (e << 20) | pos;
        }
    }
    __syncthreads();
}

constexpr int RP_HT = 0, RP_HT_LD = 1028;
constexpr int RP_PART = 16 * RP_HT_LD * 4;
constexpr int RP_LG = RP_PART + 8 * 16 * 48 * 4;
DI void route_phase(const Frame& F, const Args& a, int layer) {
    const float* mod = (const float*)(a.ws + WS_MOD);
    bf16_t* hbuf = (bf16_t*)(a.ws + WS_H);
    unsigned* ctl = (unsigned*)(a.ws + WS_CTL);
    LAS float* HT = (LAS float*)(F.lds + RP_HT);
    LAS float* PART = (LAS float*)(F.lds + RP_PART);
    LAS float* LG = (LAS float*)(F.lds + RP_LG);
    constexpr int RT_CAP = 512;
    LAS int* rcnt = (LAS int*)(F.lds + 149504);
    LAS int* rbase = (LAS int*)(F.lds + 149632);
    LAS int* rt_er = (LAS int*)(F.lds + 149760);
    LAS float* rt_gate = (LAS float*)(F.lds + 149760 + 4096);
    LAS int* rt_tok = (LAS int*)(F.lds + 149760 + 8192);
    if (F.tid < NEXP) rcnt[F.tid] = 0;
    for (int i = F.tid; i < 2 * RT_CAP; i += NTHR) rt_er[i] = -1;
    const float* wg = a.moe_wr_g + (size_t)layer * DM * 4;
    const float* we = a.moe_wr_e + (size_t)layer * DM * 32;
    const int col = F.lane & 15, kq = F.lane >> 4;
    float Bw[3][32];
#pragma unroll
    for (int s2 = 0; s2 < 32; ++s2) {
        const int k = 128 * F.wave + 16 * (s2 >> 2) + 4 * kq + (s2 & 3);
        Bw[0][s2] = col < 4 ? wg[k * 4 + col] : we[k * 32 + col - 4];
        Bw[1][s2] = we[k * 32 + 12 + col];
        Bw[2][s2] = col < 4 ? we[k * 32 + 28 + col] : 0.f;
    }
    const float* ng = a.norm_g + ((size_t)layer * 2 + 1) * DM;
    __syncthreads();
    const int ngroups = NTOK / 16;
    int li0 = 0;
    f32x4 xn[2][4];
    if (F.bid < ngroups) {
#pragma unroll
        for (int ti = 0; ti < 2; ++ti)
#pragma unroll
            for (int c = 0; c < 4; ++c) xn[ti][c] = *(const f32x4*)(a.out + (size_t)(F.bid * 16 + F.wave * 2 + ti) * DM + c * 256 + F.lane * 4);
    }
    for (int gi = F.bid; gi < ngroups; gi += F.G, li0 += 16) {
        const int tb = gi * 16 + F.wave * 2, b = tb / SEQ;
        const float* sh = mod + ((size_t)layer * NB + b) * 6 * DM + 3 * DM;
        const float* scp = sh + DM;
        f32x4 xc[2][4];
#pragma unroll
        for (int ti = 0; ti < 2; ++ti)
#pragma unroll
            for (int c = 0; c < 4; ++c) xc[ti][c] = xn[ti][c];
        if (gi + F.G < ngroups) {
#pragma unroll
            for (int ti = 0; ti < 2; ++ti)
#pragma unroll
                for (int c = 0; c < 4; ++c) xn[ti][c] = *(const f32x4*)(a.out + (size_t)((gi + F.G) * 16 + F.wave * 2 + ti) * DM + c * 256 + F.lane * 4);
        }
#pragma unroll
        for (int ti = 0; ti < 2; ++ti) {
            const int tok = tb + ti;
            f32x4 xv[4];
#pragma unroll
            for (int c = 0; c < 4; ++c) xv[c] = xc[ti][c];
            float ss = 0.f;
#pragma unroll
            for (int c = 0; c < 4; ++c) ss += xv[c][0] * xv[c][0] + xv[c][1] * xv[c][1] + xv[c][2] * xv[c][2] + xv[c][3] * xv[c][3];
            ss = wave_sum(ss);
            const float rinv = rsqrtf(ss * (1.0f / DM) + EPS);
#pragma unroll
            for (int c = 0; c < 4; ++c) {
                const int cl = c * 256 + F.lane * 4;
                const f32x4 g = *(const f32x4*)(ng + cl), s1 = *(const f32x4*)(scp + cl), s0 = *(const f32x4*)(sh + cl);
                f32x4 hv;
#pragma unroll
                for (int u = 0; u < 4; ++u) hv[u] = (xv[c][u] * rinv * g[u]) * (1.0f + s1[u]) + s0[u];
                u32x2 w; w[0] = pack_bf16(hv[0], hv[1]); w[1] = pack_bf16(hv[2], hv[3]);
                *(u32x2*)(hbuf + (size_t)tok * DM + cl) = w;
                *(LAS f32x4*)(HT + (F.wave * 2 + ti) * RP_HT_LD + cl) = hv;
            }
        }
        __syncthreads();
        {
            f32x4 acc[3];
#pragma unroll
            for (int n = 0; n < 3; ++n) acc[n] = (f32x4){0.f, 0.f, 0.f, 0.f};
            const LAS float* ap = HT + col * RP_HT_LD + 128 * F.wave + 4 * kq;
#pragma unroll
            for (int s4 = 0; s4 < 8; ++s4) {
                const f32x4 av = *(const LAS f32x4*)(ap + 16 * s4);
#pragma unroll
                for (int u = 0; u < 4; ++u)
#pragma unroll
                    for (int n = 0; n < 3; ++n) acc[n] = __builtin_amdgcn_mfma_f32_16x16x4f32(av[u], Bw[n][4 * s4 + u], acc[n], 0, 0, 0);
            }
#pragma unroll
            for (int n = 0; n < 3; ++n)
#pragma unroll
                for (int r = 0; r < 4; ++r) PART[(F.wave * 16 + 4 * kq + r) * 48 + 16 * n + col] = acc[n][r];
        }
        __syncthreads();
        {
            const int tk = F.tid >> 5, j = F.tid & 31;
            float s0 = 0.f, s1 = 0.f;
#pragma unroll
            for (int wv = 0; wv < NWAVE; ++wv) { s0 += PART[(wv * 16 + tk) * 48 + j]; s1 += PART[(wv * 16 + tk) * 48 + 32 + (j & 3)]; }
            LG[tk * 36 + j] = s0 + (j < 4 ? a.moe_br_g[layer * 4 + j] : a.moe_br_e[layer * 32 + j - 4]);
            if (j < 4) LG[tk * 36 + 32 + j] = s1 + a.moe_br_e[layer * 32 + 28 + j];
        }
        __syncthreads();
        if (F.tid < 16) {
            const int tk = F.tid, tok = gi * 16 + tk;
            float lg[36];
#pragma unroll
            for (int j = 0; j < 36; ++j) lg[j] = LG[tk * 36 + j];
            int g = 0; float gm = lg[0];
#pragma unroll
            for (int j = 1; j < 4; ++j) if (lg[j] > gm) { gm = lg[j]; g = j; }
            float den = 0.f;
#pragma unroll
            for (int j = 0; j < 4; ++j) den += __expf(lg[j] - gm);
            const float ptop = 1.0f / den;
            float fv[8];
#pragma unroll
            for (int i = 0; i < 8; ++i) fv[i] = (g == 0) ? lg[4 + i] : (g == 1) ? lg[12 + i] : (g == 2) ? lg[20 + i] : lg[28 + i];
            int i1 = 0; float v1 = fv[0];
#pragma unroll
            for (int i = 1; i < 8; ++i) if (fv[i] > v1) { v1 = fv[i]; i1 = i; }
            int i2 = -1; float v2 = -3.0e38f;
#pragma unroll
            for (int i = 0; i < 8; ++i) if (i != i1 && fv[i] > v2) { v2 = fv[i]; i2 = i; }
            const float e2 = __expf(v2 - v1), ga = ptop / (1.0f + e2), gb = ptop * e2 / (1.0f + e2);
            const int li = li0 + tk, ea = g * 8 + i1, eb = g * 8 + i2;
            const int ra = __hip_atomic_fetch_add(&rcnt[ea], 1, __ATOMIC_RELAXED, __HIP_MEMORY_SCOPE_WORKGROUP);
            const int rb = __hip_atomic_fetch_add(&rcnt[eb], 1, __ATOMIC_RELAXED, __HIP_MEMORY_SCOPE_WORKGROUP);
            if (li < RT_CAP) { rt_er[2 * li] = (ea << 16) | ra; rt_gate[2 * li] = ga; rt_tok[2 * li] = tok; rt_er[2 * li + 1] = (eb << 16) | rb; rt_gate[2 * li + 1] = gb; rt_tok[2 * li + 1] = tok; }
        }
    }
    __syncthreads();
    unsigned* cnt = ctl + CW_CNT + layer * NEXP * CNT_STRIDE;
    if (F.tid < NEXP) { const int n = rcnt[F.tid]; rbase[F.tid] = n ? (int)__hip_atomic_fetch_add(cnt + F.tid * CNT_STRIDE, (unsigned)n, __ATOMIC_RELAXED, __HIP_MEMORY_SCOPE_AGENT) : 0; }
    __syncthreads();
    int* list = (int*)(a.ws + WS_LIST); float* gatev = (float*)(a.ws + WS_GATEV); int* tsl = (int*)(a.ws + WS_TOKSLOT);
    const int nloc = li0 < RT_CAP ? li0 : RT_CAP;
    for (int i = F.tid; i < 2 * nloc; i += NTHR) {
        const int er = rt_er[i]; if (er < 0) continue;
        const int e = er >> 16, pos = rbase[e] + (er & 0xffff), tok = rt_tok[i];
        list[e * NTOK + pos] = tok; gatev[e * NTOK + pos] = rt_gate[i]; tsl[tok * 2 + (i & 1)] = (e << 20) | pos;
    }
    __syncthreads();
}

constexpr int LDS_MISC = 131072 + 64;
constexpr int LDS_XB = 163840 - 16;
constexpr int LDS_BYTES = 163840;
using pg8::Unit;
struct DenseSched {
    int nM, nN, nwg, G, c; const char* Bt; size_t tstepB;
    DI void init(int M, int N, int K, int G_, int c_, const void* Bt_) { nM = M / 256; nN = N / 256; nwg = nM * nN; G = G_; c = c_; Bt = (const char*)Bt_; tstepB = (size_t)256 * K * 2; }
    DI bool next(int i, Unit& u) const {
        const long L = (long)i * G + c; if (L >= nwg) return false;
        int wgid = (int)L; { const int q = nwg / 8, r = nwg % 8, xcd = wgid % 8, off = wgid / 8; wgid = (xcd < r ? xcd * (q + 1) : r * (q + 1) + (xcd - r) * q) + off; }
        const int nig = 8 * nN, gid = wgid / nig, fm = gid * 8, gsz = (nM - fm) < 8 ? (nM - fm) : 8;
        u.pm = fm + ((wgid % nig) % gsz); u.pn = (wgid % nig) / gsz; u.e = 0; u.nrow = 256; return true;
    }
    DI int a_row(const Unit& u, int r) const { return u.pm * 256 + r; }
    DI const char* b_base(const Unit& u) const { return Bt + (size_t)u.pn * tstepB; }
};
template <bool UP>
struct MoeSched {
    const LAS int* ntp; const unsigned* cnt; const int* list; const char* W; int nU, G, c;
    DI bool next(int i, Unit& u) const {
        const long L = (long)i * G + c; if (L >= nU) return false;
        int wgid = (int)L; { const int q = nU / 8, r = nU % 8, xcd = wgid % 8, off = wgid / 8; wgid = (xcd < r ? xcd * (q + 1) : r * (q + 1) + (xcd - r) * q) + off; }
        const int tg = wgid >> 2; u.pn = wgid & 3; u.pm = tg;
        int e = 0;
        for (int k = 1; k < NEXP; ++k) e += (ntp[k] <= tg) ? 1 : 0;
        u.e = e; const int rem = ntp[40 + e] - (tg - ntp[e]) * 256; u.nrow = rem < 256 ? rem : 256; return true;
    }
    DI int a_row(const Unit& u, int r) const {
        if (UP) { const int p = (u.pm - ntp[u.e]) * 256 + r; return (r < u.nrow) ? list[u.e * NTOK + p] : 0; }
        return u.pm * 256 + r;
    }
    DI const char* b_base(const Unit& u) const {
        return W + (size_t)u.e * 3 * MiB + (UP ? (size_t)u.pn * 256 * DM * 2 : 2 * MiB + (size_t)u.pn * 256 * DEXP * 2);
    }
};
DI void moe_tile_table(const Frame& F, const unsigned* cnt, LAS int* ntp  ) {
    if (F.tid < NEXP) ntp[40 + F.tid] = (int)cnt[F.tid * CNT_STRIDE];
    __syncthreads();
    if (F.tid == 0) { int s = 0; for (int e = 0; e < NEXP; ++e) { ntp[e] = s; s += (ntp[40 + e] + 255) >> 8; } ntp[NEXP] = s; }
    __syncthreads();
}

#define EPI_ROWS_BEGIN const int row0 = u.pm * 256 + wr * 64 + fr; _Pragma("unroll") for (int ai = 0; ai < 2; ++ai) _Pragma("unroll") for (int m = 0; m < 4; ++m) { const int row = row0 + ai * 128 + m * 16;
#define EPI_ROWS_END }
DI u32x2 pack4(const f32x4& v) { u32x2 w; w[0] = pack_bf16(v[0], v[1]); w[1] = pack_bf16(v[2], v[3]); return w; }

struct EpiAbIn {
    bf16_t* Zc;
    DI void operator()(const f32x4 (&acc)[2][2][4][2], const Unit& u, int wr, int wc, int fr, int fq) const {
        EPI_ROWS_BEGIN
            bf16_t* rp = Zc + (size_t)row * ZC_N;
            if (u.pn < 2) {
#pragma unroll
                for (int bj = 0; bj < 2; ++bj) {
                    const u32x2 lo = pack4(acc[ai][bj][m][0]), hi = pack4(acc[ai][bj][m][1]);
                    *(u32x4*)(rp + u.pn * 256 + bj * 128 + wc * 32 + 8 * fq) = (u32x4){lo[0], lo[1], hi[0], hi[1]};
                }
            } else {
                const int pnp = (u.pn - 2) & 3, j = 128 * pnp + 32 * wc + 8 * fq;
                u32x2 o[2];
#pragma unroll
                for (int bj = 0; bj < 2; ++bj) {
                    const f32x4 X = acc[ai][bj][m][0], Y = acc[ai][bj][m][1]; f32x4 v;
                    if (u.pn < 6) v = X * Y;
                    else { v[0] = X[0] * sigmoid_f(Y[0]); v[1] = X[1] * sigmoid_f(Y[1]); v[2] = X[2] * sigmoid_f(Y[2]); v[3] = X[3] * sigmoid_f(Y[3]); }
                    o[bj] = pack4(v);
                }
                *(u32x4*)(rp + (u.pn < 6 ? 512 : 1024) + j) = (u32x4){o[0][0], o[0][1], o[1][0], o[1][1]};
            }
        EPI_ROWS_END
    }
};
struct EpiResid {
    const float* xin; float* xout; const float* g1;
    DI void operator()(const f32x4 (&acc)[2][2][4][2], const Unit& u, int wr, int wc, int fr, int fq) const {
        const float* g = g1 + (size_t)((u.pm * 256) / SEQ) * 6 * DM;
        const int row0 = u.pm * 256 + wr * 64 + fr, col0 = u.pn * 256 + wc * 32 + 4 * fq;
        f32x4 gv[2][2];
#pragma unroll
        for (int bj = 0; bj < 2; ++bj)
#pragma unroll
            for (int n = 0; n < 2; ++n) gv[bj][n] = *(const f32x4*)(g + col0 + bj * 128 + n * 16);
#pragma unroll
        for (int ai = 0; ai < 2; ++ai) {
            f32x4 xo[4][2][2];
#pragma unroll
            for (int m = 0; m < 4; ++m)
#pragma unroll
                for (int bj = 0; bj < 2; ++bj)
#pragma unroll
                    for (int n = 0; n < 2; ++n) xo[m][bj][n] = *(const f32x4*)(xin + (size_t)(row0 + ai * 128 + m * 16) * DM + col0 + bj * 128 + n * 16);
            asm volatile("" ::: "memory");
#pragma unroll
            for (int m = 0; m < 4; ++m)
#pragma unroll
                for (int bj = 0; bj < 2; ++bj)
#pragma unroll
                    for (int n = 0; n < 2; ++n) *(f32x4*)(xout + (size_t)(row0 + ai * 128 + m * 16) * DM + col0 + bj * 128 + n * 16) = xo[m][bj][n] + gv[bj][n] * acc[ai][bj][m][n];
        }
    }
};
struct EpiPlain {
    bf16_t* O; int ld; int nsc; float sc;
    DI void operator()(const f32x4 (&acc)[2][2][4][2], const Unit& u, int wr, int wc, int fr, int fq) const {
        const float s_ = u.pn < nsc ? sc : 1.0f;
        EPI_ROWS_BEGIN
#pragma unroll
            for (int bj = 0; bj < 2; ++bj) {
                const u32x2 lo = pack4(acc[ai][bj][m][0] * s_), hi = pack4(acc[ai][bj][m][1] * s_);
                *(u32x4*)(O + (size_t)row * ld + u.pn * 256 + bj * 128 + wc * 32 + 8 * fq) = (u32x4){lo[0], lo[1], hi[0], hi[1]};
            }
        EPI_ROWS_END
    }
};
struct EpiPlainNat {
    bf16_t* O; int ld;
    DI void operator()(const f32x4 (&acc)[2][2][4][2], const Unit& u, int wr, int wc, int fr, int fq) const {
        EPI_ROWS_BEGIN
#pragma unroll
            for (int bj = 0; bj < 2; ++bj)
#pragma unroll
                for (int n = 0; n < 2; ++n) *(u32x2*)(O + (size_t)row * ld + u.pn * 256 + bj * 128 + wc * 32 + n * 16 + 4 * fq) = pack4(acc[ai][bj][m][n]);
        EPI_ROWS_END
    }
};
struct EpiVt {
    bf16_t* O;
    DI void operator()(const f32x4 (&acc)[2][2][4][2], const Unit& u, int wr, int wc, int fr, int fq) const {
        const int pos = 8 * (fq & 1) + 4 * (fq >> 1);
        EPI_ROWS_BEGIN
#pragma unroll
            for (int bj = 0; bj < 2; ++bj)
#pragma unroll
                for (int n = 0; n < 2; ++n) *(u32x2*)(O + (size_t)row * NTOK + u.pn * 256 + bj * 128 + wc * 32 + n * 16 + pos) = pack4(acc[ai][bj][m][n]);
        EPI_ROWS_END
    }
};
struct EpiMoeUp {
    bf16_t* act;
    DI void operator()(const f32x4 (&acc)[2][2][4][2], const Unit& u, int wr, int wc, int fr, int fq) const {
        EPI_ROWS_BEGIN
            u32x2 o[2];
#pragma unroll
            for (int bj = 0; bj < 2; ++bj) {
                const f32x4 X = acc[ai][bj][m][0], Y = acc[ai][bj][m][1]; f32x4 v;
                v[0] = silu_f(X[0]) * Y[0]; v[1] = silu_f(X[1]) * Y[1]; v[2] = silu_f(X[2]) * Y[2]; v[3] = silu_f(X[3]) * Y[3];
                o[bj] = pack4(v);
            }
            *(u32x4*)(act + (size_t)row * DEXP + 128 * u.pn + 32 * wc + 8 * fq) = (u32x4){o[0][0], o[0][1], o[1][0], o[1][1]};
        EPI_ROWS_END
    }
};
struct EpiMoeDown {
    bf16_t* y; const float* gatev; const LAS int* ntp;
    DI void operator()(const f32x4 (&acc)[2][2][4][2], const Unit& u, int wr, int wc, int fr, int fq) const {
        const int pbase = (u.pm - ntp[u.e]) * 256;
        EPI_ROWS_BEGIN
            const int r = row - u.pm * 256;
            const float gt = (r < u.nrow) ? gatev[u.e * NTOK + pbase + r] : 0.f;
#pragma unroll
            for (int bj = 0; bj < 2; ++bj) {
                const u32x2 lo = pack4(acc[ai][bj][m][0] * gt), hi = pack4(acc[ai][bj][m][1] * gt);
                *(u32x4*)(y + (size_t)row * DM + u.pn * 256 + bj * 128 + wc * 32 + 8 * fq) = (u32x4){lo[0], lo[1], hi[0], hi[1]};
            }
        EPI_ROWS_END
    }
};

DI void conv_phase(const Frame& F, const Args& a) {
    const bf16_t* Zc = (const bf16_t*)(a.ws + WS_BIG);
    bf16_t* Y = (bf16_t*)(a.ws + WS_Y);
    LAS unsigned* PB = (LAS unsigned*)F.lds;
    LAS f32x2* ST = (LAS f32x2*)(F.lds + 94 * 1024);
    const int cp = F.tid & 255, th = F.tid >> 8, wq = F.wave & 3;
    float wb[31][2], wa[3][2];
#pragma unroll
    for (int k = 0; k < 31; ++k) { const f32x2 w = *(const f32x2*)(a.ab_conv_b + k * 512 + 2 * cp); wb[k][0] = w[0]; wb[k][1] = w[1]; }
#pragma unroll
    for (int k = 0; k < 3; ++k) { const f32x2 w = *(const f32x2*)(a.ab_conv_a + k * 512 + 2 * cp); wa[k][0] = w[0]; wa[k][1] = w[1]; }
    const f32x2 cbias = *(const f32x2*)(a.ab_conv_b_bias + 2 * cp), lng = *(const f32x2*)(a.ab_ln_g + 2 * cp), lnb = *(const f32x2*)(a.ab_ln_b + 2 * cp);
    for (int tile = F.bid; tile < NTOK / 64; tile += F.G) {
        const int t0 = tile * 64, b = t0 / SEQ, tl0 = t0 % SEQ;
        for (int i = F.tid; i < 94 * 64; i += NTHR) {
            const int r = i >> 6, c8 = i & 63, pos = tl0 - 30 + r;
            u32x4 v = {0u, 0u, 0u, 0u};
            if (pos >= 0) v = *(const u32x4*)(Zc + (size_t)(b * SEQ + pos) * ZC_N + 1024 + c8 * 8);
            *(LAS u32x4*)(PB + r * 256 + c8 * 4) = v;
        }
        __syncthreads();
#pragma unroll 1
        for (int g = 0; g < 4; ++g) {
            float U[8][2];
#pragma unroll
            for (int i = 0; i < 8; ++i) { U[i][0] = cbias[0]; U[i][1] = cbias[1]; }
#pragma unroll
            for (int r = 0; r < 38; ++r) {
                const unsigned xw = PB[(32 * th + 8 * g + r) * 256 + cp];
                const float x0 = bf_lo(xw), x1 = bf_hi(xw);
#pragma unroll
                for (int i = 0; i < 8; ++i) { const int k = r - i; if (k >= 0 && k <= 30) { U[i][0] += wb[k][0] * x0; U[i][1] += wb[k][1] * x1; } }
            }
            unsigned gwv[8], pav[10];
#pragma unroll
            for (int i = 0; i < 8; ++i) gwv[i] = *(const unsigned*)(Zc + ((size_t)t0 + 32 * th + 8 * g + i) * ZC_N + 2 * cp);
#pragma unroll
            for (int i = 0; i < 10; ++i) { const int pp = tl0 + 32 * th + 8 * g + i - 2; pav[i] = pp >= 0 ? *(const unsigned*)(Zc + (size_t)(b * SEQ + pp) * ZC_N + 512 + 2 * cp) : 0u; }
            {
                float v[16];
#pragma unroll
                for (int i = 0; i < 8; ++i) { v[2 * i] = U[i][0] + U[i][1]; v[2 * i + 1] = U[i][0] * U[i][0] + U[i][1] * U[i][1]; }
#pragma unroll
                for (int hw = 8; hw >= 1; hw >>= 1) {
                    const bool up = (F.lane & (4 * hw)) != 0;
#pragma unroll
                    for (int i = 0; i < hw; ++i) { const float send = up ? v[i] : v[i + hw], keep = up ? v[i + hw] : v[i]; v[i] = keep + __shfl_xor(send, 4 * hw); }
                }
                v[0] += __shfl_xor(v[0], 2); v[0] += __shfl_xor(v[0], 1);
                if ((F.lane & 3) == 0) { const int idx = F.lane >> 2; ((LAS float*)ST)[((32 * th + 8 * g + (idx >> 1)) * 4 + wq) * 2 + (idx & 1)] = v[0]; }
            }
            __syncthreads();
#pragma unroll
            for (int i = 0; i < 8; ++i) {
                const int tl = 32 * th + 8 * g + i; const size_t tok = (size_t)t0 + tl;
                const f32x2 p0 = ST[tl * 4 + 0], p1 = ST[tl * 4 + 1], p2 = ST[tl * 4 + 2], p3 = ST[tl * 4 + 3];
                const float mean = ((p0[0] + p1[0]) + (p2[0] + p3[0])) * (1.0f / 512.0f);
                const float var = ((p0[1] + p1[1]) + (p2[1] + p3[1])) * (1.0f / 512.0f) - mean * mean;
                const float rstd = rsqrtf(var + EPS);
                const float yb0 = silu_f((U[i][0] - mean) * rstd * lng[0] + lnb[0]), yb1 = silu_f((U[i][1] - mean) * rstd * lng[1] + lnb[1]);
                *(unsigned*)(Y + tok * DM + 512 + 2 * cp) = pack_bf16(yb0, yb1);
                float a0 = 0.f, a1 = 0.f;
#pragma unroll
                for (int k = 0; k < 3; ++k) { const unsigned w = pav[i + k]; a0 += wa[k][0] * bf_lo(w); a1 += wa[k][1] * bf_hi(w); }
                const unsigned gw = gwv[i];
                *(unsigned*)(Y + tok * DM + 2 * cp) = pack_bf16(bf_lo(gw) * a0, bf_hi(gw) * a1);
            }
        }
        __syncthreads();
    }
}

#define MFMA32(a, b, c) __builtin_amdgcn_mfma_f32_32x32x16_bf16((a), (b), (c), 0, 0, 0)
#define LDS6_ISSUE(B, addr, o0, o1, o2, o3, o4, o5) asm volatile( \
    "ds_read_b128 %0, %6 offset:" #o0 "\n\tds_read_b128 %1, %6 offset:" #o1 "\n\tds_read_b128 %2, %6 offset:" #o2 "\n\tds_read_b128 %3, %6 offset:" #o3 "\n\tds_read_b128 %4, %6 offset:" #o4 "\n\tds_read_b128 %5, %6 offset:" #o5 \
    : "=&v"(B[0]), "=&v"(B[1]), "=&v"(B[2]), "=&v"(B[3]), "=&v"(B[4]), "=&v"(B[5]) : "v"(addr) : "memory")
#define LDS6_WAIT(B) asm volatile("s_waitcnt lgkmcnt(0)" : "+v"(B[0]), "+v"(B[1]), "+v"(B[2]), "+v"(B[3]), "+v"(B[4]), "+v"(B[5]) :: "memory")
constexpr int TK_HIST = 0;
constexpr int TK_HLD = 513;
constexpr int TK_TAB = 66048;
constexpr int TK_CAP = 256;
constexpr int TK_CAND = 66560;
constexpr int TK_CCNT = TK_CAND + 32 * TK_CAP * 4;
constexpr int TK_OVF = TK_CCNT + 128;
constexpr int TK_BQ = 100352;
constexpr int TK_MASK = 118784;
DI int crow_c(int r) { return (r & 3) + 8 * (r >> 2); }
template <int MODE, bool DIAG>
DI void topk_elems(const Frame& F, const f32x16& sc, int kt, int q, int h2, int myT, LAS unsigned* hist, LAS unsigned* cand, LAS int* ccnt, LAS unsigned* maskl) {
    const int lo = myT << 9, hi = (myT + 1) << 9;
    if (MODE <= 2) {
#pragma unroll
        for (int r = 0; r < 16; ++r) {
            unsigned key = (unsigned)fmaxf(sc[r], 0.0f); key = key > 262143u ? 262143u : key;
            const bool valid = !DIAG || (crow_c(r) + 4 * h2 <= q);
            if (MODE == 1) { if (valid) __hip_atomic_fetch_add(&hist[q * TK_HLD + (key >> 9)], 1u, __ATOMIC_RELAXED, __HIP_MEMORY_SCOPE_WORKGROUP); }
            else { if (valid && (int)(key >> 9) == myT) __hip_atomic_fetch_add(&hist[q * TK_HLD + (key & 511)], 1u, __ATOMIC_RELAXED, __HIP_MEMORY_SCOPE_WORKGROUP); }
        }
        return;
    }
    const int selb = (MODE == 3 ? myT : hi - 1), geb = (MODE == 3 ? myT - 1 : lo - 1);
    unsigned selw = 0u, gew = 0u;
#pragma unroll
    for (int r = 0; r < 16; ++r) {
        unsigned key = (unsigned)fmaxf(sc[r], 0.0f); key = key > 262143u ? 262143u : key;
        const unsigned d1 = (unsigned)(selb - (int)key), d2 = (unsigned)(geb - (int)key);
        selw = __builtin_amdgcn_alignbit(selw, d1, 31);
        gew = __builtin_amdgcn_alignbit(gew, d2, 31);
    }
    if (DIAG) {
        unsigned vw = 0u;
#pragma unroll
        for (int r = 0; r < 16; ++r) vw |= (crow_c(r) + 4 * h2 <= q) ? (1u << (15 - r)) : 0u;
        selw &= vw; gew &= vw;
    }
    unsigned cw = gew & ~selw & 0xffffu;
    if (cw) {
#pragma unroll
        for (int r = 0; r < 16; ++r) {
            if (cw & (1u << (15 - r))) {
                unsigned key = (unsigned)fmaxf(sc[r], 0.0f); key = key > 262143u ? 262143u : key;
                const int p = __hip_atomic_fetch_add(&ccnt[q], 1, __ATOMIC_RELAXED, __HIP_MEMORY_SCOPE_WORKGROUP);
                if (p < TK_CAP) cand[q * TK_CAP + p] = (MODE == 3 ? 0u : ((key - (unsigned)lo) << 13)) | (unsigned)(8191 - (32 * kt + crow_c(r) + 4 * h2));
            }
        }
    }
    unsigned rv = __builtin_bitreverse32(selw) >> 16;
    unsigned bits = (rv & 0xfu) | ((rv & 0xf0u) << 4) | ((rv & 0xf00u) << 8) | ((rv & 0xf000u) << 12);
    bits <<= 4 * h2;
    bits |= (unsigned)__shfl_xor((int)bits, 32);
    if (h2 == 0) maskl[q * 256 + kt] = bits;
}
template <int MODE>
DI void topk_pass(const Frame& F, const bf16_t* Z, int b, int t0, const float (&wp)[8]) {
    const LAS unsigned char* bq = F.lds + TK_BQ;
    LAS unsigned* hist = (LAS unsigned*)(F.lds + TK_HIST);
    LAS int* tab = (LAS int*)(F.lds + TK_TAB);
    LAS unsigned* cand = (LAS unsigned*)(F.lds + TK_CAND);
    LAS int* ccnt = (LAS int*)(F.lds + TK_CCNT);
    LAS unsigned* maskl = (LAS unsigned*)(F.lds + TK_MASK);
    const int lane = fresh_lane(), q = lane & 31, h2 = lane >> 5, ntile = t0 / 32 + 1;
    const int myT = (MODE >= 2) ? tab[q * 4 + 0] : 0;
    const unsigned bqa = (unsigned)(size_t)(bq + lane * 16);
    const bf16_t* kbase = Z + (size_t)b * SEQ * CD_N + Z_KI + 8 * h2 + (size_t)q * CD_N;
    bf16x8 A0n = (bf16x8){0, 0, 0, 0, 0, 0, 0, 0}, A1n = A0n;
    if (F.wave < ntile) { const bf16_t* kp = kbase + (size_t)(32 * F.wave) * CD_N; A0n = *(const bf16x8*)kp; A1n = *(const bf16x8*)(kp + 16); }
    for (int kt = F.wave; kt < ntile; kt += NWAVE) {
        const bf16x8 A0 = A0n, A1 = A1n;
        if (kt + NWAVE < ntile) { const bf16_t* kp = kbase + (size_t)(32 * (kt + NWAVE)) * CD_N; A0n = *(const bf16x8*)kp; A1n = *(const bf16x8*)(kp + 16); }
        f32x16 sc;
#pragma unroll
        for (int r = 0; r < 16; ++r) sc[r] = 131072.0f;
        {
#define TK_MF0(acc, A, B) asm volatile("v_mfma_f32_32x32x16_bf16 %0, %1, %2, 0" : "=&v"(acc) : "v"(A), "v"(B))
#define TK_MF1(acc, A, B) asm volatile("v_mfma_f32_32x32x16_bf16 %0, %1, %2, %0" : "+v"(acc) : "v"(A), "v"(B))
#define TK_FA(sv, av, wv) asm volatile("v_fma_f32 %0, |%1|, %2, %0" : "+v"(sv) : "v"(av), "v"(wv))
#define TK_AD(sv, av) asm volatile("v_add_f32 %0, %0, %1" : "+v"(sv) : "v"(av))
        bf16x8 Ba[6], Bb[6];
        f32x16 acA[3], acB[3];
        LDS6_ISSUE(Ba, bqa, 16384, 17408, 0, 1024, 2048, 3072);
        LDS6_WAIT(Ba);
        LDS6_ISSUE(Bb, bqa, 4096, 5120, 6144, 7168, 8192, 9216);
#pragma unroll
        for (int u = 0; u < 3; ++u) TK_MF0(acA[u], A0, Ba[2 * u]);
#pragma unroll
        for (int u = 0; u < 3; ++u) TK_MF1(acA[u], A1, Ba[2 * u + 1]);
        LDS6_WAIT(Bb);
        LDS6_ISSUE(Ba, bqa, 10240, 11264, 12288, 13312, 14336, 15360);
#pragma unroll
        for (int m = 0; m < 6; ++m) {
            if (m >= 3) TK_MF1(acB[m - 3], A1, Bb[2 * (m - 3) + 1]); else TK_MF0(acB[m], A0, Bb[2 * m]);
#pragma unroll
            for (int e = 0; e < 8; ++e) { const int i = 8 * m + e, u = i >> 4, r = i & 15; if (u == 0) TK_AD(sc[r], acA[0][r]); else TK_FA(sc[r], acA[u][r], wp[u - 1]); }
        }
        LDS6_WAIT(Ba);
#pragma unroll
        for (int m = 0; m < 6; ++m) {
            if (m >= 3) TK_MF1(acA[m - 3], A1, Ba[2 * (m - 3) + 1]); else TK_MF0(acA[m], A0, Ba[2 * m]);
#pragma unroll
            for (int e = 0; e < 8; ++e) { const int i = 8 * m + e, u = i >> 4, r = i & 15; TK_FA(sc[r], acB[u][r], wp[2 + u]); }
        }
#pragma unroll
        for (int u = 0; u < 3; ++u)
#pragma unroll
            for (int r = 0; r < 16; ++r) TK_FA(sc[r], acA[u][r], wp[5 + u]);
#undef TK_MF0
#undef TK_MF1
#undef TK_FA
#undef TK_AD
        }
        if (kt == ntile - 1) topk_elems<MODE, true>(F, sc, kt, q, h2, myT, hist, cand, ccnt, maskl);
        else topk_elems<MODE, false>(F, sc, kt, q, h2, myT, hist, cand, ccnt, maskl);
    }
}
DI void topk_scan(const Frame& F, int pass, int t0) {
    LAS unsigned* hist = (LAS unsigned*)(F.lds + TK_HIST);
    LAS int* tab = (LAS int*)(F.lds + TK_TAB);
    LAS int* ovf = (LAS int*)(F.lds + TK_OVF);
    for (int qi = 0; qi < 4; ++qi) {
        const int q = F.wave * 4 + qi, n = t0 + q + 1;
        int need = 256, prevT = 0, prevAbove = 0;
        if (pass == 2) { prevT = tab[q * 4 + 0]; prevAbove = tab[q * 4 + 1]; need = 256 - prevAbove; }
        if (n <= 256) { if (F.lane == 0) { tab[q * 4 + 0] = -1; tab[q * 4 + 1] = 0; tab[q * 4 + 2] = 0; } continue; }
        unsigned hv[8]; unsigned s = 0;
#pragma unroll
        for (int i = 0; i < 8; ++i) { hv[i] = hist[q * TK_HLD + 511 - (8 * F.lane + i)]; s += hv[i]; }
        unsigned inc = s;
#pragma unroll
        for (int o = 1; o < 64; o <<= 1) { const unsigned v = (unsigned)__shfl_up((int)inc, o); if (F.lane >= o) inc += v; }
        const unsigned pre = inc - s;
        if ((int)pre < need && (int)inc >= need) {
            unsigned cum = pre; int bsel = 0; unsigned above = 0, inbin = 0; bool found = false;
#pragma unroll
            for (int i = 0; i < 8; ++i) { if (!found && (int)(cum + hv[i]) >= need) { found = true; bsel = 511 - (8 * F.lane + i); above = cum; inbin = hv[i]; } cum += hv[i]; }
            if (pass == 1) { tab[q * 4 + 0] = bsel; tab[q * 4 + 1] = (int)above; tab[q * 4 + 2] = 256 - (int)above; if (inbin > (unsigned)TK_CAP) *ovf = 1; }
            else { tab[q * 4 + 0] = (prevT << 9) | bsel; tab[q * 4 + 1] = prevAbove + (int)above; tab[q * 4 + 2] = 256 - (prevAbove + (int)above); }
        }
    }
}
DI void topk_select(const Frame& F) {
    LAS int* tab = (LAS int*)(F.lds + TK_TAB);
    LAS unsigned* cand = (LAS unsigned*)(F.lds + TK_CAND);
    LAS int* ccnt = (LAS int*)(F.lds + TK_CCNT);
    LAS unsigned* maskl = (LAS unsigned*)(F.lds + TK_MASK);
    for (int qi = 0; qi < 4; ++qi) {
        const int q = F.wave * 4 + qi, need = tab[q * 4 + 2];
        int n = ccnt[q]; n = n > TK_CAP ? TK_CAP : n;
        if (need <= 0 || n <= 0) continue;
        unsigned c[4]; int rk[4]; bool vv[4];
#pragma unroll
        for (int i = 0; i < 4; ++i) { vv[i] = F.lane + 64 * i < n; c[i] = vv[i] ? cand[q * TK_CAP + F.lane + 64 * i] : 0u; rk[i] = 0; }
        for (int j = 0; j < n; ++j) {
            const unsigned cj = cand[q * TK_CAP + j];
#pragma unroll
            for (int i = 0; i < 4; ++i) rk[i] += (cj > c[i]) ? 1 : 0;
        }
#pragma unroll
        for (int i = 0; i < 4; ++i)
            if (vv[i] && rk[i] < need) { const int idx = 8191 - (int)(c[i] & 8191u); __hip_atomic_fetch_or(&maskl[q * 256 + (idx >> 5)], 1u << (idx & 31), __ATOMIC_RELAXED, __HIP_MEMORY_SCOPE_WORKGROUP); }
    }
}
DI void topk_phase(const Frame& F, const Args& a, unsigned long long& tacc) {
    unsigned long long t_s = 0;
#define TKT0(n) do { if (TIME_PH == 100 + (n)) { __syncthreads(); t_s = wall_clock64(); } } while (0)
#define TKT1(n) do { if (TIME_PH == 100 + (n)) { __syncthreads(); tacc += wall_clock64() - t_s; } } while (0)
    const bf16_t* Z = (const bf16_t*)(a.ws + WS_BIG);
    unsigned* maskg = (unsigned*)(a.ws + WS_MASK);
    LAS unsigned* hist = (LAS unsigned*)(F.lds + TK_HIST);
    LAS int* ccnt = (LAS int*)(F.lds + TK_CCNT);
    LAS int* ovf = (LAS int*)(F.lds + TK_OVF);
    LAS unsigned* maskl = (LAS unsigned*)(F.lds + TK_MASK);
    for (int pi = F.bid; pi < 512; pi += F.G) {
        const int b = pi >> 7, p = pi & 127;
        for (int half = 0; half < 2; ++half) {
            const int t0 = 32 * (half ? 255 - p : p), ntile = t0 / 32 + 1;
            const int lane0 = fresh_lane(), q = lane0 & 31, h2 = lane0 >> 5;
            const bf16_t* zr = Z + (size_t)(b * SEQ + t0 + q) * CD_N;
            TKT0(1);
            float wp[8];
            { const u32x4 wv = *(const u32x4*)(zr + Z_WI);
              const float sc = 0.0625f * 0.5f * 16384.0f;
              wp[0] = bf_lo(wv[0]) * sc; wp[1] = bf_hi(wv[0]) * sc; wp[2] = bf_lo(wv[1]) * sc; wp[3] = bf_hi(wv[1]) * sc;
              wp[4] = bf_lo(wv[2]) * sc; wp[5] = bf_hi(wv[2]) * sc; wp[6] = bf_lo(wv[3]) * sc; wp[7] = bf_hi(wv[3]) * sc; }
            __syncthreads();
            if (F.wave == 0) {
                LAS unsigned char* bqw = F.lds + TK_BQ;
                float lin[2][8];
#pragma unroll
                for (int ks = 0; ks < 2; ++ks)
#pragma unroll
                    for (int j = 0; j < 8; ++j) lin[ks][j] = 0.f;
#pragma unroll
                for (int h = 0; h < 8; ++h)
#pragma unroll
                    for (int ks = 0; ks < 2; ++ks) {
                        const u32x4 v = *(const u32x4*)(zr + Z_QI + 32 * h + 16 * ks + 8 * h2);
                        *(LAS u32x4*)(bqw + ((2 * h + ks) * 64 + lane0) * 16) = v;
#pragma unroll
                        for (int j = 0; j < 4; ++j) { lin[ks][2 * j] += wp[h] * bf_lo(v[j]); lin[ks][2 * j + 1] += wp[h] * bf_hi(v[j]); }
                    }
#pragma unroll
                for (int ks = 0; ks < 2; ++ks) {
                    u32x4 v; v[0] = pack_bf16(lin[ks][0], lin[ks][1]); v[1] = pack_bf16(lin[ks][2], lin[ks][3]); v[2] = pack_bf16(lin[ks][4], lin[ks][5]); v[3] = pack_bf16(lin[ks][6], lin[ks][7]);
                    *(LAS u32x4*)(bqw + ((16 + ks) * 64 + lane0) * 16) = v;
                }
            }
            for (int i = F.tid; i < 32 * TK_HLD; i += NTHR) hist[i] = 0u;
            if (F.tid < 32) ccnt[F.tid] = 0;
            if (F.tid == 32) *ovf = 0;
            __syncthreads();
            TKT1(1); TKT0(2);
            topk_pass<1>(F, Z, b, t0, wp);
            __syncthreads();
            TKT1(2); TKT0(3);
            topk_scan(F, 1, t0);
            __syncthreads();
            TKT1(3); TKT0(4);
            if (*ovf == 0) {
                topk_pass<4>(F, Z, b, t0, wp);
            } else {
                for (int i = F.tid; i < 32 * TK_HLD; i += NTHR) hist[i] = 0u;
                __syncthreads();
                topk_pass<2>(F, Z, b, t0, wp);
                __syncthreads();
                topk_scan(F, 2, t0);
                __syncthreads();
                topk_pass<3>(F, Z, b, t0, wp);
            }
            __syncthreads();
            TKT1(4); TKT0(5);
            topk_select(F);
            __syncthreads();
            for (int i = F.wave * 64 + fresh_lane(); i < 32 * ntile; i += NTHR) { const int qq = i / ntile, kt = i - qq * ntile; maskg[(size_t)(b * SEQ + t0 + qq) * 256 + kt] = maskl[qq * 256 + kt]; }
            TKT1(5);
        }
    }
}

constexpr int AT_KBYTES = 64 * 128;
constexpr int AT_VBYTES = 128 * 128;
constexpr int AT_BUF = AT_KBYTES + AT_VBYTES;
constexpr int AT_NSTG = 4;
constexpr int AT_LUT = AT_NSTG * AT_BUF;
constexpr int AT_LUTM = AT_LUT + 12 * 320 * 4;
constexpr int AT_LUT_LD = 320;
constexpr float NEG_INF = -__builtin_huge_valf();
constexpr float AT_THR = 8.0f;

template <int DV, bool MASKED>
DI void attn_core(const Frame& F, const bf16_t* Z, const bf16_t* Vt, int b, int qcol, int kcol, int vrow, int q0, const LAS float* lut, float c1, const unsigned* maskg, f32x16 (&O)[DV / 32]) {
    constexpr int NDV = DV / 32;
    const int q = F.lane & 31, h2 = F.lane >> 5;
    const int tw0 = q0 + 32 * F.wave, t = tw0 + q;
    const bf16_t* Zb = Z + (size_t)b * SEQ * CD_N;
    const bf16_t* Vb = Vt + (size_t)vrow * NTOK + (size_t)b * SEQ;
    const unsigned* mrow = maskg + (size_t)(b * SEQ + t) * 256;
    bf16x8 Qf[4];
#pragma unroll
    for (int ks = 0; ks < 4; ++ks) Qf[ks] = *(const bf16x8*)(Zb + (size_t)t * CD_N + qcol + 16 * ks + 8 * h2);
#pragma unroll
    for (int d = 0; d < NDV; ++d)
#pragma unroll
        for (int r = 0; r < 16; ++r) O[d][r] = 0.f;
    const LAS f32x4* lutm = (const LAS f32x4*)(F.lds + AT_LUTM);
    float m_run = NEG_INF, l_run = 0.f;
    const int jmax = (q0 + 255) >> 6;
    const int swz = (q >> 1) & 7;
    const int drow = F.lane >> 3, dpos = F.lane & 7;
    unsigned mreg[2] = {0u, 0u};
    bf16x8 Pf[4];
#pragma unroll
    for (int i = 0; i < 4; ++i) Pf[i] = (bf16x8){0, 0, 0, 0, 0, 0, 0, 0};
#define AT_DMA(j) do { const int sg_ = (j) % AT_NSTG; \
        { const int key_ = 8 * F.wave + drow, c_ = dpos ^ ((key_ >> 1) & 7); \
          __builtin_amdgcn_global_load_lds((const unsigned*)(Zb + (size_t)(64 * (j) + key_) * CD_N + kcol + 8 * c_), (LAS unsigned*)(F.lds + sg_ * AT_BUF + F.wave * 1024), 16, 0, 0); } \
        _Pragma("unroll") for (int _i = 0; _i < DV / 64; ++_i) { const int ii_ = F.wave + 8 * _i, row_ = 8 * ii_ + drow, c_ = dpos ^ ((row_ >> 1) & 7); \
          __builtin_amdgcn_global_load_lds((const unsigned*)(Vb + (size_t)row_ * NTOK + 64 * (j) + 8 * c_), (LAS unsigned*)(F.lds + sg_ * AT_BUF + AT_KBYTES + ii_ * 1024), 16, 0, 0); } \
        } while (0)
#define AT_MLOAD(j) do { if (MASKED) { mreg[0] = mrow[2 * (j)]; mreg[1] = mrow[2 * (j) + 1]; } } while (0)
#define AT_QKSM(jj) do { \
        const LAS unsigned char* kb = F.lds + ((jj) % AT_NSTG) * AT_BUF; \
        f32x16 s[2]; \
        _Pragma("unroll") for (int kb2 = 0; kb2 < 2; ++kb2) { \
            bf16x8 Kf[4]; \
            _Pragma("unroll") for (int ks = 0; ks < 4; ++ks) Kf[ks] = *(const LAS bf16x8*)(kb + (32 * kb2 + q) * 128 + (((2 * ks + h2) ^ swz) << 4)); \
            _Pragma("unroll") for (int r = 0; r < 16; ++r) s[kb2][r] = 0.f; \
            _Pragma("unroll") for (int ks = 0; ks < 4; ++ks) s[kb2] = MFMA32(Kf[ks], Qf[ks], s[kb2]); \
        } \
        const bool nearb = (64 * (jj) + 63 + 128 > tw0); \
        float mloc = NEG_INF; \
        if (!nearb) { \
            _Pragma("unroll") for (int kb2 = 0; kb2 < 2; ++kb2) _Pragma("unroll") for (int r = 0; r < 16; ++r) mloc = fmaxf(mloc, s[kb2][r]); \
            mloc = mloc * c1 + lut[96 + 128]; \
        } else { \
            const LAS float* lp = lut + (t - 64 * (jj) - 4 * h2 + 96 - 63); \
            _Pragma("unroll") for (int kb2 = 0; kb2 < 2; ++kb2) \
                _Pragma("unroll") for (int r = 0; r < 16; ++r) { const float v_ = s[kb2][r] * c1 + lp[63 - (32 * kb2 + crow_c(r))]; s[kb2][r] = v_; mloc = fmaxf(mloc, v_); } \
        } \
        mloc = fmaxf(mloc, __shfl_xor(mloc, 32)); \
        if (__any(mloc > m_run + AT_THR)) { \
            const float m_new = fmaxf(m_run, mloc); \
            const float alpha = __builtin_amdgcn_exp2f(m_run - m_new); \
            m_run = m_new; l_run *= alpha; \
            _Pragma("unroll") for (int d = 0; d < NDV; ++d) _Pragma("unroll") for (int r = 0; r < 16; ++r) O[d][r] *= alpha; \
        } \
        const float sub = lut[96 + 128] - m_run; \
        if (!nearb) { _Pragma("unroll") for (int kb2 = 0; kb2 < 2; ++kb2) _Pragma("unroll") for (int r = 0; r < 16; ++r) s[kb2][r] = __builtin_amdgcn_exp2f(s[kb2][r] * c1 + sub); } \
        else        { _Pragma("unroll") for (int kb2 = 0; kb2 < 2; ++kb2) _Pragma("unroll") for (int r = 0; r < 16; ++r) s[kb2][r] = __builtin_amdgcn_exp2f(s[kb2][r] - m_run); } \
        float psum0 = 0.f, psum1 = 0.f; \
        _Pragma("unroll") for (int kb2 = 0; kb2 < 2; ++kb2) { \
            const unsigned mw = mcur[kb2] >> (4 * h2); \
            _Pragma("unroll") for (int g = 0; g < 4; ++g) { \
                f32x4 mf = {1.f, 1.f, 1.f, 1.f}; \
                if (MASKED) mf = lutm[(mw >> (8 * g)) & 15u];                  \
                _Pragma("unroll") for (int e = 0; e < 4; ++e) { \
                    float p = s[kb2][4 * g + e]; \
                    if (MASKED) { p *= mf[e]; s[kb2][4 * g + e] = p; } \
                    if (e & 1) psum1 += p; else psum0 += p; \
                } \
            } \
        } \
        l_run += psum0 + psum1; \
        _Pragma("unroll") for (int st = 0; st < 4; ++st) { \
            u32x4 pw; \
            _Pragma("unroll") for (int e = 0; e < 4; ++e) pw[e] = pack_bf16(s[st >> 1][8 * (st & 1) + 2 * e], s[st >> 1][8 * (st & 1) + 2 * e + 1]); \
            Pf[st] = __builtin_bit_cast(bf16x8, pw); \
        } \
    } while (0)
#define AT_PV(jj) do { \
        const LAS unsigned char* vt = F.lds + ((jj) % AT_NSTG) * AT_BUF + AT_KBYTES + q * 128; \
        constexpr int NH = NDV / 2, NST = 4 * NH; \
        bf16x8 Av[2][2]; \
        _Pragma("unroll") for (int d = 0; d < 2; ++d) Av[0][d] = *(const LAS bf16x8*)(vt + (32 * d) * 128 + ((h2 ^ swz) << 4)); \
        _Pragma("unroll") for (int u = 0; u < NST; ++u) { \
            const int st = u / NH, dh = u % NH; \
            if (u + 1 < NST) { \
                const int st1 = (u + 1) / NH, dh1 = (u + 1) % NH; \
                _Pragma("unroll") for (int d = 0; d < 2; ++d) Av[(u + 1) & 1][d] = *(const LAS bf16x8*)(vt + (32 * (2 * dh1 + d)) * 128 + (((2 * st1 + h2) ^ swz) << 4)); \
            } \
            __builtin_amdgcn_s_setprio(1); \
            _Pragma("unroll") for (int d = 0; d < 2; ++d) O[2 * dh + d] = MFMA32(Av[u & 1][d], Pf[st], O[2 * dh + d]); \
            __builtin_amdgcn_s_setprio(0); \
            __builtin_amdgcn_sched_barrier(0); \
        } \
    } while (0)
#define AT_ACT(jj) (64 * (jj) <= tw0 + 31)
#define AT_WAITG() do { if (DV == 128) asm volatile("s_waitcnt vmcnt(3)" ::: "memory"); else asm volatile("s_waitcnt vmcnt(2)" ::: "memory"); } while (0)
    AT_DMA(0); AT_MLOAD(0);
    unsigned mcur[2] = {mreg[0], mreg[1]};
    if (jmax >= 1) AT_DMA(1);
    asm volatile("s_waitcnt vmcnt(0)" ::: "memory");
    __syncthreads();
    if (F.wave < 4) {
        for (int j = 0; j <= jmax; ++j) {
            if (j < jmax) AT_MLOAD(j + 1);
            if (j + 2 <= jmax) AT_DMA(j + 2);
            if (AT_ACT(j)) { AT_QKSM(j); AT_PV(j); }
            mcur[0] = mreg[0]; mcur[1] = mreg[1];
            if (j + 2 <= jmax) AT_WAITG(); else asm volatile("s_waitcnt vmcnt(0)" ::: "memory");
            asm volatile("s_waitcnt lgkmcnt(0)" ::: "memory"); __builtin_amdgcn_s_barrier(); asm volatile("" ::: "memory");
        }
    } else {
        for (int j = 0; j <= jmax; ++j) {
            if (j < jmax) AT_MLOAD(j + 1);
            if (j + 2 <= jmax) AT_DMA(j + 2);
            if (j > 0 && AT_ACT(j - 1)) AT_PV(j - 1);
            if (AT_ACT(j)) AT_QKSM(j);
            mcur[0] = mreg[0]; mcur[1] = mreg[1];
            if (j + 2 <= jmax) AT_WAITG(); else asm volatile("s_waitcnt vmcnt(0)" ::: "memory");
            asm volatile("s_waitcnt lgkmcnt(0)" ::: "memory"); __builtin_amdgcn_s_barrier(); asm volatile("" ::: "memory");
        }
        if (AT_ACT(jmax)) AT_PV(jmax);
    }
    __syncthreads();
#undef AT_WAITG
#undef AT_DMA
#undef AT_MLOAD
#undef AT_QKSM
#undef AT_PV
#undef AT_ACT
    const float lt = l_run + __shfl_xor(l_run, 32);
    const float inv = 1.0f / lt;
#pragma unroll
    for (int d = 0; d < NDV; ++d)
#pragma unroll
        for (int r = 0; r < 16; ++r) O[d][r] *= inv;
}

DI float rel_bucket_bias(const float* rel_bias, int d, int head) {
    int bkt;
    if (d < 16) bkt = d;
    else { const float lr = __logf((float)d * (1.0f / 16.0f)) / 2.0794415416798357f; int l = 16 + (int)(lr * 16.0f); bkt = l < 31 ? l : 31; }
    return rel_bias[bkt * 12 + head];
}
constexpr int AC_SLOTB = 8192, AC_K = 0, AC_V = 3 * AC_SLOTB, AC_WS = 6 * AC_SLOTB, AC_OST = AC_WS + 8 * 256, AC_M = AC_OST + 8 * 4096, AC_LUTM = AC_M + 3 * 2048, AC_LUTB = AC_LUTM + 256, AC_LUTB_LD = 640;
static_assert(AC_LUTB + 8 * AC_LUTB_LD * 4 <= 163840 - 64, "LDS");
constexpr float AC_THR = 8.0f;
typedef short v4i16_t __attribute__((ext_vector_type(4)));
typedef const LAS char* lds_cptr;
DI int ac_crow(int r, int hi) { return (r & 3) + 8 * (r >> 2) + 4 * hi; }
DI void ac_glds16(const void* g, unsigned lds_dst) { unsigned keep;
    asm volatile("s_mov_b32 %0, m0\n\ts_mov_b32 m0, %2\n\ts_nop 0\n\tglobal_load_lds_dwordx4 %1, off\n\ts_mov_b32 m0, %0" : "=&s"(keep) : "v"(g), "s"(lds_dst) : "memory"); }
DI void ac_glds4(const void* g, unsigned lds_dst) { unsigned keep;
    asm volatile("s_mov_b32 %0, m0\n\ts_mov_b32 m0, %2\n\ts_nop 0\n\tglobal_load_lds_dword %1, off\n\ts_mov_b32 m0, %0" : "=&s"(keep) : "v"(g), "s"(lds_dst) : "memory"); }
DI void ac_kload2(bf16x8* kf, lds_cptr kp, int j) { kf[2 * j] = *(const LAS bf16x8*)(kp + j * 2048); kf[2 * j + 1] = *(const LAS bf16x8*)(kp + j * 2048 + 512); }
DI s16x4 ac_vtr(lds_cptr p) { return __builtin_bit_cast(s16x4, __builtin_amdgcn_ds_read_tr16_b64_v4i16((LAS v4i16_t*)p)); }
DI void ac_bias(f32x16& p0, f32x16& p1, int jb, int qrel, int hi, const LAS float* lutb) {
    const LAS float* lp = lutb + (qrel - 64 * jb - 4 * hi + 256);
#pragma unroll
    for (int r = 0; r < 16; ++r) { const int kv = (r & 3) + 8 * (r >> 2); p0[r] += lp[-kv]; p1[r] += lp[-kv - 32]; }
}
#define AC_SBAR() __builtin_amdgcn_sched_barrier(0)
#define AC_WAIT_BAR(N) asm volatile("s_waitcnt vmcnt(" #N ") lgkmcnt(0)\n\ts_barrier" ::: "memory")
#define AC_MFMA(a, b, c) __builtin_amdgcn_mfma_f32_32x32x16_bf16((a), (b), (c), 0, 0, 0)
DI void attn_c_unit(const Frame& F, int b, int h, int qb, const bf16_t* Z, bf16_t* Yo, const unsigned* maskg, const float fb) {
    LAS unsigned char* shm = F.lds;
    const int lane = fresh_lane(), r32 = lane & 31, hi = lane >> 5, wid = F.wave;
    const size_t rowbase = (size_t)b * SEQ; const int q0 = qb * 256;
    const bf16_t* Qw = Z + (rowbase + q0 + wid * 32) * CD_N + Z_QC + h * 64;
    const bf16_t* Kh = Z + rowbase * CD_N + Z_KC + h * 64; const bf16_t* Vh = Z + rowbase * CD_N + Z_VC + h * 64;
    const unsigned lds0 = (unsigned)(size_t)shm;
    LAS float* wsf = (LAS float*)(shm + AC_WS) + wid * 64;
    const LAS f32x4* lutm = (const LAS f32x4*)(shm + AC_LUTM);
    const LAS float* lutb = (const LAS float*)(shm + AC_LUTB) + h * AC_LUTB_LD;
    const bf16_t* ksrc = Kh + (size_t)lane * CD_N + wid * 8;
    const bf16_t* vsrc = Vh + (size_t)(16 * (wid & 3) + (lane >> 2)) * CD_N + (wid >> 2) * 32 + (lane & 3) * 8;
    const unsigned* msrc = maskg + (rowbase + q0 + wid * 32 + (lane >> 1)) * 256 + (lane & 1);
    const unsigned kdst = lds0 + AC_K + wid * 1024, vdst = lds0 + AC_V + wid * 1024, mdst = lds0 + AC_M + wid * 256;
#define DMA_K(t, slot) ac_glds16(ksrc + (size_t)(t) * 64 * CD_N, (unsigned)__builtin_amdgcn_readfirstlane(kdst + (slot)))
#define DMA_V(t, slot) ac_glds16(vsrc + (size_t)(t) * 64 * CD_N, (unsigned)__builtin_amdgcn_readfirstlane(vdst + (slot)))
#define DMA_M(t, slot) ac_glds4(msrc + 2 * (t), (unsigned)__builtin_amdgcn_readfirstlane(mdst + ((slot) >> 2)))
    const lds_cptr shm3 = (lds_cptr)shm;
    const lds_cptr kp0 = shm3 + AC_K + hi * 1024 + r32 * 16;
    const lds_cptr vp0 = shm3 + AC_V + ((lane >> 4) & 1) * 32 + (lane & 3) * 8 + (4 * hi + ((lane & 15) >> 2)) * 64;
    const lds_cptr mp0 = shm3 + AC_M + wid * 256 + 8 * r32;
    const int NT = (q0 + 256) / 64;
    DMA_K(0, 0); DMA_M(0, 0); DMA_M(1, AC_SLOTB); DMA_V(0, 0); DMA_K(1, AC_SLOTB);
    bf16x8 qr[4];
#pragma unroll
    for (int d0 = 0; d0 < 4; ++d0) qr[d0] = *(const bf16x8*)(Qw + (size_t)r32 * CD_N + d0 * 16 + hi * 8);
    float mhat = 0.f, l_reg = 0.f; f32x16 o[2]; f32x16 negm;
#pragma unroll
    for (int r = 0; r < 16; ++r) { o[0][r] = 0.f; o[1][r] = 0.f; negm[r] = fb; }
    asm volatile("" : "+v"(negm));
    const int qrel = wid * 32 + r32;
    bool resc = false;
    bf16x8 kf[8];
    f32x16 pA0, pA1, pB0, pB1;
    int sl_prev = 0, sl_cur = 0, sl_next = AC_SLOTB;
#define ROT() do { sl_prev = sl_cur; sl_cur = sl_next; sl_next = (sl_next == 2 * AC_SLOTB) ? 0 : sl_next + AC_SLOTB; } while (0)
#define RESC() do { if (resc) { asm volatile("s_waitcnt lgkmcnt(0)" ::: "memory"); \
        _Pragma("unroll") for (int d_ = 0; d_ < 2; ++d_) _Pragma("unroll") for (int r = 0; r < 16; ++r) o[d_][r] *= wsf[ac_crow(r, hi)]; } } while (0)
    DMA_K(2, 2 * AC_SLOTB);
    AC_WAIT_BAR(3);
    {
#pragma unroll
        for (int d0 = 0; d0 < 4; ++d0) ac_kload2(kf, kp0, d0);
        pA0 = AC_MFMA(kf[0], qr[0], negm); pA1 = AC_MFMA(kf[1], qr[0], negm);
#pragma unroll
        for (int d0 = 1; d0 < 4; ++d0) { pA0 = AC_MFMA(kf[2 * d0], qr[d0], pA0); pA1 = AC_MFMA(kf[2 * d0 + 1], qr[d0], pA1); }
        if (NT == 4) ac_bias(pA0, pA1, 0, qrel, hi, lutb);
        float rm = -__builtin_huge_valf();
#pragma unroll
        for (int r = 0; r < 16; ++r) rm = __builtin_fmaxf(rm, __builtin_fmaxf(pA0[r], pA1[r]));
        { auto rr = __builtin_amdgcn_permlane32_swap(__float_as_uint(rm), __float_as_uint(rm), false, false); rm = __builtin_fmaxf(__uint_as_float(rr[0]), __uint_as_float(rr[1])); }
        mhat = rm;
#pragma unroll
        for (int r = 0; r < 16; ++r) negm[r] = fb - mhat;
        asm volatile("" : "+v"(negm));
        const u32x2 mwv = *(const LAS u32x2*)(mp0);
        const unsigned w0 = mwv[0] >> (4 * hi), w1 = mwv[1] >> (4 * hi);
#pragma unroll
        for (int g = 0; g < 4; ++g) {
            const f32x4 m0 = lutm[(w0 >> (8 * g)) & 15u], m1 = lutm[(w1 >> (8 * g)) & 15u];
#pragma unroll
            for (int e = 0; e < 4; ++e) { pA0[4 * g + e] = __builtin_amdgcn_exp2f(pA0[4 * g + e] - rm) * m0[e]; pA1[4 * g + e] = __builtin_amdgcn_exp2f(pA1[4 * g + e] - rm) * m1[e]; }
        }
    }
    AC_WAIT_BAR(0);
    DMA_K(3, 0); DMA_V(1, AC_SLOTB); DMA_M(2, 2 * AC_SLOTB);
    ROT();
#pragma unroll
    for (int d0 = 0; d0 < 4; ++d0) ac_kload2(kf, kp0 + sl_cur, d0);
    AC_WAIT_BAR(3);
    s16x4 vlo[8], vhi[8]; u32x4 pw0, pw1, pw2, pw3; f32x4 mfq; unsigned mw0, mw1;
#define PKW(P, B) pack_bf16(P[B], P[B + 1])
#define PAF(k) __builtin_bit_cast(bf16x8, pw##k)
#define VFR(i) (bf16x8){vlo[i][0], vlo[i][1], vlo[i][2], vlo[i][3], vhi[i][0], vhi[i][1], vhi[i][2], vhi[i][3]}
#define PIN(x) asm volatile("" : "+v"(x))
#define MX3(a, b, c) __builtin_fmaxf(__builtin_fmaxf((a), (b)), (c))
#define GAPA(MF, A0, A1, A2, A3, W0, W1, PW) do { MF; sacc += A0; sacc += A1; sacc += A2; sacc += A3; PIN(sacc); W0; W1; PIN(PW); AC_SBAR(); } while (0)
#define EX(v) __builtin_amdgcn_exp2f(v)
#define GAPB(MF, X, B, NW, NS) do { MF; X[B] = EX(X[B]) * mfq[0]; X[B + 1] = EX(X[B + 1]) * mfq[1]; X[B + 2] = EX(X[B + 2]) * mfq[2]; X[B + 3] = EX(X[B + 3]) * mfq[3]; PIN(X); \
        mfq = lutm[((NW) >> (NS)) & 15u]; AC_SBAR(); } while (0)
#define VRD(i) do { vlo[i] = ac_vtr(vp_ + (((i) >> 2) * 4096 + ((i) & 3) * 1024)); vhi[i] = ac_vtr(vp_ + (((i) >> 2) * 4096 + ((i) & 3) * 1024 + 512)); } while (0)
#define KRD(G, j) do { if (G) { ac_kload2(kf, kp0 + sl_next, j); AC_SBAR(); } } while (0)
#define STEP(C0, C1, P0, P1, t, BAND, GK, GV, GL, GM) do { AC_SBAR(); \
    const lds_cptr vp_ = vp0 + sl_prev; \
    { const u32x2 mwv_ = *(const LAS u32x2*)(mp0 + (sl_cur >> 2)); mw0 = mwv_[0] >> (4 * hi); mw1 = mwv_[1] >> (4 * hi); } \
    VRD(0); AC_SBAR(); float sacc = (P0[0] + P0[1]); \
    GAPA(C0 = AC_MFMA(kf[0], qr[0], negm), P0[2], P0[3], P0[4], P0[5],     pw0[0] = PKW(P0, 0), pw0[1] = PKW(P0, 2), pw0); \
    VRD(4); AC_SBAR(); GAPA(C1 = AC_MFMA(kf[1], qr[0], negm), P0[6], P0[7], P0[8], P0[9],     pw0[2] = PKW(P0, 4), pw0[3] = PKW(P0, 6), pw0); \
    VRD(1); AC_SBAR(); GAPA(C0 = AC_MFMA(kf[2], qr[1], C0),   P0[10], P0[11], P0[12], P0[13], pw1[0] = PKW(P0, 8), pw1[1] = PKW(P0, 10), pw1); \
    VRD(5); AC_SBAR(); GAPA(C1 = AC_MFMA(kf[3], qr[1], C1),   P0[14], P0[15], P1[0], P1[1],   pw1[2] = PKW(P0, 12), pw1[3] = PKW(P0, 14), pw1); \
    VRD(2); AC_SBAR(); GAPA(C0 = AC_MFMA(kf[4], qr[2], C0),   P1[2], P1[3], P1[4], P1[5],     pw2[0] = PKW(P1, 0), pw2[1] = PKW(P1, 2), pw2); \
    VRD(6); AC_SBAR(); GAPA(C1 = AC_MFMA(kf[5], qr[2], C1),   P1[6], P1[7], P1[8], P1[9],     pw2[2] = PKW(P1, 4), pw2[3] = PKW(P1, 6), pw2); \
    VRD(3); AC_SBAR(); GAPA(C0 = AC_MFMA(kf[6], qr[3], C0),   P1[10], P1[11], P1[12], P1[13], pw3[0] = PKW(P1, 8), pw3[1] = PKW(P1, 10), pw3); \
    VRD(7); AC_SBAR(); GAPA(C1 = AC_MFMA(kf[7], qr[3], C1),   P1[14], P1[15], 0.f, 0.f,       pw3[2] = PKW(P1, 12), pw3[3] = PKW(P1, 14), pw3); \
    l_reg += sacc; \
    if (GK) { DMA_K((t) + 3, sl_cur); } if (GV) { DMA_V((t) + 1, sl_next); } if (GM) { DMA_M((t) + 2, sl_prev); } \
    mfq = lutm[mw0 & 15u]; \
    if (BAND) { const int jb_ = (t) - (NT - 4); if (jb_ >= -2) ac_bias(C0, C1, jb_, qrel, hi, lutb); } \
    { float a_ = MX3(C0[0], C0[1], C1[0]), b_ = MX3(C0[2], C0[3], C1[1]); a_ = MX3(a_, C1[2], C1[3]); \
      _Pragma("unroll") for (int r = 4; r < 16; r += 4) { a_ = MX3(a_, C0[r], C0[r + 1]); b_ = MX3(b_, C0[r + 2], C0[r + 3]); a_ = MX3(a_, C1[r], C1[r + 1]); b_ = MX3(b_, C1[r + 2], C1[r + 3]); } \
      float rm = __builtin_fmaxf(a_, b_); { auto rr = __builtin_amdgcn_permlane32_swap(__float_as_uint(rm), __float_as_uint(rm), false, false); rm = __builtin_fmaxf(__uint_as_float(rr[0]), __uint_as_float(rr[1])); } \
      resc = false; \
      if (__builtin_expect(__any(rm > AC_THR), 0)) { const float dl = __builtin_fmaxf(rm, 0.f); mhat += dl; \
        _Pragma("unroll") for (int r = 0; r < 16; ++r) { C0[r] -= dl; C1[r] -= dl; } \
        _Pragma("unroll") for (int r = 0; r < 16; ++r) negm[r] = fb - mhat; asm volatile("" : "+v"(negm)); \
        const float f = __builtin_amdgcn_exp2f(-dl); l_reg *= f; if (hi == 0) wsf[r32] = f; resc = true; } } \
    AC_SBAR(); \
    GAPB(o[0] = AC_MFMA(PAF(0), VFR(0), o[0]), C0, 0, mw0, 8); \
    GAPB(o[1] = AC_MFMA(PAF(0), VFR(4), o[1]), C0, 4, mw0, 16); \
    KRD(GL, 0); GAPB(o[0] = AC_MFMA(PAF(1), VFR(1), o[0]), C0, 8, mw0, 24); \
    KRD(GL, 1); GAPB(o[1] = AC_MFMA(PAF(1), VFR(5), o[1]), C0, 12, mw1, 0); \
    KRD(GL, 2); GAPB(o[0] = AC_MFMA(PAF(2), VFR(2), o[0]), C1, 0, mw1, 8); \
    KRD(GL, 3); GAPB(o[1] = AC_MFMA(PAF(2), VFR(6), o[1]), C1, 4, mw1, 16); \
    GAPB(o[0] = AC_MFMA(PAF(3), VFR(3), o[0]), C1, 8, mw1, 24); \
    GAPB(o[1] = AC_MFMA(PAF(3), VFR(7), o[1]), C1, 12, mw1, 0); \
    } while (0)
    int t = 1;
    for (; t + 7 < NT; t += 2) {
        STEP(pB0, pB1, pA0, pA1, t, false, true, true, true, true);     AC_WAIT_BAR(3); RESC(); ROT();
        STEP(pA0, pA1, pB0, pB1, t + 1, false, true, true, true, true); AC_WAIT_BAR(3); RESC(); ROT();
    }
#define ENDW(tt) do { if ((tt) + 3 < NT) { AC_WAIT_BAR(3); } else if ((tt) + 2 < NT) { AC_WAIT_BAR(2); } else { AC_WAIT_BAR(0); } } while (0)
    for (; t + 1 < NT; t += 2) {
        STEP(pB0, pB1, pA0, pA1, t, true, (t + 3 < NT), (t + 1 < NT), (t + 1 < NT), (t + 2 < NT));         ENDW(t);     RESC(); ROT();
        STEP(pA0, pA1, pB0, pB1, t + 1, true, (t + 4 < NT), (t + 2 < NT), (t + 2 < NT), (t + 3 < NT));     ENDW(t + 1); RESC(); ROT();
    }
    STEP(pB0, pB1, pA0, pA1, NT - 1, true, false, false, false, false); RESC();
    {
        float sacc = pB0[0] + pB0[1];
#pragma unroll
        for (int r = 2; r < 16; ++r) sacc += pB0[r];
#pragma unroll
        for (int r = 0; r < 16; ++r) sacc += pB1[r];
        l_reg += sacc;
        pw0 = (u32x4){PKW(pB0, 0), PKW(pB0, 2), PKW(pB0, 4), PKW(pB0, 6)}; pw1 = (u32x4){PKW(pB0, 8), PKW(pB0, 10), PKW(pB0, 12), PKW(pB0, 14)};
        pw2 = (u32x4){PKW(pB1, 0), PKW(pB1, 2), PKW(pB1, 4), PKW(pB1, 6)}; pw3 = (u32x4){PKW(pB1, 8), PKW(pB1, 10), PKW(pB1, 12), PKW(pB1, 14)};
        const lds_cptr vp_ = vp0 + sl_cur;
#pragma unroll
        for (int i = 0; i < 8; ++i) VRD(i);
        o[0] = AC_MFMA(PAF(0), VFR(0), o[0]); o[1] = AC_MFMA(PAF(0), VFR(4), o[1]); o[0] = AC_MFMA(PAF(1), VFR(1), o[0]); o[1] = AC_MFMA(PAF(1), VFR(5), o[1]);
        o[0] = AC_MFMA(PAF(2), VFR(2), o[0]); o[1] = AC_MFMA(PAF(2), VFR(6), o[1]); o[0] = AC_MFMA(PAF(3), VFR(3), o[0]); o[1] = AC_MFMA(PAF(3), VFR(7), o[1]);
    }
    { auto rr = __builtin_amdgcn_permlane32_swap(__float_as_uint(l_reg), __float_as_uint(l_reg), false, false); l_reg = __uint_as_float(rr[0]) + __uint_as_float(rr[1]); }
    if (hi == 0) wsf[32 + r32] = l_reg;
    asm volatile("s_waitcnt lgkmcnt(0)" ::: "memory");
    float rli[16];
#pragma unroll
    for (int r = 0; r < 16; ++r) rli[r] = __builtin_amdgcn_rcpf(wsf[32 + ac_crow(r, hi)]);
    {
        bf16_t* Ow = Yo + (rowbase + q0 + wid * 32) * DM + h * 64;
        LAS bf16_t* stg = (LAS bf16_t*)(shm + AC_OST) + wid * 2048;
#pragma unroll
        for (int r = 0; r < 16; ++r) { const int orow = ac_crow(r, hi);
#pragma unroll
            for (int d0 = 0; d0 < 2; ++d0) stg[orow * 64 + d0 * 32 + r32] = (bf16_t)(pack_bf16(o[d0][r] * rli[r], 0.f) & 0xffffu); }
        asm volatile("s_waitcnt lgkmcnt(0)" ::: "memory");
#pragma unroll
        for (int i = 0; i < 4; ++i) { const int row = i * 8 + (lane >> 3), ch = lane & 7; const u32x4 v = *(const LAS u32x4*)(stg + row * 64 + ch * 8); *(u32x4*)(Ow + (size_t)row * DM + ch * 8) = v; }
    }
    asm volatile("s_waitcnt lgkmcnt(0)\n\ts_barrier" ::: "memory");
#undef DMA_K
#undef DMA_V
#undef DMA_M
#undef ROT
#undef RESC
#undef PKW
#undef PAF
#undef VFR
#undef PIN
#undef MX3
#undef GAPA
#undef EX
#undef GAPB
#undef VRD
#undef KRD
#undef STEP
#undef ENDW
}

template <bool DPART>
DI void attn_phase(const Frame& F, const Args& a) {
    const bf16_t* Z = (const bf16_t*)(a.ws + WS_BIG);
    const bf16_t* Vtg = (const bf16_t*)(a.ws + WS_VT);
    bf16_t* Yo = (bf16_t*)(a.ws + WS_Y);
    float* O1s = (float*)(a.ws + WS_H);
    const unsigned* maskg = (const unsigned*)(a.ws + WS_MASK);
    LAS float* lut = (LAS float*)(F.lds + AT_LUT);
    if (DPART) {
        for (int i = F.tid; i < 12 * AT_LUT_LD; i += NTHR) { const int hh = i / AT_LUT_LD, d = i % AT_LUT_LD - 96; lut[i] = d < 0 ? NEG_INF : rel_bucket_bias(a.rel_bias, d < 128 ? d : 128, hh) * LOG2E; }
    } else {
        if (F.tid < 16) ((LAS f32x4*)(F.lds + AC_LUTM))[F.tid] = (f32x4){(float)(F.tid & 1), (float)((F.tid >> 1) & 1), (float)((F.tid >> 2) & 1), (float)((F.tid >> 3) & 1)};
        LAS float* lb = (LAS float*)(F.lds + AC_LUTB);
        for (int i = F.tid; i < 8 * AC_LUTB_LD; i += NTHR) { const int hh = i / AC_LUTB_LD, d = i % AC_LUTB_LD - 256; lb[i] = d < 0 ? NEG_INF : (rel_bucket_bias(a.rel_bias, d < 128 ? d : 128, hh) - a.rel_bias[31 * 12 + hh]) * LOG2E; }
    }
    float lam;
    { float d01 = 0.f, d23 = 0.f; for (int i = 0; i < 64; ++i) { d01 += a.diff_lam[i] * a.diff_lam[64 + i]; d23 += a.diff_lam[128 + i] * a.diff_lam[192 + i]; }
      lam = __expf(d01) - __expf(d23) + 0.35550906759096f; lam = __uint_as_float(__builtin_amdgcn_readfirstlane(__float_as_uint(lam))); }
    const float one_m_li = 1.0f - 0.35550906759096f;
    __syncthreads();
    const float c1 = 0.125f * LOG2E;
    const int xcd = F.bid & 7, kk = F.bid >> 3;
    if (DPART)
    for (int it = F.bid; it < 256; it += F.G) {
        const int bh = (F.G == 256) ? 2 * xcd + (kk >> 4) : it >> 4, pr = (F.G == 256) ? (kk & 15) : (it & 15);
        const int b_ = bh >> 2, hd_ = bh & 3;
        for (int half = 0; half < 2; ++half) {
            Frame Fu = F; Fu.lane = fresh_lane();
            int b = b_, hd = hd_; asm volatile("" : "+s"(b), "+s"(hd));
            const int q0 = 256 * (half ? 31 - pr : pr);
            f32x16 O[4];
            attn_core<128, false>(Fu, Z, Vtg, b, Z_QD + 128 * hd, Z_KD + 128 * hd, VT_D + 128 * hd, q0, lut + (8 + hd) * AT_LUT_LD, c1, nullptr, O);
            {
                const int l1 = fresh_lane();
                float* o1p = O1s + (size_t)(b * SEQ + q0 + 32 * F.wave + (l1 & 31)) * 512 + 128 * hd + 4 * (l1 >> 5);
#pragma unroll
                for (int d = 0; d < 4; ++d)
#pragma unroll
                    for (int g = 0; g < 4; ++g) *(f32x4*)(o1p + 32 * d + 8 * g) = (f32x4){O[d][4 * g], O[d][4 * g + 1], O[d][4 * g + 2], O[d][4 * g + 3]};
            }
            Frame Fv = F; Fv.lane = fresh_lane();
            attn_core<128, false>(Fv, Z, Vtg, b, Z_QD + 128 * hd + 64, Z_KD + 128 * hd + 64, VT_D + 128 * hd, q0, lut + (8 + hd) * AT_LUT_LD, c1, nullptr, O);
            {
                const int l1 = fresh_lane();
                const int tq = q0 + 32 * F.wave + (l1 & 31), hh = l1 >> 5;
                const float* o1p = O1s + (size_t)(b * SEQ + tq) * 512 + 128 * hd + 4 * hh;
                float ss = 0.f;
#pragma unroll
                for (int d = 0; d < 4; ++d)
#pragma unroll
                    for (int g = 0; g < 4; ++g) {
                        const f32x4 o1 = *(const f32x4*)(o1p + 32 * d + 8 * g);
#pragma unroll
                        for (int e = 0; e < 4; ++e) { const float v = o1[e] - lam * O[d][4 * g + e]; O[d][4 * g + e] = v; ss += v * v; }
                    }
                ss += __shfl_xor(ss, 32);
                const float rinv = rsqrtf(ss * (1.0f / 128.0f) + EPS) * one_m_li;
                bf16_t* yp = Yo + (size_t)(b * SEQ + tq) * DM + 512 + 128 * hd + 4 * hh;
                const float* gp = a.diff_norm_g + 4 * hh;
#pragma unroll
                for (int d = 0; d < 4; ++d)
#pragma unroll
                    for (int g = 0; g < 4; ++g) {
                        const f32x4 gn = *(const f32x4*)(gp + 32 * d + 8 * g);
                        f32x4 v; v[0] = O[d][4 * g] * rinv * gn[0]; v[1] = O[d][4 * g + 1] * rinv * gn[1]; v[2] = O[d][4 * g + 2] * rinv * gn[2]; v[3] = O[d][4 * g + 3] * rinv * gn[3];
                        *(u32x2*)(yp + 32 * d + 8 * g) = pack4(v);
                    }
            }
        }
    }
    if (!DPART)
    for (int it = F.bid; it < 512; it += F.G) {
        const int rnd = it / F.G;
        const int bh = (F.G == 256) ? 4 * xcd + 2 * rnd + (kk >> 4) : it >> 4, pr = (F.G == 256) ? (kk & 15) : (it & 15);
        const int b_ = bh >> 3, hc_ = bh & 7;
        for (int half = 0; half < 2; ++half) {
            int b = b_, hc = hc_; asm volatile("" : "+s"(b), "+s"(hc));
            float fb = a.rel_bias[31 * 12 + hc] * LOG2E; fb = __uint_as_float(__builtin_amdgcn_readfirstlane(__float_as_uint(fb)));
            attn_c_unit(F, b, hc, half ? 31 - pr : pr, Z, Yo, maskg, fb);
        }
    }
}

#ifndef MK_ONE_LAUNCH
#define MK_ONE_LAUNCH 1
#endif
constexpr int NPH = 17;
__global__ void __launch_bounds__(NTHR, 2) fwd_kernel(Args a) {
    extern __shared__ __attribute__((aligned(16))) unsigned char lds_raw[];
    Frame F; F.lds = (LAS unsigned char*)lds_raw; F.tid = threadIdx.x; F.lane = F.tid & 63; F.wave = __builtin_amdgcn_readfirstlane(F.tid >> 6); F.G = gridDim.x; F.bid = blockIdx.x;
    unsigned* ctl = (unsigned*)(a.ws + WS_CTL);
    volatile LAS unsigned* xbw = (volatile LAS unsigned*)(F.lds + LDS_XB);
    if (F.tid < 4) xbw[F.tid] = 0u;
    __syncthreads();
    const int lo = a.ph_lo, hi = a.ph_hi;
    XcdBarrier bar; bar.bar = ctl + CW_BAR; bar.x = 0; bar.st = xbw;
    if (hi - lo > 1) bar = xcd_barrier_post(ctl + CW_BAR, xbw);
#ifndef PH_ONLY
#define IN(k) (lo <= (k) && (k) < hi)
#else
#define IN(k) ((k) == PH_ONLY && lo <= (k) && (k) < hi)
#endif
#ifndef DUP_PH
#define DUP_PH -1
#endif
#define REP(k) for (int rep_ = 0; rep_ < ((k) == DUP_PH ? 2 : 1); ++rep_)
#ifndef TIME_PH
#define TIME_PH -1
#endif
#define TIME_AMP 4
    unsigned long long tp0_ = 0, tp1_ = 0;
    if (TIME_PH == 0) tp0_ = wall_clock64();
#define SEAM(k) do { if (IN(k) && IN((k) + 1)) xcd_barrier(bar); if ((k) == TIME_PH) tp1_ = wall_clock64(); if ((k) + 1 == TIME_PH) tp0_ = wall_clock64(); } while (0)
    float* mod = (float*)(a.ws + WS_MOD);
    bf16_t* hbuf = (bf16_t*)(a.ws + WS_H);
    bf16_t* ybuf = (bf16_t*)(a.ws + WS_Y);
    LAS int* ntp = (LAS int*)(F.lds + LDS_MISC);

    if (IN(0)) REP(0) { p0_prologue(F, a); } SEAM(0);
    if (IN(1)) REP(1) { norm_phase<false, false, false>(F, a, a.x, 0, 0, 0); } SEAM(1);
    if (IN(2)) REP(2) {
        DenseSched S; S.init(NTOK, AB_N, DM, F.G, F.bid, a.ws + WS_WAB_IN);
        EpiAbIn E{(bf16_t*)(a.ws + WS_BIG)};
        pg8::gemm_phase(F.lds, (const char*)hbuf, DM, S, E);
    } SEAM(2);
    if (IN(3)) REP(3) { conv_phase(F, a); } SEAM(3);
    if (IN(4)) REP(4) {
        DenseSched S; S.init(NTOK, DM, DM, F.G, F.bid, a.ws + WS_WAB_OUT);
        EpiResid E{a.x, a.out, mod + 2 * DM};
        pg8::gemm_phase(F.lds, (const char*)ybuf, DM, S, E);
    } SEAM(4);
#define MOE_PHASES(layer, pb) do { \
        const unsigned* cnt = ctl + CW_CNT + (layer) * NEXP * CNT_STRIDE; \
        if (IN(pb)) { route_phase(F, a, (layer)); } SEAM(pb); \
        if (IN((pb) + 1)) REP((pb) + 1) { \
            moe_tile_table(F, cnt, ntp); \
            MoeSched<true> S; S.ntp = ntp; S.cnt = cnt; S.list = (const int*)(a.ws + WS_LIST); S.W = (const char*)(a.ws + WS_MOE_W); S.nU = 4 * ntp[NEXP]; S.G = F.G; S.c = F.bid; \
            EpiMoeUp E{(bf16_t*)(a.ws + WS_ACT)}; \
            pg8::gemm_phase(F.lds, (const char*)hbuf, DM, S, E); \
        } SEAM((pb) + 1); \
        if (IN((pb) + 2)) REP((pb) + 2) { \
            moe_tile_table(F, cnt, ntp); \
            MoeSched<false> S; S.ntp = ntp; S.cnt = cnt; S.list = nullptr; S.W = (const char*)(a.ws + WS_MOE_W); S.nU = 4 * ntp[NEXP]; S.G = F.G; S.c = F.bid; \
            EpiMoeDown E{(bf16_t*)(a.ws + WS_YMOE), (const float*)(a.ws + WS_GATEV), ntp}; \
            pg8::gemm_phase(F.lds, (const char*)(a.ws + WS_ACT), DEXP, S, E); \
        } SEAM((pb) + 2); } while (0)
    MOE_PHASES(0, 5);
    if (IN(8)) {
        norm_phase<true, false, false>(F, a, a.out, 1, 0, 0);
        cvt_run(F, a, 1, CVT_MOE_TILES);
    } SEAM(8);
    if (IN(9)) REP(9) {
        { DenseSched S; S.init(NTOK, CD_N, DM, F.G, F.bid, a.ws + WS_WCD_IN);
          EpiPlain E{(bf16_t*)(a.ws + WS_BIG), CD_N, 2, 0.125f * LOG2E};
          pg8::gemm_phase(F.lds, (const char*)hbuf, DM, S, E); }
        __syncthreads();
        { DenseSched S; S.init(VT_ROWS, NTOK, DM, F.G, F.bid, hbuf);
          EpiVt E{(bf16_t*)(a.ws + WS_VT)};
          pg8::gemm_phase(F.lds, (const char*)(a.ws + WS_WCD_IN + (size_t)CD_N * DM * 2), DM, S, E); }
    } SEAM(9);
    if (IN(10)) REP(10) { unsigned long long tacc_ = 0; topk_phase(F, a, tacc_); if (TIME_PH > 100 && TIME_PH < 110) { tp0_ = 0; tp1_ = tacc_; } } SEAM(10);
    if (IN(11)) REP(11) { if (TIME_PH == 111) { __syncthreads(); tp0_ = wall_clock64(); } attn_phase<true>(F, a); __syncthreads(); if (TIME_PH == 111) tp1_ = wall_clock64(); if (TIME_PH == 112) tp0_ = wall_clock64(); attn_phase<false>(F, a); if (TIME_PH == 112) { __syncthreads(); tp1_ = wall_clock64(); } } SEAM(11);
    if (IN(12)) {
        DenseSched S; S.init(NTOK, DM, DM, F.G, F.bid, a.ws + WS_WCD_OUT);
        EpiResid E{a.out, a.out, mod + (size_t)NB * 6 * DM + 2 * DM};
        pg8::gemm_phase(F.lds, (const char*)ybuf, DM, S, E);
    } SEAM(12);
    MOE_PHASES(1, 13);
#undef MOE_PHASES
    if (IN(16)) { norm_phase<true, false, true>(F, a, a.out, 1, 0, 1); }
    if (TIME_PH >= 0) {
        if (TIME_PH == 16) { asm volatile("s_waitcnt vmcnt(0)" ::: "memory"); __syncthreads(); tp1_ = wall_clock64(); }
        if (F.bid == 0 && F.tid == 0) { const unsigned long long te = wall_clock64(), dt = (tp1_ - tp0_) * TIME_AMP; while (wall_clock64() - te < dt) __builtin_amdgcn_s_sleep(8); }
    }
#undef IN
#undef SEAM
}

extern "C" void kernel_launch(void* const* d_in, const int* in_sizes, int n_in, void* d_out, int out_size, void* d_ws, size_t ws_size, hipStream_t stream) {
    static int grid = 0;
    if (grid == 0) {
        if (n_in != 26 || out_size != NTOK * DM || ws_size < WS_END) { fprintf(stderr, "kernel_launch: unexpected problem (n_in %d, out %d, ws %zu < %zu)\n", n_in, out_size, ws_size, (size_t)WS_END); grid = -1; return; }
        int dev = 0, cus = 0, per_cu = 0;
        if (hipGetDevice(&dev) != hipSuccess || hipDeviceGetAttribute(&cus, hipDeviceAttributeMultiprocessorCount, dev) != hipSuccess) { grid = -1; return; }
        if (hipFuncSetAttribute((const void*)fwd_kernel, hipFuncAttributeMaxDynamicSharedMemorySize, LDS_BYTES) != hipSuccess) { fprintf(stderr, "kernel_launch: hipFuncSetAttribute failed\n"); grid = -1; return; }
        if (hipOccupancyMaxActiveBlocksPerMultiprocessor(&per_cu, (const void*)fwd_kernel, NTHR, LDS_BYTES) != hipSuccess || per_cu < 1) { fprintf(stderr, "kernel_launch: occupancy query says %d\n", per_cu); }
        (void)hipGetLastError();
        grid = cus;
    }
    if (grid < 0) return;
    (void)hipMemsetAsync((char*)d_ws + WS_CTL, 0, CTL_BYTES, stream);
    Args a{};
    const float** fp = (const float**)&a.x;
    (void)fp;
    a.x = (const float*)d_in[0]; a.c = (const float*)d_in[1]; a.positions = (const int*)d_in[2]; a.rel_bias = (const float*)d_in[3]; a.norm_g = (const float*)d_in[4];
    a.final_norm_g = (const float*)d_in[5]; a.ada_w = (const float*)d_in[6]; a.ada_b = (const float*)d_in[7]; a.ab_w_in = (const float*)d_in[8]; a.ab_conv_a = (const float*)d_in[9];
    a.ab_conv_b = (const float*)d_in[10]; a.ab_conv_b_bias = (const float*)d_in[11]; a.ab_ln_g = (const float*)d_in[12]; a.ab_ln_b = (const float*)d_in[13]; a.ab_w_out = (const float*)d_in[14];
    a.cd_w_in = (const float*)d_in[15]; a.diff_lam = (const float*)d_in[16]; a.diff_norm_g = (const float*)d_in[17]; a.cd_w_out = (const float*)d_in[18];
    a.moe_wr_g = (const float*)d_in[19]; a.moe_br_g = (const float*)d_in[20]; a.moe_wr_e = (const float*)d_in[21]; a.moe_br_e = (const float*)d_in[22];
    a.moe_w_gate = (const float*)d_in[23]; a.moe_w_up = (const float*)d_in[24]; a.moe_w_down = (const float*)d_in[25];
    a.out = (float*)d_out; a.ws = (unsigned char*)d_ws;
#if MK_ONE_LAUNCH
    a.ph_lo = 0; a.ph_hi = NPH;
    hipLaunchKernelGGL(fwd_kernel, dim3(grid), dim3(NTHR), LDS_BYTES, stream, a);
#else
    for (int p = 0; p < NPH; ++p) { a.ph_lo = p; a.ph_hi = p + 1; hipLaunchKernelGGL(fwd_kernel, dim3(grid), dim3(NTHR), LDS_BYTES, stream, a); }
#endif
}
```

```cpp
#include <hip/hip_runtime.h>
#include <cstdio>
#include <cstdint>

#ifndef TIME_PH
#define TIME_PH -1
#endif
#define LAS __attribute__((address_space(3)))
#define DI __device__ __forceinline__
typedef unsigned short bf16_t;
typedef short bf16x8 __attribute__((ext_vector_type(8)));
typedef short s16x4 __attribute__((ext_vector_type(4)));
typedef float f32x2 __attribute__((ext_vector_type(2)));
typedef float f32x4 __attribute__((ext_vector_type(4)));
typedef float f32x16 __attribute__((ext_vector_type(16)));
typedef unsigned u32x2 __attribute__((ext_vector_type(2)));
typedef unsigned u32x4 __attribute__((ext_vector_type(4)));
typedef __bf16 bf16v2 __attribute__((ext_vector_type(2)));

constexpr int NB = 4, SEQ = 8192, DM = 1024, NTOK = NB * SEQ;
constexpr int NTHR = 512, NWAVE = 8;
constexpr int AB_N = 2560;
constexpr int ZC_N = 1536;
constexpr int CD_SRC_N = 3368;
constexpr int CD_N = 3584;
constexpr int Z_QC = 0, Z_KC = 512, Z_QD = 1024, Z_KD = 1536, Z_QI = 2048, Z_KI = 2304, Z_WI = 2336, Z_VC = 2560, Z_VD = 3072;
constexpr int VT_ROWS = 0;
constexpr int NEXP = 32, DEXP = 512;
constexpr int MOE_ROWS = 2 * NTOK + NEXP * 256;
constexpr float EPS = 1e-6f;
constexpr float LOG2E = 1.4426950408889634f;

constexpr size_t MiB = 1u << 20;
constexpr size_t WS_CTL = 0, CTL_BYTES = 64 * 1024;
constexpr size_t WS_MOD = 1 * MiB;
constexpr size_t WS_WAB_IN = 2 * MiB;
constexpr size_t WS_WAB_OUT = 7 * MiB;
constexpr size_t WS_WCD_IN = 9 * MiB;
constexpr size_t WS_WCD_OUT = 16 * MiB;
constexpr size_t WS_MOE_W = 18 * MiB;
constexpr size_t WS_H = 114 * MiB;
constexpr size_t WS_Y = 178 * MiB;
constexpr size_t WS_BIG = 242 * MiB;
constexpr size_t WS_ACT = WS_BIG;
constexpr size_t WS_YMOE = WS_BIG + 72 * MiB;
constexpr size_t WS_MASK = 466 * MiB;
constexpr size_t WS_LIST = 498 * MiB;
constexpr size_t WS_GATEV = 502 * MiB;
constexpr size_t WS_TOKSLOT = 506 * MiB;
constexpr size_t WS_END = 507 * MiB;

constexpr int CW_BAR = 0;
constexpr int CW_CNT = 4096;
constexpr int CNT_STRIDE = 64;

DI unsigned pack_bf16(float lo, float hi) { f32x2 v = {lo, hi}; bf16v2 b = __builtin_convertvector(v, bf16v2); return __builtin_bit_cast(unsigned, b); }
DI float bf_lo(unsigned w) { return __uint_as_float(w << 16); }
DI float bf_hi(unsigned w) { return __uint_as_float(w & 0xffff0000u); }
DI float bf2f(bf16_t b) { return __uint_as_float(((unsigned)b) << 16); }
DI float wave_sum(float v) {
#pragma unroll
    for (int o = 32; o >= 1; o >>= 1) v += __shfl_xor(v, o);
    return v;
}
DI int fresh_lane() { int l; asm volatile("v_mbcnt_lo_u32_b32 %0, -1, 0\n\tv_mbcnt_hi_u32_b32 %0, -1, %0" : "=v"(l)); return l; }
DI float silu_f(float v) { return v / (1.0f + __expf(-v)); }
DI float sigmoid_f(float v) { return 1.0f / (1.0f + __expf(-v)); }

#define XB_TMO      128
#define XB_XCNT(j)  (256  + 64 * (j))
#define XB_XSUB(j)  (1280 + 64 * (j))
#define XB_XGEN(j)  (2304 + 64 * (j))
#define XB_TOP      3328
#define XB_TOPGEN   3392
#define XCD_BAR_WORDS 3456
#define XB_SPIN_CAP (1u << 22)
DI unsigned xb_ld(unsigned* p)              { return __hip_atomic_load(p, __ATOMIC_RELAXED, __HIP_MEMORY_SCOPE_AGENT); }
DI unsigned xb_add(unsigned* p, unsigned v) { return __hip_atomic_fetch_add(p, v, __ATOMIC_RELAXED, __HIP_MEMORY_SCOPE_AGENT); }
DI unsigned xb_xcc_id() { return (unsigned)__builtin_amdgcn_s_getreg((3 << 11) | 20) & 0xFu; }
#define XB_SPIN(cond, bar) do { unsigned _sp = 0; while (cond) { __builtin_amdgcn_s_sleep(1); \
    if ((++_sp & 255u) == 0u) { if (xb_ld(&(bar)[XB_TMO])) break; if (_sp > XB_SPIN_CAP) { atomicAdd(&(bar)[XB_TMO], 1u); break; } } } } while (0)
struct XcdBarrier { unsigned* bar; unsigned x; volatile LAS unsigned* st; };
DI XcdBarrier xcd_barrier_post(unsigned* bar, volatile LAS unsigned* st) {
    XcdBarrier b; b.bar = bar; b.x = xb_xcc_id(); b.st = st;
    if (threadIdx.x == 0) (void)xb_add(&bar[XB_XCNT(b.x)], 1u);
    return b;
}
DI void xcd_barrier_complete(unsigned* bar, unsigned x, unsigned& nloc, unsigned& nx) {
    const unsigned G = gridDim.x * gridDim.y * gridDim.z;
    unsigned sum, cnt, mine, sp = 0u;
    for (;;) {
        sum = 0u; cnt = 0u; mine = 0u;
#pragma unroll
        for (unsigned j = 0; j < 16; ++j) { const unsigned c = xb_ld(&bar[XB_XCNT(j)]); sum += c; cnt += (c > 0u) ? 1u : 0u; mine = (j == x) ? c : mine; }
        if (sum == G) break;
        __builtin_amdgcn_s_sleep(1);
        if ((++sp & 255u) == 0u) { if (xb_ld(&bar[XB_TMO])) break; if (sp > XB_SPIN_CAP) { atomicAdd(&bar[XB_TMO], 1u); break; } }
    }
    nloc = mine > 0u ? mine : 1u; nx = cnt > 0u ? cnt : 1u;
}
DI void xcd_barrier(const XcdBarrier& b) {
    asm volatile("s_waitcnt vmcnt(0)" ::: "memory");
    __syncthreads();
    if (threadIdx.x == 0) {
        unsigned* bar = b.bar;
        __builtin_amdgcn_s_waitcnt(0);
        unsigned nloc = b.st[0], nx = b.st[1];
        if (nloc == 0u) { xcd_barrier_complete(bar, b.x, nloc, nx); b.st[0] = nloc; b.st[1] = nx; }
        const unsigned old = xb_add(&bar[XB_XSUB(b.x)], 1u);
        const unsigned gen = old / nloc;
        if (old + 1u == (gen + 1u) * nloc) {
            __builtin_amdgcn_fence(__ATOMIC_RELEASE, "agent");
            asm volatile("s_waitcnt vmcnt(0)" ::: "memory");
            const unsigned og = xb_add(&bar[XB_TOP], 1u);
            const unsigned tg = og / nx;
            if (og + 1u == (tg + 1u) * nx) xb_add(&bar[XB_TOPGEN], 1u);
            else XB_SPIN(xb_ld(&bar[XB_TOPGEN]) == tg, bar);
            __builtin_amdgcn_fence(__ATOMIC_ACQUIRE, "agent");
            xb_add(&bar[XB_XGEN(b.x)], 1u);
            asm volatile("s_waitcnt vmcnt(0)" ::: "memory");
        } else {
            XB_SPIN(xb_ld(&bar[XB_XGEN(b.x)]) == gen, bar);
            __builtin_amdgcn_fence(__ATOMIC_ACQUIRE, "agent");
            asm volatile("s_waitcnt vmcnt(0)" ::: "memory");
        }
    }
    __syncthreads();
}

namespace pg8 {
constexpr int BM = 256, BK = 64, HALF = 128, HTB = HALF * BK * 2, STAGE_BYTES = 8 * HTB;
DI int lds_byte(int r, int c) { const int st = (r >> 4) * 2 + (c >> 5), rr = r & 15, cc = c & 31, ob = rr * 64 + cc * 2; return st * 1024 + (ob ^ (((ob >> 9) & 1) << 5)); }
DI void stage_rc(int b, int& R, int& C) { const int st = b / 1024, sb = b % 1024, swz = sb ^ (((sb >> 9) & 1) << 5); R = (st >> 1) * 16 + swz / 64; C = (st & 1) * 32 + (swz % 64) / 2; }
struct Unit { int pm, pn, e, nrow; };

template <class Epi, class Sched>
DI void gemm_phase(LAS unsigned char* lds, const char* Abase, const int K, const Sched& S, const Epi& E) {
    const int tid = threadIdx.x, wid = __builtin_amdgcn_readfirstlane(tid >> 6), lane = tid & 63, wr = wid >> 2, wc = wid & 3, fr = lane & 15, fq = lane >> 4;
    const int nt = K / BK;
    int Rr[2], Cc[2]; unsigned voffB[2];
#pragma unroll
    for (int i = 0; i < 2; ++i) { int R, C; stage_rc(tid * 16 + i * 8192, R, C); Rr[i] = R; Cc[i] = C; voffB[i] = (unsigned)(R * K + C) * 2u; }
    const size_t kstep = (size_t)(BK * 2);
    const size_t hstep = (size_t)HALF * K * 2;
    const unsigned ldsw = (unsigned)wid * 1024u;
    const int aoff = lds_byte(wr * 64 + fr, fq * 8), boff = lds_byte(wc * 32 + fr, fq * 8);
#define PG8_SA(b, h) (((b) * 2 + (h)) * HTB)
#define PG8_SB(b, h) ((4 + (b) * 2 + (h)) * HTB)
#define PG8_STAGE(bufoff, gbase, voff) do { _Pragma("unroll") for (int _i = 0; _i < 2; ++_i) \
        __builtin_amdgcn_global_load_lds((const unsigned*)((const char*)(gbase) + (voff)[_i]), (LAS unsigned*)(lds + (bufoff) + ldsw + _i * 8192), 16, 0, 0); } while (0)
#define PG8_AOFF(dst, u) do { _Pragma("unroll") for (int _h = 0; _h < 2; ++_h) _Pragma("unroll") for (int _i = 0; _i < 2; ++_i) \
        dst[_h][_i] = ((unsigned)S.a_row(u, _h * HALF + Rr[_i]) * (unsigned)K + (unsigned)Cc[_i]) * 2u; } while (0)
#define PG8_LDA(dst, b, h) do { _Pragma("unroll") for (int m = 0; m < 4; ++m) _Pragma("unroll") for (int k = 0; k < 2; ++k) dst[m][k] = *(const LAS bf16x8*)(lds + PG8_SA(b, h) + aoff + m * 2048 + k * 1024); } while (0)
#define PG8_LDB(dst, b, h) do { _Pragma("unroll") for (int n = 0; n < 2; ++n) _Pragma("unroll") for (int k = 0; k < 2; ++k) dst[n][k] = *(const LAS bf16x8*)(lds + PG8_SB(b, h) + boff + n * 2048 + k * 1024); } while (0)
#define PG8_MMA(ai, bj, At, Bt) do { __builtin_amdgcn_s_setprio(1); _Pragma("unroll") for (int m = 0; m < 4; ++m) _Pragma("unroll") for (int n = 0; n < 2; ++n) _Pragma("unroll") for (int k = 0; k < 2; ++k) \
        acc[ai][bj][m][n] = __builtin_amdgcn_mfma_f32_16x16x32_bf16(Bt[n][k], At[m][k], acc[ai][bj][m][n], 0, 0, 0); __builtin_amdgcn_s_setprio(0); } while (0)
#define PG8_WAIT_V(n) asm volatile("s_waitcnt vmcnt(" #n ")" ::: "memory")
#define PG8_WAIT_L(n) asm volatile("s_waitcnt lgkmcnt(" #n ")" ::: "memory")
#define PG8_BAR __builtin_amdgcn_s_barrier()
#define PG8_SCHED __builtin_amdgcn_sched_barrier(0)
    Unit cur, nxt; int ui = 0;
    if (!S.next(0, cur)) return;
    f32x4 acc[2][2][4][2];
#pragma unroll
    for (int a = 0; a < 2; ++a)
#pragma unroll
        for (int b = 0; b < 2; ++b)
#pragma unroll
            for (int m = 0; m < 4; ++m)
#pragma unroll
                for (int n = 0; n < 2; ++n) acc[a][b][m][n] = (f32x4){0.f, 0.f, 0.f, 0.f};
    bf16x8 At[4][2], B0[2][2], B1[2][2];
    unsigned aoC[2][2], aoN[2][2];
    PG8_AOFF(aoC, cur);
    const char* cB = S.b_base(cur);
    PG8_STAGE(PG8_SB(0, 0), cB, voffB); PG8_STAGE(PG8_SA(0, 0), Abase, aoC[0]); PG8_STAGE(PG8_SB(0, 1), cB + hstep, voffB); PG8_STAGE(PG8_SA(0, 1), Abase, aoC[1]);
    if (wr == 1) PG8_BAR;
    PG8_WAIT_V(4); PG8_BAR;
    PG8_STAGE(PG8_SB(1, 0), cB + kstep, voffB); PG8_STAGE(PG8_SA(1, 0), Abase + kstep, aoC[0]); PG8_STAGE(PG8_SB(1, 1), cB + hstep + kstep, voffB);
    PG8_WAIT_V(6); PG8_BAR;
    for (;;) {
        const bool has_next = S.next(ui + 1, nxt);
        const char* nB = cB;
#pragma unroll
        for (int _h = 0; _h < 2; ++_h)
#pragma unroll
            for (int _i = 0; _i < 2; ++_i) aoN[_h][_i] = aoC[_h][_i];
        if (has_next) { PG8_AOFF(aoN, nxt); nB = S.b_base(nxt); }
        for (int t = 0; t < nt; t += 2) {
            const bool last = (t == nt - 2);
            const char* a1 = Abase + (size_t)(t + 1) * kstep;
            const char* a2 = last ? Abase : Abase + (size_t)(t + 2) * kstep; const char* b2 = last ? nB : cB + (size_t)(t + 2) * kstep;
            const char* a3 = a2 + kstep; const char* b3 = b2 + kstep;
            unsigned ao2[2][2];
#pragma unroll
            for (int _h = 0; _h < 2; ++_h)
#pragma unroll
                for (int _i = 0; _i < 2; ++_i) ao2[_h][_i] = last ? aoN[_h][_i] : aoC[_h][_i];
            PG8_LDB(B0, 0, 0); PG8_SCHED; PG8_LDA(At, 0, 0); PG8_STAGE(PG8_SA(1, 1), a1, aoC[1]);
            PG8_WAIT_L(8); PG8_BAR; PG8_WAIT_L(0); PG8_MMA(0, 0, At, B0); PG8_BAR; PG8_SCHED;
            PG8_LDB(B1, 0, 1); PG8_STAGE(PG8_SB(0, 0), b2, voffB);
            PG8_BAR; PG8_WAIT_L(0); PG8_MMA(0, 1, At, B1); PG8_BAR;
            PG8_LDA(At, 0, 1); PG8_STAGE(PG8_SA(0, 0), a2, ao2[0]);
            PG8_BAR; PG8_WAIT_L(0); PG8_MMA(1, 0, At, B0); PG8_BAR; PG8_SCHED;
            PG8_STAGE(PG8_SB(0, 1), b2 + hstep, voffB);
            PG8_WAIT_V(6); PG8_BAR; PG8_MMA(1, 1, At, B1); PG8_BAR;
            PG8_LDB(B0, 1, 0); PG8_SCHED; PG8_LDA(At, 1, 0); PG8_STAGE(PG8_SA(0, 1), a2, ao2[1]);
            PG8_WAIT_L(8); PG8_BAR; PG8_WAIT_L(0); PG8_MMA(0, 0, At, B0); PG8_BAR; PG8_SCHED;
            PG8_LDB(B1, 1, 1); PG8_STAGE(PG8_SB(1, 0), b3, voffB);
            PG8_BAR; PG8_WAIT_L(0); PG8_MMA(0, 1, At, B1); PG8_BAR;
            PG8_LDA(At, 1, 1); PG8_STAGE(PG8_SA(1, 0), a3, ao2[0]);
            PG8_BAR; PG8_WAIT_L(0); PG8_MMA(1, 0, At, B0); PG8_BAR; PG8_SCHED;
            PG8_STAGE(PG8_SB(1, 1), b3 + hstep, voffB);
            PG8_WAIT_V(6); PG8_BAR; PG8_MMA(1, 1, At, B1); PG8_BAR;
        }
        E(acc, cur, wr, wc, fr, fq);
        if (!has_next) break;
#pragma unroll
        for (int a = 0; a < 2; ++a)
#pragma unroll
            for (int b = 0; b < 2; ++b)
#pragma unroll
                for (int m = 0; m < 4; ++m)
#pragma unroll
                    for (int n = 0; n < 2; ++n) acc[a][b][m][n] = (f32x4){0.f, 0.f, 0.f, 0.f};
        cur = nxt; cB = nB; ++ui;
#pragma unroll
        for (int _h = 0; _h < 2; ++_h)
#pragma unroll
            for (int _i = 0; _i < 2; ++_i) aoC[_h][_i] = aoN[_h][_i];
    }
    PG8_WAIT_V(0);
    if (wr == 0) PG8_BAR;
    PG8_BAR;
#undef PG8_SA
#undef PG8_SB
#undef PG8_STAGE
#undef PG8_AOFF
#undef PG8_LDA
#undef PG8_LDB
#undef PG8_MMA
#undef PG8_WAIT_V
#undef PG8_WAIT_L
#undef PG8_BAR
#undef PG8_SCHED
}
}

struct Args {
    const float* x; const float* c; const int* positions; const float* rel_bias; const float* norm_g; const float* final_norm_g;
    const float* ada_w; const float* ada_b; const float* ab_w_in; const float* ab_conv_a; const float* ab_conv_b; const float* ab_conv_b_bias;
    const float* ab_ln_g; const float* ab_ln_b; const float* ab_w_out; const float* cd_w_in; const float* diff_lam; const float* diff_norm_g;
    const float* cd_w_out; const float* moe_wr_g; const float* moe_br_g; const float* moe_wr_e; const float* moe_br_e;
    const float* moe_w_gate; const float* moe_w_up; const float* moe_w_down;
    float* out; unsigned char* ws; int ph_lo, ph_hi;
};
struct Frame {
    LAS unsigned char* lds; int tid, lane, wave, G, bid;
};

struct RowSrc { const float* p; int ld; };
DI int perm32(int rho) { const int n = rho >> 4, i = rho & 15; return 8 * (i >> 2) + 4 * n + (i & 3); }
DI int permrow(int r) { return (r & ~31) + perm32(r & 31); }
DI void ilv(int rp, int& j, int& second) { const int U = rp >> 8, ru = rp & 255, bj = ru >> 7, wc = (ru >> 5) & 3, n = (ru >> 4) & 1, fq = (ru >> 2) & 3, e = ru & 3; j = 128 * U + 32 * wc + 8 * fq + 4 * bj + e; second = n; }

enum { CV_AB_IN = 0, CV_AB_OUT = 1, CV_CD_IN = 2, CV_CD_OUT = 3, CV_MOE_GU = 4, CV_MOE_D = 5 };
template <int KIND> DI RowSrc row_src(const Args& a, int layer, int e, int r) {
    RowSrc s; s.p = nullptr; s.ld = 0;
    if (KIND == CV_AB_IN) {
        s.ld = AB_N;
        if (r < 512) s.p = a.ab_w_in + permrow(r);
        else if (r < 1536) { int j, sec; ilv(r - 512, j, sec); s.p = a.ab_w_in + (sec ? 1024 + j : 512 + j); }
        else { int j, sec; ilv(r - 1536, j, sec); s.p = a.ab_w_in + (sec ? 2048 + j : 1536 + j); }
    } else if (KIND == CV_AB_OUT) { s.ld = DM; s.p = a.ab_w_out + r; }
    else if (KIND == CV_CD_IN) {
        s.ld = CD_SRC_N;
        int col = -1;
        if (r < CD_N) r = permrow(r);
        if (r < 1024) col = r;
        else if (r < 2048) col = 1832 + (r - 1024);
        else if (r < 2304) col = 1536 + (r - 2048);
        else if (r < 2336) col = 1792 + (r - 2304);
        else if (r < 2344) col = 1824 + (r - 2336);
        else if (r < 2560) col = -1;
        else if (r < 3072) col = 1024 + (r - 2560);
        else col = 2856 + (r - 3072);
        if (col >= 0) s.p = a.cd_w_in + col;
    } else if (KIND == CV_CD_OUT) { s.ld = DM; s.p = a.cd_w_out + r; }
    else if (KIND == CV_MOE_GU) {
        int j, sec; ilv(r, j, sec); s.ld = DEXP;
        const size_t base = ((size_t)layer * NEXP + e) * (size_t)DM * DEXP;
        s.p = (sec ? a.moe_w_up : a.moe_w_gate) + base + j;
    } else {
        s.ld = DM; s.p = a.moe_w_down + ((size_t)layer * NEXP + e) * (size_t)DEXP * DM + permrow(r);
    }
    return s;
}
constexpr int CV_LD = 258;
struct CvtTile { const float* sp; int ld; bf16_t* dst; int K, r0, k0; };
template <int KIND> DI CvtTile cvt_desc(const Frame& F, const Args& a, bf16_t* dst, int K, int r0, int k0, int layer, int e) {
    const RowSrc s = row_src<KIND>(a, layer, e, r0 + 4 * (F.tid & 15));
    CvtTile t; t.sp = s.p; t.ld = s.ld; t.dst = dst; t.K = K; t.r0 = r0; t.k0 = k0; return t;
}
constexpr int CVT_DENSE_TILES = (AB_N + DM + CD_N + VT_ROWS + DM) / 64 * (DM / 256);
constexpr int CVT_MOE_TILES_PER_EXP = (1024 / 64) * (1024 / 256) + (1024 / 64) * (512 / 256);
constexpr int CVT_MOE_TILES = NEXP * CVT_MOE_TILES_PER_EXP;
DI CvtTile cvt_dense_desc(const Frame& F, const Args& a, int item) {
    const int rt = item >> 2, kt = item & 3;
    int r = rt * 64;
    if (r < AB_N) return cvt_desc<CV_AB_IN>(F, a, (bf16_t*)(a.ws + WS_WAB_IN), DM, r, kt * 256, 0, 0);
    r -= AB_N;
    if (r < DM) return cvt_desc<CV_AB_OUT>(F, a, (bf16_t*)(a.ws + WS_WAB_OUT), DM, r, kt * 256, 0, 0);
    r -= DM;
    if (r < CD_N + VT_ROWS) return cvt_desc<CV_CD_IN>(F, a, (bf16_t*)(a.ws + WS_WCD_IN), DM, r, kt * 256, 0, 0);
    r -= CD_N + VT_ROWS;
    return cvt_desc<CV_CD_OUT>(F, a, (bf16_t*)(a.ws + WS_WCD_OUT), DM, r, kt * 256, 0, 0);
}
DI CvtTile cvt_moe_desc(const Frame& F, const Args& a, int layer, int item) {
    const int e = item / CVT_MOE_TILES_PER_EXP, t = item % CVT_MOE_TILES_PER_EXP;
    bf16_t* base = (bf16_t*)(a.ws + WS_MOE_W + (size_t)e * 3 * MiB);
    if (t < 64) return cvt_desc<CV_MOE_GU>(F, a, base, DM, (t >> 2) * 64, (t & 3) * 256, layer, e);
    const int t2 = t - 64; return cvt_desc<CV_MOE_D>(F, a, base + (size_t)DM * DM, DEXP, (t2 >> 1) * 64, (t2 & 1) * 256, layer, e);
}
DI void cvt_load(const Frame& F, const CvtTile& t, f32x4 (&v)[8]) {
#pragma unroll
    for (int it = 0; it < 8; ++it) {
        const int kk = (F.tid >> 4) + 32 * it;
        v[it] = (f32x4){0.f, 0.f, 0.f, 0.f};
        if (t.sp) v[it] = *(const f32x4*)(t.sp + (size_t)(t.k0 + kk) * t.ld);
    }
}
DI void cvt_store(const Frame& F, const CvtTile& t, const f32x4 (&v)[8]) {
    LAS bf16_t* T = (LAS bf16_t*)F.lds;
    const int c4 = F.tid & 15;
#pragma unroll
    for (int it = 0; it < 8; ++it) {
        const int kk = (F.tid >> 4) + 32 * it;
        const unsigned p01 = pack_bf16(v[it][0], v[it][1]), p23 = pack_bf16(v[it][2], v[it][3]);
        T[(4 * c4 + 0) * CV_LD + kk] = (bf16_t)(p01 & 0xffffu); T[(4 * c4 + 1) * CV_LD + kk] = (bf16_t)(p01 >> 16);
        T[(4 * c4 + 2) * CV_LD + kk] = (bf16_t)(p23 & 0xffffu); T[(4 * c4 + 3) * CV_LD + kk] = (bf16_t)(p23 >> 16);
    }
    __syncthreads();
    {
        const int rr = F.tid >> 3, c = F.tid & 7;
#pragma unroll
        for (int j = 0; j < 4; ++j) {
            const LAS unsigned* src = (const LAS unsigned*)(T + rr * CV_LD + 64 * j + c * 8);
            u32x4 w; w[0] = src[0]; w[1] = src[1]; w[2] = src[2]; w[3] = src[3];
            *(u32x4*)(t.dst + (size_t)(t.r0 + rr) * t.K + t.k0 + 64 * j + c * 8) = w;
        }
    }
    __syncthreads();
}
DI CvtTile cvt_any_desc(const Frame& F, const Args& a, int which, int item) {
    if (which == 0) { if (item < CVT_DENSE_TILES) return cvt_dense_desc(F, a, item); return cvt_moe_desc(F, a, 0, item - CVT_DENSE_TILES); }
    return cvt_moe_desc(F, a, 1, item);
}
DI void cvt_run(const Frame& F, const Args& a, int which, int n_items) {
    int it = F.bid;
    if (it >= n_items) return;
    CvtTile t0 = cvt_any_desc(F, a, which, it), t1 = t0, t2 = t0;
    f32x4 v0[8], v1[8], v2[8];
    cvt_load(F, t0, v0);
    bool h1 = it + F.G < n_items, h2 = it + 2 * F.G < n_items;
    if (h1) { t1 = cvt_any_desc(F, a, which, it + F.G); cvt_load(F, t1, v1); }
    for (;;) {
        h2 = it + 2 * F.G < n_items;
        if (h2) { t2 = cvt_any_desc(F, a, which, it + 2 * F.G); cvt_load(F, t2, v2); }
        cvt_store(F, t0, v0);
        if (!h1) break;
        it += F.G; t0 = t1; t1 = t2; h1 = h2;
#pragma unroll
        for (int i = 0; i < 8; ++i) { v0[i] = v1[i]; v1[i] = v2[i]; }
    }
}
DI void mod_item(const Frame& F, const Args& a, int item) {
    LAS float* sc = (LAS float*)F.lds;
    LAS float* part = (LAS float*)(F.lds + 16384);
    for (int i = F.tid; i < NB * DM; i += NTHR) sc[i] = silu_f(a.c[i]);
    __syncthreads();
    const int l = item / 96, j = (item % 96) * 64 + F.lane;
    const float* w = a.ada_w + (size_t)l * DM * 6 * DM + (size_t)(F.wave * 128) * 6 * DM + j;
    float acc[NB] = {0.f, 0.f, 0.f, 0.f};
#pragma unroll 8
    for (int k = 0; k < 128; ++k) {
        const float wv = w[(size_t)k * 6 * DM];
#pragma unroll
        for (int b = 0; b < NB; ++b) acc[b] += sc[b * DM + F.wave * 128 + k] * wv;
    }
#pragma unroll
    for (int b = 0; b < NB; ++b) part[(F.wave * NB + b) * 64 + F.lane] = acc[b];
    __syncthreads();
    if (F.tid < NB * 64) {
        const int b = F.tid >> 6, c = F.tid & 63;
        float sum = 0.f;
#pragma unroll
        for (int wv = 0; wv < NWAVE; ++wv) sum += part[(wv * NB + b) * 64 + c];
        const int jj = (item % 96) * 64 + c;
        float* mod = (float*)(a.ws + WS_MOD);
        mod[((size_t)l * NB + b) * 6 * DM + jj] = sum + a.ada_b[l * 6 * DM + jj];
    }
    __syncthreads();
}
DI void p0_prologue(const Frame& F, const Args& a) {
    for (int it = F.bid; it < 192; it += F.G) mod_item(F, a, it);
    cvt_run(F, a, 0, CVT_DENSE_TILES + CVT_MOE_TILES);
}

constexpr int WR_LD = 1028;
DI void moe_seg_table(const Frame& F, const unsigned* cnt, LAS int* seg  ) {
    if (F.tid < NEXP) seg[40 + F.tid] = (int)cnt[F.tid * CNT_STRIDE];
    __syncthreads();
    if (F.tid == 0) { int s = 0; for (int e = 0; e < NEXP; ++e) { seg[e] = s; s += ((seg[40 + e] + 255) >> 8) << 8; } seg[NEXP] = s; }
    __syncthreads();
}
template <bool COMBINE, bool ROUTE, bool FINAL>
DI void norm_phase(const Frame& F, const Args& a, const float* xsrc, int layer, int which, int layer_c) {
    const float* mod = (const float*)(a.ws + WS_MOD);
    bf16_t* hbuf = (bf16_t*)(a.ws + WS_H);
    unsigned* ctl = (unsigned*)(a.ws + WS_CTL);
    LAS float* wrT = (LAS float*)F.lds;
    LAS float* brs = (LAS float*)(F.lds + 36 * WR_LD * 4);
    LAS int* seg = (LAS int*)F.lds;
    constexpr int RT_CAP = 512;
    LAS int* rcnt = (LAS int*)(F.lds + 149504);
    LAS int* rbase = (LAS int*)(F.lds + 149632);
    LAS int* rt_er = (LAS int*)(F.lds + 149760);
    LAS float* rt_gate = (LAS float*)(F.lds + 149760 + 4096);
    LAS int* rt_tok = (LAS int*)(F.lds + 149760 + 8192);
    if (ROUTE) {
        const float* wg = a.moe_wr_g + (size_t)layer * DM * 4;
        const float* we = a.moe_wr_e + (size_t)layer * DM * 32;
        for (int i = F.tid; i < DM * 4; i += NTHR) { const int k = i >> 2, j = i & 3; wrT[j * WR_LD + k] = wg[i]; }
        for (int i = F.tid; i < DM * 32; i += NTHR) { const int k = i >> 5, j = i & 31; wrT[(4 + j) * WR_LD + k] = we[i]; }
        if (F.tid < NEXP) rcnt[F.tid] = 0;
        for (int i = F.tid; i < 2 * RT_CAP; i += NTHR) rt_er[i] = -1;
        if (F.tid < 4) brs[F.tid] = a.moe_br_g[layer * 4 + F.tid];
        else if (F.tid < 36) brs[F.tid] = a.moe_br_e[layer * 32 + F.tid - 4];
        __syncthreads();
    }
    if (COMBINE) moe_seg_table(F, ctl + CW_CNT + layer_c * NEXP * CNT_STRIDE, seg);
    const bf16_t* ymoe = (const bf16_t*)(a.ws + WS_YMOE);
    const int* tokslot = (const int*)(a.ws + WS_TOKSLOT);
    constexpr int TPW = ROUTE ? 2 : 4;
    for (int tb = (F.bid * NWAVE + F.wave) * TPW; tb < NTOK; tb += F.G * NWAVE * TPW) {
      const int b = tb / SEQ;
      f32x4 xall[TPW][4];
#pragma unroll
      for (int i = 0; i < TPW; ++i)
#pragma unroll
        for (int c = 0; c < 4; ++c) xall[i][c] = *(const f32x4*)(xsrc + (size_t)(tb + i) * DM + c * 256 + F.lane * 4);
      if (COMBINE) {
        int ts[TPW][2];
#pragma unroll
        for (int i = 0; i < TPW; ++i) { ts[i][0] = tokslot[(tb + i) * 2]; ts[i][1] = tokslot[(tb + i) * 2 + 1]; }
        u32x2 yv[TPW][2][4];
#pragma unroll
        for (int i = 0; i < TPW; ++i)
#pragma unroll
          for (int k = 0; k < 2; ++k) {
            const size_t r = (size_t)(seg[ts[i][k] >> 20] + (ts[i][k] & 0xfffff));
#pragma unroll
            for (int c = 0; c < 4; ++c) yv[i][k][c] = *(const u32x2*)(ymoe + r * DM + c * 256 + F.lane * 4);
          }
        const float* g2 = mod + ((size_t)layer_c * NB + b) * 6 * DM + 5 * DM;
#pragma unroll
        for (int c = 0; c < 4; ++c) {
          const int col = c * 256 + F.lane * 4;
          const f32x4 gv = *(const f32x4*)(g2 + col);
#pragma unroll
          for (int i = 0; i < TPW; ++i) {
            const u32x2 y0 = yv[i][0][c], y1 = yv[i][1][c];
            xall[i][c][0] += gv[0] * (bf_lo(y0[0]) + bf_lo(y1[0])); xall[i][c][1] += gv[1] * (bf_hi(y0[0]) + bf_hi(y1[0]));
            xall[i][c][2] += gv[2] * (bf_lo(y0[1]) + bf_lo(y1[1])); xall[i][c][3] += gv[3] * (bf_hi(y0[1]) + bf_hi(y1[1]));
            if (!FINAL) *(f32x4*)(a.out + (size_t)(tb + i) * DM + col) = xall[i][c];
          }
        }
      }
#pragma unroll
      for (int ti = 0; ti < TPW; ++ti) {
        const int tok = tb + ti;
        f32x4 xv[4];
#pragma unroll
        for (int c = 0; c < 4; ++c) xv[c] = xall[ti][c];
        float ss = 0.f;
#pragma unroll
        for (int c = 0; c < 4; ++c) ss += xv[c][0] * xv[c][0] + xv[c][1] * xv[c][1] + xv[c][2] * xv[c][2] + xv[c][3] * xv[c][3];
        ss = wave_sum(ss);
        const float rinv = rsqrtf(ss * (1.0f / DM) + EPS);
        if (FINAL) {
#pragma unroll
            for (int c = 0; c < 4; ++c) {
                const int col = c * 256 + F.lane * 4;
                const f32x4 g = *(const f32x4*)(a.final_norm_g + col);
                f32x4 o; o[0] = xv[c][0] * rinv * g[0]; o[1] = xv[c][1] * rinv * g[1]; o[2] = xv[c][2] * rinv * g[2]; o[3] = xv[c][3] * rinv * g[3];
                *(f32x4*)(a.out + (size_t)tok * DM + col) = o;
            }
            continue;
        }
        const float* ng = a.norm_g + ((size_t)layer * 2 + which) * DM;
        const float* sh = mod + ((size_t)layer * NB + b) * 6 * DM + (which ? 3 : 0) * DM;
        const float* sc = sh + DM;
        f32x4 hv[4];
#pragma unroll
        for (int c = 0; c < 4; ++c) {
            const int col = c * 256 + F.lane * 4;
            const f32x4 g = *(const f32x4*)(ng + col), s1 = *(const f32x4*)(sc + col), s0 = *(const f32x4*)(sh + col);
#pragma unroll
            for (int u = 0; u < 4; ++u) hv[c][u] = (xv[c][u] * rinv * g[u]) * (1.0f + s1[u]) + s0[u];
            u32x2 w; w[0] = pack_bf16(hv[c][0], hv[c][1]); w[1] = pack_bf16(hv[c][2], hv[c][3]);
            *(u32x2*)(hbuf + (size_t)tok * DM + col) = w;
        }
        if (ROUTE) {
            LAS float* lgs = (LAS float*)(F.lds + 36 * WR_LD * 4 + 256) + F.wave * 36;
#pragma unroll 1
            for (int jb = 0; jb < 36; jb += 4) {
                float pp[4];
#pragma unroll
                for (int u = 0; u < 4; ++u) {
                    float p = 0.f;
#pragma unroll
                    for (int c = 0; c < 4; ++c) {
                        const f32x4 w = *(const LAS f32x4*)(wrT + (jb + u) * WR_LD + c * 256 + F.lane * 4);
                        p += hv[c][0] * w[0] + hv[c][1] * w[1] + hv[c][2] * w[2] + hv[c][3] * w[3];
                    }
                    pp[u] = p;
                }
#pragma unroll
                for (int u = 0; u < 4; ++u) pp[u] = wave_sum(pp[u]);
                if (F.lane == 0) { *(LAS f32x4*)(lgs + jb) = (f32x4){pp[0], pp[1], pp[2], pp[3]}; }
            }
            float lg[36];
#pragma unroll
            for (int j = 0; j < 36; ++j) lg[j] = lgs[j] + brs[j];
            int g = 0; float gm = lg[0];
#pragma unroll
            for (int j = 1; j < 4; ++j) if (lg[j] > gm) { gm = lg[j]; g = j; }
            float den = 0.f;
#pragma unroll
            for (int j = 0; j < 4; ++j) den += __expf(lg[j] - gm);
            const float ptop = 1.0f / den;
            float fv[8];
#pragma unroll
            for (int i = 0; i < 8; ++i) fv[i] = (g == 0) ? lg[4 + i] : (g == 1) ? lg[12 + i] : (g == 2) ? lg[20 + i] : lg[28 + i];
            int i1 = 0; float v1 = fv[0];
#pragma unroll
            for (int i = 1; i < 8; ++i) if (fv[i] > v1) { v1 = fv[i]; i1 = i; }
            int i2 = -1; float v2 = -3.0e38f;
#pragma unroll
            for (int i = 0; i < 8; ++i) if (i != i1 && fv[i] > v2) { v2 = fv[i]; i2 = i; }
            const float e2 = __expf(v2 - v1), ga = ptop / (1.0f + e2), gb = ptop * e2 / (1.0f + e2);
            if (F.lane == 0) {
                const int li = ((tb - F.bid * NWAVE * TPW) / (F.G * NWAVE * TPW)) * NWAVE * TPW + F.wave * TPW + ti;
                const int ea = g * 8 + i1, eb = g * 8 + i2;
                const int ra = __hip_atomic_fetch_add(&rcnt[ea], 1, __ATOMIC_RELAXED, __HIP_MEMORY_SCOPE_WORKGROUP);
                const int rb = __hip_atomic_fetch_add(&rcnt[eb], 1, __ATOMIC_RELAXED, __HIP_MEMORY_SCOPE_WORKGROUP);
                if (li < RT_CAP) { rt_er[2 * li] = (ea << 16) | ra; rt_gate[2 * li] = ga; rt_tok[2 * li] = tok; rt_er[2 * li + 1] = (eb << 16) | rb; rt_gate[2 * li + 1] = gb; rt_tok[2 * li + 1] = tok; }
            }
        }
      }
    }
    if (ROUTE) {
        __syncthreads();
        unsigned* cnt = ctl + CW_CNT + layer * NEXP * CNT_STRIDE;
        if (F.tid < NEXP) { const int n = rcnt[F.tid]; rbase[F.tid] = n ? (int)__hip_atomic_fetch_add(cnt + F.tid * CNT_STRIDE, (unsigned)n, __ATOMIC_RELAXED, __HIP_MEMORY_SCOPE_AGENT) : 0; }
        __syncthreads();
        int* list = (int*)(a.ws + WS_LIST); float* gatev = (float*)(a.ws + WS_GATEV); int* tsl = (int*)(a.ws + WS_TOKSLOT);
        int nloc = 0;
        for (int tb = F.bid * NWAVE * TPW; tb < NTOK; tb += F.G * NWAVE * TPW) nloc += NWAVE * TPW;
        nloc = nloc < RT_CAP ? nloc : RT_CAP;
        for (int i = F.tid; i < 2 * nloc; i += NTHR) {
            const int er = rt_er[i]; if (er < 0) continue;
            const int e = er >> 16, pos = rbase[e] + (er & 0xffff), tok = rt_tok[i];
            list[e * NTOK + pos] = tok; gatev[e * NTOK + pos] = rt_gate[i]; tsl[tok * 2 + (i & 1)] = (e << 20) | pos;
        }
    }
    __syncthreads();
}

constexpr int RP_HT = 0, RP_HT_LD = 1028;
constexpr int RP_PART = 16 * RP_HT_LD * 4;
constexpr int RP_LG = RP_PART + 8 * 16 * 48 * 4;
DI void route_phase(const Frame& F, const Args& a, int layer) {
    const float* mod = (const float*)(a.ws + WS_MOD);
    bf16_t* hbuf = (bf16_t*)(a.ws + WS_H);
    unsigned* ctl = (unsigned*)(a.ws + WS_CTL);
    LAS float* HT = (LAS float*)(F.lds + RP_HT);
    LAS float* PART = (LAS float*)(F.lds + RP_PART);
    LAS float* LG = (LAS float*)(F.lds + RP_LG);
    constexpr int RT_CAP = 512;
    LAS int* rcnt = (LAS int*)(F.lds + 149504);
    LAS int* rbase = (LAS int*)(F.lds + 149632);
    LAS int* rt_er = (LAS int*)(F.lds + 149760);
    LAS float* rt_gate = (LAS float*)(F.lds + 149760 + 4096);
    LAS int* rt_tok = (LAS int*)(F.lds + 149760 + 8192);
    if (F.tid < NEXP) rcnt[F.tid] = 0;
    for (int i = F.tid; i < 2 * RT_CAP; i += NTHR) rt_er[i] = -1;
    const float* wg = a.moe_wr_g + (size_t)layer * DM * 4;
    const float* we = a.moe_wr_e + (size_t)layer * DM * 32;
    const int col = F.lane & 15, kq = F.lane >> 4;
    float Bw[3][32];
#pragma unroll
    for (int s2 = 0; s2 < 32; ++s2) {
        const int k = 128 * F.wave + 16 * (s2 >> 2) + 4 * kq + (s2 & 3);
        Bw[0][s2] = col < 4 ? wg[k * 4 + col] : we[k * 32 + col - 4];
        Bw[1][s2] = we[k * 32 + 12 + col];
        Bw[2][s2] = col < 4 ? we[k * 32 + 28 + col] : 0.f;
    }
    const float* ng = a.norm_g + ((size_t)layer * 2 + 1) * DM;
    __syncthreads();
    const int ngroups = NTOK / 16;
    int li0 = 0;
    f32x4 xn[2][4];
    if (F.bid < ngroups) {
#pragma unroll
        for (int ti = 0; ti < 2; ++ti)
#pragma unroll
            for (int c = 0; c < 4; ++c) xn[ti][c] = *(const f32x4*)(a.out + (size_t)(F.bid * 16 + F.wave * 2 + ti) * DM + c * 256 + F.lane * 4);
    }
    for (int gi = F.bid; gi < ngroups; gi += F.G, li0 += 16) {
        const int tb = gi * 16 + F.wave * 2, b = tb / SEQ;
        const float* sh = mod + ((size_t)layer * NB + b) * 6 * DM + 3 * DM;
        const float* scp = sh + DM;
        f32x4 xc[2][4];
#pragma unroll
        for (int ti = 0; ti < 2; ++ti)
#pragma unroll
            for (int c = 0; c < 4; ++c) xc[ti][c] = xn[ti][c];
        if (gi + F.G < ngroups) {
#pragma unroll
            for (int ti = 0; ti < 2; ++ti)
#pragma unroll
                for (int c = 0; c < 4; ++c) xn[ti][c] = *(const f32x4*)(a.out + (size_t)((gi + F.G) * 16 + F.wave * 2 + ti) * DM + c * 256 + F.lane * 4);
        }
#pragma unroll
        for (int ti = 0; ti < 2; ++ti) {
            const int tok = tb + ti;
            f32x4 xv[4];
#pragma unroll
            for (int c = 0; c < 4; ++c) xv[c] = xc[ti][c];
            float ss = 0.f;
#pragma unroll
            for (int c = 0; c < 4; ++c) ss += xv[c][0] * xv[c][0] + xv[c][1] * xv[c][1] + xv[c][2] * xv[c][2] + xv[c][3] * xv[c][3];
            ss = wave_sum(ss);
            const float rinv = rsqrtf(ss * (1.0f / DM) + EPS);
#pragma unroll
            for (int c = 0; c < 4; ++c) {
                const int cl = c * 256 + F.lane * 4;
                const f32x4 g = *(const f32x4*)(ng + cl), s1 = *(const f32x4*)(scp + cl), s0 = *(const f32x4*)(sh + cl);
                f32x4 hv;
#pragma unroll
                for (int u = 0; u < 4; ++u) hv[u] = (xv[c][u] * rinv * g[u]) * (1.0f + s1[u]) + s0[u];
                u32x2 w; w[0] = pack_bf16(hv[0], hv[1]); w[1] = pack_bf16(hv[2], hv[3]);
                *(u32x2*)(hbuf + (size_t)tok * DM + cl) = w;
                *(LAS f32x4*)(HT + (F.wave * 2 + ti) * RP_HT_LD + cl) = hv;
            }
        }
        __syncthreads();
        {
            f32x4 acc[3];
#pragma unroll
            for (int n = 0; n < 3; ++n) acc[n] = (f32x4){0.f, 0.f, 0.f, 0.f};
            const LAS float* ap = HT + col * RP_HT_LD + 128 * F.wave + 4 * kq;
#pragma unroll
            for (int s4 = 0; s4 < 8; ++s4) {
                const f32x4 av = *(const LAS f32x4*)(ap + 16 * s4);
#pragma unroll
                for (int u = 0; u < 4; ++u)
#pragma unroll
                    for (int n = 0; n < 3; ++n) acc[n] = __builtin_amdgcn_mfma_f32_16x16x4f32(av[u], Bw[n][4 * s4 + u], acc[n], 0, 0, 0);
            }
#pragma unroll
            for (int n = 0; n < 3; ++n)
#pragma unroll
                for (int r = 0; r < 4; ++r) PART[(F.wave * 16 + 4 * kq + r) * 48 + 16 * n + col] = acc[n][r];
        }
        __syncthreads();
        {
            const int tk = F.tid >> 5, j = F.tid & 31;
            float s0 = 0.f, s1 = 0.f;
#pragma unroll
            for (int wv = 0; wv < NWAVE; ++wv) { s0 += PART[(wv * 16 + tk) * 48 + j]; s1 += PART[(wv * 16 + tk) * 48 + 32 + (j & 3)]; }
            LG[tk * 36 + j] = s0 + (j < 4 ? a.moe_br_g[layer * 4 + j] : a.moe_br_e[layer * 32 + j - 4]);
            if (j < 4) LG[tk * 36 + 32 + j] = s1 + a.moe_br_e[layer * 32 + 28 + j];
        }
        __syncthreads();
        if (F.tid < 16) {
            const int tk = F.tid, tok = gi * 16 + tk;
            float lg[36];
#pragma unroll
            for (int j = 0; j < 36; ++j) lg[j] = LG[tk * 36 + j];
            int g = 0; float gm = lg[0];
#pragma unroll
            for (int j = 1; j < 4; ++j) if (lg[j] > gm) { gm = lg[j]; g = j; }
            float den = 0.f;
#pragma unroll
            for (int j = 0; j < 4; ++j) den += __expf(lg[j] - gm);
            const float ptop = 1.0f / den;
            float fv[8];
#pragma unroll
            for (int i = 0; i < 8; ++i) fv[i] = (g == 0) ? lg[4 + i] : (g == 1) ? lg[12 + i] : (g == 2) ? lg[20 + i] : lg[28 + i];
            int i1 = 0; float v1 = fv[0];
#pragma unroll
            for (int i = 1; i < 8; ++i) if (fv[i] > v1) { v1 = fv[i]; i1 = i; }
            int i2 = -1; float v2 = -3.0e38f;
#pragma unroll
            for (int i = 0; i < 8; ++i) if (i != i1 && fv[i] > v2) { v2 = fv[i]; i2 = i; }
            const float e2 = __expf(v2 - v1), ga = ptop / (1.0f + e2), gb = ptop * e2 / (1.0f + e2);
            const int li = li0 + tk, ea = g * 8 + i1, eb = g * 8 + i2;
            const int ra = __hip_atomic_fetch_add(&rcnt[ea], 1, __ATOMIC_RELAXED, __HIP_MEMORY_SCOPE_WORKGROUP);
            const int rb = __hip_atomic_fetch_add(&rcnt[eb], 1, __ATOMIC_RELAXED, __HIP_MEMORY_SCOPE_WORKGROUP);
            if (li < RT_CAP) { rt_er[2 * li] = (ea << 16) | ra; rt_gate[2 * li] = ga; rt_tok[2 * li] = tok; rt_er[2 * li + 1] = (eb << 16) | rb; rt_gate[2 * li + 1] = gb; rt_tok[2 * li + 1] = tok; }
        }
    }
    __syncthreads();
    unsigned* cnt = ctl + CW_CNT + layer * NEXP * CNT_STRIDE;
    if (F.tid < NEXP) { const int n = rcnt[F.tid]; rbase[F.tid] = n ? (int)__hip_atomic_fetch_add(cnt + F.tid * CNT_STRIDE, (unsigned)n, __ATOMIC_RELAXED, __HIP_MEMORY_SCOPE_AGENT) : 0; }
    __syncthreads();
    int* list = (int*)(a.ws + WS_LIST); float* gatev = (float*)(a.ws + WS_GATEV); int* tsl = (int*)(a.ws + WS_TOKSLOT);
    const int nloc = li0 < RT_CAP ? li0 : RT_CAP;
    for (int i = F.tid; i < 2 * nloc; i += NTHR) {
        const int er = rt_er[i]; if (er < 0) continue;
        const int e = er >> 16, pos = rbase[e] + (er & 0xffff), tok = rt_tok[i];
        list[e * NTOK + pos] = tok; gatev[e * NTOK + pos] = rt_gate[i]; tsl[tok * 2 + (i & 1)] = (e << 20) | pos;
    }
    __syncthreads();
}

constexpr int LDS_MISC = 131072 + 64;
constexpr int LDS_XB = 163840 - 16;
constexpr int LDS_BYTES = 163840;
using pg8::Unit;
struct DenseSched {
    int nM, nN, nwg, G, c; const char* Bt; size_t tstepB;
    DI void init(int M, int N, int K, int G_, int c_, const void* Bt_) { nM = M / 256; nN = N / 256; nwg = nM * nN; G = G_; c = c_; Bt = (const char*)Bt_; tstepB = (size_t)256 * K * 2; }
    DI bool next(int i, Unit& u) const {
        const long L = (long)i * G + c; if (L >= nwg) return false;
        int wgid = (int)L; { const int q = nwg / 8, r = nwg % 8, xcd = wgid % 8, off = wgid / 8; wgid = (xcd < r ? xcd * (q + 1) : r * (q + 1) + (xcd - r) * q) + off; }
        const int nig = 8 * nN, gid = wgid / nig, fm = gid * 8, gsz = (nM - fm) < 8 ? (nM - fm) : 8;
        u.pm = fm + ((wgid % nig) % gsz); u.pn = (wgid % nig) / gsz; u.e = 0; u.nrow = 256; return true;
    }
    DI int a_row(const Unit& u, int r) const { return u.pm * 256 + r; }
    DI const char* b_base(const Unit& u) const { return Bt + (size_t)u.pn * tstepB; }
};
template <bool UP>
struct MoeSched {
    const LAS int* ntp; const unsigned* cnt; const int* list; const char* W; int nU, G, c;
    DI bool next(int i, Unit& u) const {
        const long L = (long)i * G + c; if (L >= nU) return false;
        int wgid = (int)L; { const int q = nU / 8, r = nU % 8, xcd = wgid % 8, off = wgid / 8; wgid = (xcd < r ? xcd * (q + 1) : r * (q + 1) + (xcd - r) * q) + off; }
        const int tg = wgid >> 2; u.pn = wgid & 3; u.pm = tg;
        int e = 0;
        for (int k = 1; k < NEXP; ++k) e += (ntp[k] <= tg) ? 1 : 0;
        u.e = e; const int rem = ntp[40 + e] - (tg - ntp[e]) * 256; u.nrow = rem < 256 ? rem : 256; return true;
    }
    DI int a_row(const Unit& u, int r) const {
        if (UP) { const int p = (u.pm - ntp[u.e]) * 256 + r; return (r < u.nrow) ? list[u.e * NTOK + p] : 0; }
        return u.pm * 256 + r;
    }
    DI const char* b_base(const Unit& u) const {
        return W + (size_t)u.e * 3 * MiB + (UP ? (size_t)u.pn * 256 * DM * 2 : 2 * MiB + (size_t)u.pn * 256 * DEXP * 2);
    }
};
DI void moe_tile_table(const Frame& F, const unsigned* cnt, LAS int* ntp  ) {
    if (F.tid < NEXP) ntp[40 + F.tid] = (int)cnt[F.tid * CNT_STRIDE];
    __syncthreads();
    if (F.tid == 0) { int s = 0; for (int e = 0; e < NEXP; ++e) { ntp[e] = s; s += (ntp[40 + e] + 255) >> 8; } ntp[NEXP] = s; }
    __syncthreads();
}

#define EPI_ROWS_BEGIN const int row0 = u.pm * 256 + wr * 64 + fr; _Pragma("unroll") for (int ai = 0; ai < 2; ++ai) _Pragma("unroll") for (int m = 0; m < 4; ++m) { const int row = row0 + ai * 128 + m * 16;
#define EPI_ROWS_END }
DI u32x2 pack4(const f32x4& v) { u32x2 w; w[0] = pack_bf16(v[0], v[1]); w[1] = pack_bf16(v[2], v[3]); return w; }

struct EpiAbIn {
    bf16_t* Zc;
    DI void operator()(const f32x4 (&acc)[2][2][4][2], const Unit& u, int wr, int wc, int fr, int fq) const {
        EPI_ROWS_BEGIN
            bf16_t* rp = Zc + (size_t)row * ZC_N;
            if (u.pn < 2) {
#pragma unroll
                for (int bj = 0; bj < 2; ++bj) {
                    const u32x2 lo = pack4(acc[ai][bj][m][0]), hi = pack4(acc[ai][bj][m][1]);
                    *(u32x4*)(rp + u.pn * 256 + bj * 128 + wc * 32 + 8 * fq) = (u32x4){lo[0], lo[1], hi[0], hi[1]};
                }
            } else {
                const int pnp = (u.pn - 2) & 3, j = 128 * pnp + 32 * wc + 8 * fq;
                u32x2 o[2];
#pragma unroll
                for (int bj = 0; bj < 2; ++bj) {
                    const f32x4 X = acc[ai][bj][m][0], Y = acc[ai][bj][m][1]; f32x4 v;
                    if (u.pn < 6) v = X * Y;
                    else { v[0] = X[0] * sigmoid_f(Y[0]); v[1] = X[1] * sigmoid_f(Y[1]); v[2] = X[2] * sigmoid_f(Y[2]); v[3] = X[3] * sigmoid_f(Y[3]); }
                    o[bj] = pack4(v);
                }
                *(u32x4*)(rp + (u.pn < 6 ? 512 : 1024) + j) = (u32x4){o[0][0], o[0][1], o[1][0], o[1][1]};
            }
        EPI_ROWS_END
    }
};
struct EpiResid {
    const float* xin; float* xout; const float* g1;
    DI void operator()(const f32x4 (&acc)[2][2][4][2], const Unit& u, int wr, int wc, int fr, int fq) const {
        const float* g = g1 + (size_t)((u.pm * 256) / SEQ) * 6 * DM;
        const int row0 = u.pm * 256 + wr * 64 + fr, col0 = u.pn * 256 + wc * 32 + 4 * fq;
        f32x4 gv[2][2];
#pragma unroll
        for (int bj = 0; bj < 2; ++bj)
#pragma unroll
            for (int n = 0; n < 2; ++n) gv[bj][n] = *(const f32x4*)(g + col0 + bj * 128 + n * 16);
#pragma unroll
        for (int ai = 0; ai < 2; ++ai) {
            f32x4 xo[4][2][2];
#pragma unroll
            for (int m = 0; m < 4; ++m)
#pragma unroll
                for (int bj = 0; bj < 2; ++bj)
#pragma unroll
                    for (int n = 0; n < 2; ++n) xo[m][bj][n] = *(const f32x4*)(xin + (size_t)(row0 + ai * 128 + m * 16) * DM + col0 + bj * 128 + n * 16);
            asm volatile("" ::: "memory");
#pragma unroll
            for (int m = 0; m < 4; ++m)
#pragma unroll
                for (int bj = 0; bj < 2; ++bj)
#pragma unroll
                    for (int n = 0; n < 2; ++n) *(f32x4*)(xout + (size_t)(row0 + ai * 128 + m * 16) * DM + col0 + bj * 128 + n * 16) = xo[m][bj][n] + gv[bj][n] * acc[ai][bj][m][n];
        }
    }
};
struct EpiPlain {
    bf16_t* O; int ld; unsigned scmask; float sc;
    DI void operator()(const f32x4 (&acc)[2][2][4][2], const Unit& u, int wr, int wc, int fr, int fq) const {
        const float s_ = ((scmask >> u.pn) & 1u) ? sc : 1.0f;
        EPI_ROWS_BEGIN
#pragma unroll
            for (int bj = 0; bj < 2; ++bj) {
                const u32x2 lo = pack4(acc[ai][bj][m][0] * s_), hi = pack4(acc[ai][bj][m][1] * s_);
                *(u32x4*)(O + (size_t)row * ld + u.pn * 256 + bj * 128 + wc * 32 + 8 * fq) = (u32x4){lo[0], lo[1], hi[0], hi[1]};
            }
        EPI_ROWS_END
    }
};
struct EpiPlainNat {
    bf16_t* O; int ld;
    DI void operator()(const f32x4 (&acc)[2][2][4][2], const Unit& u, int wr, int wc, int fr, int fq) const {
        EPI_ROWS_BEGIN
#pragma unroll
            for (int bj = 0; bj < 2; ++bj)
#pragma unroll
                for (int n = 0; n < 2; ++n) *(u32x2*)(O + (size_t)row * ld + u.pn * 256 + bj * 128 + wc * 32 + n * 16 + 4 * fq) = pack4(acc[ai][bj][m][n]);
        EPI_ROWS_END
    }
};
struct EpiVt {
    bf16_t* O;
    DI void operator()(const f32x4 (&acc)[2][2][4][2], const Unit& u, int wr, int wc, int fr, int fq) const {
        const int pos = 8 * (fq & 1) + 4 * (fq >> 1);
        EPI_ROWS_BEGIN
#pragma unroll
            for (int bj = 0; bj < 2; ++bj)
#pragma unroll
                for (int n = 0; n < 2; ++n) *(u32x2*)(O + (size_t)row * NTOK + u.pn * 256 + bj * 128 + wc * 32 + n * 16 + pos) = pack4(acc[ai][bj][m][n]);
        EPI_ROWS_END
    }
};
struct EpiMoeUp {
    bf16_t* act;
    DI void operator()(const f32x4 (&acc)[2][2][4][2], const Unit& u, int wr, int wc, int fr, int fq) const {
        EPI_ROWS_BEGIN
            u32x2 o[2];
#pragma unroll
            for (int bj = 0; bj < 2; ++bj) {
                const f32x4 X = acc[ai][bj][m][0], Y = acc[ai][bj][m][1]; f32x4 v;
                v[0] = silu_f(X[0]) * Y[0]; v[1] = silu_f(X[1]) * Y[1]; v[2] = silu_f(X[2]) * Y[2]; v[3] = silu_f(X[3]) * Y[3];
                o[bj] = pack4(v);
            }
            *(u32x4*)(act + (size_t)row * DEXP + 128 * u.pn + 32 * wc + 8 * fq) = (u32x4){o[0][0], o[0][1], o[1][0], o[1][1]};
        EPI_ROWS_END
    }
};
struct EpiMoeDown {
    bf16_t* y; const float* gatev; const LAS int* ntp;
    DI void operator()(const f32x4 (&acc)[2][2][4][2], const Unit& u, int wr, int wc, int fr, int fq) const {
        const int pbase = (u.pm - ntp[u.e]) * 256;
        EPI_ROWS_BEGIN
            const int r = row - u.pm * 256;
            const float gt = (r < u.nrow) ? gatev[u.e * NTOK + pbase + r] : 0.f;
#pragma unroll
            for (int bj = 0; bj < 2; ++bj) {
                const u32x2 lo = pack4(acc[ai][bj][m][0] * gt), hi = pack4(acc[ai][bj][m][1] * gt);
                *(u32x4*)(y + (size_t)row * DM + u.pn * 256 + bj * 128 + wc * 32 + 8 * fq) = (u32x4){lo[0], lo[1], hi[0], hi[1]};
            }
        EPI_ROWS_END
    }
};

DI void conv_phase(const Frame& F, const Args& a) {
    const bf16_t* Zc = (const bf16_t*)(a.ws + WS_BIG);
    bf16_t* Y = (bf16_t*)(a.ws + WS_Y);
    LAS unsigned* PB = (LAS unsigned*)F.lds;
    LAS f32x2* ST = (LAS f32x2*)(F.lds + 94 * 1024);
    const int cp = F.tid & 255, th = F.tid >> 8, wq = F.wave & 3;
    float wb[31][2], wa[3][2];
#pragma unroll
    for (int k = 0; k < 31; ++k) { const f32x2 w = *(const f32x2*)(a.ab_conv_b + k * 512 + 2 * cp); wb[k][0] = w[0]; wb[k][1] = w[1]; }
#pragma unroll
    for (int k = 0; k < 3; ++k) { const f32x2 w = *(const f32x2*)(a.ab_conv_a + k * 512 + 2 * cp); wa[k][0] = w[0]; wa[k][1] = w[1]; }
    const f32x2 cbias = *(const f32x2*)(a.ab_conv_b_bias + 2 * cp), lng = *(const f32x2*)(a.ab_ln_g + 2 * cp), lnb = *(const f32x2*)(a.ab_ln_b + 2 * cp);
    for (int tile = F.bid; tile < NTOK / 64; tile += F.G) {
        const int t0 = tile * 64, b = t0 / SEQ, tl0 = t0 % SEQ;
        for (int i = F.tid; i < 94 * 64; i += NTHR) {
            const int r = i >> 6, c8 = i & 63, pos = tl0 - 30 + r;
            u32x4 v = {0u, 0u, 0u, 0u};
            if (pos >= 0) v = *(const u32x4*)(Zc + (size_t)(b * SEQ + pos) * ZC_N + 1024 + c8 * 8);
            *(LAS u32x4*)(PB + r * 256 + c8 * 4) = v;
        }
        __syncthreads();
#pragma unroll 1
        for (int g = 0; g < 4; ++g) {
            float U[8][2];
#pragma unroll
            for (int i = 0; i < 8; ++i) { U[i][0] = cbias[0]; U[i][1] = cbias[1]; }
#pragma unroll
            for (int r = 0; r < 38; ++r) {
                const unsigned xw = PB[(32 * th + 8 * g + r) * 256 + cp];
                const float x0 = bf_lo(xw), x1 = bf_hi(xw);
#pragma unroll
                for (int i = 0; i < 8; ++i) { const int k = r - i; if (k >= 0 && k <= 30) { U[i][0] += wb[k][0] * x0; U[i][1] += wb[k][1] * x1; } }
            }
            unsigned gwv[8], pav[10];
#pragma unroll
            for (int i = 0; i < 8; ++i) gwv[i] = *(const unsigned*)(Zc + ((size_t)t0 + 32 * th + 8 * g + i) * ZC_N + 2 * cp);
#pragma unroll
            for (int i = 0; i < 10; ++i) { const int pp = tl0 + 32 * th + 8 * g + i - 2; pav[i] = pp >= 0 ? *(const unsigned*)(Zc + (size_t)(b * SEQ + pp) * ZC_N + 512 + 2 * cp) : 0u; }
            {
                float v[16];
#pragma unroll
                for (int i = 0; i < 8; ++i) { v[2 * i] = U[i][0] + U[i][1]; v[2 * i + 1] = U[i][0] * U[i][0] + U[i][1] * U[i][1]; }
#pragma unroll
                for (int hw = 8; hw >= 1; hw >>= 1) {
                    const bool up = (F.lane & (4 * hw)) != 0;
#pragma unroll
                    for (int i = 0; i < hw; ++i) { const float send = up ? v[i] : v[i + hw], keep = up ? v[i + hw] : v[i]; v[i] = keep + __shfl_xor(send, 4 * hw); }
                }
                v[0] += __shfl_xor(v[0], 2); v[0] += __shfl_xor(v[0], 1);
                if ((F.lane & 3) == 0) { const int idx = F.lane >> 2; ((LAS float*)ST)[((32 * th + 8 * g + (idx >> 1)) * 4 + wq) * 2 + (idx & 1)] = v[0]; }
            }
            __syncthreads();
#pragma unroll
            for (int i = 0; i < 8; ++i) {
                const int tl = 32 * th + 8 * g + i; const size_t tok = (size_t)t0 + tl;
                const f32x2 p0 = ST[tl * 4 + 0], p1 = ST[tl * 4 + 1], p2 = ST[tl * 4 + 2], p3 = ST[tl * 4 + 3];
                const float mean = ((p0[0] + p1[0]) + (p2[0] + p3[0])) * (1.0f / 512.0f);
                const float var = ((p0[1] + p1[1]) + (p2[1] + p3[1])) * (1.0f / 512.0f) - mean * mean;
                const float rstd = rsqrtf(var + EPS);
                const float yb0 = silu_f((U[i][0] - mean) * rstd * lng[0] + lnb[0]), yb1 = silu_f((U[i][1] - mean) * rstd * lng[1] + lnb[1]);
                *(unsigned*)(Y + tok * DM + 512 + 2 * cp) = pack_bf16(yb0, yb1);
                float a0 = 0.f, a1 = 0.f;
#pragma unroll
                for (int k = 0; k < 3; ++k) { const unsigned w = pav[i + k]; a0 += wa[k][0] * bf_lo(w); a1 += wa[k][1] * bf_hi(w); }
                const unsigned gw = gwv[i];
                *(unsigned*)(Y + tok * DM + 2 * cp) = pack_bf16(bf_lo(gw) * a0, bf_hi(gw) * a1);
            }
        }
        __syncthreads();
    }
}

#define MFMA32(a, b, c) __builtin_amdgcn_mfma_f32_32x32x16_bf16((a), (b), (c), 0, 0, 0)
#define LDS6_ISSUE(B, addr, o0, o1, o2, o3, o4, o5) asm volatile( \
    "ds_read_b128 %0, %6 offset:" #o0 "\n\tds_read_b128 %1, %6 offset:" #o1 "\n\tds_read_b128 %2, %6 offset:" #o2 "\n\tds_read_b128 %3, %6 offset:" #o3 "\n\tds_read_b128 %4, %6 offset:" #o4 "\n\tds_read_b128 %5, %6 offset:" #o5 \
    : "=&v"(B[0]), "=&v"(B[1]), "=&v"(B[2]), "=&v"(B[3]), "=&v"(B[4]), "=&v"(B[5]) : "v"(addr) : "memory")
#define LDS6_WAIT(B) asm volatile("s_waitcnt lgkmcnt(0)" : "+v"(B[0]), "+v"(B[1]), "+v"(B[2]), "+v"(B[3]), "+v"(B[4]), "+v"(B[5]) :: "memory")
constexpr int TK_HIST = 0;
constexpr int TK_HLD = 513;
constexpr int TK_TAB = 66048;
constexpr int TK_CAP = 256;
constexpr int TK_CAND = 66560;
constexpr int TK_CCNT = TK_CAND + 32 * TK_CAP * 4;
constexpr int TK_OVF = TK_CCNT + 128;
constexpr int TK_BQ = 100352;
constexpr int TK_MASK = 118784;
DI int crow_c(int r) { return (r & 3) + 8 * (r >> 2); }
template <int MODE, bool DIAG>
DI void topk_elems(const Frame& F, const f32x16& sc, int kt, int q, int h2, int myT, LAS unsigned* hist, LAS unsigned* cand, LAS int* ccnt, LAS unsigned* maskl) {
    const int lo = myT << 9, hi = (myT + 1) << 9;
    if (MODE <= 2) {
#pragma unroll
        for (int r = 0; r < 16; ++r) {
            unsigned key = (unsigned)fmaxf(sc[r], 0.0f); key = key > 262143u ? 262143u : key;
            const bool valid = !DIAG || (crow_c(r) + 4 * h2 <= q);
            if (MODE == 1) { if (valid) __hip_atomic_fetch_add(&hist[q * TK_HLD + (key >> 9)], 1u, __ATOMIC_RELAXED, __HIP_MEMORY_SCOPE_WORKGROUP); }
            else { if (valid && (int)(key >> 9) == myT) __hip_atomic_fetch_add(&hist[q * TK_HLD + (key & 511)], 1u, __ATOMIC_RELAXED, __HIP_MEMORY_SCOPE_WORKGROUP); }
        }
        return;
    }
    const int selb = (MODE == 3 ? myT : hi - 1), geb = (MODE == 3 ? myT - 1 : lo - 1);
    unsigned selw = 0u, gew = 0u;
#pragma unroll
    for (int r = 0; r < 16; ++r) {
        unsigned key = (unsigned)fmaxf(sc[r], 0.0f); key = key > 262143u ? 262143u : key;
        const unsigned d1 = (unsigned)(selb - (int)key), d2 = (unsigned)(geb - (int)key);
        selw = __builtin_amdgcn_alignbit(selw, d1, 31);
        gew = __builtin_amdgcn_alignbit(gew, d2, 31);
    }
    if (DIAG) {
        unsigned vw = 0u;
#pragma unroll
        for (int r = 0; r < 16; ++r) vw |= (crow_c(r) + 4 * h2 <= q) ? (1u << (15 - r)) : 0u;
        selw &= vw; gew &= vw;
    }
    unsigned cw = gew & ~selw & 0xffffu;
    if (cw) {
#pragma unroll
        for (int r = 0; r < 16; ++r) {
            if (cw & (1u << (15 - r))) {
                unsigned key = (unsigned)fmaxf(sc[r], 0.0f); key = key > 262143u ? 262143u : key;
                const int p = __hip_atomic_fetch_add(&ccnt[q], 1, __ATOMIC_RELAXED, __HIP_MEMORY_SCOPE_WORKGROUP);
                if (p < TK_CAP) cand[q * TK_CAP + p] = (MODE == 3 ? 0u : ((key - (unsigned)lo) << 13)) | (unsigned)(8191 - (32 * kt + crow_c(r) + 4 * h2));
            }
        }
    }
    unsigned rv = __builtin_bitreverse32(selw) >> 16;
    unsigned bits = (rv & 0xfu) | ((rv & 0xf0u) << 4) | ((rv & 0xf00u) << 8) | ((rv & 0xf000u) << 12);
    bits <<= 4 * h2;
    bits |= (unsigned)__shfl_xor((int)bits, 32);
    if (h2 == 0) maskl[q * 256 + kt] = bits;
}
template <int MODE>
DI void topk_pass(const Frame& F, const bf16_t* Z, int b, int t0, const float (&wp)[8]) {
    const LAS unsigned char* bq = F.lds + TK_BQ;
    LAS unsigned* hist = (LAS unsigned*)(F.lds + TK_HIST);
    LAS int* tab = (LAS int*)(F.lds + TK_TAB);
    LAS unsigned* cand = (LAS unsigned*)(F.lds + TK_CAND);
    LAS int* ccnt = (LAS int*)(F.lds + TK_CCNT);
    LAS unsigned* maskl = (LAS unsigned*)(F.lds + TK_MASK);
    const int lane = fresh_lane(), q = lane & 31, h2 = lane >> 5, ntile = t0 / 32 + 1;
    const int myT = (MODE >= 2) ? tab[q * 4 + 0] : 0;
    const unsigned bqa = (unsigned)(size_t)(bq + lane * 16);
    const bf16_t* kbase = Z + (size_t)b * SEQ * CD_N + Z_KI + 8 * h2 + (size_t)q * CD_N;
    bf16x8 A0n = (bf16x8){0, 0, 0, 0, 0, 0, 0, 0}, A1n = A0n;
    if (F.wave < ntile) { const bf16_t* kp = kbase + (size_t)(32 * F.wave) * CD_N; A0n = *(const bf16x8*)kp; A1n = *(const bf16x8*)(kp + 16); }
    for (int kt = F.wave; kt < ntile; kt += NWAVE) {
        const bf16x8 A0 = A0n, A1 = A1n;
        if (kt + NWAVE < ntile) { const bf16_t* kp = kbase + (size_t)(32 * (kt + NWAVE)) * CD_N; A0n = *(const bf16x8*)kp; A1n = *(const bf16x8*)(kp + 16); }
        f32x16 sc;
#pragma unroll
        for (int r = 0; r < 16; ++r) sc[r] = 131072.0f;
        {
#define TK_MF0(acc, A, B) asm volatile("v_mfma_f32_32x32x16_bf16 %0, %1, %2, 0" : "=&v"(acc) : "v"(A), "v"(B))
#define TK_MF1(acc, A, B) asm volatile("v_mfma_f32_32x32x16_bf16 %0, %1, %2, %0" : "+v"(acc) : "v"(A), "v"(B))
#define TK_FA(sv, av, wv) asm volatile("v_fma_f32 %0, |%1|, %2, %0" : "+v"(sv) : "v"(av), "v"(wv))
#define TK_AD(sv, av) asm volatile("v_add_f32 %0, %0, %1" : "+v"(sv) : "v"(av))
        bf16x8 Ba[6], Bb[6];
        f32x16 acA[3], acB[3];
        LDS6_ISSUE(Ba, bqa, 16384, 17408, 0, 1024, 2048, 3072);
        LDS6_WAIT(Ba);
        LDS6_ISSUE(Bb, bqa, 4096, 5120, 6144, 7168, 8192, 9216);
#pragma unroll
        for (int u = 0; u < 3; ++u) TK_MF0(acA[u], A0, Ba[2 * u]);
#pragma unroll
        for (int u = 0; u < 3; ++u) TK_MF1(acA[u], A1, Ba[2 * u + 1]);
        LDS6_WAIT(Bb);
        LDS6_ISSUE(Ba, bqa, 10240, 11264, 12288, 13312, 14336, 15360);
#pragma unroll
        for (int m = 0; m < 6; ++m) {
            if (m >= 3) TK_MF1(acB[m - 3], A1, Bb[2 * (m - 3) + 1]); else TK_MF0(acB[m], A0, Bb[2 * m]);
#pragma unroll
            for (int e = 0; e < 8; ++e) { const int i = 8 * m + e, u = i >> 4, r = i & 15; if (u == 0) TK_AD(sc[r], acA[0][r]); else TK_FA(sc[r], acA[u][r], wp[u - 1]); }
        }
        LDS6_WAIT(Ba);
#pragma unroll
        for (int m = 0; m < 6; ++m) {
            if (m >= 3) TK_MF1(acA[m - 3], A1, Ba[2 * (m - 3) + 1]); else TK_MF0(acA[m], A0, Ba[2 * m]);
#pragma unroll
            for (int e = 0; e < 8; ++e) { const int i = 8 * m + e, u = i >> 4, r = i & 15; TK_FA(sc[r], acB[u][r], wp[2 + u]); }
        }
#pragma unroll
        for (int u = 0; u < 3; ++u)
#pragma unroll
            for (int r = 0; r < 16; ++r) TK_FA(sc[r], acA[u][r], wp[5 + u]);
#undef TK_MF0
#undef TK_MF1
#undef TK_FA
#undef TK_AD
        }
        if (kt == ntile - 1) topk_elems<MODE, true>(F, sc, kt, q, h2, myT, hist, cand, ccnt, maskl);
        else topk_elems<MODE, false>(F, sc, kt, q, h2, myT, hist, cand, ccnt, maskl);
    }
}
DI void topk_scan(const Frame& F, int pass, int t0) {
    LAS unsigned* hist = (LAS unsigned*)(F.lds + TK_HIST);
    LAS int* tab = (LAS int*)(F.lds + TK_TAB);
    LAS int* ovf = (LAS int*)(F.lds + TK_OVF);
    for (int qi = 0; qi < 4; ++qi) {
        const int q = F.wave * 4 + qi, n = t0 + q + 1;
        int need = 256, prevT = 0, prevAbove = 0;
        if (pass == 2) { prevT = tab[q * 4 + 0]; prevAbove = tab[q * 4 + 1]; need = 256 - prevAbove; }
        if (n <= 256) { if (F.lane == 0) { tab[q * 4 + 0] = -1; tab[q * 4 + 1] = 0; tab[q * 4 + 2] = 0; } continue; }
        unsigned hv[8]; unsigned s = 0;
#pragma unroll
        for (int i = 0; i < 8; ++i) { hv[i] = hist[q * TK_HLD + 511 - (8 * F.lane + i)]; s += hv[i]; }
        unsigned inc = s;
#pragma unroll
        for (int o = 1; o < 64; o <<= 1) { const unsigned v = (unsigned)__shfl_up((int)inc, o); if (F.lane >= o) inc += v; }
        const unsigned pre = inc - s;
        if ((int)pre < need && (int)inc >= need) {
            unsigned cum = pre; int bsel = 0; unsigned above = 0, inbin = 0; bool found = false;
#pragma unroll
            for (int i = 0; i < 8; ++i) { if (!found && (int)(cum + hv[i]) >= need) { found = true; bsel = 511 - (8 * F.lane + i); above = cum; inbin = hv[i]; } cum += hv[i]; }
            if (pass == 1) { tab[q * 4 + 0] = bsel; tab[q * 4 + 1] = (int)above; tab[q * 4 + 2] = 256 - (int)above; if (inbin > (unsigned)TK_CAP) *ovf = 1; }
            else { tab[q * 4 + 0] = (prevT << 9) | bsel; tab[q * 4 + 1] = prevAbove + (int)above; tab[q * 4 + 2] = 256 - (prevAbove + (int)above); }
        }
    }
}
DI void topk_select(const Frame& F) {
    LAS int* tab = (LAS int*)(F.lds + TK_TAB);
    LAS unsigned* cand = (LAS unsigned*)(F.lds + TK_CAND);
    LAS int* ccnt = (LAS int*)(F.lds + TK_CCNT);
    LAS unsigned* maskl = (LAS unsigned*)(F.lds + TK_MASK);
    for (int qi = 0; qi < 4; ++qi) {
        const int q = F.wave * 4 + qi, need = tab[q * 4 + 2];
        int n = ccnt[q]; n = n > TK_CAP ? TK_CAP : n;
        if (need <= 0 || n <= 0) continue;
        unsigned c[4]; int rk[4]; bool vv[4];
#pragma unroll
        for (int i = 0; i < 4; ++i) { vv[i] = F.lane + 64 * i < n; c[i] = vv[i] ? cand[q * TK_CAP + F.lane + 64 * i] : 0u; rk[i] = 0; }
        for (int j = 0; j < n; ++j) {
            const unsigned cj = cand[q * TK_CAP + j];
#pragma unroll
            for (int i = 0; i < 4; ++i) rk[i] += (cj > c[i]) ? 1 : 0;
        }
#pragma unroll
        for (int i = 0; i < 4; ++i)
            if (vv[i] && rk[i] < need) { const int idx = 8191 - (int)(c[i] & 8191u); __hip_atomic_fetch_or(&maskl[q * 256 + (idx >> 5)], 1u << (idx & 31), __ATOMIC_RELAXED, __HIP_MEMORY_SCOPE_WORKGROUP); }
    }
}
DI void topk_phase(const Frame& F, const Args& a, unsigned long long& tacc) {
    unsigned long long t_s = 0;
#define TKT0(n) do { if (TIME_PH == 100 + (n)) { __syncthreads(); t_s = wall_clock64(); } } while (0)
#define TKT1(n) do { if (TIME_PH == 100 + (n)) { __syncthreads(); tacc += wall_clock64() - t_s; } } while (0)
    const bf16_t* Z = (const bf16_t*)(a.ws + WS_BIG);
    unsigned* maskg = (unsigned*)(a.ws + WS_MASK);
    LAS unsigned* hist = (LAS unsigned*)(F.lds + TK_HIST);
    LAS int* ccnt = (LAS int*)(F.lds + TK_CCNT);
    LAS int* ovf = (LAS int*)(F.lds + TK_OVF);
    LAS unsigned* maskl = (LAS unsigned*)(F.lds + TK_MASK);
    for (int pi = F.bid; pi < 512; pi += F.G) {
        const int b = pi >> 7, p = pi & 127;
        for (int half = 0; half < 2; ++half) {
            const int t0 = 32 * (half ? 255 - p : p), ntile = t0 / 32 + 1;
            const int lane0 = fresh_lane(), q = lane0 & 31, h2 = lane0 >> 5;
            const bf16_t* zr = Z + (size_t)(b * SEQ + t0 + q) * CD_N;
            TKT0(1);
            float wp[8];
            { const u32x4 wv = *(const u32x4*)(zr + Z_WI);
              const float sc = 0.0625f * 0.5f * 16384.0f;
              wp[0] = bf_lo(wv[0]) * sc; wp[1] = bf_hi(wv[0]) * sc; wp[2] = bf_lo(wv[1]) * sc; wp[3] = bf_hi(wv[1]) * sc;
              wp[4] = bf_lo(wv[2]) * sc; wp[5] = bf_hi(wv[2]) * sc; wp[6] = bf_lo(wv[3]) * sc; wp[7] = bf_hi(wv[3]) * sc; }
            __syncthreads();
            if (F.wave == 0) {
                LAS unsigned char* bqw = F.lds + TK_BQ;
                float lin[2][8];
#pragma unroll
                for (int ks = 0; ks < 2; ++ks)
#pragma unroll
                    for (int j = 0; j < 8; ++j) lin[ks][j] = 0.f;
#pragma unroll
                for (int h = 0; h < 8; ++h)
#pragma unroll
                    for (int ks = 0; ks < 2; ++ks) {
                        const u32x4 v = *(const u32x4*)(zr + Z_QI + 32 * h + 16 * ks + 8 * h2);
                        *(LAS u32x4*)(bqw + ((2 * h + ks) * 64 + lane0) * 16) = v;
#pragma unroll
                        for (int j = 0; j < 4; ++j) { lin[ks][2 * j] += wp[h] * bf_lo(v[j]); lin[ks][2 * j + 1] += wp[h] * bf_hi(v[j]); }
                    }
#pragma unroll
                for (int ks = 0; ks < 2; ++ks) {
                    u32x4 v; v[0] = pack_bf16(lin[ks][0], lin[ks][1]); v[1] = pack_bf16(lin[ks][2], lin[ks][3]); v[2] = pack_bf16(lin[ks][4], lin[ks][5]); v[3] = pack_bf16(lin[ks][6], lin[ks][7]);
                    *(LAS u32x4*)(bqw + ((16 + ks) * 64 + lane0) * 16) = v;
                }
            }
            for (int i = F.tid; i < 32 * TK_HLD; i += NTHR) hist[i] = 0u;
            if (F.tid < 32) ccnt[F.tid] = 0;
            if (F.tid == 32) *ovf = 0;
            __syncthreads();
            TKT1(1); TKT0(2);
            topk_pass<1>(F, Z, b, t0, wp);
            __syncthreads();
            TKT1(2); TKT0(3);
            topk_scan(F, 1, t0);
            __syncthreads();
            TKT1(3); TKT0(4);
            if (*ovf == 0) {
                topk_pass<4>(F, Z, b, t0, wp);
            } else {
                for (int i = F.tid; i < 32 * TK_HLD; i += NTHR) hist[i] = 0u;
                __syncthreads();
                topk_pass<2>(F, Z, b, t0, wp);
                __syncthreads();
                topk_scan(F, 2, t0);
                __syncthreads();
                topk_pass<3>(F, Z, b, t0, wp);
            }
            __syncthreads();
            TKT1(4); TKT0(5);
            topk_select(F);
            __syncthreads();
            for (int i = F.wave * 64 + fresh_lane(); i < 32 * ntile; i += NTHR) { const int qq = i / ntile, kt = i - qq * ntile; maskg[(size_t)(b * SEQ + t0 + qq) * 256 + kt] = maskl[qq * 256 + kt]; }
            TKT1(5);
        }
    }
}

constexpr int AT_KBYTES = 64 * 128;
constexpr int AT_VBYTES = 128 * 128;
constexpr int AT_BUF = AT_KBYTES + AT_VBYTES;
constexpr int AT_NSTG = 4;
constexpr int AT_LUT = AT_NSTG * AT_BUF;
constexpr int AT_LUTM = AT_LUT + 12 * 320 * 4;
constexpr int AT_LUT_LD = 320;
constexpr float NEG_INF = -__builtin_huge_valf();
constexpr float AT_THR = 8.0f;

template <int DV, bool MASKED>
DI void attn_core(const Frame& F, const bf16_t* Z, const bf16_t* Vt, int b, int qcol, int kcol, int vrow, int q0, const LAS float* lut, float c1, const unsigned* maskg, f32x16 (&O)[DV / 32]) {
    constexpr int NDV = DV / 32;
    const int q = F.lane & 31, h2 = F.lane >> 5;
    const int tw0 = q0 + 32 * F.wave, t = tw0 + q;
    const bf16_t* Zb = Z + (size_t)b * SEQ * CD_N;
    const bf16_t* Vb = Vt + (size_t)vrow * NTOK + (size_t)b * SEQ;
    const unsigned* mrow = maskg + (size_t)(b * SEQ + t) * 256;
    bf16x8 Qf[4];
#pragma unroll
    for (int ks = 0; ks < 4; ++ks) Qf[ks] = *(const bf16x8*)(Zb + (size_t)t * CD_N + qcol + 16 * ks + 8 * h2);
#pragma unroll
    for (int d = 0; d < NDV; ++d)
#pragma unroll
        for (int r = 0; r < 16; ++r) O[d][r] = 0.f;
    const LAS f32x4* lutm = (const LAS f32x4*)(F.lds + AT_LUTM);
    float m_run = NEG_INF, l_run = 0.f;
    const int jmax = (q0 + 255) >> 6;
    const int swz = (q >> 1) & 7;
    const int drow = F.lane >> 3, dpos = F.lane & 7;
    unsigned mreg[2] = {0u, 0u};
    bf16x8 Pf[4];
#pragma unroll
    for (int i = 0; i < 4; ++i) Pf[i] = (bf16x8){0, 0, 0, 0, 0, 0, 0, 0};
#define AT_DMA(j) do { const int sg_ = (j) % AT_NSTG; \
        { const int key_ = 8 * F.wave + drow, c_ = dpos ^ ((key_ >> 1) & 7); \
          __builtin_amdgcn_global_load_lds((const unsigned*)(Zb + (size_t)(64 * (j) + key_) * CD_N + kcol + 8 * c_), (LAS unsigned*)(F.lds + sg_ * AT_BUF + F.wave * 1024), 16, 0, 0); } \
        _Pragma("unroll") for (int _i = 0; _i < DV / 64; ++_i) { const int ii_ = F.wave + 8 * _i, row_ = 8 * ii_ + drow, c_ = dpos ^ ((row_ >> 1) & 7); \
          __builtin_amdgcn_global_load_lds((const unsigned*)(Vb + (size_t)row_ * NTOK + 64 * (j) + 8 * c_), (LAS unsigned*)(F.lds + sg_ * AT_BUF + AT_KBYTES + ii_ * 1024), 16, 0, 0); } \
        } while (0)
#define AT_MLOAD(j) do { if (MASKED) { mreg[0] = mrow[2 * (j)]; mreg[1] = mrow[2 * (j) + 1]; } } while (0)
#define AT_QKSM(jj) do { \
        const LAS unsigned char* kb = F.lds + ((jj) % AT_NSTG) * AT_BUF; \
        f32x16 s[2]; \
        _Pragma("unroll") for (int kb2 = 0; kb2 < 2; ++kb2) { \
            bf16x8 Kf[4]; \
            _Pragma("unroll") for (int ks = 0; ks < 4; ++ks) Kf[ks] = *(const LAS bf16x8*)(kb + (32 * kb2 + q) * 128 + (((2 * ks + h2) ^ swz) << 4)); \
            _Pragma("unroll") for (int r = 0; r < 16; ++r) s[kb2][r] = 0.f; \
            _Pragma("unroll") for (int ks = 0; ks < 4; ++ks) s[kb2] = MFMA32(Kf[ks], Qf[ks], s[kb2]); \
        } \
        const bool nearb = (64 * (jj) + 63 + 128 > tw0); \
        float mloc = NEG_INF; \
        if (!nearb) { \
            _Pragma("unroll") for (int kb2 = 0; kb2 < 2; ++kb2) _Pragma("unroll") for (int r = 0; r < 16; ++r) mloc = fmaxf(mloc, s[kb2][r]); \
            mloc = mloc * c1 + lut[96 + 128]; \
        } else { \
            const LAS float* lp = lut + (t - 64 * (jj) - 4 * h2 + 96 - 63); \
            _Pragma("unroll") for (int kb2 = 0; kb2 < 2; ++kb2) \
                _Pragma("unroll") for (int r = 0; r < 16; ++r) { const float v_ = s[kb2][r] * c1 + lp[63 - (32 * kb2 + crow_c(r))]; s[kb2][r] = v_; mloc = fmaxf(mloc, v_); } \
        } \
        mloc = fmaxf(mloc, __shfl_xor(mloc, 32)); \
        if (__any(mloc > m_run + AT_THR)) { \
            const float m_new = fmaxf(m_run, mloc); \
            const float alpha = __builtin_amdgcn_exp2f(m_run - m_new); \
            m_run = m_new; l_run *= alpha; \
            _Pragma("unroll") for (int d = 0; d < NDV; ++d) _Pragma("unroll") for (int r = 0; r < 16; ++r) O[d][r] *= alpha; \
        } \
        const float sub = lut[96 + 128] - m_run; \
        if (!nearb) { _Pragma("unroll") for (int kb2 = 0; kb2 < 2; ++kb2) _Pragma("unroll") for (int r = 0; r < 16; ++r) s[kb2][r] = __builtin_amdgcn_exp2f(s[kb2][r] * c1 + sub); } \
        else        { _Pragma("unroll") for (int kb2 = 0; kb2 < 2; ++kb2) _Pragma("unroll") for (int r = 0; r < 16; ++r) s[kb2][r] = __builtin_amdgcn_exp2f(s[kb2][r] - m_run); } \
        float psum0 = 0.f, psum1 = 0.f; \
        _Pragma("unroll") for (int kb2 = 0; kb2 < 2; ++kb2) { \
            const unsigned mw = mcur[kb2] >> (4 * h2); \
            _Pragma("unroll") for (int g = 0; g < 4; ++g) { \
                f32x4 mf = {1.f, 1.f, 1.f, 1.f}; \
                if (MASKED) mf = lutm[(mw >> (8 * g)) & 15u];                  \
                _Pragma("unroll") for (int e = 0; e < 4; ++e) { \
                    float p = s[kb2][4 * g + e]; \
                    if (MASKED) { p *= mf[e]; s[kb2][4 * g + e] = p; } \
                    if (e & 1) psum1 += p; else psum0 += p; \
                } \
            } \
        } \
        l_run += psum0 + psum1; \
        _Pragma("unroll") for (int st = 0; st < 4; ++st) { \
            u32x4 pw; \
            _Pragma("unroll") for (int e = 0; e < 4; ++e) pw[e] = pack_bf16(s[st >> 1][8 * (st & 1) + 2 * e], s[st >> 1][8 * (st & 1) + 2 * e + 1]); \
            Pf[st] = __builtin_bit_cast(bf16x8, pw); \
        } \
    } while (0)
#define AT_PV(jj) do { \
        const LAS unsigned char* vt = F.lds + ((jj) % AT_NSTG) * AT_BUF + AT_KBYTES + q * 128; \
        constexpr int NH = NDV / 2, NST = 4 * NH; \
        bf16x8 Av[2][2]; \
        _Pragma("unroll") for (int d = 0; d < 2; ++d) Av[0][d] = *(const LAS bf16x8*)(vt + (32 * d) * 128 + ((h2 ^ swz) << 4)); \
        _Pragma("unroll") for (int u = 0; u < NST; ++u) { \
            const int st = u / NH, dh = u % NH; \
            if (u + 1 < NST) { \
                const int st1 = (u + 1) / NH, dh1 = (u + 1) % NH; \
                _Pragma("unroll") for (int d = 0; d < 2; ++d) Av[(u + 1) & 1][d] = *(const LAS bf16x8*)(vt + (32 * (2 * dh1 + d)) * 128 + (((2 * st1 + h2) ^ swz) << 4)); \
            } \
            __builtin_amdgcn_s_setprio(1); \
            _Pragma("unroll") for (int d = 0; d < 2; ++d) O[2 * dh + d] = MFMA32(Av[u & 1][d], Pf[st], O[2 * dh + d]); \
            __builtin_amdgcn_s_setprio(0); \
            __builtin_amdgcn_sched_barrier(0); \
        } \
    } while (0)
#define AT_ACT(jj) (64 * (jj) <= tw0 + 31)
#define AT_WAITG() do { if (DV == 128) asm volatile("s_waitcnt vmcnt(3)" ::: "memory"); else asm volatile("s_waitcnt vmcnt(2)" ::: "memory"); } while (0)
    AT_DMA(0); AT_MLOAD(0);
    unsigned mcur[2] = {mreg[0], mreg[1]};
    if (jmax >= 1) AT_DMA(1);
    asm volatile("s_waitcnt vmcnt(0)" ::: "memory");
    __syncthreads();
    if (F.wave < 4) {
        for (int j = 0; j <= jmax; ++j) {
            if (j < jmax) AT_MLOAD(j + 1);
            if (j + 2 <= jmax) AT_DMA(j + 2);
            if (AT_ACT(j)) { AT_QKSM(j); AT_PV(j); }
            mcur[0] = mreg[0]; mcur[1] = mreg[1];
            if (j + 2 <= jmax) AT_WAITG(); else asm volatile("s_waitcnt vmcnt(0)" ::: "memory");
            asm volatile("s_waitcnt lgkmcnt(0)" ::: "memory"); __builtin_amdgcn_s_barrier(); asm volatile("" ::: "memory");
        }
    } else {
        for (int j = 0; j <= jmax; ++j) {
            if (j < jmax) AT_MLOAD(j + 1);
            if (j + 2 <= jmax) AT_DMA(j + 2);
            if (j > 0 && AT_ACT(j - 1)) AT_PV(j - 1);
            if (AT_ACT(j)) AT_QKSM(j);
            mcur[0] = mreg[0]; mcur[1] = mreg[1];
            if (j + 2 <= jmax) AT_WAITG(); else asm volatile("s_waitcnt vmcnt(0)" ::: "memory");
            asm volatile("s_waitcnt lgkmcnt(0)" ::: "memory"); __builtin_amdgcn_s_barrier(); asm volatile("" ::: "memory");
        }
        if (AT_ACT(jmax)) AT_PV(jmax);
    }
    __syncthreads();
#undef AT_WAITG
#undef AT_DMA
#undef AT_MLOAD
#undef AT_QKSM
#undef AT_PV
#undef AT_ACT
    const float lt = l_run + __shfl_xor(l_run, 32);
    const float inv = 1.0f / lt;
#pragma unroll
    for (int d = 0; d < NDV; ++d)
#pragma unroll
        for (int r = 0; r < 16; ++r) O[d][r] *= inv;
}

DI float rel_bucket_bias(const float* rel_bias, int d, int head) {
    int bkt;
    if (d < 16) bkt = d;
    else { const float lr = __logf((float)d * (1.0f / 16.0f)) / 2.0794415416798357f; int l = 16 + (int)(lr * 16.0f); bkt = l < 31 ? l : 31; }
    return rel_bias[bkt * 12 + head];
}
constexpr int AC_SLOTB = 8192, AC_K = 0, AC_V = 3 * AC_SLOTB, AC_WS = 6 * AC_SLOTB, AC_OST = AC_WS + 8 * 256, AC_M = AC_OST + 8 * 4096, AC_LUTM = AC_M + 3 * 2048, AC_LUTB = AC_LUTM + 256, AC_LUTB_LD = 640;
static_assert(AC_LUTB + 8 * AC_LUTB_LD * 4 <= 163840 - 64, "LDS");
constexpr float AC_THR = 8.0f;
typedef short v4i16_t __attribute__((ext_vector_type(4)));
typedef const LAS char* lds_cptr;
DI int ac_crow(int r, int hi) { return (r & 3) + 8 * (r >> 2) + 4 * hi; }
DI void ac_glds16(const void* g, unsigned lds_dst) { unsigned keep;
    asm volatile("s_mov_b32 %0, m0\n\ts_mov_b32 m0, %2\n\ts_nop 0\n\tglobal_load_lds_dwordx4 %1, off\n\ts_mov_b32 m0, %0" : "=&s"(keep) : "v"(g), "s"(lds_dst) : "memory"); }
DI void ac_glds4(const void* g, unsigned lds_dst) { unsigned keep;
    asm volatile("s_mov_b32 %0, m0\n\ts_mov_b32 m0, %2\n\ts_nop 0\n\tglobal_load_lds_dword %1, off\n\ts_mov_b32 m0, %0" : "=&s"(keep) : "v"(g), "s"(lds_dst) : "memory"); }
DI void ac_kload2(bf16x8* kf, lds_cptr kp, int j) { kf[2 * j] = *(const LAS bf16x8*)(kp + j * 2048); kf[2 * j + 1] = *(const LAS bf16x8*)(kp + j * 2048 + 512); }
DI s16x4 ac_vtr(lds_cptr p) { return __builtin_bit_cast(s16x4, __builtin_amdgcn_ds_read_tr16_b64_v4i16((LAS v4i16_t*)p)); }
DI void ac_bias(f32x16& p0, f32x16& p1, int jb, int qrel, int hi, const LAS float* lutb) {
    const LAS float* lp = lutb + (qrel - 64 * jb - 4 * hi + 256);
#pragma unroll
    for (int r = 0; r < 16; ++r) { const int kv = (r & 3) + 8 * (r >> 2); p0[r] += lp[-kv]; p1[r] += lp[-kv - 32]; }
}
#define AC_SBAR() __builtin_amdgcn_sched_barrier(0)
#define AC_WAIT_BAR(N) asm volatile("s_waitcnt vmcnt(" #N ") lgkmcnt(0)\n\ts_barrier" ::: "memory")
#define AC_MFMA(a, b, c) __builtin_amdgcn_mfma_f32_32x32x16_bf16((a), (b), (c), 0, 0, 0)
DI void attn_c_unit(const Frame& F, int b, int h, int qb, const bf16_t* Z, bf16_t* Yo, const unsigned* maskg, const float fb) {
    LAS unsigned char* shm = F.lds;
    const int lane = fresh_lane(), r32 = lane & 31, hi = lane >> 5, wid = F.wave;
    const size_t rowbase = (size_t)b * SEQ; const int q0 = qb * 256;
    const bf16_t* Qw = Z + (rowbase + q0 + wid * 32) * CD_N + Z_QC + h * 64;
    const bf16_t* Kh = Z + rowbase * CD_N + Z_KC + h * 64; const bf16_t* Vh = Z + rowbase * CD_N + Z_VC + h * 64;
    const unsigned lds0 = (unsigned)(size_t)shm;
    LAS float* wsf = (LAS float*)(shm + AC_WS) + wid * 64;
    const LAS f32x4* lutm = (const LAS f32x4*)(shm + AC_LUTM);
    const LAS float* lutb = (const LAS float*)(shm + AC_LUTB) + h * AC_LUTB_LD;
    const bf16_t* ksrc = Kh + (size_t)lane * CD_N + wid * 8;
    const bf16_t* vsrc = Vh + (size_t)(16 * (wid & 3) + (lane >> 2)) * CD_N + (wid >> 2) * 32 + (lane & 3) * 8;
    const unsigned* msrc = maskg + (rowbase + q0 + wid * 32 + (lane >> 1)) * 256 + (lane & 1);
    const unsigned kdst = lds0 + AC_K + wid * 1024, vdst = lds0 + AC_V + wid * 1024, mdst = lds0 + AC_M + wid * 256;
#define DMA_K(t, slot) ac_glds16(ksrc + (size_t)(t) * 64 * CD_N, (unsigned)__builtin_amdgcn_readfirstlane(kdst + (slot)))
#define DMA_V(t, slot) ac_glds16(vsrc + (size_t)(t) * 64 * CD_N, (unsigned)__builtin_amdgcn_readfirstlane(vdst + (slot)))
#define DMA_M(t, slot) ac_glds4(msrc + 2 * (t), (unsigned)__builtin_amdgcn_readfirstlane(mdst + ((slot) >> 2)))
    const lds_cptr shm3 = (lds_cptr)shm;
    const lds_cptr kp0 = shm3 + AC_K + hi * 1024 + r32 * 16;
    const lds_cptr vp0 = shm3 + AC_V + ((lane >> 4) & 1) * 32 + (lane & 3) * 8 + (4 * hi + ((lane & 15) >> 2)) * 64;
    const lds_cptr mp0 = shm3 + AC_M + wid * 256 + 8 * r32;
    const int NT = (q0 + 256) / 64;
    DMA_K(0, 0); DMA_M(0, 0); DMA_M(1, AC_SLOTB); DMA_V(0, 0); DMA_K(1, AC_SLOTB);
    bf16x8 qr[4];
#pragma unroll
    for (int d0 = 0; d0 < 4; ++d0) qr[d0] = *(const bf16x8*)(Qw + (size_t)r32 * CD_N + d0 * 16 + hi * 8);
    float mhat = 0.f, l_reg = 0.f; f32x16 o[2]; f32x16 negm;
#pragma unroll
    for (int r = 0; r < 16; ++r) { o[0][r] = 0.f; o[1][r] = 0.f; negm[r] = fb; }
    asm volatile("" : "+v"(negm));
    const int qrel = wid * 32 + r32;
    bool resc = false;
    bf16x8 kf[8];
    f32x16 pA0, pA1, pB0, pB1;
    int sl_prev = 0, sl_cur = 0, sl_next = AC_SLOTB;
#define ROT() do { sl_prev = sl_cur; sl_cur = sl_next; sl_next = (sl_next == 2 * AC_SLOTB) ? 0 : sl_next + AC_SLOTB; } while (0)
#define RESC() do { if (resc) { asm volatile("s_waitcnt lgkmcnt(0)" ::: "memory"); \
        _Pragma("unroll") for (int d_ = 0; d_ < 2; ++d_) _Pragma("unroll") for (int r = 0; r < 16; ++r) o[d_][r] *= wsf[ac_crow(r, hi)]; } } while (0)
    DMA_K(2, 2 * AC_SLOTB);
    AC_WAIT_BAR(3);
    {
#pragma unroll
        for (int d0 = 0; d0 < 4; ++d0) ac_kload2(kf, kp0, d0);
        pA0 = AC_MFMA(kf[0], qr[0], negm); pA1 = AC_MFMA(kf[1], qr[0], negm);
#pragma unroll
        for (int d0 = 1; d0 < 4; ++d0) { pA0 = AC_MFMA(kf[2 * d0], qr[d0], pA0); pA1 = AC_MFMA(kf[2 * d0 + 1], qr[d0], pA1); }
        if (NT == 4) ac_bias(pA0, pA1, 0, qrel, hi, lutb);
        float rm = -__builtin_huge_valf();
#pragma unroll
        for (int r = 0; r < 16; ++r) rm = __builtin_fmaxf(rm, __builtin_fmaxf(pA0[r], pA1[r]));
        { auto rr = __builtin_amdgcn_permlane32_swap(__float_as_uint(rm), __float_as_uint(rm), false, false); rm = __builtin_fmaxf(__uint_as_float(rr[0]), __uint_as_float(rr[1])); }
        mhat = rm;
#pragma unroll
        for (int r = 0; r < 16; ++r) negm[r] = fb - mhat;
        asm volatile("" : "+v"(negm));
        const u32x2 mwv = *(const LAS u32x2*)(mp0);
        const unsigned w0 = mwv[0] >> (4 * hi), w1 = mwv[1] >> (4 * hi);
#pragma unroll
        for (int g = 0; g < 4; ++g) {
            const f32x4 m0 = lutm[(w0 >> (8 * g)) & 15u], m1 = lutm[(w1 >> (8 * g)) & 15u];
#pragma unroll
            for (int e = 0; e < 4; ++e) { pA0[4 * g + e] = __builtin_amdgcn_exp2f(pA0[4 * g + e] - rm) * m0[e]; pA1[4 * g + e] = __builtin_amdgcn_exp2f(pA1[4 * g + e] - rm) * m1[e]; }
        }
    }
    AC_WAIT_BAR(0);
    DMA_K(3, 0); DMA_V(1, AC_SLOTB); DMA_M(2, 2 * AC_SLOTB);
    ROT();
#pragma unroll
    for (int d0 = 0; d0 < 4; ++d0) ac_kload2(kf, kp0 + sl_cur, d0);
    AC_WAIT_BAR(3);
    s16x4 vlo[8], vhi[8]; u32x4 pw0, pw1, pw2, pw3; f32x4 mfq; unsigned mw0, mw1;
#define PKW(P, B) pack_bf16(P[B], P[B + 1])
#define PAF(k) __builtin_bit_cast(bf16x8, pw##k)
#define VFR(i) (bf16x8){vlo[i][0], vlo[i][1], vlo[i][2], vlo[i][3], vhi[i][0], vhi[i][1], vhi[i][2], vhi[i][3]}
#define PIN(x) asm volatile("" : "+v"(x))
#define MX3(a, b, c) __builtin_fmaxf(__builtin_fmaxf((a), (b)), (c))
#define GAPA(MF, A0, A1, A2, A3, W0, W1, PW) do { MF; sacc += A0; sacc += A1; sacc += A2; sacc += A3; PIN(sacc); W0; W1; PIN(PW); AC_SBAR(); } while (0)
#define EX(v) __builtin_amdgcn_exp2f(v)
#define GAPB(MF, X, B, NW, NS) do { MF; X[B] = EX(X[B]) * mfq[0]; X[B + 1] = EX(X[B + 1]) * mfq[1]; X[B + 2] = EX(X[B + 2]) * mfq[2]; X[B + 3] = EX(X[B + 3]) * mfq[3]; PIN(X); \
        mfq = lutm[((NW) >> (NS)) & 15u]; AC_SBAR(); } while (0)
#define VRD(i) do { vlo[i] = ac_vtr(vp_ + (((i) >> 2) * 4096 + ((i) & 3) * 1024)); vhi[i] = ac_vtr(vp_ + (((i) >> 2) * 4096 + ((i) & 3) * 1024 + 512)); } while (0)
#define KRD(G, j) do { if (G) { ac_kload2(kf, kp0 + sl_next, j); AC_SBAR(); } } while (0)
#define STEP(C0, C1, P0, P1, t, BAND, GK, GV, GL, GM) do { AC_SBAR(); \
    const lds_cptr vp_ = vp0 + sl_prev; \
    { const u32x2 mwv_ = *(const LAS u32x2*)(mp0 + (sl_cur >> 2)); mw0 = mwv_[0] >> (4 * hi); mw1 = mwv_[1] >> (4 * hi); } \
    VRD(0); AC_SBAR(); float sacc = (P0[0] + P0[1]); \
    GAPA(C0 = AC_MFMA(kf[0], qr[0], negm), P0[2], P0[3], P0[4], P0[5],     pw0[0] = PKW(P0, 0), pw0[1] = PKW(P0, 2), pw0); \
    VRD(4); AC_SBAR(); GAPA(C1 = AC_MFMA(kf[1], qr[0], negm), P0[6], P0[7], P0[8], P0[9],     pw0[2] = PKW(P0, 4), pw0[3] = PKW(P0, 6), pw0); \
    VRD(1); AC_SBAR(); GAPA(C0 = AC_MFMA(kf[2], qr[1], C0),   P0[10], P0[11], P0[12], P0[13], pw1[0] = PKW(P0, 8), pw1[1] = PKW(P0, 10), pw1); \
    VRD(5); AC_SBAR(); GAPA(C1 = AC_MFMA(kf[3], qr[1], C1),   P0[14], P0[15], P1[0], P1[1],   pw1[2] = PKW(P0, 12), pw1[3] = PKW(P0, 14), pw1); \
    VRD(2); AC_SBAR(); GAPA(C0 = AC_MFMA(kf[4], qr[2], C0),   P1[2], P1[3], P1[4], P1[5],     pw2[0] = PKW(P1, 0), pw2[1] = PKW(P1, 2), pw2); \
    VRD(6); AC_SBAR(); GAPA(C1 = AC_MFMA(kf[5], qr[2], C1),   P1[6], P1[7], P1[8], P1[9],     pw2[2] = PKW(P1, 4), pw2[3] = PKW(P1, 6), pw2); \
    VRD(3); AC_SBAR(); GAPA(C0 = AC_MFMA(kf[6], qr[3], C0),   P1[10], P1[11], P1[12], P1[13], pw3[0] = PKW(P1, 8), pw3[1] = PKW(P1, 10), pw3); \
    VRD(7); AC_SBAR(); GAPA(C1 = AC_MFMA(kf[7], qr[3], C1),   P1[14], P1[15], 0.f, 0.f,       pw3[2] = PKW(P1, 12), pw3[3] = PKW(P1, 14), pw3); \
    l_reg += sacc; \
    if (GK) { DMA_K((t) + 3, sl_cur); } if (GV) { DMA_V((t) + 1, sl_next); } if (GM) { DMA_M((t) + 2, sl_prev); } \
    mfq = lutm[mw0 & 15u]; \
    if (BAND) { const int jb_ = (t) - (NT - 4); if (jb_ >= -2) ac_bias(C0, C1, jb_, qrel, hi, lutb); } \
    { float a_ = MX3(C0[0], C0[1], C1[0]), b_ = MX3(C0[2], C0[3], C1[1]); a_ = MX3(a_, C1[2], C1[3]); \
      _Pragma("unroll") for (int r = 4; r < 16; r += 4) { a_ = MX3(a_, C0[r], C0[r + 1]); b_ = MX3(b_, C0[r + 2], C0[r + 3]); a_ = MX3(a_, C1[r], C1[r + 1]); b_ = MX3(b_, C1[r + 2], C1[r + 3]); } \
      float rm = __builtin_fmaxf(a_, b_); { auto rr = __builtin_amdgcn_permlane32_swap(__float_as_uint(rm), __float_as_uint(rm), false, false); rm = __builtin_fmaxf(__uint_as_float(rr[0]), __uint_as_float(rr[1])); } \
      resc = false; \
      if (__builtin_expect(__any(rm > AC_THR), 0)) { const float dl = __builtin_fmaxf(rm, 0.f); mhat += dl; \
        _Pragma("unroll") for (int r = 0; r < 16; ++r) { C0[r] -= dl; C1[r] -= dl; } \
        _Pragma("unroll") for (int r = 0; r < 16; ++r) negm[r] = fb - mhat; asm volatile("" : "+v"(negm)); \
        const float f = __builtin_amdgcn_exp2f(-dl); l_reg *= f; if (hi == 0) wsf[r32] = f; resc = true; } } \
    AC_SBAR(); \
    GAPB(o[0] = AC_MFMA(PAF(0), VFR(0), o[0]), C0, 0, mw0, 8); \
    GAPB(o[1] = AC_MFMA(PAF(0), VFR(4), o[1]), C0, 4, mw0, 16); \
    KRD(GL, 0); GAPB(o[0] = AC_MFMA(PAF(1), VFR(1), o[0]), C0, 8, mw0, 24); \
    KRD(GL, 1); GAPB(o[1] = AC_MFMA(PAF(1), VFR(5), o[1]), C0, 12, mw1, 0); \
    KRD(GL, 2); GAPB(o[0] = AC_MFMA(PAF(2), VFR(2), o[0]), C1, 0, mw1, 8); \
    KRD(GL, 3); GAPB(o[1] = AC_MFMA(PAF(2), VFR(6), o[1]), C1, 4, mw1, 16); \
    GAPB(o[0] = AC_MFMA(PAF(3), VFR(3), o[0]), C1, 8, mw1, 24); \
    GAPB(o[1] = AC_MFMA(PAF(3), VFR(7), o[1]), C1, 12, mw1, 0); \
    } while (0)
    int t = 1;
    for (; t + 7 < NT; t += 2) {
        STEP(pB0, pB1, pA0, pA1, t, false, true, true, true, true);     AC_WAIT_BAR(3); RESC(); ROT();
        STEP(pA0, pA1, pB0, pB1, t + 1, false, true, true, true, true); AC_WAIT_BAR(3); RESC(); ROT();
    }
#define ENDW(tt) do { if ((tt) + 3 < NT) { AC_WAIT_BAR(3); } else if ((tt) + 2 < NT) { AC_WAIT_BAR(2); } else { AC_WAIT_BAR(0); } } while (0)
    for (; t + 1 < NT; t += 2) {
        STEP(pB0, pB1, pA0, pA1, t, true, (t + 3 < NT), (t + 1 < NT), (t + 1 < NT), (t + 2 < NT));         ENDW(t);     RESC(); ROT();
        STEP(pA0, pA1, pB0, pB1, t + 1, true, (t + 4 < NT), (t + 2 < NT), (t + 2 < NT), (t + 3 < NT));     ENDW(t + 1); RESC(); ROT();
    }
    STEP(pB0, pB1, pA0, pA1, NT - 1, true, false, false, false, false); RESC();
    {
        float sacc = pB0[0] + pB0[1];
#pragma unroll
        for (int r = 2; r < 16; ++r) sacc += pB0[r];
#pragma unroll
        for (int r = 0; r < 16; ++r) sacc += pB1[r];
        l_reg += sacc;
        pw0 = (u32x4){PKW(pB0, 0), PKW(pB0, 2), PKW(pB0, 4), PKW(pB0, 6)}; pw1 = (u32x4){PKW(pB0, 8), PKW(pB0, 10), PKW(pB0, 12), PKW(pB0, 14)};
        pw2 = (u32x4){PKW(pB1, 0), PKW(pB1, 2), PKW(pB1, 4), PKW(pB1, 6)}; pw3 = (u32x4){PKW(pB1, 8), PKW(pB1, 10), PKW(pB1, 12), PKW(pB1, 14)};
        const lds_cptr vp_ = vp0 + sl_cur;
#pragma unroll
        for (int i = 0; i < 8; ++i) VRD(i);
        o[0] = AC_MFMA(PAF(0), VFR(0), o[0]); o[1] = AC_MFMA(PAF(0), VFR(4), o[1]); o[0] = AC_MFMA(PAF(1), VFR(1), o[0]); o[1] = AC_MFMA(PAF(1), VFR(5), o[1]);
        o[0] = AC_MFMA(PAF(2), VFR(2), o[0]); o[1] = AC_MFMA(PAF(2), VFR(6), o[1]); o[0] = AC_MFMA(PAF(3), VFR(3), o[0]); o[1] = AC_MFMA(PAF(3), VFR(7), o[1]);
    }
    { auto rr = __builtin_amdgcn_permlane32_swap(__float_as_uint(l_reg), __float_as_uint(l_reg), false, false); l_reg = __uint_as_float(rr[0]) + __uint_as_float(rr[1]); }
    if (hi == 0) wsf[32 + r32] = l_reg;
    asm volatile("s_waitcnt lgkmcnt(0)" ::: "memory");
    float rli[16];
#pragma unroll
    for (int r = 0; r < 16; ++r) rli[r] = __builtin_amdgcn_rcpf(wsf[32 + ac_crow(r, hi)]);
    {
        bf16_t* Ow = Yo + (rowbase + q0 + wid * 32) * DM + h * 64;
        LAS bf16_t* stg = (LAS bf16_t*)(shm + AC_OST) + wid * 2048;
#pragma unroll
        for (int r = 0; r < 16; ++r) { const int orow = ac_crow(r, hi);
#pragma unroll
            for (int d0 = 0; d0 < 2; ++d0) stg[orow * 64 + d0 * 32 + r32] = (bf16_t)(pack_bf16(o[d0][r] * rli[r], 0.f) & 0xffffu); }
        asm volatile("s_waitcnt lgkmcnt(0)" ::: "memory");
#pragma unroll
        for (int i = 0; i < 4; ++i) { const int row = i * 8 + (lane >> 3), ch = lane & 7; const u32x4 v = *(const LAS u32x4*)(stg + row * 64 + ch * 8); *(u32x4*)(Ow + (size_t)row * DM + ch * 8) = v; }
    }
    asm volatile("s_waitcnt lgkmcnt(0)\n\ts_barrier" ::: "memory");
#undef DMA_K
#undef DMA_V
#undef DMA_M
#undef ROT
#undef RESC
#undef PKW
#undef PAF
#undef VFR
#undef PIN
#undef MX3
#undef GAPA
#undef EX
#undef GAPB
#undef VRD
#undef KRD
#undef STEP
#undef ENDW
}

constexpr int AD_SLOTB = 8192, AD_K = 0, AD_V = 3 * AD_SLOTB, AD_WS = AD_V + 3 * 2 * AD_SLOTB, AD_LUTB = AD_WS + 8 * 256, AD_OST = AD_LUTB + 4 * AC_LUTB_LD * 4;
static_assert(AD_OST + 8 * 8192 <= 163840 - 64, "LDS");
DI void attn_d_unit(const Frame& F, int b, int hd, int map, int qb, const bf16_t* Z, const float fb, f32x16 (&o)[4]) {
    LAS unsigned char* shm = F.lds;
    const int lane = fresh_lane(), r32 = lane & 31, hi = lane >> 5, wid = F.wave;
    const size_t rowbase = (size_t)b * SEQ; const int q0 = qb * 256;
    const bf16_t* Qw = Z + (rowbase + q0 + wid * 32) * CD_N + Z_QD + hd * 128 + map * 64;
    const bf16_t* Kh = Z + rowbase * CD_N + Z_KD + hd * 128 + map * 64; const bf16_t* Vh = Z + rowbase * CD_N + Z_VD + hd * 128;
    const unsigned lds0 = (unsigned)(size_t)shm;
    LAS float* wsf = (LAS float*)(shm + AD_WS) + wid * 64;
    const LAS float* lutb = (const LAS float*)(shm + AD_LUTB) + hd * AC_LUTB_LD;
    const bf16_t* ksrc = Kh + (size_t)lane * CD_N + wid * 8;
    const bf16_t* vsrc = Vh + (size_t)(16 * (wid & 3) + (lane >> 2)) * CD_N + (wid >> 2) * 32 + (lane & 3) * 8;
    const unsigned kdst = lds0 + AD_K + wid * 1024, vdst = lds0 + AD_V + wid * 1024;
#define DMA_K(t, slot) ac_glds16(ksrc + (size_t)(t) * 64 * CD_N, (unsigned)__builtin_amdgcn_readfirstlane(kdst + (slot)))
#define DMA_V(t, slot) do { ac_glds16(vsrc + (size_t)(t) * 64 * CD_N, (unsigned)__builtin_amdgcn_readfirstlane(vdst + 2 * (slot))); \
                            ac_glds16(vsrc + (size_t)(t) * 64 * CD_N + 64, (unsigned)__builtin_amdgcn_readfirstlane(vdst + 2 * (slot) + 8192)); } while (0)
    const lds_cptr shm3 = (lds_cptr)shm;
    const lds_cptr kp0 = shm3 + AD_K + hi * 1024 + r32 * 16;
    const lds_cptr vp0 = shm3 + AD_V + ((lane >> 4) & 1) * 32 + (lane & 3) * 8 + (4 * hi + ((lane & 15) >> 2)) * 64;
    const int NT = (q0 + 256) / 64;
    DMA_K(0, 0); DMA_V(0, 0); DMA_K(1, AD_SLOTB);
    bf16x8 qr[4];
#pragma unroll
    for (int d0 = 0; d0 < 4; ++d0) qr[d0] = *(const bf16x8*)(Qw + (size_t)r32 * CD_N + d0 * 16 + hi * 8);
    float mhat = 0.f, l_reg = 0.f; f32x16 negm;
#pragma unroll
    for (int r = 0; r < 16; ++r) { o[0][r] = 0.f; o[1][r] = 0.f; o[2][r] = 0.f; o[3][r] = 0.f; negm[r] = fb; }
    asm volatile("" : "+v"(negm));
    const int qrel = wid * 32 + r32;
    bool resc = false;
    bf16x8 kf[8];
    f32x16 pA0, pA1, pB0, pB1;
    int sl_prev = 0, sl_cur = 0, sl_next = AD_SLOTB;
#define ROT() do { sl_prev = sl_cur; sl_cur = sl_next; sl_next = (sl_next == 2 * AD_SLOTB) ? 0 : sl_next + AD_SLOTB; } while (0)
#define RESC() do { if (resc) { asm volatile("s_waitcnt lgkmcnt(0)" ::: "memory"); \
        _Pragma("unroll") for (int d_ = 0; d_ < 4; ++d_) _Pragma("unroll") for (int r = 0; r < 16; ++r) o[d_][r] *= wsf[ac_crow(r, hi)]; } } while (0)
    DMA_K(2, 2 * AD_SLOTB);
    AC_WAIT_BAR(4);
    {
#pragma unroll
        for (int d0 = 0; d0 < 4; ++d0) ac_kload2(kf, kp0, d0);
        pA0 = AC_MFMA(kf[0], qr[0], negm); pA1 = AC_MFMA(kf[1], qr[0], negm);
#pragma unroll
        for (int d0 = 1; d0 < 4; ++d0) { pA0 = AC_MFMA(kf[2 * d0], qr[d0], pA0); pA1 = AC_MFMA(kf[2 * d0 + 1], qr[d0], pA1); }
        if (NT == 4) ac_bias(pA0, pA1, 0, qrel, hi, lutb);
        float rm = -__builtin_huge_valf();
#pragma unroll
        for (int r = 0; r < 16; ++r) rm = __builtin_fmaxf(rm, __builtin_fmaxf(pA0[r], pA1[r]));
        { auto rr = __builtin_amdgcn_permlane32_swap(__float_as_uint(rm), __float_as_uint(rm), false, false); rm = __builtin_fmaxf(__uint_as_float(rr[0]), __uint_as_float(rr[1])); }
        mhat = rm;
#pragma unroll
        for (int r = 0; r < 16; ++r) negm[r] = fb - mhat;
        asm volatile("" : "+v"(negm));
#pragma unroll
        for (int r = 0; r < 16; ++r) { pA0[r] = __builtin_amdgcn_exp2f(pA0[r] - rm); pA1[r] = __builtin_amdgcn_exp2f(pA1[r] - rm); }
    }
    AC_WAIT_BAR(0);
    DMA_K(3, 0); DMA_V(1, AD_SLOTB);
    ROT();
#pragma unroll
    for (int d0 = 0; d0 < 4; ++d0) ac_kload2(kf, kp0 + sl_cur, d0);
    AC_WAIT_BAR(3);
    s16x4 vlo[4], vhi[4]; u32x4 pw0, pw1, pw2, pw3;
#define PKW(P, B) pack_bf16(P[B], P[B + 1])
#define PAF(k) __builtin_bit_cast(bf16x8, pw##k)
#define VFR(i) (bf16x8){vlo[(i) & 3][0], vlo[(i) & 3][1], vlo[(i) & 3][2], vlo[(i) & 3][3], vhi[(i) & 3][0], vhi[(i) & 3][1], vhi[(i) & 3][2], vhi[(i) & 3][3]}
#define PIN(x) asm volatile("" : "+v"(x))
#define MX3(a, b, c) __builtin_fmaxf(__builtin_fmaxf((a), (b)), (c))
#define VRD(g) do { const int i_ = ((g) & 3) * 4 + ((g) >> 2); vlo[(g) & 3] = ac_vtr(vp_ + ((i_ >> 2) * 4096 + (i_ & 3) * 1024)); vhi[(g) & 3] = ac_vtr(vp_ + ((i_ >> 2) * 4096 + (i_ & 3) * 1024 + 512)); } while (0)
#define GAPA(MF, A0, A1, A2, A3, W0, W1, PW) do { MF; sacc += A0; sacc += A1; sacc += A2; sacc += A3; PIN(sacc); W0; W1; PIN(PW); AC_SBAR(); } while (0)
#define EX(v) __builtin_amdgcn_exp2f(v)
#define GAPB(g, X, B) do { o[(g) & 3] = AC_MFMA(PAF_SEL((g) >> 2), VFR(g), o[(g) & 3]); X[B] = EX(X[B]); X[B + 1] = EX(X[B + 1]); PIN(X); if ((g) + 3 < 16) { VRD((g) + 3); } AC_SBAR(); } while (0)
#define PAF_SEL(k) ((k) == 0 ? PAF(0) : (k) == 1 ? PAF(1) : (k) == 2 ? PAF(2) : PAF(3))
#define KRD(G, j) do { if (G) { ac_kload2(kf, kp0 + sl_next, j); AC_SBAR(); } } while (0)
#define STEP(C0, C1, P0, P1, t, BAND, GK, GV, GL) do { AC_SBAR(); \
    const lds_cptr vp_ = vp0 + 2 * sl_prev; \
    float sacc = (P0[0] + P0[1]); \
    GAPA(C0 = AC_MFMA(kf[0], qr[0], negm), P0[2], P0[3], P0[4], P0[5],     pw0[0] = PKW(P0, 0), pw0[1] = PKW(P0, 2), pw0); \
    GAPA(C1 = AC_MFMA(kf[1], qr[0], negm), P0[6], P0[7], P0[8], P0[9],     pw0[2] = PKW(P0, 4), pw0[3] = PKW(P0, 6), pw0); \
    GAPA(C0 = AC_MFMA(kf[2], qr[1], C0),   P0[10], P0[11], P0[12], P0[13], pw1[0] = PKW(P0, 8), pw1[1] = PKW(P0, 10), pw1); \
    GAPA(C1 = AC_MFMA(kf[3], qr[1], C1),   P0[14], P0[15], P1[0], P1[1],   pw1[2] = PKW(P0, 12), pw1[3] = PKW(P0, 14), pw1); \
    GAPA(C0 = AC_MFMA(kf[4], qr[2], C0),   P1[2], P1[3], P1[4], P1[5],     pw2[0] = PKW(P1, 0), pw2[1] = PKW(P1, 2), pw2); \
    VRD(0); AC_SBAR(); GAPA(C1 = AC_MFMA(kf[5], qr[2], C1),   P1[6], P1[7], P1[8], P1[9],     pw2[2] = PKW(P1, 4), pw2[3] = PKW(P1, 6), pw2); \
    VRD(1); AC_SBAR(); GAPA(C0 = AC_MFMA(kf[6], qr[3], C0),   P1[10], P1[11], P1[12], P1[13], pw3[0] = PKW(P1, 8), pw3[1] = PKW(P1, 10), pw3); \
    VRD(2); AC_SBAR(); GAPA(C1 = AC_MFMA(kf[7], qr[3], C1),   P1[14], P1[15], 0.f, 0.f,       pw3[2] = PKW(P1, 12), pw3[3] = PKW(P1, 14), pw3); \
    l_reg += sacc; \
    if (GK) { DMA_K((t) + 3, sl_cur); } if (GV) { DMA_V((t) + 1, sl_next); } \
    if (BAND) { const int jb_ = (t) - (NT - 4); if (jb_ >= -2) ac_bias(C0, C1, jb_, qrel, hi, lutb); } \
    { float a_ = MX3(C0[0], C0[1], C1[0]), b_ = MX3(C0[2], C0[3], C1[1]); a_ = MX3(a_, C1[2], C1[3]); \
      _Pragma("unroll") for (int r = 4; r < 16; r += 4) { a_ = MX3(a_, C0[r], C0[r + 1]); b_ = MX3(b_, C0[r + 2], C0[r + 3]); a_ = MX3(a_, C1[r], C1[r + 1]); b_ = MX3(b_, C1[r + 2], C1[r + 3]); } \
      float rm = __builtin_fmaxf(a_, b_); { auto rr = __builtin_amdgcn_permlane32_swap(__float_as_uint(rm), __float_as_uint(rm), false, false); rm = __builtin_fmaxf(__uint_as_float(rr[0]), __uint_as_float(rr[1])); } \
      resc = false; \
      if (__builtin_expect(__any(rm > AC_THR), 0)) { const float dl = __builtin_fmaxf(rm, 0.f); mhat += dl; \
        _Pragma("unroll") for (int r = 0; r < 16; ++r) { C0[r] -= dl; C1[r] -= dl; } \
        _Pragma("unroll") for (int r = 0; r < 16; ++r) negm[r] = fb - mhat; asm volatile("" : "+v"(negm)); \
        const float f = __builtin_amdgcn_exp2f(-dl); l_reg *= f; if (hi == 0) wsf[r32] = f; resc = true; } } \
    AC_SBAR(); \
    GAPB(0, C0, 0); GAPB(1, C0, 2); GAPB(2, C0, 4); GAPB(3, C0, 6); \
    KRD(GL, 0); GAPB(4, C0, 8); KRD(GL, 1); GAPB(5, C0, 10); KRD(GL, 2); GAPB(6, C0, 12); KRD(GL, 3); GAPB(7, C0, 14); \
    GAPB(8, C1, 0); GAPB(9, C1, 2); GAPB(10, C1, 4); GAPB(11, C1, 6); GAPB(12, C1, 8); GAPB(13, C1, 10); GAPB(14, C1, 12); GAPB(15, C1, 14); \
    } while (0)
    int t = 1;
    for (; t + 7 < NT; t += 2) {
        STEP(pB0, pB1, pA0, pA1, t, false, true, true, true);     AC_WAIT_BAR(3); RESC(); ROT();
        STEP(pA0, pA1, pB0, pB1, t + 1, false, true, true, true); AC_WAIT_BAR(3); RESC(); ROT();
    }
#define ENDW(tt) do { if ((tt) + 3 < NT) { AC_WAIT_BAR(3); } else if ((tt) + 2 < NT) { AC_WAIT_BAR(2); } else { AC_WAIT_BAR(0); } } while (0)
    for (; t + 1 < NT; t += 2) {
        STEP(pB0, pB1, pA0, pA1, t, true, (t + 3 < NT), (t + 1 < NT), (t + 1 < NT));         ENDW(t);     RESC(); ROT();
        STEP(pA0, pA1, pB0, pB1, t + 1, true, (t + 4 < NT), (t + 2 < NT), (t + 2 < NT));     ENDW(t + 1); RESC(); ROT();
    }
    STEP(pB0, pB1, pA0, pA1, NT - 1, true, false, false, false); RESC();
    {
        float sacc = pB0[0] + pB0[1];
#pragma unroll
        for (int r = 2; r < 16; ++r) sacc += pB0[r];
#pragma unroll
        for (int r = 0; r < 16; ++r) sacc += pB1[r];
        l_reg += sacc;
        pw0 = (u32x4){PKW(pB0, 0), PKW(pB0, 2), PKW(pB0, 4), PKW(pB0, 6)}; pw1 = (u32x4){PKW(pB0, 8), PKW(pB0, 10), PKW(pB0, 12), PKW(pB0, 14)};
        pw2 = (u32x4){PKW(pB1, 0), PKW(pB1, 2), PKW(pB1, 4), PKW(pB1, 6)}; pw3 = (u32x4){PKW(pB1, 8), PKW(pB1, 10), PKW(pB1, 12), PKW(pB1, 14)};
        const lds_cptr vp_ = vp0 + 2 * sl_cur;
        VRD(0); VRD(1); VRD(2);
#pragma unroll
        for (int g = 0; g < 16; ++g) {
            o[g & 3] = AC_MFMA(PAF_SEL(g >> 2), VFR(g), o[g & 3]);
            if (g + 3 < 16) { VRD(g + 3); }
            AC_SBAR();
        }
    }
    { auto rr = __builtin_amdgcn_permlane32_swap(__float_as_uint(l_reg), __float_as_uint(l_reg), false, false); l_reg = __uint_as_float(rr[0]) + __uint_as_float(rr[1]); }
    if (hi == 0) wsf[32 + r32] = l_reg;
    asm volatile("s_waitcnt lgkmcnt(0)" ::: "memory");
#pragma unroll
    for (int r = 0; r < 16; ++r) { const float rl = __builtin_amdgcn_rcpf(wsf[32 + ac_crow(r, hi)]); o[0][r] *= rl; o[1][r] *= rl; o[2][r] *= rl; o[3][r] *= rl; }
    asm volatile("s_waitcnt lgkmcnt(0)\n\ts_barrier" ::: "memory");
#undef DMA_K
#undef DMA_V
#undef ROT
#undef RESC
#undef PKW
#undef PAF
#undef PAF_SEL
#undef VFR
#undef PIN
#undef MX3
#undef GAPA
#undef EX
#undef GAPB
#undef VRD
#undef KRD
#undef STEP
#undef ENDW
}

template <bool DPART>
DI void attn_phase(const Frame& F, const Args& a) {
    const bf16_t* Z = (const bf16_t*)(a.ws + WS_BIG);
    bf16_t* Yo = (bf16_t*)(a.ws + WS_Y);
    float* O1s = (float*)(a.ws + WS_H);
    const unsigned* maskg = (const unsigned*)(a.ws + WS_MASK);
    LAS float* lut = (LAS float*)(F.lds + AT_LUT);
    if (DPART) {
        LAS float* lb = (LAS float*)(F.lds + AD_LUTB);
        for (int i = F.tid; i < 4 * AC_LUTB_LD; i += NTHR) { const int hh = 8 + i / AC_LUTB_LD, d = i % AC_LUTB_LD - 256; lb[i] = d < 0 ? NEG_INF : (rel_bucket_bias(a.rel_bias, d < 128 ? d : 128, hh) - a.rel_bias[31 * 12 + hh]) * LOG2E; }
    } else {
        if (F.tid < 16) ((LAS f32x4*)(F.lds + AC_LUTM))[F.tid] = (f32x4){(float)(F.tid & 1), (float)((F.tid >> 1) & 1), (float)((F.tid >> 2) & 1), (float)((F.tid >> 3) & 1)};
        LAS float* lb = (LAS float*)(F.lds + AC_LUTB);
        for (int i = F.tid; i < 8 * AC_LUTB_LD; i += NTHR) { const int hh = i / AC_LUTB_LD, d = i % AC_LUTB_LD - 256; lb[i] = d < 0 ? NEG_INF : (rel_bucket_bias(a.rel_bias, d < 128 ? d : 128, hh) - a.rel_bias[31 * 12 + hh]) * LOG2E; }
    }
    float lam;
    { float d01 = 0.f, d23 = 0.f; for (int i = 0; i < 64; ++i) { d01 += a.diff_lam[i] * a.diff_lam[64 + i]; d23 += a.diff_lam[128 + i] * a.diff_lam[192 + i]; }
      lam = __expf(d01) - __expf(d23) + 0.35550906759096f; lam = __uint_as_float(__builtin_amdgcn_readfirstlane(__float_as_uint(lam))); }
    const float one_m_li = 1.0f - 0.35550906759096f;
    __syncthreads();
    const float c1 = 0.125f * LOG2E;
    const int xcd = F.bid & 7, kk = F.bid >> 3;
    if (DPART)
    for (int it = F.bid; it < 256; it += F.G) {
        const int bh = (F.G == 256) ? 2 * xcd + (kk >> 4) : it >> 4, pr = (F.G == 256) ? (kk & 15) : (it & 15);
        const int b_ = bh >> 2, hd_ = bh & 3;
        for (int half = 0; half < 2; ++half) {
            const int qb = half ? 31 - pr : pr;
            for (int map = 0; map < 2; ++map) {
                int b = b_, hd = hd_; asm volatile("" : "+s"(b), "+s"(hd));
                float fb = a.rel_bias[31 * 12 + 8 + hd] * LOG2E; fb = __uint_as_float(__builtin_amdgcn_readfirstlane(__float_as_uint(fb)));
                f32x16 O[4];
                attn_d_unit(F, b, hd, map, qb, Z, fb, O);
                const int l1 = fresh_lane(), r32 = l1 & 31, hi = l1 >> 5;
                const size_t tok0 = (size_t)b * SEQ + qb * 256 + 32 * F.wave;
                float* o1p = O1s + tok0 * 512 + 128 * hd + r32;
                if (map == 0) {
#pragma unroll
                    for (int r = 0; r < 16; ++r)
#pragma unroll
                        for (int blk = 0; blk < 4; ++blk) o1p[(size_t)ac_crow(r, hi) * 512 + 32 * blk] = O[blk][r];
                } else {
                    LAS float* wsf = (LAS float*)(F.lds + AD_WS) + F.wave * 64;
                    if (hi == 0) wsf[r32] = 0.f;
                    float ss[16];
#pragma unroll
                    for (int r = 0; r < 16; ++r) {
                        float s_ = 0.f;
#pragma unroll
                        for (int blk = 0; blk < 4; ++blk) { const float v = o1p[(size_t)ac_crow(r, hi) * 512 + 32 * blk] - lam * O[blk][r]; O[blk][r] = v; s_ += v * v; }
                        ss[r] = s_;
                    }
                    asm volatile("s_waitcnt lgkmcnt(0)" ::: "memory");
#pragma unroll
                    for (int r = 0; r < 16; ++r) (void)__hip_atomic_fetch_add(&wsf[ac_crow(r, hi)], ss[r], __ATOMIC_RELAXED, __HIP_MEMORY_SCOPE_WAVEFRONT);
                    asm volatile("s_waitcnt lgkmcnt(0)" ::: "memory");
                    float gn[4];
#pragma unroll
                    for (int blk = 0; blk < 4; ++blk) gn[blk] = a.diff_norm_g[32 * blk + r32] * one_m_li;
                    LAS bf16_t* stg = (LAS bf16_t*)(F.lds + AD_OST) + F.wave * 4096;
#pragma unroll
                    for (int r = 0; r < 16; ++r) {
                        const int orow = ac_crow(r, hi);
                        const float rinv = rsqrtf(wsf[orow] * (1.0f / 128.0f) + EPS);
#pragma unroll
                        for (int blk = 0; blk < 4; ++blk) stg[orow * 128 + 32 * blk + r32] = (bf16_t)(pack_bf16(O[blk][r] * rinv * gn[blk], 0.f) & 0xffffu);
                    }
                    asm volatile("s_waitcnt lgkmcnt(0)" ::: "memory");
                    bf16_t* yp = Yo + tok0 * DM + 512 + 128 * hd;
#pragma unroll
                    for (int i = 0; i < 8; ++i) { const int row = i * 4 + (l1 >> 4), ch = l1 & 15; const u32x4 v = *(const LAS u32x4*)(stg + row * 128 + ch * 8); *(u32x4*)(yp + (size_t)row * DM + ch * 8) = v; }
                    asm volatile("s_waitcnt lgkmcnt(0)" ::: "memory");
                }
            }
        }
    }
    if (!DPART)
    for (int it = F.bid; it < 512; it += F.G) {
        const int rnd = it / F.G;
        const int bh = (F.G == 256) ? 4 * xcd + 2 * rnd + (kk >> 4) : it >> 4, pr = (F.G == 256) ? (kk & 15) : (it & 15);
        const int b_ = bh >> 3, hc_ = bh & 7;
        for (int half = 0; half < 2; ++half) {
            int b = b_, hc = hc_; asm volatile("" : "+s"(b), "+s"(hc));
            float fb = a.rel_bias[31 * 12 + hc] * LOG2E; fb = __uint_as_float(__builtin_amdgcn_readfirstlane(__float_as_uint(fb)));
            attn_c_unit(F, b, hc, half ? 31 - pr : pr, Z, Yo, maskg, fb);
        }
    }
}

#ifndef MK_ONE_LAUNCH
#define MK_ONE_LAUNCH 1
#endif
constexpr int NPH = 17;
__global__ void __launch_bounds__(NTHR, 2) fwd_kernel(Args a) {
    extern __shared__ __attribute__((aligned(16))) unsigned char lds_raw[];
    Frame F; F.lds = (LAS unsigned char*)lds_raw; F.tid = threadIdx.x; F.lane = F.tid & 63; F.wave = __builtin_amdgcn_readfirstlane(F.tid >> 6); F.G = gridDim.x; F.bid = blockIdx.x;
    unsigned* ctl = (unsigned*)(a.ws + WS_CTL);
    volatile LAS unsigned* xbw = (volatile LAS unsigned*)(F.lds + LDS_XB);
    if (F.tid < 4) xbw[F.tid] = 0u;
    __syncthreads();
    const int lo = a.ph_lo, hi = a.ph_hi;
    XcdBarrier bar; bar.bar = ctl + CW_BAR; bar.x = 0; bar.st = xbw;
    if (hi - lo > 1) bar = xcd_barrier_post(ctl + CW_BAR, xbw);
#ifndef PH_ONLY
#define IN(k) (lo <= (k) && (k) < hi)
#else
#define IN(k) ((k) == PH_ONLY && lo <= (k) && (k) < hi)
#endif
#ifndef DUP_PH
#define DUP_PH -1
#endif
#define REP(k) for (int rep_ = 0; rep_ < ((k) == DUP_PH ? 2 : 1); ++rep_)
#ifndef TIME_PH
#define TIME_PH -1
#endif
#define TIME_AMP 4
    unsigned long long tp0_ = 0, tp1_ = 0;
    if (TIME_PH == 0) tp0_ = wall_clock64();
#define SEAM(k) do { if (IN(k) && IN((k) + 1)) xcd_barrier(bar); if ((k) == TIME_PH) tp1_ = wall_clock64(); if ((k) + 1 == TIME_PH) tp0_ = wall_clock64(); } while (0)
    float* mod = (float*)(a.ws + WS_MOD);
    bf16_t* hbuf = (bf16_t*)(a.ws + WS_H);
    bf16_t* ybuf = (bf16_t*)(a.ws + WS_Y);
    LAS int* ntp = (LAS int*)(F.lds + LDS_MISC);

    if (IN(0)) REP(0) { p0_prologue(F, a); } SEAM(0);
    if (IN(1)) REP(1) { norm_phase<false, false, false>(F, a, a.x, 0, 0, 0); } SEAM(1);
    if (IN(2)) REP(2) {
        DenseSched S; S.init(NTOK, AB_N, DM, F.G, F.bid, a.ws + WS_WAB_IN);
        EpiAbIn E{(bf16_t*)(a.ws + WS_BIG)};
        pg8::gemm_phase(F.lds, (const char*)hbuf, DM, S, E);
    } SEAM(2);
    if (IN(3)) REP(3) { conv_phase(F, a); } SEAM(3);
    if (IN(4)) REP(4) {
        DenseSched S; S.init(NTOK, DM, DM, F.G, F.bid, a.ws + WS_WAB_OUT);
        EpiResid E{a.x, a.out, mod + 2 * DM};
        pg8::gemm_phase(F.lds, (const char*)ybuf, DM, S, E);
    } SEAM(4);
#define MOE_PHASES(layer, pb) do { \
        const unsigned* cnt = ctl + CW_CNT + (layer) * NEXP * CNT_STRIDE; \
        if (IN(pb)) { route_phase(F, a, (layer)); } SEAM(pb); \
        if (IN((pb) + 1)) REP((pb) + 1) { \
            moe_tile_table(F, cnt, ntp); \
            MoeSched<true> S; S.ntp = ntp; S.cnt = cnt; S.list = (const int*)(a.ws + WS_LIST); S.W = (const char*)(a.ws + WS_MOE_W); S.nU = 4 * ntp[NEXP]; S.G = F.G; S.c = F.bid; \
            EpiMoeUp E{(bf16_t*)(a.ws + WS_ACT)}; \
            pg8::gemm_phase(F.lds, (const char*)hbuf, DM, S, E); \
        } SEAM((pb) + 1); \
        if (IN((pb) + 2)) REP((pb) + 2) { \
            moe_tile_table(F, cnt, ntp); \
            MoeSched<false> S; S.ntp = ntp; S.cnt = cnt; S.list = nullptr; S.W = (const char*)(a.ws + WS_MOE_W); S.nU = 4 * ntp[NEXP]; S.G = F.G; S.c = F.bid; \
            EpiMoeDown E{(bf16_t*)(a.ws + WS_YMOE), (const float*)(a.ws + WS_GATEV), ntp}; \
            pg8::gemm_phase(F.lds, (const char*)(a.ws + WS_ACT), DEXP, S, E); \
        } SEAM((pb) + 2); } while (0)
    MOE_PHASES(0, 5);
    if (IN(8)) {
        norm_phase<true, false, false>(F, a, a.out, 1, 0, 0);
        cvt_run(F, a, 1, CVT_MOE_TILES);
    } SEAM(8);
    if (IN(9)) REP(9) {
        { DenseSched S; S.init(NTOK, CD_N, DM, F.G, F.bid, a.ws + WS_WCD_IN);
          EpiPlain E{(bf16_t*)(a.ws + WS_BIG), CD_N, 0x33u, 0.125f * LOG2E};
          pg8::gemm_phase(F.lds, (const char*)hbuf, DM, S, E); }
    } SEAM(9);
    if (IN(10)) REP(10) { unsigned long long tacc_ = 0; topk_phase(F, a, tacc_); if (TIME_PH > 100 && TIME_PH < 110) { tp0_ = 0; tp1_ = tacc_; } } SEAM(10);
    if (IN(11)) REP(11) { if (TIME_PH == 111) { __syncthreads(); tp0_ = wall_clock64(); } attn_phase<true>(F, a); __syncthreads(); if (TIME_PH == 111) tp1_ = wall_clock64(); if (TIME_PH == 112) tp0_ = wall_clock64(); attn_phase<false>(F, a); if (TIME_PH == 112) { __syncthreads(); tp1_ = wall_clock64(); } } SEAM(11);
    if (IN(12)) {
        DenseSched S; S.init(NTOK, DM, DM, F.G, F.bid, a.ws + WS_WCD_OUT);
        EpiResid E{a.out, a.out, mod + (size_t)NB * 6 * DM + 2 * DM};
        pg8::gemm_phase(F.lds, (const char*)ybuf, DM, S, E);
    } SEAM(12);
    MOE_PHASES(1, 13);
#undef MOE_PHASES
    if (IN(16)) { norm_phase<true, false, true>(F, a, a.out, 1, 0, 1); }
    if (TIME_PH >= 0) {
        if (TIME_PH == 16) { asm volatile("s_waitcnt vmcnt(0)" ::: "memory"); __syncthreads(); tp1_ = wall_clock64(); }
        if (F.bid == 0 && F.tid == 0) { const unsigned long long te = wall_clock64(), dt = (tp1_ - tp0_) * TIME_AMP; while (wall_clock64() - te < dt) __builtin_amdgcn_s_sleep(8); }
    }
#undef IN
#undef SEAM
}

extern "C" void kernel_launch(void* const* d_in, const int* in_sizes, int n_in, void* d_out, int out_size, void* d_ws, size_t ws_size, hipStream_t stream) {
    static int grid = 0;
    if (grid == 0) {
        if (n_in != 26 || out_size != NTOK * DM || ws_size < WS_END) { fprintf(stderr, "kernel_launch: unexpected problem (n_in %d, out %d, ws %zu < %zu)\n", n_in, out_size, ws_size, (size_t)WS_END); grid = -1; return; }
        int dev = 0, cus = 0, per_cu = 0;
        if (hipGetDevice(&dev) != hipSuccess || hipDeviceGetAttribute(&cus, hipDeviceAttributeMultiprocessorCount, dev) != hipSuccess) { grid = -1; return; }
        if (hipFuncSetAttribute((const void*)fwd_kernel, hipFuncAttributeMaxDynamicSharedMemorySize, LDS_BYTES) != hipSuccess) { fprintf(stderr, "kernel_launch: hipFuncSetAttribute failed\n"); grid = -1; return; }
        if (hipOccupancyMaxActiveBlocksPerMultiprocessor(&per_cu, (const void*)fwd_kernel, NTHR, LDS_BYTES) != hipSuccess || per_cu < 1) { fprintf(stderr, "kernel_launch: occupancy query says %d\n", per_cu); }
        (void)hipGetLastError();
        grid = cus;
    }
    if (grid < 0) return;
    (void)hipMemsetAsync((char*)d_ws + WS_CTL, 0, CTL_BYTES, stream);
    Args a{};
    const float** fp = (const float**)&a.x;
    (void)fp;
    a.x = (const float*)d_in[0]; a.c = (const float*)d_in[1]; a.positions = (const int*)d_in[2]; a.rel_bias = (const float*)d_in[3]; a.norm_g = (const float*)d_in[4];
    a.final_norm_g = (const float*)d_in[5]; a.ada_w = (const float*)d_in[6]; a.ada_b = (const float*)d_in[7]; a.ab_w_in = (const float*)d_in[8]; a.ab_conv_a = (const float*)d_in[9];
    a.ab_conv_b = (const float*)d_in[10]; a.ab_conv_b_bias = (const float*)d_in[11]; a.ab_ln_g = (const float*)d_in[12]; a.ab_ln_b = (const float*)d_in[13]; a.ab_w_out = (const float*)d_in[14];
    a.cd_w_in = (const float*)d_in[15]; a.diff_lam = (const float*)d_in[16]; a.diff_norm_g = (const float*)d_in[17]; a.cd_w_out = (const float*)d_in[18];
    a.moe_wr_g = (const float*)d_in[19]; a.moe_br_g = (const float*)d_in[20]; a.moe_wr_e = (const float*)d_in[21]; a.moe_br_e = (const float*)d_in[22];
    a.moe_w_gate = (const float*)d_in[23]; a.moe_w_up = (const float*)d_in[24]; a.moe_w_down = (const float*)d_in[25];
    a.out = (float*)d_out; a.ws = (unsigned char*)d_ws;
#if MK_ONE_LAUNCH
    a.ph_lo = 0; a.ph_hi = NPH;
    hipLaunchKernelGGL(fwd_kernel, dim3(grid), dim3(NTHR), LDS_BYTES, stream, a);
#else
    for (int p = 0; p < NPH; ++p) { a.ph_lo = p; a.ph_hi = p + 1; hipLaunchKernelGGL(fwd_kernel, dim3(grid), dim3(NTHR), LDS_BYTES, stream, a); }
#endif
}
```

```cpp
#include <hip/hip_runtime.h>
#include <cstdio>
#include <cstdint>

#ifndef TIME_PH
#define TIME_PH -1
#endif
#define LAS __attribute__((address_space(3)))
#define DI __device__ __forceinline__
typedef unsigned short bf16_t;
typedef short bf16x8 __attribute__((ext_vector_type(8)));
typedef short s16x4 __attribute__((ext_vector_type(4)));
typedef float f32x2 __attribute__((ext_vector_type(2)));
typedef float f32x4 __attribute__((ext_vector_type(4)));
typedef float f32x16 __attribute__((ext_vector_type(16)));
typedef unsigned u32x2 __attribute__((ext_vector_type(2)));
typedef unsigned u32x4 __attribute__((ext_vector_type(4)));
typedef __bf16 bf16v2 __attribute__((ext_vector_type(2)));

constexpr int NB = 4, SEQ = 8192, DM = 1024, NTOK = NB * SEQ;
constexpr int NTHR = 512, NWAVE = 8;
constexpr int AB_N = 2560;
constexpr int ZC_N = 1536;
constexpr int CD_SRC_N = 3368;
constexpr int CD_N = 3584;
constexpr int Z_QC = 0, Z_KC = 512, Z_QD = 1024, Z_KD = 1536, Z_QI = 2048, Z_KI = 2304, Z_WI = 2336, Z_VC = 2560, Z_VD = 3072;
constexpr int VT_ROWS = 0;
constexpr int NEXP = 32, DEXP = 512;
constexpr int MOE_ROWS = 2 * NTOK + NEXP * 256;
constexpr float EPS = 1e-6f;
constexpr float LOG2E = 1.4426950408889634f;

constexpr size_t MiB = 1u << 20;
constexpr size_t WS_CTL = 0, CTL_BYTES = 64 * 1024;
constexpr size_t WS_MOD = 1 * MiB;
constexpr size_t WS_WAB_IN = 2 * MiB;
constexpr size_t WS_WAB_OUT = 7 * MiB;
constexpr size_t WS_WCD_IN = 9 * MiB;
constexpr size_t WS_WCD_OUT = 16 * MiB;
constexpr size_t WS_MOE_W = 18 * MiB;
constexpr size_t WS_H = 114 * MiB;
constexpr size_t WS_Y = 178 * MiB;
constexpr size_t WS_BIG = 242 * MiB;
constexpr size_t WS_ACT = WS_BIG;
constexpr size_t WS_YMOE = WS_BIG + 72 * MiB;
constexpr size_t WS_MASK = 466 * MiB;
constexpr size_t WS_LIST = 498 * MiB;
constexpr size_t WS_GATEV = 502 * MiB;
constexpr size_t WS_TOKSLOT = 506 * MiB;
constexpr size_t WS_END = 507 * MiB;

constexpr int CW_BAR = 0;
constexpr int CW_CNT = 4096;
constexpr int CNT_STRIDE = 64;

DI unsigned pack_bf16(float lo, float hi) { f32x2 v = {lo, hi}; bf16v2 b = __builtin_convertvector(v, bf16v2); return __builtin_bit_cast(unsigned, b); }
DI float bf_lo(unsigned w) { return __uint_as_float(w << 16); }
DI float bf_hi(unsigned w) { return __uint_as_float(w & 0xffff0000u); }
DI float bf2f(bf16_t b) { return __uint_as_float(((unsigned)b) << 16); }
DI float wave_sum(float v) {
#pragma unroll
    for (int o = 32; o >= 1; o >>= 1) v += __shfl_xor(v, o);
    return v;
}
DI int fresh_lane() { int l; asm volatile("v_mbcnt_lo_u32_b32 %0, -1, 0\n\tv_mbcnt_hi_u32_b32 %0, -1, %0" : "=v"(l)); return l; }
DI float silu_f(float v) { return v / (1.0f + __expf(-v)); }
DI float sigmoid_f(float v) { return 1.0f / (1.0f + __expf(-v)); }

#define XB_TMO      128
#define XB_XCNT(j)  (256  + 64 * (j))
#define XB_XSUB(j)  (1280 + 64 * (j))
#define XB_XGEN(j)  (2304 + 64 * (j))
#define XB_TOP      3328
#define XB_TOPGEN   3392
#define XCD_BAR_WORDS 3456
#define XB_SPIN_CAP (1u << 22)
DI unsigned xb_ld(unsigned* p)              { return __hip_atomic_load(p, __ATOMIC_RELAXED, __HIP_MEMORY_SCOPE_AGENT); }
DI unsigned xb_add(unsigned* p, unsigned v) { return __hip_atomic_fetch_add(p, v, __ATOMIC_RELAXED, __HIP_MEMORY_SCOPE_AGENT); }
DI unsigned xb_xcc_id() { return (unsigned)__builtin_amdgcn_s_getreg((3 << 11) | 20) & 0xFu; }
#define XB_SPIN(cond, bar) do { unsigned _sp = 0; while (cond) { __builtin_amdgcn_s_sleep(1); \
    if ((++_sp & 255u) == 0u) { if (xb_ld(&(bar)[XB_TMO])) break; if (_sp > XB_SPIN_CAP) { atomicAdd(&(bar)[XB_TMO], 1u); break; } } } } while (0)
struct XcdBarrier { unsigned* bar; unsigned x; volatile LAS unsigned* st; };
DI XcdBarrier xcd_barrier_post(unsigned* bar, volatile LAS unsigned* st) {
    XcdBarrier b; b.bar = bar; b.x = xb_xcc_id(); b.st = st;
    if (threadIdx.x == 0) (void)xb_add(&bar[XB_XCNT(b.x)], 1u);
    return b;
}
DI void xcd_barrier_complete(unsigned* bar, unsigned x, unsigned& nloc, unsigned& nx) {
    const unsigned G = gridDim.x * gridDim.y * gridDim.z;
    unsigned sum, cnt, mine, sp = 0u;
    for (;;) {
        sum = 0u; cnt = 0u; mine = 0u;
#pragma unroll
        for (unsigned j = 0; j < 16; ++j) { const unsigned c = xb_ld(&bar[XB_XCNT(j)]); sum += c; cnt += (c > 0u) ? 1u : 0u; mine = (j == x) ? c : mine; }
        if (sum == G) break;
        __builtin_amdgcn_s_sleep(1);
        if ((++sp & 255u) == 0u) { if (xb_ld(&bar[XB_TMO])) break; if (sp > XB_SPIN_CAP) { atomicAdd(&bar[XB_TMO], 1u); break; } }
    }
    nloc = mine > 0u ? mine : 1u; nx = cnt > 0u ? cnt : 1u;
}
DI void xcd_barrier(const XcdBarrier& b) {
    asm volatile("s_waitcnt vmcnt(0)" ::: "memory");
    __syncthreads();
    if (threadIdx.x == 0) {
        unsigned* bar = b.bar;
        __builtin_amdgcn_s_waitcnt(0);
        unsigned nloc = b.st[0], nx = b.st[1];
        if (nloc == 0u) { xcd_barrier_complete(bar, b.x, nloc, nx); b.st[0] = nloc; b.st[1] = nx; }
        const unsigned old = xb_add(&bar[XB_XSUB(b.x)], 1u);
        const unsigned gen = old / nloc;
        if (old + 1u == (gen + 1u) * nloc) {
            __builtin_amdgcn_fence(__ATOMIC_RELEASE, "agent");
            asm volatile("s_waitcnt vmcnt(0)" ::: "memory");
            const unsigned og = xb_add(&bar[XB_TOP], 1u);
            const unsigned tg = og / nx;
            if (og + 1u == (tg + 1u) * nx) xb_add(&bar[XB_TOPGEN], 1u);
            else XB_SPIN(xb_ld(&bar[XB_TOPGEN]) == tg, bar);
            __builtin_amdgcn_fence(__ATOMIC_ACQUIRE, "agent");
            xb_add(&bar[XB_XGEN(b.x)], 1u);
            asm volatile("s_waitcnt vmcnt(0)" ::: "memory");
        } else {
            XB_SPIN(xb_ld(&bar[XB_XGEN(b.x)]) == gen, bar);
            __builtin_amdgcn_fence(__ATOMIC_ACQUIRE, "agent");
            asm volatile("s_waitcnt vmcnt(0)" ::: "memory");
        }
    }
    __syncthreads();
}

namespace pg8 {
constexpr int BM = 256, BK = 64, HALF = 128, HTB = HALF * BK * 2, STAGE_BYTES = 8 * HTB;
DI int lds_byte(int r, int c) { const int st = (r >> 4) * 2 + (c >> 5), rr = r & 15, cc = c & 31, ob = rr * 64 + cc * 2; return st * 1024 + (ob ^ (((ob >> 9) & 1) << 5)); }
DI void stage_rc(int b, int& R, int& C) { const int st = b / 1024, sb = b % 1024, swz = sb ^ (((sb >> 9) & 1) << 5); R = (st >> 1) * 16 + swz / 64; C = (st & 1) * 32 + (swz % 64) / 2; }
struct Unit { int pm, pn, e, nrow; };

template <class Epi, class Sched>
DI void gemm_phase(LAS unsigned char* lds, const char* Abase, const int K, const Sched& S, const Epi& E) {
    const int tid = threadIdx.x, wid = __builtin_amdgcn_readfirstlane(tid >> 6), lane = tid & 63, wr = wid >> 2, wc = wid & 3, fr = lane & 15, fq = lane >> 4;
    const int nt = K / BK;
    int Rr[2], Cc[2]; unsigned voffB[2];
#pragma unroll
    for (int i = 0; i < 2; ++i) { int R, C; stage_rc(tid * 16 + i * 8192, R, C); Rr[i] = R; Cc[i] = C; voffB[i] = (unsigned)(R * K + C) * 2u; }
    const size_t kstep = (size_t)(BK * 2);
    const size_t hstep = (size_t)HALF * K * 2;
    const unsigned ldsw = (unsigned)wid * 1024u;
    const int aoff = lds_byte(wr * 64 + fr, fq * 8), boff = lds_byte(wc * 32 + fr, fq * 8);
#define PG8_SA(b, h) (((b) * 2 + (h)) * HTB)
#define PG8_SB(b, h) ((4 + (b) * 2 + (h)) * HTB)
#define PG8_STAGE(bufoff, gbase, voff) do { _Pragma("unroll") for (int _i = 0; _i < 2; ++_i) \
        __builtin_amdgcn_global_load_lds((const unsigned*)((const char*)(gbase) + (voff)[_i]), (LAS unsigned*)(lds + (bufoff) + ldsw + _i * 8192), 16, 0, 0); } while (0)
#define PG8_AOFF(dst, u) do { _Pragma("unroll") for (int _h = 0; _h < 2; ++_h) _Pragma("unroll") for (int _i = 0; _i < 2; ++_i) \
        dst[_h][_i] = ((unsigned)S.a_row(u, _h * HALF + Rr[_i]) * (unsigned)K + (unsigned)Cc[_i]) * 2u; } while (0)
#define PG8_LDA(dst, b, h) do { _Pragma("unroll") for (int m = 0; m < 4; ++m) _Pragma("unroll") for (int k = 0; k < 2; ++k) dst[m][k] = *(const LAS bf16x8*)(lds + PG8_SA(b, h) + aoff + m * 2048 + k * 1024); } while (0)
#define PG8_LDB(dst, b, h) do { _Pragma("unroll") for (int n = 0; n < 2; ++n) _Pragma("unroll") for (int k = 0; k < 2; ++k) dst[n][k] = *(const LAS bf16x8*)(lds + PG8_SB(b, h) + boff + n * 2048 + k * 1024); } while (0)
#define PG8_MMA(ai, bj, At, Bt) do { __builtin_amdgcn_s_setprio(1); _Pragma("unroll") for (int m = 0; m < 4; ++m) _Pragma("unroll") for (int n = 0; n < 2; ++n) _Pragma("unroll") for (int k = 0; k < 2; ++k) \
        acc[ai][bj][m][n] = __builtin_amdgcn_mfma_f32_16x16x32_bf16(Bt[n][k], At[m][k], acc[ai][bj][m][n], 0, 0, 0); __builtin_amdgcn_s_setprio(0); } while (0)
#define PG8_WAIT_V(n) asm volatile("s_waitcnt vmcnt(" #n ")" ::: "memory")
#define PG8_WAIT_L(n) asm volatile("s_waitcnt lgkmcnt(" #n ")" ::: "memory")
#define PG8_BAR __builtin_amdgcn_s_barrier()
#define PG8_SCHED __builtin_amdgcn_sched_barrier(0)
    Unit cur, nxt; int ui = 0;
    if (!S.next(0, cur)) return;
    f32x4 acc[2][2][4][2];
#pragma unroll
    for (int a = 0; a < 2; ++a)
#pragma unroll
        for (int b = 0; b < 2; ++b)
#pragma unroll
            for (int m = 0; m < 4; ++m)
#pragma unroll
                for (int n = 0; n < 2; ++n) acc[a][b][m][n] = (f32x4){0.f, 0.f, 0.f, 0.f};
    bf16x8 At[4][2], B0[2][2], B1[2][2];
    unsigned aoC[2][2], aoN[2][2];
    PG8_AOFF(aoC, cur);
    const char* cB = S.b_base(cur);
    PG8_STAGE(PG8_SB(0, 0), cB, voffB); PG8_STAGE(PG8_SA(0, 0), Abase, aoC[0]); PG8_STAGE(PG8_SB(0, 1), cB + hstep, voffB); PG8_STAGE(PG8_SA(0, 1), Abase, aoC[1]);
    if (wr == 1) PG8_BAR;
    PG8_WAIT_V(4); PG8_BAR;
    PG8_STAGE(PG8_SB(1, 0), cB + kstep, voffB); PG8_STAGE(PG8_SA(1, 0), Abase + kstep, aoC[0]); PG8_STAGE(PG8_SB(1, 1), cB + hstep + kstep, voffB);
    PG8_WAIT_V(6); PG8_BAR;
    for (;;) {
        const bool has_next = S.next(ui + 1, nxt);
        const char* nB = cB;
#pragma unroll
        for (int _h = 0; _h < 2; ++_h)
#pragma unroll
            for (int _i = 0; _i < 2; ++_i) aoN[_h][_i] = aoC[_h][_i];
        if (has_next) { PG8_AOFF(aoN, nxt); nB = S.b_base(nxt); }
        for (int t = 0; t < nt; t += 2) {
            const bool last = (t == nt - 2);
            const char* a1 = Abase + (size_t)(t + 1) * kstep;
            const char* a2 = last ? Abase : Abase + (size_t)(t + 2) * kstep; const char* b2 = last ? nB : cB + (size_t)(t + 2) * kstep;
            const char* a3 = a2 + kstep; const char* b3 = b2 + kstep;
            unsigned ao2[2][2];
#pragma unroll
            for (int _h = 0; _h < 2; ++_h)
#pragma unroll
                for (int _i = 0; _i < 2; ++_i) ao2[_h][_i] = last ? aoN[_h][_i] : aoC[_h][_i];
            PG8_LDB(B0, 0, 0); PG8_SCHED; PG8_LDA(At, 0, 0); PG8_STAGE(PG8_SA(1, 1), a1, aoC[1]);
            PG8_WAIT_L(8); PG8_BAR; PG8_WAIT_L(0); PG8_MMA(0, 0, At, B0); PG8_BAR; PG8_SCHED;
            PG8_LDB(B1, 0, 1); PG8_STAGE(PG8_SB(0, 0), b2, voffB);
            PG8_BAR; PG8_WAIT_L(0); PG8_MMA(0, 1, At, B1); PG8_BAR;
            PG8_LDA(At, 0, 1); PG8_STAGE(PG8_SA(0, 0), a2, ao2[0]);
            PG8_BAR; PG8_WAIT_L(0); PG8_MMA(1, 0, At, B0); PG8_BAR; PG8_SCHED;
            PG8_STAGE(PG8_SB(0, 1), b2 + hstep, voffB);
            PG8_WAIT_V(6); PG8_BAR; PG8_MMA(1, 1, At, B1); PG8_BAR;
            PG8_LDB(B0, 1, 0); PG8_SCHED; PG8_LDA(At, 1, 0); PG8_STAGE(PG8_SA(0, 1), a2, ao2[1]);
            PG8_WAIT_L(8); PG8_BAR; PG8_WAIT_L(0); PG8_MMA(0, 0, At, B0); PG8_BAR; PG8_SCHED;
            PG8_LDB(B1, 1, 1); PG8_STAGE(PG8_SB(1, 0), b3, voffB);
            PG8_BAR; PG8_WAIT_L(0); PG8_MMA(0, 1, At, B1); PG8_BAR;
            PG8_LDA(At, 1, 1); PG8_STAGE(PG8_SA(1, 0), a3, ao2[0]);
            PG8_BAR; PG8_WAIT_L(0); PG8_MMA(1, 0, At, B0); PG8_BAR; PG8_SCHED;
            PG8_STAGE(PG8_SB(1, 1), b3 + hstep, voffB);
            PG8_WAIT_V(6); PG8_BAR; PG8_MMA(1, 1, At, B1); PG8_BAR;
        }
        E(acc, cur, wr, wc, fr, fq);
        if (!has_next) break;
#pragma unroll
        for (int a = 0; a < 2; ++a)
#pragma unroll
            for (int b = 0; b < 2; ++b)
#pragma unroll
                for (int m = 0; m < 4; ++m)
#pragma unroll
                    for (int n = 0; n < 2; ++n) acc[a][b][m][n] = (f32x4){0.f, 0.f, 0.f, 0.f};
        cur = nxt; cB = nB; ++ui;
#pragma unroll
        for (int _h = 0; _h < 2; ++_h)
#pragma unroll
            for (int _i = 0; _i < 2; ++_i) aoC[_h][_i] = aoN[_h][_i];
    }
    PG8_WAIT_V(0);
    if (wr == 0) PG8_BAR;
    PG8_BAR;
#undef PG8_SA
#undef PG8_SB
#undef PG8_STAGE
#undef PG8_AOFF
#undef PG8_LDA
#undef PG8_LDB
#undef PG8_MMA
#undef PG8_WAIT_V
#undef PG8_WAIT_L
#undef PG8_BAR
#undef PG8_SCHED
}
}

struct Args {
    const float* x; const float* c; const int* positions; const float* rel_bias; const float* norm_g; const float* final_norm_g;
    const float* ada_w; const float* ada_b; const float* ab_w_in; const float* ab_conv_a; const float* ab_conv_b; const float* ab_conv_b_bias;
    const float* ab_ln_g; const float* ab_ln_b; const float* ab_w_out; const float* cd_w_in; const float* diff_lam; const float* diff_norm_g;
    const float* cd_w_out; const float* moe_wr_g; const float* moe_br_g; const float* moe_wr_e; const float* moe_br_e;
    const float* moe_w_gate; const float* moe_w_up; const float* moe_w_down;
    float* out; unsigned char* ws; int ph_lo, ph_hi;
};
struct Frame {
    LAS unsigned char* lds; int tid, lane, wave, G, bid;
};

struct RowSrc { const float* p; int ld; };
DI int perm32(int rho) { const int n = rho >> 4, i = rho & 15; return 8 * (i >> 2) + 4 * n + (i & 3); }
DI int permrow(int r) { return (r & ~31) + perm32(r & 31); }
DI void ilv(int rp, int& j, int& second) { const int U = rp >> 8, ru = rp & 255, bj = ru >> 7, wc = (ru >> 5) & 3, n = (ru >> 4) & 1, fq = (ru >> 2) & 3, e = ru & 3; j = 128 * U + 32 * wc + 8 * fq + 4 * bj + e; second = n; }

enum { CV_AB_IN = 0, CV_AB_OUT = 1, CV_CD_IN = 2, CV_CD_OUT = 3, CV_MOE_GU = 4, CV_MOE_D = 5 };
template <int KIND> DI RowSrc row_src(const Args& a, int layer, int e, int r) {
    RowSrc s; s.p = nullptr; s.ld = 0;
    if (KIND == CV_AB_IN) {
        s.ld = AB_N;
        if (r < 512) s.p = a.ab_w_in + permrow(r);
        else if (r < 1536) { int j, sec; ilv(r - 512, j, sec); s.p = a.ab_w_in + (sec ? 1024 + j : 512 + j); }
        else { int j, sec; ilv(r - 1536, j, sec); s.p = a.ab_w_in + (sec ? 2048 + j : 1536 + j); }
    } else if (KIND == CV_AB_OUT) { s.ld = DM; s.p = a.ab_w_out + r; }
    else if (KIND == CV_CD_IN) {
        s.ld = CD_SRC_N;
        int col = -1;
        if (r < CD_N) r = permrow(r);
        if (r < 1024) col = r;
        else if (r < 2048) col = 1832 + (r - 1024);
        else if (r < 2304) col = 1536 + (r - 2048);
        else if (r < 2336) col = 1792 + (r - 2304);
        else if (r < 2344) col = 1824 + (r - 2336);
        else if (r < 2560) col = -1;
        else if (r < 3072) col = 1024 + (r - 2560);
        else col = 2856 + (r - 3072);
        if (col >= 0) s.p = a.cd_w_in + col;
    } else if (KIND == CV_CD_OUT) { s.ld = DM; s.p = a.cd_w_out + r; }
    else if (KIND == CV_MOE_GU) {
        int j, sec; ilv(r, j, sec); s.ld = DEXP;
        const size_t base = ((size_t)layer * NEXP + e) * (size_t)DM * DEXP;
        s.p = (sec ? a.moe_w_up : a.moe_w_gate) + base + j;
    } else {
        s.ld = DM; s.p = a.moe_w_down + ((size_t)layer * NEXP + e) * (size_t)DEXP * DM + permrow(r);
    }
    return s;
}
constexpr int CV_LD = 258;
struct CvtTile { const float* sp; int ld; bf16_t* dst; int K, r0, k0; };
template <int KIND> DI CvtTile cvt_desc(const Frame& F, const Args& a, bf16_t* dst, int K, int r0, int k0, int layer, int e) {
    const RowSrc s = row_src<KIND>(a, layer, e, r0 + 4 * (F.tid & 15));
    CvtTile t; t.sp = s.p; t.ld = s.ld; t.dst = dst; t.K = K; t.r0 = r0; t.k0 = k0; return t;
}
constexpr int CVT_DENSE_TILES = (AB_N + DM + CD_N + VT_ROWS + DM) / 64 * (DM / 256);
constexpr int CVT_MOE_TILES_PER_EXP = (1024 / 64) * (1024 / 256) + (1024 / 64) * (512 / 256);
constexpr int CVT_MOE_TILES = NEXP * CVT_MOE_TILES_PER_EXP;
DI CvtTile cvt_dense_desc(const Frame& F, const Args& a, int item) {
    const int rt = item >> 2, kt = item & 3;
    int r = rt * 64;
    if (r < AB_N) return cvt_desc<CV_AB_IN>(F, a, (bf16_t*)(a.ws + WS_WAB_IN), DM, r, kt * 256, 0, 0);
    r -= AB_N;
    if (r < DM) return cvt_desc<CV_AB_OUT>(F, a, (bf16_t*)(a.ws + WS_WAB_OUT), DM, r, kt * 256, 0, 0);
    r -= DM;
    if (r < CD_N + VT_ROWS) return cvt_desc<CV_CD_IN>(F, a, (bf16_t*)(a.ws + WS_WCD_IN), DM, r, kt * 256, 0, 0);
    r -= CD_N + VT_ROWS;
    return cvt_desc<CV_CD_OUT>(F, a, (bf16_t*)(a.ws + WS_WCD_OUT), DM, r, kt * 256, 0, 0);
}
DI CvtTile cvt_moe_desc(const Frame& F, const Args& a, int layer, int item) {
    const int e = item / CVT_MOE_TILES_PER_EXP, t = item % CVT_MOE_TILES_PER_EXP;
    bf16_t* base = (bf16_t*)(a.ws + WS_MOE_W + (size_t)e * 3 * MiB);
    if (t < 64) return cvt_desc<CV_MOE_GU>(F, a, base, DM, (t >> 2) * 64, (t & 3) * 256, layer, e);
    const int t2 = t - 64; return cvt_desc<CV_MOE_D>(F, a, base + (size_t)DM * DM, DEXP, (t2 >> 1) * 64, (t2 & 1) * 256, layer, e);
}
DI void cvt_load(const Frame& F, const CvtTile& t, f32x4 (&v)[8]) {
#pragma unroll
    for (int it = 0; it < 8; ++it) {
        const int kk = (F.tid >> 4) + 32 * it;
        v[it] = (f32x4){0.f, 0.f, 0.f, 0.f};
        if (t.sp) v[it] = *(const f32x4*)(t.sp + (size_t)(t.k0 + kk) * t.ld);
    }
}
DI void cvt_store(const Frame& F, const CvtTile& t, const f32x4 (&v)[8]) {
    LAS bf16_t* T = (LAS bf16_t*)F.lds;
    const int c4 = F.tid & 15;
#pragma unroll
    for (int it = 0; it < 8; ++it) {
        const int kk = (F.tid >> 4) + 32 * it;
        const unsigned p01 = pack_bf16(v[it][0], v[it][1]), p23 = pack_bf16(v[it][2], v[it][3]);
        T[(4 * c4 + 0) * CV_LD + kk] = (bf16_t)(p01 & 0xffffu); T[(4 * c4 + 1) * CV_LD + kk] = (bf16_t)(p01 >> 16);
        T[(4 * c4 + 2) * CV_LD + kk] = (bf16_t)(p23 & 0xffffu); T[(4 * c4 + 3) * CV_LD + kk] = (bf16_t)(p23 >> 16);
    }
    __syncthreads();
    {
        const int rr = F.tid >> 3, c = F.tid & 7;
#pragma unroll
        for (int j = 0; j < 4; ++j) {
            const LAS unsigned* src = (const LAS unsigned*)(T + rr * CV_LD + 64 * j + c * 8);
            u32x4 w; w[0] = src[0]; w[1] = src[1]; w[2] = src[2]; w[3] = src[3];
            *(u32x4*)(t.dst + (size_t)(t.r0 + rr) * t.K + t.k0 + 64 * j + c * 8) = w;
        }
    }
    __syncthreads();
}
DI CvtTile cvt_any_desc(const Frame& F, const Args& a, int which, int item) {
    if (which == 0) { if (item < CVT_DENSE_TILES) return cvt_dense_desc(F, a, item); return cvt_moe_desc(F, a, 0, item - CVT_DENSE_TILES); }
    return cvt_moe_desc(F, a, 1, item);
}
DI void cvt_run(const Frame& F, const Args& a, int which, int n_items) {
    int it = F.bid;
    if (it >= n_items) return;
    CvtTile t0 = cvt_any_desc(F, a, which, it), t1 = t0, t2 = t0;
    f32x4 v0[8], v1[8], v2[8];
    cvt_load(F, t0, v0);
    bool h1 = it + F.G < n_items, h2 = it + 2 * F.G < n_items;
    if (h1) { t1 = cvt_any_desc(F, a, which, it + F.G); cvt_load(F, t1, v1); }
    for (;;) {
        h2 = it + 2 * F.G < n_items;
        if (h2) { t2 = cvt_any_desc(F, a, which, it + 2 * F.G); cvt_load(F, t2, v2); }
        cvt_store(F, t0, v0);
        if (!h1) break;
        it += F.G; t0 = t1; t1 = t2; h1 = h2;
#pragma unroll
        for (int i = 0; i < 8; ++i) { v0[i] = v1[i]; v1[i] = v2[i]; }
    }
}
DI void mod_item(const Frame& F, const Args& a, int item) {
    LAS float* sc = (LAS float*)F.lds;
    LAS float* part = (LAS float*)(F.lds + 16384);
    for (int i = F.tid; i < NB * DM; i += NTHR) sc[i] = silu_f(a.c[i]);
    __syncthreads();
    const int l = item / 96, j = (item % 96) * 64 + F.lane;
    const float* w = a.ada_w + (size_t)l * DM * 6 * DM + (size_t)(F.wave * 128) * 6 * DM + j;
    float acc[NB] = {0.f, 0.f, 0.f, 0.f};
#pragma unroll 32
    for (int k = 0; k < 128; ++k) {
        const float wv = w[(size_t)k * 6 * DM];
#pragma unroll
        for (int b = 0; b < NB; ++b) acc[b] += sc[b * DM + F.wave * 128 + k] * wv;
    }
#pragma unroll
    for (int b = 0; b < NB; ++b) part[(F.wave * NB + b) * 64 + F.lane] = acc[b];
    __syncthreads();
    if (F.tid < NB * 64) {
        const int b = F.tid >> 6, c = F.tid & 63;
        float sum = 0.f;
#pragma unroll
        for (int wv = 0; wv < NWAVE; ++wv) sum += part[(wv * NB + b) * 64 + c];
        const int jj = (item % 96) * 64 + c;
        float* mod = (float*)(a.ws + WS_MOD);
        mod[((size_t)l * NB + b) * 6 * DM + jj] = sum + a.ada_b[l * 6 * DM + jj];
    }
    __syncthreads();
}
DI void p0_prologue(const Frame& F, const Args& a) {
    for (int it = F.bid; it < 192; it += F.G) mod_item(F, a, it);
    cvt_run(F, a, 0, CVT_DENSE_TILES + CVT_MOE_TILES);
}

constexpr int WR_LD = 1028;
DI void moe_seg_table(const Frame& F, const unsigned* cnt, LAS int* seg  ) {
    if (F.tid < NEXP) seg[40 + F.tid] = (int)cnt[F.tid * CNT_STRIDE];
    __syncthreads();
    if (F.tid == 0) { int s = 0; for (int e = 0; e < NEXP; ++e) { seg[e] = s; s += ((seg[40 + e] + 255) >> 8) << 8; } seg[NEXP] = s; }
    __syncthreads();
}
template <bool COMBINE, bool ROUTE, bool FINAL>
DI void norm_phase(const Frame& F, const Args& a, const float* xsrc, int layer, int which, int layer_c) {
    const float* mod = (const float*)(a.ws + WS_MOD);
    bf16_t* hbuf = (bf16_t*)(a.ws + WS_H);
    unsigned* ctl = (unsigned*)(a.ws + WS_CTL);
    LAS float* wrT = (LAS float*)F.lds;
    LAS float* brs = (LAS float*)(F.lds + 36 * WR_LD * 4);
    LAS int* seg = (LAS int*)F.lds;
    constexpr int RT_CAP = 512;
    LAS int* rcnt = (LAS int*)(F.lds + 149504);
    LAS int* rbase = (LAS int*)(F.lds + 149632);
    LAS int* rt_er = (LAS int*)(F.lds + 149760);
    LAS float* rt_gate = (LAS float*)(F.lds + 149760 + 4096);
    LAS int* rt_tok = (LAS int*)(F.lds + 149760 + 8192);
    if (ROUTE) {
        const float* wg = a.moe_wr_g + (size_t)layer * DM * 4;
        const float* we = a.moe_wr_e + (size_t)layer * DM * 32;
        for (int i = F.tid; i < DM * 4; i += NTHR) { const int k = i >> 2, j = i & 3; wrT[j * WR_LD + k] = wg[i]; }
        for (int i = F.tid; i < DM * 32; i += NTHR) { const int k = i >> 5, j = i & 31; wrT[(4 + j) * WR_LD + k] = we[i]; }
        if (F.tid < NEXP) rcnt[F.tid] = 0;
        for (int i = F.tid; i < 2 * RT_CAP; i += NTHR) rt_er[i] = -1;
        if (F.tid < 4) brs[F.tid] = a.moe_br_g[layer * 4 + F.tid];
        else if (F.tid < 36) brs[F.tid] = a.moe_br_e[layer * 32 + F.tid - 4];
        __syncthreads();
    }
    if (COMBINE) moe_seg_table(F, ctl + CW_CNT + layer_c * NEXP * CNT_STRIDE, seg);
    const bf16_t* ymoe = (const bf16_t*)(a.ws + WS_YMOE);
    const int* tokslot = (const int*)(a.ws + WS_TOKSLOT);
    constexpr int TPW = ROUTE ? 2 : 4;
    for (int tb = (F.bid * NWAVE + F.wave) * TPW; tb < NTOK; tb += F.G * NWAVE * TPW) {
      const int b = tb / SEQ;
      f32x4 xall[TPW][4];
#pragma unroll
      for (int i = 0; i < TPW; ++i)
#pragma unroll
        for (int c = 0; c < 4; ++c) xall[i][c] = *(const f32x4*)(xsrc + (size_t)(tb + i) * DM + c * 256 + F.lane * 4);
      if (COMBINE) {
        int ts[TPW][2];
#pragma unroll
        for (int i = 0; i < TPW; ++i) { ts[i][0] = tokslot[(tb + i) * 2]; ts[i][1] = tokslot[(tb + i) * 2 + 1]; }
        u32x2 yv[TPW][2][4];
#pragma unroll
        for (int i = 0; i < TPW; ++i)
#pragma unroll
          for (int k = 0; k < 2; ++k) {
            const size_t r = (size_t)(seg[ts[i][k] >> 20] + (ts[i][k] & 0xfffff));
#pragma unroll
            for (int c = 0; c < 4; ++c) yv[i][k][c] = *(const u32x2*)(ymoe + r * DM + c * 256 + F.lane * 4);
          }
        const float* g2 = mod + ((size_t)layer_c * NB + b) * 6 * DM + 5 * DM;
#pragma unroll
        for (int c = 0; c < 4; ++c) {
          const int col = c * 256 + F.lane * 4;
          const f32x4 gv = *(const f32x4*)(g2 + col);
#pragma unroll
          for (int i = 0; i < TPW; ++i) {
            const u32x2 y0 = yv[i][0][c], y1 = yv[i][1][c];
            xall[i][c][0] += gv[0] * (bf_lo(y0[0]) + bf_lo(y1[0])); xall[i][c][1] += gv[1] * (bf_hi(y0[0]) + bf_hi(y1[0]));
            xall[i][c][2] += gv[2] * (bf_lo(y0[1]) + bf_lo(y1[1])); xall[i][c][3] += gv[3] * (bf_hi(y0[1]) + bf_hi(y1[1]));
            if (!FINAL) *(f32x4*)(a.out + (size_t)(tb + i) * DM + col) = xall[i][c];
          }
        }
      }
#pragma unroll
      for (int ti = 0; ti < TPW; ++ti) {
        const int tok = tb + ti;
        f32x4 xv[4];
#pragma unroll
        for (int c = 0; c < 4; ++c) xv[c] = xall[ti][c];
        float ss = 0.f;
#pragma unroll
        for (int c = 0; c < 4; ++c) ss += xv[c][0] * xv[c][0] + xv[c][1] * xv[c][1] + xv[c][2] * xv[c][2] + xv[c][3] * xv[c][3];
        ss = wave_sum(ss);
        const float rinv = rsqrtf(ss * (1.0f / DM) + EPS);
        if (FINAL) {
#pragma unroll
            for (int c = 0; c < 4; ++c) {
                const int col = c * 256 + F.lane * 4;
                const f32x4 g = *(const f32x4*)(a.final_norm_g + col);
                f32x4 o; o[0] = xv[c][0] * rinv * g[0]; o[1] = xv[c][1] * rinv * g[1]; o[2] = xv[c][2] * rinv * g[2]; o[3] = xv[c][3] * rinv * g[3];
                *(f32x4*)(a.out + (size_t)tok * DM + col) = o;
            }
            continue;
        }
        const float* ng = a.norm_g + ((size_t)layer * 2 + which) * DM;
        const float* sh = mod + ((size_t)layer * NB + b) * 6 * DM + (which ? 3 : 0) * DM;
        const float* sc = sh + DM;
        f32x4 hv[4];
#pragma unroll
        for (int c = 0; c < 4; ++c) {
            const int col = c * 256 + F.lane * 4;
            const f32x4 g = *(const f32x4*)(ng + col), s1 = *(const f32x4*)(sc + col), s0 = *(const f32x4*)(sh + col);
#pragma unroll
            for (int u = 0; u < 4; ++u) hv[c][u] = (xv[c][u] * rinv * g[u]) * (1.0f + s1[u]) + s0[u];
            u32x2 w; w[0] = pack_bf16(hv[c][0], hv[c][1]); w[1] = pack_bf16(hv[c][2], hv[c][3]);
            *(u32x2*)(hbuf + (size_t)tok * DM + col) = w;
        }
        if (ROUTE) {
            LAS float* lgs = (LAS float*)(F.lds + 36 * WR_LD * 4 + 256) + F.wave * 36;
#pragma unroll 1
            for (int jb = 0; jb < 36; jb += 4) {
                float pp[4];
#pragma unroll
                for (int u = 0; u < 4; ++u) {
                    float p = 0.f;
#pragma unroll
                    for (int c = 0; c < 4; ++c) {
                        const f32x4 w = *(const LAS f32x4*)(wrT + (jb + u) * WR_LD + c * 256 + F.lane * 4);
                        p += hv[c][0] * w[0] + hv[c][1] * w[1] + hv[c][2] * w[2] + hv[c][3] * w[3];
                    }
                    pp[u] = p;
                }
#pragma unroll
                for (int u = 0; u < 4; ++u) pp[u] = wave_sum(pp[u]);
                if (F.lane == 0) { *(LAS f32x4*)(lgs + jb) = (f32x4){pp[0], pp[1], pp[2], pp[3]}; }
            }
            float lg[36];
#pragma unroll
            for (int j = 0; j < 36; ++j) lg[j] = lgs[j] + brs[j];
            int g = 0; float gm = lg[0];
#pragma unroll
            for (int j = 1; j < 4; ++j) if (lg[j] > gm) { gm = lg[j]; g = j; }
            float den = 0.f;
#pragma unroll
            for (int j = 0; j < 4; ++j) den += __expf(lg[j] - gm);
            const float ptop = 1.0f / den;
            float fv[8];
#pragma unroll
            for (int i = 0; i < 8; ++i) fv[i] = (g == 0) ? lg[4 + i] : (g == 1) ? lg[12 + i] : (g == 2) ? lg[20 + i] : lg[28 + i];
            int i1 = 0; float v1 = fv[0];
#pragma unroll
            for (int i = 1; i < 8; ++i) if (fv[i] > v1) { v1 = fv[i]; i1 = i; }
            int i2 = -1; float v2 = -3.0e38f;
#pragma unroll
            for (int i = 0; i < 8; ++i) if (i != i1 && fv[i] > v2) { v2 = fv[i]; i2 = i; }
            const float e2 = __expf(v2 - v1), ga = ptop / (1.0f + e2), gb = ptop * e2 / (1.0f + e2);
            if (F.lane == 0) {
                const int li = ((tb - F.bid * NWAVE * TPW) / (F.G * NWAVE * TPW)) * NWAVE * TPW + F.wave * TPW + ti;
                const int ea = g * 8 + i1, eb = g * 8 + i2;
                const int ra = __hip_atomic_fetch_add(&rcnt[ea], 1, __ATOMIC_RELAXED, __HIP_MEMORY_SCOPE_WORKGROUP);
                const int rb = __hip_atomic_fetch_add(&rcnt[eb], 1, __ATOMIC_RELAXED, __HIP_MEMORY_SCOPE_WORKGROUP);
                if (li < RT_CAP) { rt_er[2 * li] = (ea << 16) | ra; rt_gate[2 * li] = ga; rt_tok[2 * li] = tok; rt_er[2 * li + 1] = (eb << 16) | rb; rt_gate[2 * li + 1] = gb; rt_tok[2 * li + 1] = tok; }
            }
        }
      }
    }
    if (ROUTE) {
        __syncthreads();
        unsigned* cnt = ctl + CW_CNT + layer * NEXP * CNT_STRIDE;
        if (F.tid < NEXP) { const int n = rcnt[F.tid]; rbase[F.tid] = n ? (int)__hip_atomic_fetch_add(cnt + F.tid * CNT_STRIDE, (unsigned)n, __ATOMIC_RELAXED, __HIP_MEMORY_SCOPE_AGENT) : 0; }
        __syncthreads();
        int* list = (int*)(a.ws + WS_LIST); float* gatev = (float*)(a.ws + WS_GATEV); int* tsl = (int*)(a.ws + WS_TOKSLOT);
        int nloc = 0;
        for (int tb = F.bid * NWAVE * TPW; tb < NTOK; tb += F.G * NWAVE * TPW) nloc += NWAVE * TPW;
        nloc = nloc < RT_CAP ? nloc : RT_CAP;
        for (int i = F.tid; i < 2 * nloc; i += NTHR) {
            const int er = rt_er[i]; if (er < 0) continue;
            const int e = er >> 16, pos = rbase[e] + (er & 0xffff), tok = rt_tok[i];
            list[e * NTOK + pos] = tok; gatev[e * NTOK + pos] = rt_gate[i]; tsl[tok * 2 + (i & 1)] = (e << 20) | pos;
        }
    }
    __syncthreads();
}

constexpr int RP_HT = 0, RP_HT_LD = 1028;
constexpr int RP_PART = 16 * RP_HT_LD * 4;
constexpr int RP_LG = RP_PART + 8 * 16 * 48 * 4;
DI void route_phase(const Frame& F, const Args& a, int layer) {
    const float* mod = (const float*)(a.ws + WS_MOD);
    bf16_t* hbuf = (bf16_t*)(a.ws + WS_H);
    unsigned* ctl = (unsigned*)(a.ws + WS_CTL);
    LAS float* HT = (LAS float*)(F.lds + RP_HT);
    LAS float* PART = (LAS float*)(F.lds + RP_PART);
    LAS float* LG = (LAS float*)(F.lds + RP_LG);
    constexpr int RT_CAP = 512;
    LAS int* rcnt = (LAS int*)(F.lds + 149504);
    LAS int* rbase = (LAS int*)(F.lds + 149632);
    LAS int* rt_er = (LAS int*)(F.lds + 149760);
    LAS float* rt_gate = (LAS float*)(F.lds + 149760 + 4096);
    LAS int* rt_tok = (LAS int*)(F.lds + 149760 + 8192);
    if (F.tid < NEXP) rcnt[F.tid] = 0;
    for (int i = F.tid; i < 2 * RT_CAP; i += NTHR) rt_er[i] = -1;
    const float* wg = a.moe_wr_g + (size_t)layer * DM * 4;
    const float* we = a.moe_wr_e + (size_t)layer * DM * 32;
    const int col = F.lane & 15, kq = F.lane >> 4;
    float Bw[3][32];
#pragma unroll
    for (int s2 = 0; s2 < 32; ++s2) {
        const int k = 128 * F.wave + 16 * (s2 >> 2) + 4 * kq + (s2 & 3);
        Bw[0][s2] = col < 4 ? wg[k * 4 + col] : we[k * 32 + col - 4];
        Bw[1][s2] = we[k * 32 + 12 + col];
        Bw[2][s2] = col < 4 ? we[k * 32 + 28 + col] : 0.f;
    }
    const float* ng = a.norm_g + ((size_t)layer * 2 + 1) * DM;
    __syncthreads();
    const int ngroups = NTOK / 16;
    int li0 = 0;
    f32x4 xn[2][4];
    if (F.bid < ngroups) {
#pragma unroll
        for (int ti = 0; ti < 2; ++ti)
#pragma unroll
            for (int c = 0; c < 4; ++c) xn[ti][c] = *(const f32x4*)(a.out + (size_t)(F.bid * 16 + F.wave * 2 + ti) * DM + c * 256 + F.lane * 4);
    }
    for (int gi = F.bid; gi < ngroups; gi += F.G, li0 += 16) {
        const int tb = gi * 16 + F.wave * 2, b = tb / SEQ;
        const float* sh = mod + ((size_t)layer * NB + b) * 6 * DM + 3 * DM;
        const float* scp = sh + DM;
        f32x4 xc[2][4];
#pragma unroll
        for (int ti = 0; ti < 2; ++ti)
#pragma unroll
            for (int c = 0; c < 4; ++c) xc[ti][c] = xn[ti][c];
        if (gi + F.G < ngroups) {
#pragma unroll
            for (int ti = 0; ti < 2; ++ti)
#pragma unroll
                for (int c = 0; c < 4; ++c) xn[ti][c] = *(const f32x4*)(a.out + (size_t)((gi + F.G) * 16 + F.wave * 2 + ti) * DM + c * 256 + F.lane * 4);
        }
#pragma unroll
        for (int ti = 0; ti < 2; ++ti) {
            const int tok = tb + ti;
            f32x4 xv[4];
#pragma unroll
            for (int c = 0; c < 4; ++c) xv[c] = xc[ti][c];
            float ss = 0.f;
#pragma unroll
            for (int c = 0; c < 4; ++c) ss += xv[c][0] * xv[c][0] + xv[c][1] * xv[c][1] + xv[c][2] * xv[c][2] + xv[c][3] * xv[c][3];
            ss = wave_sum(ss);
            const float rinv = rsqrtf(ss * (1.0f / DM) + EPS);
#pragma unroll
            for (int c = 0; c < 4; ++c) {
                const int cl = c * 256 + F.lane * 4;
                const f32x4 g = *(const f32x4*)(ng + cl), s1 = *(const f32x4*)(scp + cl), s0 = *(const f32x4*)(sh + cl);
                f32x4 hv;
#pragma unroll
                for (int u = 0; u < 4; ++u) hv[u] = (xv[c][u] * rinv * g[u]) * (1.0f + s1[u]) + s0[u];
                u32x2 w; w[0] = pack_bf16(hv[0], hv[1]); w[1] = pack_bf16(hv[2], hv[3]);
                *(u32x2*)(hbuf + (size_t)tok * DM + cl) = w;
                *(LAS f32x4*)(HT + (F.wave * 2 + ti) * RP_HT_LD + cl) = hv;
            }
        }
        __syncthreads();
        {
            f32x4 acc[3];
#pragma unroll
            for (int n = 0; n < 3; ++n) acc[n] = (f32x4){0.f, 0.f, 0.f, 0.f};
            const LAS float* ap = HT + col * RP_HT_LD + 128 * F.wave + 4 * kq;
#pragma unroll
            for (int s4 = 0; s4 < 8; ++s4) {
                const f32x4 av = *(const LAS f32x4*)(ap + 16 * s4);
#pragma unroll
                for (int u = 0; u < 4; ++u)
#pragma unroll
                    for (int n = 0; n < 3; ++n) acc[n] = __builtin_amdgcn_mfma_f32_16x16x4f32(av[u], Bw[n][4 * s4 + u], acc[n], 0, 0, 0);
            }
#pragma unroll
            for (int n = 0; n < 3; ++n)
#pragma unroll
                for (int r = 0; r < 4; ++r) PART[(F.wave * 16 + 4 * kq + r) * 48 + 16 * n + col] = acc[n][r];
        }
        __syncthreads();
        {
            const int tk = F.tid >> 5, j = F.tid & 31;
            float s0 = 0.f, s1 = 0.f;
#pragma unroll
            for (int wv = 0; wv < NWAVE; ++wv) { s0 += PART[(wv * 16 + tk) * 48 + j]; s1 += PART[(wv * 16 + tk) * 48 + 32 + (j & 3)]; }
            LG[tk * 36 + j] = s0 + (j < 4 ? a.moe_br_g[layer * 4 + j] : a.moe_br_e[layer * 32 + j - 4]);
            if (j < 4) LG[tk * 36 + 32 + j] = s1 + a.moe_br_e[layer * 32 + 28 + j];
        }
        __syncthreads();
        if (F.tid < 16) {
            const int tk = F.tid, tok = gi * 16 + tk;
            float lg[36];
#pragma unroll
            for (int j = 0; j < 36; ++j) lg[j] = LG[tk * 36 + j];
            int g = 0; float gm = lg[0];
#pragma unroll
            for (int j = 1; j < 4; ++j) if (lg[j] > gm) { gm = lg[j]; g = j; }
            float den = 0.f;
#pragma unroll
            for (int j = 0; j < 4; ++j) den += __expf(lg[j] - gm);
            const float ptop = 1.0f / den;
            float fv[8];
#pragma unroll
            for (int i = 0; i < 8; ++i) fv[i] = (g == 0) ? lg[4 + i] : (g == 1) ? lg[12 + i] : (g == 2) ? lg[20 + i] : lg[28 + i];
            int i1 = 0; float v1 = fv[0];
#pragma unroll
            for (int i = 1; i < 8; ++i) if (fv[i] > v1) { v1 = fv[i]; i1 = i; }
            int i2 = -1; float v2 = -3.0e38f;
#pragma unroll
            for (int i = 0; i < 8; ++i) if (i != i1 && fv[i] > v2) { v2 = fv[i]; i2 = i; }
            const float e2 = __expf(v2 - v1), ga = ptop / (1.0f + e2), gb = ptop * e2 / (1.0f + e2);
            const int li = li0 + tk, ea = g * 8 + i1, eb = g * 8 + i2;
            const int ra = __hip_atomic_fetch_add(&rcnt[ea], 1, __ATOMIC_RELAXED, __HIP_MEMORY_SCOPE_WORKGROUP);
            const int rb = __hip_atomic_fetch_add(&rcnt[eb], 1, __ATOMIC_RELAXED, __HIP_MEMORY_SCOPE_WORKGROUP);
            if (li < RT_CAP) { rt_er[2 * li] = (ea << 16) | ra; rt_gate[2 * li] = ga; rt_tok[2 * li] = tok; rt_er[2 * li + 1] = (eb << 16) | rb; rt_gate[2 * li + 1] = gb; rt_tok[2 * li + 1] = tok; }
        }
    }
    __syncthreads();
    unsigned* cnt = ctl + CW_CNT + layer * NEXP * CNT_STRIDE;
    if (F.tid < NEXP) { const int n = rcnt[F.tid]; rbase[F.tid] = n ? (int)__hip_atomic_fetch_add(cnt + F.tid * CNT_STRIDE, (unsigned)n, __ATOMIC_RELAXED, __HIP_MEMORY_SCOPE_AGENT) : 0; }
    __syncthreads();
    int* list = (int*)(a.ws + WS_LIST); float* gatev = (float*)(a.ws + WS_GATEV); int* tsl = (int*)(a.ws + WS_TOKSLOT);
    const int nloc = li0 < RT_CAP ? li0 : RT_CAP;
    for (int i = F.tid; i < 2 * nloc; i += NTHR) {
        const int er = rt_er[i]; if (er < 0) continue;
        const int e = er >> 16, pos = rbase[e] + (er & 0xffff), tok = rt_tok[i];
        list[e * NTOK + pos] = tok; gatev[e * NTOK + pos] = rt_gate[i]; tsl[tok * 2 + (i & 1)] = (e << 20) | pos;
    }
    __syncthreads();
}

constexpr int LDS_MISC = 131072 + 64;
constexpr int LDS_XB = 163840 - 16;
constexpr int LDS_BYTES = 163840;
using pg8::Unit;
struct DenseSched {
    int nM, nN, nwg, G, c; const char* Bt; size_t tstepB;
    DI void init(int M, int N, int K, int G_, int c_, const void* Bt_) { nM = M / 256; nN = N / 256; nwg = nM * nN; G = G_; c = c_; Bt = (const char*)Bt_; tstepB = (size_t)256 * K * 2; }
    DI bool next(int i, Unit& u) const {
        const long L = (long)i * G + c; if (L >= nwg) return false;
        int wgid = (int)L; { const int q = nwg / 8, r = nwg % 8, xcd = wgid % 8, off = wgid / 8; wgid = (xcd < r ? xcd * (q + 1) : r * (q + 1) + (xcd - r) * q) + off; }
        const int nig = 8 * nN, gid = wgid / nig, fm = gid * 8, gsz = (nM - fm) < 8 ? (nM - fm) : 8;
        u.pm = fm + ((wgid % nig) % gsz); u.pn = (wgid % nig) / gsz; u.e = 0; u.nrow = 256; return true;
    }
    DI int a_row(const Unit& u, int r) const { return u.pm * 256 + r; }
    DI const char* b_base(const Unit& u) const { return Bt + (size_t)u.pn * tstepB; }
};
template <bool UP>
struct MoeSched {
    const LAS int* ntp; const unsigned* cnt; const int* list; const char* W; int nU, G, c;
    DI bool next(int i, Unit& u) const {
        const long L = (long)i * G + c; if (L >= nU) return false;
        int wgid = (int)L; { const int q = nU / 8, r = nU % 8, xcd = wgid % 8, off = wgid / 8; wgid = (xcd < r ? xcd * (q + 1) : r * (q + 1) + (xcd - r) * q) + off; }
        const int tg = wgid >> 2; u.pn = wgid & 3; u.pm = tg;
        int e = 0;
        for (int k = 1; k < NEXP; ++k) e += (ntp[k] <= tg) ? 1 : 0;
        u.e = e; const int rem = ntp[40 + e] - (tg - ntp[e]) * 256; u.nrow = rem < 256 ? rem : 256; return true;
    }
    DI int a_row(const Unit& u, int r) const {
        if (UP) { const int p = (u.pm - ntp[u.e]) * 256 + r; return (r < u.nrow) ? list[u.e * NTOK + p] : 0; }
        return u.pm * 256 + r;
    }
    DI const char* b_base(const Unit& u) const {
        return W + (size_t)u.e * 3 * MiB + (UP ? (size_t)u.pn * 256 * DM * 2 : 2 * MiB + (size_t)u.pn * 256 * DEXP * 2);
    }
};
DI void moe_tile_table(const Frame& F, const unsigned* cnt, LAS int* ntp  ) {
    if (F.tid < NEXP) ntp[40 + F.tid] = (int)cnt[F.tid * CNT_STRIDE];
    __syncthreads();
    if (F.tid == 0) { int s = 0; for (int e = 0; e < NEXP; ++e) { ntp[e] = s; s += (ntp[40 + e] + 255) >> 8; } ntp[NEXP] = s; }
    __syncthreads();
}

#define EPI_ROWS_BEGIN const int row0 = u.pm * 256 + wr * 64 + fr; _Pragma("unroll") for (int ai = 0; ai < 2; ++ai) _Pragma("unroll") for (int m = 0; m < 4; ++m) { const int row = row0 + ai * 128 + m * 16;
#define EPI_ROWS_END }
DI u32x2 pack4(const f32x4& v) { u32x2 w; w[0] = pack_bf16(v[0], v[1]); w[1] = pack_bf16(v[2], v[3]); return w; }

struct EpiAbIn {
    bf16_t* Zc;
    DI void operator()(const f32x4 (&acc)[2][2][4][2], const Unit& u, int wr, int wc, int fr, int fq) const {
        EPI_ROWS_BEGIN
            bf16_t* rp = Zc + (size_t)row * ZC_N;
            if (u.pn < 2) {
#pragma unroll
                for (int bj = 0; bj < 2; ++bj) {
                    const u32x2 lo = pack4(acc[ai][bj][m][0]), hi = pack4(acc[ai][bj][m][1]);
                    *(u32x4*)(rp + u.pn * 256 + bj * 128 + wc * 32 + 8 * fq) = (u32x4){lo[0], lo[1], hi[0], hi[1]};
                }
            } else {
                const int pnp = (u.pn - 2) & 3, j = 128 * pnp + 32 * wc + 8 * fq;
                u32x2 o[2];
#pragma unroll
                for (int bj = 0; bj < 2; ++bj) {
                    const f32x4 X = acc[ai][bj][m][0], Y = acc[ai][bj][m][1]; f32x4 v;
                    if (u.pn < 6) v = X * Y;
                    else { v[0] = X[0] * sigmoid_f(Y[0]); v[1] = X[1] * sigmoid_f(Y[1]); v[2] = X[2] * sigmoid_f(Y[2]); v[3] = X[3] * sigmoid_f(Y[3]); }
                    o[bj] = pack4(v);
                }
                *(u32x4*)(rp + (u.pn < 6 ? 512 : 1024) + j) = (u32x4){o[0][0], o[0][1], o[1][0], o[1][1]};
            }
        EPI_ROWS_END
    }
};
struct EpiResid {
    const float* xin; float* xout; const float* g1;
    DI void operator()(const f32x4 (&acc)[2][2][4][2], const Unit& u, int wr, int wc, int fr, int fq) const {
        const float* g = g1 + (size_t)((u.pm * 256) / SEQ) * 6 * DM;
        const int row0 = u.pm * 256 + wr * 64 + fr, col0 = u.pn * 256 + wc * 32 + 4 * fq;
        f32x4 gv[2][2];
#pragma unroll
        for (int bj = 0; bj < 2; ++bj)
#pragma unroll
            for (int n = 0; n < 2; ++n) gv[bj][n] = *(const f32x4*)(g + col0 + bj * 128 + n * 16);
#pragma unroll
        for (int ai = 0; ai < 2; ++ai) {
            f32x4 xo[4][2][2];
#pragma unroll
            for (int m = 0; m < 4; ++m)
#pragma unroll
                for (int bj = 0; bj < 2; ++bj)
#pragma unroll
                    for (int n = 0; n < 2; ++n) xo[m][bj][n] = *(const f32x4*)(xin + (size_t)(row0 + ai * 128 + m * 16) * DM + col0 + bj * 128 + n * 16);
            asm volatile("" ::: "memory");
#pragma unroll
            for (int m = 0; m < 4; ++m)
#pragma unroll
                for (int bj = 0; bj < 2; ++bj)
#pragma unroll
                    for (int n = 0; n < 2; ++n) *(f32x4*)(xout + (size_t)(row0 + ai * 128 + m * 16) * DM + col0 + bj * 128 + n * 16) = xo[m][bj][n] + gv[bj][n] * acc[ai][bj][m][n];
        }
    }
};
struct EpiPlain {
    bf16_t* O; int ld; unsigned scmask; float sc;
    DI void operator()(const f32x4 (&acc)[2][2][4][2], const Unit& u, int wr, int wc, int fr, int fq) const {
        const float s_ = ((scmask >> u.pn) & 1u) ? sc : 1.0f;
        EPI_ROWS_BEGIN
#pragma unroll
            for (int bj = 0; bj < 2; ++bj) {
                const u32x2 lo = pack4(acc[ai][bj][m][0] * s_), hi = pack4(acc[ai][bj][m][1] * s_);
                *(u32x4*)(O + (size_t)row * ld + u.pn * 256 + bj * 128 + wc * 32 + 8 * fq) = (u32x4){lo[0], lo[1], hi[0], hi[1]};
            }
        EPI_ROWS_END
    }
};
struct EpiPlainNat {
    bf16_t* O; int ld;
    DI void operator()(const f32x4 (&acc)[2][2][4][2], const Unit& u, int wr, int wc, int fr, int fq) const {
        EPI_ROWS_BEGIN
#pragma unroll
            for (int bj = 0; bj < 2; ++bj)
#pragma unroll
                for (int n = 0; n < 2; ++n) *(u32x2*)(O + (size_t)row * ld + u.pn * 256 + bj * 128 + wc * 32 + n * 16 + 4 * fq) = pack4(acc[ai][bj][m][n]);
        EPI_ROWS_END
    }
};
struct EpiVt {
    bf16_t* O;
    DI void operator()(const f32x4 (&acc)[2][2][4][2], const Unit& u, int wr, int wc, int fr, int fq) const {
        const int pos = 8 * (fq & 1) + 4 * (fq >> 1);
        EPI_ROWS_BEGIN
#pragma unroll
            for (int bj = 0; bj < 2; ++bj)
#pragma unroll
                for (int n = 0; n < 2; ++n) *(u32x2*)(O + (size_t)row * NTOK + u.pn * 256 + bj * 128 + wc * 32 + n * 16 + pos) = pack4(acc[ai][bj][m][n]);
        EPI_ROWS_END
    }
};
struct EpiMoeUp {
    bf16_t* act;
    DI void operator()(const f32x4 (&acc)[2][2][4][2], const Unit& u, int wr, int wc, int fr, int fq) const {
        EPI_ROWS_BEGIN
            u32x2 o[2];
#pragma unroll
            for (int bj = 0; bj < 2; ++bj) {
                const f32x4 X = acc[ai][bj][m][0], Y = acc[ai][bj][m][1]; f32x4 v;
                v[0] = silu_f(X[0]) * Y[0]; v[1] = silu_f(X[1]) * Y[1]; v[2] = silu_f(X[2]) * Y[2]; v[3] = silu_f(X[3]) * Y[3];
                o[bj] = pack4(v);
            }
            *(u32x4*)(act + (size_t)row * DEXP + 128 * u.pn + 32 * wc + 8 * fq) = (u32x4){o[0][0], o[0][1], o[1][0], o[1][1]};
        EPI_ROWS_END
    }
};
struct EpiMoeDown {
    bf16_t* y; const float* gatev; const LAS int* ntp;
    DI void operator()(const f32x4 (&acc)[2][2][4][2], const Unit& u, int wr, int wc, int fr, int fq) const {
        const int pbase = (u.pm - ntp[u.e]) * 256;
        EPI_ROWS_BEGIN
            const int r = row - u.pm * 256;
            const float gt = (r < u.nrow) ? gatev[u.e * NTOK + pbase + r] : 0.f;
#pragma unroll
            for (int bj = 0; bj < 2; ++bj) {
                const u32x2 lo = pack4(acc[ai][bj][m][0] * gt), hi = pack4(acc[ai][bj][m][1] * gt);
                *(u32x4*)(y + (size_t)row * DM + u.pn * 256 + bj * 128 + wc * 32 + 8 * fq) = (u32x4){lo[0], lo[1], hi[0], hi[1]};
            }
        EPI_ROWS_END
    }
};

DI void conv_phase(const Frame& F, const Args& a) {
    const bf16_t* Zc = (const bf16_t*)(a.ws + WS_BIG);
    bf16_t* Y = (bf16_t*)(a.ws + WS_Y);
    LAS unsigned* PB = (LAS unsigned*)F.lds;
    LAS f32x2* ST = (LAS f32x2*)(F.lds + 94 * 1024);
    const int cp = F.tid & 255, th = F.tid >> 8, wq = F.wave & 3;
    float wb[31][2], wa[3][2];
#pragma unroll
    for (int k = 0; k < 31; ++k) { const f32x2 w = *(const f32x2*)(a.ab_conv_b + k * 512 + 2 * cp); wb[k][0] = w[0]; wb[k][1] = w[1]; }
#pragma unroll
    for (int k = 0; k < 3; ++k) { const f32x2 w = *(const f32x2*)(a.ab_conv_a + k * 512 + 2 * cp); wa[k][0] = w[0]; wa[k][1] = w[1]; }
    const f32x2 cbias = *(const f32x2*)(a.ab_conv_b_bias + 2 * cp), lng = *(const f32x2*)(a.ab_ln_g + 2 * cp), lnb = *(const f32x2*)(a.ab_ln_b + 2 * cp);
    for (int tile = F.bid; tile < NTOK / 64; tile += F.G) {
        const int t0 = tile * 64, b = t0 / SEQ, tl0 = t0 % SEQ;
        for (int i = F.tid; i < 94 * 64; i += NTHR) {
            const int r = i >> 6, c8 = i & 63, pos = tl0 - 30 + r;
            u32x4 v = {0u, 0u, 0u, 0u};
            if (pos >= 0) v = *(const u32x4*)(Zc + (size_t)(b * SEQ + pos) * ZC_N + 1024 + c8 * 8);
            *(LAS u32x4*)(PB + r * 256 + c8 * 4) = v;
        }
        __syncthreads();
#pragma unroll 1
        for (int g = 0; g < 4; ++g) {
            float U[8][2];
#pragma unroll
            for (int i = 0; i < 8; ++i) { U[i][0] = cbias[0]; U[i][1] = cbias[1]; }
#pragma unroll
            for (int r = 0; r < 38; ++r) {
                const unsigned xw = PB[(32 * th + 8 * g + r) * 256 + cp];
                const float x0 = bf_lo(xw), x1 = bf_hi(xw);
#pragma unroll
                for (int i = 0; i < 8; ++i) { const int k = r - i; if (k >= 0 && k <= 30) { U[i][0] += wb[k][0] * x0; U[i][1] += wb[k][1] * x1; } }
            }
            unsigned gwv[8], pav[10];
#pragma unroll
            for (int i = 0; i < 8; ++i) gwv[i] = *(const unsigned*)(Zc + ((size_t)t0 + 32 * th + 8 * g + i) * ZC_N + 2 * cp);
#pragma unroll
            for (int i = 0; i < 10; ++i) { const int pp = tl0 + 32 * th + 8 * g + i - 2; pav[i] = pp >= 0 ? *(const unsigned*)(Zc + (size_t)(b * SEQ + pp) * ZC_N + 512 + 2 * cp) : 0u; }
            {
                float v[16];
#pragma unroll
                for (int i = 0; i < 8; ++i) { v[2 * i] = U[i][0] + U[i][1]; v[2 * i + 1] = U[i][0] * U[i][0] + U[i][1] * U[i][1]; }
#pragma unroll
                for (int hw = 8; hw >= 1; hw >>= 1) {
                    const bool up = (F.lane & (4 * hw)) != 0;
#pragma unroll
                    for (int i = 0; i < hw; ++i) { const float send = up ? v[i] : v[i + hw], keep = up ? v[i + hw] : v[i]; v[i] = keep + __shfl_xor(send, 4 * hw); }
                }
                v[0] += __shfl_xor(v[0], 2); v[0] += __shfl_xor(v[0], 1);
                if ((F.lane & 3) == 0) { const int idx = F.lane >> 2; ((LAS float*)ST)[((32 * th + 8 * g + (idx >> 1)) * 4 + wq) * 2 + (idx & 1)] = v[0]; }
            }
            __syncthreads();
#pragma unroll
            for (int i = 0; i < 8; ++i) {
                const int tl = 32 * th + 8 * g + i; const size_t tok = (size_t)t0 + tl;
                const f32x2 p0 = ST[tl * 4 + 0], p1 = ST[tl * 4 + 1], p2 = ST[tl * 4 + 2], p3 = ST[tl * 4 + 3];
                const float mean = ((p0[0] + p1[0]) + (p2[0] + p3[0])) * (1.0f / 512.0f);
                const float var = ((p0[1] + p1[1]) + (p2[1] + p3[1])) * (1.0f / 512.0f) - mean * mean;
                const float rstd = rsqrtf(var + EPS);
                const float yb0 = silu_f((U[i][0] - mean) * rstd * lng[0] + lnb[0]), yb1 = silu_f((U[i][1] - mean) * rstd * lng[1] + lnb[1]);
                *(unsigned*)(Y + tok * DM + 512 + 2 * cp) = pack_bf16(yb0, yb1);
                float a0 = 0.f, a1 = 0.f;
#pragma unroll
                for (int k = 0; k < 3; ++k) { const unsigned w = pav[i + k]; a0 += wa[k][0] * bf_lo(w); a1 += wa[k][1] * bf_hi(w); }
                const unsigned gw = gwv[i];
                *(unsigned*)(Y + tok * DM + 2 * cp) = pack_bf16(bf_lo(gw) * a0, bf_hi(gw) * a1);
            }
        }
        __syncthreads();
    }
}

#define MFMA32(a, b, c) __builtin_amdgcn_mfma_f32_32x32x16_bf16((a), (b), (c), 0, 0, 0)
#define LDS6_ISSUE(B, addr, o0, o1, o2, o3, o4, o5) asm volatile( \
    "ds_read_b128 %0, %6 offset:" #o0 "\n\tds_read_b128 %1, %6 offset:" #o1 "\n\tds_read_b128 %2, %6 offset:" #o2 "\n\tds_read_b128 %3, %6 offset:" #o3 "\n\tds_read_b128 %4, %6 offset:" #o4 "\n\tds_read_b128 %5, %6 offset:" #o5 \
    : "=&v"(B[0]), "=&v"(B[1]), "=&v"(B[2]), "=&v"(B[3]), "=&v"(B[4]), "=&v"(B[5]) : "v"(addr) : "memory")
#define LDS6_WAIT(B) asm volatile("s_waitcnt lgkmcnt(0)" : "+v"(B[0]), "+v"(B[1]), "+v"(B[2]), "+v"(B[3]), "+v"(B[4]), "+v"(B[5]) :: "memory")
constexpr int TK_HIST = 0;
constexpr int TK_HLD = 513;
constexpr int TK_TAB = 66048;
constexpr int TK_CAP = 256;
constexpr int TK_CAND = 66560;
constexpr int TK_CCNT = TK_CAND + 32 * TK_CAP * 4;
constexpr int TK_OVF = TK_CCNT + 128;
constexpr int TK_BQ = 100352;
constexpr int TK_MASK = 118784;
DI int crow_c(int r) { return (r & 3) + 8 * (r >> 2); }
DI unsigned tk_key(float s) { unsigned k; asm("v_cvt_u32_f32 %0, %1" : "=v"(k) : "v"(s)); return k; }
template <int MODE, bool DIAG>
DI void topk_elems(const Frame& F, const f32x16& sc, int kt, int q, int h2, int myT, LAS unsigned* hist, LAS unsigned* cand, LAS int* ccnt, LAS unsigned* maskl) {
    const int lo = myT << 9, hi = (myT + 1) << 9;
    if (MODE <= 2) {
#pragma unroll
        for (int r = 0; r < 16; ++r) {
            unsigned key = tk_key(sc[r]); key = key > 262143u ? 262143u : key;
            const bool valid = !DIAG || (crow_c(r) + 4 * h2 <= q);
            if (MODE == 1) { if (valid) __hip_atomic_fetch_add(&hist[q * TK_HLD + (key >> 9)], 1u, __ATOMIC_RELAXED, __HIP_MEMORY_SCOPE_WORKGROUP); }
            else { if (valid && (int)(key >> 9) == myT) __hip_atomic_fetch_add(&hist[q * TK_HLD + (key & 511)], 1u, __ATOMIC_RELAXED, __HIP_MEMORY_SCOPE_WORKGROUP); }
        }
        return;
    }
    const int selb = (MODE == 3 ? myT : hi - 1), geb = (MODE == 3 ? myT - 1 : lo - 1);
    unsigned selw = 0u, gew = 0u;
#pragma unroll
    for (int r = 0; r < 16; ++r) {
        const unsigned key = tk_key(sc[r]);
        const unsigned d1 = (unsigned)(selb - (int)key), d2 = (unsigned)(geb - (int)key);
        selw = __builtin_amdgcn_alignbit(selw, d1, 31);
        gew = __builtin_amdgcn_alignbit(gew, d2, 31);
    }
    if (DIAG) {
        unsigned vw = 0u;
#pragma unroll
        for (int r = 0; r < 16; ++r) vw |= (crow_c(r) + 4 * h2 <= q) ? (1u << (15 - r)) : 0u;
        selw &= vw; gew &= vw;
    }
    unsigned cw = gew & ~selw & 0xffffu;
    if (cw) {
#pragma unroll
        for (int r = 0; r < 16; ++r) {
            if (cw & (1u << (15 - r))) {
                const unsigned key = tk_key(sc[r]);
                const int p = __hip_atomic_fetch_add(&ccnt[q], 1, __ATOMIC_RELAXED, __HIP_MEMORY_SCOPE_WORKGROUP);
                if (p < TK_CAP) cand[q * TK_CAP + p] = (MODE == 3 ? 0u : ((key - (unsigned)lo) << 13)) | (unsigned)(8191 - (32 * kt + crow_c(r) + 4 * h2));
            }
        }
    }
    unsigned rv = __builtin_bitreverse32(selw) >> 16;
    unsigned bits = (rv & 0xfu) | ((rv & 0xf0u) << 4) | ((rv & 0xf00u) << 8) | ((rv & 0xf000u) << 12);
    bits <<= 4 * h2;
    bits |= (unsigned)__shfl_xor((int)bits, 32);
    if (h2 == 0) maskl[q * 256 + kt] = bits;
}
template <int MODE>
DI void topk_pass(const Frame& F, const bf16_t* Z, int b, int t0, const float (&wp)[8]) {
    const LAS unsigned char* bq = F.lds + TK_BQ;
    LAS unsigned* hist = (LAS unsigned*)(F.lds + TK_HIST);
    LAS int* tab = (LAS int*)(F.lds + TK_TAB);
    LAS unsigned* cand = (LAS unsigned*)(F.lds + TK_CAND);
    LAS int* ccnt = (LAS int*)(F.lds + TK_CCNT);
    LAS unsigned* maskl = (LAS unsigned*)(F.lds + TK_MASK);
    const int lane = fresh_lane(), q = lane & 31, h2 = lane >> 5, ntile = t0 / 32 + 1;
    const int myT = (MODE >= 2) ? tab[q * 4 + 0] : 0;
    const unsigned bqa = (unsigned)(size_t)(bq + lane * 16);
    const bf16_t* kbase = Z + (size_t)b * SEQ * CD_N + Z_KI + 8 * h2 + (size_t)q * CD_N;
    bf16x8 A0n = (bf16x8){0, 0, 0, 0, 0, 0, 0, 0}, A1n = A0n;
    if (F.wave < ntile) { const bf16_t* kp = kbase + (size_t)(32 * F.wave) * CD_N; A0n = *(const bf16x8*)kp; A1n = *(const bf16x8*)(kp + 16); }
    for (int kt = F.wave; kt < ntile; kt += NWAVE) {
        const bf16x8 A0 = A0n, A1 = A1n;
        if (kt + NWAVE < ntile) { const bf16_t* kp = kbase + (size_t)(32 * (kt + NWAVE)) * CD_N; A0n = *(const bf16x8*)kp; A1n = *(const bf16x8*)(kp + 16); }
        f32x16 sc;
#pragma unroll
        for (int r = 0; r < 16; ++r) sc[r] = 131072.0f;
        {
#define TK_MF0(acc, A, B) asm volatile("v_mfma_f32_32x32x16_bf16 %0, %1, %2, 0" : "=&v"(acc) : "v"(A), "v"(B))
#define TK_MF1(acc, A, B) asm volatile("v_mfma_f32_32x32x16_bf16 %0, %1, %2, %0" : "+v"(acc) : "v"(A), "v"(B))
#define TK_FA(sv, av, wv) asm volatile("v_fma_f32 %0, |%1|, %2, %0" : "+v"(sv) : "v"(av), "v"(wv))
#define TK_AD(sv, av) asm volatile("v_add_f32 %0, %0, %1" : "+v"(sv) : "v"(av))
        bf16x8 Ba[6], Bb[6];
        f32x16 acA[3], acB[3];
        LDS6_ISSUE(Ba, bqa, 16384, 17408, 0, 1024, 2048, 3072);
        LDS6_WAIT(Ba);
        LDS6_ISSUE(Bb, bqa, 4096, 5120, 6144, 7168, 8192, 9216);
#pragma unroll
        for (int u = 0; u < 3; ++u) TK_MF0(acA[u], A0, Ba[2 * u]);
#pragma unroll
        for (int u = 0; u < 3; ++u) TK_MF1(acA[u], A1, Ba[2 * u + 1]);
        LDS6_WAIT(Bb);
        LDS6_ISSUE(Ba, bqa, 10240, 11264, 12288, 13312, 14336, 15360);
#pragma unroll
        for (int m = 0; m < 6; ++m) {
            if (m >= 3) TK_MF1(acB[m - 3], A1, Bb[2 * (m - 3) + 1]); else TK_MF0(acB[m], A0, Bb[2 * m]);
#pragma unroll
            for (int e = 0; e < 8; ++e) { const int i = 8 * m + e, u = i >> 4, r = i & 15; if (u == 0) TK_AD(sc[r], acA[0][r]); else TK_FA(sc[r], acA[u][r], wp[u - 1]); }
        }
        LDS6_WAIT(Ba);
#pragma unroll
        for (int m = 0; m < 6; ++m) {
            if (m >= 3) TK_MF1(acA[m - 3], A1, Ba[2 * (m - 3) + 1]); else TK_MF0(acA[m], A0, Ba[2 * m]);
#pragma unroll
            for (int e = 0; e < 8; ++e) { const int i = 8 * m + e, u = i >> 4, r = i & 15; TK_FA(sc[r], acB[u][r], wp[2 + u]); }
        }
#pragma unroll
        for (int u = 0; u < 3; ++u)
#pragma unroll
            for (int r = 0; r < 16; ++r) TK_FA(sc[r], acA[u][r], wp[5 + u]);
#undef TK_MF0
#undef TK_MF1
#undef TK_FA
#undef TK_AD
        }
        if (kt == ntile - 1) topk_elems<MODE, true>(F, sc, kt, q, h2, myT, hist, cand, ccnt, maskl);
        else topk_elems<MODE, false>(F, sc, kt, q, h2, myT, hist, cand, ccnt, maskl);
    }
}
DI void topk_scan(const Frame& F, int pass, int t0) {
    LAS unsigned* hist = (LAS unsigned*)(F.lds + TK_HIST);
    LAS int* tab = (LAS int*)(F.lds + TK_TAB);
    LAS int* ovf = (LAS int*)(F.lds + TK_OVF);
    for (int qi = 0; qi < 4; ++qi) {
        const int q = F.wave * 4 + qi, n = t0 + q + 1;
        int need = 256, prevT = 0, prevAbove = 0;
        if (pass == 2) { prevT = tab[q * 4 + 0]; prevAbove = tab[q * 4 + 1]; need = 256 - prevAbove; }
        if (n <= 256) { if (F.lane == 0) { tab[q * 4 + 0] = -1; tab[q * 4 + 1] = 0; tab[q * 4 + 2] = 0; } continue; }
        unsigned hv[8]; unsigned s = 0;
#pragma unroll
        for (int i = 0; i < 8; ++i) { hv[i] = hist[q * TK_HLD + 511 - (8 * F.lane + i)]; s += hv[i]; }
        unsigned inc = s;
#pragma unroll
        for (int o = 1; o < 64; o <<= 1) { const unsigned v = (unsigned)__shfl_up((int)inc, o); if (F.lane >= o) inc += v; }
        const unsigned pre = inc - s;
        if ((int)pre < need && (int)inc >= need) {
            unsigned cum = pre; int bsel = 0; unsigned above = 0, inbin = 0; bool found = false;
#pragma unroll
            for (int i = 0; i < 8; ++i) { if (!found && (int)(cum + hv[i]) >= need) { found = true; bsel = 511 - (8 * F.lane + i); above = cum; inbin = hv[i]; } cum += hv[i]; }
            if (pass == 1) { tab[q * 4 + 0] = bsel; tab[q * 4 + 1] = (int)above; tab[q * 4 + 2] = 256 - (int)above; if (inbin > (unsigned)TK_CAP) *ovf = 1; }
            else { tab[q * 4 + 0] = (prevT << 9) | bsel; tab[q * 4 + 1] = prevAbove + (int)above; tab[q * 4 + 2] = 256 - (prevAbove + (int)above); }
        }
    }
}
DI void topk_select(const Frame& F) {
    LAS int* tab = (LAS int*)(F.lds + TK_TAB);
    LAS unsigned* cand = (LAS unsigned*)(F.lds + TK_CAND);
    LAS int* ccnt = (LAS int*)(F.lds + TK_CCNT);
    LAS unsigned* maskl = (LAS unsigned*)(F.lds + TK_MASK);
    for (int qi = 0; qi < 4; ++qi) {
        const int q = F.wave * 4 + qi, need = tab[q * 4 + 2];
        int n = ccnt[q]; n = n > TK_CAP ? TK_CAP : n;
        if (need <= 0 || n <= 0) continue;
        unsigned c[4]; int rk[4]; bool vv[4];
#pragma unroll
        for (int i = 0; i < 4; ++i) { vv[i] = F.lane + 64 * i < n; c[i] = vv[i] ? cand[q * TK_CAP + F.lane + 64 * i] : 0u; rk[i] = 0; }
        for (int j = 0; j < n; ++j) {
            const unsigned cj = cand[q * TK_CAP + j];
#pragma unroll
            for (int i = 0; i < 4; ++i) rk[i] += (cj > c[i]) ? 1 : 0;
        }
#pragma unroll
        for (int i = 0; i < 4; ++i)
            if (vv[i] && rk[i] < need) { const int idx = 8191 - (int)(c[i] & 8191u); __hip_atomic_fetch_or(&maskl[q * 256 + (idx >> 5)], 1u << (idx & 31), __ATOMIC_RELAXED, __HIP_MEMORY_SCOPE_WORKGROUP); }
    }
}
DI void topk_phase(const Frame& F, const Args& a, unsigned long long& tacc) {
    unsigned long long t_s = 0;
#define TKT0(n) do { if (TIME_PH == 100 + (n)) { __syncthreads(); t_s = wall_clock64(); } } while (0)
#define TKT1(n) do { if (TIME_PH == 100 + (n)) { __syncthreads(); tacc += wall_clock64() - t_s; } } while (0)
    const bf16_t* Z = (const bf16_t*)(a.ws + WS_BIG);
    unsigned* maskg = (unsigned*)(a.ws + WS_MASK);
    LAS unsigned* hist = (LAS unsigned*)(F.lds + TK_HIST);
    LAS int* ccnt = (LAS int*)(F.lds + TK_CCNT);
    LAS int* ovf = (LAS int*)(F.lds + TK_OVF);
    LAS unsigned* maskl = (LAS unsigned*)(F.lds + TK_MASK);
    for (int pi = F.bid; pi < 512; pi += F.G) {
        const int b = pi >> 7, p = pi & 127;
        for (int half = 0; half < 2; ++half) {
            const int t0 = 32 * (half ? 255 - p : p), ntile = t0 / 32 + 1;
            const int lane0 = fresh_lane(), q = lane0 & 31, h2 = lane0 >> 5;
            const bf16_t* zr = Z + (size_t)(b * SEQ + t0 + q) * CD_N;
            TKT0(1);
            float wp[8];
            { const u32x4 wv = *(const u32x4*)(zr + Z_WI);
              const float sc = 0.0625f * 0.5f * 16384.0f;
              wp[0] = bf_lo(wv[0]) * sc; wp[1] = bf_hi(wv[0]) * sc; wp[2] = bf_lo(wv[1]) * sc; wp[3] = bf_hi(wv[1]) * sc;
              wp[4] = bf_lo(wv[2]) * sc; wp[5] = bf_hi(wv[2]) * sc; wp[6] = bf_lo(wv[3]) * sc; wp[7] = bf_hi(wv[3]) * sc; }
            __syncthreads();
            if (F.wave == 0) {
                LAS unsigned char* bqw = F.lds + TK_BQ;
                float lin[2][8];
#pragma unroll
                for (int ks = 0; ks < 2; ++ks)
#pragma unroll
                    for (int j = 0; j < 8; ++j) lin[ks][j] = 0.f;
#pragma unroll
                for (int h = 0; h < 8; ++h)
#pragma unroll
                    for (int ks = 0; ks < 2; ++ks) {
                        const u32x4 v = *(const u32x4*)(zr + Z_QI + 32 * h + 16 * ks + 8 * h2);
                        *(LAS u32x4*)(bqw + ((2 * h + ks) * 64 + lane0) * 16) = v;
#pragma unroll
                        for (int j = 0; j < 4; ++j) { lin[ks][2 * j] += wp[h] * bf_lo(v[j]); lin[ks][2 * j + 1] += wp[h] * bf_hi(v[j]); }
                    }
#pragma unroll
                for (int ks = 0; ks < 2; ++ks) {
                    u32x4 v; v[0] = pack_bf16(lin[ks][0], lin[ks][1]); v[1] = pack_bf16(lin[ks][2], lin[ks][3]); v[2] = pack_bf16(lin[ks][4], lin[ks][5]); v[3] = pack_bf16(lin[ks][6], lin[ks][7]);
                    *(LAS u32x4*)(bqw + ((16 + ks) * 64 + lane0) * 16) = v;
                }
            }
            for (int i = F.tid; i < 32 * TK_HLD; i += NTHR) hist[i] = 0u;
            if (F.tid < 32) ccnt[F.tid] = 0;
            if (F.tid == 32) *ovf = 0;
            __syncthreads();
            TKT1(1); TKT0(2);
            topk_pass<1>(F, Z, b, t0, wp);
            __syncthreads();
            TKT1(2); TKT0(3);
            topk_scan(F, 1, t0);
            __syncthreads();
            TKT1(3); TKT0(4);
            if (*ovf == 0) {
                topk_pass<4>(F, Z, b, t0, wp);
            } else {
                for (int i = F.tid; i < 32 * TK_HLD; i += NTHR) hist[i] = 0u;
                __syncthreads();
                topk_pass<2>(F, Z, b, t0, wp);
                __syncthreads();
                topk_scan(F, 2, t0);
                __syncthreads();
                topk_pass<3>(F, Z, b, t0, wp);
            }
            __syncthreads();
            TKT1(4); TKT0(5);
            topk_select(F);
            __syncthreads();
            for (int i = F.wave * 64 + fresh_lane(); i < 32 * ntile; i += NTHR) { const int qq = i / ntile, kt = i - qq * ntile; maskg[(size_t)(b * SEQ + t0 + qq) * 256 + kt] = maskl[qq * 256 + kt]; }
            TKT1(5);
        }
    }
}

constexpr int AT_KBYTES = 64 * 128;
constexpr int AT_VBYTES = 128 * 128;
constexpr int AT_BUF = AT_KBYTES + AT_VBYTES;
constexpr int AT_NSTG = 4;
constexpr int AT_LUT = AT_NSTG * AT_BUF;
constexpr int AT_LUTM = AT_LUT + 12 * 320 * 4;
constexpr int AT_LUT_LD = 320;
constexpr float NEG_INF = -__builtin_huge_valf();
constexpr float AT_THR = 8.0f;

template <int DV, bool MASKED>
DI void attn_core(const Frame& F, const bf16_t* Z, const bf16_t* Vt, int b, int qcol, int kcol, int vrow, int q0, const LAS float* lut, float c1, const unsigned* maskg, f32x16 (&O)[DV / 32]) {
    constexpr int NDV = DV / 32;
    const int q = F.lane & 31, h2 = F.lane >> 5;
    const int tw0 = q0 + 32 * F.wave, t = tw0 + q;
    const bf16_t* Zb = Z + (size_t)b * SEQ * CD_N;
    const bf16_t* Vb = Vt + (size_t)vrow * NTOK + (size_t)b * SEQ;
    const unsigned* mrow = maskg + (size_t)(b * SEQ + t) * 256;
    bf16x8 Qf[4];
#pragma unroll
    for (int ks = 0; ks < 4; ++ks) Qf[ks] = *(const bf16x8*)(Zb + (size_t)t * CD_N + qcol + 16 * ks + 8 * h2);
#pragma unroll
    for (int d = 0; d < NDV; ++d)
#pragma unroll
        for (int r = 0; r < 16; ++r) O[d][r] = 0.f;
    const LAS f32x4* lutm = (const LAS f32x4*)(F.lds + AT_LUTM);
    float m_run = NEG_INF, l_run = 0.f;
    const int jmax = (q0 + 255) >> 6;
    const int swz = (q >> 1) & 7;
    const int drow = F.lane >> 3, dpos = F.lane & 7;
    unsigned mreg[2] = {0u, 0u};
    bf16x8 Pf[4];
#pragma unroll
    for (int i = 0; i < 4; ++i) Pf[i] = (bf16x8){0, 0, 0, 0, 0, 0, 0, 0};
#define AT_DMA(j) do { const int sg_ = (j) % AT_NSTG; \
        { const int key_ = 8 * F.wave + drow, c_ = dpos ^ ((key_ >> 1) & 7); \
          __builtin_amdgcn_global_load_lds((const unsigned*)(Zb + (size_t)(64 * (j) + key_) * CD_N + kcol + 8 * c_), (LAS unsigned*)(F.lds + sg_ * AT_BUF + F.wave * 1024), 16, 0, 0); } \
        _Pragma("unroll") for (int _i = 0; _i < DV / 64; ++_i) { const int ii_ = F.wave + 8 * _i, row_ = 8 * ii_ + drow, c_ = dpos ^ ((row_ >> 1) & 7); \
          __builtin_amdgcn_global_load_lds((const unsigned*)(Vb + (size_t)row_ * NTOK + 64 * (j) + 8 * c_), (LAS unsigned*)(F.lds + sg_ * AT_BUF + AT_KBYTES + ii_ * 1024), 16, 0, 0); } \
        } while (0)
#define AT_MLOAD(j) do { if (MASKED) { mreg[0] = mrow[2 * (j)]; mreg[1] = mrow[2 * (j) + 1]; } } while (0)
#define AT_QKSM(jj) do { \
        const LAS unsigned char* kb = F.lds + ((jj) % AT_NSTG) * AT_BUF; \
        f32x16 s[2]; \
        _Pragma("unroll") for (int kb2 = 0; kb2 < 2; ++kb2) { \
            bf16x8 Kf[4]; \
            _Pragma("unroll") for (int ks = 0; ks < 4; ++ks) Kf[ks] = *(const LAS bf16x8*)(kb + (32 * kb2 + q) * 128 + (((2 * ks + h2) ^ swz) << 4)); \
            _Pragma("unroll") for (int r = 0; r < 16; ++r) s[kb2][r] = 0.f; \
            _Pragma("unroll") for (int ks = 0; ks < 4; ++ks) s[kb2] = MFMA32(Kf[ks], Qf[ks], s[kb2]); \
        } \
        const bool nearb = (64 * (jj) + 63 + 128 > tw0); \
        float mloc = NEG_INF; \
        if (!nearb) { \
            _Pragma("unroll") for (int kb2 = 0; kb2 < 2; ++kb2) _Pragma("unroll") for (int r = 0; r < 16; ++r) mloc = fmaxf(mloc, s[kb2][r]); \
            mloc = mloc * c1 + lut[96 + 128]; \
        } else { \
            const LAS float* lp = lut + (t - 64 * (jj) - 4 * h2 + 96 - 63); \
            _Pragma("unroll") for (int kb2 = 0; kb2 < 2; ++kb2) \
                _Pragma("unroll") for (int r = 0; r < 16; ++r) { const float v_ = s[kb2][r] * c1 + lp[63 - (32 * kb2 + crow_c(r))]; s[kb2][r] = v_; mloc = fmaxf(mloc, v_); } \
        } \
        mloc = fmaxf(mloc, __shfl_xor(mloc, 32)); \
        if (__any(mloc > m_run + AT_THR)) { \
            const float m_new = fmaxf(m_run, mloc); \
            const float alpha = __builtin_amdgcn_exp2f(m_run - m_new); \
            m_run = m_new; l_run *= alpha; \
            _Pragma("unroll") for (int d = 0; d < NDV; ++d) _Pragma("unroll") for (int r = 0; r < 16; ++r) O[d][r] *= alpha; \
        } \
        const float sub = lut[96 + 128] - m_run; \
        if (!nearb) { _Pragma("unroll") for (int kb2 = 0; kb2 < 2; ++kb2) _Pragma("unroll") for (int r = 0; r < 16; ++r) s[kb2][r] = __builtin_amdgcn_exp2f(s[kb2][r] * c1 + sub); } \
        else        { _Pragma("unroll") for (int kb2 = 0; kb2 < 2; ++kb2) _Pragma("unroll") for (int r = 0; r < 16; ++r) s[kb2][r] = __builtin_amdgcn_exp2f(s[kb2][r] - m_run); } \
        float psum0 = 0.f, psum1 = 0.f; \
        _Pragma("unroll") for (int kb2 = 0; kb2 < 2; ++kb2) { \
            const unsigned mw = mcur[kb2] >> (4 * h2); \
            _Pragma("unroll") for (int g = 0; g < 4; ++g) { \
                f32x4 mf = {1.f, 1.f, 1.f, 1.f}; \
                if (MASKED) mf = lutm[(mw >> (8 * g)) & 15u];                  \
                _Pragma("unroll") for (int e = 0; e < 4; ++e) { \
                    float p = s[kb2][4 * g + e]; \
                    if (MASKED) { p *= mf[e]; s[kb2][4 * g + e] = p; } \
                    if (e & 1) psum1 += p; else psum0 += p; \
                } \
            } \
        } \
        l_run += psum0 + psum1; \
        _Pragma("unroll") for (int st = 0; st < 4; ++st) { \
            u32x4 pw; \
            _Pragma("unroll") for (int e = 0; e < 4; ++e) pw[e] = pack_bf16(s[st >> 1][8 * (st & 1) + 2 * e], s[st >> 1][8 * (st & 1) + 2 * e + 1]); \
            Pf[st] = __builtin_bit_cast(bf16x8, pw); \
        } \
    } while (0)
#define AT_PV(jj) do { \
        const LAS unsigned char* vt = F.lds + ((jj) % AT_NSTG) * AT_BUF + AT_KBYTES + q * 128; \
        constexpr int NH = NDV / 2, NST = 4 * NH; \
        bf16x8 Av[2][2]; \
        _Pragma("unroll") for (int d = 0; d < 2; ++d) Av[0][d] = *(const LAS bf16x8*)(vt + (32 * d) * 128 + ((h2 ^ swz) << 4)); \
        _Pragma("unroll") for (int u = 0; u < NST; ++u) { \
            const int st = u / NH, dh = u % NH; \
            if (u + 1 < NST) { \
                const int st1 = (u + 1) / NH, dh1 = (u + 1) % NH; \
                _Pragma("unroll") for (int d = 0; d < 2; ++d) Av[(u + 1) & 1][d] = *(const LAS bf16x8*)(vt + (32 * (2 * dh1 + d)) * 128 + (((2 * st1 + h2) ^ swz) << 4)); \
            } \
            __builtin_amdgcn_s_setprio(1); \
            _Pragma("unroll") for (int d = 0; d < 2; ++d) O[2 * dh + d] = MFMA32(Av[u & 1][d], Pf[st], O[2 * dh + d]); \
            __builtin_amdgcn_s_setprio(0); \
            __builtin_amdgcn_sched_barrier(0); \
        } \
    } while (0)
#define AT_ACT(jj) (64 * (jj) <= tw0 + 31)
#define AT_WAITG() do { if (DV == 128) asm volatile("s_waitcnt vmcnt(3)" ::: "memory"); else asm volatile("s_waitcnt vmcnt(2)" ::: "memory"); } while (0)
    AT_DMA(0); AT_MLOAD(0);
    unsigned mcur[2] = {mreg[0], mreg[1]};
    if (jmax >= 1) AT_DMA(1);
    asm volatile("s_waitcnt vmcnt(0)" ::: "memory");
    __syncthreads();
    if (F.wave < 4) {
        for (int j = 0; j <= jmax; ++j) {
            if (j < jmax) AT_MLOAD(j + 1);
            if (j + 2 <= jmax) AT_DMA(j + 2);
            if (AT_ACT(j)) { AT_QKSM(j); AT_PV(j); }
            mcur[0] = mreg[0]; mcur[1] = mreg[1];
            if (j + 2 <= jmax) AT_WAITG(); else asm volatile("s_waitcnt vmcnt(0)" ::: "memory");
            asm volatile("s_waitcnt lgkmcnt(0)" ::: "memory"); __builtin_amdgcn_s_barrier(); asm volatile("" ::: "memory");
        }
    } else {
        for (int j = 0; j <= jmax; ++j) {
            if (j < jmax) AT_MLOAD(j + 1);
            if (j + 2 <= jmax) AT_DMA(j + 2);
            if (j > 0 && AT_ACT(j - 1)) AT_PV(j - 1);
            if (AT_ACT(j)) AT_QKSM(j);
            mcur[0] = mreg[0]; mcur[1] = mreg[1];
            if (j + 2 <= jmax) AT_WAITG(); else asm volatile("s_waitcnt vmcnt(0)" ::: "memory");
            asm volatile("s_waitcnt lgkmcnt(0)" ::: "memory"); __builtin_amdgcn_s_barrier(); asm volatile("" ::: "memory");
        }
        if (AT_ACT(jmax)) AT_PV(jmax);
    }
    __syncthreads();
#undef AT_WAITG
#undef AT_DMA
#undef AT_MLOAD
#undef AT_QKSM
#undef AT_PV
#undef AT_ACT
    const float lt = l_run + __shfl_xor(l_run, 32);
    const float inv = 1.0f / lt;
#pragma unroll
    for (int d = 0; d < NDV; ++d)
#pragma unroll
        for (int r = 0; r < 16; ++r) O[d][r] *= inv;
}

DI float rel_bucket_bias(const float* rel_bias, int d, int head) {
    int bkt;
    if (d < 16) bkt = d;
    else { const float lr = __logf((float)d * (1.0f / 16.0f)) / 2.0794415416798357f; int l = 16 + (int)(lr * 16.0f); bkt = l < 31 ? l : 31; }
    return rel_bias[bkt * 12 + head];
}
constexpr int AC_SLOTB = 8192, AC_K = 0, AC_V = 3 * AC_SLOTB, AC_WS = 6 * AC_SLOTB, AC_LUTM = AC_WS + 8 * 256, AC_OST = AC_LUTM + 256, AC_M = AC_OST + 8 * 4096, AC_LUTB = AC_M + 3 * 2048, AC_LUTB_LD = 640;
static_assert(AC_LUTB + 8 * AC_LUTB_LD * 4 <= 163840 - 64, "LDS");
constexpr float AC_THR = 8.0f;
typedef short v4i16_t __attribute__((ext_vector_type(4)));
typedef const LAS char* lds_cptr;
DI int ac_crow(int r, int hi) { return (r & 3) + 8 * (r >> 2) + 4 * hi; }
DI void ac_glds16(const void* g, unsigned lds_dst) { unsigned keep;
    asm volatile("s_mov_b32 %0, m0\n\ts_mov_b32 m0, %2\n\ts_nop 0\n\tglobal_load_lds_dwordx4 %1, off\n\ts_mov_b32 m0, %0" : "=&s"(keep) : "v"(g), "s"(lds_dst) : "memory"); }
DI void ac_glds4(const void* g, unsigned lds_dst) { unsigned keep;
    asm volatile("s_mov_b32 %0, m0\n\ts_mov_b32 m0, %2\n\ts_nop 0\n\tglobal_load_lds_dword %1, off\n\ts_mov_b32 m0, %0" : "=&s"(keep) : "v"(g), "s"(lds_dst) : "memory"); }
DI void ac_kload2(bf16x8* kf, lds_cptr kp, int j) { kf[2 * j] = *(const LAS bf16x8*)(kp + j * 2048); kf[2 * j + 1] = *(const LAS bf16x8*)(kp + j * 2048 + 512); }
DI s16x4 ac_vtr(lds_cptr p) { return __builtin_bit_cast(s16x4, __builtin_amdgcn_ds_read_tr16_b64_v4i16((LAS v4i16_t*)p)); }
DI void ac_bias(f32x16& p0, f32x16& p1, int jb, int qrel, int hi, const LAS float* lutb) {
    const LAS float* lp = lutb + (qrel - 64 * jb - 4 * hi + 256);
#pragma unroll
    for (int r = 0; r < 16; ++r) { const int kv = (r & 3) + 8 * (r >> 2); p0[r] += lp[-kv]; p1[r] += lp[-kv - 32]; }
}
DI float ac_fand(float a, unsigned m) { return __uint_as_float(__float_as_uint(a) & m); }
#define AC_SBAR() __builtin_amdgcn_sched_barrier(0)
#define AC_WAIT_BAR(N) asm volatile("s_waitcnt vmcnt(" #N ") lgkmcnt(0)\n\ts_barrier" ::: "memory")
#define AC_MFMA(a, b, c) __builtin_amdgcn_mfma_f32_32x32x16_bf16((a), (b), (c), 0, 0, 0)
DI void attn_c_unit(const Frame& F, int b, int h, int qb, const bf16_t* Z, bf16_t* Yo, const unsigned* maskg, const float fb) {
    LAS unsigned char* shm = F.lds;
    const int lane = fresh_lane(), r32 = lane & 31, hi = lane >> 5, wid = F.wave;
    const size_t rowbase = (size_t)b * SEQ; const int q0 = qb * 256;
    const bf16_t* Qw = Z + (rowbase + q0 + wid * 32) * CD_N + Z_QC + h * 64;
    const bf16_t* Kh = Z + rowbase * CD_N + Z_KC + h * 64; const bf16_t* Vh = Z + rowbase * CD_N + Z_VC + h * 64;
    const unsigned lds0 = (unsigned)(size_t)shm;
    LAS float* wsf = (LAS float*)(shm + AC_WS) + wid * 64;
    const LAS u32x4* lutm = (const LAS u32x4*)(shm + AC_LUTM);
    const LAS float* lutb = (const LAS float*)(shm + AC_LUTB) + h * AC_LUTB_LD;
    const bf16_t* ksrc = Kh + (size_t)lane * CD_N + wid * 8;
    const bf16_t* vsrc = Vh + (size_t)(16 * (wid & 3) + (lane >> 2)) * CD_N + (wid >> 2) * 32 + (lane & 3) * 8;
    const unsigned* msrc = maskg + (rowbase + q0 + wid * 32 + (lane >> 1)) * 256 + (lane & 1);
    const unsigned kdst = lds0 + AC_K + wid * 1024, vdst = lds0 + AC_V + wid * 1024, mdst = lds0 + AC_M + wid * 256;
#define DMA_K(t, slot) ac_glds16(ksrc + (size_t)(t) * 64 * CD_N, (unsigned)__builtin_amdgcn_readfirstlane(kdst + (slot)))
#define DMA_V(t, slot) ac_glds16(vsrc + (size_t)(t) * 64 * CD_N, (unsigned)__builtin_amdgcn_readfirstlane(vdst + (slot)))
#define DMA_M(t, slot) ac_glds4(msrc + 2 * (t), (unsigned)__builtin_amdgcn_readfirstlane(mdst + ((slot) >> 2)))
    const lds_cptr shm3 = (lds_cptr)shm;
    const lds_cptr kp0 = shm3 + AC_K + hi * 1024 + r32 * 16;
    const lds_cptr vp0 = shm3 + AC_V + ((lane >> 4) & 1) * 32 + (lane & 3) * 8 + (4 * hi + ((lane & 15) >> 2)) * 64;
    const lds_cptr mp0 = shm3 + AC_M + wid * 256 + 8 * r32;
    const int NT = (q0 + 256) / 64;
    DMA_K(0, 0); DMA_M(0, 0); DMA_M(1, AC_SLOTB); DMA_V(0, 0); DMA_K(1, AC_SLOTB);
    bf16x8 qr[4];
#pragma unroll
    for (int d0 = 0; d0 < 4; ++d0) qr[d0] = *(const bf16x8*)(Qw + (size_t)r32 * CD_N + d0 * 16 + hi * 8);
    float mhat = 0.f, l_reg = 0.f; f32x16 o[2]; f32x16 negm;
#pragma unroll
    for (int r = 0; r < 16; ++r) { o[0][r] = 0.f; o[1][r] = 0.f; negm[r] = fb; }
    asm volatile("" : "+v"(negm));
    const int qrel = wid * 32 + r32;
    bool resc = false;
    bf16x8 kf[8];
    f32x16 pA0, pA1, pB0, pB1;
    int sl_prev = 0, sl_cur = 0, sl_next = AC_SLOTB;
#define ROT() do { sl_prev = sl_cur; sl_cur = sl_next; sl_next = (sl_next == 2 * AC_SLOTB) ? 0 : sl_next + AC_SLOTB; } while (0)
#define RESC() do { if (resc) { asm volatile("s_waitcnt lgkmcnt(0)" ::: "memory"); \
        _Pragma("unroll") for (int d_ = 0; d_ < 2; ++d_) _Pragma("unroll") for (int r = 0; r < 16; ++r) o[d_][r] *= wsf[ac_crow(r, hi)]; } } while (0)
    DMA_K(2, 2 * AC_SLOTB);
    AC_WAIT_BAR(3);
    {
#pragma unroll
        for (int d0 = 0; d0 < 4; ++d0) ac_kload2(kf, kp0, d0);
        pA0 = AC_MFMA(kf[0], qr[0], negm); pA1 = AC_MFMA(kf[1], qr[0], negm);
#pragma unroll
        for (int d0 = 1; d0 < 4; ++d0) { pA0 = AC_MFMA(kf[2 * d0], qr[d0], pA0); pA1 = AC_MFMA(kf[2 * d0 + 1], qr[d0], pA1); }
        if (NT == 4) ac_bias(pA0, pA1, 0, qrel, hi, lutb);
        float rm = -__builtin_huge_valf();
#pragma unroll
        for (int r = 0; r < 16; ++r) rm = __builtin_fmaxf(rm, __builtin_fmaxf(pA0[r], pA1[r]));
        { auto rr = __builtin_amdgcn_permlane32_swap(__float_as_uint(rm), __float_as_uint(rm), false, false); rm = __builtin_fmaxf(__uint_as_float(rr[0]), __uint_as_float(rr[1])); }
        mhat = rm;
#pragma unroll
        for (int r = 0; r < 16; ++r) negm[r] = fb - mhat;
        asm volatile("" : "+v"(negm));
        const u32x2 mwv = *(const LAS u32x2*)(mp0);
        const unsigned w0 = mwv[0] >> (4 * hi), w1 = mwv[1] >> (4 * hi);
#pragma unroll
        for (int g = 0; g < 4; ++g) {
            const u32x4 m0 = lutm[(w0 >> (8 * g)) & 15u], m1 = lutm[(w1 >> (8 * g)) & 15u];
#pragma unroll
            for (int e = 0; e < 4; ++e) { pA0[4 * g + e] = ac_fand(__builtin_amdgcn_exp2f(pA0[4 * g + e] - rm), m0[e]); pA1[4 * g + e] = ac_fand(__builtin_amdgcn_exp2f(pA1[4 * g + e] - rm), m1[e]); }
        }
    }
    AC_WAIT_BAR(0);
    DMA_K(3, 0); DMA_V(1, AC_SLOTB); DMA_M(2, 2 * AC_SLOTB);
    ROT();
#pragma unroll
    for (int d0 = 0; d0 < 4; ++d0) ac_kload2(kf, kp0 + sl_cur, d0);
    AC_WAIT_BAR(3);
    s16x4 vlo[8], vhi[8]; u32x4 pw0, pw1, pw2, pw3; u32x4 mfa, mfb; unsigned mw0, mw1;
#define PKW(P, B) pack_bf16(P[B], P[B + 1])
#define PAF(k) __builtin_bit_cast(bf16x8, pw##k)
#define VFR(i) (bf16x8){vlo[i][0], vlo[i][1], vlo[i][2], vlo[i][3], vhi[i][0], vhi[i][1], vhi[i][2], vhi[i][3]}
#define PIN(x) asm volatile("" : "+v"(x))
#define MX3(a, b, c) __builtin_fmaxf(__builtin_fmaxf((a), (b)), (c))
#define GAPA(MF, A0, A1, A2, A3, W0, W1, PW) do { MF; sacc += A0; sacc += A1; sacc += A2; sacc += A3; PIN(sacc); W0; W1; PIN(PW); AC_SBAR(); } while (0)
#define EX(v) __builtin_amdgcn_exp2f(v)
#define LUTQ(W, S) (*(const LAS u32x4*)(size_t)(unsigned)(AC_LUTM + __builtin_amdgcn_ubfe((W), (S), 8)))
#define GAPB(MF, X, B, MQ, NW, NS) do { MF; X[B] = ac_fand(EX(X[B]), MQ[0]); X[B + 1] = ac_fand(EX(X[B + 1]), MQ[1]); X[B + 2] = ac_fand(EX(X[B + 2]), MQ[2]); X[B + 3] = ac_fand(EX(X[B + 3]), MQ[3]); PIN(X); \
        MQ = LUTQ(NW, NS); AC_SBAR(); } while (0)
#define VRD(i) do { vlo[i] = ac_vtr(vp_ + (((i) >> 2) * 4096 + ((i) & 3) * 1024)); vhi[i] = ac_vtr(vp_ + (((i) >> 2) * 4096 + ((i) & 3) * 1024 + 512)); } while (0)
#define KRD(G, j) do { if (G) { ac_kload2(kf, kp0 + sl_next, j); AC_SBAR(); } } while (0)
#define STEP(C0, C1, P0, P1, t, BAND, GK, GV, GL, GM) do { AC_SBAR(); \
    const lds_cptr vp_ = vp0 + sl_prev; \
    { const u32x2 mwv_ = *(const LAS u32x2*)(mp0 + (sl_cur >> 2)); mw0 = ((mwv_[0] >> (4 * hi)) & 0x0f0f0f0fu) << 4; mw1 = ((mwv_[1] >> (4 * hi)) & 0x0f0f0f0fu) << 4; } \
    VRD(0); AC_SBAR(); float sacc = (P0[0] + P0[1]); \
    GAPA(C0 = AC_MFMA(kf[0], qr[0], negm), P0[2], P0[3], P0[4], P0[5],     pw0[0] = PKW(P0, 0), pw0[1] = PKW(P0, 2), pw0); \
    VRD(4); AC_SBAR(); GAPA(C1 = AC_MFMA(kf[1], qr[0], negm), P0[6], P0[7], P0[8], P0[9],     pw0[2] = PKW(P0, 4), pw0[3] = PKW(P0, 6), pw0); \
    VRD(1); AC_SBAR(); GAPA(C0 = AC_MFMA(kf[2], qr[1], C0),   P0[10], P0[11], P0[12], P0[13], pw1[0] = PKW(P0, 8), pw1[1] = PKW(P0, 10), pw1); \
    VRD(5); AC_SBAR(); GAPA(C1 = AC_MFMA(kf[3], qr[1], C1),   P0[14], P0[15], P1[0], P1[1],   pw1[2] = PKW(P0, 12), pw1[3] = PKW(P0, 14), pw1); \
    VRD(2); AC_SBAR(); GAPA(C0 = AC_MFMA(kf[4], qr[2], C0),   P1[2], P1[3], P1[4], P1[5],     pw2[0] = PKW(P1, 0), pw2[1] = PKW(P1, 2), pw2); \
    VRD(6); AC_SBAR(); GAPA(C1 = AC_MFMA(kf[5], qr[2], C1),   P1[6], P1[7], P1[8], P1[9],     pw2[2] = PKW(P1, 4), pw2[3] = PKW(P1, 6), pw2); \
    VRD(3); AC_SBAR(); GAPA(C0 = AC_MFMA(kf[6], qr[3], C0),   P1[10], P1[11], P1[12], P1[13], pw3[0] = PKW(P1, 8), pw3[1] = PKW(P1, 10), pw3); \
    VRD(7); AC_SBAR(); GAPA(C1 = AC_MFMA(kf[7], qr[3], C1),   P1[14], P1[15], 0.f, 0.f,       pw3[2] = PKW(P1, 12), pw3[3] = PKW(P1, 14), pw3); \
    l_reg += sacc; \
    if (GK) { DMA_K((t) + 3, sl_cur); } if (GV) { DMA_V((t) + 1, sl_next); } if (GM) { DMA_M((t) + 2, sl_prev); } \
    mfa = LUTQ(mw0, 0); mfb = LUTQ(mw0, 8); \
    if (BAND) { const int jb_ = (t) - (NT - 4); if (jb_ >= -2) ac_bias(C0, C1, jb_, qrel, hi, lutb); } \
    { float a_ = MX3(C0[0], C0[1], C1[0]), b_ = MX3(C0[2], C0[3], C1[1]); a_ = MX3(a_, C1[2], C1[3]); \
      _Pragma("unroll") for (int r = 4; r < 16; r += 4) { a_ = MX3(a_, C0[r], C0[r + 1]); b_ = MX3(b_, C0[r + 2], C0[r + 3]); a_ = MX3(a_, C1[r], C1[r + 1]); b_ = MX3(b_, C1[r + 2], C1[r + 3]); } \
      float rm = __builtin_fmaxf(a_, b_); { auto rr = __builtin_amdgcn_permlane32_swap(__float_as_uint(rm), __float_as_uint(rm), false, false); rm = __builtin_fmaxf(__uint_as_float(rr[0]), __uint_as_float(rr[1])); } \
      resc = false; \
      if (__builtin_expect(__any(rm > AC_THR), 0)) { const float dl = __builtin_fmaxf(rm, 0.f); mhat += dl; \
        _Pragma("unroll") for (int r = 0; r < 16; ++r) { C0[r] -= dl; C1[r] -= dl; } \
        _Pragma("unroll") for (int r = 0; r < 16; ++r) negm[r] = fb - mhat; asm volatile("" : "+v"(negm)); \
        const float f = __builtin_amdgcn_exp2f(-dl); l_reg *= f; if (hi == 0) wsf[r32] = f; resc = true; } } \
    AC_SBAR(); \
    GAPB(o[0] = AC_MFMA(PAF(0), VFR(0), o[0]), C0, 0, mfa, mw0, 16); \
    GAPB(o[1] = AC_MFMA(PAF(0), VFR(4), o[1]), C0, 4, mfb, mw0, 24); \
    KRD(GL, 0); GAPB(o[0] = AC_MFMA(PAF(1), VFR(1), o[0]), C0, 8, mfa, mw1, 0); \
    KRD(GL, 1); GAPB(o[1] = AC_MFMA(PAF(1), VFR(5), o[1]), C0, 12, mfb, mw1, 8); \
    KRD(GL, 2); GAPB(o[0] = AC_MFMA(PAF(2), VFR(2), o[0]), C1, 0, mfa, mw1, 16); \
    KRD(GL, 3); GAPB(o[1] = AC_MFMA(PAF(2), VFR(6), o[1]), C1, 4, mfb, mw1, 24); \
    GAPB(o[0] = AC_MFMA(PAF(3), VFR(3), o[0]), C1, 8, mfa, mw1, 24); \
    GAPB(o[1] = AC_MFMA(PAF(3), VFR(7), o[1]), C1, 12, mfb, mw1, 24); \
    } while (0)
    int t = 1;
    for (; t + 7 < NT; t += 2) {
        STEP(pB0, pB1, pA0, pA1, t, false, true, true, true, true);     AC_WAIT_BAR(3); RESC(); ROT();
        STEP(pA0, pA1, pB0, pB1, t + 1, false, true, true, true, true); AC_WAIT_BAR(3); RESC(); ROT();
    }
#define ENDW(tt) do { if ((tt) + 3 < NT) { AC_WAIT_BAR(3); } else if ((tt) + 2 < NT) { AC_WAIT_BAR(2); } else { AC_WAIT_BAR(0); } } while (0)
    for (; t + 1 < NT; t += 2) {
        STEP(pB0, pB1, pA0, pA1, t, true, (t + 3 < NT), (t + 1 < NT), (t + 1 < NT), (t + 2 < NT));         ENDW(t);     RESC(); ROT();
        STEP(pA0, pA1, pB0, pB1, t + 1, true, (t + 4 < NT), (t + 2 < NT), (t + 2 < NT), (t + 3 < NT));     ENDW(t + 1); RESC(); ROT();
    }
    STEP(pB0, pB1, pA0, pA1, NT - 1, true, false, false, false, false); RESC();
    {
        float sacc = pB0[0] + pB0[1];
#pragma unroll
        for (int r = 2; r < 16; ++r) sacc += pB0[r];
#pragma unroll
        for (int r = 0; r < 16; ++r) sacc += pB1[r];
        l_reg += sacc;
        pw0 = (u32x4){PKW(pB0, 0), PKW(pB0, 2), PKW(pB0, 4), PKW(pB0, 6)}; pw1 = (u32x4){PKW(pB0, 8), PKW(pB0, 10), PKW(pB0, 12), PKW(pB0, 14)};
        pw2 = (u32x4){PKW(pB1, 0), PKW(pB1, 2), PKW(pB1, 4), PKW(pB1, 6)}; pw3 = (u32x4){PKW(pB1, 8), PKW(pB1, 10), PKW(pB1, 12), PKW(pB1, 14)};
        const lds_cptr vp_ = vp0 + sl_cur;
#pragma unroll
        for (int i = 0; i < 8; ++i) VRD(i);
        o[0] = AC_MFMA(PAF(0), VFR(0), o[0]); o[1] = AC_MFMA(PAF(0), VFR(4), o[1]); o[0] = AC_MFMA(PAF(1), VFR(1), o[0]); o[1] = AC_MFMA(PAF(1), VFR(5), o[1]);
        o[0] = AC_MFMA(PAF(2), VFR(2), o[0]); o[1] = AC_MFMA(PAF(2), VFR(6), o[1]); o[0] = AC_MFMA(PAF(3), VFR(3), o[0]); o[1] = AC_MFMA(PAF(3), VFR(7), o[1]);
    }
    { auto rr = __builtin_amdgcn_permlane32_swap(__float_as_uint(l_reg), __float_as_uint(l_reg), false, false); l_reg = __uint_as_float(rr[0]) + __uint_as_float(rr[1]); }
    if (hi == 0) wsf[32 + r32] = l_reg;
    asm volatile("s_waitcnt lgkmcnt(0)" ::: "memory");
    float rli[16];
#pragma unroll
    for (int r = 0; r < 16; ++r) rli[r] = __builtin_amdgcn_rcpf(wsf[32 + ac_crow(r, hi)]);
    {
        bf16_t* Ow = Yo + (rowbase + q0 + wid * 32) * DM + h * 64;
        LAS bf16_t* stg = (LAS bf16_t*)(shm + AC_OST) + wid * 2048;
#pragma unroll
        for (int r = 0; r < 16; ++r) { const int orow = ac_crow(r, hi);
#pragma unroll
            for (int d0 = 0; d0 < 2; ++d0) stg[orow * 64 + d0 * 32 + r32] = (bf16_t)(pack_bf16(o[d0][r] * rli[r], 0.f) & 0xffffu); }
        asm volatile("s_waitcnt lgkmcnt(0)" ::: "memory");
#pragma unroll
        for (int i = 0; i < 4; ++i) { const int row = i * 8 + (lane >> 3), ch = lane & 7; const u32x4 v = *(const LAS u32x4*)(stg + row * 64 + ch * 8); *(u32x4*)(Ow + (size_t)row * DM + ch * 8) = v; }
    }
    asm volatile("s_waitcnt lgkmcnt(0)\n\ts_barrier" ::: "memory");
#undef DMA_K
#undef DMA_V
#undef DMA_M
#undef ROT
#undef RESC
#undef PKW
#undef PAF
#undef VFR
#undef PIN
#undef MX3
#undef GAPA
#undef EX
#undef GAPB
#undef LUTQ
#undef VRD
#undef KRD
#undef STEP
#undef ENDW
}

constexpr int AD_SLOTB = 8192, AD_K = 0, AD_V = 3 * AD_SLOTB, AD_WS = AD_V + 3 * 2 * AD_SLOTB, AD_LUTB = AD_WS + 8 * 256, AD_OST = AD_LUTB + 4 * AC_LUTB_LD * 4;
static_assert(AD_OST + 8 * 8192 <= 163840 - 64, "LDS");
DI void attn_d_unit(const Frame& F, int b, int hd, int map, int qb, const bf16_t* Z, const float fb, f32x16 (&o)[4]) {
    LAS unsigned char* shm = F.lds;
    const int lane = fresh_lane(), r32 = lane & 31, hi = lane >> 5, wid = F.wave;
    const size_t rowbase = (size_t)b * SEQ; const int q0 = qb * 256;
    const bf16_t* Qw = Z + (rowbase + q0 + wid * 32) * CD_N + Z_QD + hd * 128 + map * 64;
    const bf16_t* Kh = Z + rowbase * CD_N + Z_KD + hd * 128 + map * 64; const bf16_t* Vh = Z + rowbase * CD_N + Z_VD + hd * 128;
    const unsigned lds0 = (unsigned)(size_t)shm;
    LAS float* wsf = (LAS float*)(shm + AD_WS) + wid * 64;
    const LAS float* lutb = (const LAS float*)(shm + AD_LUTB) + hd * AC_LUTB_LD;
    const bf16_t* ksrc = Kh + (size_t)lane * CD_N + wid * 8;
    const bf16_t* vsrc = Vh + (size_t)(16 * (wid & 3) + (lane >> 2)) * CD_N + (wid >> 2) * 32 + (lane & 3) * 8;
    const unsigned kdst = lds0 + AD_K + wid * 1024, vdst = lds0 + AD_V + wid * 1024;
#define DMA_K(t, slot) ac_glds16(ksrc + (size_t)(t) * 64 * CD_N, (unsigned)__builtin_amdgcn_readfirstlane(kdst + (slot)))
#define DMA_V(t, slot) do { ac_glds16(vsrc + (size_t)(t) * 64 * CD_N, (unsigned)__builtin_amdgcn_readfirstlane(vdst + 2 * (slot))); \
                            ac_glds16(vsrc + (size_t)(t) * 64 * CD_N + 64, (unsigned)__builtin_amdgcn_readfirstlane(vdst + 2 * (slot) + 8192)); } while (0)
    const lds_cptr shm3 = (lds_cptr)shm;
    const lds_cptr kp0 = shm3 + AD_K + hi * 1024 + r32 * 16;
    const lds_cptr vp0 = shm3 + AD_V + ((lane >> 4) & 1) * 32 + (lane & 3) * 8 + (4 * hi + ((lane & 15) >> 2)) * 64;
    const int NT = (q0 + 256) / 64;
    DMA_K(0, 0); DMA_V(0, 0); DMA_K(1, AD_SLOTB);
    bf16x8 qr[4];
#pragma unroll
    for (int d0 = 0; d0 < 4; ++d0) qr[d0] = *(const bf16x8*)(Qw + (size_t)r32 * CD_N + d0 * 16 + hi * 8);
    float mhat = 0.f, l_reg = 0.f; f32x16 negm;
#pragma unroll
    for (int r = 0; r < 16; ++r) { o[0][r] = 0.f; o[1][r] = 0.f; o[2][r] = 0.f; o[3][r] = 0.f; negm[r] = fb; }
    asm volatile("" : "+v"(negm));
    const int qrel = wid * 32 + r32;
    bool resc = false;
    bf16x8 kf[8];
    f32x16 pA0, pA1, pB0, pB1;
    int sl_prev = 0, sl_cur = 0, sl_next = AD_SLOTB;
#define ROT() do { sl_prev = sl_cur; sl_cur = sl_next; sl_next = (sl_next == 2 * AD_SLOTB) ? 0 : sl_next + AD_SLOTB; } while (0)
#define RESC() do { if (resc) { asm volatile("s_waitcnt lgkmcnt(0)" ::: "memory"); \
        _Pragma("unroll") for (int d_ = 0; d_ < 4; ++d_) _Pragma("unroll") for (int r = 0; r < 16; ++r) o[d_][r] *= wsf[ac_crow(r, hi)]; } } while (0)
    DMA_K(2, 2 * AD_SLOTB);
    AC_WAIT_BAR(4);
    {
#pragma unroll
        for (int d0 = 0; d0 < 4; ++d0) ac_kload2(kf, kp0, d0);
        pA0 = AC_MFMA(kf[0], qr[0], negm); pA1 = AC_MFMA(kf[1], qr[0], negm);
#pragma unroll
        for (int d0 = 1; d0 < 4; ++d0) { pA0 = AC_MFMA(kf[2 * d0], qr[d0], pA0); pA1 = AC_MFMA(kf[2 * d0 + 1], qr[d0], pA1); }
        if (NT == 4) ac_bias(pA0, pA1, 0, qrel, hi, lutb);
        float rm = -__builtin_huge_valf();
#pragma unroll
        for (int r = 0; r < 16; ++r) rm = __builtin_fmaxf(rm, __builtin_fmaxf(pA0[r], pA1[r]));
        { auto rr = __builtin_amdgcn_permlane32_swap(__float_as_uint(rm), __float_as_uint(rm), false, false); rm = __builtin_fmaxf(__uint_as_float(rr[0]), __uint_as_float(rr[1])); }
        mhat = rm;
#pragma unroll
        for (int r = 0; r < 16; ++r) negm[r] = fb - mhat;
        asm volatile("" : "+v"(negm));
#pragma unroll
        for (int r = 0; r < 16; ++r) { pA0[r] = __builtin_amdgcn_exp2f(pA0[r] - rm); pA1[r] = __builtin_amdgcn_exp2f(pA1[r] - rm); }
    }
    AC_WAIT_BAR(0);
    DMA_K(3, 0); DMA_V(1, AD_SLOTB);
    ROT();
#pragma unroll
    for (int d0 = 0; d0 < 4; ++d0) ac_kload2(kf, kp0 + sl_cur, d0);
    AC_WAIT_BAR(3);
    s16x4 vlo[4], vhi[4]; u32x4 pw0, pw1, pw2, pw3;
#define PKW(P, B) pack_bf16(P[B], P[B + 1])
#define PAF(k) __builtin_bit_cast(bf16x8, pw##k)
#define VFR(i) (bf16x8){vlo[(i) & 3][0], vlo[(i) & 3][1], vlo[(i) & 3][2], vlo[(i) & 3][3], vhi[(i) & 3][0], vhi[(i) & 3][1], vhi[(i) & 3][2], vhi[(i) & 3][3]}
#define PIN(x) asm volatile("" : "+v"(x))
#define MX3(a, b, c) __builtin_fmaxf(__builtin_fmaxf((a), (b)), (c))
#define VRD(g) do { const int i_ = ((g) & 3) * 4 + ((g) >> 2); vlo[(g) & 3] = ac_vtr(vp_ + ((i_ >> 2) * 4096 + (i_ & 3) * 1024)); vhi[(g) & 3] = ac_vtr(vp_ + ((i_ >> 2) * 4096 + (i_ & 3) * 1024 + 512)); } while (0)
#define GAPA(MF, A0, A1, A2, A3, W0, W1, PW) do { MF; sacc += A0; sacc += A1; sacc += A2; sacc += A3; PIN(sacc); W0; W1; PIN(PW); AC_SBAR(); } while (0)
#define EX(v) __builtin_amdgcn_exp2f(v)
#define GAPB(g, X, B) do { o[(g) & 3] = AC_MFMA(PAF_SEL((g) >> 2), VFR(g), o[(g) & 3]); X[B] = EX(X[B]); X[B + 1] = EX(X[B + 1]); PIN(X); if ((g) + 3 < 16) { VRD((g) + 3); } AC_SBAR(); } while (0)
#define PAF_SEL(k) ((k) == 0 ? PAF(0) : (k) == 1 ? PAF(1) : (k) == 2 ? PAF(2) : PAF(3))
#define KRD(G, j) do { if (G) { ac_kload2(kf, kp0 + sl_next, j); AC_SBAR(); } } while (0)
#define STEP(C0, C1, P0, P1, t, BAND, GK, GV, GL) do { AC_SBAR(); \
    const lds_cptr vp_ = vp0 + 2 * sl_prev; \
    float sacc = (P0[0] + P0[1]); \
    GAPA(C0 = AC_MFMA(kf[0], qr[0], negm), P0[2], P0[3], P0[4], P0[5],     pw0[0] = PKW(P0, 0), pw0[1] = PKW(P0, 2), pw0); \
    GAPA(C1 = AC_MFMA(kf[1], qr[0], negm), P0[6], P0[7], P0[8], P0[9],     pw0[2] = PKW(P0, 4), pw0[3] = PKW(P0, 6), pw0); \
    GAPA(C0 = AC_MFMA(kf[2], qr[1], C0),   P0[10], P0[11], P0[12], P0[13], pw1[0] = PKW(P0, 8), pw1[1] = PKW(P0, 10), pw1); \
    GAPA(C1 = AC_MFMA(kf[3], qr[1], C1),   P0[14], P0[15], P1[0], P1[1],   pw1[2] = PKW(P0, 12), pw1[3] = PKW(P0, 14), pw1); \
    GAPA(C0 = AC_MFMA(kf[4], qr[2], C0),   P1[2], P1[3], P1[4], P1[5],     pw2[0] = PKW(P1, 0), pw2[1] = PKW(P1, 2), pw2); \
    VRD(0); AC_SBAR(); GAPA(C1 = AC_MFMA(kf[5], qr[2], C1),   P1[6], P1[7], P1[8], P1[9],     pw2[2] = PKW(P1, 4), pw2[3] = PKW(P1, 6), pw2); \
    VRD(1); AC_SBAR(); GAPA(C0 = AC_MFMA(kf[6], qr[3], C0),   P1[10], P1[11], P1[12], P1[13], pw3[0] = PKW(P1, 8), pw3[1] = PKW(P1, 10), pw3); \
    VRD(2); AC_SBAR(); GAPA(C1 = AC_MFMA(kf[7], qr[3], C1),   P1[14], P1[15], 0.f, 0.f,       pw3[2] = PKW(P1, 12), pw3[3] = PKW(P1, 14), pw3); \
    l_reg += sacc; \
    if (GK) { DMA_K((t) + 3, sl_cur); } if (GV) { DMA_V((t) + 1, sl_next); } \
    if (BAND) { const int jb_ = (t) - (NT - 4); if (jb_ >= -2) ac_bias(C0, C1, jb_, qrel, hi, lutb); } \
    { float a_ = MX3(C0[0], C0[1], C1[0]), b_ = MX3(C0[2], C0[3], C1[1]); a_ = MX3(a_, C1[2], C1[3]); \
      _Pragma("unroll") for (int r = 4; r < 16; r += 4) { a_ = MX3(a_, C0[r], C0[r + 1]); b_ = MX3(b_, C0[r + 2], C0[r + 3]); a_ = MX3(a_, C1[r], C1[r + 1]); b_ = MX3(b_, C1[r + 2], C1[r + 3]); } \
      float rm = __builtin_fmaxf(a_, b_); { auto rr = __builtin_amdgcn_permlane32_swap(__float_as_uint(rm), __float_as_uint(rm), false, false); rm = __builtin_fmaxf(__uint_as_float(rr[0]), __uint_as_float(rr[1])); } \
      resc = false; \
      if (__builtin_expect(__any(rm > AC_THR), 0)) { const float dl = __builtin_fmaxf(rm, 0.f); mhat += dl; \
        _Pragma("unroll") for (int r = 0; r < 16; ++r) { C0[r] -= dl; C1[r] -= dl; } \
        _Pragma("unroll") for (int r = 0; r < 16; ++r) negm[r] = fb - mhat; asm volatile("" : "+v"(negm)); \
        const float f = __builtin_amdgcn_exp2f(-dl); l_reg *= f; if (hi == 0) wsf[r32] = f; resc = true; } } \
    AC_SBAR(); \
    GAPB(0, C0, 0); GAPB(1, C0, 2); GAPB(2, C0, 4); GAPB(3, C0, 6); \
    KRD(GL, 0); GAPB(4, C0, 8); KRD(GL, 1); GAPB(5, C0, 10); KRD(GL, 2); GAPB(6, C0, 12); KRD(GL, 3); GAPB(7, C0, 14); \
    GAPB(8, C1, 0); GAPB(9, C1, 2); GAPB(10, C1, 4); GAPB(11, C1, 6); GAPB(12, C1, 8); GAPB(13, C1, 10); GAPB(14, C1, 12); GAPB(15, C1, 14); \
    } while (0)
    int t = 1;
    for (; t + 7 < NT; t += 2) {
        STEP(pB0, pB1, pA0, pA1, t, false, true, true, true);     AC_WAIT_BAR(3); RESC(); ROT();
        STEP(pA0, pA1, pB0, pB1, t + 1, false, true, true, true); AC_WAIT_BAR(3); RESC(); ROT();
    }
#define ENDW(tt) do { if ((tt) + 3 < NT) { AC_WAIT_BAR(3); } else if ((tt) + 2 < NT) { AC_WAIT_BAR(2); } else { AC_WAIT_BAR(0); } } while (0)
    for (; t + 1 < NT; t += 2) {
        STEP(pB0, pB1, pA0, pA1, t, true, (t + 3 < NT), (t + 1 < NT), (t + 1 < NT));         ENDW(t);     RESC(); ROT();
        STEP(pA0, pA1, pB0, pB1, t + 1, true, (t + 4 < NT), (t + 2 < NT), (t + 2 < NT));     ENDW(t + 1); RESC(); ROT();
    }
    STEP(pB0, pB1, pA0, pA1, NT - 1, true, false, false, false); RESC();
    {
        float sacc = pB0[0] + pB0[1];
#pragma unroll
        for (int r = 2; r < 16; ++r) sacc += pB0[r];
#pragma unroll
        for (int r = 0; r < 16; ++r) sacc += pB1[r];
        l_reg += sacc;
        pw0 = (u32x4){PKW(pB0, 0), PKW(pB0, 2), PKW(pB0, 4), PKW(pB0, 6)}; pw1 = (u32x4){PKW(pB0, 8), PKW(pB0, 10), PKW(pB0, 12), PKW(pB0, 14)};
        pw2 = (u32x4){PKW(pB1, 0), PKW(pB1, 2), PKW(pB1, 4), PKW(pB1, 6)}; pw3 = (u32x4){PKW(pB1, 8), PKW(pB1, 10), PKW(pB1, 12), PKW(pB1, 14)};
        const lds_cptr vp_ = vp0 + 2 * sl_cur;
        VRD(0); VRD(1); VRD(2);
#pragma unroll
        for (int g = 0; g < 16; ++g) {
            o[g & 3] = AC_MFMA(PAF_SEL(g >> 2), VFR(g), o[g & 3]);
            if (g + 3 < 16) { VRD(g + 3); }
            AC_SBAR();
        }
    }
    { auto rr = __builtin_amdgcn_permlane32_swap(__float_as_uint(l_reg), __float_as_uint(l_reg), false, false); l_reg = __uint_as_float(rr[0]) + __uint_as_float(rr[1]); }
    if (hi == 0) wsf[32 + r32] = l_reg;
    asm volatile("s_waitcnt lgkmcnt(0)" ::: "memory");
#pragma unroll
    for (int r = 0; r < 16; ++r) { const float rl = __builtin_amdgcn_rcpf(wsf[32 + ac_crow(r, hi)]); o[0][r] *= rl; o[1][r] *= rl; o[2][r] *= rl; o[3][r] *= rl; }
    asm volatile("s_waitcnt lgkmcnt(0)\n\ts_barrier" ::: "memory");
#undef DMA_K
#undef DMA_V
#undef ROT
#undef RESC
#undef PKW
#undef PAF
#undef PAF_SEL
#undef VFR
#undef PIN
#undef MX3
#undef GAPA
#undef EX
#undef GAPB
#undef VRD
#undef KRD
#undef STEP
#undef ENDW
}

template <bool DPART>
DI void attn_phase(const Frame& F, const Args& a) {
    const bf16_t* Z = (const bf16_t*)(a.ws + WS_BIG);
    bf16_t* Yo = (bf16_t*)(a.ws + WS_Y);
    float* O1s = (float*)(a.ws + WS_H);
    const unsigned* maskg = (const unsigned*)(a.ws + WS_MASK);
    LAS float* lut = (LAS float*)(F.lds + AT_LUT);
    if (DPART) {
        LAS float* lb = (LAS float*)(F.lds + AD_LUTB);
        for (int i = F.tid; i < 4 * AC_LUTB_LD; i += NTHR) { const int hh = 8 + i / AC_LUTB_LD, d = i % AC_LUTB_LD - 256; lb[i] = d < 0 ? NEG_INF : (rel_bucket_bias(a.rel_bias, d < 128 ? d : 128, hh) - a.rel_bias[31 * 12 + hh]) * LOG2E; }
    } else {
        if ((unsigned)(size_t)F.lds != 0u) __builtin_trap();
        if (F.tid < 16) ((LAS u32x4*)(F.lds + AC_LUTM))[F.tid] = (u32x4){0u - (unsigned)(F.tid & 1), 0u - (unsigned)((F.tid >> 1) & 1), 0u - (unsigned)((F.tid >> 2) & 1), 0u - (unsigned)((F.tid >> 3) & 1)};
        LAS float* lb = (LAS float*)(F.lds + AC_LUTB);
        for (int i = F.tid; i < 8 * AC_LUTB_LD; i += NTHR) { const int hh = i / AC_LUTB_LD, d = i % AC_LUTB_LD - 256; lb[i] = d < 0 ? NEG_INF : (rel_bucket_bias(a.rel_bias, d < 128 ? d : 128, hh) - a.rel_bias[31 * 12 + hh]) * LOG2E; }
    }
    float lam;
    { float d01 = 0.f, d23 = 0.f; for (int i = 0; i < 64; ++i) { d01 += a.diff_lam[i] * a.diff_lam[64 + i]; d23 += a.diff_lam[128 + i] * a.diff_lam[192 + i]; }
      lam = __expf(d01) - __expf(d23) + 0.35550906759096f; lam = __uint_as_float(__builtin_amdgcn_readfirstlane(__float_as_uint(lam))); }
    const float one_m_li = 1.0f - 0.35550906759096f;
    __syncthreads();
    const float c1 = 0.125f * LOG2E;
    const int xcd = F.bid & 7, kk = F.bid >> 3;
    if (DPART)
    for (int it = F.bid; it < 256; it += F.G) {
        const int bh = (F.G == 256) ? 2 * xcd + (kk >> 4) : it >> 4, pr = (F.G == 256) ? (kk & 15) : (it & 15);
        const int b_ = bh >> 2, hd_ = bh & 3;
        for (int half = 0; half < 2; ++half) {
            const int qb = half ? 31 - pr : pr;
            for (int map = 0; map < 2; ++map) {
                int b = b_, hd = hd_; asm volatile("" : "+s"(b), "+s"(hd));
                float fb = a.rel_bias[31 * 12 + 8 + hd] * LOG2E; fb = __uint_as_float(__builtin_amdgcn_readfirstlane(__float_as_uint(fb)));
                f32x16 O[4];
                attn_d_unit(F, b, hd, map, qb, Z, fb, O);
                const int l1 = fresh_lane(), r32 = l1 & 31, hi = l1 >> 5;
                const size_t tok0 = (size_t)b * SEQ + qb * 256 + 32 * F.wave;
                float* o1p = O1s + tok0 * 512 + 128 * hd + r32;
                if (map == 0) {
#pragma unroll
                    for (int r = 0; r < 16; ++r)
#pragma unroll
                        for (int blk = 0; blk < 4; ++blk) o1p[(size_t)ac_crow(r, hi) * 512 + 32 * blk] = O[blk][r];
                } else {
                    LAS float* wsf = (LAS float*)(F.lds + AD_WS) + F.wave * 64;
                    if (hi == 0) wsf[r32] = 0.f;
                    float ss[16];
#pragma unroll
                    for (int r = 0; r < 16; ++r) {
                        float s_ = 0.f;
#pragma unroll
                        for (int blk = 0; blk < 4; ++blk) { const float v = o1p[(size_t)ac_crow(r, hi) * 512 + 32 * blk] - lam * O[blk][r]; O[blk][r] = v; s_ += v * v; }
                        ss[r] = s_;
                    }
                    asm volatile("s_waitcnt lgkmcnt(0)" ::: "memory");
#pragma unroll
                    for (int r = 0; r < 16; ++r) (void)__hip_atomic_fetch_add(&wsf[ac_crow(r, hi)], ss[r], __ATOMIC_RELAXED, __HIP_MEMORY_SCOPE_WAVEFRONT);
                    asm volatile("s_waitcnt lgkmcnt(0)" ::: "memory");
                    float gn[4];
#pragma unroll
                    for (int blk = 0; blk < 4; ++blk) gn[blk] = a.diff_norm_g[32 * blk + r32] * one_m_li;
                    LAS bf16_t* stg = (LAS bf16_t*)(F.lds + AD_OST) + F.wave * 4096;
#pragma unroll
                    for (int r = 0; r < 16; ++r) {
                        const int orow = ac_crow(r, hi);
                        const float rinv = rsqrtf(wsf[orow] * (1.0f / 128.0f) + EPS);
#pragma unroll
                        for (int blk = 0; blk < 4; ++blk) stg[orow * 128 + 32 * blk + r32] = (bf16_t)(pack_bf16(O[blk][r] * rinv * gn[blk], 0.f) & 0xffffu);
                    }
                    asm volatile("s_waitcnt lgkmcnt(0)" ::: "memory");
                    bf16_t* yp = Yo + tok0 * DM + 512 + 128 * hd;
#pragma unroll
                    for (int i = 0; i < 8; ++i) { const int row = i * 4 + (l1 >> 4), ch = l1 & 15; const u32x4 v = *(const LAS u32x4*)(stg + row * 128 + ch * 8); *(u32x4*)(yp + (size_t)row * DM + ch * 8) = v; }
                    asm volatile("s_waitcnt lgkmcnt(0)" ::: "memory");
                }
            }
        }
    }
    if (!DPART)
    for (int it = F.bid; it < 512; it += F.G) {
        const int rnd = it / F.G;
        const int bh = (F.G == 256) ? 4 * xcd + 2 * rnd + (kk >> 4) : it >> 4, pr = (F.G == 256) ? (kk & 15) : (it & 15);
        const int b_ = bh >> 3, hc_ = bh & 7;
        for (int half = 0; half < 2; ++half) {
            int b = b_, hc = hc_; asm volatile("" : "+s"(b), "+s"(hc));
            float fb = a.rel_bias[31 * 12 + hc] * LOG2E; fb = __uint_as_float(__builtin_amdgcn_readfirstlane(__float_as_uint(fb)));
            attn_c_unit(F, b, hc, half ? 31 - pr : pr, Z, Yo, maskg, fb);
        }
    }
}

#ifndef MK_ONE_LAUNCH
#define MK_ONE_LAUNCH 1
#endif
constexpr int NPH = 17;
__global__ void __launch_bounds__(NTHR, 2) fwd_kernel(Args a) {
    extern __shared__ __attribute__((aligned(16))) unsigned char lds_raw[];
    Frame F; F.lds = (LAS unsigned char*)lds_raw; F.tid = threadIdx.x; F.lane = F.tid & 63; F.wave = __builtin_amdgcn_readfirstlane(F.tid >> 6); F.G = gridDim.x; F.bid = blockIdx.x;
    unsigned* ctl = (unsigned*)(a.ws + WS_CTL);
    volatile LAS unsigned* xbw = (volatile LAS unsigned*)(F.lds + LDS_XB);
    if (F.tid < 4) xbw[F.tid] = 0u;
    __syncthreads();
    const int lo = a.ph_lo, hi = a.ph_hi;
    XcdBarrier bar; bar.bar = ctl + CW_BAR; bar.x = 0; bar.st = xbw;
    if (hi - lo > 1) bar = xcd_barrier_post(ctl + CW_BAR, xbw);
#ifndef PH_ONLY
#define IN(k) (lo <= (k) && (k) < hi)
#else
#define IN(k) ((k) == PH_ONLY && lo <= (k) && (k) < hi)
#endif
#ifndef DUP_PH
#define DUP_PH -1
#endif
#define REP(k) for (int rep_ = 0; rep_ < ((k) == DUP_PH ? 2 : 1); ++rep_)
#ifndef TIME_PH
#define TIME_PH -1
#endif
#define TIME_AMP 4
    unsigned long long tp0_ = 0, tp1_ = 0;
    if (TIME_PH == 0) tp0_ = wall_clock64();
#define SEAM(k) do { if (IN(k) && IN((k) + 1)) xcd_barrier(bar); if ((k) == TIME_PH) tp1_ = wall_clock64(); if ((k) + 1 == TIME_PH) tp0_ = wall_clock64(); } while (0)
    float* mod = (float*)(a.ws + WS_MOD);
    bf16_t* hbuf = (bf16_t*)(a.ws + WS_H);
    bf16_t* ybuf = (bf16_t*)(a.ws + WS_Y);
    LAS int* ntp = (LAS int*)(F.lds + LDS_MISC);

    if (IN(0)) REP(0) { p0_prologue(F, a); } SEAM(0);
    if (IN(1)) REP(1) { norm_phase<false, false, false>(F, a, a.x, 0, 0, 0); } SEAM(1);
    if (IN(2)) REP(2) {
        DenseSched S; S.init(NTOK, AB_N, DM, F.G, F.bid, a.ws + WS_WAB_IN);
        EpiAbIn E{(bf16_t*)(a.ws + WS_BIG)};
        pg8::gemm_phase(F.lds, (const char*)hbuf, DM, S, E);
    } SEAM(2);
    if (IN(3)) REP(3) { conv_phase(F, a); } SEAM(3);
    if (IN(4)) REP(4) {
        DenseSched S; S.init(NTOK, DM, DM, F.G, F.bid, a.ws + WS_WAB_OUT);
        EpiResid E{a.x, a.out, mod + 2 * DM};
        pg8::gemm_phase(F.lds, (const char*)ybuf, DM, S, E);
    } SEAM(4);
#define MOE_PHASES(layer, pb) do { \
        const unsigned* cnt = ctl + CW_CNT + (layer) * NEXP * CNT_STRIDE; \
        if (IN(pb)) { route_phase(F, a, (layer)); } SEAM(pb); \
        if (IN((pb) + 1)) REP((pb) + 1) { \
            moe_tile_table(F, cnt, ntp); \
            MoeSched<true> S; S.ntp = ntp; S.cnt = cnt; S.list = (const int*)(a.ws + WS_LIST); S.W = (const char*)(a.ws + WS_MOE_W); S.nU = 4 * ntp[NEXP]; S.G = F.G; S.c = F.bid; \
            EpiMoeUp E{(bf16_t*)(a.ws + WS_ACT)}; \
            pg8::gemm_phase(F.lds, (const char*)hbuf, DM, S, E); \
        } SEAM((pb) + 1); \
        if (IN((pb) + 2)) REP((pb) + 2) { \
            moe_tile_table(F, cnt, ntp); \
            MoeSched<false> S; S.ntp = ntp; S.cnt = cnt; S.list = nullptr; S.W = (const char*)(a.ws + WS_MOE_W); S.nU = 4 * ntp[NEXP]; S.G = F.G; S.c = F.bid; \
            EpiMoeDown E{(bf16_t*)(a.ws + WS_YMOE), (const float*)(a.ws + WS_GATEV), ntp}; \
            pg8::gemm_phase(F.lds, (const char*)(a.ws + WS_ACT), DEXP, S, E); \
        } SEAM((pb) + 2); } while (0)
    MOE_PHASES(0, 5);
    if (IN(8)) {
        norm_phase<true, false, false>(F, a, a.out, 1, 0, 0);
        cvt_run(F, a, 1, CVT_MOE_TILES);
    } SEAM(8);
    if (IN(9)) REP(9) {
        { DenseSched S; S.init(NTOK, CD_N, DM, F.G, F.bid, a.ws + WS_WCD_IN);
          EpiPlain E{(bf16_t*)(a.ws + WS_BIG), CD_N, 0x33u, 0.125f * LOG2E};
          pg8::gemm_phase(F.lds, (const char*)hbuf, DM, S, E); }
    } SEAM(9);
    if (IN(10)) REP(10) { unsigned long long tacc_ = 0; topk_phase(F, a, tacc_); if (TIME_PH > 100 && TIME_PH < 110) { tp0_ = 0; tp1_ = tacc_; } } SEAM(10);
    if (IN(11)) REP(11) { if (TIME_PH == 111) { __syncthreads(); tp0_ = wall_clock64(); } attn_phase<true>(F, a); __syncthreads(); if (TIME_PH == 111) tp1_ = wall_clock64(); if (TIME_PH == 112) tp0_ = wall_clock64(); attn_phase<false>(F, a); if (TIME_PH == 112) { __syncthreads(); tp1_ = wall_clock64(); } } SEAM(11);
    if (IN(12)) {
        DenseSched S; S.init(NTOK, DM, DM, F.G, F.bid, a.ws + WS_WCD_OUT);
        EpiResid E{a.out, a.out, mod + (size_t)NB * 6 * DM + 2 * DM};
        pg8::gemm_phase(F.lds, (const char*)ybuf, DM, S, E);
    } SEAM(12);
    MOE_PHASES(1, 13);
#undef MOE_PHASES
    if (IN(16)) { norm_phase<true, false, true>(F, a, a.out, 1, 0, 1); }
    if (TIME_PH >= 0) {
        if (TIME_PH == 16) { asm volatile("s_waitcnt vmcnt(0)" ::: "memory"); __syncthreads(); tp1_ = wall_clock64(); }
        if (F.bid == 0 && F.tid == 0) { const unsigned long long te = wall_clock64(), dt = (tp1_ - tp0_) * TIME_AMP; while (wall_clock64() - te < dt) __builtin_amdgcn_s_sleep(8); }
    }
#undef IN
#undef SEAM
}

extern "C" void kernel_launch(void* const* d_in, const int* in_sizes, int n_in, void* d_out, int out_size, void* d_ws, size_t ws_size, hipStream_t stream) {
    static int grid = 0;
    if (grid == 0) {
        if (n_in != 26 || out_size != NTOK * DM || ws_size < WS_END) { fprintf(stderr, "kernel_launch: unexpected problem (n_in %d, out %d, ws %zu < %zu)\n", n_in, out_size, ws_size, (size_t)WS_END); grid = -1; return; }
        int dev = 0, cus = 0, per_cu = 0;
        if (hipGetDevice(&dev) != hipSuccess || hipDeviceGetAttribute(&cus, hipDeviceAttributeMultiprocessorCount, dev) != hipSuccess) { grid = -1; return; }
        if (hipFuncSetAttribute((const void*)fwd_kernel, hipFuncAttributeMaxDynamicSharedMemorySize, LDS_BYTES) != hipSuccess) { fprintf(stderr, "kernel_launch: hipFuncSetAttribute failed\n"); grid = -1; return; }
        if (hipOccupancyMaxActiveBlocksPerMultiprocessor(&per_cu, (const void*)fwd_kernel, NTHR, LDS_BYTES) != hipSuccess || per_cu < 1) { fprintf(stderr, "kernel_launch: occupancy query says %d\n", per_cu); }
        (void)hipGetLastError();
        grid = cus;
    }
    if (grid < 0) return;
    (void)hipMemsetAsync((char*)d_ws + WS_CTL, 0, CTL_BYTES, stream);
    Args a{};
    const float** fp = (const float**)&a.x;
    (void)fp;
    a.x = (const float*)d_in[0]; a.c = (const float*)d_in[1]; a.positions = (const int*)d_in[2]; a.rel_bias = (const float*)d_in[3]; a.norm_g = (const float*)d_in[4];
    a.final_norm_g = (const float*)d_in[5]; a.ada_w = (const float*)d_in[6]; a.ada_b = (const float*)d_in[7]; a.ab_w_in = (const float*)d_in[8]; a.ab_conv_a = (const float*)d_in[9];
    a.ab_conv_b = (const float*)d_in[10]; a.ab_conv_b_bias = (const float*)d_in[11]; a.ab_ln_g = (const float*)d_in[12]; a.ab_ln_b = (const float*)d_in[13]; a.ab_w_out = (const float*)d_in[14];
    a.cd_w_in = (const float*)d_in[15]; a.diff_lam = (const float*)d_in[16]; a.diff_norm_g = (const float*)d_in[17]; a.cd_w_out = (const float*)d_in[18];
    a.moe_wr_g = (const float*)d_in[19]; a.moe_br_g = (const float*)d_in[20]; a.moe_wr_e = (const float*)d_in[21]; a.moe_br_e = (const float*)d_in[22];
    a.moe_w_gate = (const float*)d_in[23]; a.moe_w_up = (const float*)d_in[24]; a.moe_w_down = (const float*)d_in[25];
    a.out = (float*)d_out; a.ws = (unsigned char*)d_ws;
#if MK_ONE_LAUNCH
    a.ph_lo = 0; a.ph_hi = NPH;
    hipLaunchKernelGGL(fwd_kernel, dim3(grid), dim3(NTHR), LDS_BYTES, stream, a);
#else
    for (int p = 0; p < NPH; ++p) { a.ph_lo = p; a.ph_hi = p + 1; hipLaunchKernelGGL(fwd_kernel, dim3(grid), dim3(NTHR), LDS_BYTES, stream, a); }
#endif
}
```
